# Optimizing an MI355X kernel written in HIP

```python
import math
import numpy as np
import jax
import jax.numpy as jnp
from jax import lax

D_MODEL = 1024
BATCH = 8
SEQ = 4096
DEPTH = 2

N_MIXERS = 2
HEAD_DIM = 64
MIX_WIDTH = D_MODEL
MEM_HEADS = 4
MEM_WIDTH = MEM_HEADS * HEAD_DIM
TOK_WIDTH = MIX_WIDTH - MEM_WIDTH
MEM_LEN = 256
S5_GROUP_CH = 16
S5_GROUPS = TOK_WIDTH // S5_GROUP_CH
S5_STATE = 64
DT_MIN = 0.001
DT_MAX = 0.1
MOBA_HEADS = TOK_WIDTH // HEAD_DIM
MOBA_BLOCK = 256
MOBA_TOPK = 3
Q_CHUNK = 32
FFN_HIDDEN = -(-(8 * D_MODEL) // (3 * 256)) * 256
N_S5_LAYERS = (DEPTH + 1) // 2
N_MOBA_LAYERS = DEPTH // 2
RMS_EPS = 1e-6
NEG_INF = -1e30

kernel_name = "hybrid_s5_moba_memory_trunk"


def _rmsnorm(x, g):
    xf = x.astype(jnp.float32)
    y = xf * lax.rsqrt(jnp.mean(xf * xf, axis=-1, keepdims=True) + RMS_EPS) * g.astype(jnp.float32)
    return y.astype(x.dtype)


def _alibi_slopes(n):
    return jnp.asarray(2.0 ** (-8.0 * (np.arange(n) + 1) / n), dtype=jnp.float32)


def _swiglu(h, w_gate, w_up, w_down):
    return (jax.nn.silu(h @ w_gate) * (h @ w_up)) @ w_down


def _memory_attention(q, mem_k, mem_v):
    bsz, s, _ = q.shape
    qh = q.astype(jnp.float32).reshape(bsz, s, MEM_HEADS, HEAD_DIM) * (HEAD_DIM ** -0.5)
    scores = jnp.einsum('bshd,bmhd->bhsm', qh, mem_k.astype(jnp.float32))
    p = jax.nn.softmax(scores, axis=-1)
    out = jnp.einsum('bhsm,bmhd->bshd', p, mem_v.astype(jnp.float32))
    return out.reshape(bsz, s, MEM_WIDTH).astype(q.dtype)


def _s5_mixer(u, lam_re, lam_im, log_dt, b_re, b_im, c_re, c_im, d, w_glu, b_glu):
    bsz, s, _ = u.shape
    f32 = jnp.float32
    uf = u.astype(f32)
    ug = uf.reshape(bsz, s, S5_GROUPS, S5_GROUP_CH)
    lr = lam_re.astype(f32)
    li = lam_im.astype(f32)
    dt = jnp.exp(log_dt.astype(f32))[:, None]
    mag = jnp.exp(lr * dt)
    ar = mag * jnp.cos(li * dt)
    ai = mag * jnp.sin(li * dt)
    den = lr * lr + li * li
    nr = ar - 1.0
    fr = (nr * lr + ai * li) / den
    fi = (ai * lr - nr * li) / den
    br = b_re.astype(f32)
    bi = b_im.astype(f32)
    bbr = fr[..., None] * br - fi[..., None] * bi
    bbi = fr[..., None] * bi + fi[..., None] * br
    bu_r = jnp.einsum('bsgc,gpc->bsgp', ug, bbr)
    bu_i = jnp.einsum('bsgc,gpc->bsgp', ug, bbi)
    a_r = jnp.broadcast_to(ar[None, None], (1, s, S5_GROUPS, S5_STATE))
    a_i = jnp.broadcast_to(ai[None, None], (1, s, S5_GROUPS, S5_STATE))

    def combine(e1, e2):
        a1r, a1i, b1r, b1i = e1
        a2r, a2i, b2r, b2i = e2
        return (a2r * a1r - a2i * a1i,
                a2r * a1i + a2i * a1r,
                a2r * b1r - a2i * b1i + b2r,
                a2r * b1i + a2i * b1r + b2i)

    _, _, xr, xi = lax.associative_scan(combine, (a_r, a_i, bu_r, bu_i), axis=1)
    y = (jnp.einsum('bsgp,gcp->bsgc', xr, c_re.astype(f32))
         - jnp.einsum('bsgp,gcp->bsgc', xi, c_im.astype(f32)))
    y = y.reshape(bsz, s, TOK_WIDTH) + d.astype(f32) * uf
    y = jax.nn.gelu(y, approximate=False)
    y = y * jax.nn.sigmoid(y @ w_glu.astype(f32) + b_glu.astype(f32))
    return y.astype(u.dtype)


def _moba_attention(q, k, v, slopes):
    bsz, nh, s, dh = q.shape
    nb = -(-s // MOBA_BLOCK)
    pad = nb * MOBA_BLOCK - s
    k_blk = jnp.pad(k, ((0, 0), (0, 0), (0, pad), (0, 0))).reshape(bsz, nh, nb, MOBA_BLOCK, dh)
    v_blk = jnp.pad(v, ((0, 0), (0, 0), (0, pad), (0, 0))).reshape(bsz, nh, nb, MOBA_BLOCK, dh)
    k_mean = jnp.mean(k_blk, axis=3)
    top = min(MOBA_TOPK, nb)
    n_chunks = s // Q_CHUNK
    q_chunks = (q * (dh ** -0.5)).reshape(bsz, nh, n_chunks, Q_CHUNK, dh).transpose(2, 0, 1, 3, 4)
    offs = jnp.arange(MOBA_BLOCK, dtype=jnp.int32)
    blk_ids = jnp.arange(nb, dtype=jnp.int32)
    bidx = jnp.arange(bsz)[:, None, None, None]
    hidx = jnp.arange(nh)[None, :, None, None]
    slope5 = slopes[None, :, None, None, None]

    def one_chunk(args):
        ci, qc = args
        start = ci * Q_CHUNK
        t = start + jnp.arange(Q_CHUNK, dtype=jnp.int32)
        qb = start // MOBA_BLOCK
        gate = jnp.einsum('bhqd,bhnd->bhqn', qc, k_mean)
        gate = jnp.where(blk_ids < qb, gate, NEG_INF)
        _, sel = lax.top_k(gate, top)
        valid = jnp.arange(top) < qb
        k_sel = k_blk[bidx, hidx, sel]
        v_sel = v_blk[bidx, hidx, sel]
        s_sel = jnp.einsum('bhqd,bhqnld->bhqnl', qc, k_sel)
        pos_sel = sel[..., None] * MOBA_BLOCK + offs
        dist_sel = (t[None, None, :, None, None] - pos_sel).astype(jnp.float32)
        s_sel = jnp.where(valid[None, None, None, :, None], s_sel - slope5 * dist_sel, NEG_INF)
        k_own = lax.dynamic_index_in_dim(k_blk, qb, axis=2, keepdims=False)
        v_own = lax.dynamic_index_in_dim(v_blk, qb, axis=2, keepdims=False)
        s_own = jnp.einsum('bhqd,bhld->bhql', qc, k_own)
        dist_own = t[:, None] - (qb * MOBA_BLOCK + offs)[None, :]
        s_own = jnp.where(dist_own[None, None] >= 0,
                          s_own - slopes[:, None, None] * dist_own.astype(jnp.float32)[None, None],
                          NEG_INF)
        n_sel = top * MOBA_BLOCK
        s_all = jnp.concatenate([s_sel.reshape(bsz, nh, Q_CHUNK, n_sel), s_own], axis=-1)
        p = jax.nn.softmax(s_all, axis=-1)
        p_sel = p[..., :n_sel].reshape(bsz, nh, Q_CHUNK, top, MOBA_BLOCK)
        p_own = p[..., n_sel:]
        return (jnp.einsum('bhqnl,bhqnld->bhqd', p_sel, v_sel)
                + jnp.einsum('bhql,bhld->bhqd', p_own, v_own))

    out = lax.map(one_chunk, (jnp.arange(n_chunks, dtype=jnp.int32), q_chunks))
    return out.transpose(1, 2, 0, 3, 4).reshape(bsz, nh, s, dh)


def _moba_mixer(qkv, slopes):
    bsz, s, _ = qkv.shape
    t = qkv.astype(jnp.float32).reshape(bsz, s, 3, MOBA_HEADS, HEAD_DIM).transpose(2, 0, 3, 1, 4)
    out = _moba_attention(t[0], t[1], t[2], slopes)
    return out.transpose(0, 2, 1, 3).reshape(bsz, s, TOK_WIDTH).astype(qkv.dtype)


def setup_inputs(seed: int = 0) -> dict:
    key = jax.random.key(seed)
    ks = jax.random.split(key, 24)
    f32 = jnp.float32

    def nrm(k, shape, scale):
        return jax.random.normal(k, shape, f32) * scale

    n_idx = jnp.arange(S5_STATE, dtype=f32)
    return {
        "x": nrm(ks[0], (BATCH, SEQ, D_MODEL), 1.0),
        "mem": nrm(ks[1], (BATCH, MEM_LEN, D_MODEL), 1.0),
        "mem_norm_g": 1.0 + nrm(ks[2], (D_MODEL,), 0.01),
        "w_mem_kv": nrm(ks[3], (D_MODEL, 2 * MEM_WIDTH), D_MODEL ** -0.5),
        "mix_norm_g": 1.0 + nrm(ks[4], (DEPTH, D_MODEL), 0.01),
        "s5_w_in": nrm(ks[5], (N_S5_LAYERS, D_MODEL, TOK_WIDTH + MEM_WIDTH), D_MODEL ** -0.5),
        "s5_lambda_re": -0.5 + nrm(ks[6], (N_S5_LAYERS, S5_GROUPS, S5_STATE), 0.01),
        "s5_lambda_im": math.pi * n_idx + nrm(ks[7], (N_S5_LAYERS, S5_GROUPS, S5_STATE), 0.01),
        "s5_log_dt": jax.random.uniform(ks[8], (N_S5_LAYERS, S5_GROUPS), f32,
                                        minval=math.log(DT_MIN), maxval=math.log(DT_MAX)),
        "s5_b_re": nrm(ks[9], (N_S5_LAYERS, S5_GROUPS, S5_STATE, S5_GROUP_CH), (2 * S5_GROUP_CH) ** -0.5),
        "s5_b_im": nrm(ks[10], (N_S5_LAYERS, S5_GROUPS, S5_STATE, S5_GROUP_CH), (2 * S5_GROUP_CH) ** -0.5),
        "s5_c_re": nrm(ks[11], (N_S5_LAYERS, S5_GROUPS, S5_GROUP_CH, S5_STATE), (2 * S5_STATE) ** -0.5),
        "s5_c_im": nrm(ks[12], (N_S5_LAYERS, S5_GROUPS, S5_GROUP_CH, S5_STATE), (2 * S5_STATE) ** -0.5),
        "s5_d": nrm(ks[13], (N_S5_LAYERS, TOK_WIDTH), 1.0),
        "s5_w_glu": nrm(ks[14], (N_S5_LAYERS, TOK_WIDTH, TOK_WIDTH), TOK_WIDTH ** -0.5),
        "s5_b_glu": nrm(ks[15], (N_S5_LAYERS, TOK_WIDTH), 0.01),
        "moba_w_in": nrm(ks[16], (N_MOBA_LAYERS, D_MODEL, 3 * TOK_WIDTH + MEM_WIDTH), D_MODEL ** -0.5),
        "w_out": nrm(ks[17], (DEPTH, MIX_WIDTH, D_MODEL), MIX_WIDTH ** -0.5),
        "ffn_norm_g": 1.0 + nrm(ks[18], (DEPTH, D_MODEL), 0.01),
        "w_gate": nrm(ks[19], (DEPTH, D_MODEL, FFN_HIDDEN), D_MODEL ** -0.5),
        "w_up": nrm(ks[20], (DEPTH, D_MODEL, FFN_HIDDEN), D_MODEL ** -0.5),
        "w_down": nrm(ks[21], (DEPTH, FFN_HIDDEN, D_MODEL), FFN_HIDDEN ** -0.5),
        "final_norm_g": 1.0 + nrm(ks[22], (D_MODEL,), 0.01),
    }


def reference(x, mem, mem_norm_g, w_mem_kv, mix_norm_g, s5_w_in, s5_lambda_re, s5_lambda_im,
              s5_log_dt, s5_b_re, s5_b_im, s5_c_re, s5_c_im, s5_d, s5_w_glu, s5_b_glu,
              moba_w_in, w_out, ffn_norm_g, w_gate, w_up, w_down, final_norm_g):
    bsz = x.shape[0]
    mem_kv = _rmsnorm(mem, mem_norm_g) @ w_mem_kv
    mem_k = mem_kv[..., :MEM_WIDTH].reshape(bsz, -1, MEM_HEADS, HEAD_DIM)
    mem_v = mem_kv[..., MEM_WIDTH:].reshape(bsz, -1, MEM_HEADS, HEAD_DIM)
    slopes = _alibi_slopes(MOBA_HEADS)

    for i in range(DEPTH):
        j = i // N_MIXERS
        h = _rmsnorm(x, mix_norm_g[i])
        if i % N_MIXERS == 0:
            proj = h @ s5_w_in[j]
            tok = _s5_mixer(proj[..., :TOK_WIDTH], s5_lambda_re[j], s5_lambda_im[j], s5_log_dt[j],
                            s5_b_re[j], s5_b_im[j], s5_c_re[j], s5_c_im[j], s5_d[j],
                            s5_w_glu[j], s5_b_glu[j])
        else:
            proj = h @ moba_w_in[j]
            tok = _moba_mixer(proj[..., :3 * TOK_WIDTH], slopes)
        mem_out = _memory_attention(proj[..., -MEM_WIDTH:], mem_k, mem_v)
        x = x + jnp.concatenate([tok, mem_out], axis=-1) @ w_out[i]
        h = _rmsnorm(x, ffn_norm_g[i])
        x = x + _swiglu(h, w_gate[i], w_up[i], w_down[i])
    return _rmsnorm(x, final_norm_g)
```

```cpp
#include <hip/hip_runtime.h>
#include <hip/hip_bf16.h>
#include <cstdio>
#include <cstdint>
#include <cmath>
namespace pg8 {
#define PG8_LAS __attribute__((address_space(3)))
typedef unsigned short bf16_t;
typedef short bf16x8 __attribute__((ext_vector_type(8)));
typedef float f32x4 __attribute__((ext_vector_type(4)));
typedef unsigned u32x4 __attribute__((ext_vector_type(4)));
constexpr int BM = 256, BK = 64, HALF = 128, HTB = HALF * BK * 2  , STAGE_BYTES = 8 * HTB, NXCD = 8, WGM = 8;

__host__ __device__ __forceinline__ int lds_byte(int r, int c) { const int st = (r >> 4) * 2 + (c >> 5), rr = r & 15, cc = c & 31, ob = rr * 64 + cc * 2; return st * 1024 + (ob ^ (((ob >> 9) & 1) << 5)); }
__host__ __device__ __forceinline__ void stage_rc(int b, int& R, int& C) { const int st = b / 1024, sb = b % 1024, swz = sb ^ (((sb >> 9) & 1) << 5); R = (st >> 1) * 16 + swz / 64; C = (st & 1) * 32 + (swz % 64) / 2; }
__host__ __device__ __forceinline__ int perm32(int rho) { const int n = rho >> 4, i = rho & 15; return 8 * (i >> 2) + 4 * n + (i & 3); }

struct Unit { int pm, pn; };
struct Gemm { const bf16_t* A; const bf16_t* Bt; int M, N, K; };

struct StaticOrder {
    int nM, nN, nwg, G, c;
    __host__ __device__ void init(int M, int N, int G_, int c_) { nM = M / BM; nN = N / BM; nwg = nM * nN; G = G_; c = c_; }
    __host__ __device__ bool next(int i, Unit& u) const {
        const long L = (long)i * G + c; if (L >= nwg) return false;
        int wgid = (int)L; { const int q = nwg / NXCD, r = nwg % NXCD, xcd = wgid % NXCD, off = wgid / NXCD; wgid = (xcd < r ? xcd * (q + 1) : r * (q + 1) + (xcd - r) * q) + off; }
        const int nig = WGM * nN, gid = wgid / nig, fm = gid * WGM, gsz = (nM - fm) < WGM ? (nM - fm) : WGM;
        u.pm = fm + ((wgid % nig) % gsz); u.pn = (wgid % nig) / gsz; return true;
    }
    __device__ __forceinline__ void a_ready(const Unit&) const {}
    __device__ __forceinline__ void done(const Unit&) const {}
};

__device__ __forceinline__ unsigned cvt_pk_bf16(float lo, float hi) { unsigned r; asm volatile("v_cvt_pk_bf16_f32 %0, %1, %2" : "=v"(r) : "v"(lo), "v"(hi)); return r; }
typedef float f32x2 __attribute__((ext_vector_type(2)));
typedef unsigned u32x2 __attribute__((ext_vector_type(2)));
constexpr float RMS_EPS = 1e-6f;
__device__ __forceinline__ float row_rstd(const float* ssq, int row) {
    const f32x4* p = (const f32x4*)(ssq + (size_t)row * 16);
    const f32x4 a = p[0], b = p[1], c = p[2], d = p[3];
    const float s = (((a[0] + a[1]) + (a[2] + a[3])) + ((b[0] + b[1]) + (b[2] + b[3]))) + (((c[0] + c[1]) + (c[2] + c[3])) + ((d[0] + d[1]) + (d[2] + d[3])));
    return 1.0f / sqrtf(s * (1.0f / 1024.0f) + RMS_EPS);
}
__device__ __forceinline__ float bf2f(unsigned short h) { return __uint_as_float(((unsigned)h) << 16); }
__device__ __forceinline__ float bflo(unsigned w) { return __uint_as_float(w << 16); }
__device__ __forceinline__ float bfhi(unsigned w) { return __uint_as_float(w & 0xffff0000u); }

__device__ __forceinline__ f32x2 gelu_pk(f32x2 v) {
    const f32x2 av = __builtin_elementwise_abs(v), d = av * 0.2316418882f + 1.0f;
    f32x2 t; t.x = __builtin_amdgcn_rcpf(d.x); t.y = __builtin_amdgcn_rcpf(d.y);
    f32x2 q = t * 0.5307027145f + (-0.7265760135f); q = q * t + 0.7107068705f; q = q * t + (-0.142248368f); q = q * t + 0.127414796f; q = q * t;
    const f32x2 s = (v * v) * (-0.72134752044f);
    f32x2 e; e.x = __builtin_amdgcn_exp2f(s.x); e.y = __builtin_amdgcn_exp2f(s.y);
    const f32x2 m = v * (q * e), r = v - m;
    f32x2 o; o.x = v.x < 0.f ? m.x : r.x; o.y = v.y < 0.f ? m.y : r.y; return o;
}

struct EpiProj {
    static constexpr bool PERM = true, AFTER_DRAIN = false;
    const float* ssq; bf16_t* base; size_t seg_stride; int tps, nseg, ldc; float scale0; bf16_t* qm; float scale_qm;
    __device__ __forceinline__ void operator()(const f32x4 (&acc)[2][2][4][2], const Unit& u, int wr, int wc, int fr, int fq) const {
        const int seg = u.pn / tps, within = u.pn - seg * tps;
        bf16_t* o; int ld, colt; float sc;
        if (seg < nseg) { o = base + (size_t)seg * seg_stride; ld = ldc; colt = within * BM; sc = (seg == 0) ? scale0 : 1.0f; }
        else { o = qm; ld = 256; colt = 0; sc = scale_qm; }
        const int row0 = u.pm * BM + wr * 64 + fr, col0 = colt + wc * 32 + 8 * fq;
#pragma unroll
        for (int ai = 0; ai < 2; ++ai)
#pragma unroll
            for (int m = 0; m < 4; ++m) { const int row = row0 + ai * HALF + m * 16; const float rs = row_rstd(ssq, row) * sc; bf16_t* rowp = o + (size_t)row * ld + col0;
#pragma unroll
                for (int bj = 0; bj < 2; ++bj) { const f32x4 v0 = acc[ai][bj][m][0] * rs, v1 = acc[ai][bj][m][1] * rs;
                    u32x4 w; w.x = cvt_pk_bf16(v0[0], v0[1]); w.y = cvt_pk_bf16(v0[2], v0[3]); w.z = cvt_pk_bf16(v1[0], v1[1]); w.w = cvt_pk_bf16(v1[2], v1[3]);
                    *(u32x4*)(rowp + bj * HALF) = w; } }
    }
};
struct EpiGlu {
    static constexpr bool PERM = true, AFTER_DRAIN = false;
    const bf16_t* Y; int ldy; const float* bias; bf16_t* mix; int ldm;
    __device__ __forceinline__ void operator()(const f32x4 (&acc)[2][2][4][2], const Unit& u, int wr, int wc, int fr, int fq) const {
        const int row0 = u.pm * BM + wr * 64 + fr, col0 = u.pn * BM + wc * 32 + 8 * fq;
        f32x4 bv[2][2];
#pragma unroll
        for (int bj = 0; bj < 2; ++bj)
#pragma unroll
            for (int n = 0; n < 2; ++n) bv[bj][n] = *(const f32x4*)(bias + col0 + bj * HALF + 4 * n);
#pragma unroll
        for (int ai = 0; ai < 2; ++ai)
#pragma unroll
            for (int m = 0; m < 4; ++m) { const int row = row0 + ai * HALF + m * 16;
#pragma unroll
                for (int bj = 0; bj < 2; ++bj) { const u32x4 yw = *(const u32x4*)(Y + (size_t)row * ldy + col0 + bj * HALF);
                    const f32x4 z0 = acc[ai][bj][m][0] + bv[bj][0], z1 = acc[ai][bj][m][1] + bv[bj][1];
                    float t[8]; const float yv[8] = {bflo(yw.x), bfhi(yw.x), bflo(yw.y), bfhi(yw.y), bflo(yw.z), bfhi(yw.z), bflo(yw.w), bfhi(yw.w)};
#pragma unroll
                    for (int e = 0; e < 4; ++e) { t[e] = yv[e] * __builtin_amdgcn_rcpf(1.0f + __builtin_amdgcn_exp2f(-1.4426950408889634f * z0[e])); t[4 + e] = yv[4 + e] * __builtin_amdgcn_rcpf(1.0f + __builtin_amdgcn_exp2f(-1.4426950408889634f * z1[e])); }
                    u32x4 w; w.x = cvt_pk_bf16(t[0], t[1]); w.y = cvt_pk_bf16(t[2], t[3]); w.z = cvt_pk_bf16(t[4], t[5]); w.w = cvt_pk_bf16(t[6], t[7]);
                    *(u32x4*)(mix + (size_t)row * ldm + col0 + bj * HALF) = w; } }
    }
};
struct EpiRes {
    static constexpr bool PERM = false, AFTER_DRAIN = false;
    const float* base; float* out; bf16_t* xb; float* ssq_out;
    __device__ __forceinline__ void operator()(const f32x4 (&acc)[2][2][4][2], const Unit& u, int wr, int wc, int fr, int fq) const {
        const int row0 = u.pm * BM + wr * 64 + fr, col0 = u.pn * BM + wc * 32 + 4 * fq;
#pragma unroll
        for (int ai = 0; ai < 2; ++ai)
#pragma unroll
            for (int m = 0; m < 4; ++m) { const int row = row0 + ai * HALF + m * 16; const size_t off = (size_t)row * 1024 + col0; float ss = 0.f;
#pragma unroll
                for (int bj = 0; bj < 2; ++bj)
#pragma unroll
                    for (int n = 0; n < 2; ++n) { const f32x4 b = *(const f32x4*)(base + off + bj * HALF + n * 16); const f32x4 o = b + acc[ai][bj][m][n];
                        *(f32x4*)(out + off + bj * HALF + n * 16) = o; u32x2 w; w.x = cvt_pk_bf16(o[0], o[1]); w.y = cvt_pk_bf16(o[2], o[3]); *(u32x2*)(xb + off + bj * HALF + n * 16) = w;
                        ss += (o[0] * o[0] + o[1] * o[1]) + (o[2] * o[2] + o[3] * o[3]); }
                ss += __shfl_xor(ss, 16); ss += __shfl_xor(ss, 32);
                if (fq == 0) ssq_out[(size_t)row * 16 + u.pn * 4 + wc] = ss; }
    }
};
struct EpiGU {
    static constexpr bool PERM = true, AFTER_DRAIN = false;
    const float* ssq; bf16_t* H; int ldh;
    __device__ __forceinline__ void operator()(const f32x4 (&acc)[2][2][4][2], const Unit& u, int wr, int wc, int fr, int fq) const {
        const int row0 = u.pm * BM + wr * 64 + fr, col0 = u.pn * HALF + wc * 32 + 8 * fq;
#pragma unroll
        for (int ai = 0; ai < 2; ++ai)
#pragma unroll
            for (int m = 0; m < 4; ++m) { const int row = row0 + ai * HALF + m * 16; const float rs = row_rstd(ssq, row);
                float t[8];
#pragma unroll
                for (int n = 0; n < 2; ++n)
#pragma unroll
                    for (int e = 0; e < 4; ++e) { const float g = acc[ai][0][m][n][e] * rs, up = acc[ai][1][m][n][e] * rs;
                        t[4 * n + e] = g * __builtin_amdgcn_rcpf(1.0f + __builtin_amdgcn_exp2f(-1.4426950408889634f * g)) * up; }
                u32x4 w; w.x = cvt_pk_bf16(t[0], t[1]); w.y = cvt_pk_bf16(t[2], t[3]); w.z = cvt_pk_bf16(t[4], t[5]); w.w = cvt_pk_bf16(t[6], t[7]);
                *(u32x4*)(H + (size_t)row * ldh + col0) = w; }
    }
};

template <class Epi, class Sched, bool ALIGN_EPI = false, bool SP2 = false>
__device__ __forceinline__ void gemm_phase(PG8_LAS unsigned char* lds, const Gemm g, const Sched& S, const Epi& E) {
    const int tid = threadIdx.x, wid = __builtin_amdgcn_readfirstlane(tid >> 6), lane = tid & 63, wr = wid >> 2, wc = wid & 3, fr = lane & 15, fq = lane >> 4;
    const int K = g.K, nt = K / BK;
    unsigned voffA[2], voffB[2];
#pragma unroll
    for (int i = 0; i < 2; ++i) { int R, C; stage_rc(tid * 16 + i * 8192, R, C); const int Rb = Epi::PERM ? ((R & ~31) + perm32(R & 31)) : R;
        voffA[i] = (unsigned)(R * K + C) * 2u; voffB[i] = (unsigned)(Rb * K + C) * 2u; }
    const size_t kstep = (size_t)(BK * 2);
    const size_t hstep = (size_t)HALF * K * 2;
    const size_t tstep = 2 * hstep;
    const unsigned ldsw = (unsigned)wid * 1024u;
    const int aoff = lds_byte(wr * 64 + fr, fq * 8), boff = lds_byte(wc * 32 + fr, fq * 8);
#define PG8_SA(b, h) (((b) * 2 + (h)) * HTB)
#define PG8_SB(b, h) ((4 + (b) * 2 + (h)) * HTB)
#define PG8_STAGE(bufoff, gbase, voff) do { _Pragma("unroll") for (int _i = 0; _i < 2; ++_i) \
        __builtin_amdgcn_global_load_lds((const unsigned*)((const char*)(gbase) + (voff)[_i]), (PG8_LAS unsigned*)(lds + (bufoff) + ldsw + _i * 8192), 16, 0, 0); } while (0)
#define PG8_LDA(dst, b, h) do { _Pragma("unroll") for (int m = 0; m < 4; ++m) _Pragma("unroll") for (int k = 0; k < 2; ++k) dst[m][k] = *(const PG8_LAS bf16x8*)(lds + PG8_SA(b, h) + aoff + m * 2048 + k * 1024); } while (0)
#define PG8_LDB(dst, b, h) do { _Pragma("unroll") for (int n = 0; n < 2; ++n) _Pragma("unroll") for (int k = 0; k < 2; ++k) dst[n][k] = *(const PG8_LAS bf16x8*)(lds + PG8_SB(b, h) + boff + n * 2048 + k * 1024); } while (0)
#define PG8_MMA(ai, bj, At, Bt) do { __builtin_amdgcn_s_setprio(1); _Pragma("unroll") for (int m = 0; m < 4; ++m) _Pragma("unroll") for (int n = 0; n < 2; ++n) _Pragma("unroll") for (int k = 0; k < 2; ++k) \
        acc[ai][bj][m][n] = __builtin_amdgcn_mfma_f32_16x16x32_bf16(Bt[n][k], At[m][k], acc[ai][bj][m][n], 0, 0, 0); __builtin_amdgcn_s_setprio(0); } while (0)
#define PG8_WAIT_V(n) asm volatile("s_waitcnt vmcnt(" #n ")" ::: "memory")
#define PG8_WAIT_L(n) asm volatile("s_waitcnt lgkmcnt(" #n ")" ::: "memory")
#define PG8_BAR __builtin_amdgcn_s_barrier()
#define PG8_SCHED __builtin_amdgcn_sched_barrier(0)
    Unit cur, nxt; int ui = 0;
    if (!S.next(0, cur)) return;
    f32x4 acc[2][2][4][2];
#pragma unroll
    for (int a = 0; a < 2; ++a)
#pragma unroll
        for (int b = 0; b < 2; ++b)
#pragma unroll
            for (int m = 0; m < 4; ++m)
#pragma unroll
                for (int n = 0; n < 2; ++n) acc[a][b][m][n] = (f32x4){0.f, 0.f, 0.f, 0.f};
    bf16x8 At[4][2], B0[2][2], B1[2][2];
    const char* cA = (const char*)g.A + (size_t)cur.pm * tstep; const char* cB = (const char*)g.Bt + (size_t)cur.pn * tstep;
    S.a_ready(cur);
    if constexpr (SP2) {
        PG8_STAGE(PG8_SB(0, 0), cB, voffB); PG8_STAGE(PG8_SB(0, 1), cB + hstep, voffB); PG8_STAGE(PG8_SA(0, 0), cA, voffA); PG8_STAGE(PG8_SA(0, 1), cA + hstep, voffA);
        if (wr == 1) PG8_BAR;
        PG8_WAIT_V(2); PG8_BAR;
        PG8_STAGE(PG8_SB(1, 0), cB + kstep, voffB); PG8_STAGE(PG8_SA(1, 0), cA + kstep, voffA); PG8_STAGE(PG8_SB(1, 1), cB + hstep + kstep, voffB);
        PG8_WAIT_V(6); PG8_BAR;
    } else {
        PG8_STAGE(PG8_SB(0, 0), cB, voffB); PG8_STAGE(PG8_SA(0, 0), cA, voffA); PG8_STAGE(PG8_SB(0, 1), cB + hstep, voffB); PG8_STAGE(PG8_SA(0, 1), cA + hstep, voffA);
        if (wr == 1) PG8_BAR;
        PG8_WAIT_V(4); PG8_BAR;
        PG8_STAGE(PG8_SB(1, 0), cB + kstep, voffB); PG8_STAGE(PG8_SA(1, 0), cA + kstep, voffA); PG8_STAGE(PG8_SB(1, 1), cB + hstep + kstep, voffB);
        PG8_WAIT_V(6); PG8_BAR;
    }
    for (;;) {
        const bool has_next = S.next(ui + 1, nxt);
        const char* nA = has_next ? (const char*)g.A + (size_t)nxt.pm * tstep : cA; const char* nB = has_next ? (const char*)g.Bt + (size_t)nxt.pn * tstep : cB;
        for (int t = 0; t < nt; t += 2) {
            const bool last = (t == nt - 2);
            const char* a1 = cA + (size_t)(t + 1) * kstep;
            const char* a2 = last ? nA : cA + (size_t)(t + 2) * kstep; const char* b2 = last ? nB : cB + (size_t)(t + 2) * kstep;
            const char* a3 = a2 + kstep; const char* b3 = b2 + kstep;
            if (last && has_next) S.a_ready(nxt);
            if constexpr (SP2) {
            PG8_LDB(B0, 0, 0); PG8_LDB(B1, 0, 1); PG8_SCHED; PG8_LDA(At, 0, 0); PG8_STAGE(PG8_SA(1, 1), a1 + hstep, voffA);
            PG8_WAIT_V(8); PG8_WAIT_L(0); PG8_BAR; PG8_MMA(0, 0, At, B0); PG8_MMA(0, 1, At, B1); PG8_BAR; PG8_SCHED;
            PG8_LDA(At, 0, 1); PG8_STAGE(PG8_SB(0, 0), b2, voffB); PG8_STAGE(PG8_SB(0, 1), b2 + hstep, voffB); PG8_STAGE(PG8_SA(0, 0), a2, voffA);
            PG8_WAIT_V(8); PG8_WAIT_L(0); PG8_BAR; PG8_MMA(1, 0, At, B0); PG8_MMA(1, 1, At, B1); PG8_BAR; PG8_SCHED;
            PG8_LDB(B0, 1, 0); PG8_LDB(B1, 1, 1); PG8_SCHED; PG8_LDA(At, 1, 0); PG8_STAGE(PG8_SA(0, 1), a2 + hstep, voffA);
            PG8_WAIT_V(8); PG8_WAIT_L(0); PG8_BAR; PG8_MMA(0, 0, At, B0); PG8_MMA(0, 1, At, B1); PG8_BAR; PG8_SCHED;
            PG8_LDA(At, 1, 1); PG8_STAGE(PG8_SB(1, 0), b3, voffB); PG8_STAGE(PG8_SB(1, 1), b3 + hstep, voffB); PG8_STAGE(PG8_SA(1, 0), a3, voffA);
            PG8_WAIT_V(8); PG8_WAIT_L(0); PG8_BAR; PG8_MMA(1, 0, At, B0); PG8_MMA(1, 1, At, B1); PG8_BAR; PG8_SCHED;
            } else {
            PG8_LDB(B0, 0, 0); PG8_SCHED; PG8_LDA(At, 0, 0); PG8_STAGE(PG8_SA(1, 1), a1 + hstep, voffA);
            PG8_WAIT_L(8); PG8_BAR; PG8_WAIT_L(0); PG8_MMA(0, 0, At, B0); PG8_BAR; PG8_SCHED;
            PG8_LDB(B1, 0, 1); PG8_STAGE(PG8_SB(0, 0), b2, voffB);
            PG8_BAR; PG8_WAIT_L(0); PG8_MMA(0, 1, At, B1); PG8_BAR;
            PG8_LDA(At, 0, 1); PG8_STAGE(PG8_SA(0, 0), a2, voffA);
            PG8_BAR; PG8_WAIT_L(0); PG8_MMA(1, 0, At, B0); PG8_BAR; PG8_SCHED;
            PG8_STAGE(PG8_SB(0, 1), b2 + hstep, voffB);
            PG8_WAIT_V(6); PG8_BAR; PG8_MMA(1, 1, At, B1); PG8_BAR;
            PG8_LDB(B0, 1, 0); PG8_SCHED; PG8_LDA(At, 1, 0); PG8_STAGE(PG8_SA(0, 1), a2 + hstep, voffA);
            PG8_WAIT_L(8); PG8_BAR; PG8_WAIT_L(0); PG8_MMA(0, 0, At, B0); PG8_BAR; PG8_SCHED;
            PG8_LDB(B1, 1, 1); PG8_STAGE(PG8_SB(1, 0), b3, voffB);
            PG8_BAR; PG8_WAIT_L(0); PG8_MMA(0, 1, At, B1); PG8_BAR;
            PG8_LDA(At, 1, 1); PG8_STAGE(PG8_SA(1, 0), a3, voffA);
            PG8_BAR; PG8_WAIT_L(0); PG8_MMA(1, 0, At, B0); PG8_BAR; PG8_SCHED;
            PG8_STAGE(PG8_SB(1, 1), b3 + hstep, voffB);
            PG8_WAIT_V(6); PG8_BAR; PG8_MMA(1, 1, At, B1); PG8_BAR;
            }
        }
        if constexpr (ALIGN_EPI) { if (wr == 0) PG8_BAR; }
        if constexpr (!Epi::AFTER_DRAIN) { E(acc, cur, wr, wc, fr, fq); S.done(cur); }
        if (!has_next) break;
#pragma unroll
        for (int a = 0; a < 2; ++a)
#pragma unroll
            for (int b = 0; b < 2; ++b)
#pragma unroll
                for (int m = 0; m < 4; ++m)
#pragma unroll
                    for (int n = 0; n < 2; ++n) acc[a][b][m][n] = (f32x4){0.f, 0.f, 0.f, 0.f};
        cur = nxt; cA = nA; cB = nB; ++ui;
        if constexpr (ALIGN_EPI) { if (wr == 1) PG8_BAR; }
    }
    PG8_WAIT_V(0);
    if constexpr (!ALIGN_EPI) { if (wr == 0) PG8_BAR; }
    PG8_BAR;
    if constexpr (Epi::AFTER_DRAIN) { E.fused(acc, cur, wr, wc, fr, fq, lds, wid, lane); S.done(cur); }
#undef PG8_SA
#undef PG8_SB
#undef PG8_STAGE
#undef PG8_LDA
#undef PG8_LDB
#undef PG8_MMA
#undef PG8_WAIT_V
#undef PG8_WAIT_L
#undef PG8_BAR
#undef PG8_SCHED
}
}
constexpr int NWAVES = 8;
constexpr int BATCH = 8, SEQ = 4096, DM = 1024, TOK = BATCH * SEQ;
constexpr int TOKW = 768, MEMW = 256, MEML = 256, NGRP = 48, NST = 64, GCH = 16, NHEAD = 12, MHEAD = 4, HD = 64, FFN = 2816, NBLK = 16, MBLK = 256;
constexpr float C2 = 0.125f * 1.4426950408889634f;
constexpr float LOG2E = 1.4426950408889634f;

constexpr size_t MiB = 1u << 20;
constexpr size_t WS_CTL = 0, CTL_ZERO_BYTES = 1 * MiB;
constexpr size_t WS_SS0 = 1 * MiB, WS_SSA = 3 * MiB, WS_SSB = 5 * MiB, WS_SSM = 7 * MiB, WS_KMEAN = 8 * MiB;
constexpr size_t WS_WIN0 = 16 * MiB, WS_WGLU = 18 * MiB, WS_WIN1 = 20 * MiB, WS_WOUT0 = 26 * MiB, WS_WOUT1 = 28 * MiB;
constexpr size_t WS_WGU0 = 30 * MiB, WS_WGU1 = 41 * MiB, WS_WDN0 = 52 * MiB, WS_WDN1 = 58 * MiB, WS_WMKV = 64 * MiB;
constexpr size_t WS_MEMB = 65 * MiB, WS_MEMK = 69 * MiB, WS_MEMV = 70 * MiB;
constexpr size_t WS_XB = 72 * MiB;
constexpr size_t WS_R = 136 * MiB;
constexpr size_t WS_U = WS_R, WS_Y = WS_R + 48 * MiB;
constexpr size_t WS_Q1 = WS_R, WS_K1 = WS_R + 48 * MiB, WS_V1 = WS_R + 96 * MiB;
constexpr size_t WS_QM = WS_R + 144 * MiB;
constexpr size_t WS_MIX = WS_R + 160 * MiB;
constexpr size_t WS_H = WS_R;
constexpr size_t WS_END = WS_R + 224 * MiB;
constexpr int CW_BAR = 4096;

constexpr int RING_OFF = 0, RING_BYTES = 131072;
constexpr int LDSCTL_OFF = RING_BYTES, MISC_OFF = LDSCTL_OFF + 320;
constexpr int LDS_BYTES = 147456;

#define GAS __attribute__((address_space(1)))
#define LAS __attribute__((address_space(3)))
typedef unsigned short bf16;
typedef unsigned v4u __attribute__((ext_vector_type(4)));
typedef unsigned v2u __attribute__((ext_vector_type(2)));
typedef float f32x4 __attribute__((ext_vector_type(4)));
typedef GAS unsigned gu32;
#define RLX_AGENT __ATOMIC_RELAXED, __HIP_MEMORY_SCOPE_AGENT
#define LDS_WAIT() asm volatile("s_waitcnt lgkmcnt(0)" ::: "memory")
#define VM_WAIT() asm volatile("s_waitcnt vmcnt(0)" ::: "memory")
__device__ __forceinline__ unsigned f2bf(float f) { unsigned u = __builtin_bit_cast(unsigned, f); return (u + 0x7fffu + ((u >> 16) & 1u)) >> 16; }
__device__ __forceinline__ unsigned pk2(float lo, float hi) { return f2bf(lo) | (f2bf(hi) << 16); }
__device__ __forceinline__ float bf2f(unsigned short h) { return __uint_as_float(((unsigned)h) << 16); }
__device__ __forceinline__ float bflo(unsigned w) { return __uint_as_float(w << 16); }
__device__ __forceinline__ float bfhi(unsigned w) { return __uint_as_float(w & 0xffff0000u); }

#define XB_TMO      128
#define XB_XCNT(j)  (256  + 64 * (j))
#define XB_XSUB(j)  (1280 + 64 * (j))
#define XB_XGEN(j)  (2304 + 64 * (j))
#define XB_TOP      3328
#define XB_TOPGEN   3392
#define XCD_BAR_WORDS 3456
#define XB_SPIN_CAP (1u << 18)

__device__ __forceinline__ unsigned xb_ld(unsigned* p)              { return __hip_atomic_load(p, __ATOMIC_RELAXED, __HIP_MEMORY_SCOPE_AGENT); }
__device__ __forceinline__ unsigned xb_add(unsigned* p, unsigned v) { return __hip_atomic_fetch_add(p, v, __ATOMIC_RELAXED, __HIP_MEMORY_SCOPE_AGENT); }
__device__ __forceinline__ unsigned xb_xcc_id() { return (unsigned)__builtin_amdgcn_s_getreg((3 << 11) | 20) & 0xFu; }
#define XB_SPIN(cond, bar) do { unsigned _sp = 0; while (cond) { __builtin_amdgcn_s_sleep(1); \
    if ((++_sp & 255u) == 0u) { if (xb_ld(&(bar)[XB_TMO])) break; if (_sp > XB_SPIN_CAP) { atomicAdd(&(bar)[XB_TMO], 1u); break; } } } } while (0)

struct XcdBarrier {
    unsigned* bar; unsigned x;
    volatile LAS unsigned* st;
};

__device__ __forceinline__ XcdBarrier xcd_barrier_post(unsigned* bar, volatile LAS unsigned* st) {
    XcdBarrier b; b.bar = bar; b.x = xb_xcc_id(); b.st = st;
    if (threadIdx.x == 0) (void)xb_add(&bar[XB_XCNT(b.x)], 1u);
    return b;
}
__device__ __forceinline__ void xcd_barrier_complete(unsigned* bar, unsigned x, unsigned& nloc, unsigned& nx) {
    const unsigned G = gridDim.x * gridDim.y * gridDim.z;
    unsigned sum, cnt, mine, sp = 0u;
    for (;;) {
        sum = 0u; cnt = 0u; mine = 0u;
#pragma unroll
        for (unsigned j = 0; j < 16; ++j) { const unsigned c = xb_ld(&bar[XB_XCNT(j)]); sum += c; cnt += (c > 0u) ? 1u : 0u; mine = (j == x) ? c : mine; }
        if (sum == G) break;
        __builtin_amdgcn_s_sleep(1);
        if ((++sp & 255u) == 0u) { if (xb_ld(&bar[XB_TMO])) break; if (sp > XB_SPIN_CAP) { atomicAdd(&bar[XB_TMO], 1u); break; } }
    }
    nloc = mine > 0u ? mine : 1u; nx = cnt > 0u ? cnt : 1u;
}

__device__ __forceinline__ void xcd_barrier(const XcdBarrier& b) {
    asm volatile("s_waitcnt vmcnt(0)" ::: "memory");
    __syncthreads();
    if (threadIdx.x == 0) {
        unsigned* bar = b.bar;
        __builtin_amdgcn_s_waitcnt(0);
        unsigned nloc = b.st[0], nx = b.st[1];
        if (nloc == 0u) { xcd_barrier_complete(bar, b.x, nloc, nx); b.st[0] = nloc; b.st[1] = nx; }
        const unsigned old = xb_add(&bar[XB_XSUB(b.x)], 1u);
        const unsigned gen = old / nloc;
        if (old + 1u == (gen + 1u) * nloc) {
            __builtin_amdgcn_fence(__ATOMIC_RELEASE, "agent");
            asm volatile("s_waitcnt vmcnt(0)" ::: "memory");
            const unsigned og = xb_add(&bar[XB_TOP], 1u);
            const unsigned tg = og / nx;
            if (og + 1u == (tg + 1u) * nx) xb_add(&bar[XB_TOPGEN], 1u);
            else XB_SPIN(xb_ld(&bar[XB_TOPGEN]) == tg, bar);
            __builtin_amdgcn_fence(__ATOMIC_ACQUIRE, "agent");
            xb_add(&bar[XB_XGEN(b.x)], 1u);
            asm volatile("s_waitcnt vmcnt(0)" ::: "memory");
        } else {
            XB_SPIN(xb_ld(&bar[XB_XGEN(b.x)]) == gen, bar);
            __builtin_amdgcn_fence(__ATOMIC_ACQUIRE, "agent");
            asm volatile("s_waitcnt vmcnt(0)" ::: "memory");
        }
    }
    __syncthreads();
}
__device__ __forceinline__ float wave_sum(float v) {
#pragma unroll
    for (int o = 1; o < 64; o <<= 1) v += __shfl_xor(v, o);
    return v;
}
__device__ __forceinline__ float wave_max(float v) {
#pragma unroll
    for (int o = 1; o < 64; o <<= 1) v = fmaxf(v, __shfl_xor(v, o));
    return v;
}
__device__ __forceinline__ int opaque_zero() { int z; asm volatile("v_mov_b32 %0, 0" : "=v"(z)); return z; }

__device__ __forceinline__ void p0_transpose_item(const float* W, int K, int N, bf16* WT, int dest_row0, int k0, int n0, const float* gk, LAS float* scr, int lane) {
#pragma unroll 8
    for (int i = 0; i < 32; ++i) { const int kk = 2 * i + (lane >> 5); float v = W[(size_t)(k0 + kk) * N + n0 + (lane & 31)]; if (gk) v *= gk[k0 + kk]; scr[kk * 33 + (lane & 31)] = v; }
    LDS_WAIT(); asm volatile("" ::: "memory");
    const int c = lane & 7;
#pragma unroll
    for (int j = 0; j < 4; ++j) { const int n = (lane >> 3) + 8 * j; const LAS float* s = scr + (8 * c) * 33 + n;
        v4u o; o.x = pk2(s[0 * 33], s[1 * 33]); o.y = pk2(s[2 * 33], s[3 * 33]); o.z = pk2(s[4 * 33], s[5 * 33]); o.w = pk2(s[6 * 33], s[7 * 33]);
        *(GAS v4u*)(WT + (size_t)(dest_row0 + n) * K + k0 + 8 * c) = o; }
    LDS_WAIT(); asm volatile("" ::: "memory");
}
__device__ __forceinline__ void p0_matrix_item(const float* W, int K, int N, bf16* WT, const float* gk, int mode, int item, LAS float* scr, int lane) {
    const int nblk = N / 32, kb = item / nblk, nb = item - kb * nblk, k0 = 64 * kb, n0 = 32 * nb;
    const int dr = (mode == 0) ? n0 : (256 * (n0 >> 7) + (n0 & 127) + (mode == 2 ? 128 : 0));
    p0_transpose_item(W, K, N, WT, dr, k0, n0, gk, scr, lane);
}
__device__ __forceinline__ void row_to_bf16_ssq(const float* xrow, bf16* orow, float* ssq16, int lane) {
    const GAS f32x4* xr = (const GAS f32x4*)xrow + lane;
    f32x4 v[4]; float s = 0.f;
#pragma unroll
    for (int j = 0; j < 4; ++j) { v[j] = xr[64 * j]; s += (v[j].x * v[j].x + v[j].y * v[j].y) + (v[j].z * v[j].z + v[j].w * v[j].w); }
    s = wave_sum(s);
    GAS unsigned long long* o8 = (GAS unsigned long long*)orow + lane;
#pragma unroll
    for (int j = 0; j < 4; ++j) o8[64 * j] = (unsigned long long)pk2(v[j].x, v[j].y) | ((unsigned long long)pk2(v[j].z, v[j].w) << 32);
    if (lane < 16) ssq16[lane] = (lane == 0) ? s : 0.f;
}

__device__ __forceinline__ void s5_naive_unit(int b, int g, const bf16* U, bf16* Y, const float* lam_re, const float* lam_im, const float* log_dt, const float* b_re, const float* b_im,
                                              const float* c_re, const float* c_im, const float* dvec, int lane) {
    const int p = lane;
    const float lr = lam_re[g * 64 + p], li = lam_im[g * 64 + p], dt = expf(log_dt[g]);
    const float mag = expf(lr * dt), ar = mag * cosf(li * dt), ai = mag * sinf(li * dt);
    const float den = lr * lr + li * li, nr = ar - 1.0f, fr = (nr * lr + ai * li) / den, fi = (ai * lr - nr * li) / den;
    float bbr[16], bbi[16], cr[16], ci[16];
#pragma unroll
    for (int c = 0; c < 16; ++c) { const float br = b_re[((size_t)g * 64 + p) * 16 + c], bi = b_im[((size_t)g * 64 + p) * 16 + c]; bbr[c] = fr * br - fi * bi; bbi[c] = fr * bi + fi * br;
        cr[c] = c_re[((size_t)g * 16 + c) * 64 + p]; ci[c] = c_im[((size_t)g * 16 + c) * 64 + p]; }
    const int ch = ((lane & 1) << 3) | ((lane & 2) << 1) | ((lane & 4) >> 1) | ((lane & 8) >> 3);
    const float dch = dvec[16 * g + ch];
    const int z0 = opaque_zero();
    const bf16* up = U + (size_t)b * SEQ * TOKW + 16 * g + z0;
    bf16* yp = Y + (size_t)b * SEQ * TOKW + 16 * g + ch;
    float xr = 0.f, xi = 0.f;
#pragma unroll 2
    for (int s = 0; s < SEQ; ++s) {
        const v4u w0 = *(const GAS v4u*)(up + (size_t)s * TOKW), w1 = *(const GAS v4u*)(up + (size_t)s * TOKW + 8);
        const float uch = bf2f(up[(size_t)s * TOKW + ch]);
        const float uu[16] = {bflo(w0.x), bfhi(w0.x), bflo(w0.y), bfhi(w0.y), bflo(w0.z), bfhi(w0.z), bflo(w0.w), bfhi(w0.w), bflo(w1.x), bfhi(w1.x), bflo(w1.y), bfhi(w1.y), bflo(w1.z), bfhi(w1.z), bflo(w1.w), bfhi(w1.w)};
        float bur = 0.f, bui = 0.f;
#pragma unroll
        for (int c = 0; c < 16; ++c) { bur += bbr[c] * uu[c]; bui += bbi[c] * uu[c]; }
        const float nxr = ar * xr - ai * xi + bur, nxi = ar * xi + ai * xr + bui; xr = nxr; xi = nxi;
        float v[16];
#pragma unroll
        for (int c = 0; c < 16; ++c) v[c] = cr[c] * xr - ci[c] * xi;
        float w[8], x4[4], x2[2], z;
        { const bool bit = lane & 1;
#pragma unroll
          for (int j = 0; j < 8; ++j) { const float send = bit ? v[j] : v[j + 8], keep = bit ? v[j + 8] : v[j]; w[j] = keep + __shfl_xor(send, 1); } }
        { const bool bit = lane & 2;
#pragma unroll
          for (int j = 0; j < 4; ++j) { const float send = bit ? w[j] : w[j + 4], keep = bit ? w[j + 4] : w[j]; x4[j] = keep + __shfl_xor(send, 2); } }
        { const bool bit = lane & 4;
#pragma unroll
          for (int j = 0; j < 2; ++j) { const float send = bit ? x4[j] : x4[j + 2], keep = bit ? x4[j + 2] : x4[j]; x2[j] = keep + __shfl_xor(send, 4); } }
        { const bool bit = lane & 8; const float send = bit ? x2[0] : x2[1], keep = bit ? x2[1] : x2[0]; z = keep + __shfl_xor(send, 8); }
        z += __shfl_xor(z, 16); z += __shfl_xor(z, 32);
        const float yv = z + dch * uch;
        const float ge = 0.5f * yv * (1.0f + erff(yv * 0.70710678118654752f));
        if (lane < 16) yp[(size_t)s * TOKW] = (bf16)f2bf(ge);
    }
}

__device__ __forceinline__ void memattn_naive_unit(int tok, int h, const bf16* QM, const bf16* memk, const bf16* memv, bf16* mix, LAS float* ps, int lane) {
    const int b = tok >> 12; const int z0 = opaque_zero();
    const float qv = bf2f(QM[(size_t)tok * 256 + h * 64 + lane]);
    float q[64];
#pragma unroll
    for (int d = 0; d < 64; ++d) q[d] = __shfl(qv, d);
    float sc[4];
#pragma unroll
    for (int i = 0; i < 4; ++i) { const int j = lane + 64 * i; const GAS v4u* kr = (const GAS v4u*)(memk + ((size_t)(b * 256 + j)) * 256 + h * 64 + z0); float a = 0.f;
#pragma unroll
        for (int c = 0; c < 8; ++c) { const v4u w = kr[c]; a += q[8 * c] * bflo(w.x) + q[8 * c + 1] * bfhi(w.x) + q[8 * c + 2] * bflo(w.y) + q[8 * c + 3] * bfhi(w.y) + q[8 * c + 4] * bflo(w.z) + q[8 * c + 5] * bfhi(w.z) + q[8 * c + 6] * bflo(w.w) + q[8 * c + 7] * bfhi(w.w); }
        sc[i] = a; }
    const float m = wave_max(fmaxf(fmaxf(sc[0], sc[1]), fmaxf(sc[2], sc[3])));
    float l = 0.f;
#pragma unroll
    for (int i = 0; i < 4; ++i) { const float pe = __builtin_amdgcn_exp2f(sc[i] - m); l += pe; ps[lane + 64 * i] = pe; }
    l = wave_sum(l);
    LDS_WAIT(); asm volatile("" ::: "memory");
    float o = 0.f; const bf16* vp = memv + (size_t)(b * 256) * 256 + h * 64 + lane;
#pragma unroll 8
    for (int j = 0; j < 256; ++j) o += ps[j] * bf2f(vp[(size_t)j * 256]);
    mix[(size_t)tok * 1024 + 768 + h * 64 + lane] = (bf16)f2bf(o / l);
    LDS_WAIT(); asm volatile("" ::: "memory");
}

__device__ __forceinline__ float dot64_bf16(const float (&q)[64], const GAS v4u* kr) {
    float a = 0.f;
#pragma unroll
    for (int c = 0; c < 8; ++c) { const v4u w = kr[c]; a += q[8 * c] * bflo(w.x) + q[8 * c + 1] * bfhi(w.x) + q[8 * c + 2] * bflo(w.y) + q[8 * c + 3] * bfhi(w.y) + q[8 * c + 4] * bflo(w.z) + q[8 * c + 5] * bfhi(w.z) + q[8 * c + 6] * bflo(w.w) + q[8 * c + 7] * bfhi(w.w); }
    return a;
}
__device__ __forceinline__ void moba_naive_unit(int tok, int h, const bf16* Q1, const bf16* K1, const bf16* V1, const float* KMEAN, bf16* mix, LAS float* ps, int lane) {
    const int b = tok >> 12, s = tok & (SEQ - 1), qb = s >> 8; const int z0 = opaque_zero();
    const float qv = bf2f(Q1[(size_t)tok * TOKW + h * 64 + lane]);
    float q[64];
#pragma unroll
    for (int d = 0; d < 64; ++d) q[d] = __shfl(qv, d);
    float gate = -1e30f;
    { const int n = lane & 15; const GAS f32x4* km = (const GAS f32x4*)(KMEAN + ((size_t)((b * NHEAD + h) * NBLK + n)) * 64 + z0); float a = 0.f;
#pragma unroll
      for (int c = 0; c < 16; ++c) { const f32x4 w = km[c]; a += q[4 * c] * w.x + q[4 * c + 1] * w.y + q[4 * c + 2] * w.z + q[4 * c + 3] * w.w; }
      if (n < qb) gate = a; }
    float g[16];
#pragma unroll
    for (int n = 0; n < 16; ++n) g[n] = __shfl(gate, n);
    const int nsel = qb < 3 ? qb : 3;
    unsigned mask = 0u;
#pragma unroll
    for (int r = 0; r < 3; ++r) { float best = -3.0e38f; int bi = 0;
#pragma unroll
        for (int n = 0; n < 16; ++n) { const bool c = !((mask >> n) & 1u) && g[n] > best; best = c ? g[n] : best; bi = c ? n : bi; }
        if (r < nsel) mask |= 1u << bi; }
    int blk0 = 0, blk1 = 0, blk2 = 0, cnt = 0;
#pragma unroll
    for (int n = 0; n < 16; ++n) if ((mask >> n) & 1u) { if (cnt == 0) blk0 = n; else if (cnt == 1) blk1 = n; else blk2 = n; ++cnt; }
    const int nslots = nsel + 1;
    const float slope = __builtin_amdgcn_exp2f(-8.0f * (float)(h + 1) / 12.0f) * LOG2E;
    const bf16* kh = K1 + (size_t)b * SEQ * TOKW + h * 64 + z0;
    float mx = -3.0e38f;
#pragma unroll
    for (int sl = 0; sl < 4; ++sl) if (sl < nslots) {
        const int blk = (sl == nsel) ? qb : (sl == 0 ? blk0 : (sl == 1 ? blk1 : blk2));
#pragma unroll
        for (int i = 0; i < 4; ++i) { const int j = lane + 64 * i, pos = blk * 256 + j;
            float a = dot64_bf16(q, (const GAS v4u*)(kh + (size_t)pos * TOKW)) + slope * (float)(pos - s);
            if (pos > s) a = -3.0e38f;
            ps[sl * 256 + j] = a; mx = fmaxf(mx, a); } }
    mx = wave_max(mx);
    LDS_WAIT(); asm volatile("" ::: "memory");
    float l = 0.f;
#pragma unroll
    for (int sl = 0; sl < 4; ++sl) if (sl < nslots) {
#pragma unroll
        for (int i = 0; i < 4; ++i) { const int j = lane + 64 * i; const float a = ps[sl * 256 + j]; const float pe = (a < -1.0e37f) ? 0.f : __builtin_amdgcn_exp2f(a - mx); l += pe; ps[sl * 256 + j] = pe; } }
    l = wave_sum(l);
    LDS_WAIT(); asm volatile("" ::: "memory");
    float o = 0.f; const bf16* vh = V1 + (size_t)b * SEQ * TOKW + h * 64 + lane;
#pragma unroll
    for (int sl = 0; sl < 4; ++sl) if (sl < nslots) {
        const int blk = (sl == nsel) ? qb : (sl == 0 ? blk0 : (sl == 1 ? blk1 : blk2));
        const bf16* vp = vh + (size_t)(blk * 256) * TOKW;
#pragma unroll 8
        for (int j = 0; j < 256; ++j) o += ps[sl * 256 + j] * bf2f(vp[(size_t)j * TOKW]); }
    mix[(size_t)tok * 1024 + h * 64 + lane] = (bf16)f2bf(o / l);
    LDS_WAIT(); asm volatile("" ::: "memory");
}

#ifndef MK_ONE_LAUNCH
#define MK_ONE_LAUNCH 0
#endif
constexpr int N_PHASES = 14;
struct Args { const float* in[23]; float* out; unsigned char* ws; int ph_lo, ph_hi; };

__global__ void __launch_bounds__(NWAVES * 64, 2) mega_fwd(Args args) {
    extern __shared__ __attribute__((aligned(16))) unsigned char lds[];
    LAS unsigned char* L = (LAS unsigned char*)lds;
    volatile LAS unsigned* MISC = (volatile LAS unsigned*)(L + MISC_OFF);
    const int tid = threadIdx.x, lane = tid & 63, wave = __builtin_amdgcn_readfirstlane(tid >> 6);
    const int G = gridDim.x; const int bx = blockIdx.x;
    const int vcu = (G % 8 == 0) ? (bx % 8) * (G / 8) + bx / 8 : bx;
    const int gw = vcu * NWAVES + wave, NGW = G * NWAVES;
    unsigned char* ws = args.ws;
    gu32* ctl = (gu32*)(ws + WS_CTL);
    for (int u = tid; u < (LDS_BYTES - LDSCTL_OFF) / 4; u += NWAVES * 64) ((LAS unsigned*)(L + LDSCTL_OFF))[u] = 0u;
    __syncthreads();
    XcdBarrier bar; bar.bar = (unsigned*)(ctl + CW_BAR); bar.x = 0; bar.st = nullptr;
    if (MK_ONE_LAUNCH) bar = xcd_barrier_post((unsigned*)(ctl + CW_BAR), MISC + 8);
    const int lo = args.ph_lo, hi = args.ph_hi;
#define IN(k) (lo <= (k) && (k) < hi)
#define SEAM(k) do { if (IN(k) && IN((k) + 1)) xcd_barrier(bar); } while (0)

    const float* x = args.in[0]; const float* mem = args.in[1];
    float* out = args.out;
    float* SS0 = (float*)(ws + WS_SS0); float* SSA = (float*)(ws + WS_SSA); float* SSB = (float*)(ws + WS_SSB); float* SSM = (float*)(ws + WS_SSM);
    float* KMEAN = (float*)(ws + WS_KMEAN);
    bf16* WIN0 = (bf16*)(ws + WS_WIN0); bf16* WGLU = (bf16*)(ws + WS_WGLU); bf16* WIN1 = (bf16*)(ws + WS_WIN1);
    bf16* WOUT0 = (bf16*)(ws + WS_WOUT0); bf16* WOUT1 = (bf16*)(ws + WS_WOUT1);
    bf16* WGU0 = (bf16*)(ws + WS_WGU0); bf16* WGU1 = (bf16*)(ws + WS_WGU1); bf16* WDN0 = (bf16*)(ws + WS_WDN0); bf16* WDN1 = (bf16*)(ws + WS_WDN1); bf16* WMKV = (bf16*)(ws + WS_WMKV);
    bf16* MEMB = (bf16*)(ws + WS_MEMB); bf16* MEMK = (bf16*)(ws + WS_MEMK); bf16* MEMV = (bf16*)(ws + WS_MEMV);
    bf16* XB = (bf16*)(ws + WS_XB); bf16* Ub = (bf16*)(ws + WS_U); bf16* Yb = (bf16*)(ws + WS_Y);
    bf16* Q1 = (bf16*)(ws + WS_Q1); bf16* K1 = (bf16*)(ws + WS_K1); bf16* V1 = (bf16*)(ws + WS_V1);
    bf16* QM = (bf16*)(ws + WS_QM); bf16* MIX = (bf16*)(ws + WS_MIX); bf16* Hb = (bf16*)(ws + WS_H);

    if (IN(0)) {
        LAS float* scr = (LAS float*)(L + RING_OFF + wave * 16384);
        constexpr int I_SQ = 16 * 32, I_GLU = 12 * 24, I_IN1 = 16 * 80, I_GU = 16 * 88, I_DN = 44 * 32, I_MKV = 16 * 16;
        constexpr int NITEMS = I_SQ + I_GLU + I_IN1 + 2 * I_SQ + 4 * I_GU + 2 * I_DN + I_MKV;
        const float* mixg = args.in[4]; const float* ffng = args.in[18];
        for (int it = gw; it < NITEMS; it += NGW) {
            int r = it;
            if (r < I_SQ) { p0_matrix_item(args.in[5], 1024, 1024, WIN0, mixg, 0, r, scr, lane); continue; } r -= I_SQ;
            if (r < I_GLU) { p0_matrix_item(args.in[14], 768, 768, WGLU, nullptr, 0, r, scr, lane); continue; } r -= I_GLU;
            if (r < I_IN1) { p0_matrix_item(args.in[16], 1024, 2560, WIN1, mixg + 1024, 0, r, scr, lane); continue; } r -= I_IN1;
            if (r < I_SQ) { p0_matrix_item(args.in[17], 1024, 1024, WOUT0, nullptr, 0, r, scr, lane); continue; } r -= I_SQ;
            if (r < I_SQ) { p0_matrix_item(args.in[17] + 1024 * 1024, 1024, 1024, WOUT1, nullptr, 0, r, scr, lane); continue; } r -= I_SQ;
            if (r < I_GU) { p0_matrix_item(args.in[19], 1024, FFN, WGU0, ffng, 1, r, scr, lane); continue; } r -= I_GU;
            if (r < I_GU) { p0_matrix_item(args.in[20], 1024, FFN, WGU0, ffng, 2, r, scr, lane); continue; } r -= I_GU;
            if (r < I_GU) { p0_matrix_item(args.in[19] + (size_t)1024 * FFN, 1024, FFN, WGU1, ffng + 1024, 1, r, scr, lane); continue; } r -= I_GU;
            if (r < I_GU) { p0_matrix_item(args.in[20] + (size_t)1024 * FFN, 1024, FFN, WGU1, ffng + 1024, 2, r, scr, lane); continue; } r -= I_GU;
            if (r < I_DN) { p0_matrix_item(args.in[21], FFN, 1024, WDN0, nullptr, 0, r, scr, lane); continue; } r -= I_DN;
            if (r < I_DN) { p0_matrix_item(args.in[21] + (size_t)FFN * 1024, FFN, 1024, WDN1, nullptr, 0, r, scr, lane); continue; } r -= I_DN;
            p0_matrix_item(args.in[3], 1024, 512, WMKV, args.in[2], 0, r, scr, lane);
        }
        for (int m = gw; m < TOK; m += NGW) row_to_bf16_ssq(x + (size_t)m * DM, XB + (size_t)m * DM, SS0 + (size_t)m * 16, lane);
        for (int m = gw; m < BATCH * MEML; m += NGW) row_to_bf16_ssq(mem + (size_t)m * DM, MEMB + (size_t)m * DM, SSM + (size_t)m * 16, lane);
    }
    SEAM(0);
    if (IN(1)) {
        { pg8::Gemm g{XB, WIN0, TOK, 1024, 1024}; pg8::StaticOrder S; S.init(TOK, 1024, G, bx);
          pg8::EpiProj E{SS0, Ub, 0, 3, 1, TOKW, 1.0f, QM, C2};
          pg8::gemm_phase<pg8::EpiProj, pg8::StaticOrder, true, true>(L + RING_OFF, g, S, E); }
        { pg8::Gemm g{MEMB, WMKV, BATCH * MEML, 512, 1024}; pg8::StaticOrder S; S.init(BATCH * MEML, 512, G, bx);
          pg8::EpiProj E{SSM, MEMK, (size_t)(WS_MEMV - WS_MEMK) / 2, 1, 2, 256, 1.0f, nullptr, 1.0f};
          pg8::gemm_phase<pg8::EpiProj, pg8::StaticOrder, true, true>(L + RING_OFF, g, S, E); }
    }
    SEAM(1);
    if (IN(2)) {
        for (int un = gw; un < BATCH * NGRP; un += NGW)
            s5_naive_unit(un / NGRP, un % NGRP, Ub, Yb, args.in[6], args.in[7], args.in[8], args.in[9], args.in[10], args.in[11], args.in[12], args.in[13], lane);
        LAS float* ps = (LAS float*)(L + RING_OFF + wave * 4096);
        for (int un = gw; un < TOK * MHEAD; un += NGW) memattn_naive_unit(un >> 2, un & 3, QM, MEMK, MEMV, MIX, ps, lane);
    }
    SEAM(2);
    if (IN(3)) {
        pg8::Gemm g{Yb, WGLU, TOK, TOKW, TOKW}; pg8::StaticOrder S; S.init(TOK, TOKW, G, bx);
        pg8::EpiGlu E{Yb, TOKW, args.in[15], MIX, 1024};
        pg8::gemm_phase<pg8::EpiGlu, pg8::StaticOrder, true, true>(L + RING_OFF, g, S, E);
    }
    SEAM(3);
    if (IN(4)) {
        pg8::Gemm g{MIX, WOUT0, TOK, 1024, 1024}; pg8::StaticOrder S; S.init(TOK, 1024, G, bx);
        pg8::EpiRes E{x, out, XB, SSA};
        pg8::gemm_phase<pg8::EpiRes, pg8::StaticOrder, true, true>(L + RING_OFF, g, S, E);
    }
    SEAM(4);
    if (IN(5)) {
        pg8::Gemm g{XB, WGU0, TOK, 2 * FFN, 1024}; pg8::StaticOrder S; S.init(TOK, 2 * FFN, G, bx);
        pg8::EpiGU E{SSA, Hb, FFN};
        pg8::gemm_phase<pg8::EpiGU, pg8::StaticOrder, true, true>(L + RING_OFF, g, S, E);
    }
    SEAM(5);
    if (IN(6)) {
        pg8::Gemm g{Hb, WDN0, TOK, 1024, FFN}; pg8::StaticOrder S; S.init(TOK, 1024, G, bx);
        pg8::EpiRes E{out, out, XB, SSB};
        pg8::gemm_phase<pg8::EpiRes, pg8::StaticOrder, true, true>(L + RING_OFF, g, S, E);
    }
    SEAM(6);
    if (IN(7)) {
        pg8::Gemm g{XB, WIN1, TOK, 2560, 1024}; pg8::StaticOrder S; S.init(TOK, 2560, G, bx);
        pg8::EpiProj E{SSB, Q1, (size_t)(WS_K1 - WS_Q1) / 2, 3, 3, TOKW, C2, QM, C2};
        pg8::gemm_phase<pg8::EpiProj, pg8::StaticOrder, true, true>(L + RING_OFF, g, S, E);
    }
    SEAM(7);
    if (IN(8)) {
        for (int un = gw; un < BATCH * NHEAD * NBLK; un += NGW) {
            const int n = un & 15, bh = un >> 4, h = bh % NHEAD, b = bh / NHEAD;
            const bf16* kp = K1 + ((size_t)b * SEQ + (size_t)n * MBLK) * TOKW + h * 64 + lane; float a = 0.f;
#pragma unroll 8
            for (int i = 0; i < MBLK; ++i) a += bf2f(kp[(size_t)i * TOKW]);
            KMEAN[(size_t)un * 64 + lane] = a * (1.0f / MBLK);
        }
    }
    SEAM(8);
    if (IN(9)) {
        LAS float* ps = (LAS float*)(L + RING_OFF + wave * 4096);
        for (int un = gw; un < TOK * NHEAD; un += NGW) moba_naive_unit(un / NHEAD, un % NHEAD, Q1, K1, V1, KMEAN, MIX, ps, lane);
        for (int un = gw; un < TOK * MHEAD; un += NGW) memattn_naive_unit(un >> 2, un & 3, QM, MEMK, MEMV, MIX, ps, lane);
    }
    SEAM(9);
    if (IN(10)) {
        pg8::Gemm g{MIX, WOUT1, TOK, 1024, 1024}; pg8::StaticOrder S; S.init(TOK, 1024, G, bx);
        pg8::EpiRes E{out, out, XB, SSA};
        pg8::gemm_phase<pg8::EpiRes, pg8::StaticOrder, true, true>(L + RING_OFF, g, S, E);
    }
    SEAM(10);
    if (IN(11)) {
        pg8::Gemm g{XB, WGU1, TOK, 2 * FFN, 1024}; pg8::StaticOrder S; S.init(TOK, 2 * FFN, G, bx);
        pg8::EpiGU E{SSA, Hb, FFN};
        pg8::gemm_phase<pg8::EpiGU, pg8::StaticOrder, true, true>(L + RING_OFF, g, S, E);
    }
    SEAM(11);
    if (IN(12)) {
        pg8::Gemm g{Hb, WDN1, TOK, 1024, FFN}; pg8::StaticOrder S; S.init(TOK, 1024, G, bx);
        pg8::EpiRes E{out, out, XB, SSB};
        pg8::gemm_phase<pg8::EpiRes, pg8::StaticOrder, true, true>(L + RING_OFF, g, S, E);
    }
    SEAM(12);
    if (IN(13)) {
        const float* gf = args.in[22];
        for (int m = gw; m < TOK; m += NGW) {
            const float rs = pg8::row_rstd(SSB, m);
            GAS f32x4* xr = (GAS f32x4*)(out + (size_t)m * DM) + lane; const GAS f32x4* gp = (const GAS f32x4*)gf + lane;
#pragma unroll
            for (int j = 0; j < 4; ++j) { const f32x4 v = xr[64 * j], gg = gp[64 * j]; xr[64 * j] = v * rs * gg; }
        }
    }
#undef IN
#undef SEAM
}

extern "C" void kernel_launch(void* const* d_in, const int* in_sizes, int n_in, void* d_out, int out_size, void* d_ws, size_t ws_size, hipStream_t stream) {
    static int grid = 0;
    if (grid == 0) {
        if (n_in != 23 || out_size != TOK * DM || ws_size < WS_END) { fprintf(stderr, "kernel_launch: unexpected shapes: n_in %d out %d ws %zu\n", n_in, out_size, ws_size); grid = -1; return; }
        int dev = 0, cus = 0, per_cu = 0;
        if (hipGetDevice(&dev) != hipSuccess || hipDeviceGetAttribute(&cus, hipDeviceAttributeMultiprocessorCount, dev) != hipSuccess) { grid = -1; return; }
        if (hipFuncSetAttribute((const void*)mega_fwd, hipFuncAttributeMaxDynamicSharedMemorySize, LDS_BYTES) != hipSuccess) { fprintf(stderr, "kernel_launch: hipFuncSetAttribute failed\n"); grid = -1; return; }
        if (hipOccupancyMaxActiveBlocksPerMultiprocessor(&per_cu, (const void*)mega_fwd, NWAVES * 64, LDS_BYTES) != hipSuccess || per_cu < 1)
            fprintf(stderr, "kernel_launch: occupancy query reports %d workgroups per CU\n", per_cu);
        (void)hipGetLastError();
        grid = cus;
    }
    if (grid < 0) return;
    if (hipMemsetAsync((char*)d_ws + WS_CTL, 0, CTL_ZERO_BYTES, stream) != hipSuccess) return;
    Args a{};
    for (int i = 0; i < 23; ++i) a.in[i] = (const float*)d_in[i];
    a.out = (float*)d_out; a.ws = (unsigned char*)d_ws;
#if MK_ONE_LAUNCH
    a.ph_lo = 0; a.ph_hi = N_PHASES;
    hipLaunchKernelGGL(mega_fwd, dim3(grid), dim3(NWAVES * 64), LDS_BYTES, stream, a);
#else
    for (int p = 0; p < N_PHASES; ++p) { a.ph_lo = p; a.ph_hi = p + 1; hipLaunchKernelGGL(mega_fwd, dim3(grid), dim3(NWAVES * 64), LDS_BYTES, stream, a); }
#endif
}
```

```cpp
#include <hip/hip_runtime.h>
#include <hip/hip_bf16.h>
#include <cstdio>
#include <cstdint>
#include <cmath>
namespace pg8 {
#define PG8_LAS __attribute__((address_space(3)))
typedef unsigned short bf16_t;
typedef short bf16x8 __attribute__((ext_vector_type(8)));
typedef float f32x4 __attribute__((ext_vector_type(4)));
typedef unsigned u32x4 __attribute__((ext_vector_type(4)));
constexpr int BM = 256, BK = 64, HALF = 128, HTB = HALF * BK * 2  , STAGE_BYTES = 8 * HTB, NXCD = 8, WGM = 8;

__host__ __device__ __forceinline__ int lds_byte(int r, int c) { const int st = (r >> 4) * 2 + (c >> 5), rr = r & 15, cc = c & 31, ob = rr * 64 + cc * 2; return st * 1024 + (ob ^ (((ob >> 9) & 1) << 5)); }
__host__ __device__ __forceinline__ void stage_rc(int b, int& R, int& C) { const int st = b / 1024, sb = b % 1024, swz = sb ^ (((sb >> 9) & 1) << 5); R = (st >> 1) * 16 + swz / 64; C = (st & 1) * 32 + (swz % 64) / 2; }
__host__ __device__ __forceinline__ int perm32(int rho) { const int n = rho >> 4, i = rho & 15; return 8 * (i >> 2) + 4 * n + (i & 3); }

struct Unit { int pm, pn; };
struct Gemm { const bf16_t* A; const bf16_t* Bt; int M, N, K; };

struct StaticOrder {
    int nM, nN, nwg, G, c;
    __host__ __device__ void init(int M, int N, int G_, int c_) { nM = M / BM; nN = N / BM; nwg = nM * nN; G = G_; c = c_; }
    __host__ __device__ bool next(int i, Unit& u) const {
        const long L = (long)i * G + c; if (L >= nwg) return false;
        int wgid = (int)L; { const int q = nwg / NXCD, r = nwg % NXCD, xcd = wgid % NXCD, off = wgid / NXCD; wgid = (xcd < r ? xcd * (q + 1) : r * (q + 1) + (xcd - r) * q) + off; }
        const int nig = WGM * nN, gid = wgid / nig, fm = gid * WGM, gsz = (nM - fm) < WGM ? (nM - fm) : WGM;
        u.pm = fm + ((wgid % nig) % gsz); u.pn = (wgid % nig) / gsz; return true;
    }
    __device__ __forceinline__ void a_ready(const Unit&) const {}
    __device__ __forceinline__ void done(const Unit&) const {}
};

__device__ __forceinline__ unsigned cvt_pk_bf16(float lo, float hi) { unsigned r; asm volatile("v_cvt_pk_bf16_f32 %0, %1, %2" : "=v"(r) : "v"(lo), "v"(hi)); return r; }
typedef float f32x2 __attribute__((ext_vector_type(2)));
typedef unsigned u32x2 __attribute__((ext_vector_type(2)));
constexpr float RMS_EPS = 1e-6f;
__device__ __forceinline__ float row_rstd(const float* ssq, int row) {
    const f32x4* p = (const f32x4*)(ssq + (size_t)row * 16);
    const f32x4 a = p[0], b = p[1], c = p[2], d = p[3];
    const float s = (((a[0] + a[1]) + (a[2] + a[3])) + ((b[0] + b[1]) + (b[2] + b[3]))) + (((c[0] + c[1]) + (c[2] + c[3])) + ((d[0] + d[1]) + (d[2] + d[3])));
    return 1.0f / sqrtf(s * (1.0f / 1024.0f) + RMS_EPS);
}
__device__ __forceinline__ float bf2f(unsigned short h) { return __uint_as_float(((unsigned)h) << 16); }
__device__ __forceinline__ float bflo(unsigned w) { return __uint_as_float(w << 16); }
__device__ __forceinline__ float bfhi(unsigned w) { return __uint_as_float(w & 0xffff0000u); }

__device__ __forceinline__ f32x2 gelu_pk(f32x2 v) {
    const f32x2 av = __builtin_elementwise_abs(v), d = av * 0.2316418882f + 1.0f;
    f32x2 t; t.x = __builtin_amdgcn_rcpf(d.x); t.y = __builtin_amdgcn_rcpf(d.y);
    f32x2 q = t * 0.5307027145f + (-0.7265760135f); q = q * t + 0.7107068705f; q = q * t + (-0.142248368f); q = q * t + 0.127414796f; q = q * t;
    const f32x2 s = (v * v) * (-0.72134752044f);
    f32x2 e; e.x = __builtin_amdgcn_exp2f(s.x); e.y = __builtin_amdgcn_exp2f(s.y);
    const f32x2 m = v * (q * e), r = v - m;
    f32x2 o; o.x = v.x < 0.f ? m.x : r.x; o.y = v.y < 0.f ? m.y : r.y; return o;
}

struct EpiProj {
    static constexpr bool PERM = true, AFTER_DRAIN = false;
    const float* ssq; bf16_t* base; size_t seg_stride; int tps, nseg, ldc; float scale0; bf16_t* qm; float scale_qm;
    __device__ __forceinline__ void operator()(const f32x4 (&acc)[2][2][4][2], const Unit& u, int wr, int wc, int fr, int fq) const {
        const int seg = u.pn / tps, within = u.pn - seg * tps;
        bf16_t* o; int ld, colt; float sc;
        if (seg < nseg) { o = base + (size_t)seg * seg_stride; ld = ldc; colt = within * BM; sc = (seg == 0) ? scale0 : 1.0f; }
        else { o = qm; ld = 256; colt = 0; sc = scale_qm; }
        const int row0 = u.pm * BM + wr * 64 + fr, col0 = colt + wc * 32 + 8 * fq;
#pragma unroll
        for (int ai = 0; ai < 2; ++ai)
#pragma unroll
            for (int m = 0; m < 4; ++m) { const int row = row0 + ai * HALF + m * 16; const float rs = row_rstd(ssq, row) * sc; bf16_t* rowp = o + (size_t)row * ld + col0;
#pragma unroll
                for (int bj = 0; bj < 2; ++bj) { const f32x4 v0 = acc[ai][bj][m][0] * rs, v1 = acc[ai][bj][m][1] * rs;
                    u32x4 w; w.x = cvt_pk_bf16(v0[0], v0[1]); w.y = cvt_pk_bf16(v0[2], v0[3]); w.z = cvt_pk_bf16(v1[0], v1[1]); w.w = cvt_pk_bf16(v1[2], v1[3]);
                    *(u32x4*)(rowp + bj * HALF) = w; } }
    }
};
struct EpiGlu {
    static constexpr bool PERM = true, AFTER_DRAIN = false;
    const bf16_t* Y; int ldy; const float* bias; bf16_t* mix; int ldm;
    __device__ __forceinline__ void operator()(const f32x4 (&acc)[2][2][4][2], const Unit& u, int wr, int wc, int fr, int fq) const {
        const int row0 = u.pm * BM + wr * 64 + fr, col0 = u.pn * BM + wc * 32 + 8 * fq;
        f32x4 bv[2][2];
#pragma unroll
        for (int bj = 0; bj < 2; ++bj)
#pragma unroll
            for (int n = 0; n < 2; ++n) bv[bj][n] = *(const f32x4*)(bias + col0 + bj * HALF + 4 * n);
#pragma unroll
        for (int ai = 0; ai < 2; ++ai)
#pragma unroll
            for (int m = 0; m < 4; ++m) { const int row = row0 + ai * HALF + m * 16;
#pragma unroll
                for (int bj = 0; bj < 2; ++bj) { const u32x4 yw = *(const u32x4*)(Y + (size_t)row * ldy + col0 + bj * HALF);
                    const f32x4 z0 = acc[ai][bj][m][0] + bv[bj][0], z1 = acc[ai][bj][m][1] + bv[bj][1];
                    float t[8]; const float yv[8] = {bflo(yw.x), bfhi(yw.x), bflo(yw.y), bfhi(yw.y), bflo(yw.z), bfhi(yw.z), bflo(yw.w), bfhi(yw.w)};
#pragma unroll
                    for (int e = 0; e < 4; ++e) { t[e] = yv[e] * __builtin_amdgcn_rcpf(1.0f + __builtin_amdgcn_exp2f(-1.4426950408889634f * z0[e])); t[4 + e] = yv[4 + e] * __builtin_amdgcn_rcpf(1.0f + __builtin_amdgcn_exp2f(-1.4426950408889634f * z1[e])); }
                    u32x4 w; w.x = cvt_pk_bf16(t[0], t[1]); w.y = cvt_pk_bf16(t[2], t[3]); w.z = cvt_pk_bf16(t[4], t[5]); w.w = cvt_pk_bf16(t[6], t[7]);
                    *(u32x4*)(mix + (size_t)row * ldm + col0 + bj * HALF) = w; } }
    }
};
struct EpiRes {
    static constexpr bool PERM = false, AFTER_DRAIN = false;
    const float* base; float* out; bf16_t* xb; float* ssq_out;
    __device__ __forceinline__ void operator()(const f32x4 (&acc)[2][2][4][2], const Unit& u, int wr, int wc, int fr, int fq) const {
        const int row0 = u.pm * BM + wr * 64 + fr, col0 = u.pn * BM + wc * 32 + 4 * fq;
#pragma unroll
        for (int ai = 0; ai < 2; ++ai)
#pragma unroll
            for (int m = 0; m < 4; ++m) { const int row = row0 + ai * HALF + m * 16; const size_t off = (size_t)row * 1024 + col0; float ss = 0.f;
#pragma unroll
                for (int bj = 0; bj < 2; ++bj)
#pragma unroll
                    for (int n = 0; n < 2; ++n) { const f32x4 b = *(const f32x4*)(base + off + bj * HALF + n * 16); const f32x4 o = b + acc[ai][bj][m][n];
                        *(f32x4*)(out + off + bj * HALF + n * 16) = o; u32x2 w; w.x = cvt_pk_bf16(o[0], o[1]); w.y = cvt_pk_bf16(o[2], o[3]); *(u32x2*)(xb + off + bj * HALF + n * 16) = w;
                        ss += (o[0] * o[0] + o[1] * o[1]) + (o[2] * o[2] + o[3] * o[3]); }
                ss += __shfl_xor(ss, 16); ss += __shfl_xor(ss, 32);
                if (fq == 0) ssq_out[(size_t)row * 16 + u.pn * 4 + wc] = ss; }
    }
};
struct EpiGU {
    static constexpr bool PERM = true, AFTER_DRAIN = false;
    const float* ssq; bf16_t* H; int ldh;
    __device__ __forceinline__ void operator()(const f32x4 (&acc)[2][2][4][2], const Unit& u, int wr, int wc, int fr, int fq) const {
        const int row0 = u.pm * BM + wr * 64 + fr, col0 = u.pn * HALF + wc * 32 + 8 * fq;
#pragma unroll
        for (int ai = 0; ai < 2; ++ai)
#pragma unroll
            for (int m = 0; m < 4; ++m) { const int row = row0 + ai * HALF + m * 16; const float rs = row_rstd(ssq, row);
                float t[8];
#pragma unroll
                for (int n = 0; n < 2; ++n)
#pragma unroll
                    for (int e = 0; e < 4; ++e) { const float g = acc[ai][0][m][n][e] * rs, up = acc[ai][1][m][n][e] * rs;
                        t[4 * n + e] = g * __builtin_amdgcn_rcpf(1.0f + __builtin_amdgcn_exp2f(-1.4426950408889634f * g)) * up; }
                u32x4 w; w.x = cvt_pk_bf16(t[0], t[1]); w.y = cvt_pk_bf16(t[2], t[3]); w.z = cvt_pk_bf16(t[4], t[5]); w.w = cvt_pk_bf16(t[6], t[7]);
                *(u32x4*)(H + (size_t)row * ldh + col0) = w; }
    }
};

template <class Epi, class Sched, bool ALIGN_EPI = false, bool SP2 = false>
__device__ __forceinline__ void gemm_phase(PG8_LAS unsigned char* lds, const Gemm g, const Sched& S, const Epi& E) {
    const int tid = threadIdx.x, wid = __builtin_amdgcn_readfirstlane(tid >> 6), lane = tid & 63, wr = wid >> 2, wc = wid & 3, fr = lane & 15, fq = lane >> 4;
    const int K = g.K, nt = K / BK;
    unsigned voffA[2], voffB[2];
#pragma unroll
    for (int i = 0; i < 2; ++i) { int R, C; stage_rc(tid * 16 + i * 8192, R, C); const int Rb = Epi::PERM ? ((R & ~31) + perm32(R & 31)) : R;
        voffA[i] = (unsigned)(R * K + C) * 2u; voffB[i] = (unsigned)(Rb * K + C) * 2u; }
    const size_t kstep = (size_t)(BK * 2);
    const size_t hstep = (size_t)HALF * K * 2;
    const size_t tstep = 2 * hstep;
    const unsigned ldsw = (unsigned)wid * 1024u;
    const int aoff = lds_byte(wr * 64 + fr, fq * 8), boff = lds_byte(wc * 32 + fr, fq * 8);
#define PG8_SA(b, h) (((b) * 2 + (h)) * HTB)
#define PG8_SB(b, h) ((4 + (b) * 2 + (h)) * HTB)
#define PG8_STAGE(bufoff, gbase, voff) do { _Pragma("unroll") for (int _i = 0; _i < 2; ++_i) \
        __builtin_amdgcn_global_load_lds((const unsigned*)((const char*)(gbase) + (voff)[_i]), (PG8_LAS unsigned*)(lds + (bufoff) + ldsw + _i * 8192), 16, 0, 0); } while (0)
#define PG8_LDA(dst, b, h) do { _Pragma("unroll") for (int m = 0; m < 4; ++m) _Pragma("unroll") for (int k = 0; k < 2; ++k) dst[m][k] = *(const PG8_LAS bf16x8*)(lds + PG8_SA(b, h) + aoff + m * 2048 + k * 1024); } while (0)
#define PG8_LDB(dst, b, h) do { _Pragma("unroll") for (int n = 0; n < 2; ++n) _Pragma("unroll") for (int k = 0; k < 2; ++k) dst[n][k] = *(const PG8_LAS bf16x8*)(lds + PG8_SB(b, h) + boff + n * 2048 + k * 1024); } while (0)
#define PG8_MMA(ai, bj, At, Bt) do { __builtin_amdgcn_s_setprio(1); _Pragma("unroll") for (int m = 0; m < 4; ++m) _Pragma("unroll") for (int n = 0; n < 2; ++n) _Pragma("unroll") for (int k = 0; k < 2; ++k) \
        acc[ai][bj][m][n] = __builtin_amdgcn_mfma_f32_16x16x32_bf16(Bt[n][k], At[m][k], acc[ai][bj][m][n], 0, 0, 0); __builtin_amdgcn_s_setprio(0); } while (0)
#define PG8_WAIT_V(n) asm volatile("s_waitcnt vmcnt(" #n ")" ::: "memory")
#define PG8_WAIT_L(n) asm volatile("s_waitcnt lgkmcnt(" #n ")" ::: "memory")
#define PG8_BAR __builtin_amdgcn_s_barrier()
#define PG8_SCHED __builtin_amdgcn_sched_barrier(0)
    Unit cur, nxt; int ui = 0;
    if (!S.next(0, cur)) return;
    f32x4 acc[2][2][4][2];
#pragma unroll
    for (int a = 0; a < 2; ++a)
#pragma unroll
        for (int b = 0; b < 2; ++b)
#pragma unroll
            for (int m = 0; m < 4; ++m)
#pragma unroll
                for (int n = 0; n < 2; ++n) acc[a][b][m][n] = (f32x4){0.f, 0.f, 0.f, 0.f};
    bf16x8 At[4][2], B0[2][2], B1[2][2];
    const char* cA = (const char*)g.A + (size_t)cur.pm * tstep; const char* cB = (const char*)g.Bt + (size_t)cur.pn * tstep;
    S.a_ready(cur);
    if constexpr (SP2) {
        PG8_STAGE(PG8_SB(0, 0), cB, voffB); PG8_STAGE(PG8_SB(0, 1), cB + hstep, voffB); PG8_STAGE(PG8_SA(0, 0), cA, voffA); PG8_STAGE(PG8_SA(0, 1), cA + hstep, voffA);
        if (wr == 1) PG8_BAR;
        PG8_WAIT_V(2); PG8_BAR;
        PG8_STAGE(PG8_SB(1, 0), cB + kstep, voffB); PG8_STAGE(PG8_SA(1, 0), cA + kstep, voffA); PG8_STAGE(PG8_SB(1, 1), cB + hstep + kstep, voffB);
        PG8_WAIT_V(6); PG8_BAR;
    } else {
        PG8_STAGE(PG8_SB(0, 0), cB, voffB); PG8_STAGE(PG8_SA(0, 0), cA, voffA); PG8_STAGE(PG8_SB(0, 1), cB + hstep, voffB); PG8_STAGE(PG8_SA(0, 1), cA + hstep, voffA);
        if (wr == 1) PG8_BAR;
        PG8_WAIT_V(4); PG8_BAR;
        PG8_STAGE(PG8_SB(1, 0), cB + kstep, voffB); PG8_STAGE(PG8_SA(1, 0), cA + kstep, voffA); PG8_STAGE(PG8_SB(1, 1), cB + hstep + kstep, voffB);
        PG8_WAIT_V(6); PG8_BAR;
    }
    for (;;) {
        const bool has_next = S.next(ui + 1, nxt);
        const char* nA = has_next ? (const char*)g.A + (size_t)nxt.pm * tstep : cA; const char* nB = has_next ? (const char*)g.Bt + (size_t)nxt.pn * tstep : cB;
        for (int t = 0; t < nt; t += 2) {
            const bool last = (t == nt - 2);
            const char* a1 = cA + (size_t)(t + 1) * kstep;
            const char* a2 = last ? nA : cA + (size_t)(t + 2) * kstep; const char* b2 = last ? nB : cB + (size_t)(t + 2) * kstep;
            const char* a3 = a2 + kstep; const char* b3 = b2 + kstep;
            if (last && has_next) S.a_ready(nxt);
            if constexpr (SP2) {
            PG8_LDB(B0, 0, 0); PG8_LDB(B1, 0, 1); PG8_SCHED; PG8_LDA(At, 0, 0); PG8_STAGE(PG8_SA(1, 1), a1 + hstep, voffA);
            PG8_WAIT_V(8); PG8_WAIT_L(0); PG8_BAR; PG8_MMA(0, 0, At, B0); PG8_MMA(0, 1, At, B1); PG8_BAR; PG8_SCHED;
            PG8_LDA(At, 0, 1); PG8_STAGE(PG8_SB(0, 0), b2, voffB); PG8_STAGE(PG8_SB(0, 1), b2 + hstep, voffB); PG8_STAGE(PG8_SA(0, 0), a2, voffA);
            PG8_WAIT_V(8); PG8_WAIT_L(0); PG8_BAR; PG8_MMA(1, 0, At, B0); PG8_MMA(1, 1, At, B1); PG8_BAR; PG8_SCHED;
            PG8_LDB(B0, 1, 0); PG8_LDB(B1, 1, 1); PG8_SCHED; PG8_LDA(At, 1, 0); PG8_STAGE(PG8_SA(0, 1), a2 + hstep, voffA);
            PG8_WAIT_V(8); PG8_WAIT_L(0); PG8_BAR; PG8_MMA(0, 0, At, B0); PG8_MMA(0, 1, At, B1); PG8_BAR; PG8_SCHED;
            PG8_LDA(At, 1, 1); PG8_STAGE(PG8_SB(1, 0), b3, voffB); PG8_STAGE(PG8_SB(1, 1), b3 + hstep, voffB); PG8_STAGE(PG8_SA(1, 0), a3, voffA);
            PG8_WAIT_V(8); PG8_WAIT_L(0); PG8_BAR; PG8_MMA(1, 0, At, B0); PG8_MMA(1, 1, At, B1); PG8_BAR; PG8_SCHED;
            } else {
            PG8_LDB(B0, 0, 0); PG8_SCHED; PG8_LDA(At, 0, 0); PG8_STAGE(PG8_SA(1, 1), a1 + hstep, voffA);
            PG8_WAIT_L(8); PG8_BAR; PG8_WAIT_L(0); PG8_MMA(0, 0, At, B0); PG8_BAR; PG8_SCHED;
            PG8_LDB(B1, 0, 1); PG8_STAGE(PG8_SB(0, 0), b2, voffB);
            PG8_BAR; PG8_WAIT_L(0); PG8_MMA(0, 1, At, B1); PG8_BAR;
            PG8_LDA(At, 0, 1); PG8_STAGE(PG8_SA(0, 0), a2, voffA);
            PG8_BAR; PG8_WAIT_L(0); PG8_MMA(1, 0, At, B0); PG8_BAR; PG8_SCHED;
            PG8_STAGE(PG8_SB(0, 1), b2 + hstep, voffB);
            PG8_WAIT_V(6); PG8_BAR; PG8_MMA(1, 1, At, B1); PG8_BAR;
            PG8_LDB(B0, 1, 0); PG8_SCHED; PG8_LDA(At, 1, 0); PG8_STAGE(PG8_SA(0, 1), a2 + hstep, voffA);
            PG8_WAIT_L(8); PG8_BAR; PG8_WAIT_L(0); PG8_MMA(0, 0, At, B0); PG8_BAR; PG8_SCHED;
            PG8_LDB(B1, 1, 1); PG8_STAGE(PG8_SB(1, 0), b3, voffB);
            PG8_BAR; PG8_WAIT_L(0); PG8_MMA(0, 1, At, B1); PG8_BAR;
            PG8_LDA(At, 1, 1); PG8_STAGE(PG8_SA(1, 0), a3, voffA);
            PG8_BAR; PG8_WAIT_L(0); PG8_MMA(1, 0, At, B0); PG8_BAR; PG8_SCHED;
            PG8_STAGE(PG8_SB(1, 1), b3 + hstep, voffB);
            PG8_WAIT_V(6); PG8_BAR; PG8_MMA(1, 1, At, B1); PG8_BAR;
            }
        }
        if constexpr (ALIGN_EPI) { if (wr == 0) PG8_BAR; }
        if constexpr (!Epi::AFTER_DRAIN) { E(acc, cur, wr, wc, fr, fq); S.done(cur); }
        if (!has_next) break;
#pragma unroll
        for (int a = 0; a < 2; ++a)
#pragma unroll
            for (int b = 0; b < 2; ++b)
#pragma unroll
                for (int m = 0; m < 4; ++m)
#pragma unroll
                    for (int n = 0; n < 2; ++n) acc[a][b][m][n] = (f32x4){0.f, 0.f, 0.f, 0.f};
        cur = nxt; cA = nA; cB = nB; ++ui;
        if constexpr (ALIGN_EPI) { if (wr == 1) PG8_BAR; }
    }
    PG8_WAIT_V(0);
    if constexpr (!ALIGN_EPI) { if (wr == 0) PG8_BAR; }
    PG8_BAR;
    if constexpr (Epi::AFTER_DRAIN) { E.fused(acc, cur, wr, wc, fr, fq, lds, wid, lane); S.done(cur); }
#undef PG8_SA
#undef PG8_SB
#undef PG8_STAGE
#undef PG8_LDA
#undef PG8_LDB
#undef PG8_MMA
#undef PG8_WAIT_V
#undef PG8_WAIT_L
#undef PG8_BAR
#undef PG8_SCHED
}
}
constexpr int NWAVES = 8;
constexpr int BATCH = 8, SEQ = 4096, DM = 1024, TOK = BATCH * SEQ;
constexpr int TOKW = 768, MEMW = 256, MEML = 256, NGRP = 48, NST = 64, GCH = 16, NHEAD = 12, MHEAD = 4, HD = 64, FFN = 2816, NBLK = 16, MBLK = 256;
constexpr float C2 = 0.125f * 1.4426950408889634f;
constexpr float LOG2E = 1.4426950408889634f;

constexpr size_t MiB = 1u << 20;
constexpr size_t WS_CTL = 0, CTL_ZERO_BYTES = 1 * MiB;
constexpr size_t WS_SS0 = 1 * MiB, WS_SSA = 3 * MiB, WS_SSB = 5 * MiB, WS_SSM = 7 * MiB, WS_KMEAN = 8 * MiB;
constexpr size_t WS_WIN0 = 16 * MiB, WS_WGLU = 18 * MiB, WS_WIN1 = 20 * MiB, WS_WOUT0 = 26 * MiB, WS_WOUT1 = 28 * MiB;
constexpr size_t WS_WGU0 = 30 * MiB, WS_WGU1 = 41 * MiB, WS_WDN0 = 52 * MiB, WS_WDN1 = 58 * MiB, WS_WMKV = 64 * MiB;
constexpr size_t WS_MEMB = 65 * MiB, WS_MEMK = 69 * MiB, WS_MEMV = 70 * MiB;
constexpr size_t WS_XB = 72 * MiB;
constexpr size_t WS_R = 136 * MiB;
constexpr size_t WS_U = WS_R, WS_Y = WS_R + 48 * MiB;
constexpr size_t WS_Q1 = WS_R, WS_K1 = WS_R + 48 * MiB, WS_V1 = WS_R + 96 * MiB;
constexpr size_t WS_QM = WS_R + 144 * MiB;
constexpr size_t WS_MIX = WS_R + 160 * MiB;
constexpr size_t WS_H = WS_R;
constexpr size_t WS_END = WS_R + 224 * MiB;
constexpr int CW_BAR = 4096;

constexpr int RING_OFF = 0, RING_BYTES = 131072;
constexpr int LDSCTL_OFF = RING_BYTES, MISC_OFF = LDSCTL_OFF + 320;
constexpr int LDS_BYTES = 147456;

#define GAS __attribute__((address_space(1)))
#define LAS __attribute__((address_space(3)))
typedef unsigned short bf16;
typedef unsigned v4u __attribute__((ext_vector_type(4)));
typedef unsigned v2u __attribute__((ext_vector_type(2)));
typedef float f32x4 __attribute__((ext_vector_type(4)));
typedef GAS unsigned gu32;
#define RLX_AGENT __ATOMIC_RELAXED, __HIP_MEMORY_SCOPE_AGENT
#define LDS_WAIT() asm volatile("s_waitcnt lgkmcnt(0)" ::: "memory")
#define VM_WAIT() asm volatile("s_waitcnt vmcnt(0)" ::: "memory")
__device__ __forceinline__ unsigned f2bf(float f) { unsigned u = __builtin_bit_cast(unsigned, f); return (u + 0x7fffu + ((u >> 16) & 1u)) >> 16; }
__device__ __forceinline__ unsigned pk2(float lo, float hi) { return f2bf(lo) | (f2bf(hi) << 16); }
__device__ __forceinline__ float bf2f(unsigned short h) { return __uint_as_float(((unsigned)h) << 16); }
__device__ __forceinline__ float bflo(unsigned w) { return __uint_as_float(w << 16); }
__device__ __forceinline__ float bfhi(unsigned w) { return __uint_as_float(w & 0xffff0000u); }

#define XB_TMO      128
#define XB_XCNT(j)  (256  + 64 * (j))
#define XB_XSUB(j)  (1280 + 64 * (j))
#define XB_XGEN(j)  (2304 + 64 * (j))
#define XB_TOP      3328
#define XB_TOPGEN   3392
#define XCD_BAR_WORDS 3456
#define XB_SPIN_CAP (1u << 18)

__device__ __forceinline__ unsigned xb_ld(unsigned* p)              { return __hip_atomic_load(p, __ATOMIC_RELAXED, __HIP_MEMORY_SCOPE_AGENT); }
__device__ __forceinline__ unsigned xb_add(unsigned* p, unsigned v) { return __hip_atomic_fetch_add(p, v, __ATOMIC_RELAXED, __HIP_MEMORY_SCOPE_AGENT); }
__device__ __forceinline__ unsigned xb_xcc_id() { return (unsigned)__builtin_amdgcn_s_getreg((3 << 11) | 20) & 0xFu; }
#define XB_SPIN(cond, bar) do { unsigned _sp = 0; while (cond) { __builtin_amdgcn_s_sleep(1); \
    if ((++_sp & 255u) == 0u) { if (xb_ld(&(bar)[XB_TMO])) break; if (_sp > XB_SPIN_CAP) { atomicAdd(&(bar)[XB_TMO], 1u); break; } } } } while (0)

struct XcdBarrier {
    unsigned* bar; unsigned x;
    volatile LAS unsigned* st;
};

__device__ __forceinline__ XcdBarrier xcd_barrier_post(unsigned* bar, volatile LAS unsigned* st) {
    XcdBarrier b; b.bar = bar; b.x = xb_xcc_id(); b.st = st;
    if (threadIdx.x == 0) (void)xb_add(&bar[XB_XCNT(b.x)], 1u);
    return b;
}
__device__ __forceinline__ void xcd_barrier_complete(unsigned* bar, unsigned x, unsigned& nloc, unsigned& nx) {
    const unsigned G = gridDim.x * gridDim.y * gridDim.z;
    unsigned sum, cnt, mine, sp = 0u;
    for (;;) {
        sum = 0u; cnt = 0u; mine = 0u;
#pragma unroll
        for (unsigned j = 0; j < 16; ++j) { const unsigned c = xb_ld(&bar[XB_XCNT(j)]); sum += c; cnt += (c > 0u) ? 1u : 0u; mine = (j == x) ? c : mine; }
        if (sum == G) break;
        __builtin_amdgcn_s_sleep(1);
        if ((++sp & 255u) == 0u) { if (xb_ld(&bar[XB_TMO])) break; if (sp > XB_SPIN_CAP) { atomicAdd(&bar[XB_TMO], 1u); break; } }
    }
    nloc = mine > 0u ? mine : 1u; nx = cnt > 0u ? cnt : 1u;
}

__device__ __forceinline__ void xcd_barrier(const XcdBarrier& b) {
    asm volatile("s_waitcnt vmcnt(0)" ::: "memory");
    __syncthreads();
    if (threadIdx.x == 0) {
        unsigned* bar = b.bar;
        __builtin_amdgcn_s_waitcnt(0);
        unsigned nloc = b.st[0], nx = b.st[1];
        if (nloc == 0u) { xcd_barrier_complete(bar, b.x, nloc, nx); b.st[0] = nloc; b.st[1] = nx; }
        const unsigned old = xb_add(&bar[XB_XSUB(b.x)], 1u);
        const unsigned gen = old / nloc;
        if (old + 1u == (gen + 1u) * nloc) {
            __builtin_amdgcn_fence(__ATOMIC_RELEASE, "agent");
            asm volatile("s_waitcnt vmcnt(0)" ::: "memory");
            const unsigned og = xb_add(&bar[XB_TOP], 1u);
            const unsigned tg = og / nx;
            if (og + 1u == (tg + 1u) * nx) xb_add(&bar[XB_TOPGEN], 1u);
            else XB_SPIN(xb_ld(&bar[XB_TOPGEN]) == tg, bar);
            __builtin_amdgcn_fence(__ATOMIC_ACQUIRE, "agent");
            xb_add(&bar[XB_XGEN(b.x)], 1u);
            asm volatile("s_waitcnt vmcnt(0)" ::: "memory");
        } else {
            XB_SPIN(xb_ld(&bar[XB_XGEN(b.x)]) == gen, bar);
            __builtin_amdgcn_fence(__ATOMIC_ACQUIRE, "agent");
            asm volatile("s_waitcnt vmcnt(0)" ::: "memory");
        }
    }
    __syncthreads();
}
__device__ __forceinline__ float wave_sum(float v) {
#pragma unroll
    for (int o = 1; o < 64; o <<= 1) v += __shfl_xor(v, o);
    return v;
}
__device__ __forceinline__ float wave_max(float v) {
#pragma unroll
    for (int o = 1; o < 64; o <<= 1) v = fmaxf(v, __shfl_xor(v, o));
    return v;
}
__device__ __forceinline__ int opaque_zero() { int z; asm volatile("v_mov_b32 %0, 0" : "=v"(z)); return z; }

__device__ __forceinline__ void p0_transpose_item(const float* W, int K, int N, bf16* WT, int dest_row0, int k0, int n0, const float* gk, LAS float* scr, int lane) {
#pragma unroll 8
    for (int i = 0; i < 32; ++i) { const int kk = 2 * i + (lane >> 5); float v = W[(size_t)(k0 + kk) * N + n0 + (lane & 31)]; if (gk) v *= gk[k0 + kk]; scr[kk * 33 + (lane & 31)] = v; }
    LDS_WAIT(); asm volatile("" ::: "memory");
    const int c = lane & 7;
#pragma unroll
    for (int j = 0; j < 4; ++j) { const int n = (lane >> 3) + 8 * j; const LAS float* s = scr + (8 * c) * 33 + n;
        v4u o; o.x = pk2(s[0 * 33], s[1 * 33]); o.y = pk2(s[2 * 33], s[3 * 33]); o.z = pk2(s[4 * 33], s[5 * 33]); o.w = pk2(s[6 * 33], s[7 * 33]);
        *(GAS v4u*)(WT + (size_t)(dest_row0 + n) * K + k0 + 8 * c) = o; }
    LDS_WAIT(); asm volatile("" ::: "memory");
}
__device__ __forceinline__ void p0_matrix_item(const float* W, int K, int N, bf16* WT, const float* gk, int mode, int item, LAS float* scr, int lane) {
    const int nblk = N / 32, kb = item / nblk, nb = item - kb * nblk, k0 = 64 * kb, n0 = 32 * nb;
    const int dr = (mode == 0) ? n0 : (256 * (n0 >> 7) + (n0 & 127) + (mode == 2 ? 128 : 0));
    p0_transpose_item(W, K, N, WT, dr, k0, n0, gk, scr, lane);
}
__device__ __forceinline__ void row_to_bf16_ssq(const float* xrow, bf16* orow, float* ssq16, int lane) {
    const GAS f32x4* xr = (const GAS f32x4*)xrow + lane;
    f32x4 v[4]; float s = 0.f;
#pragma unroll
    for (int j = 0; j < 4; ++j) { v[j] = xr[64 * j]; s += (v[j].x * v[j].x + v[j].y * v[j].y) + (v[j].z * v[j].z + v[j].w * v[j].w); }
    s = wave_sum(s);
    GAS unsigned long long* o8 = (GAS unsigned long long*)orow + lane;
#pragma unroll
    for (int j = 0; j < 4; ++j) o8[64 * j] = (unsigned long long)pk2(v[j].x, v[j].y) | ((unsigned long long)pk2(v[j].z, v[j].w) << 32);
    if (lane < 16) ssq16[lane] = (lane == 0) ? s : 0.f;
}

__device__ __forceinline__ void s5_naive_unit(int b, int g, const bf16* U, bf16* Y, const float* lam_re, const float* lam_im, const float* log_dt, const float* b_re, const float* b_im,
                                              const float* c_re, const float* c_im, const float* dvec, int lane) {
    const int p = lane;
    const float lr = lam_re[g * 64 + p], li = lam_im[g * 64 + p], dt = expf(log_dt[g]);
    const float mag = expf(lr * dt), ar = mag * cosf(li * dt), ai = mag * sinf(li * dt);
    const float den = lr * lr + li * li, nr = ar - 1.0f, fr = (nr * lr + ai * li) / den, fi = (ai * lr - nr * li) / den;
    float bbr[16], bbi[16], cr[16], ci[16];
#pragma unroll
    for (int c = 0; c < 16; ++c) { const float br = b_re[((size_t)g * 64 + p) * 16 + c], bi = b_im[((size_t)g * 64 + p) * 16 + c]; bbr[c] = fr * br - fi * bi; bbi[c] = fr * bi + fi * br;
        cr[c] = c_re[((size_t)g * 16 + c) * 64 + p]; ci[c] = c_im[((size_t)g * 16 + c) * 64 + p]; }
    const int ch = ((lane & 1) << 3) | ((lane & 2) << 1) | ((lane & 4) >> 1) | ((lane & 8) >> 3);
    const float dch = dvec[16 * g + ch];
    const int z0 = opaque_zero();
    const bf16* up = U + (size_t)b * SEQ * TOKW + 16 * g + z0;
    bf16* yp = Y + (size_t)b * SEQ * TOKW + 16 * g + ch;
    float xr = 0.f, xi = 0.f;
#pragma unroll 2
    for (int s = 0; s < SEQ; ++s) {
        const v4u w0 = *(const GAS v4u*)(up + (size_t)s * TOKW), w1 = *(const GAS v4u*)(up + (size_t)s * TOKW + 8);
        const float uch = bf2f(up[(size_t)s * TOKW + ch]);
        const float uu[16] = {bflo(w0.x), bfhi(w0.x), bflo(w0.y), bfhi(w0.y), bflo(w0.z), bfhi(w0.z), bflo(w0.w), bfhi(w0.w), bflo(w1.x), bfhi(w1.x), bflo(w1.y), bfhi(w1.y), bflo(w1.z), bfhi(w1.z), bflo(w1.w), bfhi(w1.w)};
        float bur = 0.f, bui = 0.f;
#pragma unroll
        for (int c = 0; c < 16; ++c) { bur += bbr[c] * uu[c]; bui += bbi[c] * uu[c]; }
        const float nxr = ar * xr - ai * xi + bur, nxi = ar * xi + ai * xr + bui; xr = nxr; xi = nxi;
        float v[16];
#pragma unroll
        for (int c = 0; c < 16; ++c) v[c] = cr[c] * xr - ci[c] * xi;
        float w[8], x4[4], x2[2], z;
        { const bool bit = lane & 1;
#pragma unroll
          for (int j = 0; j < 8; ++j) { const float send = bit ? v[j] : v[j + 8], keep = bit ? v[j + 8] : v[j]; w[j] = keep + __shfl_xor(send, 1); } }
        { const bool bit = lane & 2;
#pragma unroll
          for (int j = 0; j < 4; ++j) { const float send = bit ? w[j] : w[j + 4], keep = bit ? w[j + 4] : w[j]; x4[j] = keep + __shfl_xor(send, 2); } }
        { const bool bit = lane & 4;
#pragma unroll
          for (int j = 0; j < 2; ++j) { const float send = bit ? x4[j] : x4[j + 2], keep = bit ? x4[j + 2] : x4[j]; x2[j] = keep + __shfl_xor(send, 4); } }
        { const bool bit = lane & 8; const float send = bit ? x2[0] : x2[1], keep = bit ? x2[1] : x2[0]; z = keep + __shfl_xor(send, 8); }
        z += __shfl_xor(z, 16); z += __shfl_xor(z, 32);
        const float yv = z + dch * uch;
        const float ge = 0.5f * yv * (1.0f + erff(yv * 0.70710678118654752f));
        if (lane < 16) yp[(size_t)s * TOKW] = (bf16)f2bf(ge);
    }
}

__device__ __forceinline__ void memattn_naive_unit(int tok, int h, const bf16* QM, const bf16* memk, const bf16* memv, bf16* mix, LAS float* ps, int lane) {
    const int b = tok >> 12; const int z0 = opaque_zero();
    const float qv = bf2f(QM[(size_t)tok * 256 + h * 64 + lane]);
    float q[64];
#pragma unroll
    for (int d = 0; d < 64; ++d) q[d] = __shfl(qv, d);
    float sc[4];
#pragma unroll
    for (int i = 0; i < 4; ++i) { const int j = lane + 64 * i; const GAS v4u* kr = (const GAS v4u*)(memk + ((size_t)(b * 256 + j)) * 256 + h * 64 + z0); float a = 0.f;
#pragma unroll
        for (int c = 0; c < 8; ++c) { const v4u w = kr[c]; a += q[8 * c] * bflo(w.x) + q[8 * c + 1] * bfhi(w.x) + q[8 * c + 2] * bflo(w.y) + q[8 * c + 3] * bfhi(w.y) + q[8 * c + 4] * bflo(w.z) + q[8 * c + 5] * bfhi(w.z) + q[8 * c + 6] * bflo(w.w) + q[8 * c + 7] * bfhi(w.w); }
        sc[i] = a; }
    const float m = wave_max(fmaxf(fmaxf(sc[0], sc[1]), fmaxf(sc[2], sc[3])));
    float l = 0.f;
#pragma unroll
    for (int i = 0; i < 4; ++i) { const float pe = __builtin_amdgcn_exp2f(sc[i] - m); l += pe; ps[lane + 64 * i] = pe; }
    l = wave_sum(l);
    LDS_WAIT(); asm volatile("" ::: "memory");
    float o = 0.f; const bf16* vp = memv + (size_t)(b * 256) * 256 + h * 64 + lane;
#pragma unroll 8
    for (int j = 0; j < 256; ++j) o += ps[j] * bf2f(vp[(size_t)j * 256]);
    mix[(size_t)tok * 1024 + 768 + h * 64 + lane] = (bf16)f2bf(o / l);
    LDS_WAIT(); asm volatile("" ::: "memory");
}

__device__ __forceinline__ float dot64_bf16(const float (&q)[64], const GAS v4u* kr) {
    float a = 0.f;
#pragma unroll
    for (int c = 0; c < 8; ++c) { const v4u w = kr[c]; a += q[8 * c] * bflo(w.x) + q[8 * c + 1] * bfhi(w.x) + q[8 * c + 2] * bflo(w.y) + q[8 * c + 3] * bfhi(w.y) + q[8 * c + 4] * bflo(w.z) + q[8 * c + 5] * bfhi(w.z) + q[8 * c + 6] * bflo(w.w) + q[8 * c + 7] * bfhi(w.w); }
    return a;
}
__device__ __forceinline__ void moba_naive_unit(int tok, int h, const bf16* Q1, const bf16* K1, const bf16* V1, const float* KMEAN, bf16* mix, LAS float* ps, int lane) {
    const int b = tok >> 12, s = tok & (SEQ - 1), qb = s >> 8; const int z0 = opaque_zero();
    const float qv = bf2f(Q1[(size_t)tok * TOKW + h * 64 + lane]);
    float q[64];
#pragma unroll
    for (int d = 0; d < 64; ++d) q[d] = __shfl(qv, d);
    float gate = -1e30f;
    { const int n = lane & 15; const GAS f32x4* km = (const GAS f32x4*)(KMEAN + ((size_t)((b * NHEAD + h) * NBLK + n)) * 64 + z0); float a = 0.f;
#pragma unroll
      for (int c = 0; c < 16; ++c) { const f32x4 w = km[c]; a += q[4 * c] * w.x + q[4 * c + 1] * w.y + q[4 * c + 2] * w.z + q[4 * c + 3] * w.w; }
      if (n < qb) gate = a; }
    float g[16];
#pragma unroll
    for (int n = 0; n < 16; ++n) g[n] = __shfl(gate, n);
    const int nsel = qb < 3 ? qb : 3;
    unsigned mask = 0u;
#pragma unroll
    for (int r = 0; r < 3; ++r) { float best = -3.0e38f; int bi = 0;
#pragma unroll
        for (int n = 0; n < 16; ++n) { const bool c = !((mask >> n) & 1u) && g[n] > best; best = c ? g[n] : best; bi = c ? n : bi; }
        if (r < nsel) mask |= 1u << bi; }
    int blk0 = 0, blk1 = 0, blk2 = 0, cnt = 0;
#pragma unroll
    for (int n = 0; n < 16; ++n) if ((mask >> n) & 1u) { if (cnt == 0) blk0 = n; else if (cnt == 1) blk1 = n; else blk2 = n; ++cnt; }
    const int nslots = nsel + 1;
    const float slope = __builtin_amdgcn_exp2f(-8.0f * (float)(h + 1) / 12.0f) * LOG2E;
    const bf16* kh = K1 + (size_t)b * SEQ * TOKW + h * 64 + z0;
    float mx = -3.0e38f;
#pragma unroll
    for (int sl = 0; sl < 4; ++sl) if (sl < nslots) {
        const int blk = (sl == nsel) ? qb : (sl == 0 ? blk0 : (sl == 1 ? blk1 : blk2));
#pragma unroll
        for (int i = 0; i < 4; ++i) { const int j = lane + 64 * i, pos = blk * 256 + j;
            float a = dot64_bf16(q, (const GAS v4u*)(kh + (size_t)pos * TOKW)) + slope * (float)(pos - s);
            if (pos > s) a = -3.0e38f;
            ps[sl * 256 + j] = a; mx = fmaxf(mx, a); } }
    mx = wave_max(mx);
    LDS_WAIT(); asm volatile("" ::: "memory");
    float l = 0.f;
#pragma unroll
    for (int sl = 0; sl < 4; ++sl) if (sl < nslots) {
#pragma unroll
        for (int i = 0; i < 4; ++i) { const int j = lane + 64 * i; const float a = ps[sl * 256 + j]; const float pe = (a < -1.0e37f) ? 0.f : __builtin_amdgcn_exp2f(a - mx); l += pe; ps[sl * 256 + j] = pe; } }
    l = wave_sum(l);
    LDS_WAIT(); asm volatile("" ::: "memory");
    float o = 0.f; const bf16* vh = V1 + (size_t)b * SEQ * TOKW + h * 64 + lane;
#pragma unroll
    for (int sl = 0; sl < 4; ++sl) if (sl < nslots) {
        const int blk = (sl == nsel) ? qb : (sl == 0 ? blk0 : (sl == 1 ? blk1 : blk2));
        const bf16* vp = vh + (size_t)(blk * 256) * TOKW;
#pragma unroll 8
        for (int j = 0; j < 256; ++j) o += ps[sl * 256 + j] * bf2f(vp[(size_t)j * TOKW]); }
    mix[(size_t)tok * 1024 + h * 64 + lane] = (bf16)f2bf(o / l);
    LDS_WAIT(); asm volatile("" ::: "memory");
}

#ifndef MK_ONE_LAUNCH
#define MK_ONE_LAUNCH 1
#endif
constexpr int N_PHASES = 14;
struct Args { const float* in[23]; float* out; unsigned char* ws; int ph_lo, ph_hi; };

__global__ void __launch_bounds__(NWAVES * 64, 2) mega_fwd(Args args) {
    extern __shared__ __attribute__((aligned(16))) unsigned char lds[];
    LAS unsigned char* L = (LAS unsigned char*)lds;
    volatile LAS unsigned* MISC = (volatile LAS unsigned*)(L + MISC_OFF);
    const int tid = threadIdx.x, lane = tid & 63, wave = __builtin_amdgcn_readfirstlane(tid >> 6);
    const int G = gridDim.x; const int bx = blockIdx.x;
    const int vcu = (G % 8 == 0) ? (bx % 8) * (G / 8) + bx / 8 : bx;
    const int gw = vcu * NWAVES + wave, NGW = G * NWAVES;
    unsigned char* ws = args.ws;
    gu32* ctl = (gu32*)(ws + WS_CTL);
    for (int u = tid; u < (LDS_BYTES - LDSCTL_OFF) / 4; u += NWAVES * 64) ((LAS unsigned*)(L + LDSCTL_OFF))[u] = 0u;
    __syncthreads();
    XcdBarrier bar; bar.bar = (unsigned*)(ctl + CW_BAR); bar.x = 0; bar.st = nullptr;
    if (MK_ONE_LAUNCH) bar = xcd_barrier_post((unsigned*)(ctl + CW_BAR), MISC + 8);
    const int lo = args.ph_lo, hi = args.ph_hi;
#define IN(k) (lo <= (k) && (k) < hi)
#define SEAM(k) do { if (IN(k) && IN((k) + 1)) xcd_barrier(bar); } while (0)

    const float* x = args.in[0]; const float* mem = args.in[1];
    float* out = args.out;
    float* SS0 = (float*)(ws + WS_SS0); float* SSA = (float*)(ws + WS_SSA); float* SSB = (float*)(ws + WS_SSB); float* SSM = (float*)(ws + WS_SSM);
    float* KMEAN = (float*)(ws + WS_KMEAN);
    bf16* WIN0 = (bf16*)(ws + WS_WIN0); bf16* WGLU = (bf16*)(ws + WS_WGLU); bf16* WIN1 = (bf16*)(ws + WS_WIN1);
    bf16* WOUT0 = (bf16*)(ws + WS_WOUT0); bf16* WOUT1 = (bf16*)(ws + WS_WOUT1);
    bf16* WGU0 = (bf16*)(ws + WS_WGU0); bf16* WGU1 = (bf16*)(ws + WS_WGU1); bf16* WDN0 = (bf16*)(ws + WS_WDN0); bf16* WDN1 = (bf16*)(ws + WS_WDN1); bf16* WMKV = (bf16*)(ws + WS_WMKV);
    bf16* MEMB = (bf16*)(ws + WS_MEMB); bf16* MEMK = (bf16*)(ws + WS_MEMK); bf16* MEMV = (bf16*)(ws + WS_MEMV);
    bf16* XB = (bf16*)(ws + WS_XB); bf16* Ub = (bf16*)(ws + WS_U); bf16* Yb = (bf16*)(ws + WS_Y);
    bf16* Q1 = (bf16*)(ws + WS_Q1); bf16* K1 = (bf16*)(ws + WS_K1); bf16* V1 = (bf16*)(ws + WS_V1);
    bf16* QM = (bf16*)(ws + WS_QM); bf16* MIX = (bf16*)(ws + WS_MIX); bf16* Hb = (bf16*)(ws + WS_H);

    if (IN(0)) {
        LAS float* scr = (LAS float*)(L + RING_OFF + wave * 16384);
        constexpr int I_SQ = 16 * 32, I_GLU = 12 * 24, I_IN1 = 16 * 80, I_GU = 16 * 88, I_DN = 44 * 32, I_MKV = 16 * 16;
        constexpr int NITEMS = I_SQ + I_GLU + I_IN1 + 2 * I_SQ + 4 * I_GU + 2 * I_DN + I_MKV;
        const float* mixg = args.in[4]; const float* ffng = args.in[18];
        for (int it = gw; it < NITEMS; it += NGW) {
            int r = it;
            if (r < I_SQ) { p0_matrix_item(args.in[5], 1024, 1024, WIN0, mixg, 0, r, scr, lane); continue; } r -= I_SQ;
            if (r < I_GLU) { p0_matrix_item(args.in[14], 768, 768, WGLU, nullptr, 0, r, scr, lane); continue; } r -= I_GLU;
            if (r < I_IN1) { p0_matrix_item(args.in[16], 1024, 2560, WIN1, mixg + 1024, 0, r, scr, lane); continue; } r -= I_IN1;
            if (r < I_SQ) { p0_matrix_item(args.in[17], 1024, 1024, WOUT0, nullptr, 0, r, scr, lane); continue; } r -= I_SQ;
            if (r < I_SQ) { p0_matrix_item(args.in[17] + 1024 * 1024, 1024, 1024, WOUT1, nullptr, 0, r, scr, lane); continue; } r -= I_SQ;
            if (r < I_GU) { p0_matrix_item(args.in[19], 1024, FFN, WGU0, ffng, 1, r, scr, lane); continue; } r -= I_GU;
            if (r < I_GU) { p0_matrix_item(args.in[20], 1024, FFN, WGU0, ffng, 2, r, scr, lane); continue; } r -= I_GU;
            if (r < I_GU) { p0_matrix_item(args.in[19] + (size_t)1024 * FFN, 1024, FFN, WGU1, ffng + 1024, 1, r, scr, lane); continue; } r -= I_GU;
            if (r < I_GU) { p0_matrix_item(args.in[20] + (size_t)1024 * FFN, 1024, FFN, WGU1, ffng + 1024, 2, r, scr, lane); continue; } r -= I_GU;
            if (r < I_DN) { p0_matrix_item(args.in[21], FFN, 1024, WDN0, nullptr, 0, r, scr, lane); continue; } r -= I_DN;
            if (r < I_DN) { p0_matrix_item(args.in[21] + (size_t)FFN * 1024, FFN, 1024, WDN1, nullptr, 0, r, scr, lane); continue; } r -= I_DN;
            p0_matrix_item(args.in[3], 1024, 512, WMKV, args.in[2], 0, r, scr, lane);
        }
        for (int m = gw; m < TOK; m += NGW) row_to_bf16_ssq(x + (size_t)m * DM, XB + (size_t)m * DM, SS0 + (size_t)m * 16, lane);
        for (int m = gw; m < BATCH * MEML; m += NGW) row_to_bf16_ssq(mem + (size_t)m * DM, MEMB + (size_t)m * DM, SSM + (size_t)m * 16, lane);
    }
    SEAM(0);
    if (IN(1)) {
        { pg8::Gemm g{XB, WIN0, TOK, 1024, 1024}; pg8::StaticOrder S; S.init(TOK, 1024, G, bx);
          pg8::EpiProj E{SS0, Ub, 0, 3, 1, TOKW, 1.0f, QM, C2};
          pg8::gemm_phase<pg8::EpiProj, pg8::StaticOrder, true, true>(L + RING_OFF, g, S, E); }
        { pg8::Gemm g{MEMB, WMKV, BATCH * MEML, 512, 1024}; pg8::StaticOrder S; S.init(BATCH * MEML, 512, G, bx);
          pg8::EpiProj E{SSM, MEMK, (size_t)(WS_MEMV - WS_MEMK) / 2, 1, 2, 256, 1.0f, nullptr, 1.0f};
          pg8::gemm_phase<pg8::EpiProj, pg8::StaticOrder, true, true>(L + RING_OFF, g, S, E); }
    }
    SEAM(1);
    if (IN(2)) {
        for (int un = gw; un < BATCH * NGRP; un += NGW)
            s5_naive_unit(un / NGRP, un % NGRP, Ub, Yb, args.in[6], args.in[7], args.in[8], args.in[9], args.in[10], args.in[11], args.in[12], args.in[13], lane);
        LAS float* ps = (LAS float*)(L + RING_OFF + wave * 4096);
        for (int un = gw; un < TOK * MHEAD; un += NGW) memattn_naive_unit(un >> 2, un & 3, QM, MEMK, MEMV, MIX, ps, lane);
    }
    SEAM(2);
    if (IN(3)) {
        pg8::Gemm g{Yb, WGLU, TOK, TOKW, TOKW}; pg8::StaticOrder S; S.init(TOK, TOKW, G, bx);
        pg8::EpiGlu E{Yb, TOKW, args.in[15], MIX, 1024};
        pg8::gemm_phase<pg8::EpiGlu, pg8::StaticOrder, true, true>(L + RING_OFF, g, S, E);
    }
    SEAM(3);
    if (IN(4)) {
        pg8::Gemm g{MIX, WOUT0, TOK, 1024, 1024}; pg8::StaticOrder S; S.init(TOK, 1024, G, bx);
        pg8::EpiRes E{x, out, XB, SSA};
        pg8::gemm_phase<pg8::EpiRes, pg8::StaticOrder, true, true>(L + RING_OFF, g, S, E);
    }
    SEAM(4);
    if (IN(5)) {
        pg8::Gemm g{XB, WGU0, TOK, 2 * FFN, 1024}; pg8::StaticOrder S; S.init(TOK, 2 * FFN, G, bx);
        pg8::EpiGU E{SSA, Hb, FFN};
        pg8::gemm_phase<pg8::EpiGU, pg8::StaticOrder, true, true>(L + RING_OFF, g, S, E);
    }
    SEAM(5);
    if (IN(6)) {
        pg8::Gemm g{Hb, WDN0, TOK, 1024, FFN}; pg8::StaticOrder S; S.init(TOK, 1024, G, bx);
        pg8::EpiRes E{out, out, XB, SSB};
        pg8::gemm_phase<pg8::EpiRes, pg8::StaticOrder, true, true>(L + RING_OFF, g, S, E);
    }
    SEAM(6);
    if (IN(7)) {
        pg8::Gemm g{XB, WIN1, TOK, 2560, 1024}; pg8::StaticOrder S; S.init(TOK, 2560, G, bx);
        pg8::EpiProj E{SSB, Q1, (size_t)(WS_K1 - WS_Q1) / 2, 3, 3, TOKW, C2, QM, C2};
        pg8::gemm_phase<pg8::EpiProj, pg8::StaticOrder, true, true>(L + RING_OFF, g, S, E);
    }
    SEAM(7);
    if (IN(8)) {
        for (int un = gw; un < BATCH * NHEAD * NBLK; un += NGW) {
            const int n = un & 15, bh = un >> 4, h = bh % NHEAD, b = bh / NHEAD;
            const bf16* kp = K1 + ((size_t)b * SEQ + (size_t)n * MBLK) * TOKW + h * 64 + lane; float a = 0.f;
#pragma unroll 8
            for (int i = 0; i < MBLK; ++i) a += bf2f(kp[(size_t)i * TOKW]);
            KMEAN[(size_t)un * 64 + lane] = a * (1.0f / MBLK);
        }
    }
    SEAM(8);
    if (IN(9)) {
        LAS float* ps = (LAS float*)(L + RING_OFF + wave * 4096);
        for (int un = gw; un < TOK * NHEAD; un += NGW) moba_naive_unit(un / NHEAD, un % NHEAD, Q1, K1, V1, KMEAN, MIX, ps, lane);
        for (int un = gw; un < TOK * MHEAD; un += NGW) memattn_naive_unit(un >> 2, un & 3, QM, MEMK, MEMV, MIX, ps, lane);
    }
    SEAM(9);
    if (IN(10)) {
        pg8::Gemm g{MIX, WOUT1, TOK, 1024, 1024}; pg8::StaticOrder S; S.init(TOK, 1024, G, bx);
        pg8::EpiRes E{out, out, XB, SSA};
        pg8::gemm_phase<pg8::EpiRes, pg8::StaticOrder, true, true>(L + RING_OFF, g, S, E);
    }
    SEAM(10);
    if (IN(11)) {
        pg8::Gemm g{XB, WGU1, TOK, 2 * FFN, 1024}; pg8::StaticOrder S; S.init(TOK, 2 * FFN, G, bx);
        pg8::EpiGU E{SSA, Hb, FFN};
        pg8::gemm_phase<pg8::EpiGU, pg8::StaticOrder, true, true>(L + RING_OFF, g, S, E);
    }
    SEAM(11);
    if (IN(12)) {
        pg8::Gemm g{Hb, WDN1, TOK, 1024, FFN}; pg8::StaticOrder S; S.init(TOK, 1024, G, bx);
        pg8::EpiRes E{out, out, XB, SSB};
        pg8::gemm_phase<pg8::EpiRes, pg8::StaticOrder, true, true>(L + RING_OFF, g, S, E);
    }
    SEAM(12);
    if (IN(13)) {
        const float* gf = args.in[22];
        for (int m = gw; m < TOK; m += NGW) {
            const float rs = pg8::row_rstd(SSB, m);
            GAS f32x4* xr = (GAS f32x4*)(out + (size_t)m * DM) + lane; const GAS f32x4* gp = (const GAS f32x4*)gf + lane;
#pragma unroll
            for (int j = 0; j < 4; ++j) { const f32x4 v = xr[64 * j], gg = gp[64 * j]; xr[64 * j] = v * rs * gg; }
        }
    }
#undef IN
#undef SEAM
}

extern "C" void kernel_launch(void* const* d_in, const int* in_sizes, int n_in, void* d_out, int out_size, void* d_ws, size_t ws_size, hipStream_t stream) {
    static int grid = 0;
    if (grid == 0) {
        if (n_in != 23 || out_size != TOK * DM || ws_size < WS_END) { fprintf(stderr, "kernel_launch: unexpected shapes: n_in %d out %d ws %zu\n", n_in, out_size, ws_size); grid = -1; return; }
        int dev = 0, cus = 0, per_cu = 0;
        if (hipGetDevice(&dev) != hipSuccess || hipDeviceGetAttribute(&cus, hipDeviceAttributeMultiprocessorCount, dev) != hipSuccess) { grid = -1; return; }
        if (hipFuncSetAttribute((const void*)mega_fwd, hipFuncAttributeMaxDynamicSharedMemorySize, LDS_BYTES) != hipSuccess) { fprintf(stderr, "kernel_launch: hipFuncSetAttribute failed\n"); grid = -1; return; }
        if (hipOccupancyMaxActiveBlocksPerMultiprocessor(&per_cu, (const void*)mega_fwd, NWAVES * 64, LDS_BYTES) != hipSuccess || per_cu < 1)
            fprintf(stderr, "kernel_launch: occupancy query reports %d workgroups per CU\n", per_cu);
        (void)hipGetLastError();
        grid = cus;
    }
    if (grid < 0) return;
    if (hipMemsetAsync((char*)d_ws + WS_CTL, 0, CTL_ZERO_BYTES, stream) != hipSuccess) return;
    Args a{};
    for (int i = 0; i < 23; ++i) a.in[i] = (const float*)d_in[i];
    a.out = (float*)d_out; a.ws = (unsigned char*)d_ws;
#if MK_ONE_LAUNCH
    a.ph_lo = 0; a.ph_hi = N_PHASES;
    hipLaunchKernelGGL(mega_fwd, dim3(grid), dim3(NWAVES * 64), LDS_BYTES, stream, a);
#else
    for (int p = 0; p < N_PHASES; ++p) { a.ph_lo = p; a.ph_hi = p + 1; hipLaunchKernelGGL(mega_fwd, dim3(grid), dim3(NWAVES * 64), LDS_BYTES, stream, a); }
#endif
}
```

```cpp
#include <hip/hip_runtime.h>
#include <hip/hip_bf16.h>
#include <cstdio>
#include <cstdint>
#include <cmath>
namespace pg8 {
#define PG8_LAS __attribute__((address_space(3)))
typedef unsigned short bf16_t;
typedef short bf16x8 __attribute__((ext_vector_type(8)));
typedef float f32x4 __attribute__((ext_vector_type(4)));
typedef unsigned u32x4 __attribute__((ext_vector_type(4)));
constexpr int BM = 256, BK = 64, HALF = 128, HTB = HALF * BK * 2  , STAGE_BYTES = 8 * HTB, NXCD = 8, WGM = 8;

__host__ __device__ __forceinline__ int lds_byte(int r, int c) { const int st = (r >> 4) * 2 + (c >> 5), rr = r & 15, cc = c & 31, ob = rr * 64 + cc * 2; return st * 1024 + (ob ^ (((ob >> 9) & 1) << 5)); }
__host__ __device__ __forceinline__ void stage_rc(int b, int& R, int& C) { const int st = b / 1024, sb = b % 1024, swz = sb ^ (((sb >> 9) & 1) << 5); R = (st >> 1) * 16 + swz / 64; C = (st & 1) * 32 + (swz % 64) / 2; }
__host__ __device__ __forceinline__ int perm32(int rho) { const int n = rho >> 4, i = rho & 15; return 8 * (i >> 2) + 4 * n + (i & 3); }

struct Unit { int pm, pn; };
struct Gemm { const bf16_t* A; const bf16_t* Bt; int M, N, K; };

struct StaticOrder {
    int nM, nN, nwg, G, c;
    __host__ __device__ void init(int M, int N, int G_, int c_) { nM = M / BM; nN = N / BM; nwg = nM * nN; G = G_; c = c_; }
    __host__ __device__ bool next(int i, Unit& u) const {
        const long L = (long)i * G + c; if (L >= nwg) return false;
        int wgid = (int)L; { const int q = nwg / NXCD, r = nwg % NXCD, xcd = wgid % NXCD, off = wgid / NXCD; wgid = (xcd < r ? xcd * (q + 1) : r * (q + 1) + (xcd - r) * q) + off; }
        const int nig = WGM * nN, gid = wgid / nig, fm = gid * WGM, gsz = (nM - fm) < WGM ? (nM - fm) : WGM;
        u.pm = fm + ((wgid % nig) % gsz); u.pn = (wgid % nig) / gsz; return true;
    }
    __device__ __forceinline__ void a_ready(const Unit&) const {}
    __device__ __forceinline__ void done(const Unit&) const {}
};

__device__ __forceinline__ unsigned cvt_pk_bf16(float lo, float hi) { unsigned r; asm volatile("v_cvt_pk_bf16_f32 %0, %1, %2" : "=v"(r) : "v"(lo), "v"(hi)); return r; }
typedef float f32x2 __attribute__((ext_vector_type(2)));
typedef unsigned u32x2 __attribute__((ext_vector_type(2)));
constexpr float RMS_EPS = 1e-6f;
__device__ __forceinline__ float row_rstd(const float* ssq, int row) {
    const f32x4* p = (const f32x4*)(ssq + (size_t)row * 16);
    const f32x4 a = p[0], b = p[1], c = p[2], d = p[3];
    const float s = (((a[0] + a[1]) + (a[2] + a[3])) + ((b[0] + b[1]) + (b[2] + b[3]))) + (((c[0] + c[1]) + (c[2] + c[3])) + ((d[0] + d[1]) + (d[2] + d[3])));
    return 1.0f / sqrtf(s * (1.0f / 1024.0f) + RMS_EPS);
}
__device__ __forceinline__ float bf2f(unsigned short h) { return __uint_as_float(((unsigned)h) << 16); }
__device__ __forceinline__ float bflo(unsigned w) { return __uint_as_float(w << 16); }
__device__ __forceinline__ float bfhi(unsigned w) { return __uint_as_float(w & 0xffff0000u); }

__device__ __forceinline__ f32x2 gelu_pk(f32x2 v) {
    const f32x2 av = __builtin_elementwise_abs(v), d = av * 0.2316418882f + 1.0f;
    f32x2 t; t.x = __builtin_amdgcn_rcpf(d.x); t.y = __builtin_amdgcn_rcpf(d.y);
    f32x2 q = t * 0.5307027145f + (-0.7265760135f); q = q * t + 0.7107068705f; q = q * t + (-0.142248368f); q = q * t + 0.127414796f; q = q * t;
    const f32x2 s = (v * v) * (-0.72134752044f);
    f32x2 e; e.x = __builtin_amdgcn_exp2f(s.x); e.y = __builtin_amdgcn_exp2f(s.y);
    const f32x2 m = v * (q * e), r = v - m;
    f32x2 o; o.x = v.x < 0.f ? m.x : r.x; o.y = v.y < 0.f ? m.y : r.y; return o;
}

struct EpiProj {
    static constexpr bool PERM = true, AFTER_DRAIN = false;
    const float* ssq; bf16_t* base; size_t seg_stride; int tps, nseg, ldc; float scale0; bf16_t* qm; float scale_qm;
    __device__ __forceinline__ void operator()(const f32x4 (&acc)[2][2][4][2], const Unit& u, int wr, int wc, int fr, int fq) const {
        const int seg = u.pn / tps, within = u.pn - seg * tps;
        bf16_t* o; int ld, colt; float sc;
        if (seg < nseg) { o = base + (size_t)seg * seg_stride; ld = ldc; colt = within * BM; sc = (seg == 0) ? scale0 : 1.0f; }
        else { o = qm; ld = 256; colt = 0; sc = scale_qm; }
        const int row0 = u.pm * BM + wr * 64 + fr, col0 = colt + wc * 32 + 8 * fq;
#pragma unroll
        for (int ai = 0; ai < 2; ++ai)
#pragma unroll
            for (int m = 0; m < 4; ++m) { const int row = row0 + ai * HALF + m * 16; const float rs = row_rstd(ssq, row) * sc; bf16_t* rowp = o + (size_t)row * ld + col0;
#pragma unroll
                for (int bj = 0; bj < 2; ++bj) { const f32x4 v0 = acc[ai][bj][m][0] * rs, v1 = acc[ai][bj][m][1] * rs;
                    u32x4 w; w.x = cvt_pk_bf16(v0[0], v0[1]); w.y = cvt_pk_bf16(v0[2], v0[3]); w.z = cvt_pk_bf16(v1[0], v1[1]); w.w = cvt_pk_bf16(v1[2], v1[3]);
                    *(u32x4*)(rowp + bj * HALF) = w; } }
    }
};
struct EpiGlu {
    static constexpr bool PERM = true, AFTER_DRAIN = false;
    const bf16_t* Y; int ldy; const float* bias; bf16_t* mix; int ldm;
    __device__ __forceinline__ void operator()(const f32x4 (&acc)[2][2][4][2], const Unit& u, int wr, int wc, int fr, int fq) const {
        const int row0 = u.pm * BM + wr * 64 + fr, col0 = u.pn * BM + wc * 32 + 8 * fq;
        f32x4 bv[2][2];
#pragma unroll
        for (int bj = 0; bj < 2; ++bj)
#pragma unroll
            for (int n = 0; n < 2; ++n) bv[bj][n] = *(const f32x4*)(bias + col0 + bj * HALF + 4 * n);
#pragma unroll
        for (int ai = 0; ai < 2; ++ai)
#pragma unroll
            for (int m = 0; m < 4; ++m) { const int row = row0 + ai * HALF + m * 16;
#pragma unroll
                for (int bj = 0; bj < 2; ++bj) { const u32x4 yw = *(const u32x4*)(Y + (size_t)row * ldy + col0 + bj * HALF);
                    const f32x4 z0 = acc[ai][bj][m][0] + bv[bj][0], z1 = acc[ai][bj][m][1] + bv[bj][1];
                    float t[8]; const float yv[8] = {bflo(yw.x), bfhi(yw.x), bflo(yw.y), bfhi(yw.y), bflo(yw.z), bfhi(yw.z), bflo(yw.w), bfhi(yw.w)};
#pragma unroll
                    for (int e = 0; e < 4; ++e) { t[e] = yv[e] * __builtin_amdgcn_rcpf(1.0f + __builtin_amdgcn_exp2f(-1.4426950408889634f * z0[e])); t[4 + e] = yv[4 + e] * __builtin_amdgcn_rcpf(1.0f + __builtin_amdgcn_exp2f(-1.4426950408889634f * z1[e])); }
                    u32x4 w; w.x = cvt_pk_bf16(t[0], t[1]); w.y = cvt_pk_bf16(t[2], t[3]); w.z = cvt_pk_bf16(t[4], t[5]); w.w = cvt_pk_bf16(t[6], t[7]);
                    *(u32x4*)(mix + (size_t)row * ldm + col0 + bj * HALF) = w; } }
    }
};
struct EpiRes {
    static constexpr bool PERM = false, AFTER_DRAIN = false;
    const float* base; float* out; bf16_t* xb; float* ssq_out;
    __device__ __forceinline__ void operator()(const f32x4 (&acc)[2][2][4][2], const Unit& u, int wr, int wc, int fr, int fq) const {
        const int row0 = u.pm * BM + wr * 64 + fr, col0 = u.pn * BM + wc * 32 + 4 * fq;
#pragma unroll
        for (int ai = 0; ai < 2; ++ai)
#pragma unroll
            for (int m = 0; m < 4; ++m) { const int row = row0 + ai * HALF + m * 16; const size_t off = (size_t)row * 1024 + col0; float ss = 0.f;
#pragma unroll
                for (int bj = 0; bj < 2; ++bj)
#pragma unroll
                    for (int n = 0; n < 2; ++n) { const f32x4 b = *(const f32x4*)(base + off + bj * HALF + n * 16); const f32x4 o = b + acc[ai][bj][m][n];
                        *(f32x4*)(out + off + bj * HALF + n * 16) = o; u32x2 w; w.x = cvt_pk_bf16(o[0], o[1]); w.y = cvt_pk_bf16(o[2], o[3]); *(u32x2*)(xb + off + bj * HALF + n * 16) = w;
                        ss += (o[0] * o[0] + o[1] * o[1]) + (o[2] * o[2] + o[3] * o[3]); }
                ss += __shfl_xor(ss, 16); ss += __shfl_xor(ss, 32);
                if (fq == 0) ssq_out[(size_t)row * 16 + u.pn * 4 + wc] = ss; }
    }
};
struct EpiGU {
    static constexpr bool PERM = true, AFTER_DRAIN = false;
    const float* ssq; bf16_t* H; int ldh;
    __device__ __forceinline__ void operator()(const f32x4 (&acc)[2][2][4][2], const Unit& u, int wr, int wc, int fr, int fq) const {
        const int row0 = u.pm * BM + wr * 64 + fr, col0 = u.pn * HALF + wc * 32 + 8 * fq;
#pragma unroll
        for (int ai = 0; ai < 2; ++ai)
#pragma unroll
            for (int m = 0; m < 4; ++m) { const int row = row0 + ai * HALF + m * 16; const float rs = row_rstd(ssq, row);
                float t[8];
#pragma unroll
                for (int n = 0; n < 2; ++n)
#pragma unroll
                    for (int e = 0; e < 4; ++e) { const float g = acc[ai][0][m][n][e] * rs, up = acc[ai][1][m][n][e] * rs;
                        t[4 * n + e] = g * __builtin_amdgcn_rcpf(1.0f + __builtin_amdgcn_exp2f(-1.4426950408889634f * g)) * up; }
                u32x4 w; w.x = cvt_pk_bf16(t[0], t[1]); w.y = cvt_pk_bf16(t[2], t[3]); w.z = cvt_pk_bf16(t[4], t[5]); w.w = cvt_pk_bf16(t[6], t[7]);
                *(u32x4*)(H + (size_t)row * ldh + col0) = w; }
    }
};

template <class Epi, class Sched, bool ALIGN_EPI = false, bool SP2 = false>
__device__ __forceinline__ void gemm_phase(PG8_LAS unsigned char* lds, const Gemm g, const Sched& S, const Epi& E) {
    const int tid = threadIdx.x, wid = __builtin_amdgcn_readfirstlane(tid >> 6), lane = tid & 63, wr = wid >> 2, wc = wid & 3, fr = lane & 15, fq = lane >> 4;
    const int K = g.K, nt = K / BK;
    unsigned voffA[2], voffB[2];
#pragma unroll
    for (int i = 0; i < 2; ++i) { int R, C; stage_rc(tid * 16 + i * 8192, R, C); const int Rb = Epi::PERM ? ((R & ~31) + perm32(R & 31)) : R;
        voffA[i] = (unsigned)(R * K + C) * 2u; voffB[i] = (unsigned)(Rb * K + C) * 2u; }
    const size_t kstep = (size_t)(BK * 2);
    const size_t hstep = (size_t)HALF * K * 2;
    const size_t tstep = 2 * hstep;
    const unsigned ldsw = (unsigned)wid * 1024u;
    const int aoff = lds_byte(wr * 64 + fr, fq * 8), boff = lds_byte(wc * 32 + fr, fq * 8);
#define PG8_SA(b, h) (((b) * 2 + (h)) * HTB)
#define PG8_SB(b, h) ((4 + (b) * 2 + (h)) * HTB)
#define PG8_STAGE(bufoff, gbase, voff) do { _Pragma("unroll") for (int _i = 0; _i < 2; ++_i) \
        __builtin_amdgcn_global_load_lds((const unsigned*)((const char*)(gbase) + (voff)[_i]), (PG8_LAS unsigned*)(lds + (bufoff) + ldsw + _i * 8192), 16, 0, 0); } while (0)
#define PG8_LDA(dst, b, h) do { _Pragma("unroll") for (int m = 0; m < 4; ++m) _Pragma("unroll") for (int k = 0; k < 2; ++k) dst[m][k] = *(const PG8_LAS bf16x8*)(lds + PG8_SA(b, h) + aoff + m * 2048 + k * 1024); } while (0)
#define PG8_LDB(dst, b, h) do { _Pragma("unroll") for (int n = 0; n < 2; ++n) _Pragma("unroll") for (int k = 0; k < 2; ++k) dst[n][k] = *(const PG8_LAS bf16x8*)(lds + PG8_SB(b, h) + boff + n * 2048 + k * 1024); } while (0)
#define PG8_MMA(ai, bj, At, Bt) do { __builtin_amdgcn_s_setprio(1); _Pragma("unroll") for (int m = 0; m < 4; ++m) _Pragma("unroll") for (int n = 0; n < 2; ++n) _Pragma("unroll") for (int k = 0; k < 2; ++k) \
        acc[ai][bj][m][n] = __builtin_amdgcn_mfma_f32_16x16x32_bf16(Bt[n][k], At[m][k], acc[ai][bj][m][n], 0, 0, 0); __builtin_amdgcn_s_setprio(0); } while (0)
#define PG8_WAIT_V(n) asm volatile("s_waitcnt vmcnt(" #n ")" ::: "memory")
#define PG8_WAIT_L(n) asm volatile("s_waitcnt lgkmcnt(" #n ")" ::: "memory")
#define PG8_BAR __builtin_amdgcn_s_barrier()
#define PG8_SCHED __builtin_amdgcn_sched_barrier(0)
    Unit cur, nxt; int ui = 0;
    if (!S.next(0, cur)) return;
    f32x4 acc[2][2][4][2];
#pragma unroll
    for (int a = 0; a < 2; ++a)
#pragma unroll
        for (int b = 0; b < 2; ++b)
#pragma unroll
            for (int m = 0; m < 4; ++m)
#pragma unroll
                for (int n = 0; n < 2; ++n) acc[a][b][m][n] = (f32x4){0.f, 0.f, 0.f, 0.f};
    bf16x8 At[4][2], B0[2][2], B1[2][2];
    const char* cA = (const char*)g.A + (size_t)cur.pm * tstep; const char* cB = (const char*)g.Bt + (size_t)cur.pn * tstep;
    S.a_ready(cur);
    if constexpr (SP2) {
        PG8_STAGE(PG8_SB(0, 0), cB, voffB); PG8_STAGE(PG8_SB(0, 1), cB + hstep, voffB); PG8_STAGE(PG8_SA(0, 0), cA, voffA); PG8_STAGE(PG8_SA(0, 1), cA + hstep, voffA);
        if (wr == 1) PG8_BAR;
        PG8_WAIT_V(2); PG8_BAR;
        PG8_STAGE(PG8_SB(1, 0), cB + kstep, voffB); PG8_STAGE(PG8_SA(1, 0), cA + kstep, voffA); PG8_STAGE(PG8_SB(1, 1), cB + hstep + kstep, voffB);
        PG8_WAIT_V(6); PG8_BAR;
    } else {
        PG8_STAGE(PG8_SB(0, 0), cB, voffB); PG8_STAGE(PG8_SA(0, 0), cA, voffA); PG8_STAGE(PG8_SB(0, 1), cB + hstep, voffB); PG8_STAGE(PG8_SA(0, 1), cA + hstep, voffA);
        if (wr == 1) PG8_BAR;
        PG8_WAIT_V(4); PG8_BAR;
        PG8_STAGE(PG8_SB(1, 0), cB + kstep, voffB); PG8_STAGE(PG8_SA(1, 0), cA + kstep, voffA); PG8_STAGE(PG8_SB(1, 1), cB + hstep + kstep, voffB);
        PG8_WAIT_V(6); PG8_BAR;
    }
    for (;;) {
        const bool has_next = S.next(ui + 1, nxt);
        const char* nA = has_next ? (const char*)g.A + (size_t)nxt.pm * tstep : cA; const char* nB = has_next ? (const char*)g.Bt + (size_t)nxt.pn * tstep : cB;
        for (int t = 0; t < nt; t += 2) {
            const bool last = (t == nt - 2);
            const char* a1 = cA + (size_t)(t + 1) * kstep;
            const char* a2 = last ? nA : cA + (size_t)(t + 2) * kstep; const char* b2 = last ? nB : cB + (size_t)(t + 2) * kstep;
            const char* a3 = a2 + kstep; const char* b3 = b2 + kstep;
            if (last && has_next) S.a_ready(nxt);
            if constexpr (SP2) {
            PG8_LDB(B0, 0, 0); PG8_LDB(B1, 0, 1); PG8_SCHED; PG8_LDA(At, 0, 0); PG8_STAGE(PG8_SA(1, 1), a1 + hstep, voffA);
            PG8_WAIT_V(8); PG8_WAIT_L(0); PG8_BAR; PG8_MMA(0, 0, At, B0); PG8_MMA(0, 1, At, B1); PG8_BAR; PG8_SCHED;
            PG8_LDA(At, 0, 1); PG8_STAGE(PG8_SB(0, 0), b2, voffB); PG8_STAGE(PG8_SB(0, 1), b2 + hstep, voffB); PG8_STAGE(PG8_SA(0, 0), a2, voffA);
            PG8_WAIT_V(8); PG8_WAIT_L(0); PG8_BAR; PG8_MMA(1, 0, At, B0); PG8_MMA(1, 1, At, B1); PG8_BAR; PG8_SCHED;
            PG8_LDB(B0, 1, 0); PG8_LDB(B1, 1, 1); PG8_SCHED; PG8_LDA(At, 1, 0); PG8_STAGE(PG8_SA(0, 1), a2 + hstep, voffA);
            PG8_WAIT_V(8); PG8_WAIT_L(0); PG8_BAR; PG8_MMA(0, 0, At, B0); PG8_MMA(0, 1, At, B1); PG8_BAR; PG8_SCHED;
            PG8_LDA(At, 1, 1); PG8_STAGE(PG8_SB(1, 0), b3, voffB); PG8_STAGE(PG8_SB(1, 1), b3 + hstep, voffB); PG8_STAGE(PG8_SA(1, 0), a3, voffA);
            PG8_WAIT_V(8); PG8_WAIT_L(0); PG8_BAR; PG8_MMA(1, 0, At, B0); PG8_MMA(1, 1, At, B1); PG8_BAR; PG8_SCHED;
            } else {
            PG8_LDB(B0, 0, 0); PG8_SCHED; PG8_LDA(At, 0, 0); PG8_STAGE(PG8_SA(1, 1), a1 + hstep, voffA);
            PG8_WAIT_L(8); PG8_BAR; PG8_WAIT_L(0); PG8_MMA(0, 0, At, B0); PG8_BAR; PG8_SCHED;
            PG8_LDB(B1, 0, 1); PG8_STAGE(PG8_SB(0, 0), b2, voffB);
            PG8_BAR; PG8_WAIT_L(0); PG8_MMA(0, 1, At, B1); PG8_BAR;
            PG8_LDA(At, 0, 1); PG8_STAGE(PG8_SA(0, 0), a2, voffA);
            PG8_BAR; PG8_WAIT_L(0); PG8_MMA(1, 0, At, B0); PG8_BAR; PG8_SCHED;
            PG8_STAGE(PG8_SB(0, 1), b2 + hstep, voffB);
            PG8_WAIT_V(6); PG8_BAR; PG8_MMA(1, 1, At, B1); PG8_BAR;
            PG8_LDB(B0, 1, 0); PG8_SCHED; PG8_LDA(At, 1, 0); PG8_STAGE(PG8_SA(0, 1), a2 + hstep, voffA);
            PG8_WAIT_L(8); PG8_BAR; PG8_WAIT_L(0); PG8_MMA(0, 0, At, B0); PG8_BAR; PG8_SCHED;
            PG8_LDB(B1, 1, 1); PG8_STAGE(PG8_SB(1, 0), b3, voffB);
            PG8_BAR; PG8_WAIT_L(0); PG8_MMA(0, 1, At, B1); PG8_BAR;
            PG8_LDA(At, 1, 1); PG8_STAGE(PG8_SA(1, 0), a3, voffA);
            PG8_BAR; PG8_WAIT_L(0); PG8_MMA(1, 0, At, B0); PG8_BAR; PG8_SCHED;
            PG8_STAGE(PG8_SB(1, 1), b3 + hstep, voffB);
            PG8_WAIT_V(6); PG8_BAR; PG8_MMA(1, 1, At, B1); PG8_BAR;
            }
        }
        if constexpr (ALIGN_EPI) { if (wr == 0) PG8_BAR; }
        if constexpr (!Epi::AFTER_DRAIN) { E(acc, cur, wr, wc, fr, fq); S.done(cur); }
        if (!has_next) break;
#pragma unroll
        for (int a = 0; a < 2; ++a)
#pragma unroll
            for (int b = 0; b < 2; ++b)
#pragma unroll
                for (int m = 0; m < 4; ++m)
#pragma unroll
                    for (int n = 0; n < 2; ++n) acc[a][b][m][n] = (f32x4){0.f, 0.f, 0.f, 0.f};
        cur = nxt; cA = nA; cB = nB; ++ui;
        if constexpr (ALIGN_EPI) { if (wr == 1) PG8_BAR; }
    }
    PG8_WAIT_V(0);
    if constexpr (!ALIGN_EPI) { if (wr == 0) PG8_BAR; }
    PG8_BAR;
    if constexpr (Epi::AFTER_DRAIN) { E.fused(acc, cur, wr, wc, fr, fq, lds, wid, lane); S.done(cur); }
#undef PG8_SA
#undef PG8_SB
#undef PG8_STAGE
#undef PG8_LDA
#undef PG8_LDB
#undef PG8_MMA
#undef PG8_WAIT_V
#undef PG8_WAIT_L
#undef PG8_BAR
#undef PG8_SCHED
}
}
constexpr int NWAVES = 8;
constexpr int BATCH = 8, SEQ = 4096, DM = 1024, TOK = BATCH * SEQ;
constexpr int TOKW = 768, MEMW = 256, MEML = 256, NGRP = 48, NST = 64, GCH = 16, NHEAD = 12, MHEAD = 4, HD = 64, FFN = 2816, NBLK = 16, MBLK = 256;
constexpr float C2 = 0.125f * 1.4426950408889634f;
constexpr float LOG2E = 1.4426950408889634f;

constexpr size_t MiB = 1u << 20;
constexpr size_t WS_CTL = 0, CTL_ZERO_BYTES = 1 * MiB;
constexpr size_t WS_SS0 = 1 * MiB, WS_SSA = 3 * MiB, WS_SSB = 5 * MiB, WS_SSM = 7 * MiB, WS_KMEAN = 8 * MiB;
constexpr size_t WS_WIN0 = 16 * MiB, WS_WGLU = 18 * MiB, WS_WIN1 = 20 * MiB, WS_WOUT0 = 26 * MiB, WS_WOUT1 = 28 * MiB;
constexpr size_t WS_WGU0 = 30 * MiB, WS_WGU1 = 41 * MiB, WS_WDN0 = 52 * MiB, WS_WDN1 = 58 * MiB, WS_WMKV = 64 * MiB;
constexpr size_t WS_MEMB = 65 * MiB, WS_MEMK = 69 * MiB, WS_MEMV = 70 * MiB;
constexpr size_t WS_XB = 72 * MiB;
constexpr size_t WS_R = 136 * MiB;
constexpr size_t WS_U = WS_R, WS_Y = WS_R + 48 * MiB;
constexpr size_t WS_Q1 = WS_R, WS_K1 = WS_R + 48 * MiB, WS_V1 = WS_R + 96 * MiB;
constexpr size_t WS_QM = WS_R + 144 * MiB;
constexpr size_t WS_MIX = WS_R + 160 * MiB;
constexpr size_t WS_H = WS_R;
constexpr size_t WS_END = WS_R + 224 * MiB;
constexpr int CW_BAR = 4096;

constexpr int RING_OFF = 0, RING_BYTES = 131072;
constexpr int LDSCTL_OFF = RING_BYTES, MISC_OFF = LDSCTL_OFF + 320;
constexpr int LDS_BYTES = 147456;

#define GAS __attribute__((address_space(1)))
#define LAS __attribute__((address_space(3)))
typedef unsigned short bf16;
typedef unsigned v4u __attribute__((ext_vector_type(4)));
typedef unsigned v2u __attribute__((ext_vector_type(2)));
typedef float f32x4 __attribute__((ext_vector_type(4)));
typedef GAS unsigned gu32;
#define RLX_AGENT __ATOMIC_RELAXED, __HIP_MEMORY_SCOPE_AGENT
#define LDS_WAIT() asm volatile("s_waitcnt lgkmcnt(0)" ::: "memory")
#define VM_WAIT() asm volatile("s_waitcnt vmcnt(0)" ::: "memory")
__device__ __forceinline__ unsigned f2bf(float f) { unsigned u = __builtin_bit_cast(unsigned, f); return (u + 0x7fffu + ((u >> 16) & 1u)) >> 16; }
__device__ __forceinline__ unsigned pk2(float lo, float hi) { return f2bf(lo) | (f2bf(hi) << 16); }
__device__ __forceinline__ float bf2f(unsigned short h) { return __uint_as_float(((unsigned)h) << 16); }
__device__ __forceinline__ float bflo(unsigned w) { return __uint_as_float(w << 16); }
__device__ __forceinline__ float bfhi(unsigned w) { return __uint_as_float(w & 0xffff0000u); }

#define XB_TMO      128
#define XB_XCNT(j)  (256  + 64 * (j))
#define XB_XSUB(j)  (1280 + 64 * (j))
#define XB_XGEN(j)  (2304 + 64 * (j))
#define XB_TOP      3328
#define XB_TOPGEN   3392
#define XCD_BAR_WORDS 3456
#define XB_SPIN_CAP (1u << 18)

__device__ __forceinline__ unsigned xb_ld(unsigned* p)              { return __hip_atomic_load(p, __ATOMIC_RELAXED, __HIP_MEMORY_SCOPE_AGENT); }
__device__ __forceinline__ unsigned xb_add(unsigned* p, unsigned v) { return __hip_atomic_fetch_add(p, v, __ATOMIC_RELAXED, __HIP_MEMORY_SCOPE_AGENT); }
__device__ __forceinline__ unsigned xb_xcc_id() { return (unsigned)__builtin_amdgcn_s_getreg((3 << 11) | 20) & 0xFu; }
#define XB_SPIN(cond, bar) do { unsigned _sp = 0; while (cond) { __builtin_amdgcn_s_sleep(1); \
    if ((++_sp & 255u) == 0u) { if (xb_ld(&(bar)[XB_TMO])) break; if (_sp > XB_SPIN_CAP) { atomicAdd(&(bar)[XB_TMO], 1u); break; } } } } while (0)

struct XcdBarrier {
    unsigned* bar; unsigned x;
    volatile LAS unsigned* st;
};

__device__ __forceinline__ XcdBarrier xcd_barrier_post(unsigned* bar, volatile LAS unsigned* st) {
    XcdBarrier b; b.bar = bar; b.x = xb_xcc_id(); b.st = st;
    if (threadIdx.x == 0) (void)xb_add(&bar[XB_XCNT(b.x)], 1u);
    return b;
}
__device__ __forceinline__ void xcd_barrier_complete(unsigned* bar, unsigned x, unsigned& nloc, unsigned& nx) {
    const unsigned G = gridDim.x * gridDim.y * gridDim.z;
    unsigned sum, cnt, mine, sp = 0u;
    for (;;) {
        sum = 0u; cnt = 0u; mine = 0u;
#pragma unroll
        for (unsigned j = 0; j < 16; ++j) { const unsigned c = xb_ld(&bar[XB_XCNT(j)]); sum += c; cnt += (c > 0u) ? 1u : 0u; mine = (j == x) ? c : mine; }
        if (sum == G) break;
        __builtin_amdgcn_s_sleep(1);
        if ((++sp & 255u) == 0u) { if (xb_ld(&bar[XB_TMO])) break; if (sp > XB_SPIN_CAP) { atomicAdd(&bar[XB_TMO], 1u); break; } }
    }
    nloc = mine > 0u ? mine : 1u; nx = cnt > 0u ? cnt : 1u;
}

__device__ __forceinline__ void xcd_barrier(const XcdBarrier& b) {
    asm volatile("s_waitcnt vmcnt(0)" ::: "memory");
    __syncthreads();
    if (threadIdx.x == 0) {
        unsigned* bar = b.bar;
        __builtin_amdgcn_s_waitcnt(0);
        unsigned nloc = b.st[0], nx = b.st[1];
        if (nloc == 0u) { xcd_barrier_complete(bar, b.x, nloc, nx); b.st[0] = nloc; b.st[1] = nx; }
        const unsigned old = xb_add(&bar[XB_XSUB(b.x)], 1u);
        const unsigned gen = old / nloc;
        if (old + 1u == (gen + 1u) * nloc) {
            __builtin_amdgcn_fence(__ATOMIC_RELEASE, "agent");
            asm volatile("s_waitcnt vmcnt(0)" ::: "memory");
            const unsigned og = xb_add(&bar[XB_TOP], 1u);
            const unsigned tg = og / nx;
            if (og + 1u == (tg + 1u) * nx) xb_add(&bar[XB_TOPGEN], 1u);
            else XB_SPIN(xb_ld(&bar[XB_TOPGEN]) == tg, bar);
            __builtin_amdgcn_fence(__ATOMIC_ACQUIRE, "agent");
            xb_add(&bar[XB_XGEN(b.x)], 1u);
            asm volatile("s_waitcnt vmcnt(0)" ::: "memory");
        } else {
            XB_SPIN(xb_ld(&bar[XB_XGEN(b.x)]) == gen, bar);
            __builtin_amdgcn_fence(__ATOMIC_ACQUIRE, "agent");
            asm volatile("s_waitcnt vmcnt(0)" ::: "memory");
        }
    }
    __syncthreads();
}
namespace attn_body {
using bf16=__hip_bfloat16;
using bf16x8=__attribute__((ext_vector_type(8)))short;
using s16x4=__attribute__((ext_vector_type(4)))short;
using f32x16=__attribute__((ext_vector_type(16)))float;
using u32x4=__attribute__((ext_vector_type(4)))unsigned;
constexpr int D=64;
constexpr int NW=8,QBLK=32,QB=QBLK*NW,KVBLK=64;
__device__ __forceinline__ int crow(int r,int hi){return (r&3)+8*(r>>2)+4*hi;}
#define SBAR() __builtin_amdgcn_sched_barrier(0)
__device__ __forceinline__ void cmask(f32x16&p0,f32x16&p1,int jb,int qrel,int hi){
  const float NEG=-INFINITY; int kb=64*jb+4*hi;
  #pragma unroll
  for(int r=0;r<16;++r){int kv=kb+(r&3)+8*(r>>2); if(kv>qrel)p0[r]=NEG; if(kv+32>qrel)p1[r]=NEG;}
}

constexpr int NSLOT=3, SLOTB=8192;
constexpr int LDS_K=0, LDS_V=NSLOT*SLOTB, LDS_WS=2*NSLOT*SLOTB, LDS_OST=LDS_WS+NW*64*4, LDS_BYTES=LDS_OST+NW*4096;
__device__ __forceinline__ void glds16(const void*gsrc,unsigned lds_dst){unsigned keep;
  asm volatile("s_mov_b32 %0, m0\n\ts_mov_b32 m0, %2\n\ts_nop 0\n\tglobal_load_lds_dwordx4 %1, off\n\ts_mov_b32 m0, %0":"=&s"(keep):"v"(gsrc),"s"(lds_dst):"memory");}
__device__ __forceinline__ float max3f(float a,float b,float c){float r;asm("v_max3_f32 %0, %1, %2, %3":"=v"(r):"v"(a),"v"(b),"v"(c));return r;}
__device__ __forceinline__ float max2f(float a,float b){float r;asm("v_max_f32_e32 %0, %1, %2":"=v"(r):"v"(a),"v"(b));return r;}
__device__ __forceinline__ float fadd_s(float a,float b){float r;asm("v_add_f32_e32 %0, %1, %2":"=v"(r):"v"(a),"v"(b));return r;}
__device__ __forceinline__ float fsub_s(float a,float b){float r;asm("v_sub_f32_e32 %0, %1, %2":"=v"(r):"v"(a),"v"(b));return r;}
typedef float f32x2_t __attribute__((ext_vector_type(2))); typedef __bf16 bf16x2_t __attribute__((ext_vector_type(2)));
__device__ __forceinline__ unsigned cvtpk_s(float lo,float hi){f32x2_t v={lo,hi};bf16x2_t b=__builtin_convertvector(v,bf16x2_t);return __builtin_bit_cast(unsigned,b);}
#define WAIT_BAR(N) asm volatile("s_waitcnt vmcnt(" #N ") lgkmcnt(0)\n\ts_barrier":::"memory")

__device__ __forceinline__ void qkt(f32x16&p0,f32x16&p1,const char*Kslot,const bf16x8*qr,int r32,int hi){
  const char*kb=Kslot+hi*1024+r32*16;
  #pragma unroll
  for(int d0=0;d0<4;++d0){
    const bf16x8 b0=*reinterpret_cast<const bf16x8*>(kb+d0*2048);
    const bf16x8 b1=*reinterpret_cast<const bf16x8*>(kb+d0*2048+512);
    p0=__builtin_amdgcn_mfma_f32_32x32x16_bf16(b0,qr[d0],p0,0,0,0);p1=__builtin_amdgcn_mfma_f32_32x32x16_bf16(b1,qr[d0],p1,0,0,0);}
}
typedef __attribute__((address_space(3))) const char* lds_cptr;
typedef short v4i16_t __attribute__((ext_vector_type(4)));
__device__ __forceinline__ void kload8(bf16x8*kf,lds_cptr kp){
  kf[0]=*(const __attribute__((address_space(3))) bf16x8*)(kp);      kf[1]=*(const __attribute__((address_space(3))) bf16x8*)(kp+512);
  kf[2]=*(const __attribute__((address_space(3))) bf16x8*)(kp+2048); kf[3]=*(const __attribute__((address_space(3))) bf16x8*)(kp+2560);
  kf[4]=*(const __attribute__((address_space(3))) bf16x8*)(kp+4096); kf[5]=*(const __attribute__((address_space(3))) bf16x8*)(kp+4608);
  kf[6]=*(const __attribute__((address_space(3))) bf16x8*)(kp+6144); kf[7]=*(const __attribute__((address_space(3))) bf16x8*)(kp+6656);
}
__device__ __forceinline__ void kload2(bf16x8*kf,lds_cptr kp,int j){ kf[2*j]=*(const __attribute__((address_space(3))) bf16x8*)(kp+j*2048); kf[2*j+1]=*(const __attribute__((address_space(3))) bf16x8*)(kp+j*2048+512); }
__device__ __forceinline__ s16x4 vtr(lds_cptr p){ return __builtin_bit_cast(s16x4,__builtin_amdgcn_ds_read_tr16_b64_v4i16((__attribute__((address_space(3))) v4i16_t*)p)); }
__device__ __forceinline__ float rowmax(const f32x16&p0,const f32x16&p1){
  float a=max3f(p0[0],p0[1],p1[0]),b=max3f(p0[2],p0[3],p1[1]);a=max3f(a,p1[2],p1[3]);
  #pragma unroll
  for(int r=4;r<16;r+=4){a=max3f(a,p0[r],p0[r+1]);b=max3f(b,p0[r+2],p0[r+3]);a=max3f(a,p1[r],p1[r+1]);b=max3f(b,p1[r+2],p1[r+3]);}
  const float m=max2f(a,b);
  auto rr=__builtin_amdgcn_permlane32_swap(__float_as_uint(m),__float_as_uint(m),false,false);
  return max2f(__uint_as_float(rr[0]),__uint_as_float(rr[1]));
}
__device__ __forceinline__ void pv(f32x16*o,int vb,bf16x8 pa0,bf16x8 pa1,bf16x8 pa2,bf16x8 pa3){
  #pragma unroll
  for(int d0=0;d0<2;++d0){s16x4 lo[4],hi[4];
    #pragma unroll
    for(int ks=0;ks<4;++ks){
      asm volatile("ds_read_b64_tr_b16 %0,%1 offset:%c2":"=&v"(lo[ks]):"v"(vb),"i"(d0*4096+ks*1024):"memory");
      asm volatile("ds_read_b64_tr_b16 %0,%1 offset:%c2":"=&v"(hi[ks]):"v"(vb),"i"(d0*4096+ks*1024+512):"memory");}
    asm volatile("s_waitcnt lgkmcnt(0)":::"memory");SBAR();
    #define PK(k) (bf16x8){lo[k][0],lo[k][1],lo[k][2],lo[k][3],hi[k][0],hi[k][1],hi[k][2],hi[k][3]}
    o[d0]=__builtin_amdgcn_mfma_f32_32x32x16_bf16(pa0,PK(0),o[d0],0,0,0);
    o[d0]=__builtin_amdgcn_mfma_f32_32x32x16_bf16(pa1,PK(1),o[d0],0,0,0);
    o[d0]=__builtin_amdgcn_mfma_f32_32x32x16_bf16(pa2,PK(2),o[d0],0,0,0);
    o[d0]=__builtin_amdgcn_mfma_f32_32x32x16_bf16(pa3,PK(3),o[d0],0,0,0);
    #undef PK
  }
}

#ifndef ATTN_STORE16
#define ATTN_STORE16(p,v) (*(u32x4*)(p)=(v))
#endif
template<int MODE,int THRL,int QP,int KP,int OP> __device__ __forceinline__ void attn_unit(const bf16*Qw0,const bf16*__restrict__ Kh,const bf16*__restrict__ Vh,bf16*Ow0,const int NT,
                                                                                          const float slope2,const bf16*kmh,const bf16*kml,const int qb,char*shm){
  int tid_=threadIdx.x; asm volatile("":"+v"(tid_));
  const int tid=tid_,lane=tid&63,r32=lane&31,hi=lane>>5; const int wid=__builtin_amdgcn_readfirstlane(tid>>6);
  const bf16*Qw=Qw0+(long)(wid*QBLK)*QP;
  const unsigned lds0=(unsigned)(uintptr_t)shm;
  float*wsf=(float*)(shm+LDS_WS)+wid*64;
  const bf16*ksrc=Kh+(long)lane*KP+wid*8;
  const bf16*vsrc=Vh+(long)(16*(wid&3)+(lane>>2))*KP+(wid>>2)*32+(lane&3)*8;
  const unsigned kdst=lds0+LDS_K+wid*1024, vdst=lds0+LDS_V+wid*1024;
  #define DMA_K(t,slot) glds16(ksrc+(long)(t)*KVBLK*KP,(unsigned)__builtin_amdgcn_readfirstlane(kdst+(slot)))
  #define DMA_V(t,slot) glds16(vsrc+(long)(t)*KVBLK*KP,(unsigned)__builtin_amdgcn_readfirstlane(vdst+(slot)))
  const int vb0=(int)(lds0+LDS_V)+((lane>>4)&1)*32+(lane&3)*8+(4*hi+((lane&15)>>2))*64;
  const char*Kbase=shm+LDS_K; bf16x8 kf[8];
  const lds_cptr shm3=(lds_cptr)shm; const lds_cptr kp0=shm3+LDS_K+hi*1024+r32*16; const lds_cptr vp0=shm3+LDS_V+((lane>>4)&1)*32+(lane&3)*8+(4*hi+((lane&15)>>2))*64;
  DMA_K(0,0);DMA_V(0,0);DMA_K(1,SLOTB);
  bf16x8 qr[4];
  #pragma unroll
  for(int d0=0;d0<4;++d0)qr[d0]=*reinterpret_cast<const bf16x8*>(&Qw[(long)r32*QP+d0*16+hi*8]);
  unsigned selm=0xffffffffu;
  if constexpr(MODE==1){
    f32x16 G=f32x16{};
    #pragma unroll
    for(int d0=0;d0<4;++d0){
      bf16x8 ah=bf16x8{},al=bf16x8{};
      if(r32<16){ ah=*reinterpret_cast<const bf16x8*>(&kmh[r32*64+d0*16+hi*8]); al=*reinterpret_cast<const bf16x8*>(&kml[r32*64+d0*16+hi*8]); }
      G=__builtin_amdgcn_mfma_f32_32x32x16_bf16(ah,qr[d0],G,0,0,0); G=__builtin_amdgcn_mfma_f32_32x32x16_bf16(al,qr[d0],G,0,0,0);}
    float g[16];
    #pragma unroll
    for(int r=0;r<4;++r){ const float a=G[r],b=G[4+r]; const float oa=__shfl_xor(a,32),ob=__shfl_xor(b,32);
      g[r]=hi?oa:a; g[4+r]=hi?a:oa; g[8+r]=hi?ob:b; g[12+r]=hi?b:ob; }
    #pragma unroll
    for(int n=0;n<16;++n) if(n>=qb) g[n]=-1.0e30f;
    const int nsel=qb<3?qb:3; unsigned mask=0u;
    #pragma unroll
    for(int rr=0;rr<3;++rr){ float best=-3.0e38f; int bi=0;
      #pragma unroll
      for(int n=0;n<16;++n){ const bool c=!((mask>>n)&1u)&&g[n]>best; best=c?g[n]:best; bi=c?n:bi; }
      if(rr<nsel) mask|=1u<<bi; }
    selm=mask|(1u<<qb);
  }
  float mhat=0.f,l_reg=0.f;f32x16 o[2];o[0]=f32x16{};o[1]=f32x16{};
  const int qrel=wid*QBLK+r32;
  const float hb=(MODE==1)?slope2*(float)(4*hi):0.f, s32=(MODE==1)?32.f*slope2:0.f, s64=(MODE==1)?64.f*slope2:0.f;
  #define CINIT(C0,C1,t) do{ float b0_=fsub_s(fadd_s(s64*(float)(t),hb),mhat); if(MODE==1){ if(!((selm>>((t)>>2))&1u)) b0_=-3.0e38f; } const float b1_=b0_+s32; \
    _Pragma("unroll") for(int r=0;r<16;++r){ if(MODE==1){ C0[r]=__builtin_fmaf(slope2,(float)((r&3)+8*(r>>2)),b0_); C1[r]=__builtin_fmaf(slope2,(float)((r&3)+8*(r>>2)),b1_); } else { C0[r]=b0_; C1[r]=b1_; } } }while(0)
  #define CMASK(P0,P1,t) do{ if(MODE==1){ int jb_=(t)-(NT-4); if(jb_>=0)cmask(P0,P1,jb_,qrel,hi);} }while(0)
  bool resc=false;
  #define START(P0,P1) do{ const float rm=rowmax(P0,P1); resc=false; \
    { const float dl=__builtin_fmaxf(rm,-1000.f); mhat=fadd_s(mhat,dl); \
      _Pragma("unroll") for(int r=0;r<16;++r){P0[r]=fsub_s(P0[r],dl);P1[r]=fsub_s(P1[r],dl);} } \
    _Pragma("unroll") for(int r=0;r<16;++r)P0[r]=__builtin_amdgcn_exp2f(P0[r]); }while(0)
  #define RESC() do{ if(resc){ asm volatile("s_waitcnt lgkmcnt(0)":::"memory"); \
      _Pragma("unroll") for(int d_=0;d_<2;++d_) _Pragma("unroll") for(int r=0;r<16;++r)o[d_][r]*=wsf[crow(r,hi)]; } }while(0)
  f32x16 pA0,pA1,pB0,pB1;
  int sl_prev=0,sl_cur=0,sl_next=SLOTB;
  #define ROT() do{sl_prev=sl_cur;sl_cur=sl_next;sl_next=(sl_next==(NSLOT-1)*SLOTB)?0:sl_next+SLOTB;}while(0)
  DMA_K(2,2*SLOTB);
  WAIT_BAR(3);
  CINIT(pA0,pA1,0);
  qkt(pA0,pA1,Kbase,qr,r32,hi);asm volatile("s_nop 15\n\ts_nop 7":"+v"(pA0),"+v"(pA1));CMASK(pA0,pA1,0);
  START(pA0,pA1);
  _Pragma("unroll") for(int r=0;r<16;++r)pA1[r]=__builtin_amdgcn_exp2f(pA1[r]);
  WAIT_BAR(0);
  DMA_K(3,0);DMA_V(1,SLOTB);
  ROT();
  kload8(kf,kp0+sl_cur);
  WAIT_BAR(2);
  s16x4 vlo[8],vhi[8]; u32x4 pw0,pw1,pw2,pw3;
  #define PKW(P,B) cvtpk_s(P[B],P[B+1])
  #define PAF(k) __builtin_bit_cast(bf16x8,pw##k)
  #define VFR(i) (bf16x8){vlo[i][0],vlo[i][1],vlo[i][2],vlo[i][3],vhi[i][0],vhi[i][1],vhi[i][2],vhi[i][3]}
  #define PIN(x) asm volatile("":"+v"(x))
  #define MX3(a,b,c) __builtin_fmaxf(__builtin_fmaxf((a),(b)),(c))
  #define GAPA(MF,A0,A1,A2,A3,W0,W1,PW) do{ MF; sacc+=A0; sacc+=A1; sacc+=A2; sacc+=A3; PIN(sacc); W0; W1; PIN(PW); SBAR(); }while(0)
  #define EX(v) __builtin_amdgcn_exp2f(v)
  #define GAPB(MF,X,B) do{ MF; X[B]=EX(X[B]); X[B+1]=EX(X[B+1]); X[B+2]=EX(X[B+2]); X[B+3]=EX(X[B+3]); PIN(X); SBAR(); }while(0)
  #define VRD(i) do{ vlo[i]=vtr(vp_+(((i)>>2)*4096+((i)&3)*1024)); vhi[i]=vtr(vp_+(((i)>>2)*4096+((i)&3)*1024+512)); }while(0)
  #define KRD(G,j) do{ if(G){ kload2(kf,kp0+sl_next,j); SBAR(); } }while(0)
  #define STEP(C0,C1,P0,P1,t,GK,GV,GL) do{ CINIT(C0,C1,t); PIN(C0); PIN(C1); SBAR(); \
    const lds_cptr vp_=vp0+sl_prev; \
    VRD(0); SBAR(); float sacc=(P0[0]+P0[1]); \
    GAPA(C0=__builtin_amdgcn_mfma_f32_32x32x16_bf16(kf[0],qr[0],C0,0,0,0), P0[2],P0[3],P0[4],P0[5],     pw0[0]=PKW(P0,0), pw0[1]=PKW(P0,2), pw0); \
    VRD(4); SBAR(); GAPA(C1=__builtin_amdgcn_mfma_f32_32x32x16_bf16(kf[1],qr[0],C1,0,0,0), P0[6],P0[7],P0[8],P0[9],     pw0[2]=PKW(P0,4), pw0[3]=PKW(P0,6), pw0); \
    VRD(1); SBAR(); GAPA(C0=__builtin_amdgcn_mfma_f32_32x32x16_bf16(kf[2],qr[1],C0,0,0,0),   P0[10],P0[11],P0[12],P0[13], pw1[0]=PKW(P0,8), pw1[1]=PKW(P0,10), pw1); \
    VRD(5); SBAR(); GAPA(C1=__builtin_amdgcn_mfma_f32_32x32x16_bf16(kf[3],qr[1],C1,0,0,0),   P0[14],P0[15],P1[0],P1[1],   pw1[2]=PKW(P0,12),pw1[3]=PKW(P0,14), pw1); \
    VRD(2); SBAR(); GAPA(C0=__builtin_amdgcn_mfma_f32_32x32x16_bf16(kf[4],qr[2],C0,0,0,0),   P1[2],P1[3],P1[4],P1[5],     pw2[0]=PKW(P1,0), pw2[1]=PKW(P1,2), pw2); \
    VRD(6); SBAR(); GAPA(C1=__builtin_amdgcn_mfma_f32_32x32x16_bf16(kf[5],qr[2],C1,0,0,0),   P1[6],P1[7],P1[8],P1[9],     pw2[2]=PKW(P1,4), pw2[3]=PKW(P1,6), pw2); \
    VRD(3); SBAR(); GAPA(C0=__builtin_amdgcn_mfma_f32_32x32x16_bf16(kf[6],qr[3],C0,0,0,0),   P1[10],P1[11],P1[12],P1[13], pw3[0]=PKW(P1,8), pw3[1]=PKW(P1,10), pw3); \
    VRD(7); SBAR(); GAPA(C1=__builtin_amdgcn_mfma_f32_32x32x16_bf16(kf[7],qr[3],C1,0,0,0),   P1[14],P1[15],0.f,0.f,       pw3[2]=PKW(P1,12),pw3[3]=PKW(P1,14), pw3); \
    l_reg+=sacc; \
    if(GK){DMA_K((t)+3,sl_cur);} if(GV){DMA_V((t)+1,sl_next);} \
    CMASKX(C0,C1,t); \
    { float a=MX3(C0[0],C0[1],C1[0]),b=MX3(C0[2],C0[3],C1[1]); a=MX3(a,C1[2],C1[3]); \
      _Pragma("unroll") for(int r=4;r<16;r+=4){a=MX3(a,C0[r],C0[r+1]);b=MX3(b,C0[r+2],C0[r+3]);a=MX3(a,C1[r],C1[r+1]);b=MX3(b,C1[r+2],C1[r+3]);} \
      float rm=__builtin_fmaxf(a,b); { auto rr=__builtin_amdgcn_permlane32_swap(__float_as_uint(rm),__float_as_uint(rm),false,false); rm=__builtin_fmaxf(__uint_as_float(rr[0]),__uint_as_float(rr[1])); } \
      resc=false; \
      if(__builtin_expect(__any(rm>(float)THRL),0)){ const float dl=__builtin_fmaxf(rm,0.f); mhat+=dl; \
        _Pragma("unroll") for(int r=0;r<16;++r){C0[r]-=dl;C1[r]-=dl;} \
        const float f=__builtin_amdgcn_exp2f(-dl); l_reg*=f; if(hi==0)wsf[r32]=f; resc=true; } } \
    SBAR(); \
    GAPB(o[0]=__builtin_amdgcn_mfma_f32_32x32x16_bf16(PAF(0),VFR(0),o[0],0,0,0), C0,0); \
    GAPB(o[1]=__builtin_amdgcn_mfma_f32_32x32x16_bf16(PAF(0),VFR(4),o[1],0,0,0), C0,4); \
    KRD(GL,0); GAPB(o[0]=__builtin_amdgcn_mfma_f32_32x32x16_bf16(PAF(1),VFR(1),o[0],0,0,0), C0,8); \
    KRD(GL,1); GAPB(o[1]=__builtin_amdgcn_mfma_f32_32x32x16_bf16(PAF(1),VFR(5),o[1],0,0,0), C0,12); \
    KRD(GL,2); GAPB(o[0]=__builtin_amdgcn_mfma_f32_32x32x16_bf16(PAF(2),VFR(2),o[0],0,0,0), C1,0); \
    KRD(GL,3); GAPB(o[1]=__builtin_amdgcn_mfma_f32_32x32x16_bf16(PAF(2),VFR(6),o[1],0,0,0), C1,4); \
    GAPB(o[0]=__builtin_amdgcn_mfma_f32_32x32x16_bf16(PAF(3),VFR(3),o[0],0,0,0), C1,8); \
    GAPB(o[1]=__builtin_amdgcn_mfma_f32_32x32x16_bf16(PAF(3),VFR(7),o[1],0,0,0), C1,12); \
    }while(0)
  int t=1;
  #define CMASKX(P0,P1,t) do{}while(0)
  for(;t+5<NT;t+=2){
    STEP(pB0,pB1,pA0,pA1,t,true,true,true);     WAIT_BAR(2); RESC(); ROT();
    STEP(pA0,pA1,pB0,pB1,t+1,true,true,true);   WAIT_BAR(2); RESC(); ROT();
  }
  #undef CMASKX
  #define CMASKX(P0,P1,t) CMASK(P0,P1,t)
  #define ENDW(tt) do{ if((tt)+3<NT){WAIT_BAR(2);} else if((tt)+2<NT){WAIT_BAR(1);} else {WAIT_BAR(0);} }while(0)
  for(;t+1<NT;t+=2){
    STEP(pB0,pB1,pA0,pA1,t,(t+3<NT),(t+1<NT),(t+1<NT));       ENDW(t);   RESC(); ROT();
    STEP(pA0,pA1,pB0,pB1,t+1,(t+4<NT),(t+2<NT),(t+2<NT));     ENDW(t+1); RESC(); ROT();
  }
  STEP(pB0,pB1,pA0,pA1,NT-1,false,false,false); RESC();
  { float sacc=pB0[0]+pB0[1]; _Pragma("unroll") for(int r=2;r<16;++r)sacc+=pB0[r]; _Pragma("unroll") for(int r=0;r<16;++r)sacc+=pB1[r]; l_reg+=sacc;
    pw0=(u32x4){PKW(pB0,0),PKW(pB0,2),PKW(pB0,4),PKW(pB0,6)};pw1=(u32x4){PKW(pB0,8),PKW(pB0,10),PKW(pB0,12),PKW(pB0,14)};pw2=(u32x4){PKW(pB1,0),PKW(pB1,2),PKW(pB1,4),PKW(pB1,6)};pw3=(u32x4){PKW(pB1,8),PKW(pB1,10),PKW(pB1,12),PKW(pB1,14)};
    SBAR(); pv(o,vb0+sl_cur,PAF(0),PAF(1),PAF(2),PAF(3)); }
  #undef PKW
  #undef PAF
  #undef VFR
  #undef PIN
  #undef MX3
  #undef GAPA
  #undef GAPB
  #undef EX
  #undef VRD
  #undef KRD
  #undef STEP
  #undef ENDW
  #undef CMASKX
  {auto rr=__builtin_amdgcn_permlane32_swap(__float_as_uint(l_reg),__float_as_uint(l_reg),false,false);l_reg=__uint_as_float(rr[0])+__uint_as_float(rr[1]);}
  if(hi==0)wsf[32+r32]=l_reg;asm volatile("s_waitcnt lgkmcnt(0)":::"memory");
  float rli[16];
  #pragma unroll
  for(int r=0;r<16;++r)rli[r]=__builtin_amdgcn_rcpf(wsf[32+crow(r,hi)]);
  bf16*Ow=Ow0+(long)(wid*QBLK)*OP;
  { bf16*stg=(bf16*)(shm+LDS_OST)+wid*2048;
    #pragma unroll
    for(int r=0;r<16;++r){const int orow=crow(r,hi);
      #pragma unroll
      for(int d0=0;d0<2;++d0)stg[orow*64+d0*32+r32]=__float2bfloat16(o[d0][r]*rli[r]);}
    asm volatile("s_waitcnt lgkmcnt(0)":::"memory");
    #pragma unroll
    for(int i=0;i<4;++i){const int row=i*8+(lane>>3),ch=lane&7; const u32x4 v=*(const u32x4*)(stg+row*64+ch*8); ATTN_STORE16(Ow+(long)row*OP+ch*8,v);} }
  asm volatile("s_waitcnt lgkmcnt(0)\n\ts_barrier":::"memory");
  #undef DMA_K
  #undef DMA_V
  #undef CMASK
  #undef CINIT
  #undef START
  #undef RESC
  #undef ROT
}
constexpr int ATTN_LDS_BYTES=LDS_BYTES;
#undef SBAR
#undef WAIT_BAR
}
__device__ __forceinline__ float wave_sum(float v) {
#pragma unroll
    for (int o = 1; o < 64; o <<= 1) v += __shfl_xor(v, o);
    return v;
}
__device__ __forceinline__ float wave_max(float v) {
#pragma unroll
    for (int o = 1; o < 64; o <<= 1) v = fmaxf(v, __shfl_xor(v, o));
    return v;
}
__device__ __forceinline__ int opaque_zero() { int z; asm volatile("v_mov_b32 %0, 0" : "=v"(z)); return z; }

__device__ __forceinline__ void p0_transpose_item(const float* W, int K, int N, bf16* WT, int dest_row0, int k0, int n0, const float* gk, LAS float* scr, int lane) {
#pragma unroll 8
    for (int i = 0; i < 32; ++i) { const int kk = 2 * i + (lane >> 5); float v = W[(size_t)(k0 + kk) * N + n0 + (lane & 31)]; if (gk) v *= gk[k0 + kk]; scr[kk * 33 + (lane & 31)] = v; }
    LDS_WAIT(); asm volatile("" ::: "memory");
    const int c = lane & 7;
#pragma unroll
    for (int j = 0; j < 4; ++j) { const int n = (lane >> 3) + 8 * j; const LAS float* s = scr + (8 * c) * 33 + n;
        v4u o; o.x = pk2(s[0 * 33], s[1 * 33]); o.y = pk2(s[2 * 33], s[3 * 33]); o.z = pk2(s[4 * 33], s[5 * 33]); o.w = pk2(s[6 * 33], s[7 * 33]);
        *(GAS v4u*)(WT + (size_t)(dest_row0 + n) * K + k0 + 8 * c) = o; }
    LDS_WAIT(); asm volatile("" ::: "memory");
}
__device__ __forceinline__ void p0_matrix_item(const float* W, int K, int N, bf16* WT, const float* gk, int mode, int item, LAS float* scr, int lane) {
    const int nblk = N / 32, kb = item / nblk, nb = item - kb * nblk, k0 = 64 * kb, n0 = 32 * nb;
    const int dr = (mode == 0) ? n0 : (256 * (n0 >> 7) + (n0 & 127) + (mode == 2 ? 128 : 0));
    p0_transpose_item(W, K, N, WT, dr, k0, n0, gk, scr, lane);
}
__device__ __forceinline__ void row_to_bf16_ssq(const float* xrow, bf16* orow, float* ssq16, int lane) {
    const GAS f32x4* xr = (const GAS f32x4*)xrow + lane;
    f32x4 v[4]; float s = 0.f;
#pragma unroll
    for (int j = 0; j < 4; ++j) { v[j] = xr[64 * j]; s += (v[j].x * v[j].x + v[j].y * v[j].y) + (v[j].z * v[j].z + v[j].w * v[j].w); }
    s = wave_sum(s);
    GAS unsigned long long* o8 = (GAS unsigned long long*)orow + lane;
#pragma unroll
    for (int j = 0; j < 4; ++j) o8[64 * j] = (unsigned long long)pk2(v[j].x, v[j].y) | ((unsigned long long)pk2(v[j].z, v[j].w) << 32);
    if (lane < 16) ssq16[lane] = (lane == 0) ? s : 0.f;
}

__device__ __forceinline__ void s5_naive_unit(int b, int g, const bf16* U, bf16* Y, const float* lam_re, const float* lam_im, const float* log_dt, const float* b_re, const float* b_im,
                                              const float* c_re, const float* c_im, const float* dvec, int lane) {
    const int p = lane;
    const float lr = lam_re[g * 64 + p], li = lam_im[g * 64 + p], dt = expf(log_dt[g]);
    const float mag = expf(lr * dt), ar = mag * cosf(li * dt), ai = mag * sinf(li * dt);
    const float den = lr * lr + li * li, nr = ar - 1.0f, fr = (nr * lr + ai * li) / den, fi = (ai * lr - nr * li) / den;
    float bbr[16], bbi[16], cr[16], ci[16];
#pragma unroll
    for (int c = 0; c < 16; ++c) { const float br = b_re[((size_t)g * 64 + p) * 16 + c], bi = b_im[((size_t)g * 64 + p) * 16 + c]; bbr[c] = fr * br - fi * bi; bbi[c] = fr * bi + fi * br;
        cr[c] = c_re[((size_t)g * 16 + c) * 64 + p]; ci[c] = c_im[((size_t)g * 16 + c) * 64 + p]; }
    const int ch = ((lane & 1) << 3) | ((lane & 2) << 1) | ((lane & 4) >> 1) | ((lane & 8) >> 3);
    const float dch = dvec[16 * g + ch];
    const int z0 = opaque_zero();
    const bf16* up = U + (size_t)b * SEQ * TOKW + 16 * g + z0;
    bf16* yp = Y + (size_t)b * SEQ * TOKW + 16 * g + ch;
    float xr = 0.f, xi = 0.f;
#pragma unroll 2
    for (int s = 0; s < SEQ; ++s) {
        const v4u w0 = *(const GAS v4u*)(up + (size_t)s * TOKW), w1 = *(const GAS v4u*)(up + (size_t)s * TOKW + 8);
        const float uch = bf2f(up[(size_t)s * TOKW + ch]);
        const float uu[16] = {bflo(w0.x), bfhi(w0.x), bflo(w0.y), bfhi(w0.y), bflo(w0.z), bfhi(w0.z), bflo(w0.w), bfhi(w0.w), bflo(w1.x), bfhi(w1.x), bflo(w1.y), bfhi(w1.y), bflo(w1.z), bfhi(w1.z), bflo(w1.w), bfhi(w1.w)};
        float bur = 0.f, bui = 0.f;
#pragma unroll
        for (int c = 0; c < 16; ++c) { bur += bbr[c] * uu[c]; bui += bbi[c] * uu[c]; }
        const float nxr = ar * xr - ai * xi + bur, nxi = ar * xi + ai * xr + bui; xr = nxr; xi = nxi;
        float v[16];
#pragma unroll
        for (int c = 0; c < 16; ++c) v[c] = cr[c] * xr - ci[c] * xi;
        float w[8], x4[4], x2[2], z;
        { const bool bit = lane & 1;
#pragma unroll
          for (int j = 0; j < 8; ++j) { const float send = bit ? v[j] : v[j + 8], keep = bit ? v[j + 8] : v[j]; w[j] = keep + __shfl_xor(send, 1); } }
        { const bool bit = lane & 2;
#pragma unroll
          for (int j = 0; j < 4; ++j) { const float send = bit ? w[j] : w[j + 4], keep = bit ? w[j + 4] : w[j]; x4[j] = keep + __shfl_xor(send, 2); } }
        { const bool bit = lane & 4;
#pragma unroll
          for (int j = 0; j < 2; ++j) { const float send = bit ? x4[j] : x4[j + 2], keep = bit ? x4[j + 2] : x4[j]; x2[j] = keep + __shfl_xor(send, 4); } }
        { const bool bit = lane & 8; const float send = bit ? x2[0] : x2[1], keep = bit ? x2[1] : x2[0]; z = keep + __shfl_xor(send, 8); }
        z += __shfl_xor(z, 16); z += __shfl_xor(z, 32);
        const float yv = z + dch * uch;
        const float ge = 0.5f * yv * (1.0f + erff(yv * 0.70710678118654752f));
        if (lane < 16) yp[(size_t)s * TOKW] = (bf16)f2bf(ge);
    }
}

__device__ __forceinline__ void memattn_naive_unit(int tok, int h, const bf16* QM, const bf16* memk, const bf16* memv, bf16* mix, LAS float* ps, int lane) {
    const int b = tok >> 12; const int z0 = opaque_zero();
    const float qv = bf2f(QM[(size_t)tok * 256 + h * 64 + lane]);
    float q[64];
#pragma unroll
    for (int d = 0; d < 64; ++d) q[d] = __shfl(qv, d);
    float sc[4];
#pragma unroll
    for (int i = 0; i < 4; ++i) { const int j = lane + 64 * i; const GAS v4u* kr = (const GAS v4u*)(memk + ((size_t)(b * 256 + j)) * 256 + h * 64 + z0); float a = 0.f;
#pragma unroll
        for (int c = 0; c < 8; ++c) { const v4u w = kr[c]; a += q[8 * c] * bflo(w.x) + q[8 * c + 1] * bfhi(w.x) + q[8 * c + 2] * bflo(w.y) + q[8 * c + 3] * bfhi(w.y) + q[8 * c + 4] * bflo(w.z) + q[8 * c + 5] * bfhi(w.z) + q[8 * c + 6] * bflo(w.w) + q[8 * c + 7] * bfhi(w.w); }
        sc[i] = a; }
    const float m = wave_max(fmaxf(fmaxf(sc[0], sc[1]), fmaxf(sc[2], sc[3])));
    float l = 0.f;
#pragma unroll
    for (int i = 0; i < 4; ++i) { const float pe = __builtin_amdgcn_exp2f(sc[i] - m); l += pe; ps[lane + 64 * i] = pe; }
    l = wave_sum(l);
    LDS_WAIT(); asm volatile("" ::: "memory");
    float o = 0.f; const bf16* vp = memv + (size_t)(b * 256) * 256 + h * 64 + lane;
#pragma unroll 8
    for (int j = 0; j < 256; ++j) o += ps[j] * bf2f(vp[(size_t)j * 256]);
    mix[(size_t)tok * 1024 + 768 + h * 64 + lane] = (bf16)f2bf(o / l);
    LDS_WAIT(); asm volatile("" ::: "memory");
}

__device__ __forceinline__ float dot64_bf16(const float (&q)[64], const GAS v4u* kr) {
    float a = 0.f;
#pragma unroll
    for (int c = 0; c < 8; ++c) { const v4u w = kr[c]; a += q[8 * c] * bflo(w.x) + q[8 * c + 1] * bfhi(w.x) + q[8 * c + 2] * bflo(w.y) + q[8 * c + 3] * bfhi(w.y) + q[8 * c + 4] * bflo(w.z) + q[8 * c + 5] * bfhi(w.z) + q[8 * c + 6] * bflo(w.w) + q[8 * c + 7] * bfhi(w.w); }
    return a;
}
__device__ __forceinline__ void moba_naive_unit(int tok, int h, const bf16* Q1, const bf16* K1, const bf16* V1, const float* KMEAN, bf16* mix, LAS float* ps, int lane) {
    const int b = tok >> 12, s = tok & (SEQ - 1), qb = s >> 8; const int z0 = opaque_zero();
    const float qv = bf2f(Q1[(size_t)tok * TOKW + h * 64 + lane]);
    float q[64];
#pragma unroll
    for (int d = 0; d < 64; ++d) q[d] = __shfl(qv, d);
    float gate = -1e30f;
    { const int n = lane & 15; const GAS f32x4* km = (const GAS f32x4*)(KMEAN + ((size_t)((b * NHEAD + h) * NBLK + n)) * 64 + z0); float a = 0.f;
#pragma unroll
      for (int c = 0; c < 16; ++c) { const f32x4 w = km[c]; a += q[4 * c] * w.x + q[4 * c + 1] * w.y + q[4 * c + 2] * w.z + q[4 * c + 3] * w.w; }
      if (n < qb) gate = a; }
    float g[16];
#pragma unroll
    for (int n = 0; n < 16; ++n) g[n] = __shfl(gate, n);
    const int nsel = qb < 3 ? qb : 3;
    unsigned mask = 0u;
#pragma unroll
    for (int r = 0; r < 3; ++r) { float best = -3.0e38f; int bi = 0;
#pragma unroll
        for (int n = 0; n < 16; ++n) { const bool c = !((mask >> n) & 1u) && g[n] > best; best = c ? g[n] : best; bi = c ? n : bi; }
        if (r < nsel) mask |= 1u << bi; }
    int blk0 = 0, blk1 = 0, blk2 = 0, cnt = 0;
#pragma unroll
    for (int n = 0; n < 16; ++n) if ((mask >> n) & 1u) { if (cnt == 0) blk0 = n; else if (cnt == 1) blk1 = n; else blk2 = n; ++cnt; }
    const int nslots = nsel + 1;
    const float slope = __builtin_amdgcn_exp2f(-8.0f * (float)(h + 1) / 12.0f) * LOG2E;
    const bf16* kh = K1 + (size_t)b * SEQ * TOKW + h * 64 + z0;
    float mx = -3.0e38f;
#pragma unroll
    for (int sl = 0; sl < 4; ++sl) if (sl < nslots) {
        const int blk = (sl == nsel) ? qb : (sl == 0 ? blk0 : (sl == 1 ? blk1 : blk2));
#pragma unroll
        for (int i = 0; i < 4; ++i) { const int j = lane + 64 * i, pos = blk * 256 + j;
            float a = dot64_bf16(q, (const GAS v4u*)(kh + (size_t)pos * TOKW)) + slope * (float)(pos - s);
            if (pos > s) a = -3.0e38f;
            ps[sl * 256 + j] = a; mx = fmaxf(mx, a); } }
    mx = wave_max(mx);
    LDS_WAIT(); asm volatile("" ::: "memory");
    float l = 0.f;
#pragma unroll
    for (int sl = 0; sl < 4; ++sl) if (sl < nslots) {
#pragma unroll
        for (int i = 0; i < 4; ++i) { const int j = lane + 64 * i; const float a = ps[sl * 256 + j]; const float pe = (a < -1.0e37f) ? 0.f : __builtin_amdgcn_exp2f(a - mx); l += pe; ps[sl * 256 + j] = pe; } }
    l = wave_sum(l);
    LDS_WAIT(); asm volatile("" ::: "memory");
    float o = 0.f; const bf16* vh = V1 + (size_t)b * SEQ * TOKW + h * 64 + lane;
#pragma unroll
    for (int sl = 0; sl < 4; ++sl) if (sl < nslots) {
        const int blk = (sl == nsel) ? qb : (sl == 0 ? blk0 : (sl == 1 ? blk1 : blk2));
        const bf16* vp = vh + (size_t)(blk * 256) * TOKW;
#pragma unroll 8
        for (int j = 0; j < 256; ++j) o += ps[sl * 256 + j] * bf2f(vp[(size_t)j * TOKW]); }
    mix[(size_t)tok * 1024 + h * 64 + lane] = (bf16)f2bf(o / l);
    LDS_WAIT(); asm volatile("" ::: "memory");
}

#ifndef MK_ONE_LAUNCH
#define MK_ONE_LAUNCH 1
#endif
constexpr int N_PHASES = 14;
struct Args { const float* in[23]; float* out; unsigned char* ws; int ph_lo, ph_hi; };

__global__ void __launch_bounds__(NWAVES * 64, 2) mega_fwd(Args args) {
    extern __shared__ __attribute__((aligned(16))) unsigned char lds[];
    LAS unsigned char* L = (LAS unsigned char*)lds;
    volatile LAS unsigned* MISC = (volatile LAS unsigned*)(L + MISC_OFF);
    const int tid = threadIdx.x, lane = tid & 63, wave = __builtin_amdgcn_readfirstlane(tid >> 6);
    const int G = gridDim.x; const int bx = blockIdx.x;
    const int vcu = (G % 8 == 0) ? (bx % 8) * (G / 8) + bx / 8 : bx;
    const int gw = vcu * NWAVES + wave, NGW = G * NWAVES;
    unsigned char* ws = args.ws;
    gu32* ctl = (gu32*)(ws + WS_CTL);
    for (int u = tid; u < (LDS_BYTES - LDSCTL_OFF) / 4; u += NWAVES * 64) ((LAS unsigned*)(L + LDSCTL_OFF))[u] = 0u;
    __syncthreads();
    XcdBarrier bar; bar.bar = (unsigned*)(ctl + CW_BAR); bar.x = 0; bar.st = nullptr;
    if (MK_ONE_LAUNCH) bar = xcd_barrier_post((unsigned*)(ctl + CW_BAR), MISC + 8);
#define MEMATTN_PHASE() do { for (int un = vcu; un < BATCH * MHEAD * NBLK; un += G) { const int b_ = un >> 6, h_ = (un >> 4) & 3, qb_ = un & 15; const size_t qrow_ = (size_t)b_ * SEQ + (size_t)qb_ * 256; \
        attn_body::attn_unit<0, 8, 256, 256, 1024>((const attn_body::bf16*)(QM + qrow_ * 256 + h_ * 64), (const attn_body::bf16*)(MEMK + (size_t)b_ * MEML * 256 + h_ * 64), (const attn_body::bf16*)(MEMV + (size_t)b_ * MEML * 256 + h_ * 64), \
            (attn_body::bf16*)(MIX + qrow_ * 1024 + 768 + h_ * 64), 4, 0.f, nullptr, nullptr, 0, (char*)lds + RING_OFF); } } while (0)
    const int lo = args.ph_lo, hi = args.ph_hi;
#define IN(k) (lo <= (k) && (k) < hi)
#define SEAM(k) do { if (IN(k) && IN((k) + 1)) xcd_barrier(bar); } while (0)

    const float* x = args.in[0]; const float* mem = args.in[1];
    float* out = args.out;
    float* SS0 = (float*)(ws + WS_SS0); float* SSA = (float*)(ws + WS_SSA); float* SSB = (float*)(ws + WS_SSB); float* SSM = (float*)(ws + WS_SSM);
    bf16* KMH = (bf16*)(ws + WS_KMEAN); bf16* KML = (bf16*)(ws + WS_KMEAN + 512 * 1024);
    bf16* WIN0 = (bf16*)(ws + WS_WIN0); bf16* WGLU = (bf16*)(ws + WS_WGLU); bf16* WIN1 = (bf16*)(ws + WS_WIN1);
    bf16* WOUT0 = (bf16*)(ws + WS_WOUT0); bf16* WOUT1 = (bf16*)(ws + WS_WOUT1);
    bf16* WGU0 = (bf16*)(ws + WS_WGU0); bf16* WGU1 = (bf16*)(ws + WS_WGU1); bf16* WDN0 = (bf16*)(ws + WS_WDN0); bf16* WDN1 = (bf16*)(ws + WS_WDN1); bf16* WMKV = (bf16*)(ws + WS_WMKV);
    bf16* MEMB = (bf16*)(ws + WS_MEMB); bf16* MEMK = (bf16*)(ws + WS_MEMK); bf16* MEMV = (bf16*)(ws + WS_MEMV);
    bf16* XB = (bf16*)(ws + WS_XB); bf16* Ub = (bf16*)(ws + WS_U); bf16* Yb = (bf16*)(ws + WS_Y);
    bf16* Q1 = (bf16*)(ws + WS_Q1); bf16* K1 = (bf16*)(ws + WS_K1); bf16* V1 = (bf16*)(ws + WS_V1);
    bf16* QM = (bf16*)(ws + WS_QM); bf16* MIX = (bf16*)(ws + WS_MIX); bf16* Hb = (bf16*)(ws + WS_H);

    if (IN(0)) {
        LAS float* scr = (LAS float*)(L + RING_OFF + wave * 16384);
        constexpr int I_SQ = 16 * 32, I_GLU = 12 * 24, I_IN1 = 16 * 80, I_GU = 16 * 88, I_DN = 44 * 32, I_MKV = 16 * 16;
        constexpr int NITEMS = I_SQ + I_GLU + I_IN1 + 2 * I_SQ + 4 * I_GU + 2 * I_DN + I_MKV;
        const float* mixg = args.in[4]; const float* ffng = args.in[18];
        for (int it = gw; it < NITEMS; it += NGW) {
            int r = it;
            if (r < I_SQ) { p0_matrix_item(args.in[5], 1024, 1024, WIN0, mixg, 0, r, scr, lane); continue; } r -= I_SQ;
            if (r < I_GLU) { p0_matrix_item(args.in[14], 768, 768, WGLU, nullptr, 0, r, scr, lane); continue; } r -= I_GLU;
            if (r < I_IN1) { p0_matrix_item(args.in[16], 1024, 2560, WIN1, mixg + 1024, 0, r, scr, lane); continue; } r -= I_IN1;
            if (r < I_SQ) { p0_matrix_item(args.in[17], 1024, 1024, WOUT0, nullptr, 0, r, scr, lane); continue; } r -= I_SQ;
            if (r < I_SQ) { p0_matrix_item(args.in[17] + 1024 * 1024, 1024, 1024, WOUT1, nullptr, 0, r, scr, lane); continue; } r -= I_SQ;
            if (r < I_GU) { p0_matrix_item(args.in[19], 1024, FFN, WGU0, ffng, 1, r, scr, lane); continue; } r -= I_GU;
            if (r < I_GU) { p0_matrix_item(args.in[20], 1024, FFN, WGU0, ffng, 2, r, scr, lane); continue; } r -= I_GU;
            if (r < I_GU) { p0_matrix_item(args.in[19] + (size_t)1024 * FFN, 1024, FFN, WGU1, ffng + 1024, 1, r, scr, lane); continue; } r -= I_GU;
            if (r < I_GU) { p0_matrix_item(args.in[20] + (size_t)1024 * FFN, 1024, FFN, WGU1, ffng + 1024, 2, r, scr, lane); continue; } r -= I_GU;
            if (r < I_DN) { p0_matrix_item(args.in[21], FFN, 1024, WDN0, nullptr, 0, r, scr, lane); continue; } r -= I_DN;
            if (r < I_DN) { p0_matrix_item(args.in[21] + (size_t)FFN * 1024, FFN, 1024, WDN1, nullptr, 0, r, scr, lane); continue; } r -= I_DN;
            p0_matrix_item(args.in[3], 1024, 512, WMKV, args.in[2], 0, r, scr, lane);
        }
        for (int m = gw; m < TOK; m += NGW) row_to_bf16_ssq(x + (size_t)m * DM, XB + (size_t)m * DM, SS0 + (size_t)m * 16, lane);
        for (int m = gw; m < BATCH * MEML; m += NGW) row_to_bf16_ssq(mem + (size_t)m * DM, MEMB + (size_t)m * DM, SSM + (size_t)m * 16, lane);
    }
    SEAM(0);
    if (IN(1)) {
        { pg8::Gemm g{XB, WIN0, TOK, 1024, 1024}; pg8::StaticOrder S; S.init(TOK, 1024, G, bx);
          pg8::EpiProj E{SS0, Ub, 0, 3, 1, TOKW, 1.0f, QM, C2};
          pg8::gemm_phase<pg8::EpiProj, pg8::StaticOrder, true, true>(L + RING_OFF, g, S, E); }
        { pg8::Gemm g{MEMB, WMKV, BATCH * MEML, 512, 1024}; pg8::StaticOrder S; S.init(BATCH * MEML, 512, G, bx);
          pg8::EpiProj E{SSM, MEMK, (size_t)(WS_MEMV - WS_MEMK) / 2, 1, 2, 256, 1.0f, nullptr, 1.0f};
          pg8::gemm_phase<pg8::EpiProj, pg8::StaticOrder, true, true>(L + RING_OFF, g, S, E); }
    }
    SEAM(1);
    if (IN(2)) {
        for (int un = gw; un < BATCH * NGRP; un += NGW)
            s5_naive_unit(un / NGRP, un % NGRP, Ub, Yb, args.in[6], args.in[7], args.in[8], args.in[9], args.in[10], args.in[11], args.in[12], args.in[13], lane);
        __syncthreads();
        MEMATTN_PHASE();
    }
    SEAM(2);
    if (IN(3)) {
        pg8::Gemm g{Yb, WGLU, TOK, TOKW, TOKW}; pg8::StaticOrder S; S.init(TOK, TOKW, G, bx);
        pg8::EpiGlu E{Yb, TOKW, args.in[15], MIX, 1024};
        pg8::gemm_phase<pg8::EpiGlu, pg8::StaticOrder, true, true>(L + RING_OFF, g, S, E);
    }
    SEAM(3);
    if (IN(4)) {
        pg8::Gemm g{MIX, WOUT0, TOK, 1024, 1024}; pg8::StaticOrder S; S.init(TOK, 1024, G, bx);
        pg8::EpiRes E{x, out, XB, SSA};
        pg8::gemm_phase<pg8::EpiRes, pg8::StaticOrder, true, true>(L + RING_OFF, g, S, E);
    }
    SEAM(4);
    if (IN(5)) {
        pg8::Gemm g{XB, WGU0, TOK, 2 * FFN, 1024}; pg8::StaticOrder S; S.init(TOK, 2 * FFN, G, bx);
        pg8::EpiGU E{SSA, Hb, FFN};
        pg8::gemm_phase<pg8::EpiGU, pg8::StaticOrder, true, true>(L + RING_OFF, g, S, E);
    }
    SEAM(5);
    if (IN(6)) {
        pg8::Gemm g{Hb, WDN0, TOK, 1024, FFN}; pg8::StaticOrder S; S.init(TOK, 1024, G, bx);
        pg8::EpiRes E{out, out, XB, SSB};
        pg8::gemm_phase<pg8::EpiRes, pg8::StaticOrder, true, true>(L + RING_OFF, g, S, E);
    }
    SEAM(6);
    if (IN(7)) {
        pg8::Gemm g{XB, WIN1, TOK, 2560, 1024}; pg8::StaticOrder S; S.init(TOK, 2560, G, bx);
        pg8::EpiProj E{SSB, Q1, (size_t)(WS_K1 - WS_Q1) / 2, 3, 3, TOKW, C2, QM, C2};
        pg8::gemm_phase<pg8::EpiProj, pg8::StaticOrder, true, true>(L + RING_OFF, g, S, E);
    }
    SEAM(7);
    if (IN(8)) {
        for (int un = gw; un < BATCH * NHEAD * NBLK; un += NGW) {
            const int n = un & 15, bh = un >> 4, h = bh % NHEAD, b = bh / NHEAD;
            const bf16* kp = K1 + ((size_t)b * SEQ + (size_t)n * MBLK) * TOKW + h * 64 + lane; float a = 0.f;
#pragma unroll 8
            for (int i = 0; i < MBLK; ++i) a += bf2f(kp[(size_t)i * TOKW]);
            const float km_ = a * (1.0f / MBLK); const unsigned kh_ = f2bf(km_); const float rem_ = km_ - __uint_as_float(kh_ << 16);
            KMH[(size_t)un * 64 + lane] = (bf16)kh_; KML[(size_t)un * 64 + lane] = (bf16)f2bf(rem_);
        }
    }
    SEAM(8);
    if (IN(9)) {
        for (int p_ = vcu; p_ < BATCH * NHEAD * 8; p_ += G) { const int bh_ = p_ >> 3, sg_ = p_ & 7, b_ = bh_ / NHEAD, h_ = bh_ - b_ * NHEAD;
            const float slope2 = __builtin_amdgcn_exp2f(-8.0f * (float)(h_ + 1) / 12.0f) * LOG2E;
#pragma unroll 1
            for (int k_ = 0; k_ < 2; ++k_) { const int qb_ = k_ ? 15 - sg_ : sg_; const size_t qrow_ = (size_t)b_ * SEQ + (size_t)qb_ * 256, krow_ = (size_t)b_ * SEQ;
                attn_body::attn_unit<1, 8, 768, 768, 1024>((const attn_body::bf16*)(Q1 + qrow_ * TOKW + h_ * 64), (const attn_body::bf16*)(K1 + krow_ * TOKW + h_ * 64), (const attn_body::bf16*)(V1 + krow_ * TOKW + h_ * 64),
                    (attn_body::bf16*)(MIX + qrow_ * 1024 + h_ * 64), 4 * qb_ + 4, slope2, (const attn_body::bf16*)(KMH + (size_t)bh_ * 1024), (const attn_body::bf16*)(KML + (size_t)bh_ * 1024), qb_, (char*)lds + RING_OFF); } }
        MEMATTN_PHASE();
    }
    SEAM(9);
    if (IN(10)) {
        pg8::Gemm g{MIX, WOUT1, TOK, 1024, 1024}; pg8::StaticOrder S; S.init(TOK, 1024, G, bx);
        pg8::EpiRes E{out, out, XB, SSA};
        pg8::gemm_phase<pg8::EpiRes, pg8::StaticOrder, true, true>(L + RING_OFF, g, S, E);
    }
    SEAM(10);
    if (IN(11)) {
        pg8::Gemm g{XB, WGU1, TOK, 2 * FFN, 1024}; pg8::StaticOrder S; S.init(TOK, 2 * FFN, G, bx);
        pg8::EpiGU E{SSA, Hb, FFN};
        pg8::gemm_phase<pg8::EpiGU, pg8::StaticOrder, true, true>(L + RING_OFF, g, S, E);
    }
    SEAM(11);
    if (IN(12)) {
        pg8::Gemm g{Hb, WDN1, TOK, 1024, FFN}; pg8::StaticOrder S; S.init(TOK, 1024, G, bx);
        pg8::EpiRes E{out, out, XB, SSB};
        pg8::gemm_phase<pg8::EpiRes, pg8::StaticOrder, true, true>(L + RING_OFF, g, S, E);
    }
    SEAM(12);
    if (IN(13)) {
        const float* gf = args.in[22];
        for (int m = gw; m < TOK; m += NGW) {
            const float rs = pg8::row_rstd(SSB, m);
            GAS f32x4* xr = (GAS f32x4*)(out + (size_t)m * DM) + lane; const GAS f32x4* gp = (const GAS f32x4*)gf + lane;
#pragma unroll
            for (int j = 0; j < 4; ++j) { const f32x4 v = xr[64 * j], gg = gp[64 * j]; xr[64 * j] = v * rs * gg; }
        }
    }
#undef IN
#undef SEAM
}

extern "C" void kernel_launch(void* const* d_in, const int* in_sizes, int n_in, void* d_out, int out_size, void* d_ws, size_t ws_size, hipStream_t stream) {
    static int grid = 0;
    if (grid == 0) {
        if (n_in != 23 || out_size != TOK * DM || ws_size < WS_END) { fprintf(stderr, "kernel_launch: unexpected shapes: n_in %d out %d ws %zu\n", n_in, out_size, ws_size); grid = -1; return; }
        int dev = 0, cus = 0, per_cu = 0;
        if (hipGetDevice(&dev) != hipSuccess || hipDeviceGetAttribute(&cus, hipDeviceAttributeMultiprocessorCount, dev) != hipSuccess) { grid = -1; return; }
        if (hipFuncSetAttribute((const void*)mega_fwd, hipFuncAttributeMaxDynamicSharedMemorySize, LDS_BYTES) != hipSuccess) { fprintf(stderr, "kernel_launch: hipFuncSetAttribute failed\n"); grid = -1; return; }
        if (hipOccupancyMaxActiveBlocksPerMultiprocessor(&per_cu, (const void*)mega_fwd, NWAVES * 64, LDS_BYTES) != hipSuccess || per_cu < 1)
            fprintf(stderr, "kernel_launch: occupancy query reports %d workgroups per CU\n", per_cu);
        (void)hipGetLastError();
        grid = cus;
    }
    if (grid < 0) return;
    if (hipMemsetAsync((char*)d_ws + WS_CTL, 0, CTL_ZERO_BYTES, stream) != hipSuccess) return;
    Args a{};
    for (int i = 0; i < 23; ++i) a.in[i] = (const float*)d_in[i];
    a.out = (float*)d_out; a.ws = (unsigned char*)d_ws;
#if MK_ONE_LAUNCH
    a.ph_lo = 0; a.ph_hi = N_PHASES;
    hipLaunchKernelGGL(mega_fwd, dim3(grid), dim3(NWAVES * 64), LDS_BYTES, stream, a);
#else
    for (int p = 0; p < N_PHASES; ++p) { a.ph_lo = p; a.ph_hi = p + 1; hipLaunchKernelGGL(mega_fwd, dim3(grid), dim3(NWAVES * 64), LDS_BYTES, stream, a); }
#endif
}
```

```cpp
#include <hip/hip_runtime.h>
#include <hip/hip_bf16.h>
#include <cstdio>
#include <cstdint>
#include <cmath>
namespace pg8 {
#define PG8_LAS __attribute__((address_space(3)))
typedef unsigned short bf16_t;
typedef short bf16x8 __attribute__((ext_vector_type(8)));
typedef float f32x4 __attribute__((ext_vector_type(4)));
typedef unsigned u32x4 __attribute__((ext_vector_type(4)));
constexpr int BM = 256, BK = 64, HALF = 128, HTB = HALF * BK * 2  , STAGE_BYTES = 8 * HTB, NXCD = 8, WGM = 8;

__host__ __device__ __forceinline__ int lds_byte(int r, int c) { const int st = (r >> 4) * 2 + (c >> 5), rr = r & 15, cc = c & 31, ob = rr * 64 + cc * 2; return st * 1024 + (ob ^ (((ob >> 9) & 1) << 5)); }
__host__ __device__ __forceinline__ void stage_rc(int b, int& R, int& C) { const int st = b / 1024, sb = b % 1024, swz = sb ^ (((sb >> 9) & 1) << 5); R = (st >> 1) * 16 + swz / 64; C = (st & 1) * 32 + (swz % 64) / 2; }
__host__ __device__ __forceinline__ int perm32(int rho) { const int n = rho >> 4, i = rho & 15; return 8 * (i >> 2) + 4 * n + (i & 3); }

struct Unit { int pm, pn; };
struct Gemm { const bf16_t* A; const bf16_t* Bt; int M, N, K, amode; };

struct StaticOrder {
    int nM, nN, nwg, G, c;
    __host__ __device__ void init(int M, int N, int G_, int c_) { nM = M / BM; nN = N / BM; nwg = nM * nN; G = G_; c = c_; }
    __host__ __device__ bool next(int i, Unit& u) const {
        const long L = (long)i * G + c; if (L >= nwg) return false;
        int wgid = (int)L; { const int q = nwg / NXCD, r = nwg % NXCD, xcd = wgid % NXCD, off = wgid / NXCD; wgid = (xcd < r ? xcd * (q + 1) : r * (q + 1) + (xcd - r) * q) + off; }
        const int nig = WGM * nN, gid = wgid / nig, fm = gid * WGM, gsz = (nM - fm) < WGM ? (nM - fm) : WGM;
        u.pm = fm + ((wgid % nig) % gsz); u.pn = (wgid % nig) / gsz; return true;
    }
    __device__ __forceinline__ void a_ready(const Unit&) const {}
    __device__ __forceinline__ void done(const Unit&) const {}
};

__device__ __forceinline__ unsigned cvt_pk_bf16(float lo, float hi) { unsigned r; asm volatile("v_cvt_pk_bf16_f32 %0, %1, %2" : "=v"(r) : "v"(lo), "v"(hi)); return r; }
typedef float f32x2 __attribute__((ext_vector_type(2)));
typedef unsigned u32x2 __attribute__((ext_vector_type(2)));
constexpr float RMS_EPS = 1e-6f;
__device__ __forceinline__ float row_rstd(const float* ssq, int row) {
    const f32x4* p = (const f32x4*)(ssq + (size_t)row * 16);
    const f32x4 a = p[0], b = p[1], c = p[2], d = p[3];
    const float s = (((a[0] + a[1]) + (a[2] + a[3])) + ((b[0] + b[1]) + (b[2] + b[3]))) + (((c[0] + c[1]) + (c[2] + c[3])) + ((d[0] + d[1]) + (d[2] + d[3])));
    return 1.0f / sqrtf(s * (1.0f / 1024.0f) + RMS_EPS);
}
__device__ __forceinline__ float bf2f(unsigned short h) { return __uint_as_float(((unsigned)h) << 16); }
__device__ __forceinline__ float bflo(unsigned w) { return __uint_as_float(w << 16); }
__device__ __forceinline__ float bfhi(unsigned w) { return __uint_as_float(w & 0xffff0000u); }

__device__ __forceinline__ f32x2 gelu_pk(f32x2 v) {
    const f32x2 av = __builtin_elementwise_abs(v), d = av * 0.2316418882f + 1.0f;
    f32x2 t; t.x = __builtin_amdgcn_rcpf(d.x); t.y = __builtin_amdgcn_rcpf(d.y);
    f32x2 q = t * 0.5307027145f + (-0.7265760135f); q = q * t + 0.7107068705f; q = q * t + (-0.142248368f); q = q * t + 0.127414796f; q = q * t;
    const f32x2 s = (v * v) * (-0.72134752044f);
    f32x2 e; e.x = __builtin_amdgcn_exp2f(s.x); e.y = __builtin_amdgcn_exp2f(s.y);
    const f32x2 m = v * (q * e), r = v - m;
    f32x2 o; o.x = v.x < 0.f ? m.x : r.x; o.y = v.y < 0.f ? m.y : r.y; return o;
}

struct EpiProj {
    static constexpr bool PERM = true, AFTER_DRAIN = false;
    const float* ssq; bf16_t* base; size_t seg_stride; int tps, nseg, ldc; float scale0; bf16_t* qm; float scale_qm; int gm_rows;
    __device__ __forceinline__ void operator()(const f32x4 (&acc)[2][2][4][2], const Unit& u, int wr, int wc, int fr, int fq) const {
        const int seg = u.pn / tps, within = u.pn - seg * tps;
        bf16_t* o; int ld, colt; float sc;
        if (seg < nseg) { o = base + (size_t)seg * seg_stride; ld = ldc; colt = within * BM; sc = (seg == 0) ? scale0 : 1.0f; }
        else { o = qm; ld = 256; colt = 0; sc = scale_qm; }
        const int row0 = u.pm * BM + wr * 64 + fr, col0 = colt + wc * 32 + 8 * fq;
#pragma unroll
        for (int ai = 0; ai < 2; ++ai)
#pragma unroll
            for (int m = 0; m < 4; ++m) { const int row = row0 + ai * HALF + m * 16; const float rs = row_rstd(ssq, row) * sc; bf16_t* rowp = o + (size_t)row * ld + col0;
                const bool gm = (gm_rows != 0) && (seg < nseg);
#pragma unroll
                for (int bj = 0; bj < 2; ++bj) { const f32x4 v0 = acc[ai][bj][m][0] * rs, v1 = acc[ai][bj][m][1] * rs;
                    u32x4 w; w.x = cvt_pk_bf16(v0[0], v0[1]); w.y = cvt_pk_bf16(v0[2], v0[3]); w.z = cvt_pk_bf16(v1[0], v1[1]); w.w = cvt_pk_bf16(v1[2], v1[3]);
                    const int cc = col0 + bj * HALF;
                    bf16_t* dst = gm ? (o + ((size_t)(cc >> 4) * gm_rows + row) * 16 + (cc & 15)) : (rowp + bj * HALF);
                    *(u32x4*)dst = w; } }
    }
};
struct EpiGlu {
    static constexpr bool PERM = true, AFTER_DRAIN = false;
    const bf16_t* Y; int ldy; const float* bias; bf16_t* mix; int ldm; int ygm_rows;
    __device__ __forceinline__ void operator()(const f32x4 (&acc)[2][2][4][2], const Unit& u, int wr, int wc, int fr, int fq) const {
        const int row0 = u.pm * BM + wr * 64 + fr, col0 = u.pn * BM + wc * 32 + 8 * fq;
        f32x4 bv[2][2];
#pragma unroll
        for (int bj = 0; bj < 2; ++bj)
#pragma unroll
            for (int n = 0; n < 2; ++n) bv[bj][n] = *(const f32x4*)(bias + col0 + bj * HALF + 4 * n);
#pragma unroll
        for (int ai = 0; ai < 2; ++ai)
#pragma unroll
            for (int m = 0; m < 4; ++m) { const int row = row0 + ai * HALF + m * 16;
#pragma unroll
                for (int bj = 0; bj < 2; ++bj) { const int cc = col0 + bj * HALF; const u32x4 yw = ygm_rows ? *(const u32x4*)(Y + ((size_t)(cc >> 4) * ygm_rows + row) * 16 + (cc & 15)) : *(const u32x4*)(Y + (size_t)row * ldy + cc);
                    const f32x4 z0 = acc[ai][bj][m][0] + bv[bj][0], z1 = acc[ai][bj][m][1] + bv[bj][1];
                    float t[8]; const float yv[8] = {bflo(yw.x), bfhi(yw.x), bflo(yw.y), bfhi(yw.y), bflo(yw.z), bfhi(yw.z), bflo(yw.w), bfhi(yw.w)};
#pragma unroll
                    for (int e = 0; e < 4; ++e) { t[e] = yv[e] * __builtin_amdgcn_rcpf(1.0f + __builtin_amdgcn_exp2f(-1.4426950408889634f * z0[e])); t[4 + e] = yv[4 + e] * __builtin_amdgcn_rcpf(1.0f + __builtin_amdgcn_exp2f(-1.4426950408889634f * z1[e])); }
                    u32x4 w; w.x = cvt_pk_bf16(t[0], t[1]); w.y = cvt_pk_bf16(t[2], t[3]); w.z = cvt_pk_bf16(t[4], t[5]); w.w = cvt_pk_bf16(t[6], t[7]);
                    *(u32x4*)(mix + (size_t)row * ldm + col0 + bj * HALF) = w; } }
    }
};
struct EpiRes {
    static constexpr bool PERM = false, AFTER_DRAIN = false;
    const float* base; float* out; bf16_t* xb; float* ssq_out;
    __device__ __forceinline__ void operator()(const f32x4 (&acc)[2][2][4][2], const Unit& u, int wr, int wc, int fr, int fq) const {
        const int row0 = u.pm * BM + wr * 64 + fr, col0 = u.pn * BM + wc * 32 + 4 * fq;
#pragma unroll
        for (int ai = 0; ai < 2; ++ai)
#pragma unroll
            for (int m = 0; m < 4; ++m) { const int row = row0 + ai * HALF + m * 16; const size_t off = (size_t)row * 1024 + col0; float ss = 0.f;
#pragma unroll
                for (int bj = 0; bj < 2; ++bj)
#pragma unroll
                    for (int n = 0; n < 2; ++n) { const f32x4 b = *(const f32x4*)(base + off + bj * HALF + n * 16); const f32x4 o = b + acc[ai][bj][m][n];
                        *(f32x4*)(out + off + bj * HALF + n * 16) = o; u32x2 w; w.x = cvt_pk_bf16(o[0], o[1]); w.y = cvt_pk_bf16(o[2], o[3]); *(u32x2*)(xb + off + bj * HALF + n * 16) = w;
                        ss += (o[0] * o[0] + o[1] * o[1]) + (o[2] * o[2] + o[3] * o[3]); }
                ss += __shfl_xor(ss, 16); ss += __shfl_xor(ss, 32);
                if (fq == 0) ssq_out[(size_t)row * 16 + u.pn * 4 + wc] = ss; }
    }
};
struct EpiGU {
    static constexpr bool PERM = true, AFTER_DRAIN = false;
    const float* ssq; bf16_t* H; int ldh;
    __device__ __forceinline__ void operator()(const f32x4 (&acc)[2][2][4][2], const Unit& u, int wr, int wc, int fr, int fq) const {
        const int row0 = u.pm * BM + wr * 64 + fr, col0 = u.pn * HALF + wc * 32 + 8 * fq;
#pragma unroll
        for (int ai = 0; ai < 2; ++ai)
#pragma unroll
            for (int m = 0; m < 4; ++m) { const int row = row0 + ai * HALF + m * 16; const float rs = row_rstd(ssq, row);
                float t[8];
#pragma unroll
                for (int n = 0; n < 2; ++n)
#pragma unroll
                    for (int e = 0; e < 4; ++e) { const float g = acc[ai][0][m][n][e] * rs, up = acc[ai][1][m][n][e] * rs;
                        t[4 * n + e] = g * __builtin_amdgcn_rcpf(1.0f + __builtin_amdgcn_exp2f(-1.4426950408889634f * g)) * up; }
                u32x4 w; w.x = cvt_pk_bf16(t[0], t[1]); w.y = cvt_pk_bf16(t[2], t[3]); w.z = cvt_pk_bf16(t[4], t[5]); w.w = cvt_pk_bf16(t[6], t[7]);
                *(u32x4*)(H + (size_t)row * ldh + col0) = w; }
    }
};

template <class Epi, class Sched, bool ALIGN_EPI = false, bool SP2 = false>
__device__ __forceinline__ void gemm_phase(PG8_LAS unsigned char* lds, const Gemm g, const Sched& S, const Epi& E) {
    const int tid = threadIdx.x, wid = __builtin_amdgcn_readfirstlane(tid >> 6), lane = tid & 63, wr = wid >> 2, wc = wid & 3, fr = lane & 15, fq = lane >> 4;
    const int K = g.K, nt = K / BK;
    unsigned voffA[2], voffB[2];
#pragma unroll
    for (int i = 0; i < 2; ++i) { int R, C; stage_rc(tid * 16 + i * 8192, R, C); const int Rb = Epi::PERM ? ((R & ~31) + perm32(R & 31)) : R;
        voffA[i] = g.amode ? (unsigned)((C >> 4) * g.M * 32 + R * 32 + (C & 15) * 2) : (unsigned)(R * K + C) * 2u; voffB[i] = (unsigned)(Rb * K + C) * 2u; }
    const size_t kstep = (size_t)(BK * 2);
    const size_t hstep = (size_t)HALF * K * 2;
    const size_t tstep = 2 * hstep;
    const size_t kstepA = g.amode ? (size_t)4 * g.M * 32 : kstep, hstepA = g.amode ? (size_t)HALF * 32 : hstep, tstepA = 2 * hstepA;
    const unsigned ldsw = (unsigned)wid * 1024u;
    const int aoff = lds_byte(wr * 64 + fr, fq * 8), boff = lds_byte(wc * 32 + fr, fq * 8);
#define PG8_SA(b, h) (((b) * 2 + (h)) * HTB)
#define PG8_SB(b, h) ((4 + (b) * 2 + (h)) * HTB)
#define PG8_STAGE(bufoff, gbase, voff) do { _Pragma("unroll") for (int _i = 0; _i < 2; ++_i) \
        __builtin_amdgcn_global_load_lds((const unsigned*)((const char*)(gbase) + (voff)[_i]), (PG8_LAS unsigned*)(lds + (bufoff) + ldsw + _i * 8192), 16, 0, 0); } while (0)
#define PG8_LDA(dst, b, h) do { _Pragma("unroll") for (int m = 0; m < 4; ++m) _Pragma("unroll") for (int k = 0; k < 2; ++k) dst[m][k] = *(const PG8_LAS bf16x8*)(lds + PG8_SA(b, h) + aoff + m * 2048 + k * 1024); } while (0)
#define PG8_LDB(dst, b, h) do { _Pragma("unroll") for (int n = 0; n < 2; ++n) _Pragma("unroll") for (int k = 0; k < 2; ++k) dst[n][k] = *(const PG8_LAS bf16x8*)(lds + PG8_SB(b, h) + boff + n * 2048 + k * 1024); } while (0)
#define PG8_MMA(ai, bj, At, Bt) do { __builtin_amdgcn_s_setprio(1); _Pragma("unroll") for (int m = 0; m < 4; ++m) _Pragma("unroll") for (int n = 0; n < 2; ++n) _Pragma("unroll") for (int k = 0; k < 2; ++k) \
        acc[ai][bj][m][n] = __builtin_amdgcn_mfma_f32_16x16x32_bf16(Bt[n][k], At[m][k], acc[ai][bj][m][n], 0, 0, 0); __builtin_amdgcn_s_setprio(0); } while (0)
#define PG8_WAIT_V(n) asm volatile("s_waitcnt vmcnt(" #n ")" ::: "memory")
#define PG8_WAIT_L(n) asm volatile("s_waitcnt lgkmcnt(" #n ")" ::: "memory")
#define PG8_BAR __builtin_amdgcn_s_barrier()
#define PG8_SCHED __builtin_amdgcn_sched_barrier(0)
    Unit cur, nxt; int ui = 0;
    if (!S.next(0, cur)) return;
    f32x4 acc[2][2][4][2];
#pragma unroll
    for (int a = 0; a < 2; ++a)
#pragma unroll
        for (int b = 0; b < 2; ++b)
#pragma unroll
            for (int m = 0; m < 4; ++m)
#pragma unroll
                for (int n = 0; n < 2; ++n) acc[a][b][m][n] = (f32x4){0.f, 0.f, 0.f, 0.f};
    bf16x8 At[4][2], B0[2][2], B1[2][2];
    const char* cA = (const char*)g.A + (size_t)cur.pm * tstepA; const char* cB = (const char*)g.Bt + (size_t)cur.pn * tstep;
    S.a_ready(cur);
    if constexpr (SP2) {
        PG8_STAGE(PG8_SB(0, 0), cB, voffB); PG8_STAGE(PG8_SB(0, 1), cB + hstep, voffB); PG8_STAGE(PG8_SA(0, 0), cA, voffA); PG8_STAGE(PG8_SA(0, 1), cA + hstepA, voffA);
        if (wr == 1) PG8_BAR;
        PG8_WAIT_V(2); PG8_BAR;
        PG8_STAGE(PG8_SB(1, 0), cB + kstep, voffB); PG8_STAGE(PG8_SA(1, 0), cA + kstepA, voffA); PG8_STAGE(PG8_SB(1, 1), cB + hstep + kstep, voffB);
        PG8_WAIT_V(6); PG8_BAR;
    } else {
        PG8_STAGE(PG8_SB(0, 0), cB, voffB); PG8_STAGE(PG8_SA(0, 0), cA, voffA); PG8_STAGE(PG8_SB(0, 1), cB + hstep, voffB); PG8_STAGE(PG8_SA(0, 1), cA + hstepA, voffA);
        if (wr == 1) PG8_BAR;
        PG8_WAIT_V(4); PG8_BAR;
        PG8_STAGE(PG8_SB(1, 0), cB + kstep, voffB); PG8_STAGE(PG8_SA(1, 0), cA + kstepA, voffA); PG8_STAGE(PG8_SB(1, 1), cB + hstep + kstep, voffB);
        PG8_WAIT_V(6); PG8_BAR;
    }
    for (;;) {
        const bool has_next = S.next(ui + 1, nxt);
        const char* nA = has_next ? (const char*)g.A + (size_t)nxt.pm * tstepA : cA; const char* nB = has_next ? (const char*)g.Bt + (size_t)nxt.pn * tstep : cB;
        for (int t = 0; t < nt; t += 2) {
            const bool last = (t == nt - 2);
            const char* a1 = cA + (size_t)(t + 1) * kstepA;
            const char* a2 = last ? nA : cA + (size_t)(t + 2) * kstepA; const char* b2 = last ? nB : cB + (size_t)(t + 2) * kstep;
            const char* a3 = a2 + kstepA; const char* b3 = b2 + kstep;
            if (last && has_next) S.a_ready(nxt);
            if constexpr (SP2) {
            PG8_LDB(B0, 0, 0); PG8_LDB(B1, 0, 1); PG8_SCHED; PG8_LDA(At, 0, 0); PG8_STAGE(PG8_SA(1, 1), a1 + hstepA, voffA);
            PG8_WAIT_V(8); PG8_WAIT_L(0); PG8_BAR; PG8_MMA(0, 0, At, B0); PG8_MMA(0, 1, At, B1); PG8_BAR; PG8_SCHED;
            PG8_LDA(At, 0, 1); PG8_STAGE(PG8_SB(0, 0), b2, voffB); PG8_STAGE(PG8_SB(0, 1), b2 + hstep, voffB); PG8_STAGE(PG8_SA(0, 0), a2, voffA);
            PG8_WAIT_V(8); PG8_WAIT_L(0); PG8_BAR; PG8_MMA(1, 0, At, B0); PG8_MMA(1, 1, At, B1); PG8_BAR; PG8_SCHED;
            PG8_LDB(B0, 1, 0); PG8_LDB(B1, 1, 1); PG8_SCHED; PG8_LDA(At, 1, 0); PG8_STAGE(PG8_SA(0, 1), a2 + hstepA, voffA);
            PG8_WAIT_V(8); PG8_WAIT_L(0); PG8_BAR; PG8_MMA(0, 0, At, B0); PG8_MMA(0, 1, At, B1); PG8_BAR; PG8_SCHED;
            PG8_LDA(At, 1, 1); PG8_STAGE(PG8_SB(1, 0), b3, voffB); PG8_STAGE(PG8_SB(1, 1), b3 + hstep, voffB); PG8_STAGE(PG8_SA(1, 0), a3, voffA);
            PG8_WAIT_V(8); PG8_WAIT_L(0); PG8_BAR; PG8_MMA(1, 0, At, B0); PG8_MMA(1, 1, At, B1); PG8_BAR; PG8_SCHED;
            } else {
            PG8_LDB(B0, 0, 0); PG8_SCHED; PG8_LDA(At, 0, 0); PG8_STAGE(PG8_SA(1, 1), a1 + hstepA, voffA);
            PG8_WAIT_L(8); PG8_BAR; PG8_WAIT_L(0); PG8_MMA(0, 0, At, B0); PG8_BAR; PG8_SCHED;
            PG8_LDB(B1, 0, 1); PG8_STAGE(PG8_SB(0, 0), b2, voffB);
            PG8_BAR; PG8_WAIT_L(0); PG8_MMA(0, 1, At, B1); PG8_BAR;
            PG8_LDA(At, 0, 1); PG8_STAGE(PG8_SA(0, 0), a2, voffA);
            PG8_BAR; PG8_WAIT_L(0); PG8_MMA(1, 0, At, B0); PG8_BAR; PG8_SCHED;
            PG8_STAGE(PG8_SB(0, 1), b2 + hstep, voffB);
            PG8_WAIT_V(6); PG8_BAR; PG8_MMA(1, 1, At, B1); PG8_BAR;
            PG8_LDB(B0, 1, 0); PG8_SCHED; PG8_LDA(At, 1, 0); PG8_STAGE(PG8_SA(0, 1), a2 + hstepA, voffA);
            PG8_WAIT_L(8); PG8_BAR; PG8_WAIT_L(0); PG8_MMA(0, 0, At, B0); PG8_BAR; PG8_SCHED;
            PG8_LDB(B1, 1, 1); PG8_STAGE(PG8_SB(1, 0), b3, voffB);
            PG8_BAR; PG8_WAIT_L(0); PG8_MMA(0, 1, At, B1); PG8_BAR;
            PG8_LDA(At, 1, 1); PG8_STAGE(PG8_SA(1, 0), a3, voffA);
            PG8_BAR; PG8_WAIT_L(0); PG8_MMA(1, 0, At, B0); PG8_BAR; PG8_SCHED;
            PG8_STAGE(PG8_SB(1, 1), b3 + hstep, voffB);
            PG8_WAIT_V(6); PG8_BAR; PG8_MMA(1, 1, At, B1); PG8_BAR;
            }
        }
        if constexpr (ALIGN_EPI) { if (wr == 0) PG8_BAR; }
        if constexpr (!Epi::AFTER_DRAIN) { E(acc, cur, wr, wc, fr, fq); S.done(cur); }
        if (!has_next) break;
#pragma unroll
        for (int a = 0; a < 2; ++a)
#pragma unroll
            for (int b = 0; b < 2; ++b)
#pragma unroll
                for (int m = 0; m < 4; ++m)
#pragma unroll
                    for (int n = 0; n < 2; ++n) acc[a][b][m][n] = (f32x4){0.f, 0.f, 0.f, 0.f};
        cur = nxt; cA = nA; cB = nB; ++ui;
        if constexpr (ALIGN_EPI) { if (wr == 1) PG8_BAR; }
    }
    PG8_WAIT_V(0);
    if constexpr (!ALIGN_EPI) { if (wr == 0) PG8_BAR; }
    PG8_BAR;
    if constexpr (Epi::AFTER_DRAIN) { E.fused(acc, cur, wr, wc, fr, fq, lds, wid, lane); S.done(cur); }
#undef PG8_SA
#undef PG8_SB
#undef PG8_STAGE
#undef PG8_LDA
#undef PG8_LDB
#undef PG8_MMA
#undef PG8_WAIT_V
#undef PG8_WAIT_L
#undef PG8_BAR
#undef PG8_SCHED
}
}
constexpr int NWAVES = 8;
constexpr int BATCH = 8, SEQ = 4096, DM = 1024, TOK = BATCH * SEQ;
constexpr int TOKW = 768, MEMW = 256, MEML = 256, NGRP = 48, NST = 64, GCH = 16, NHEAD = 12, MHEAD = 4, HD = 64, FFN = 2816, NBLK = 16, MBLK = 256;
constexpr float C2 = 0.125f * 1.4426950408889634f;
constexpr float LOG2E = 1.4426950408889634f;

constexpr size_t MiB = 1u << 20;
constexpr size_t WS_CTL = 0, CTL_ZERO_BYTES = 1 * MiB;
constexpr size_t WS_S5TAB = 9 * MiB, WS_S5E = 13 * MiB;
constexpr size_t WS_SS0 = 1 * MiB, WS_SSA = 3 * MiB, WS_SSB = 5 * MiB, WS_SSM = 7 * MiB, WS_KMEAN = 8 * MiB;
constexpr size_t WS_WIN0 = 16 * MiB, WS_WGLU = 18 * MiB, WS_WIN1 = 20 * MiB, WS_WOUT0 = 26 * MiB, WS_WOUT1 = 28 * MiB;
constexpr size_t WS_WGU0 = 30 * MiB, WS_WGU1 = 41 * MiB, WS_WDN0 = 52 * MiB, WS_WDN1 = 58 * MiB, WS_WMKV = 64 * MiB;
constexpr size_t WS_MEMB = 65 * MiB, WS_MEMK = 69 * MiB, WS_MEMV = 70 * MiB;
constexpr size_t WS_XB = 72 * MiB;
constexpr size_t WS_R = 136 * MiB;
constexpr size_t WS_U = WS_R, WS_Y = WS_R + 48 * MiB;
constexpr size_t WS_Q1 = WS_R, WS_K1 = WS_R + 48 * MiB, WS_V1 = WS_R + 96 * MiB;
constexpr size_t WS_QM = WS_R + 144 * MiB;
constexpr size_t WS_MIX = WS_R + 160 * MiB;
constexpr size_t WS_H = WS_R;
constexpr size_t WS_END = WS_R + 224 * MiB;
constexpr int CW_BAR = 4096;

constexpr int RING_OFF = 0, RING_BYTES = 147456;
constexpr int LDSCTL_OFF = RING_BYTES, MISC_OFF = LDSCTL_OFF + 320;
constexpr int LDS_BYTES = RING_BYTES + 1024;

#define GAS __attribute__((address_space(1)))
#define LAS __attribute__((address_space(3)))
typedef unsigned short bf16;
typedef unsigned v4u __attribute__((ext_vector_type(4)));
typedef unsigned v2u __attribute__((ext_vector_type(2)));
typedef float f32x4 __attribute__((ext_vector_type(4)));
typedef GAS unsigned gu32;
typedef float f32x2 __attribute__((ext_vector_type(2)));
#define RLX_AGENT __ATOMIC_RELAXED, __HIP_MEMORY_SCOPE_AGENT
#define LDS_WAIT() asm volatile("s_waitcnt lgkmcnt(0)" ::: "memory")
#define VM_WAIT() asm volatile("s_waitcnt vmcnt(0)" ::: "memory")
__device__ __forceinline__ unsigned f2bf(float f) { unsigned u = __builtin_bit_cast(unsigned, f); return (u + 0x7fffu + ((u >> 16) & 1u)) >> 16; }
__device__ __forceinline__ unsigned pk2(float lo, float hi) { return f2bf(lo) | (f2bf(hi) << 16); }
__device__ __forceinline__ float bf2f(unsigned short h) { return __uint_as_float(((unsigned)h) << 16); }
__device__ __forceinline__ float bflo(unsigned w) { return __uint_as_float(w << 16); }
__device__ __forceinline__ float bfhi(unsigned w) { return __uint_as_float(w & 0xffff0000u); }

#define XB_TMO      128
#define XB_XCNT(j)  (256  + 64 * (j))
#define XB_XSUB(j)  (1280 + 64 * (j))
#define XB_XGEN(j)  (2304 + 64 * (j))
#define XB_TOP      3328
#define XB_TOPGEN   3392
#define XCD_BAR_WORDS 3456
#define XB_SPIN_CAP (1u << 18)

__device__ __forceinline__ unsigned xb_ld(unsigned* p)              { return __hip_atomic_load(p, __ATOMIC_RELAXED, __HIP_MEMORY_SCOPE_AGENT); }
__device__ __forceinline__ unsigned xb_add(unsigned* p, unsigned v) { return __hip_atomic_fetch_add(p, v, __ATOMIC_RELAXED, __HIP_MEMORY_SCOPE_AGENT); }
__device__ __forceinline__ unsigned xb_xcc_id() { return (unsigned)__builtin_amdgcn_s_getreg((3 << 11) | 20) & 0xFu; }
#define XB_SPIN(cond, bar) do { unsigned _sp = 0; while (cond) { __builtin_amdgcn_s_sleep(1); \
    if ((++_sp & 255u) == 0u) { if (xb_ld(&(bar)[XB_TMO])) break; if (_sp > XB_SPIN_CAP) { atomicAdd(&(bar)[XB_TMO], 1u); break; } } } } while (0)

struct XcdBarrier {
    unsigned* bar; unsigned x;
    volatile LAS unsigned* st;
};

__device__ __forceinline__ XcdBarrier xcd_barrier_post(unsigned* bar, volatile LAS unsigned* st) {
    XcdBarrier b; b.bar = bar; b.x = xb_xcc_id(); b.st = st;
    if (threadIdx.x == 0) (void)xb_add(&bar[XB_XCNT(b.x)], 1u);
    return b;
}
__device__ __forceinline__ void xcd_barrier_complete(unsigned* bar, unsigned x, unsigned& nloc, unsigned& nx) {
    const unsigned G = gridDim.x * gridDim.y * gridDim.z;
    unsigned sum, cnt, mine, sp = 0u;
    for (;;) {
        sum = 0u; cnt = 0u; mine = 0u;
#pragma unroll
        for (unsigned j = 0; j < 16; ++j) { const unsigned c = xb_ld(&bar[XB_XCNT(j)]); sum += c; cnt += (c > 0u) ? 1u : 0u; mine = (j == x) ? c : mine; }
        if (sum == G) break;
        __builtin_amdgcn_s_sleep(1);
        if ((++sp & 255u) == 0u) { if (xb_ld(&bar[XB_TMO])) break; if (sp > XB_SPIN_CAP) { atomicAdd(&bar[XB_TMO], 1u); break; } }
    }
    nloc = mine > 0u ? mine : 1u; nx = cnt > 0u ? cnt : 1u;
}

__device__ __forceinline__ void xcd_barrier(const XcdBarrier& b) {
    asm volatile("s_waitcnt vmcnt(0)" ::: "memory");
    __syncthreads();
    if (threadIdx.x == 0) {
        unsigned* bar = b.bar;
        __builtin_amdgcn_s_waitcnt(0);
        unsigned nloc = b.st[0], nx = b.st[1];
        if (nloc == 0u) { xcd_barrier_complete(bar, b.x, nloc, nx); b.st[0] = nloc; b.st[1] = nx; }
        const unsigned old = xb_add(&bar[XB_XSUB(b.x)], 1u);
        const unsigned gen = old / nloc;
        if (old + 1u == (gen + 1u) * nloc) {
            __builtin_amdgcn_fence(__ATOMIC_RELEASE, "agent");
            asm volatile("s_waitcnt vmcnt(0)" ::: "memory");
            const unsigned og = xb_add(&bar[XB_TOP], 1u);
            const unsigned tg = og / nx;
            if (og + 1u == (tg + 1u) * nx) xb_add(&bar[XB_TOPGEN], 1u);
            else XB_SPIN(xb_ld(&bar[XB_TOPGEN]) == tg, bar);
            __builtin_amdgcn_fence(__ATOMIC_ACQUIRE, "agent");
            xb_add(&bar[XB_XGEN(b.x)], 1u);
            asm volatile("s_waitcnt vmcnt(0)" ::: "memory");
        } else {
            XB_SPIN(xb_ld(&bar[XB_XGEN(b.x)]) == gen, bar);
            __builtin_amdgcn_fence(__ATOMIC_ACQUIRE, "agent");
            asm volatile("s_waitcnt vmcnt(0)" ::: "memory");
        }
    }
    __syncthreads();
}
namespace attn_body {
using bf16=__hip_bfloat16;
using bf16x8=__attribute__((ext_vector_type(8)))short;
using s16x4=__attribute__((ext_vector_type(4)))short;
using f32x16=__attribute__((ext_vector_type(16)))float;
using u32x4=__attribute__((ext_vector_type(4)))unsigned;
constexpr int D=64;
constexpr int NW=8,QBLK=32,QB=QBLK*NW,KVBLK=64;
__device__ __forceinline__ int crow(int r,int hi){return (r&3)+8*(r>>2)+4*hi;}
#define SBAR() __builtin_amdgcn_sched_barrier(0)
__device__ __forceinline__ void cmask(f32x16&p0,f32x16&p1,int jb,int qrel,int hi){
  const float NEG=-INFINITY; int kb=64*jb+4*hi;
  #pragma unroll
  for(int r=0;r<16;++r){int kv=kb+(r&3)+8*(r>>2); if(kv>qrel)p0[r]=NEG; if(kv+32>qrel)p1[r]=NEG;}
}

constexpr int NSLOT=3, SLOTB=8192;
constexpr int LDS_K=0, LDS_V=NSLOT*SLOTB, LDS_WS=2*NSLOT*SLOTB, LDS_OST=LDS_WS+NW*64*4, LDS_BYTES=LDS_OST+NW*4096;
__device__ __forceinline__ void glds16(const void*gsrc,unsigned lds_dst){unsigned keep;
  asm volatile("s_mov_b32 %0, m0\n\ts_mov_b32 m0, %2\n\ts_nop 0\n\tglobal_load_lds_dwordx4 %1, off\n\ts_mov_b32 m0, %0":"=&s"(keep):"v"(gsrc),"s"(lds_dst):"memory");}
__device__ __forceinline__ float max3f(float a,float b,float c){float r;asm("v_max3_f32 %0, %1, %2, %3":"=v"(r):"v"(a),"v"(b),"v"(c));return r;}
__device__ __forceinline__ float max2f(float a,float b){float r;asm("v_max_f32_e32 %0, %1, %2":"=v"(r):"v"(a),"v"(b));return r;}
__device__ __forceinline__ float fadd_s(float a,float b){float r;asm("v_add_f32_e32 %0, %1, %2":"=v"(r):"v"(a),"v"(b));return r;}
__device__ __forceinline__ float fsub_s(float a,float b){float r;asm("v_sub_f32_e32 %0, %1, %2":"=v"(r):"v"(a),"v"(b));return r;}
typedef float f32x2_t __attribute__((ext_vector_type(2))); typedef __bf16 bf16x2_t __attribute__((ext_vector_type(2)));
__device__ __forceinline__ unsigned cvtpk_s(float lo,float hi){f32x2_t v={lo,hi};bf16x2_t b=__builtin_convertvector(v,bf16x2_t);return __builtin_bit_cast(unsigned,b);}
#define WAIT_BAR(N) asm volatile("s_waitcnt vmcnt(" #N ") lgkmcnt(0)\n\ts_barrier":::"memory")

__device__ __forceinline__ void qkt(f32x16&p0,f32x16&p1,const char*Kslot,const bf16x8*qr,int r32,int hi){
  const char*kb=Kslot+hi*1024+r32*16;
  #pragma unroll
  for(int d0=0;d0<4;++d0){
    const bf16x8 b0=*reinterpret_cast<const bf16x8*>(kb+d0*2048);
    const bf16x8 b1=*reinterpret_cast<const bf16x8*>(kb+d0*2048+512);
    p0=__builtin_amdgcn_mfma_f32_32x32x16_bf16(b0,qr[d0],p0,0,0,0);p1=__builtin_amdgcn_mfma_f32_32x32x16_bf16(b1,qr[d0],p1,0,0,0);}
}
typedef __attribute__((address_space(3))) const char* lds_cptr;
typedef short v4i16_t __attribute__((ext_vector_type(4)));
__device__ __forceinline__ void kload8(bf16x8*kf,lds_cptr kp){
  kf[0]=*(const __attribute__((address_space(3))) bf16x8*)(kp);      kf[1]=*(const __attribute__((address_space(3))) bf16x8*)(kp+512);
  kf[2]=*(const __attribute__((address_space(3))) bf16x8*)(kp+2048); kf[3]=*(const __attribute__((address_space(3))) bf16x8*)(kp+2560);
  kf[4]=*(const __attribute__((address_space(3))) bf16x8*)(kp+4096); kf[5]=*(const __attribute__((address_space(3))) bf16x8*)(kp+4608);
  kf[6]=*(const __attribute__((address_space(3))) bf16x8*)(kp+6144); kf[7]=*(const __attribute__((address_space(3))) bf16x8*)(kp+6656);
}
__device__ __forceinline__ void kload2(bf16x8*kf,lds_cptr kp,int j){ kf[2*j]=*(const __attribute__((address_space(3))) bf16x8*)(kp+j*2048); kf[2*j+1]=*(const __attribute__((address_space(3))) bf16x8*)(kp+j*2048+512); }
__device__ __forceinline__ s16x4 vtr(lds_cptr p){ return __builtin_bit_cast(s16x4,__builtin_amdgcn_ds_read_tr16_b64_v4i16((__attribute__((address_space(3))) v4i16_t*)p)); }
__device__ __forceinline__ float rowmax(const f32x16&p0,const f32x16&p1){
  float a=max3f(p0[0],p0[1],p1[0]),b=max3f(p0[2],p0[3],p1[1]);a=max3f(a,p1[2],p1[3]);
  #pragma unroll
  for(int r=4;r<16;r+=4){a=max3f(a,p0[r],p0[r+1]);b=max3f(b,p0[r+2],p0[r+3]);a=max3f(a,p1[r],p1[r+1]);b=max3f(b,p1[r+2],p1[r+3]);}
  const float m=max2f(a,b);
  auto rr=__builtin_amdgcn_permlane32_swap(__float_as_uint(m),__float_as_uint(m),false,false);
  return max2f(__uint_as_float(rr[0]),__uint_as_float(rr[1]));
}
__device__ __forceinline__ void pv(f32x16*o,int vb,bf16x8 pa0,bf16x8 pa1,bf16x8 pa2,bf16x8 pa3){
  #pragma unroll
  for(int d0=0;d0<2;++d0){s16x4 lo[4],hi[4];
    #pragma unroll
    for(int ks=0;ks<4;++ks){
      asm volatile("ds_read_b64_tr_b16 %0,%1 offset:%c2":"=&v"(lo[ks]):"v"(vb),"i"(d0*4096+ks*1024):"memory");
      asm volatile("ds_read_b64_tr_b16 %0,%1 offset:%c2":"=&v"(hi[ks]):"v"(vb),"i"(d0*4096+ks*1024+512):"memory");}
    asm volatile("s_waitcnt lgkmcnt(0)":::"memory");SBAR();
    #define PK(k) (bf16x8){lo[k][0],lo[k][1],lo[k][2],lo[k][3],hi[k][0],hi[k][1],hi[k][2],hi[k][3]}
    o[d0]=__builtin_amdgcn_mfma_f32_32x32x16_bf16(pa0,PK(0),o[d0],0,0,0);
    o[d0]=__builtin_amdgcn_mfma_f32_32x32x16_bf16(pa1,PK(1),o[d0],0,0,0);
    o[d0]=__builtin_amdgcn_mfma_f32_32x32x16_bf16(pa2,PK(2),o[d0],0,0,0);
    o[d0]=__builtin_amdgcn_mfma_f32_32x32x16_bf16(pa3,PK(3),o[d0],0,0,0);
    #undef PK
  }
}

#ifndef ATTN_STORE16
#define ATTN_STORE16(p,v) (*(u32x4*)(p)=(v))
#endif
template<int MODE,int THRL,int QP,int KP,int OP> __device__ __forceinline__ void attn_unit(const bf16*Qw0,const bf16*__restrict__ Kh,const bf16*__restrict__ Vh,bf16*Ow0,const int NT,
                                                                                          const float slope2,const bf16*kmh,const bf16*kml,const int qb,char*shm){
  int tid_=threadIdx.x; asm volatile("":"+v"(tid_));
  const int tid=tid_,lane=tid&63,r32=lane&31,hi=lane>>5; const int wid=__builtin_amdgcn_readfirstlane(tid>>6);
  const bf16*Qw=Qw0+(long)(wid*QBLK)*QP;
  const unsigned lds0=(unsigned)(uintptr_t)shm;
  float*wsf=(float*)(shm+LDS_WS)+wid*64;
  const bf16*ksrc=Kh+(long)lane*KP+wid*8;
  const bf16*vsrc=Vh+(long)(16*(wid&3)+(lane>>2))*KP+(wid>>2)*32+(lane&3)*8;
  const unsigned kdst=lds0+LDS_K+wid*1024, vdst=lds0+LDS_V+wid*1024;
  #define DMA_K(t,slot) glds16(ksrc+(long)(t)*KVBLK*KP,(unsigned)__builtin_amdgcn_readfirstlane(kdst+(slot)))
  #define DMA_V(t,slot) glds16(vsrc+(long)(t)*KVBLK*KP,(unsigned)__builtin_amdgcn_readfirstlane(vdst+(slot)))
  const int vb0=(int)(lds0+LDS_V)+((lane>>4)&1)*32+(lane&3)*8+(4*hi+((lane&15)>>2))*64;
  const char*Kbase=shm+LDS_K; bf16x8 kf[8];
  const lds_cptr shm3=(lds_cptr)shm; const lds_cptr kp0=shm3+LDS_K+hi*1024+r32*16; const lds_cptr vp0=shm3+LDS_V+((lane>>4)&1)*32+(lane&3)*8+(4*hi+((lane&15)>>2))*64;
  DMA_K(0,0);DMA_V(0,0);DMA_K(1,SLOTB);
  bf16x8 qr[4];
  #pragma unroll
  for(int d0=0;d0<4;++d0)qr[d0]=*reinterpret_cast<const bf16x8*>(&Qw[(long)r32*QP+d0*16+hi*8]);
  unsigned selm=0xffffffffu;
  if constexpr(MODE==1){
    f32x16 G=f32x16{};
    #pragma unroll
    for(int d0=0;d0<4;++d0){
      bf16x8 ah=bf16x8{},al=bf16x8{};
      if(r32<16){ ah=*reinterpret_cast<const bf16x8*>(&kmh[r32*64+d0*16+hi*8]); al=*reinterpret_cast<const bf16x8*>(&kml[r32*64+d0*16+hi*8]); }
      G=__builtin_amdgcn_mfma_f32_32x32x16_bf16(ah,qr[d0],G,0,0,0); G=__builtin_amdgcn_mfma_f32_32x32x16_bf16(al,qr[d0],G,0,0,0);}
    float g[16];
    #pragma unroll
    for(int r=0;r<4;++r){ const float a=G[r],b=G[4+r]; const float oa=__shfl_xor(a,32),ob=__shfl_xor(b,32);
      g[r]=hi?oa:a; g[4+r]=hi?a:oa; g[8+r]=hi?ob:b; g[12+r]=hi?b:ob; }
    #pragma unroll
    for(int n=0;n<16;++n) if(n>=qb) g[n]=-1.0e30f;
    const int nsel=qb<3?qb:3; unsigned mask=0u;
    #pragma unroll
    for(int rr=0;rr<3;++rr){ float best=-3.0e38f; int bi=0;
      #pragma unroll
      for(int n=0;n<16;++n){ const bool c=!((mask>>n)&1u)&&g[n]>best; best=c?g[n]:best; bi=c?n:bi; }
      if(rr<nsel) mask|=1u<<bi; }
    selm=mask|(1u<<qb);
  }
  float mhat=0.f,l_reg=0.f;f32x16 o[2];o[0]=f32x16{};o[1]=f32x16{};
  const int qrel=wid*QBLK+r32;
  const float hb=(MODE==1)?slope2*(float)(4*hi):0.f, s32=(MODE==1)?32.f*slope2:0.f, s64=(MODE==1)?64.f*slope2:0.f;
  #define CINIT(C0,C1,t) do{ float b0_=fsub_s(fadd_s(s64*(float)(t),hb),mhat); if(MODE==1){ if(!((selm>>((t)>>2))&1u)) b0_=-3.0e38f; } const float b1_=b0_+s32; \
    _Pragma("unroll") for(int r=0;r<16;++r){ if(MODE==1){ C0[r]=__builtin_fmaf(slope2,(float)((r&3)+8*(r>>2)),b0_); C1[r]=__builtin_fmaf(slope2,(float)((r&3)+8*(r>>2)),b1_); } else { C0[r]=b0_; C1[r]=b1_; } } }while(0)
  #define CMASK(P0,P1,t) do{ if(MODE==1){ int jb_=(t)-(NT-4); if(jb_>=0)cmask(P0,P1,jb_,qrel,hi);} }while(0)
  bool resc=false;
  #define START(P0,P1) do{ const float rm=rowmax(P0,P1); resc=false; \
    { const float dl=__builtin_fmaxf(rm,-1000.f); mhat=fadd_s(mhat,dl); \
      _Pragma("unroll") for(int r=0;r<16;++r){P0[r]=fsub_s(P0[r],dl);P1[r]=fsub_s(P1[r],dl);} } \
    _Pragma("unroll") for(int r=0;r<16;++r)P0[r]=__builtin_amdgcn_exp2f(P0[r]); }while(0)
  #define RESC() do{ if(resc){ asm volatile("s_waitcnt lgkmcnt(0)":::"memory"); \
      _Pragma("unroll") for(int d_=0;d_<2;++d_) _Pragma("unroll") for(int r=0;r<16;++r)o[d_][r]*=wsf[crow(r,hi)]; } }while(0)
  f32x16 pA0,pA1,pB0,pB1;
  int sl_prev=0,sl_cur=0,sl_next=SLOTB;
  #define ROT() do{sl_prev=sl_cur;sl_cur=sl_next;sl_next=(sl_next==(NSLOT-1)*SLOTB)?0:sl_next+SLOTB;}while(0)
  DMA_K(2,2*SLOTB);
  WAIT_BAR(3);
  CINIT(pA0,pA1,0);
  qkt(pA0,pA1,Kbase,qr,r32,hi);asm volatile("s_nop 15\n\ts_nop 7":"+v"(pA0),"+v"(pA1));CMASK(pA0,pA1,0);
  START(pA0,pA1);
  _Pragma("unroll") for(int r=0;r<16;++r)pA1[r]=__builtin_amdgcn_exp2f(pA1[r]);
  WAIT_BAR(0);
  DMA_K(3,0);DMA_V(1,SLOTB);
  ROT();
  kload8(kf,kp0+sl_cur);
  WAIT_BAR(2);
  s16x4 vlo[8],vhi[8]; u32x4 pw0,pw1,pw2,pw3;
  #define PKW(P,B) cvtpk_s(P[B],P[B+1])
  #define PAF(k) __builtin_bit_cast(bf16x8,pw##k)
  #define VFR(i) (bf16x8){vlo[i][0],vlo[i][1],vlo[i][2],vlo[i][3],vhi[i][0],vhi[i][1],vhi[i][2],vhi[i][3]}
  #define PIN(x) asm volatile("":"+v"(x))
  #define MX3(a,b,c) __builtin_fmaxf(__builtin_fmaxf((a),(b)),(c))
  #define GAPA(MF,A0,A1,A2,A3,W0,W1,PW) do{ MF; sacc+=A0; sacc+=A1; sacc+=A2; sacc+=A3; PIN(sacc); W0; W1; PIN(PW); SBAR(); }while(0)
  #define EX(v) __builtin_amdgcn_exp2f(v)
  #define GAPB(MF,X,B) do{ MF; X[B]=EX(X[B]); X[B+1]=EX(X[B+1]); X[B+2]=EX(X[B+2]); X[B+3]=EX(X[B+3]); PIN(X); SBAR(); }while(0)
  #define VRD(i) do{ vlo[i]=vtr(vp_+(((i)>>2)*4096+((i)&3)*1024)); vhi[i]=vtr(vp_+(((i)>>2)*4096+((i)&3)*1024+512)); }while(0)
  #define KRD(G,j) do{ if(G){ kload2(kf,kp0+sl_next,j); SBAR(); } }while(0)
  #define STEP(C0,C1,P0,P1,t,GK,GV,GL) do{ CINIT(C0,C1,t); PIN(C0); PIN(C1); SBAR(); \
    const lds_cptr vp_=vp0+sl_prev; \
    VRD(0); SBAR(); float sacc=(P0[0]+P0[1]); \
    GAPA(C0=__builtin_amdgcn_mfma_f32_32x32x16_bf16(kf[0],qr[0],C0,0,0,0), P0[2],P0[3],P0[4],P0[5],     pw0[0]=PKW(P0,0), pw0[1]=PKW(P0,2), pw0); \
    VRD(4); SBAR(); GAPA(C1=__builtin_amdgcn_mfma_f32_32x32x16_bf16(kf[1],qr[0],C1,0,0,0), P0[6],P0[7],P0[8],P0[9],     pw0[2]=PKW(P0,4), pw0[3]=PKW(P0,6), pw0); \
    VRD(1); SBAR(); GAPA(C0=__builtin_amdgcn_mfma_f32_32x32x16_bf16(kf[2],qr[1],C0,0,0,0),   P0[10],P0[11],P0[12],P0[13], pw1[0]=PKW(P0,8), pw1[1]=PKW(P0,10), pw1); \
    VRD(5); SBAR(); GAPA(C1=__builtin_amdgcn_mfma_f32_32x32x16_bf16(kf[3],qr[1],C1,0,0,0),   P0[14],P0[15],P1[0],P1[1],   pw1[2]=PKW(P0,12),pw1[3]=PKW(P0,14), pw1); \
    VRD(2); SBAR(); GAPA(C0=__builtin_amdgcn_mfma_f32_32x32x16_bf16(kf[4],qr[2],C0,0,0,0),   P1[2],P1[3],P1[4],P1[5],     pw2[0]=PKW(P1,0), pw2[1]=PKW(P1,2), pw2); \
    VRD(6); SBAR(); GAPA(C1=__builtin_amdgcn_mfma_f32_32x32x16_bf16(kf[5],qr[2],C1,0,0,0),   P1[6],P1[7],P1[8],P1[9],     pw2[2]=PKW(P1,4), pw2[3]=PKW(P1,6), pw2); \
    VRD(3); SBAR(); GAPA(C0=__builtin_amdgcn_mfma_f32_32x32x16_bf16(kf[6],qr[3],C0,0,0,0),   P1[10],P1[11],P1[12],P1[13], pw3[0]=PKW(P1,8), pw3[1]=PKW(P1,10), pw3); \
    VRD(7); SBAR(); GAPA(C1=__builtin_amdgcn_mfma_f32_32x32x16_bf16(kf[7],qr[3],C1,0,0,0),   P1[14],P1[15],0.f,0.f,       pw3[2]=PKW(P1,12),pw3[3]=PKW(P1,14), pw3); \
    l_reg+=sacc; \
    if(GK){DMA_K((t)+3,sl_cur);} if(GV){DMA_V((t)+1,sl_next);} \
    CMASKX(C0,C1,t); \
    { float a=MX3(C0[0],C0[1],C1[0]),b=MX3(C0[2],C0[3],C1[1]); a=MX3(a,C1[2],C1[3]); \
      _Pragma("unroll") for(int r=4;r<16;r+=4){a=MX3(a,C0[r],C0[r+1]);b=MX3(b,C0[r+2],C0[r+3]);a=MX3(a,C1[r],C1[r+1]);b=MX3(b,C1[r+2],C1[r+3]);} \
      float rm=__builtin_fmaxf(a,b); { auto rr=__builtin_amdgcn_permlane32_swap(__float_as_uint(rm),__float_as_uint(rm),false,false); rm=__builtin_fmaxf(__uint_as_float(rr[0]),__uint_as_float(rr[1])); } \
      resc=false; \
      if(__builtin_expect(__any(rm>(float)THRL),0)){ const float dl=__builtin_fmaxf(rm,0.f); mhat+=dl; \
        _Pragma("unroll") for(int r=0;r<16;++r){C0[r]-=dl;C1[r]-=dl;} \
        const float f=__builtin_amdgcn_exp2f(-dl); l_reg*=f; if(hi==0)wsf[r32]=f; resc=true; } } \
    SBAR(); \
    GAPB(o[0]=__builtin_amdgcn_mfma_f32_32x32x16_bf16(PAF(0),VFR(0),o[0],0,0,0), C0,0); \
    GAPB(o[1]=__builtin_amdgcn_mfma_f32_32x32x16_bf16(PAF(0),VFR(4),o[1],0,0,0), C0,4); \
    KRD(GL,0); GAPB(o[0]=__builtin_amdgcn_mfma_f32_32x32x16_bf16(PAF(1),VFR(1),o[0],0,0,0), C0,8); \
    KRD(GL,1); GAPB(o[1]=__builtin_amdgcn_mfma_f32_32x32x16_bf16(PAF(1),VFR(5),o[1],0,0,0), C0,12); \
    KRD(GL,2); GAPB(o[0]=__builtin_amdgcn_mfma_f32_32x32x16_bf16(PAF(2),VFR(2),o[0],0,0,0), C1,0); \
    KRD(GL,3); GAPB(o[1]=__builtin_amdgcn_mfma_f32_32x32x16_bf16(PAF(2),VFR(6),o[1],0,0,0), C1,4); \
    GAPB(o[0]=__builtin_amdgcn_mfma_f32_32x32x16_bf16(PAF(3),VFR(3),o[0],0,0,0), C1,8); \
    GAPB(o[1]=__builtin_amdgcn_mfma_f32_32x32x16_bf16(PAF(3),VFR(7),o[1],0,0,0), C1,12); \
    }while(0)
  int t=1;
  #define CMASKX(P0,P1,t) do{}while(0)
  for(;t+5<NT;t+=2){
    STEP(pB0,pB1,pA0,pA1,t,true,true,true);     WAIT_BAR(2); RESC(); ROT();
    STEP(pA0,pA1,pB0,pB1,t+1,true,true,true);   WAIT_BAR(2); RESC(); ROT();
  }
  #undef CMASKX
  #define CMASKX(P0,P1,t) CMASK(P0,P1,t)
  #define ENDW(tt) do{ if((tt)+3<NT){WAIT_BAR(2);} else if((tt)+2<NT){WAIT_BAR(1);} else {WAIT_BAR(0);} }while(0)
  for(;t+1<NT;t+=2){
    STEP(pB0,pB1,pA0,pA1,t,(t+3<NT),(t+1<NT),(t+1<NT));       ENDW(t);   RESC(); ROT();
    STEP(pA0,pA1,pB0,pB1,t+1,(t+4<NT),(t+2<NT),(t+2<NT));     ENDW(t+1); RESC(); ROT();
  }
  STEP(pB0,pB1,pA0,pA1,NT-1,false,false,false); RESC();
  { float sacc=pB0[0]+pB0[1]; _Pragma("unroll") for(int r=2;r<16;++r)sacc+=pB0[r]; _Pragma("unroll") for(int r=0;r<16;++r)sacc+=pB1[r]; l_reg+=sacc;
    pw0=(u32x4){PKW(pB0,0),PKW(pB0,2),PKW(pB0,4),PKW(pB0,6)};pw1=(u32x4){PKW(pB0,8),PKW(pB0,10),PKW(pB0,12),PKW(pB0,14)};pw2=(u32x4){PKW(pB1,0),PKW(pB1,2),PKW(pB1,4),PKW(pB1,6)};pw3=(u32x4){PKW(pB1,8),PKW(pB1,10),PKW(pB1,12),PKW(pB1,14)};
    SBAR(); pv(o,vb0+sl_cur,PAF(0),PAF(1),PAF(2),PAF(3)); }
  #undef PKW
  #undef PAF
  #undef VFR
  #undef PIN
  #undef MX3
  #undef GAPA
  #undef GAPB
  #undef EX
  #undef VRD
  #undef KRD
  #undef STEP
  #undef ENDW
  #undef CMASKX
  {auto rr=__builtin_amdgcn_permlane32_swap(__float_as_uint(l_reg),__float_as_uint(l_reg),false,false);l_reg=__uint_as_float(rr[0])+__uint_as_float(rr[1]);}
  if(hi==0)wsf[32+r32]=l_reg;asm volatile("s_waitcnt lgkmcnt(0)":::"memory");
  float rli[16];
  #pragma unroll
  for(int r=0;r<16;++r)rli[r]=__builtin_amdgcn_rcpf(wsf[32+crow(r,hi)]);
  bf16*Ow=Ow0+(long)(wid*QBLK)*OP;
  { bf16*stg=(bf16*)(shm+LDS_OST)+wid*2048;
    #pragma unroll
    for(int r=0;r<16;++r){const int orow=crow(r,hi);
      #pragma unroll
      for(int d0=0;d0<2;++d0)stg[orow*64+d0*32+r32]=__float2bfloat16(o[d0][r]*rli[r]);}
    asm volatile("s_waitcnt lgkmcnt(0)":::"memory");
    #pragma unroll
    for(int i=0;i<4;++i){const int row=i*8+(lane>>3),ch=lane&7; const u32x4 v=*(const u32x4*)(stg+row*64+ch*8); ATTN_STORE16(Ow+(long)row*OP+ch*8,v);} }
  asm volatile("s_waitcnt lgkmcnt(0)\n\ts_barrier":::"memory");
  #undef DMA_K
  #undef DMA_V
  #undef CMASK
  #undef CINIT
  #undef START
  #undef RESC
  #undef ROT
}
constexpr int ATTN_LDS_BYTES=LDS_BYTES;
#undef SBAR
#undef WAIT_BAR
}
__device__ __forceinline__ float wave_sum(float v) {
#pragma unroll
    for (int o = 1; o < 64; o <<= 1) v += __shfl_xor(v, o);
    return v;
}
__device__ __forceinline__ float wave_max(float v) {
#pragma unroll
    for (int o = 1; o < 64; o <<= 1) v = fmaxf(v, __shfl_xor(v, o));
    return v;
}
__device__ __forceinline__ int opaque_zero() { int z; asm volatile("v_mov_b32 %0, 0" : "=v"(z)); return z; }

__device__ __forceinline__ void p0_transpose_item(const float* W, int K, int N, bf16* WT, int dest_row0, int k0, int n0, const float* gk, LAS float* scr, int lane) {
#pragma unroll 8
    for (int i = 0; i < 32; ++i) { const int kk = 2 * i + (lane >> 5); float v = W[(size_t)(k0 + kk) * N + n0 + (lane & 31)]; if (gk) v *= gk[k0 + kk]; scr[kk * 33 + (lane & 31)] = v; }
    LDS_WAIT(); asm volatile("" ::: "memory");
    const int c = lane & 7;
#pragma unroll
    for (int j = 0; j < 4; ++j) { const int n = (lane >> 3) + 8 * j; const LAS float* s = scr + (8 * c) * 33 + n;
        v4u o; o.x = pk2(s[0 * 33], s[1 * 33]); o.y = pk2(s[2 * 33], s[3 * 33]); o.z = pk2(s[4 * 33], s[5 * 33]); o.w = pk2(s[6 * 33], s[7 * 33]);
        *(GAS v4u*)(WT + (size_t)(dest_row0 + n) * K + k0 + 8 * c) = o; }
    LDS_WAIT(); asm volatile("" ::: "memory");
}
__device__ __forceinline__ void p0_matrix_item(const float* W, int K, int N, bf16* WT, const float* gk, int mode, int item, LAS float* scr, int lane) {
    const int nblk = N / 32, kb = item / nblk, nb = item - kb * nblk, k0 = 64 * kb, n0 = 32 * nb;
    const int dr = (mode == 0) ? n0 : (256 * (n0 >> 7) + (n0 & 127) + (mode == 2 ? 128 : 0));
    p0_transpose_item(W, K, N, WT, dr, k0, n0, gk, scr, lane);
}
__device__ __forceinline__ void row_to_bf16_ssq(const float* xrow, bf16* orow, float* ssq16, int lane) {
    const GAS f32x4* xr = (const GAS f32x4*)xrow + lane;
    f32x4 v[4]; float s = 0.f;
#pragma unroll
    for (int j = 0; j < 4; ++j) { v[j] = xr[64 * j]; s += (v[j].x * v[j].x + v[j].y * v[j].y) + (v[j].z * v[j].z + v[j].w * v[j].w); }
    s = wave_sum(s);
    GAS unsigned long long* o8 = (GAS unsigned long long*)orow + lane;
#pragma unroll
    for (int j = 0; j < 4; ++j) o8[64 * j] = (unsigned long long)pk2(v[j].x, v[j].y) | ((unsigned long long)pk2(v[j].z, v[j].w) << 32);
    if (lane < 16) ssq16[lane] = (lane == 0) ? s : 0.f;
}

__device__ __forceinline__ void s5_naive_unit(int b, int g, const bf16* U, bf16* Y, const float* lam_re, const float* lam_im, const float* log_dt, const float* b_re, const float* b_im,
                                              const float* c_re, const float* c_im, const float* dvec, int lane) {
    const int p = lane;
    const float lr = lam_re[g * 64 + p], li = lam_im[g * 64 + p], dt = expf(log_dt[g]);
    const float mag = expf(lr * dt), ar = mag * cosf(li * dt), ai = mag * sinf(li * dt);
    const float den = lr * lr + li * li, nr = ar - 1.0f, fr = (nr * lr + ai * li) / den, fi = (ai * lr - nr * li) / den;
    float bbr[16], bbi[16], cr[16], ci[16];
#pragma unroll
    for (int c = 0; c < 16; ++c) { const float br = b_re[((size_t)g * 64 + p) * 16 + c], bi = b_im[((size_t)g * 64 + p) * 16 + c]; bbr[c] = fr * br - fi * bi; bbi[c] = fr * bi + fi * br;
        cr[c] = c_re[((size_t)g * 16 + c) * 64 + p]; ci[c] = c_im[((size_t)g * 16 + c) * 64 + p]; }
    const int ch = ((lane & 1) << 3) | ((lane & 2) << 1) | ((lane & 4) >> 1) | ((lane & 8) >> 3);
    const float dch = dvec[16 * g + ch];
    const int z0 = opaque_zero();
    constexpr int TP = 16;
    const bf16* up = U + ((size_t)g * TOK + (size_t)b * SEQ) * 16 + z0;
    bf16* yp = Y + ((size_t)g * TOK + (size_t)b * SEQ) * 16 + ch;
    float xr = 0.f, xi = 0.f;
#pragma unroll 2
    for (int s = 0; s < SEQ; ++s) {
        const v4u w0 = *(const GAS v4u*)(up + (size_t)s * TP), w1 = *(const GAS v4u*)(up + (size_t)s * TP + 8);
        const float uch = bf2f(up[(size_t)s * TP + ch]);
        const float uu[16] = {bflo(w0.x), bfhi(w0.x), bflo(w0.y), bfhi(w0.y), bflo(w0.z), bfhi(w0.z), bflo(w0.w), bfhi(w0.w), bflo(w1.x), bfhi(w1.x), bflo(w1.y), bfhi(w1.y), bflo(w1.z), bfhi(w1.z), bflo(w1.w), bfhi(w1.w)};
        float bur = 0.f, bui = 0.f;
#pragma unroll
        for (int c = 0; c < 16; ++c) { bur += bbr[c] * uu[c]; bui += bbi[c] * uu[c]; }
        const float nxr = ar * xr - ai * xi + bur, nxi = ar * xi + ai * xr + bui; xr = nxr; xi = nxi;
        float v[16];
#pragma unroll
        for (int c = 0; c < 16; ++c) v[c] = cr[c] * xr - ci[c] * xi;
        float w[8], x4[4], x2[2], z;
        { const bool bit = lane & 1;
#pragma unroll
          for (int j = 0; j < 8; ++j) { const float send = bit ? v[j] : v[j + 8], keep = bit ? v[j + 8] : v[j]; w[j] = keep + __shfl_xor(send, 1); } }
        { const bool bit = lane & 2;
#pragma unroll
          for (int j = 0; j < 4; ++j) { const float send = bit ? w[j] : w[j + 4], keep = bit ? w[j + 4] : w[j]; x4[j] = keep + __shfl_xor(send, 2); } }
        { const bool bit = lane & 4;
#pragma unroll
          for (int j = 0; j < 2; ++j) { const float send = bit ? x4[j] : x4[j + 2], keep = bit ? x4[j + 2] : x4[j]; x2[j] = keep + __shfl_xor(send, 4); } }
        { const bool bit = lane & 8; const float send = bit ? x2[0] : x2[1], keep = bit ? x2[1] : x2[0]; z = keep + __shfl_xor(send, 8); }
        z += __shfl_xor(z, 16); z += __shfl_xor(z, 32);
        const float yv = z + dch * uch;
        const float ge = 0.5f * yv * (1.0f + erff(yv * 0.70710678118654752f));
        if (lane < 16) yp[(size_t)s * TP] = (bf16)f2bf(ge);
    }
}

__device__ __forceinline__ void memattn_naive_unit(int tok, int h, const bf16* QM, const bf16* memk, const bf16* memv, bf16* mix, LAS float* ps, int lane) {
    const int b = tok >> 12; const int z0 = opaque_zero();
    const float qv = bf2f(QM[(size_t)tok * 256 + h * 64 + lane]);
    float q[64];
#pragma unroll
    for (int d = 0; d < 64; ++d) q[d] = __shfl(qv, d);
    float sc[4];
#pragma unroll
    for (int i = 0; i < 4; ++i) { const int j = lane + 64 * i; const GAS v4u* kr = (const GAS v4u*)(memk + ((size_t)(b * 256 + j)) * 256 + h * 64 + z0); float a = 0.f;
#pragma unroll
        for (int c = 0; c < 8; ++c) { const v4u w = kr[c]; a += q[8 * c] * bflo(w.x) + q[8 * c + 1] * bfhi(w.x) + q[8 * c + 2] * bflo(w.y) + q[8 * c + 3] * bfhi(w.y) + q[8 * c + 4] * bflo(w.z) + q[8 * c + 5] * bfhi(w.z) + q[8 * c + 6] * bflo(w.w) + q[8 * c + 7] * bfhi(w.w); }
        sc[i] = a; }
    const float m = wave_max(fmaxf(fmaxf(sc[0], sc[1]), fmaxf(sc[2], sc[3])));
    float l = 0.f;
#pragma unroll
    for (int i = 0; i < 4; ++i) { const float pe = __builtin_amdgcn_exp2f(sc[i] - m); l += pe; ps[lane + 64 * i] = pe; }
    l = wave_sum(l);
    LDS_WAIT(); asm volatile("" ::: "memory");
    float o = 0.f; const bf16* vp = memv + (size_t)(b * 256) * 256 + h * 64 + lane;
#pragma unroll 8
    for (int j = 0; j < 256; ++j) o += ps[j] * bf2f(vp[(size_t)j * 256]);
    mix[(size_t)tok * 1024 + 768 + h * 64 + lane] = (bf16)f2bf(o / l);
    LDS_WAIT(); asm volatile("" ::: "memory");
}

__device__ __forceinline__ float dot64_bf16(const float (&q)[64], const GAS v4u* kr) {
    float a = 0.f;
#pragma unroll
    for (int c = 0; c < 8; ++c) { const v4u w = kr[c]; a += q[8 * c] * bflo(w.x) + q[8 * c + 1] * bfhi(w.x) + q[8 * c + 2] * bflo(w.y) + q[8 * c + 3] * bfhi(w.y) + q[8 * c + 4] * bflo(w.z) + q[8 * c + 5] * bfhi(w.z) + q[8 * c + 6] * bflo(w.w) + q[8 * c + 7] * bfhi(w.w); }
    return a;
}
__device__ __forceinline__ void moba_naive_unit(int tok, int h, const bf16* Q1, const bf16* K1, const bf16* V1, const float* KMEAN, bf16* mix, LAS float* ps, int lane) {
    const int b = tok >> 12, s = tok & (SEQ - 1), qb = s >> 8; const int z0 = opaque_zero();
    const float qv = bf2f(Q1[(size_t)tok * TOKW + h * 64 + lane]);
    float q[64];
#pragma unroll
    for (int d = 0; d < 64; ++d) q[d] = __shfl(qv, d);
    float gate = -1e30f;
    { const int n = lane & 15; const GAS f32x4* km = (const GAS f32x4*)(KMEAN + ((size_t)((b * NHEAD + h) * NBLK + n)) * 64 + z0); float a = 0.f;
#pragma unroll
      for (int c = 0; c < 16; ++c) { const f32x4 w = km[c]; a += q[4 * c] * w.x + q[4 * c + 1] * w.y + q[4 * c + 2] * w.z + q[4 * c + 3] * w.w; }
      if (n < qb) gate = a; }
    float g[16];
#pragma unroll
    for (int n = 0; n < 16; ++n) g[n] = __shfl(gate, n);
    const int nsel = qb < 3 ? qb : 3;
    unsigned mask = 0u;
#pragma unroll
    for (int r = 0; r < 3; ++r) { float best = -3.0e38f; int bi = 0;
#pragma unroll
        for (int n = 0; n < 16; ++n) { const bool c = !((mask >> n) & 1u) && g[n] > best; best = c ? g[n] : best; bi = c ? n : bi; }
        if (r < nsel) mask |= 1u << bi; }
    int blk0 = 0, blk1 = 0, blk2 = 0, cnt = 0;
#pragma unroll
    for (int n = 0; n < 16; ++n) if ((mask >> n) & 1u) { if (cnt == 0) blk0 = n; else if (cnt == 1) blk1 = n; else blk2 = n; ++cnt; }
    const int nslots = nsel + 1;
    const float slope = __builtin_amdgcn_exp2f(-8.0f * (float)(h + 1) / 12.0f) * LOG2E;
    const bf16* kh = K1 + (size_t)b * SEQ * TOKW + h * 64 + z0;
    float mx = -3.0e38f;
#pragma unroll
    for (int sl = 0; sl < 4; ++sl) if (sl < nslots) {
        const int blk = (sl == nsel) ? qb : (sl == 0 ? blk0 : (sl == 1 ? blk1 : blk2));
#pragma unroll
        for (int i = 0; i < 4; ++i) { const int j = lane + 64 * i, pos = blk * 256 + j;
            float a = dot64_bf16(q, (const GAS v4u*)(kh + (size_t)pos * TOKW)) + slope * (float)(pos - s);
            if (pos > s) a = -3.0e38f;
            ps[sl * 256 + j] = a; mx = fmaxf(mx, a); } }
    mx = wave_max(mx);
    LDS_WAIT(); asm volatile("" ::: "memory");
    float l = 0.f;
#pragma unroll
    for (int sl = 0; sl < 4; ++sl) if (sl < nslots) {
#pragma unroll
        for (int i = 0; i < 4; ++i) { const int j = lane + 64 * i; const float a = ps[sl * 256 + j]; const float pe = (a < -1.0e37f) ? 0.f : __builtin_amdgcn_exp2f(a - mx); l += pe; ps[sl * 256 + j] = pe; } }
    l = wave_sum(l);
    LDS_WAIT(); asm volatile("" ::: "memory");
    float o = 0.f; const bf16* vh = V1 + (size_t)b * SEQ * TOKW + h * 64 + lane;
#pragma unroll
    for (int sl = 0; sl < 4; ++sl) if (sl < nslots) {
        const int blk = (sl == nsel) ? qb : (sl == 0 ? blk0 : (sl == 1 ? blk1 : blk2));
        const bf16* vp = vh + (size_t)(blk * 256) * TOKW;
#pragma unroll 8
        for (int j = 0; j < 256; ++j) o += ps[sl * 256 + j] * bf2f(vp[(size_t)j * TOKW]); }
    mix[(size_t)tok * 1024 + h * 64 + lane] = (bf16)f2bf(o / l);
    LDS_WAIT(); asm volatile("" ::: "memory");
}

constexpr int S5_PITCH = 272;
constexpr int S5_WST = 0, S5_WYC = 128 * S5_PITCH, S5_KT = 2 * 128 * S5_PITCH, S5_TAB_BYTES = S5_KT + 9 * 512;
constexpr int S5_XS = S5_TAB_BYTES, S5_XS_BYTES = 32 * S5_PITCH;
static_assert(S5_XS + NWAVES * S5_XS_BYTES <= RING_BYTES, "S5 LDS map");
typedef short s5_bf16x8 __attribute__((ext_vector_type(8)));
typedef float s5_f32x16 __attribute__((ext_vector_type(16)));

__device__ __forceinline__ void s5_apow(float lr, float li, float dt, int n, float& pr, float& pi) { const float m = expf(lr * dt * (float)n), th = li * dt * (float)n; pr = m * cosf(th); pi = m * sinf(th); }
__device__ __forceinline__ void s5_zoh(float lr, float li, float dt, float& fr, float& fi) {
    float ar, ai; s5_apow(lr, li, dt, 1, ar, ai); const float den = lr * lr + li * li, nr = ar - 1.0f; fr = (nr * lr + ai * li) / den; fi = (ai * lr - nr * li) / den;
}
__device__ __forceinline__ void s5_tab_wst(int g, int jt, unsigned char* tab, const float* lam_re, const float* lam_im, const float* log_dt, const float* b_re, const float* b_im, int lane) {
    const int s = lane >> 3, cp = lane & 7; const float dt = expf(log_dt[g]);
    for (int r = 0; r < 32; ++r) { const int p = (jt >> 1) * 32 + r; const float lr = lam_re[g * 64 + p], li = lam_im[g * 64 + p];
        float pr, pi, fr, fi; s5_apow(lr, li, dt, 7 - s, pr, pi); s5_zoh(lr, li, dt, fr, fi);
        float o[2];
#pragma unroll
        for (int e = 0; e < 2; ++e) { const int c = 2 * cp + e; const float br = b_re[((size_t)g * 64 + p) * 16 + c], bi = b_im[((size_t)g * 64 + p) * 16 + c];
            const float bbr = fr * br - fi * bi, bbi = fr * bi + fi * br; o[e] = (jt & 1) ? (pr * bbi + pi * bbr) : (pr * bbr - pi * bbi); }
        *(GAS unsigned*)(tab + S5_WST + (32 * jt + r) * S5_PITCH + (16 * s + 2 * cp) * 2) = pk2(o[0], o[1]); }
}
__device__ __forceinline__ void s5_tab_wyc(int g, int t, unsigned char* tab, const float* lam_re, const float* lam_im, const float* log_dt, const float* c_re, const float* c_im, int lane) {
    const int p = lane; const float dt = expf(log_dt[g]); float pr, pi; s5_apow(lam_re[g * 64 + p], lam_im[g * 64 + p], dt, t + 1, pr, pi);
    for (int c = 0; c < 16; ++c) { const float cr = c_re[((size_t)g * 16 + c) * 64 + p], ci = c_im[((size_t)g * 16 + c) * 64 + p];
        *(GAS unsigned*)(tab + S5_WYC + (16 * t + c) * S5_PITCH + 4 * p) = pk2(cr * pr - ci * pi, -(cr * pi + ci * pr)); }
}
__device__ __forceinline__ void s5_tab_kt(int g, int d, unsigned char* tab, const float* lam_re, const float* lam_im, const float* log_dt, const float* b_re, const float* b_im, const float* c_re, const float* c_im,
                                          const float* dvec, int lane) {
    const float dt = expf(log_dt[g]); float mr, mi;
    { const float lr = lam_re[g * 64 + lane], li = lam_im[g * 64 + lane]; float pr, pi, fr, fi; s5_apow(lr, li, dt, d, pr, pi); s5_zoh(lr, li, dt, fr, fi); mr = pr * fr - pi * fi; mi = pr * fi + pi * fr; }
    float acc[4] = {0.f, 0.f, 0.f, 0.f};
    for (int p = 0; p < 64; ++p) { const float pmr = __shfl(mr, p), pmi = __shfl(mi, p);
#pragma unroll
        for (int i = 0; i < 4; ++i) { const int e = lane + 64 * i, c = e >> 4, c2 = e & 15;
            const float br = b_re[((size_t)g * 64 + p) * 16 + c2], bi = b_im[((size_t)g * 64 + p) * 16 + c2], cr = c_re[((size_t)g * 16 + c) * 64 + p], ci = c_im[((size_t)g * 16 + c) * 64 + p];
            const float tr = pmr * br - pmi * bi, ti = pmr * bi + pmi * br; acc[i] += cr * tr - ci * ti; } }
#pragma unroll
    for (int i = 0; i < 4; ++i) { const int e = lane + 64 * i, c = e >> 4, c2 = e & 15; float v = acc[i]; if (d == 0 && c == c2) v += dvec[16 * g + c];
        *(GAS bf16*)(tab + S5_KT + (d + 1) * 512 + c * 32 + c2 * 2) = (bf16)f2bf(v);
        if (d == 0) *(GAS bf16*)(tab + S5_KT + c * 32 + c2 * 2) = (bf16)0; }
}

template <bool FINAL>
__device__ __forceinline__ void s5_unit(int g, int seg, const bf16* Ug, bf16* Yg, const unsigned char* tab, float* Ebuf, const float* lam_re, const float* lam_im, const float* log_dt, LAS unsigned char* L) {
    int tid_ = threadIdx.x; asm volatile("" : "+v"(tid_));
    const int tid = tid_, lane = tid & 63, r32 = lane & 31, hi = lane >> 5, b = __builtin_amdgcn_readfirstlane(tid >> 6);
    { const int npc = (FINAL ? S5_TAB_BYTES : S5_WYC) / 16; const GAS v4u* src = (const GAS v4u*)tab; LAS v4u* dst = (LAS v4u*)L;
      for (int i = tid; i < npc; i += NWAVES * 64) dst[i] = src[i]; }
    const size_t tok0 = (size_t)g * TOK + (size_t)b * SEQ + (size_t)seg * 256;
    s5_bf16x8 A[8];
    { const bf16* up = Ug + (tok0 + 8 * r32) * 16 + 8 * hi;
#pragma unroll
      for (int s = 0; s < 8; ++s) A[s] = *(const GAS s5_bf16x8*)(up + s * 16); }
    float aLr[2], aLi[2], aSr[2], aSi[2];
    { const float dt = expf(log_dt[g]);
#pragma unroll
      for (int k = 0; k < 2; ++k) { float xr, xi; s5_apow(lam_re[g * 64 + 32 * k + r32], lam_im[g * 64 + 32 * k + r32], dt, 1, xr, xi);
#pragma unroll
          for (int q = 0; q < 3; ++q) { const float nr = xr * xr - xi * xi, ni = 2.0f * xr * xi; xr = nr; xi = ni; }
          aLr[k] = xr; aLi[k] = xi;
#pragma unroll
          for (int q = 0; q < 5; ++q) { const float nr = xr * xr - xi * xi, ni = 2.0f * xr * xi; xr = nr; xi = ni; }
          aSr[k] = xr; aSi[k] = xi; } }
    float cr[2] = {0.f, 0.f}, ci[2] = {0.f, 0.f};
    if (FINAL) {
        const float* eb = Ebuf + ((size_t)(b * NGRP + g) * 16) * 128;
        for (int j = 0; j < seg; ++j) {
#pragma unroll
            for (int k = 0; k < 2; ++k) { const f32x2 e = *(const GAS f32x2*)(eb + (size_t)j * 128 + 2 * (32 * k + r32));
                const float nr = aSr[k] * cr[k] - aSi[k] * ci[k] + e.x, ni = aSr[k] * ci[k] + aSi[k] * cr[k] + e.y; cr[k] = nr; ci[k] = ni; } }
    }
    __syncthreads();
    s5_f32x16 S[4];
#pragma unroll
    for (int j = 0; j < 4; ++j) { S[j] = s5_f32x16{};
#pragma unroll
        for (int s = 0; s < 8; ++s) { const s5_bf16x8 bf = *(const LAS s5_bf16x8*)(L + S5_WST + (32 * j + r32) * S5_PITCH + (16 * s + 8 * hi) * 2);
            S[j] = __builtin_amdgcn_mfma_f32_32x32x16_bf16(A[s], bf, S[j], 0, 0, 0); } }
#pragma unroll
    for (int i = 0; i < 8; ++i) { const bool own = ((i & 1) == hi);
#pragma unroll
        for (int q = 0; q < 4; ++q) { const int reg = 4 * (i >> 1) + q;
#pragma unroll
            for (int k = 0; k < 2; ++k) { const float sr = S[2 * k][reg], si = S[2 * k + 1][reg];
                const float nr = aLr[k] * cr[k] - aLi[k] * ci[k] + sr, ni = aLr[k] * ci[k] + aLi[k] * cr[k] + si;
                S[2 * k][reg] = own ? cr[k] : sr; S[2 * k + 1][reg] = own ? ci[k] : si; cr[k] = own ? nr : cr[k]; ci[k] = own ? ni : ci[k]; } }
#pragma unroll
        for (int k = 0; k < 2; ++k) { const float orr = __shfl_xor(cr[k], 32), oi = __shfl_xor(ci[k], 32); cr[k] = own ? cr[k] : orr; ci[k] = own ? ci[k] : oi; } }
    if (!FINAL) {
        if (hi == 0) { float* eb = Ebuf + ((size_t)(b * NGRP + g) * 16 + seg) * 128;
#pragma unroll
            for (int k = 0; k < 2; ++k) *(GAS f32x2*)(eb + 2 * (32 * k + r32)) = (f32x2){cr[k], ci[k]}; }
    } else {
        LAS unsigned char* XS = L + S5_XS + b * S5_XS_BYTES;
#pragma unroll
        for (int reg = 0; reg < 16; ++reg) { const int chunk = (reg & 3) + 8 * (reg >> 2) + 4 * hi;
#pragma unroll
            for (int k = 0; k < 2; ++k) *(LAS unsigned*)(XS + chunk * S5_PITCH + 4 * (32 * k + r32)) = pk2(S[2 * k][reg], S[2 * k + 1][reg]); }
        s5_bf16x8 Xf[8];
#pragma unroll
        for (int kk = 0; kk < 8; ++kk) Xf[kk] = *(const LAS s5_bf16x8*)(XS + r32 * S5_PITCH + (16 * kk + 8 * hi) * 2);
        s5_f32x16 Yc[4];
#pragma unroll
        for (int j = 0; j < 4; ++j) { Yc[j] = s5_f32x16{};
#pragma unroll
            for (int s = 0; s < 8; ++s) if (s <= 2 * j + 1) { const int d1 = 2 * j + (r32 >> 4) - s + 1;
                const s5_bf16x8 bf = *(const LAS s5_bf16x8*)(L + S5_KT + d1 * 512 + (r32 & 15) * 32 + 16 * hi);
                Yc[j] = __builtin_amdgcn_mfma_f32_32x32x16_bf16(A[s], bf, Yc[j], 0, 0, 0); }
#pragma unroll
            for (int kk = 0; kk < 8; ++kk) { const s5_bf16x8 bf = *(const LAS s5_bf16x8*)(L + S5_WYC + (32 * j + r32) * S5_PITCH + (16 * kk + 8 * hi) * 2);
                Yc[j] = __builtin_amdgcn_mfma_f32_32x32x16_bf16(Xf[kk], bf, Yc[j], 0, 0, 0); } }
        asm volatile("s_waitcnt lgkmcnt(0)" ::: "memory");
#pragma unroll
        for (int j = 0; j < 4; ++j)
#pragma unroll
            for (int reg = 0; reg < 16; reg += 2) { const pg8::f32x2 ge = pg8::gelu_pk((pg8::f32x2){Yc[j][reg], Yc[j][reg + 1]});
                const int chunk = (reg & 3) + 8 * (reg >> 2) + 4 * hi, tokl = 8 * chunk + 2 * j + (r32 >> 4), c = r32 & 15;
                *(LAS bf16*)(XS + tokl * 32 + c * 2) = (bf16)f2bf(ge.x); *(LAS bf16*)(XS + (tokl + 8) * 32 + c * 2) = (bf16)f2bf(ge.y); }
        asm volatile("s_waitcnt lgkmcnt(0)" ::: "memory");
        bf16* yo = Yg + tok0 * 16;
#pragma unroll
        for (int i = 0; i < 8; ++i) { const int pc = lane + 64 * i; const v4u w = *(const LAS v4u*)(XS + 16 * pc); *(GAS v4u*)(yo + 8 * pc) = w; }
    }
    __syncthreads();
}

#ifndef MK_ONE_LAUNCH
#define MK_ONE_LAUNCH 1
#endif
constexpr int N_PHASES = 15;
struct Args { const float* in[23]; float* out; unsigned char* ws; int ph_lo, ph_hi; };

__global__ void __launch_bounds__(NWAVES * 64, 2) mega_fwd(Args args) {
    extern __shared__ __attribute__((aligned(16))) unsigned char lds[];
    LAS unsigned char* L = (LAS unsigned char*)lds;
    volatile LAS unsigned* MISC = (volatile LAS unsigned*)(L + MISC_OFF);
    const int tid = threadIdx.x, lane = tid & 63, wave = __builtin_amdgcn_readfirstlane(tid >> 6);
    const int G = gridDim.x; const int bx = blockIdx.x;
    const int vcu = (G % 8 == 0) ? (bx % 8) * (G / 8) + bx / 8 : bx;
    const int gw = vcu * NWAVES + wave, NGW = G * NWAVES;
    unsigned char* ws = args.ws;
    gu32* ctl = (gu32*)(ws + WS_CTL);
    for (int u = tid; u < (LDS_BYTES - LDSCTL_OFF) / 4; u += NWAVES * 64) ((LAS unsigned*)(L + LDSCTL_OFF))[u] = 0u;
    __syncthreads();
    XcdBarrier bar; bar.bar = (unsigned*)(ctl + CW_BAR); bar.x = 0; bar.st = nullptr;
    if (MK_ONE_LAUNCH) bar = xcd_barrier_post((unsigned*)(ctl + CW_BAR), MISC + 8);
#define MEMATTN_PHASE() do { for (int un = vcu; un < BATCH * MHEAD * NBLK; un += G) { const int b_ = un >> 6, h_ = (un >> 4) & 3, qb_ = un & 15; const size_t qrow_ = (size_t)b_ * SEQ + (size_t)qb_ * 256; \
        attn_body::attn_unit<0, 8, 256, 256, 1024>((const attn_body::bf16*)(QM + qrow_ * 256 + h_ * 64), (const attn_body::bf16*)(MEMK + (size_t)b_ * MEML * 256 + h_ * 64), (const attn_body::bf16*)(MEMV + (size_t)b_ * MEML * 256 + h_ * 64), \
            (attn_body::bf16*)(MIX + qrow_ * 1024 + 768 + h_ * 64), 4, 0.f, nullptr, nullptr, 0, (char*)lds + RING_OFF); } } while (0)
    const int lo = args.ph_lo, hi = args.ph_hi;
#define IN(k) (lo <= (k) && (k) < hi)
#define SEAM(k) do { if (IN(k) && IN((k) + 1)) xcd_barrier(bar); } while (0)

    const float* x = args.in[0]; const float* mem = args.in[1];
    float* out = args.out;
    float* SS0 = (float*)(ws + WS_SS0); float* SSA = (float*)(ws + WS_SSA); float* SSB = (float*)(ws + WS_SSB); float* SSM = (float*)(ws + WS_SSM);
    unsigned char* S5TAB = ws + WS_S5TAB; float* S5E = (float*)(ws + WS_S5E);
    bf16* KMH = (bf16*)(ws + WS_KMEAN); bf16* KML = (bf16*)(ws + WS_KMEAN + 512 * 1024);
    bf16* WIN0 = (bf16*)(ws + WS_WIN0); bf16* WGLU = (bf16*)(ws + WS_WGLU); bf16* WIN1 = (bf16*)(ws + WS_WIN1);
    bf16* WOUT0 = (bf16*)(ws + WS_WOUT0); bf16* WOUT1 = (bf16*)(ws + WS_WOUT1);
    bf16* WGU0 = (bf16*)(ws + WS_WGU0); bf16* WGU1 = (bf16*)(ws + WS_WGU1); bf16* WDN0 = (bf16*)(ws + WS_WDN0); bf16* WDN1 = (bf16*)(ws + WS_WDN1); bf16* WMKV = (bf16*)(ws + WS_WMKV);
    bf16* MEMB = (bf16*)(ws + WS_MEMB); bf16* MEMK = (bf16*)(ws + WS_MEMK); bf16* MEMV = (bf16*)(ws + WS_MEMV);
    bf16* XB = (bf16*)(ws + WS_XB); bf16* Ub = (bf16*)(ws + WS_U); bf16* Yb = (bf16*)(ws + WS_Y);
    bf16* Q1 = (bf16*)(ws + WS_Q1); bf16* K1 = (bf16*)(ws + WS_K1); bf16* V1 = (bf16*)(ws + WS_V1);
    bf16* QM = (bf16*)(ws + WS_QM); bf16* MIX = (bf16*)(ws + WS_MIX); bf16* Hb = (bf16*)(ws + WS_H);

    if (IN(0)) {
        LAS float* scr = (LAS float*)(L + RING_OFF + wave * 16384);
        constexpr int I_SQ = 16 * 32, I_GLU = 12 * 24, I_IN1 = 16 * 80, I_GU = 16 * 88, I_DN = 44 * 32, I_MKV = 16 * 16;
        constexpr int I_TKT = NGRP * 8, I_TST = NGRP * 4, I_TYC = NGRP * 8;
        constexpr int NITEMS = I_TKT + I_TST + I_TYC + I_SQ + I_GLU + I_IN1 + 2 * I_SQ + 4 * I_GU + 2 * I_DN + I_MKV;
        const float* mixg = args.in[4]; const float* ffng = args.in[18];
        for (int it = gw; it < NITEMS; it += NGW) {
            int r = it;
            if (r < I_TKT) { s5_tab_kt(r >> 3, r & 7, S5TAB + (size_t)(r >> 3) * S5_TAB_BYTES, args.in[6], args.in[7], args.in[8], args.in[9], args.in[10], args.in[11], args.in[12], args.in[13], lane); continue; } r -= I_TKT;
            if (r < I_TST) { s5_tab_wst(r >> 2, r & 3, S5TAB + (size_t)(r >> 2) * S5_TAB_BYTES, args.in[6], args.in[7], args.in[8], args.in[9], args.in[10], lane); continue; } r -= I_TST;
            if (r < I_TYC) { s5_tab_wyc(r >> 3, r & 7, S5TAB + (size_t)(r >> 3) * S5_TAB_BYTES, args.in[6], args.in[7], args.in[8], args.in[11], args.in[12], lane); continue; } r -= I_TYC;
            if (r < I_SQ) { p0_matrix_item(args.in[5], 1024, 1024, WIN0, mixg, 0, r, scr, lane); continue; } r -= I_SQ;
            if (r < I_GLU) { p0_matrix_item(args.in[14], 768, 768, WGLU, nullptr, 0, r, scr, lane); continue; } r -= I_GLU;
            if (r < I_IN1) { p0_matrix_item(args.in[16], 1024, 2560, WIN1, mixg + 1024, 0, r, scr, lane); continue; } r -= I_IN1;
            if (r < I_SQ) { p0_matrix_item(args.in[17], 1024, 1024, WOUT0, nullptr, 0, r, scr, lane); continue; } r -= I_SQ;
            if (r < I_SQ) { p0_matrix_item(args.in[17] + 1024 * 1024, 1024, 1024, WOUT1, nullptr, 0, r, scr, lane); continue; } r -= I_SQ;
            if (r < I_GU) { p0_matrix_item(args.in[19], 1024, FFN, WGU0, ffng, 1, r, scr, lane); continue; } r -= I_GU;
            if (r < I_GU) { p0_matrix_item(args.in[20], 1024, FFN, WGU0, ffng, 2, r, scr, lane); continue; } r -= I_GU;
            if (r < I_GU) { p0_matrix_item(args.in[19] + (size_t)1024 * FFN, 1024, FFN, WGU1, ffng + 1024, 1, r, scr, lane); continue; } r -= I_GU;
            if (r < I_GU) { p0_matrix_item(args.in[20] + (size_t)1024 * FFN, 1024, FFN, WGU1, ffng + 1024, 2, r, scr, lane); continue; } r -= I_GU;
            if (r < I_DN) { p0_matrix_item(args.in[21], FFN, 1024, WDN0, nullptr, 0, r, scr, lane); continue; } r -= I_DN;
            if (r < I_DN) { p0_matrix_item(args.in[21] + (size_t)FFN * 1024, FFN, 1024, WDN1, nullptr, 0, r, scr, lane); continue; } r -= I_DN;
            p0_matrix_item(args.in[3], 1024, 512, WMKV, args.in[2], 0, r, scr, lane);
        }
        for (int m = gw; m < TOK; m += NGW) row_to_bf16_ssq(x + (size_t)m * DM, XB + (size_t)m * DM, SS0 + (size_t)m * 16, lane);
        for (int m = gw; m < BATCH * MEML; m += NGW) row_to_bf16_ssq(mem + (size_t)m * DM, MEMB + (size_t)m * DM, SSM + (size_t)m * 16, lane);
    }
    SEAM(0);
    if (IN(1)) {
        { pg8::Gemm g{XB, WIN0, TOK, 1024, 1024, 0}; pg8::StaticOrder S; S.init(TOK, 1024, G, bx);
          pg8::EpiProj E{SS0, Ub, 0, 3, 1, TOKW, 1.0f, QM, C2, TOK};
          pg8::gemm_phase<pg8::EpiProj, pg8::StaticOrder, true, true>(L + RING_OFF, g, S, E); }
        { pg8::Gemm g{MEMB, WMKV, BATCH * MEML, 512, 1024, 0}; pg8::StaticOrder S; S.init(BATCH * MEML, 512, G, bx);
          pg8::EpiProj E{SSM, MEMK, (size_t)(WS_MEMV - WS_MEMK) / 2, 1, 2, 256, 1.0f, nullptr, 1.0f, 0};
          pg8::gemm_phase<pg8::EpiProj, pg8::StaticOrder, true, true>(L + RING_OFF, g, S, E); }
    }
    SEAM(1);
    if (IN(2)) {
        for (int un = vcu; un < NGRP * 16; un += G) s5_unit<false>(un >> 4, un & 15, Ub, Yb, S5TAB + (size_t)(un >> 4) * S5_TAB_BYTES, S5E, args.in[6], args.in[7], args.in[8], L + RING_OFF);
        MEMATTN_PHASE();
    }
    SEAM(2);
    if (IN(3)) {
        for (int un = vcu; un < NGRP * 16; un += G) s5_unit<true>(un >> 4, un & 15, Ub, Yb, S5TAB + (size_t)(un >> 4) * S5_TAB_BYTES, S5E, args.in[6], args.in[7], args.in[8], L + RING_OFF);
    }
    SEAM(3);
    if (IN(4)) {
        pg8::Gemm g{Yb, WGLU, TOK, TOKW, TOKW, 1}; pg8::StaticOrder S; S.init(TOK, TOKW, G, bx);
        pg8::EpiGlu E{Yb, TOKW, args.in[15], MIX, 1024, TOK};
        pg8::gemm_phase<pg8::EpiGlu, pg8::StaticOrder, true, true>(L + RING_OFF, g, S, E);
    }
    SEAM(4);
    if (IN(5)) {
        pg8::Gemm g{MIX, WOUT0, TOK, 1024, 1024, 0}; pg8::StaticOrder S; S.init(TOK, 1024, G, bx);
        pg8::EpiRes E{x, out, XB, SSA};
        pg8::gemm_phase<pg8::EpiRes, pg8::StaticOrder, true, true>(L + RING_OFF, g, S, E);
    }
    SEAM(5);
    if (IN(6)) {
        pg8::Gemm g{XB, WGU0, TOK, 2 * FFN, 1024, 0}; pg8::StaticOrder S; S.init(TOK, 2 * FFN, G, bx);
        pg8::EpiGU E{SSA, Hb, FFN};
        pg8::gemm_phase<pg8::EpiGU, pg8::StaticOrder, true, true>(L + RING_OFF, g, S, E);
    }
    SEAM(6);
    if (IN(7)) {
        pg8::Gemm g{Hb, WDN0, TOK, 1024, FFN, 0}; pg8::StaticOrder S; S.init(TOK, 1024, G, bx);
        pg8::EpiRes E{out, out, XB, SSB};
        pg8::gemm_phase<pg8::EpiRes, pg8::StaticOrder, true, true>(L + RING_OFF, g, S, E);
    }
    SEAM(7);
    if (IN(8)) {
        pg8::Gemm g{XB, WIN1, TOK, 2560, 1024, 0}; pg8::StaticOrder S; S.init(TOK, 2560, G, bx);
        pg8::EpiProj E{SSB, Q1, (size_t)(WS_K1 - WS_Q1) / 2, 3, 3, TOKW, C2, QM, C2, 0};
        pg8::gemm_phase<pg8::EpiProj, pg8::StaticOrder, true, true>(L + RING_OFF, g, S, E);
    }
    SEAM(8);
    if (IN(9)) {
        for (int un = gw; un < BATCH * NHEAD * NBLK; un += NGW) {
            const int n = un & 15, bh = un >> 4, h = bh % NHEAD, b = bh / NHEAD;
            const bf16* kp = K1 + ((size_t)b * SEQ + (size_t)n * MBLK) * TOKW + h * 64 + lane; float a = 0.f;
#pragma unroll 8
            for (int i = 0; i < MBLK; ++i) a += bf2f(kp[(size_t)i * TOKW]);
            const float km_ = a * (1.0f / MBLK); const unsigned kh_ = f2bf(km_); const float rem_ = km_ - __uint_as_float(kh_ << 16);
            KMH[(size_t)un * 64 + lane] = (bf16)kh_; KML[(size_t)un * 64 + lane] = (bf16)f2bf(rem_);
        }
    }
    SEAM(9);
    if (IN(10)) {
        for (int p_ = vcu; p_ < BATCH * NHEAD * 8; p_ += G) { const int bh_ = p_ >> 3, sg_ = p_ & 7, b_ = bh_ / NHEAD, h_ = bh_ - b_ * NHEAD;
            const float slope2 = __builtin_amdgcn_exp2f(-8.0f * (float)(h_ + 1) / 12.0f) * LOG2E;
#pragma unroll 1
            for (int k_ = 0; k_ < 2; ++k_) { const int qb_ = k_ ? 15 - sg_ : sg_; const size_t qrow_ = (size_t)b_ * SEQ + (size_t)qb_ * 256, krow_ = (size_t)b_ * SEQ;
                attn_body::attn_unit<1, 8, 768, 768, 1024>((const attn_body::bf16*)(Q1 + qrow_ * TOKW + h_ * 64), (const attn_body::bf16*)(K1 + krow_ * TOKW + h_ * 64), (const attn_body::bf16*)(V1 + krow_ * TOKW + h_ * 64),
                    (attn_body::bf16*)(MIX + qrow_ * 1024 + h_ * 64), 4 * qb_ + 4, slope2, (const attn_body::bf16*)(KMH + (size_t)bh_ * 1024), (const attn_body::bf16*)(KML + (size_t)bh_ * 1024), qb_, (char*)lds + RING_OFF); } }
        MEMATTN_PHASE();
    }
    SEAM(10);
    if (IN(11)) {
        pg8::Gemm g{MIX, WOUT1, TOK, 1024, 1024, 0}; pg8::StaticOrder S; S.init(TOK, 1024, G, bx);
        pg8::EpiRes E{out, out, XB, SSA};
        pg8::gemm_phase<pg8::EpiRes, pg8::StaticOrder, true, true>(L + RING_OFF, g, S, E);
    }
    SEAM(11);
    if (IN(12)) {
        pg8::Gemm g{XB, WGU1, TOK, 2 * FFN, 1024, 0}; pg8::StaticOrder S; S.init(TOK, 2 * FFN, G, bx);
        pg8::EpiGU E{SSA, Hb, FFN};
        pg8::gemm_phase<pg8::EpiGU, pg8::StaticOrder, true, true>(L + RING_OFF, g, S, E);
    }
    SEAM(12);
    if (IN(13)) {
        pg8::Gemm g{Hb, WDN1, TOK, 1024, FFN, 0}; pg8::StaticOrder S; S.init(TOK, 1024, G, bx);
        pg8::EpiRes E{out, out, XB, SSB};
        pg8::gemm_phase<pg8::EpiRes, pg8::StaticOrder, true, true>(L + RING_OFF, g, S, E);
    }
    SEAM(13);
    if (IN(14)) {
        const float* gf = args.in[22];
        for (int m = gw; m < TOK; m += NGW) {
            const float rs = pg8::row_rstd(SSB, m);
            GAS f32x4* xr = (GAS f32x4*)(out + (size_t)m * DM) + lane; const GAS f32x4* gp = (const GAS f32x4*)gf + lane;
#pragma unroll
            for (int j = 0; j < 4; ++j) { const f32x4 v = xr[64 * j], gg = gp[64 * j]; xr[64 * j] = v * rs * gg; }
        }
    }
#undef IN
#undef SEAM
}

extern "C" void kernel_launch(void* const* d_in, const int* in_sizes, int n_in, void* d_out, int out_size, void* d_ws, size_t ws_size, hipStream_t stream) {
    static int grid = 0;
    if (grid == 0) {
        if (n_in != 23 || out_size != TOK * DM || ws_size < WS_END) { fprintf(stderr, "kernel_launch: unexpected shapes: n_in %d out %d ws %zu\n", n_in, out_size, ws_size); grid = -1; return; }
        int dev = 0, cus = 0, per_cu = 0;
        if (hipGetDevice(&dev) != hipSuccess || hipDeviceGetAttribute(&cus, hipDeviceAttributeMultiprocessorCount, dev) != hipSuccess) { grid = -1; return; }
        if (hipFuncSetAttribute((const void*)mega_fwd, hipFuncAttributeMaxDynamicSharedMemorySize, LDS_BYTES) != hipSuccess) { fprintf(stderr, "kernel_launch: hipFuncSetAttribute failed\n"); grid = -1; return; }
        if (hipOccupancyMaxActiveBlocksPerMultiprocessor(&per_cu, (const void*)mega_fwd, NWAVES * 64, LDS_BYTES) != hipSuccess || per_cu < 1)
            fprintf(stderr, "kernel_launch: occupancy query reports %d workgroups per CU\n", per_cu);
        (void)hipGetLastError();
        grid = cus;
    }
    if (grid < 0) return;
    if (hipMemsetAsync((char*)d_ws + WS_CTL, 0, CTL_ZERO_BYTES, stream) != hipSuccess) return;
    Args a{};
    for (int i = 0; i < 23; ++i) a.in[i] = (const float*)d_in[i];
    a.out = (float*)d_out; a.ws = (unsigned char*)d_ws;
#if MK_ONE_LAUNCH
    a.ph_lo = 0; a.ph_hi = N_PHASES;
    hipLaunchKernelGGL(mega_fwd, dim3(grid), dim3(NWAVES * 64), LDS_BYTES, stream, a);
#else
    for (int p = 0; p < N_PHASES; ++p) { a.ph_lo = p; a.ph_hi = p + 1; hipLaunchKernelGGL(mega_fwd, dim3(grid), dim3(NWAVES * 64), LDS_BYTES, stream, a); }
#endif
}
```

```cpp
#include <hip/hip_runtime.h>
#include <hip/hip_bf16.h>
#include <cstdio>
#include <cstdint>
#include <cmath>
namespace pg8 {
#define PG8_LAS __attribute__((address_space(3)))
typedef unsigned short bf16_t;
typedef short bf16x8 __attribute__((ext_vector_type(8)));
typedef float f32x4 __attribute__((ext_vector_type(4)));
typedef unsigned u32x4 __attribute__((ext_vector_type(4)));
constexpr int BM = 256, BK = 64, HALF = 128, HTB = HALF * BK * 2  , STAGE_BYTES = 8 * HTB, NXCD = 8, WGM = 8;

__host__ __device__ __forceinline__ int lds_byte(int r, int c) { const int st = (r >> 4) * 2 + (c >> 5), rr = r & 15, cc = c & 31, ob = rr * 64 + cc * 2; return st * 1024 + (ob ^ (((ob >> 9) & 1) << 5)); }
__host__ __device__ __forceinline__ void stage_rc(int b, int& R, int& C) { const int st = b / 1024, sb = b % 1024, swz = sb ^ (((sb >> 9) & 1) << 5); R = (st >> 1) * 16 + swz / 64; C = (st & 1) * 32 + (swz % 64) / 2; }
__host__ __device__ __forceinline__ int perm32(int rho) { const int n = rho >> 4, i = rho & 15; return 8 * (i >> 2) + 4 * n + (i & 3); }

struct Unit { int pm, pn; };
struct Gemm { const bf16_t* A; const bf16_t* Bt; int M, N, K, amode; };

struct StaticOrder {
    int nM, nN, nwg, G, c;
    __host__ __device__ void init(int M, int N, int G_, int c_) { nM = M / BM; nN = N / BM; nwg = nM * nN; G = G_; c = c_; }
    __host__ __device__ bool next(int i, Unit& u) const {
        const long L = (long)i * G + c; if (L >= nwg) return false;
        int wgid = (int)L; { const int q = nwg / NXCD, r = nwg % NXCD, xcd = wgid % NXCD, off = wgid / NXCD; wgid = (xcd < r ? xcd * (q + 1) : r * (q + 1) + (xcd - r) * q) + off; }
        const int nig = WGM * nN, gid = wgid / nig, fm = gid * WGM, gsz = (nM - fm) < WGM ? (nM - fm) : WGM;
        u.pm = fm + ((wgid % nig) % gsz); u.pn = (wgid % nig) / gsz; return true;
    }
    __device__ __forceinline__ void a_ready(const Unit&) const {}
    __device__ __forceinline__ void done(const Unit&) const {}
};

__device__ __forceinline__ unsigned cvt_pk_bf16(float lo, float hi) { unsigned r; asm volatile("v_cvt_pk_bf16_f32 %0, %1, %2" : "=v"(r) : "v"(lo), "v"(hi)); return r; }
typedef float f32x2 __attribute__((ext_vector_type(2)));
typedef unsigned u32x2 __attribute__((ext_vector_type(2)));
constexpr float RMS_EPS = 1e-6f;
__device__ __forceinline__ float row_rstd(const float* ssq, int row) {
    const f32x4* p = (const f32x4*)(ssq + (size_t)row * 16);
    const f32x4 a = p[0], b = p[1], c = p[2], d = p[3];
    const float s = (((a[0] + a[1]) + (a[2] + a[3])) + ((b[0] + b[1]) + (b[2] + b[3]))) + (((c[0] + c[1]) + (c[2] + c[3])) + ((d[0] + d[1]) + (d[2] + d[3])));
    return 1.0f / sqrtf(s * (1.0f / 1024.0f) + RMS_EPS);
}
__device__ __forceinline__ float bf2f(unsigned short h) { return __uint_as_float(((unsigned)h) << 16); }
__device__ __forceinline__ float bflo(unsigned w) { return __uint_as_float(w << 16); }
__device__ __forceinline__ float bfhi(unsigned w) { return __uint_as_float(w & 0xffff0000u); }

__device__ __forceinline__ f32x2 gelu_pk(f32x2 v) {
    const f32x2 av = __builtin_elementwise_abs(v), d = av * 0.2316418882f + 1.0f;
    f32x2 t; t.x = __builtin_amdgcn_rcpf(d.x); t.y = __builtin_amdgcn_rcpf(d.y);
    f32x2 q = t * 0.5307027145f + (-0.7265760135f); q = q * t + 0.7107068705f; q = q * t + (-0.142248368f); q = q * t + 0.127414796f; q = q * t;
    const f32x2 s = (v * v) * (-0.72134752044f);
    f32x2 e; e.x = __builtin_amdgcn_exp2f(s.x); e.y = __builtin_amdgcn_exp2f(s.y);
    const f32x2 m = v * (q * e), r = v - m;
    f32x2 o; o.x = v.x < 0.f ? m.x : r.x; o.y = v.y < 0.f ? m.y : r.y; return o;
}

__device__ __forceinline__ float row_rstd4(const float* ssq, int row, int fq) {
    const f32x4 a = *(const f32x4*)(ssq + (size_t)row * 16 + 4 * fq);
    float s = (a[0] + a[1]) + (a[2] + a[3]); s += __shfl_xor(s, 16); s += __shfl_xor(s, 32);
    return 1.0f / sqrtf(s * (1.0f / 1024.0f) + RMS_EPS);
}
struct EpiProj {
    static constexpr bool PERM = true, AFTER_DRAIN = false;
    const float* ssq; bf16_t* base; size_t seg_stride; int tps, nseg, ldc; float scale0; bf16_t* qm; float scale_qm; int gm_rows;
    float* kmp; int kseg;
    __device__ __forceinline__ void operator()(const f32x4 (&acc)[2][2][4][2], const Unit& u, int wr, int wc, int fr, int fq) const {
        const int seg = u.pn / tps, within = u.pn - seg * tps;
        bf16_t* o; int ld, colt; float sc;
        if (seg < nseg) { o = base + (size_t)seg * seg_stride; ld = ldc; colt = within * BM; sc = (seg == 0) ? scale0 : 1.0f; }
        else { o = qm; ld = 256; colt = 0; sc = scale_qm; }
        const int row0 = u.pm * BM + wr * 64 + fr, col0 = colt + wc * 32 + 8 * fq;
        f32x4 cs[2][2] = {{{0.f, 0.f, 0.f, 0.f}, {0.f, 0.f, 0.f, 0.f}}, {{0.f, 0.f, 0.f, 0.f}, {0.f, 0.f, 0.f, 0.f}}};
#pragma unroll
        for (int ai = 0; ai < 2; ++ai)
#pragma unroll
            for (int m = 0; m < 4; ++m) { const int row = row0 + ai * HALF + m * 16; const float rs = row_rstd4(ssq, row, fq) * sc; bf16_t* rowp = o + (size_t)row * ld + col0;
                const bool gm = (gm_rows != 0) && (seg < nseg);
#pragma unroll
                for (int bj = 0; bj < 2; ++bj) { const f32x4 v0 = acc[ai][bj][m][0] * rs, v1 = acc[ai][bj][m][1] * rs;
                    u32x4 w; w.x = cvt_pk_bf16(v0[0], v0[1]); w.y = cvt_pk_bf16(v0[2], v0[3]); w.z = cvt_pk_bf16(v1[0], v1[1]); w.w = cvt_pk_bf16(v1[2], v1[3]);
                    const int cc = col0 + bj * HALF;
                    bf16_t* dst = gm ? (o + ((size_t)(cc >> 4) * gm_rows + row) * 16 + (cc & 15)) : (rowp + bj * HALF);
                    *(u32x4*)dst = w; cs[bj][0] += v0; cs[bj][1] += v1; } }
        if (seg == kseg) {
#pragma unroll
            for (int bj = 0; bj < 2; ++bj)
#pragma unroll
                for (int n = 0; n < 2; ++n)
#pragma unroll
                    for (int e = 0; e < 4; ++e) { float s = cs[bj][n][e]; s += __shfl_xor(s, 1); s += __shfl_xor(s, 2); s += __shfl_xor(s, 4); s += __shfl_xor(s, 8); cs[bj][n][e] = s; }
            if (fr == 0) { const int bb = u.pm >> 4, blk = u.pm & 15;
#pragma unroll
                for (int bj = 0; bj < 2; ++bj) { const int cc = col0 + bj * HALF, h = cc >> 6, d = cc & 63;
                    float* kd = kmp + (size_t)wr * (8 * 12 * 16 * 64) + ((size_t)((bb * 12 + h) * 16 + blk)) * 64 + d;
                    *(__attribute__((address_space(1))) f32x4*)kd = cs[bj][0]; *(__attribute__((address_space(1))) f32x4*)(kd + 4) = cs[bj][1]; } }
        }
    }
};
struct EpiGlu {
    static constexpr bool PERM = true, AFTER_DRAIN = false;
    const bf16_t* Y; int ldy; const float* bias; bf16_t* mix; int ldm; int ygm_rows;
    __device__ __forceinline__ void operator()(const f32x4 (&acc)[2][2][4][2], const Unit& u, int wr, int wc, int fr, int fq) const {
        const int row0 = u.pm * BM + wr * 64 + fr, col0 = u.pn * BM + wc * 32 + 8 * fq;
        f32x4 bv[2][2];
#pragma unroll
        for (int bj = 0; bj < 2; ++bj)
#pragma unroll
            for (int n = 0; n < 2; ++n) bv[bj][n] = *(const f32x4*)(bias + col0 + bj * HALF + 4 * n);
#pragma unroll
        for (int ai = 0; ai < 2; ++ai)
#pragma unroll
            for (int m = 0; m < 4; ++m) { const int row = row0 + ai * HALF + m * 16;
#pragma unroll
                for (int bj = 0; bj < 2; ++bj) { const int cc = col0 + bj * HALF; const u32x4 yw = ygm_rows ? *(const u32x4*)(Y + ((size_t)(cc >> 4) * ygm_rows + row) * 16 + (cc & 15)) : *(const u32x4*)(Y + (size_t)row * ldy + cc);
                    const f32x4 z0 = acc[ai][bj][m][0] + bv[bj][0], z1 = acc[ai][bj][m][1] + bv[bj][1];
                    float t[8]; const float yv[8] = {bflo(yw.x), bfhi(yw.x), bflo(yw.y), bfhi(yw.y), bflo(yw.z), bfhi(yw.z), bflo(yw.w), bfhi(yw.w)};
#pragma unroll
                    for (int e = 0; e < 4; ++e) { t[e] = yv[e] * __builtin_amdgcn_rcpf(1.0f + __builtin_amdgcn_exp2f(-1.4426950408889634f * z0[e])); t[4 + e] = yv[4 + e] * __builtin_amdgcn_rcpf(1.0f + __builtin_amdgcn_exp2f(-1.4426950408889634f * z1[e])); }
                    u32x4 w; w.x = cvt_pk_bf16(t[0], t[1]); w.y = cvt_pk_bf16(t[2], t[3]); w.z = cvt_pk_bf16(t[4], t[5]); w.w = cvt_pk_bf16(t[6], t[7]);
                    *(u32x4*)(mix + (size_t)row * ldm + col0 + bj * HALF) = w; } }
    }
};
struct EpiRes {
    static constexpr bool PERM = false, AFTER_DRAIN = false;
    const float* base; float* out; bf16_t* xb; float* ssq_out;
    __device__ __forceinline__ void operator()(const f32x4 (&acc)[2][2][4][2], const Unit& u, int wr, int wc, int fr, int fq) const {
        const int row0 = u.pm * BM + wr * 64 + fr, col0 = u.pn * BM + wc * 32 + 4 * fq;
#pragma unroll
        for (int ai = 0; ai < 2; ++ai)
#pragma unroll
            for (int m = 0; m < 4; ++m) { const int row = row0 + ai * HALF + m * 16; const size_t off = (size_t)row * 1024 + col0; float ss = 0.f;
#pragma unroll
                for (int bj = 0; bj < 2; ++bj)
#pragma unroll
                    for (int n = 0; n < 2; ++n) { const f32x4 b = *(const f32x4*)(base + off + bj * HALF + n * 16); const f32x4 o = b + acc[ai][bj][m][n];
                        *(f32x4*)(out + off + bj * HALF + n * 16) = o; u32x2 w; w.x = cvt_pk_bf16(o[0], o[1]); w.y = cvt_pk_bf16(o[2], o[3]); *(u32x2*)(xb + off + bj * HALF + n * 16) = w;
                        ss += (o[0] * o[0] + o[1] * o[1]) + (o[2] * o[2] + o[3] * o[3]); }
                ss += __shfl_xor(ss, 16); ss += __shfl_xor(ss, 32);
                if (fq == 0) ssq_out[(size_t)row * 16 + u.pn * 4 + wc] = ss; }
    }
};
struct EpiGU {
    static constexpr bool PERM = true, AFTER_DRAIN = false;
    const float* ssq; bf16_t* H; int ldh;
    __device__ __forceinline__ void operator()(const f32x4 (&acc)[2][2][4][2], const Unit& u, int wr, int wc, int fr, int fq) const {
        const int row0 = u.pm * BM + wr * 64 + fr, col0 = u.pn * HALF + wc * 32 + 8 * fq;
#pragma unroll
        for (int ai = 0; ai < 2; ++ai)
#pragma unroll
            for (int m = 0; m < 4; ++m) { const int row = row0 + ai * HALF + m * 16; const float rs = row_rstd4(ssq, row, fq);
                float t[8];
#pragma unroll
                for (int n = 0; n < 2; ++n)
#pragma unroll
                    for (int e = 0; e < 4; ++e) { const float g = acc[ai][0][m][n][e] * rs, up = acc[ai][1][m][n][e] * rs;
                        t[4 * n + e] = g * __builtin_amdgcn_rcpf(1.0f + __builtin_amdgcn_exp2f(-1.4426950408889634f * g)) * up; }
                u32x4 w; w.x = cvt_pk_bf16(t[0], t[1]); w.y = cvt_pk_bf16(t[2], t[3]); w.z = cvt_pk_bf16(t[4], t[5]); w.w = cvt_pk_bf16(t[6], t[7]);
                *(u32x4*)(H + (size_t)row * ldh + col0) = w; }
    }
};

template <class Epi, class Sched, bool ALIGN_EPI = false, bool SP2 = false>
__device__ __forceinline__ void gemm_phase(PG8_LAS unsigned char* lds, const Gemm g, const Sched& S, const Epi& E) {
    const int tid = threadIdx.x, wid = __builtin_amdgcn_readfirstlane(tid >> 6), lane = tid & 63, wr = wid >> 2, wc = wid & 3, fr = lane & 15, fq = lane >> 4;
    const int K = g.K, nt = K / BK;
    unsigned voffA[2], voffB[2];
#pragma unroll
    for (int i = 0; i < 2; ++i) { int R, C; stage_rc(tid * 16 + i * 8192, R, C); const int Rb = Epi::PERM ? ((R & ~31) + perm32(R & 31)) : R;
        voffA[i] = g.amode ? (unsigned)((C >> 4) * g.M * 32 + R * 32 + (C & 15) * 2) : (unsigned)(R * K + C) * 2u; voffB[i] = (unsigned)(Rb * K + C) * 2u; }
    const size_t kstep = (size_t)(BK * 2);
    const size_t hstep = (size_t)HALF * K * 2;
    const size_t tstep = 2 * hstep;
    const size_t kstepA = g.amode ? (size_t)4 * g.M * 32 : kstep, hstepA = g.amode ? (size_t)HALF * 32 : hstep, tstepA = 2 * hstepA;
    const unsigned ldsw = (unsigned)wid * 1024u;
    const int aoff = lds_byte(wr * 64 + fr, fq * 8), boff = lds_byte(wc * 32 + fr, fq * 8);
#define PG8_SA(b, h) (((b) * 2 + (h)) * HTB)
#define PG8_SB(b, h) ((4 + (b) * 2 + (h)) * HTB)
#define PG8_STAGE(bufoff, gbase, voff) do { _Pragma("unroll") for (int _i = 0; _i < 2; ++_i) \
        __builtin_amdgcn_global_load_lds((const unsigned*)((const char*)(gbase) + (voff)[_i]), (PG8_LAS unsigned*)(lds + (bufoff) + ldsw + _i * 8192), 16, 0, 0); } while (0)
#define PG8_LDA(dst, b, h) do { _Pragma("unroll") for (int m = 0; m < 4; ++m) _Pragma("unroll") for (int k = 0; k < 2; ++k) dst[m][k] = *(const PG8_LAS bf16x8*)(lds + PG8_SA(b, h) + aoff + m * 2048 + k * 1024); } while (0)
#define PG8_LDB(dst, b, h) do { _Pragma("unroll") for (int n = 0; n < 2; ++n) _Pragma("unroll") for (int k = 0; k < 2; ++k) dst[n][k] = *(const PG8_LAS bf16x8*)(lds + PG8_SB(b, h) + boff + n * 2048 + k * 1024); } while (0)
#define PG8_MMA(ai, bj, At, Bt) do { __builtin_amdgcn_s_setprio(1); _Pragma("unroll") for (int m = 0; m < 4; ++m) _Pragma("unroll") for (int n = 0; n < 2; ++n) _Pragma("unroll") for (int k = 0; k < 2; ++k) \
        acc[ai][bj][m][n] = __builtin_amdgcn_mfma_f32_16x16x32_bf16(Bt[n][k], At[m][k], acc[ai][bj][m][n], 0, 0, 0); __builtin_amdgcn_s_setprio(0); } while (0)
#define PG8_WAIT_V(n) asm volatile("s_waitcnt vmcnt(" #n ")" ::: "memory")
#define PG8_WAIT_L(n) asm volatile("s_waitcnt lgkmcnt(" #n ")" ::: "memory")
#define PG8_BAR __builtin_amdgcn_s_barrier()
#define PG8_SCHED __builtin_amdgcn_sched_barrier(0)
    Unit cur, nxt; int ui = 0;
    if (!S.next(0, cur)) return;
    f32x4 acc[2][2][4][2];
#pragma unroll
    for (int a = 0; a < 2; ++a)
#pragma unroll
        for (int b = 0; b < 2; ++b)
#pragma unroll
            for (int m = 0; m < 4; ++m)
#pragma unroll
                for (int n = 0; n < 2; ++n) acc[a][b][m][n] = (f32x4){0.f, 0.f, 0.f, 0.f};
    bf16x8 At[4][2], B0[2][2], B1[2][2];
    const char* cA = (const char*)g.A + (size_t)cur.pm * tstepA; const char* cB = (const char*)g.Bt + (size_t)cur.pn * tstep;
    S.a_ready(cur);
    if constexpr (SP2) {
        PG8_STAGE(PG8_SB(0, 0), cB, voffB); PG8_STAGE(PG8_SB(0, 1), cB + hstep, voffB); PG8_STAGE(PG8_SA(0, 0), cA, voffA); PG8_STAGE(PG8_SA(0, 1), cA + hstepA, voffA);
        if (wr == 1) PG8_BAR;
        PG8_WAIT_V(2); PG8_BAR;
        PG8_STAGE(PG8_SB(1, 0), cB + kstep, voffB); PG8_STAGE(PG8_SA(1, 0), cA + kstepA, voffA); PG8_STAGE(PG8_SB(1, 1), cB + hstep + kstep, voffB);
        PG8_WAIT_V(6); PG8_BAR;
    } else {
        PG8_STAGE(PG8_SB(0, 0), cB, voffB); PG8_STAGE(PG8_SA(0, 0), cA, voffA); PG8_STAGE(PG8_SB(0, 1), cB + hstep, voffB); PG8_STAGE(PG8_SA(0, 1), cA + hstepA, voffA);
        if (wr == 1) PG8_BAR;
        PG8_WAIT_V(4); PG8_BAR;
        PG8_STAGE(PG8_SB(1, 0), cB + kstep, voffB); PG8_STAGE(PG8_SA(1, 0), cA + kstepA, voffA); PG8_STAGE(PG8_SB(1, 1), cB + hstep + kstep, voffB);
        PG8_WAIT_V(6); PG8_BAR;
    }
    for (;;) {
        const bool has_next = S.next(ui + 1, nxt);
        const char* nA = has_next ? (const char*)g.A + (size_t)nxt.pm * tstepA : cA; const char* nB = has_next ? (const char*)g.Bt + (size_t)nxt.pn * tstep : cB;
        for (int t = 0; t < nt; t += 2) {
            const bool last = (t == nt - 2);
            const char* a1 = cA + (size_t)(t + 1) * kstepA;
            const char* a2 = last ? nA : cA + (size_t)(t + 2) * kstepA; const char* b2 = last ? nB : cB + (size_t)(t + 2) * kstep;
            const char* a3 = a2 + kstepA; const char* b3 = b2 + kstep;
            if (last && has_next) S.a_ready(nxt);
            if constexpr (SP2) {
            PG8_LDB(B0, 0, 0); PG8_LDB(B1, 0, 1); PG8_SCHED; PG8_LDA(At, 0, 0); PG8_STAGE(PG8_SA(1, 1), a1 + hstepA, voffA);
            PG8_WAIT_V(8); PG8_WAIT_L(0); PG8_BAR; PG8_MMA(0, 0, At, B0); PG8_MMA(0, 1, At, B1); PG8_BAR; PG8_SCHED;
            PG8_LDA(At, 0, 1); PG8_STAGE(PG8_SB(0, 0), b2, voffB); PG8_STAGE(PG8_SB(0, 1), b2 + hstep, voffB); PG8_STAGE(PG8_SA(0, 0), a2, voffA);
            PG8_WAIT_V(8); PG8_WAIT_L(0); PG8_BAR; PG8_MMA(1, 0, At, B0); PG8_MMA(1, 1, At, B1); PG8_BAR; PG8_SCHED;
            PG8_LDB(B0, 1, 0); PG8_LDB(B1, 1, 1); PG8_SCHED; PG8_LDA(At, 1, 0); PG8_STAGE(PG8_SA(0, 1), a2 + hstepA, voffA);
            PG8_WAIT_V(8); PG8_WAIT_L(0); PG8_BAR; PG8_MMA(0, 0, At, B0); PG8_MMA(0, 1, At, B1); PG8_BAR; PG8_SCHED;
            PG8_LDA(At, 1, 1); PG8_STAGE(PG8_SB(1, 0), b3, voffB); PG8_STAGE(PG8_SB(1, 1), b3 + hstep, voffB); PG8_STAGE(PG8_SA(1, 0), a3, voffA);
            PG8_WAIT_V(8); PG8_WAIT_L(0); PG8_BAR; PG8_MMA(1, 0, At, B0); PG8_MMA(1, 1, At, B1); PG8_BAR; PG8_SCHED;
            } else {
            PG8_LDB(B0, 0, 0); PG8_SCHED; PG8_LDA(At, 0, 0); PG8_STAGE(PG8_SA(1, 1), a1 + hstepA, voffA);
            PG8_WAIT_L(8); PG8_BAR; PG8_WAIT_L(0); PG8_MMA(0, 0, At, B0); PG8_BAR; PG8_SCHED;
            PG8_LDB(B1, 0, 1); PG8_STAGE(PG8_SB(0, 0), b2, voffB);
            PG8_BAR; PG8_WAIT_L(0); PG8_MMA(0, 1, At, B1); PG8_BAR;
            PG8_LDA(At, 0, 1); PG8_STAGE(PG8_SA(0, 0), a2, voffA);
            PG8_BAR; PG8_WAIT_L(0); PG8_MMA(1, 0, At, B0); PG8_BAR; PG8_SCHED;
            PG8_STAGE(PG8_SB(0, 1), b2 + hstep, voffB);
            PG8_WAIT_V(6); PG8_BAR; PG8_MMA(1, 1, At, B1); PG8_BAR;
            PG8_LDB(B0, 1, 0); PG8_SCHED; PG8_LDA(At, 1, 0); PG8_STAGE(PG8_SA(0, 1), a2 + hstepA, voffA);
            PG8_WAIT_L(8); PG8_BAR; PG8_WAIT_L(0); PG8_MMA(0, 0, At, B0); PG8_BAR; PG8_SCHED;
            PG8_LDB(B1, 1, 1); PG8_STAGE(PG8_SB(1, 0), b3, voffB);
            PG8_BAR; PG8_WAIT_L(0); PG8_MMA(0, 1, At, B1); PG8_BAR;
            PG8_LDA(At, 1, 1); PG8_STAGE(PG8_SA(1, 0), a3, voffA);
            PG8_BAR; PG8_WAIT_L(0); PG8_MMA(1, 0, At, B0); PG8_BAR; PG8_SCHED;
            PG8_STAGE(PG8_SB(1, 1), b3 + hstep, voffB);
            PG8_WAIT_V(6); PG8_BAR; PG8_MMA(1, 1, At, B1); PG8_BAR;
            }
        }
        if constexpr (ALIGN_EPI) { if (wr == 0) PG8_BAR; }
        if constexpr (!Epi::AFTER_DRAIN) { E(acc, cur, wr, wc, fr, fq); S.done(cur); }
        if (!has_next) break;
#pragma unroll
        for (int a = 0; a < 2; ++a)
#pragma unroll
            for (int b = 0; b < 2; ++b)
#pragma unroll
                for (int m = 0; m < 4; ++m)
#pragma unroll
                    for (int n = 0; n < 2; ++n) acc[a][b][m][n] = (f32x4){0.f, 0.f, 0.f, 0.f};
        cur = nxt; cA = nA; cB = nB; ++ui;
        if constexpr (ALIGN_EPI) { if (wr == 1) PG8_BAR; }
    }
    PG8_WAIT_V(0);
    if constexpr (!ALIGN_EPI) { if (wr == 0) PG8_BAR; }
    PG8_BAR;
    if constexpr (Epi::AFTER_DRAIN) { E.fused(acc, cur, wr, wc, fr, fq, lds, wid, lane); S.done(cur); }
#undef PG8_SA
#undef PG8_SB
#undef PG8_STAGE
#undef PG8_LDA
#undef PG8_LDB
#undef PG8_MMA
#undef PG8_WAIT_V
#undef PG8_WAIT_L
#undef PG8_BAR
#undef PG8_SCHED
}
}
constexpr int NWAVES = 8;
constexpr int BATCH = 8, SEQ = 4096, DM = 1024, TOK = BATCH * SEQ;
constexpr int TOKW = 768, MEMW = 256, MEML = 256, NGRP = 48, NST = 64, GCH = 16, NHEAD = 12, MHEAD = 4, HD = 64, FFN = 2816, NBLK = 16, MBLK = 256;
constexpr float C2 = 0.125f * 1.4426950408889634f;
constexpr float LOG2E = 1.4426950408889634f;

constexpr size_t MiB = 1u << 20;
constexpr size_t WS_CTL = 0, CTL_ZERO_BYTES = 1 * MiB;
constexpr size_t WS_S5TAB = 9 * MiB, WS_S5E = 13 * MiB;
constexpr size_t WS_SS0 = 1 * MiB, WS_SSA = 3 * MiB, WS_SSB = 5 * MiB, WS_SSM = 7 * MiB, WS_KMEAN = 8 * MiB;
constexpr size_t WS_WIN0 = 16 * MiB, WS_WGLU = 18 * MiB, WS_WIN1 = 20 * MiB, WS_WOUT0 = 26 * MiB, WS_WOUT1 = 28 * MiB;
constexpr size_t WS_WGU0 = 30 * MiB, WS_WGU1 = 41 * MiB, WS_WDN0 = 52 * MiB, WS_WDN1 = 58 * MiB, WS_WMKV = 64 * MiB;
constexpr size_t WS_MEMB = 65 * MiB, WS_MEMK = 69 * MiB, WS_MEMV = 70 * MiB;
constexpr size_t WS_XB = 72 * MiB;
constexpr size_t WS_R = 136 * MiB;
constexpr size_t WS_U = WS_R, WS_Y = WS_R + 48 * MiB;
constexpr size_t WS_Q1 = WS_R, WS_K1 = WS_R + 48 * MiB, WS_V1 = WS_R + 96 * MiB;
constexpr size_t WS_QM = WS_R + 144 * MiB;
constexpr size_t WS_MIX = WS_R + 160 * MiB;
constexpr size_t WS_H = WS_R;
constexpr size_t WS_END = WS_R + 224 * MiB;
constexpr int CW_BAR = 4096;

constexpr int RING_OFF = 0, RING_BYTES = 147456;
constexpr int LDSCTL_OFF = RING_BYTES, MISC_OFF = LDSCTL_OFF + 320;
constexpr int LDS_BYTES = RING_BYTES + 1024;

#define GAS __attribute__((address_space(1)))
#define LAS __attribute__((address_space(3)))
typedef unsigned short bf16;
typedef unsigned v4u __attribute__((ext_vector_type(4)));
typedef unsigned v2u __attribute__((ext_vector_type(2)));
typedef float f32x4 __attribute__((ext_vector_type(4)));
typedef GAS unsigned gu32;
typedef float f32x2 __attribute__((ext_vector_type(2)));
#define RLX_AGENT __ATOMIC_RELAXED, __HIP_MEMORY_SCOPE_AGENT
#define LDS_WAIT() asm volatile("s_waitcnt lgkmcnt(0)" ::: "memory")
#define VM_WAIT() asm volatile("s_waitcnt vmcnt(0)" ::: "memory")
__device__ __forceinline__ unsigned f2bf(float f) { unsigned u = __builtin_bit_cast(unsigned, f); return (u + 0x7fffu + ((u >> 16) & 1u)) >> 16; }
__device__ __forceinline__ unsigned pk2(float lo, float hi) { return f2bf(lo) | (f2bf(hi) << 16); }
__device__ __forceinline__ float bf2f(unsigned short h) { return __uint_as_float(((unsigned)h) << 16); }
__device__ __forceinline__ float bflo(unsigned w) { return __uint_as_float(w << 16); }
__device__ __forceinline__ float bfhi(unsigned w) { return __uint_as_float(w & 0xffff0000u); }

#define XB_TMO      128
#define XB_XCNT(j)  (256  + 64 * (j))
#define XB_XSUB(j)  (1280 + 64 * (j))
#define XB_XGEN(j)  (2304 + 64 * (j))
#define XB_TOP      3328
#define XB_TOPGEN   3392
#define XCD_BAR_WORDS 3456
#define XB_SPIN_CAP (1u << 18)

__device__ __forceinline__ unsigned xb_ld(unsigned* p)              { return __hip_atomic_load(p, __ATOMIC_RELAXED, __HIP_MEMORY_SCOPE_AGENT); }
__device__ __forceinline__ unsigned xb_add(unsigned* p, unsigned v) { return __hip_atomic_fetch_add(p, v, __ATOMIC_RELAXED, __HIP_MEMORY_SCOPE_AGENT); }
__device__ __forceinline__ unsigned xb_xcc_id() { return (unsigned)__builtin_amdgcn_s_getreg((3 << 11) | 20) & 0xFu; }
#define XB_SPIN(cond, bar) do { unsigned _sp = 0; while (cond) { __builtin_amdgcn_s_sleep(1); \
    if ((++_sp & 255u) == 0u) { if (xb_ld(&(bar)[XB_TMO])) break; if (_sp > XB_SPIN_CAP) { atomicAdd(&(bar)[XB_TMO], 1u); break; } } } } while (0)

struct XcdBarrier {
    unsigned* bar; unsigned x;
    volatile LAS unsigned* st;
};

__device__ __forceinline__ XcdBarrier xcd_barrier_post(unsigned* bar, volatile LAS unsigned* st) {
    XcdBarrier b; b.bar = bar; b.x = xb_xcc_id(); b.st = st;
    if (threadIdx.x == 0) (void)xb_add(&bar[XB_XCNT(b.x)], 1u);
    return b;
}
__device__ __forceinline__ void xcd_barrier_complete(unsigned* bar, unsigned x, unsigned& nloc, unsigned& nx) {
    const unsigned G = gridDim.x * gridDim.y * gridDim.z;
    unsigned sum, cnt, mine, sp = 0u;
    for (;;) {
        sum = 0u; cnt = 0u; mine = 0u;
#pragma unroll
        for (unsigned j = 0; j < 16; ++j) { const unsigned c = xb_ld(&bar[XB_XCNT(j)]); sum += c; cnt += (c > 0u) ? 1u : 0u; mine = (j == x) ? c : mine; }
        if (sum == G) break;
        __builtin_amdgcn_s_sleep(1);
        if ((++sp & 255u) == 0u) { if (xb_ld(&bar[XB_TMO])) break; if (sp > XB_SPIN_CAP) { atomicAdd(&bar[XB_TMO], 1u); break; } }
    }
    nloc = mine > 0u ? mine : 1u; nx = cnt > 0u ? cnt : 1u;
}

__device__ __forceinline__ void xcd_barrier(const XcdBarrier& b) {
    asm volatile("s_waitcnt vmcnt(0)" ::: "memory");
    __syncthreads();
    if (threadIdx.x == 0) {
        unsigned* bar = b.bar;
        __builtin_amdgcn_s_waitcnt(0);
        unsigned nloc = b.st[0], nx = b.st[1];
        if (nloc == 0u) { xcd_barrier_complete(bar, b.x, nloc, nx); b.st[0] = nloc; b.st[1] = nx; }
        const unsigned old = xb_add(&bar[XB_XSUB(b.x)], 1u);
        const unsigned gen = old / nloc;
        if (old + 1u == (gen + 1u) * nloc) {
            __builtin_amdgcn_fence(__ATOMIC_RELEASE, "agent");
            asm volatile("s_waitcnt vmcnt(0)" ::: "memory");
            const unsigned og = xb_add(&bar[XB_TOP], 1u);
            const unsigned tg = og / nx;
            if (og + 1u == (tg + 1u) * nx) xb_add(&bar[XB_TOPGEN], 1u);
            else XB_SPIN(xb_ld(&bar[XB_TOPGEN]) == tg, bar);
            __builtin_amdgcn_fence(__ATOMIC_ACQUIRE, "agent");
            xb_add(&bar[XB_XGEN(b.x)], 1u);
            asm volatile("s_waitcnt vmcnt(0)" ::: "memory");
        } else {
            XB_SPIN(xb_ld(&bar[XB_XGEN(b.x)]) == gen, bar);
            __builtin_amdgcn_fence(__ATOMIC_ACQUIRE, "agent");
            asm volatile("s_waitcnt vmcnt(0)" ::: "memory");
        }
    }
    __syncthreads();
}
namespace attn_body {
using bf16=__hip_bfloat16;
using bf16x8=__attribute__((ext_vector_type(8)))short;
using s16x4=__attribute__((ext_vector_type(4)))short;
using f32x16=__attribute__((ext_vector_type(16)))float;
using u32x4=__attribute__((ext_vector_type(4)))unsigned;
constexpr int D=64;
constexpr int NW=8,QBLK=32,QB=QBLK*NW,KVBLK=64;
__device__ __forceinline__ int crow(int r,int hi){return (r&3)+8*(r>>2)+4*hi;}
#define SBAR() __builtin_amdgcn_sched_barrier(0)
__device__ __forceinline__ void cmask(f32x16&p0,f32x16&p1,int jb,int qrel,int hi){
  const float NEG=-INFINITY; int kb=64*jb+4*hi;
  #pragma unroll
  for(int r=0;r<16;++r){int kv=kb+(r&3)+8*(r>>2); if(kv>qrel)p0[r]=NEG; if(kv+32>qrel)p1[r]=NEG;}
}

constexpr int NSLOT=3, SLOTB=8192;
constexpr int LDS_K=0, LDS_V=NSLOT*SLOTB, LDS_WS=2*NSLOT*SLOTB, LDS_OST=LDS_WS+NW*64*4, LDS_BYTES=LDS_OST+NW*4096;
__device__ __forceinline__ void glds16(const void*gsrc,unsigned lds_dst){unsigned keep;
  asm volatile("s_mov_b32 %0, m0\n\ts_mov_b32 m0, %2\n\ts_nop 0\n\tglobal_load_lds_dwordx4 %1, off\n\ts_mov_b32 m0, %0":"=&s"(keep):"v"(gsrc),"s"(lds_dst):"memory");}
__device__ __forceinline__ float max3f(float a,float b,float c){float r;asm("v_max3_f32 %0, %1, %2, %3":"=v"(r):"v"(a),"v"(b),"v"(c));return r;}
__device__ __forceinline__ float max2f(float a,float b){float r;asm("v_max_f32_e32 %0, %1, %2":"=v"(r):"v"(a),"v"(b));return r;}
__device__ __forceinline__ float fadd_s(float a,float b){float r;asm("v_add_f32_e32 %0, %1, %2":"=v"(r):"v"(a),"v"(b));return r;}
__device__ __forceinline__ float fsub_s(float a,float b){float r;asm("v_sub_f32_e32 %0, %1, %2":"=v"(r):"v"(a),"v"(b));return r;}
typedef float f32x2_t __attribute__((ext_vector_type(2))); typedef float f32x4_t __attribute__((ext_vector_type(4))); typedef __bf16 bf16x2_t __attribute__((ext_vector_type(2)));
__device__ __forceinline__ unsigned cvtpk_s(float lo,float hi){f32x2_t v={lo,hi};bf16x2_t b=__builtin_convertvector(v,bf16x2_t);return __builtin_bit_cast(unsigned,b);}
#define WAIT_BAR(N) asm volatile("s_waitcnt vmcnt(" #N ") lgkmcnt(0)\n\ts_barrier":::"memory")

__device__ __forceinline__ void qkt(f32x16&p0,f32x16&p1,const char*Kslot,const bf16x8*qr,int r32,int hi){
  const char*kb=Kslot+hi*1024+r32*16;
  #pragma unroll
  for(int d0=0;d0<4;++d0){
    const bf16x8 b0=*reinterpret_cast<const bf16x8*>(kb+d0*2048);
    const bf16x8 b1=*reinterpret_cast<const bf16x8*>(kb+d0*2048+512);
    p0=__builtin_amdgcn_mfma_f32_32x32x16_bf16(b0,qr[d0],p0,0,0,0);p1=__builtin_amdgcn_mfma_f32_32x32x16_bf16(b1,qr[d0],p1,0,0,0);}
}
typedef __attribute__((address_space(3))) const char* lds_cptr;
typedef short v4i16_t __attribute__((ext_vector_type(4)));
__device__ __forceinline__ void kload8(bf16x8*kf,lds_cptr kp){
  kf[0]=*(const __attribute__((address_space(3))) bf16x8*)(kp);      kf[1]=*(const __attribute__((address_space(3))) bf16x8*)(kp+512);
  kf[2]=*(const __attribute__((address_space(3))) bf16x8*)(kp+2048); kf[3]=*(const __attribute__((address_space(3))) bf16x8*)(kp+2560);
  kf[4]=*(const __attribute__((address_space(3))) bf16x8*)(kp+4096); kf[5]=*(const __attribute__((address_space(3))) bf16x8*)(kp+4608);
  kf[6]=*(const __attribute__((address_space(3))) bf16x8*)(kp+6144); kf[7]=*(const __attribute__((address_space(3))) bf16x8*)(kp+6656);
}
__device__ __forceinline__ void kload2(bf16x8*kf,lds_cptr kp,int j){ kf[2*j]=*(const __attribute__((address_space(3))) bf16x8*)(kp+j*2048); kf[2*j+1]=*(const __attribute__((address_space(3))) bf16x8*)(kp+j*2048+512); }
__device__ __forceinline__ s16x4 vtr(lds_cptr p){ return __builtin_bit_cast(s16x4,__builtin_amdgcn_ds_read_tr16_b64_v4i16((__attribute__((address_space(3))) v4i16_t*)p)); }
__device__ __forceinline__ float rowmax(const f32x16&p0,const f32x16&p1){
  float a=max3f(p0[0],p0[1],p1[0]),b=max3f(p0[2],p0[3],p1[1]);a=max3f(a,p1[2],p1[3]);
  #pragma unroll
  for(int r=4;r<16;r+=4){a=max3f(a,p0[r],p0[r+1]);b=max3f(b,p0[r+2],p0[r+3]);a=max3f(a,p1[r],p1[r+1]);b=max3f(b,p1[r+2],p1[r+3]);}
  const float m=max2f(a,b);
  auto rr=__builtin_amdgcn_permlane32_swap(__float_as_uint(m),__float_as_uint(m),false,false);
  return max2f(__uint_as_float(rr[0]),__uint_as_float(rr[1]));
}
__device__ __forceinline__ void pv(f32x16*o,int vb,bf16x8 pa0,bf16x8 pa1,bf16x8 pa2,bf16x8 pa3){
  #pragma unroll
  for(int d0=0;d0<2;++d0){s16x4 lo[4],hi[4];
    #pragma unroll
    for(int ks=0;ks<4;++ks){
      asm volatile("ds_read_b64_tr_b16 %0,%1 offset:%c2":"=&v"(lo[ks]):"v"(vb),"i"(d0*4096+ks*1024):"memory");
      asm volatile("ds_read_b64_tr_b16 %0,%1 offset:%c2":"=&v"(hi[ks]):"v"(vb),"i"(d0*4096+ks*1024+512):"memory");}
    asm volatile("s_waitcnt lgkmcnt(0)":::"memory");SBAR();
    #define PK(k) (bf16x8){lo[k][0],lo[k][1],lo[k][2],lo[k][3],hi[k][0],hi[k][1],hi[k][2],hi[k][3]}
    o[d0]=__builtin_amdgcn_mfma_f32_32x32x16_bf16(pa0,PK(0),o[d0],0,0,0);
    o[d0]=__builtin_amdgcn_mfma_f32_32x32x16_bf16(pa1,PK(1),o[d0],0,0,0);
    o[d0]=__builtin_amdgcn_mfma_f32_32x32x16_bf16(pa2,PK(2),o[d0],0,0,0);
    o[d0]=__builtin_amdgcn_mfma_f32_32x32x16_bf16(pa3,PK(3),o[d0],0,0,0);
    #undef PK
  }
}

#ifndef ATTN_STORE16
#define ATTN_STORE16(p,v) (*(u32x4*)(p)=(v))
#endif
template<int MODE,int THRL,int QP,int KP,int OP> __device__ __forceinline__ void attn_unit(const bf16*Qw0,const bf16*__restrict__ Kh,const bf16*__restrict__ Vh,bf16*Ow0,const int NT,
                                                                                          const float slope2,const float*kms0,const float*kms1,const int qb,char*shm){
  int tid_=threadIdx.x; asm volatile("":"+v"(tid_));
  const int tid=tid_,lane=tid&63,r32=lane&31,hi=lane>>5; const int wid=__builtin_amdgcn_readfirstlane(tid>>6);
  const bf16*Qw=Qw0+(long)(wid*QBLK)*QP;
  const unsigned lds0=(unsigned)(uintptr_t)shm;
  float*wsf=(float*)(shm+LDS_WS)+wid*64;
  const bf16*ksrc=Kh+(long)lane*KP+wid*8;
  const bf16*vsrc=Vh+(long)(16*(wid&3)+(lane>>2))*KP+(wid>>2)*32+(lane&3)*8;
  const unsigned kdst=lds0+LDS_K+wid*1024, vdst=lds0+LDS_V+wid*1024;
  #define PT(t) ((MODE==0)?(NT-1-(t)):(((t)<NT-4)?(NT-5-(t)):(t)))
  #define DMA_K(t,slot) glds16(ksrc+(long)PT(t)*KVBLK*KP,(unsigned)__builtin_amdgcn_readfirstlane(kdst+(slot)))
  #define DMA_V(t,slot) glds16(vsrc+(long)PT(t)*KVBLK*KP,(unsigned)__builtin_amdgcn_readfirstlane(vdst+(slot)))
  const int vb0=(int)(lds0+LDS_V)+((lane>>4)&1)*32+(lane&3)*8+(4*hi+((lane&15)>>2))*64;
  const char*Kbase=shm+LDS_K; bf16x8 kf[8];
  const lds_cptr shm3=(lds_cptr)shm; const lds_cptr kp0=shm3+LDS_K+hi*1024+r32*16; const lds_cptr vp0=shm3+LDS_V+((lane>>4)&1)*32+(lane&3)*8+(4*hi+((lane&15)>>2))*64;
  DMA_K(0,0);DMA_V(0,0);DMA_K(1,SLOTB);
  bf16x8 qr[4];
  #pragma unroll
  for(int d0=0;d0<4;++d0)qr[d0]=*reinterpret_cast<const bf16x8*>(&Qw[(long)r32*QP+d0*16+hi*8]);
  unsigned selm=0xffffffffu;
  if constexpr(MODE==1){
    f32x16 G=f32x16{};
    #pragma unroll
    for(int d0=0;d0<4;++d0){
      bf16x8 ah=bf16x8{},al=bf16x8{};
      if(r32<16){ const float*p0_=kms0+r32*64+d0*16+hi*8,*p1_=kms1+r32*64+d0*16+hi*8;
        const f32x4_t s0=*reinterpret_cast<const f32x4_t*>(p0_)+*reinterpret_cast<const f32x4_t*>(p1_), s1=*reinterpret_cast<const f32x4_t*>(p0_+4)+*reinterpret_cast<const f32x4_t*>(p1_+4);
        const float km_[8]={s0[0],s0[1],s0[2],s0[3],s1[0],s1[1],s1[2],s1[3]};
        #pragma unroll
        for(int i_=0;i_<8;i_+=2){ const unsigned wh_=cvtpk_s(km_[i_],km_[i_+1]); const float r0_=km_[i_]-__uint_as_float(wh_<<16), r1_=km_[i_+1]-__uint_as_float(wh_&0xffff0000u); const unsigned wl_=cvtpk_s(r0_,r1_);
          ah[i_]=(short)(wh_&0xffffu); ah[i_+1]=(short)(wh_>>16); al[i_]=(short)(wl_&0xffffu); al[i_+1]=(short)(wl_>>16); } }
      G=__builtin_amdgcn_mfma_f32_32x32x16_bf16(ah,qr[d0],G,0,0,0); G=__builtin_amdgcn_mfma_f32_32x32x16_bf16(al,qr[d0],G,0,0,0);}
    float g[16];
    #pragma unroll
    for(int r=0;r<4;++r){ const float a=G[r],b=G[4+r]; const float oa=__shfl_xor(a,32),ob=__shfl_xor(b,32);
      g[r]=hi?oa:a; g[4+r]=hi?a:oa; g[8+r]=hi?ob:b; g[12+r]=hi?b:ob; }
    #pragma unroll
    for(int n=0;n<16;++n) if(n>=qb) g[n]=-1.0e30f;
    const int nsel=qb<3?qb:3; unsigned mask=0u;
    #pragma unroll
    for(int rr=0;rr<3;++rr){ float best=-3.0e38f; int bi=0;
      #pragma unroll
      for(int n=0;n<16;++n){ const bool c=!((mask>>n)&1u)&&g[n]>best; best=c?g[n]:best; bi=c?n:bi; }
      if(rr<nsel) mask|=1u<<bi; }
    selm=mask|(1u<<qb);
  }
  float mhat=0.f,l_reg=0.f;f32x16 o[2];o[0]=f32x16{};o[1]=f32x16{};
  const int qrel=wid*QBLK+r32;
  const float hb=(MODE==1)?slope2*(float)(4*hi):0.f, s32=(MODE==1)?32.f*slope2:0.f, s64=(MODE==1)?64.f*slope2:0.f;
  #define CBASE(b0_,b1_,t) float b0_=fsub_s(fadd_s(s64*(float)PT(t),hb),mhat); if(MODE==1){ if(!((selm>>(PT(t)>>2))&1u)) b0_=-3.0e38f; } const float b1_=b0_+s32
  #define CFILL(X,B,bb) do{ _Pragma("unroll") for(int i_=0;i_<4;++i_){ if(MODE==1) X[(B)+i_]=__builtin_fmaf(slope2,(float)((((B)+i_)&3)+8*(((B)+i_)>>2)),bb); else X[(B)+i_]=bb; } }while(0)
  #define CINIT(C0,C1,t) do{ CBASE(b0_,b1_,t); CFILL(C0,0,b0_);CFILL(C0,4,b0_);CFILL(C0,8,b0_);CFILL(C0,12,b0_);CFILL(C1,0,b1_);CFILL(C1,4,b1_);CFILL(C1,8,b1_);CFILL(C1,12,b1_); }while(0)
  #define CMASK(P0,P1,t) do{ if(MODE==1){ int jb_=(t)-(NT-4); if(jb_>=0)cmask(P0,P1,jb_,qrel,hi);} }while(0)
  bool resc=false;
  #define START(P0,P1) do{ const float rm=rowmax(P0,P1); resc=false; \
    { const float dl=__builtin_fmaxf(rm,-1000.f); mhat=fadd_s(mhat,dl); \
      _Pragma("unroll") for(int r=0;r<16;++r){P0[r]=fsub_s(P0[r],dl);P1[r]=fsub_s(P1[r],dl);} } \
    _Pragma("unroll") for(int r=0;r<16;++r)P0[r]=__builtin_amdgcn_exp2f(P0[r]); }while(0)
  #define RESC() do{ if(resc){ asm volatile("s_waitcnt lgkmcnt(0)":::"memory"); \
      _Pragma("unroll") for(int d_=0;d_<2;++d_) _Pragma("unroll") for(int r=0;r<16;++r)o[d_][r]*=wsf[crow(r,hi)]; } }while(0)
  f32x16 pA0,pA1,pB0,pB1;
  int sl_prev=0,sl_cur=0,sl_next=SLOTB;
  #define ROT() do{sl_prev=sl_cur;sl_cur=sl_next;sl_next=(sl_next==(NSLOT-1)*SLOTB)?0:sl_next+SLOTB;}while(0)
  DMA_K(2,2*SLOTB);
  WAIT_BAR(3);
  CINIT(pA0,pA1,0);
  qkt(pA0,pA1,Kbase,qr,r32,hi);asm volatile("s_nop 15\n\ts_nop 7":"+v"(pA0),"+v"(pA1));CMASK(pA0,pA1,0);
  START(pA0,pA1);
  _Pragma("unroll") for(int r=0;r<16;++r)pA1[r]=__builtin_amdgcn_exp2f(pA1[r]);
  WAIT_BAR(0);
  DMA_K(3,0);DMA_V(1,SLOTB);
  ROT();
  kload8(kf,kp0+sl_cur);
  WAIT_BAR(2);
  s16x4 vlo[8],vhi[8]; u32x4 pw0,pw1,pw2,pw3;
  #define PKW(P,B) cvtpk_s(P[B],P[B+1])
  #define PAF(k) __builtin_bit_cast(bf16x8,pw##k)
  #define VFR(i) (bf16x8){vlo[i][0],vlo[i][1],vlo[i][2],vlo[i][3],vhi[i][0],vhi[i][1],vhi[i][2],vhi[i][3]}
  #define PIN(x) asm volatile("":"+v"(x))
  #define MX3(a,b,c) __builtin_fmaxf(__builtin_fmaxf((a),(b)),(c))
  #define GAPA(MF,A0,A1,A2,A3,W0,W1,PW) do{ MF; sacc+=A0; sacc+=A1; sacc+=A2; sacc+=A3; PIN(sacc); W0; W1; PIN(PW); SBAR(); }while(0)
  #define EX(v) __builtin_amdgcn_exp2f(v)
  #define GAPB(MF,X,B,N,bb) do{ MF; X[B]=EX(X[B]); X[B+1]=EX(X[B+1]); X[B+2]=EX(X[B+2]); X[B+3]=EX(X[B+3]); PIN(X); CFILL(N,B,bb); PIN(N); SBAR(); }while(0)
  #define VRD(i) do{ vlo[i]=vtr(vp_+(((i)>>2)*4096+((i)&3)*1024)); vhi[i]=vtr(vp_+(((i)>>2)*4096+((i)&3)*1024+512)); }while(0)
  #define KRD(G,j) do{ if(G){ kload2(kf,kp0+sl_next,j); SBAR(); } }while(0)
  #define STEP(C0,C1,P0,P1,t,GK,GV,GL) do{ SBAR(); \
    const lds_cptr vp_=vp0+sl_prev; \
    VRD(0); SBAR(); float sacc=(P0[0]+P0[1]); \
    GAPA(C0=__builtin_amdgcn_mfma_f32_32x32x16_bf16(kf[0],qr[0],C0,0,0,0), P0[2],P0[3],P0[4],P0[5],     pw0[0]=PKW(P0,0), pw0[1]=PKW(P0,2), pw0); \
    VRD(4); SBAR(); GAPA(C1=__builtin_amdgcn_mfma_f32_32x32x16_bf16(kf[1],qr[0],C1,0,0,0), P0[6],P0[7],P0[8],P0[9],     pw0[2]=PKW(P0,4), pw0[3]=PKW(P0,6), pw0); \
    VRD(1); SBAR(); GAPA(C0=__builtin_amdgcn_mfma_f32_32x32x16_bf16(kf[2],qr[1],C0,0,0,0),   P0[10],P0[11],P0[12],P0[13], pw1[0]=PKW(P0,8), pw1[1]=PKW(P0,10), pw1); \
    VRD(5); SBAR(); GAPA(C1=__builtin_amdgcn_mfma_f32_32x32x16_bf16(kf[3],qr[1],C1,0,0,0),   P0[14],P0[15],P1[0],P1[1],   pw1[2]=PKW(P0,12),pw1[3]=PKW(P0,14), pw1); \
    VRD(2); SBAR(); GAPA(C0=__builtin_amdgcn_mfma_f32_32x32x16_bf16(kf[4],qr[2],C0,0,0,0),   P1[2],P1[3],P1[4],P1[5],     pw2[0]=PKW(P1,0), pw2[1]=PKW(P1,2), pw2); \
    VRD(6); SBAR(); GAPA(C1=__builtin_amdgcn_mfma_f32_32x32x16_bf16(kf[5],qr[2],C1,0,0,0),   P1[6],P1[7],P1[8],P1[9],     pw2[2]=PKW(P1,4), pw2[3]=PKW(P1,6), pw2); \
    VRD(3); SBAR(); GAPA(C0=__builtin_amdgcn_mfma_f32_32x32x16_bf16(kf[6],qr[3],C0,0,0,0),   P1[10],P1[11],P1[12],P1[13], pw3[0]=PKW(P1,8), pw3[1]=PKW(P1,10), pw3); \
    VRD(7); SBAR(); GAPA(C1=__builtin_amdgcn_mfma_f32_32x32x16_bf16(kf[7],qr[3],C1,0,0,0),   P1[14],P1[15],0.f,0.f,       pw3[2]=PKW(P1,12),pw3[3]=PKW(P1,14), pw3); \
    l_reg+=sacc; \
    if(GK){DMA_K((t)+3,sl_cur);} if(GV){DMA_V((t)+1,sl_next);} \
    CMASKX(C0,C1,t); \
    { float a=MX3(C0[0],C0[1],C1[0]),b=MX3(C0[2],C0[3],C1[1]); a=MX3(a,C1[2],C1[3]); \
      _Pragma("unroll") for(int r=4;r<16;r+=4){a=MX3(a,C0[r],C0[r+1]);b=MX3(b,C0[r+2],C0[r+3]);a=MX3(a,C1[r],C1[r+1]);b=MX3(b,C1[r+2],C1[r+3]);} \
      float rm=__builtin_fmaxf(a,b); { auto rr=__builtin_amdgcn_permlane32_swap(__float_as_uint(rm),__float_as_uint(rm),false,false); rm=__builtin_fmaxf(__uint_as_float(rr[0]),__uint_as_float(rr[1])); } \
      resc=false; \
      if(__builtin_expect(__any(rm>(float)THRL),0)){ const float dl=__builtin_fmaxf(rm,0.f); mhat+=dl; \
        _Pragma("unroll") for(int r=0;r<16;++r){C0[r]-=dl;C1[r]-=dl;} \
        const float f=__builtin_amdgcn_exp2f(-dl); l_reg*=f; if(hi==0)wsf[r32]=f; resc=true; } } \
    CBASE(n0_,n1_,(t)+1);                                   \
    SBAR(); \
    GAPB(o[0]=__builtin_amdgcn_mfma_f32_32x32x16_bf16(PAF(0),VFR(0),o[0],0,0,0), C0,0, P0,n0_); \
    GAPB(o[1]=__builtin_amdgcn_mfma_f32_32x32x16_bf16(PAF(0),VFR(4),o[1],0,0,0), C0,4, P0,n0_); \
    KRD(GL,0); GAPB(o[0]=__builtin_amdgcn_mfma_f32_32x32x16_bf16(PAF(1),VFR(1),o[0],0,0,0), C0,8, P0,n0_); \
    KRD(GL,1); GAPB(o[1]=__builtin_amdgcn_mfma_f32_32x32x16_bf16(PAF(1),VFR(5),o[1],0,0,0), C0,12, P0,n0_); \
    KRD(GL,2); GAPB(o[0]=__builtin_amdgcn_mfma_f32_32x32x16_bf16(PAF(2),VFR(2),o[0],0,0,0), C1,0, P1,n1_); \
    KRD(GL,3); GAPB(o[1]=__builtin_amdgcn_mfma_f32_32x32x16_bf16(PAF(2),VFR(6),o[1],0,0,0), C1,4, P1,n1_); \
    GAPB(o[0]=__builtin_amdgcn_mfma_f32_32x32x16_bf16(PAF(3),VFR(3),o[0],0,0,0), C1,8, P1,n1_); \
    GAPB(o[1]=__builtin_amdgcn_mfma_f32_32x32x16_bf16(PAF(3),VFR(7),o[1],0,0,0), C1,12, P1,n1_); \
    }while(0)
  int t=1;
  CINIT(pB0,pB1,1);
  #define ENDW(tt) do{ if((tt)+3<NT){WAIT_BAR(2);} else if((tt)+2<NT){WAIT_BAR(1);} else {WAIT_BAR(0);} }while(0)
  #define CMASKX(P0,P1,t) CMASK(P0,P1,t)
  for(;t+1<NT&&t<5;t+=2){
    STEP(pB0,pB1,pA0,pA1,t,(t+3<NT),(t+1<NT),(t+1<NT));       ENDW(t);   RESC(); ROT();
    STEP(pA0,pA1,pB0,pB1,t+1,(t+4<NT),(t+2<NT),(t+2<NT));     ENDW(t+1); RESC(); ROT();
  }
  #undef CMASKX
  #define CMASKX(P0,P1,t) do{}while(0)
  for(;t+5<NT;t+=2){
    STEP(pB0,pB1,pA0,pA1,t,true,true,true);     WAIT_BAR(2); RESC(); ROT();
    STEP(pA0,pA1,pB0,pB1,t+1,true,true,true);   WAIT_BAR(2); RESC(); ROT();
  }
  #undef CMASKX
  #define CMASKX(P0,P1,t) CMASK(P0,P1,t)
  for(;t+1<NT;t+=2){
    STEP(pB0,pB1,pA0,pA1,t,(t+3<NT),(t+1<NT),(t+1<NT));       ENDW(t);   RESC(); ROT();
    STEP(pA0,pA1,pB0,pB1,t+1,(t+4<NT),(t+2<NT),(t+2<NT));     ENDW(t+1); RESC(); ROT();
  }
  STEP(pB0,pB1,pA0,pA1,NT-1,false,false,false); RESC();
  { float sacc=pB0[0]+pB0[1]; _Pragma("unroll") for(int r=2;r<16;++r)sacc+=pB0[r]; _Pragma("unroll") for(int r=0;r<16;++r)sacc+=pB1[r]; l_reg+=sacc;
    pw0=(u32x4){PKW(pB0,0),PKW(pB0,2),PKW(pB0,4),PKW(pB0,6)};pw1=(u32x4){PKW(pB0,8),PKW(pB0,10),PKW(pB0,12),PKW(pB0,14)};pw2=(u32x4){PKW(pB1,0),PKW(pB1,2),PKW(pB1,4),PKW(pB1,6)};pw3=(u32x4){PKW(pB1,8),PKW(pB1,10),PKW(pB1,12),PKW(pB1,14)};
    SBAR(); pv(o,vb0+sl_cur,PAF(0),PAF(1),PAF(2),PAF(3)); }
  #undef PKW
  #undef PAF
  #undef VFR
  #undef PIN
  #undef MX3
  #undef GAPA
  #undef GAPB
  #undef EX
  #undef VRD
  #undef KRD
  #undef STEP
  #undef ENDW
  #undef CMASKX
  {auto rr=__builtin_amdgcn_permlane32_swap(__float_as_uint(l_reg),__float_as_uint(l_reg),false,false);l_reg=__uint_as_float(rr[0])+__uint_as_float(rr[1]);}
  if(hi==0)wsf[32+r32]=l_reg;asm volatile("s_waitcnt lgkmcnt(0)":::"memory");
  float rli[16];
  #pragma unroll
  for(int r=0;r<16;++r)rli[r]=__builtin_amdgcn_rcpf(wsf[32+crow(r,hi)]);
  bf16*Ow=Ow0+(long)(wid*QBLK)*OP;
  { bf16*stg=(bf16*)(shm+LDS_OST)+wid*2048;
    #pragma unroll
    for(int r=0;r<16;++r){const int orow=crow(r,hi);
      #pragma unroll
      for(int d0=0;d0<2;++d0)stg[orow*64+d0*32+r32]=__float2bfloat16(o[d0][r]*rli[r]);}
    asm volatile("s_waitcnt lgkmcnt(0)":::"memory");
    #pragma unroll
    for(int i=0;i<4;++i){const int row=i*8+(lane>>3),ch=lane&7; const u32x4 v=*(const u32x4*)(stg+row*64+ch*8); ATTN_STORE16(Ow+(long)row*OP+ch*8,v);} }
  asm volatile("s_waitcnt lgkmcnt(0)\n\ts_barrier":::"memory");
  #undef DMA_K
  #undef DMA_V
  #undef CMASK
  #undef CINIT
  #undef CBASE
  #undef CFILL
  #undef PT
  #undef START
  #undef RESC
  #undef ROT
}
constexpr int ATTN_LDS_BYTES=LDS_BYTES;
#undef SBAR
#undef WAIT_BAR
}
__device__ __forceinline__ float wave_sum(float v) {
#pragma unroll
    for (int o = 1; o < 64; o <<= 1) v += __shfl_xor(v, o);
    return v;
}
__device__ __forceinline__ float wave_max(float v) {
#pragma unroll
    for (int o = 1; o < 64; o <<= 1) v = fmaxf(v, __shfl_xor(v, o));
    return v;
}
__device__ __forceinline__ int opaque_zero() { int z; asm volatile("v_mov_b32 %0, 0" : "=v"(z)); return z; }

__device__ __forceinline__ void p0_transpose_item(const float* W, int K, int N, bf16* WT, int dest_row0, int k0, int n0, const float* gk, LAS float* scr, int lane) {
    float wv[32];
#pragma unroll
    for (int i = 0; i < 32; ++i) { const int kk = 2 * i + (lane >> 5); wv[i] = W[(size_t)(k0 + kk) * N + n0 + (lane & 31)]; }
    if (gk) {
#pragma unroll
        for (int i = 0; i < 32; ++i) wv[i] *= gk[k0 + 2 * i + (lane >> 5)]; }
#pragma unroll
    for (int i = 0; i < 32; ++i) { const int kk = 2 * i + (lane >> 5); scr[kk * 33 + (lane & 31)] = wv[i]; }
    LDS_WAIT(); asm volatile("" ::: "memory");
    const int c = lane & 7;
#pragma unroll
    for (int j = 0; j < 4; ++j) { const int n = (lane >> 3) + 8 * j; const LAS float* s = scr + (8 * c) * 33 + n;
        v4u o; o.x = pk2(s[0 * 33], s[1 * 33]); o.y = pk2(s[2 * 33], s[3 * 33]); o.z = pk2(s[4 * 33], s[5 * 33]); o.w = pk2(s[6 * 33], s[7 * 33]);
        *(GAS v4u*)(WT + (size_t)(dest_row0 + n) * K + k0 + 8 * c) = o; }
    LDS_WAIT(); asm volatile("" ::: "memory");
}
__device__ __forceinline__ void p0_matrix_item(const float* W, int K, int N, bf16* WT, const float* gk, int mode, int item, LAS float* scr, int lane) {
    const int nblk = N / 32, kb = item / nblk, nb = item - kb * nblk, k0 = 64 * kb, n0 = 32 * nb;
    const int dr = (mode == 0) ? n0 : (256 * (n0 >> 7) + (n0 & 127) + (mode == 2 ? 128 : 0));
    p0_transpose_item(W, K, N, WT, dr, k0, n0, gk, scr, lane);
}
template <int NR>
__device__ __forceinline__ void rows_to_bf16_ssq(const float* xrow, bf16* orow, float* ssq16, int lane) {
    f32x4 v[NR][4];
#pragma unroll
    for (int r = 0; r < NR; ++r) { const GAS f32x4* xr = (const GAS f32x4*)(xrow + (size_t)r * 1024) + lane;
#pragma unroll
        for (int j = 0; j < 4; ++j) v[r][j] = xr[64 * j]; }
#pragma unroll
    for (int r = 0; r < NR; ++r) { float s = 0.f;
#pragma unroll
        for (int j = 0; j < 4; ++j) s += (v[r][j].x * v[r][j].x + v[r][j].y * v[r][j].y) + (v[r][j].z * v[r][j].z + v[r][j].w * v[r][j].w);
        s = wave_sum(s);
        GAS unsigned long long* o8 = (GAS unsigned long long*)(orow + (size_t)r * 1024) + lane;
#pragma unroll
        for (int j = 0; j < 4; ++j) o8[64 * j] = (unsigned long long)pk2(v[r][j].x, v[r][j].y) | ((unsigned long long)pk2(v[r][j].z, v[r][j].w) << 32);
        if (lane < 16) ssq16[r * 16 + lane] = (lane == 0) ? s : 0.f; }
}

__device__ __forceinline__ void s5_naive_unit(int b, int g, const bf16* U, bf16* Y, const float* lam_re, const float* lam_im, const float* log_dt, const float* b_re, const float* b_im,
                                              const float* c_re, const float* c_im, const float* dvec, int lane) {
    const int p = lane;
    const float lr = lam_re[g * 64 + p], li = lam_im[g * 64 + p], dt = expf(log_dt[g]);
    const float mag = expf(lr * dt), ar = mag * cosf(li * dt), ai = mag * sinf(li * dt);
    const float den = lr * lr + li * li, nr = ar - 1.0f, fr = (nr * lr + ai * li) / den, fi = (ai * lr - nr * li) / den;
    float bbr[16], bbi[16], cr[16], ci[16];
#pragma unroll
    for (int c = 0; c < 16; ++c) { const float br = b_re[((size_t)g * 64 + p) * 16 + c], bi = b_im[((size_t)g * 64 + p) * 16 + c]; bbr[c] = fr * br - fi * bi; bbi[c] = fr * bi + fi * br;
        cr[c] = c_re[((size_t)g * 16 + c) * 64 + p]; ci[c] = c_im[((size_t)g * 16 + c) * 64 + p]; }
    const int ch = ((lane & 1) << 3) | ((lane & 2) << 1) | ((lane & 4) >> 1) | ((lane & 8) >> 3);
    const float dch = dvec[16 * g + ch];
    const int z0 = opaque_zero();
    constexpr int TP = 16;
    const bf16* up = U + ((size_t)g * TOK + (size_t)b * SEQ) * 16 + z0;
    bf16* yp = Y + ((size_t)g * TOK + (size_t)b * SEQ) * 16 + ch;
    float xr = 0.f, xi = 0.f;
#pragma unroll 2
    for (int s = 0; s < SEQ; ++s) {
        const v4u w0 = *(const GAS v4u*)(up + (size_t)s * TP), w1 = *(const GAS v4u*)(up + (size_t)s * TP + 8);
        const float uch = bf2f(up[(size_t)s * TP + ch]);
        const float uu[16] = {bflo(w0.x), bfhi(w0.x), bflo(w0.y), bfhi(w0.y), bflo(w0.z), bfhi(w0.z), bflo(w0.w), bfhi(w0.w), bflo(w1.x), bfhi(w1.x), bflo(w1.y), bfhi(w1.y), bflo(w1.z), bfhi(w1.z), bflo(w1.w), bfhi(w1.w)};
        float bur = 0.f, bui = 0.f;
#pragma unroll
        for (int c = 0; c < 16; ++c) { bur += bbr[c] * uu[c]; bui += bbi[c] * uu[c]; }
        const float nxr = ar * xr - ai * xi + bur, nxi = ar * xi + ai * xr + bui; xr = nxr; xi = nxi;
        float v[16];
#pragma unroll
        for (int c = 0; c < 16; ++c) v[c] = cr[c] * xr - ci[c] * xi;
        float w[8], x4[4], x2[2], z;
        { const bool bit = lane & 1;
#pragma unroll
          for (int j = 0; j < 8; ++j) { const float send = bit ? v[j] : v[j + 8], keep = bit ? v[j + 8] : v[j]; w[j] = keep + __shfl_xor(send, 1); } }
        { const bool bit = lane & 2;
#pragma unroll
          for (int j = 0; j < 4; ++j) { const float send = bit ? w[j] : w[j + 4], keep = bit ? w[j + 4] : w[j]; x4[j] = keep + __shfl_xor(send, 2); } }
        { const bool bit = lane & 4;
#pragma unroll
          for (int j = 0; j < 2; ++j) { const float send = bit ? x4[j] : x4[j + 2], keep = bit ? x4[j + 2] : x4[j]; x2[j] = keep + __shfl_xor(send, 4); } }
        { const bool bit = lane & 8; const float send = bit ? x2[0] : x2[1], keep = bit ? x2[1] : x2[0]; z = keep + __shfl_xor(send, 8); }
        z += __shfl_xor(z, 16); z += __shfl_xor(z, 32);
        const float yv = z + dch * uch;
        const float ge = 0.5f * yv * (1.0f + erff(yv * 0.70710678118654752f));
        if (lane < 16) yp[(size_t)s * TP] = (bf16)f2bf(ge);
    }
}

__device__ __forceinline__ void memattn_naive_unit(int tok, int h, const bf16* QM, const bf16* memk, const bf16* memv, bf16* mix, LAS float* ps, int lane) {
    const int b = tok >> 12; const int z0 = opaque_zero();
    const float qv = bf2f(QM[(size_t)tok * 256 + h * 64 + lane]);
    float q[64];
#pragma unroll
    for (int d = 0; d < 64; ++d) q[d] = __shfl(qv, d);
    float sc[4];
#pragma unroll
    for (int i = 0; i < 4; ++i) { const int j = lane + 64 * i; const GAS v4u* kr = (const GAS v4u*)(memk + ((size_t)(b * 256 + j)) * 256 + h * 64 + z0); float a = 0.f;
#pragma unroll
        for (int c = 0; c < 8; ++c) { const v4u w = kr[c]; a += q[8 * c] * bflo(w.x) + q[8 * c + 1] * bfhi(w.x) + q[8 * c + 2] * bflo(w.y) + q[8 * c + 3] * bfhi(w.y) + q[8 * c + 4] * bflo(w.z) + q[8 * c + 5] * bfhi(w.z) + q[8 * c + 6] * bflo(w.w) + q[8 * c + 7] * bfhi(w.w); }
        sc[i] = a; }
    const float m = wave_max(fmaxf(fmaxf(sc[0], sc[1]), fmaxf(sc[2], sc[3])));
    float l = 0.f;
#pragma unroll
    for (int i = 0; i < 4; ++i) { const float pe = __builtin_amdgcn_exp2f(sc[i] - m); l += pe; ps[lane + 64 * i] = pe; }
    l = wave_sum(l);
    LDS_WAIT(); asm volatile("" ::: "memory");
    float o = 0.f; const bf16* vp = memv + (size_t)(b * 256) * 256 + h * 64 + lane;
#pragma unroll 8
    for (int j = 0; j < 256; ++j) o += ps[j] * bf2f(vp[(size_t)j * 256]);
    mix[(size_t)tok * 1024 + 768 + h * 64 + lane] = (bf16)f2bf(o / l);
    LDS_WAIT(); asm volatile("" ::: "memory");
}

__device__ __forceinline__ float dot64_bf16(const float (&q)[64], const GAS v4u* kr) {
    float a = 0.f;
#pragma unroll
    for (int c = 0; c < 8; ++c) { const v4u w = kr[c]; a += q[8 * c] * bflo(w.x) + q[8 * c + 1] * bfhi(w.x) + q[8 * c + 2] * bflo(w.y) + q[8 * c + 3] * bfhi(w.y) + q[8 * c + 4] * bflo(w.z) + q[8 * c + 5] * bfhi(w.z) + q[8 * c + 6] * bflo(w.w) + q[8 * c + 7] * bfhi(w.w); }
    return a;
}
__device__ __forceinline__ void moba_naive_unit(int tok, int h, const bf16* Q1, const bf16* K1, const bf16* V1, const float* KMEAN, bf16* mix, LAS float* ps, int lane) {
    const int b = tok >> 12, s = tok & (SEQ - 1), qb = s >> 8; const int z0 = opaque_zero();
    const float qv = bf2f(Q1[(size_t)tok * TOKW + h * 64 + lane]);
    float q[64];
#pragma unroll
    for (int d = 0; d < 64; ++d) q[d] = __shfl(qv, d);
    float gate = -1e30f;
    { const int n = lane & 15; const GAS f32x4* km = (const GAS f32x4*)(KMEAN + ((size_t)((b * NHEAD + h) * NBLK + n)) * 64 + z0); float a = 0.f;
#pragma unroll
      for (int c = 0; c < 16; ++c) { const f32x4 w = km[c]; a += q[4 * c] * w.x + q[4 * c + 1] * w.y + q[4 * c + 2] * w.z + q[4 * c + 3] * w.w; }
      if (n < qb) gate = a; }
    float g[16];
#pragma unroll
    for (int n = 0; n < 16; ++n) g[n] = __shfl(gate, n);
    const int nsel = qb < 3 ? qb : 3;
    unsigned mask = 0u;
#pragma unroll
    for (int r = 0; r < 3; ++r) { float best = -3.0e38f; int bi = 0;
#pragma unroll
        for (int n = 0; n < 16; ++n) { const bool c = !((mask >> n) & 1u) && g[n] > best; best = c ? g[n] : best; bi = c ? n : bi; }
        if (r < nsel) mask |= 1u << bi; }
    int blk0 = 0, blk1 = 0, blk2 = 0, cnt = 0;
#pragma unroll
    for (int n = 0; n < 16; ++n) if ((mask >> n) & 1u) { if (cnt == 0) blk0 = n; else if (cnt == 1) blk1 = n; else blk2 = n; ++cnt; }
    const int nslots = nsel + 1;
    const float slope = __builtin_amdgcn_exp2f(-8.0f * (float)(h + 1) / 12.0f) * LOG2E;
    const bf16* kh = K1 + (size_t)b * SEQ * TOKW + h * 64 + z0;
    float mx = -3.0e38f;
#pragma unroll
    for (int sl = 0; sl < 4; ++sl) if (sl < nslots) {
        const int blk = (sl == nsel) ? qb : (sl == 0 ? blk0 : (sl == 1 ? blk1 : blk2));
#pragma unroll
        for (int i = 0; i < 4; ++i) { const int j = lane + 64 * i, pos = blk * 256 + j;
            float a = dot64_bf16(q, (const GAS v4u*)(kh + (size_t)pos * TOKW)) + slope * (float)(pos - s);
            if (pos > s) a = -3.0e38f;
            ps[sl * 256 + j] = a; mx = fmaxf(mx, a); } }
    mx = wave_max(mx);
    LDS_WAIT(); asm volatile("" ::: "memory");
    float l = 0.f;
#pragma unroll
    for (int sl = 0; sl < 4; ++sl) if (sl < nslots) {
#pragma unroll
        for (int i = 0; i < 4; ++i) { const int j = lane + 64 * i; const float a = ps[sl * 256 + j]; const float pe = (a < -1.0e37f) ? 0.f : __builtin_amdgcn_exp2f(a - mx); l += pe; ps[sl * 256 + j] = pe; } }
    l = wave_sum(l);
    LDS_WAIT(); asm volatile("" ::: "memory");
    float o = 0.f; const bf16* vh = V1 + (size_t)b * SEQ * TOKW + h * 64 + lane;
#pragma unroll
    for (int sl = 0; sl < 4; ++sl) if (sl < nslots) {
        const int blk = (sl == nsel) ? qb : (sl == 0 ? blk0 : (sl == 1 ? blk1 : blk2));
        const bf16* vp = vh + (size_t)(blk * 256) * TOKW;
#pragma unroll 8
        for (int j = 0; j < 256; ++j) o += ps[sl * 256 + j] * bf2f(vp[(size_t)j * TOKW]); }
    mix[(size_t)tok * 1024 + h * 64 + lane] = (bf16)f2bf(o / l);
    LDS_WAIT(); asm volatile("" ::: "memory");
}

constexpr int S5_PITCH = 272;
constexpr int S5_WST = 0, S5_WYC = 128 * S5_PITCH, S5_KT = 2 * 128 * S5_PITCH, S5_TAB_BYTES = S5_KT + 10 * 512;
constexpr int S5_XS = S5_TAB_BYTES, S5_XS_BYTES = 32 * S5_PITCH;
static_assert(S5_XS + NWAVES * S5_XS_BYTES <= RING_BYTES, "S5 LDS map");
typedef short s5_bf16x8 __attribute__((ext_vector_type(8)));
typedef float s5_f32x16 __attribute__((ext_vector_type(16)));

__device__ __forceinline__ void s5_apow(float lr, float li, float dt, int n, float& pr, float& pi) { const float m = expf(lr * dt * (float)n), th = li * dt * (float)n; pr = m * cosf(th); pi = m * sinf(th); }
__device__ __forceinline__ void s5_apow_fast(float lr, float li, float dt, int n, float& pr, float& pi) { const float m = __expf(lr * dt * (float)n), th = li * dt * (float)n; pr = m * __cosf(th); pi = m * __sinf(th); }
__device__ __forceinline__ void s5_zoh(float lr, float li, float dt, float& fr, float& fi) {
    float ar, ai; s5_apow(lr, li, dt, 1, ar, ai); const float den = lr * lr + li * li, nr = ar - 1.0f; fr = (nr * lr + ai * li) / den; fi = (ai * lr - nr * li) / den;
}
__device__ __forceinline__ void s5_tab_wst(int g, int jt, unsigned char* tab, const float* lam_re, const float* lam_im, const float* log_dt, const float* b_re, const float* b_im, int lane) {
    const int s = lane >> 3, cp = lane & 7; const float dt = expf(log_dt[g]);
#pragma unroll 4
    for (int r = 0; r < 32; ++r) { const int p = (jt >> 1) * 32 + r; const float lr = lam_re[g * 64 + p], li = lam_im[g * 64 + p];
        float pr, pi, fr, fi; s5_apow_fast(lr, li, dt, 7 - s, pr, pi); s5_zoh(lr, li, dt, fr, fi);
        float o[2];
#pragma unroll
        for (int e = 0; e < 2; ++e) { const int c = 2 * cp + e; const float br = b_re[((size_t)g * 64 + p) * 16 + c], bi = b_im[((size_t)g * 64 + p) * 16 + c];
            const float bbr = fr * br - fi * bi, bbi = fr * bi + fi * br; o[e] = (jt & 1) ? (pr * bbi + pi * bbr) : (pr * bbr - pi * bbi); }
        *(GAS unsigned*)(tab + S5_WST + (32 * jt + r) * S5_PITCH + (16 * s + 2 * cp) * 2) = pk2(o[0], o[1]); }
}
__device__ __forceinline__ void s5_tab_wyc(int g, int t, unsigned char* tab, const float* lam_re, const float* lam_im, const float* log_dt, const float* c_re, const float* c_im, int lane) {
    const int p = lane; const float dt = expf(log_dt[g]); float pr, pi; s5_apow_fast(lam_re[g * 64 + p], lam_im[g * 64 + p], dt, t + 1, pr, pi);
#pragma unroll
    for (int c = 0; c < 16; ++c) { const float cr = c_re[((size_t)g * 16 + c) * 64 + p], ci = c_im[((size_t)g * 16 + c) * 64 + p];
        *(GAS unsigned*)(tab + S5_WYC + (16 * t + c) * S5_PITCH + 4 * p) = pk2(cr * pr - ci * pi, -(cr * pi + ci * pr)); }
}
__device__ __forceinline__ void s5_tab_kt(int g, int d, unsigned char* tab, const float* lam_re, const float* lam_im, const float* log_dt, const float* b_re, const float* b_im, const float* c_re, const float* c_im,
                                          const float* dvec, int lane) {
    const float dt = expf(log_dt[g]); float mr, mi;
    { const float lr = lam_re[g * 64 + lane], li = lam_im[g * 64 + lane]; float pr, pi, fr, fi; s5_apow_fast(lr, li, dt, d, pr, pi); s5_zoh(lr, li, dt, fr, fi); mr = pr * fr - pi * fi; mi = pr * fi + pi * fr; }
    float acc[4] = {0.f, 0.f, 0.f, 0.f};
#pragma unroll 8
    for (int p = 0; p < 64; ++p) { const float pmr = __shfl(mr, p), pmi = __shfl(mi, p);
#pragma unroll
        for (int i = 0; i < 4; ++i) { const int e = lane + 64 * i, c = e >> 4, c2 = e & 15;
            const float br = b_re[((size_t)g * 64 + p) * 16 + c2], bi = b_im[((size_t)g * 64 + p) * 16 + c2], cr = c_re[((size_t)g * 16 + c) * 64 + p], ci = c_im[((size_t)g * 16 + c) * 64 + p];
            const float tr = pmr * br - pmi * bi, ti = pmr * bi + pmi * br; acc[i] += cr * tr - ci * ti; } }
#pragma unroll
    for (int i = 0; i < 4; ++i) { const int e = lane + 64 * i, c = e >> 4, c2 = e & 15; float v = acc[i]; if (d == 0 && c == c2) v += dvec[16 * g + c];
        *(GAS bf16*)(tab + S5_KT + (d + 1) * 512 + c * 32 + c2 * 2) = (bf16)f2bf(v);
        if (d == 0) *(GAS bf16*)(tab + S5_KT + c * 32 + c2 * 2) = (bf16)0; }
}

template <bool FINAL>
__device__ __forceinline__ void s5_unit(int g, int seg, const bf16* Ug, bf16* Yg, const unsigned char* tab, float* Ebuf, const float* lam_re, const float* lam_im, const float* log_dt, LAS unsigned char* L) {
    int tid_ = threadIdx.x; asm volatile("" : "+v"(tid_));
    const int tid = tid_, lane = tid & 63, r32 = lane & 31, hi = lane >> 5, b = __builtin_amdgcn_readfirstlane(tid >> 6);
    { const int npc = (FINAL ? S5_TAB_BYTES : S5_WYC) / 1024; const unsigned l0 = (unsigned)(uintptr_t)(unsigned char*)L;
      for (int i = b; i < npc; i += NWAVES) attn_body::glds16(tab + (size_t)i * 1024 + lane * 16, (unsigned)__builtin_amdgcn_readfirstlane(l0 + i * 1024)); }
    const size_t tok0 = (size_t)g * TOK + (size_t)b * SEQ + (size_t)seg * 256;
    s5_bf16x8 A[8];
    { const bf16* up = Ug + (tok0 + 8 * r32) * 16 + 8 * hi;
#pragma unroll
      for (int s = 0; s < 8; ++s) A[s] = *(const GAS s5_bf16x8*)(up + s * 16); }
    float aLr[2], aLi[2], aSr[2], aSi[2];
    { const float dt = expf(log_dt[g]);
#pragma unroll
      for (int k = 0; k < 2; ++k) { float xr, xi; s5_apow(lam_re[g * 64 + 32 * k + r32], lam_im[g * 64 + 32 * k + r32], dt, 1, xr, xi);
#pragma unroll
          for (int q = 0; q < 3; ++q) { const float nr = xr * xr - xi * xi, ni = 2.0f * xr * xi; xr = nr; xi = ni; }
          aLr[k] = xr; aLi[k] = xi;
#pragma unroll
          for (int q = 0; q < 5; ++q) { const float nr = xr * xr - xi * xi, ni = 2.0f * xr * xi; xr = nr; xi = ni; }
          aSr[k] = xr; aSi[k] = xi; } }
    float cr[2] = {0.f, 0.f}, ci[2] = {0.f, 0.f};
    if (FINAL) {
        const float* eb = Ebuf + ((size_t)(b * NGRP + g) * 16) * 128;
        f32x2 ev[15][2];
#pragma unroll
        for (int j = 0; j < 15; ++j)
#pragma unroll
            for (int k = 0; k < 2; ++k) ev[j][k] = (j < seg) ? *(const GAS f32x2*)(eb + (size_t)j * 128 + 2 * (32 * k + r32)) : (f32x2){0.f, 0.f};
#pragma unroll
        for (int j = 0; j < 15; ++j) if (j < seg) {
#pragma unroll
            for (int k = 0; k < 2; ++k) { const float nr = aSr[k] * cr[k] - aSi[k] * ci[k] + ev[j][k].x, ni = aSr[k] * ci[k] + aSi[k] * cr[k] + ev[j][k].y; cr[k] = nr; ci[k] = ni; } }
    }
    asm volatile("s_waitcnt vmcnt(0)" ::: "memory");
    __syncthreads();
    s5_f32x16 S[4];
#pragma unroll
    for (int j = 0; j < 4; ++j) { S[j] = s5_f32x16{};
#pragma unroll
        for (int s = 0; s < 8; ++s) { const s5_bf16x8 bf = *(const LAS s5_bf16x8*)(L + S5_WST + (32 * j + r32) * S5_PITCH + (16 * s + 8 * hi) * 2);
            S[j] = __builtin_amdgcn_mfma_f32_32x32x16_bf16(A[s], bf, S[j], 0, 0, 0); } }
#pragma unroll
    for (int i = 0; i < 8; ++i) { const bool own = ((i & 1) == hi);
#pragma unroll
        for (int q = 0; q < 4; ++q) { const int reg = 4 * (i >> 1) + q;
#pragma unroll
            for (int k = 0; k < 2; ++k) { const float sr = S[2 * k][reg], si = S[2 * k + 1][reg];
                const float nr = aLr[k] * cr[k] - aLi[k] * ci[k] + sr, ni = aLr[k] * ci[k] + aLi[k] * cr[k] + si;
                S[2 * k][reg] = own ? cr[k] : sr; S[2 * k + 1][reg] = own ? ci[k] : si; cr[k] = own ? nr : cr[k]; ci[k] = own ? ni : ci[k]; } }
#pragma unroll
        for (int k = 0; k < 2; ++k) { const float orr = __shfl_xor(cr[k], 32), oi = __shfl_xor(ci[k], 32); cr[k] = own ? cr[k] : orr; ci[k] = own ? ci[k] : oi; } }
    if (!FINAL) {
        if (hi == 0) { float* eb = Ebuf + ((size_t)(b * NGRP + g) * 16 + seg) * 128;
#pragma unroll
            for (int k = 0; k < 2; ++k) *(GAS f32x2*)(eb + 2 * (32 * k + r32)) = (f32x2){cr[k], ci[k]}; }
    } else {
        LAS unsigned char* XS = L + S5_XS + b * S5_XS_BYTES;
#pragma unroll
        for (int reg = 0; reg < 16; ++reg) { const int chunk = (reg & 3) + 8 * (reg >> 2) + 4 * hi;
#pragma unroll
            for (int k = 0; k < 2; ++k) *(LAS unsigned*)(XS + chunk * S5_PITCH + 4 * (32 * k + r32)) = pk2(S[2 * k][reg], S[2 * k + 1][reg]); }
        s5_bf16x8 Xf[8];
#pragma unroll
        for (int kk = 0; kk < 8; ++kk) Xf[kk] = *(const LAS s5_bf16x8*)(XS + r32 * S5_PITCH + (16 * kk + 8 * hi) * 2);
        s5_f32x16 Yc[4];
#pragma unroll
        for (int j = 0; j < 4; ++j) { Yc[j] = s5_f32x16{};
#pragma unroll
            for (int s = 0; s < 8; ++s) if (s <= 2 * j + 1) { const int d1 = 2 * j + (r32 >> 4) - s + 1;
                const s5_bf16x8 bf = *(const LAS s5_bf16x8*)(L + S5_KT + d1 * 512 + (r32 & 15) * 32 + 16 * hi);
                Yc[j] = __builtin_amdgcn_mfma_f32_32x32x16_bf16(A[s], bf, Yc[j], 0, 0, 0); }
#pragma unroll
            for (int kk = 0; kk < 8; ++kk) { const s5_bf16x8 bf = *(const LAS s5_bf16x8*)(L + S5_WYC + (32 * j + r32) * S5_PITCH + (16 * kk + 8 * hi) * 2);
                Yc[j] = __builtin_amdgcn_mfma_f32_32x32x16_bf16(Xf[kk], bf, Yc[j], 0, 0, 0); } }
        asm volatile("s_waitcnt lgkmcnt(0)" ::: "memory");
#pragma unroll
        for (int j = 0; j < 4; ++j)
#pragma unroll
            for (int reg = 0; reg < 16; reg += 2) { const pg8::f32x2 ge = pg8::gelu_pk((pg8::f32x2){Yc[j][reg], Yc[j][reg + 1]});
                const int chunk = (reg & 3) + 8 * (reg >> 2) + 4 * hi, tokl = 8 * chunk + 2 * j + (r32 >> 4), c = r32 & 15;
                *(LAS bf16*)(XS + tokl * 32 + c * 2) = (bf16)f2bf(ge.x); *(LAS bf16*)(XS + (tokl + 8) * 32 + c * 2) = (bf16)f2bf(ge.y); }
        asm volatile("s_waitcnt lgkmcnt(0)" ::: "memory");
        bf16* yo = Yg + tok0 * 16;
#pragma unroll
        for (int i = 0; i < 8; ++i) { const int pc = lane + 64 * i; const v4u w = *(const LAS v4u*)(XS + 16 * pc); *(GAS v4u*)(yo + 8 * pc) = w; }
    }
    __syncthreads();
}

#ifndef MK_ONE_LAUNCH
#define MK_ONE_LAUNCH 1
#endif
constexpr int N_PHASES = 14;
struct Args { const float* in[23]; float* out; unsigned char* ws; int ph_lo, ph_hi; };

#ifndef PROBE_P0
#define PROBE_P0 0
#endif
#define P0_ITEM(it) do { \
            int r = it; \
            if (r < I_TKT) { s5_tab_kt(r >> 3, r & 7, S5TAB + (size_t)(r >> 3) * S5_TAB_BYTES, args.in[6], args.in[7], args.in[8], args.in[9], args.in[10], args.in[11], args.in[12], args.in[13], lane); break; } r -= I_TKT; \
            if (r < I_TST) { s5_tab_wst(r >> 2, r & 3, S5TAB + (size_t)(r >> 2) * S5_TAB_BYTES, args.in[6], args.in[7], args.in[8], args.in[9], args.in[10], lane); break; } r -= I_TST; \
            if (r < I_TYC) { s5_tab_wyc(r >> 3, r & 7, S5TAB + (size_t)(r >> 3) * S5_TAB_BYTES, args.in[6], args.in[7], args.in[8], args.in[11], args.in[12], lane); break; } r -= I_TYC; \
            if (r < I_SQ) { p0_matrix_item(args.in[5], 1024, 1024, WIN0, mixg, 0, r, scr, lane); break; } r -= I_SQ; \
            if (r < I_GLU) { p0_matrix_item(args.in[14], 768, 768, WGLU, nullptr, 0, r, scr, lane); break; } r -= I_GLU; \
            if (r < I_IN1) { p0_matrix_item(args.in[16], 1024, 2560, WIN1, mixg + 1024, 0, r, scr, lane); break; } r -= I_IN1; \
            if (r < I_SQ) { p0_matrix_item(args.in[17], 1024, 1024, WOUT0, nullptr, 0, r, scr, lane); break; } r -= I_SQ; \
            if (r < I_SQ) { p0_matrix_item(args.in[17] + 1024 * 1024, 1024, 1024, WOUT1, nullptr, 0, r, scr, lane); break; } r -= I_SQ; \
            if (r < I_GU) { p0_matrix_item(args.in[19], 1024, FFN, WGU0, ffng, 1, r, scr, lane); break; } r -= I_GU; \
            if (r < I_GU) { p0_matrix_item(args.in[20], 1024, FFN, WGU0, ffng, 2, r, scr, lane); break; } r -= I_GU; \
            if (r < I_GU) { p0_matrix_item(args.in[19] + (size_t)1024 * FFN, 1024, FFN, WGU1, ffng + 1024, 1, r, scr, lane); break; } r -= I_GU; \
            if (r < I_GU) { p0_matrix_item(args.in[20] + (size_t)1024 * FFN, 1024, FFN, WGU1, ffng + 1024, 2, r, scr, lane); break; } r -= I_GU; \
            if (r < I_DN) { p0_matrix_item(args.in[21], FFN, 1024, WDN0, nullptr, 0, r, scr, lane); break; } r -= I_DN; \
            if (r < I_DN) { p0_matrix_item(args.in[21] + (size_t)FFN * 1024, FFN, 1024, WDN1, nullptr, 0, r, scr, lane); break; } r -= I_DN; \
            p0_matrix_item(args.in[3], 1024, 512, WMKV, args.in[2], 0, r, scr, lane); \
        } while (0)
__global__ void __launch_bounds__(NWAVES * 64, 2) mega_fwd(Args args) {
    extern __shared__ __attribute__((aligned(16))) unsigned char lds[];
    LAS unsigned char* L = (LAS unsigned char*)lds;
    volatile LAS unsigned* MISC = (volatile LAS unsigned*)(L + MISC_OFF);
    const int tid = threadIdx.x, lane = tid & 63, wave = __builtin_amdgcn_readfirstlane(tid >> 6);
    const int G = gridDim.x; const int bx = blockIdx.x;
    const int vcu = (G % 8 == 0) ? (bx % 8) * (G / 8) + bx / 8 : bx;
    const int gw = vcu * NWAVES + wave, NGW = G * NWAVES;
    unsigned char* ws = args.ws;
    gu32* ctl = (gu32*)(ws + WS_CTL);
    for (int u = tid; u < (LDS_BYTES - LDSCTL_OFF) / 4; u += NWAVES * 64) ((LAS unsigned*)(L + LDSCTL_OFF))[u] = 0u;
    __syncthreads();
    XcdBarrier bar; bar.bar = (unsigned*)(ctl + CW_BAR); bar.x = 0; bar.st = nullptr;
    if (MK_ONE_LAUNCH) bar = xcd_barrier_post((unsigned*)(ctl + CW_BAR), MISC + 8);
#define MEMATTN_PHASE(u0_, us_) do { for (int un = (u0_); un < BATCH * MHEAD * NBLK; un += (us_)) { const int b_ = un >> 6, h_ = (un >> 4) & 3, qb_ = un & 15; const size_t qrow_ = (size_t)b_ * SEQ + (size_t)qb_ * 256; \
        attn_body::attn_unit<0, 8, 256, 256, 1024>((const attn_body::bf16*)(QM + qrow_ * 256 + h_ * 64), (const attn_body::bf16*)(MEMK + (size_t)b_ * MEML * 256 + h_ * 64), (const attn_body::bf16*)(MEMV + (size_t)b_ * MEML * 256 + h_ * 64), \
            (attn_body::bf16*)(MIX + qrow_ * 1024 + 768 + h_ * 64), 4, 0.f, nullptr, nullptr, 0, (char*)lds + RING_OFF); } } while (0)
    const int lo = args.ph_lo, hi = args.ph_hi;
#ifndef PROBE_DUP
#define PROBE_DUP -1
#endif
#define IN(k) (lo <= (k) && (k) < hi)
#define PH_REP(k) for (int rep_ = 0; rep_ < ((PROBE_DUP == (k)) ? 2 : 1); ++rep_)
#define SEAM(k) do { if (IN(k) && IN((k) + 1)) xcd_barrier(bar); } while (0)

    const float* x = args.in[0]; const float* mem = args.in[1];
    float* out = args.out;
    float* SS0 = (float*)(ws + WS_SS0); float* SSA = (float*)(ws + WS_SSA); float* SSB = (float*)(ws + WS_SSB); float* SSM = (float*)(ws + WS_SSM);
    unsigned char* S5TAB = ws + WS_S5TAB; float* S5E = (float*)(ws + WS_S5E);
    float* KMP = (float*)(ws + WS_KMEAN);
    bf16* WIN0 = (bf16*)(ws + WS_WIN0); bf16* WGLU = (bf16*)(ws + WS_WGLU); bf16* WIN1 = (bf16*)(ws + WS_WIN1);
    bf16* WOUT0 = (bf16*)(ws + WS_WOUT0); bf16* WOUT1 = (bf16*)(ws + WS_WOUT1);
    bf16* WGU0 = (bf16*)(ws + WS_WGU0); bf16* WGU1 = (bf16*)(ws + WS_WGU1); bf16* WDN0 = (bf16*)(ws + WS_WDN0); bf16* WDN1 = (bf16*)(ws + WS_WDN1); bf16* WMKV = (bf16*)(ws + WS_WMKV);
    bf16* MEMB = (bf16*)(ws + WS_MEMB); bf16* MEMK = (bf16*)(ws + WS_MEMK); bf16* MEMV = (bf16*)(ws + WS_MEMV);
    bf16* XB = (bf16*)(ws + WS_XB); bf16* Ub = (bf16*)(ws + WS_U); bf16* Yb = (bf16*)(ws + WS_Y);
    bf16* Q1 = (bf16*)(ws + WS_Q1); bf16* K1 = (bf16*)(ws + WS_K1); bf16* V1 = (bf16*)(ws + WS_V1);
    bf16* QM = (bf16*)(ws + WS_QM); bf16* MIX = (bf16*)(ws + WS_MIX); bf16* Hb = (bf16*)(ws + WS_H);

    if (IN(0)) PH_REP(0) {
        if (rep_) xcd_barrier(bar);
        LAS float* scr = (LAS float*)(L + RING_OFF + wave * 16384);
        constexpr int I_SQ = 16 * 32, I_GLU = 12 * 24, I_IN1 = 16 * 80, I_GU = 16 * 88, I_DN = 44 * 32, I_MKV = 16 * 16;
        constexpr int I_TKT = NGRP * 8, I_TST = NGRP * 4, I_TYC = NGRP * 8;
        constexpr int NITEMS = I_TKT + I_TST + I_TYC + I_SQ + I_GLU + I_IN1 + 2 * I_SQ + 4 * I_GU + 2 * I_DN + I_MKV;
        const float* mixg = args.in[4]; const float* ffng = args.in[18];
        for (int it = gw; it < NITEMS; it += NGW) P0_ITEM(it);
        for (int m = 4 * gw; m < TOK; m += 4 * NGW) rows_to_bf16_ssq<4>(x + (size_t)m * DM, XB + (size_t)m * DM, SS0 + (size_t)m * 16, lane);
        for (int m = gw; m < BATCH * MEML; m += NGW) rows_to_bf16_ssq<1>(mem + (size_t)m * DM, MEMB + (size_t)m * DM, SSM + (size_t)m * 16, lane);
#if PROBE_P0 == 1
        for (int it = gw; it < I_TKT + I_TST + I_TYC; it += NGW) P0_ITEM(it);
#elif PROBE_P0 == 2
        for (int it = I_TKT + I_TST + I_TYC + gw; it < NITEMS; it += NGW) P0_ITEM(it);
#elif PROBE_P0 == 3
        for (int m = 4 * gw; m < TOK; m += 4 * NGW) rows_to_bf16_ssq<4>(x + (size_t)m * DM, XB + (size_t)m * DM, SS0 + (size_t)m * 16, lane);
        for (int m = gw; m < BATCH * MEML; m += NGW) rows_to_bf16_ssq<1>(mem + (size_t)m * DM, MEMB + (size_t)m * DM, SSM + (size_t)m * 16, lane);
#endif
    }
    SEAM(0);
    if (IN(1)) PH_REP(1) {
        if (rep_) xcd_barrier(bar);
        { pg8::Gemm g{XB, WIN0, TOK, 1024, 1024, 0}; pg8::StaticOrder S; S.init(TOK, 1024, G, bx);
          pg8::EpiProj E{SS0, Ub, 0, 3, 1, TOKW, 1.0f, QM, C2, TOK, nullptr, -1};
          pg8::gemm_phase<pg8::EpiProj, pg8::StaticOrder, true, true>(L + RING_OFF, g, S, E); }
    }
    SEAM(1);
    if (IN(2)) PH_REP(2) {
        if (rep_) xcd_barrier(bar);
        const int nS5 = (G == 256) ? 240 : G;
        if (bx < nS5) { for (int un = bx; un < NGRP * 16; un += nS5) s5_unit<false>(un >> 4, un & 15, Ub, Yb, S5TAB + (size_t)(un >> 4) * S5_TAB_BYTES, S5E, args.in[6], args.in[7], args.in[8], L + RING_OFF); }
        if (G != 256 || bx >= nS5) { pg8::Gemm g{MEMB, WMKV, BATCH * MEML, 512, 1024, 0}; pg8::StaticOrder S; S.init(BATCH * MEML, 512, (G == 256) ? 16 : G, (G == 256) ? bx - nS5 : bx);
          pg8::EpiProj E{SSM, MEMK, (size_t)(WS_MEMV - WS_MEMK) / 2, 1, 2, 256, 1.0f, nullptr, 1.0f, 0, nullptr, -1};
          pg8::gemm_phase<pg8::EpiProj, pg8::StaticOrder, true, true>(L + RING_OFF, g, S, E); }
    }
    SEAM(2);
    if (IN(3)) PH_REP(3) {
        if (rep_) xcd_barrier(bar);
        for (int un = vcu; un < NGRP * 16; un += G) s5_unit<true>(un >> 4, un & 15, Ub, Yb, S5TAB + (size_t)(un >> 4) * S5_TAB_BYTES, S5E, args.in[6], args.in[7], args.in[8], L + RING_OFF);
    }
    SEAM(3);
    if (IN(4)) PH_REP(4) {
        if (rep_) xcd_barrier(bar);
        pg8::Gemm g{Yb, WGLU, TOK, TOKW, TOKW, 1}; pg8::StaticOrder S; S.init(TOK, TOKW, G, bx);
        pg8::EpiGlu E{Yb, TOKW, args.in[15], MIX, 1024, TOK};
        pg8::gemm_phase<pg8::EpiGlu, pg8::StaticOrder, true, true>(L + RING_OFF, g, S, E);
        if (G == 256) { if (bx >= 128) MEMATTN_PHASE(bx - 128, 128); }
        else MEMATTN_PHASE(vcu, G);
    }
    SEAM(4);
    if (IN(5)) PH_REP(5) {
        if (rep_) xcd_barrier(bar);
        pg8::Gemm g{MIX, WOUT0, TOK, 1024, 1024, 0}; pg8::StaticOrder S; S.init(TOK, 1024, G, bx);
        pg8::EpiRes E{x, out, XB, SSA};
        pg8::gemm_phase<pg8::EpiRes, pg8::StaticOrder, true, true>(L + RING_OFF, g, S, E);
    }
    SEAM(5);
    if (IN(6)) PH_REP(6) {
        if (rep_) xcd_barrier(bar);
        pg8::Gemm g{XB, WGU0, TOK, 2 * FFN, 1024, 0}; pg8::StaticOrder S; S.init(TOK, 2 * FFN, G, bx);
        pg8::EpiGU E{SSA, Hb, FFN};
        pg8::gemm_phase<pg8::EpiGU, pg8::StaticOrder, true, true>(L + RING_OFF, g, S, E);
    }
    SEAM(6);
    if (IN(7)) PH_REP(7) {
        if (rep_) xcd_barrier(bar);
        pg8::Gemm g{Hb, WDN0, TOK, 1024, FFN, 0}; pg8::StaticOrder S; S.init(TOK, 1024, G, bx);
        pg8::EpiRes E{out, out, XB, SSB};
        pg8::gemm_phase<pg8::EpiRes, pg8::StaticOrder, true, true>(L + RING_OFF, g, S, E);
    }
    SEAM(7);
    if (IN(8)) PH_REP(8) {
        if (rep_) xcd_barrier(bar);
        pg8::Gemm g{XB, WIN1, TOK, 2560, 1024, 0}; pg8::StaticOrder S; S.init(TOK, 2560, G, bx);
        pg8::EpiProj E{SSB, Q1, (size_t)(WS_K1 - WS_Q1) / 2, 3, 3, TOKW, C2, QM, C2, 0, KMP, 1};
        pg8::gemm_phase<pg8::EpiProj, pg8::StaticOrder, true, true>(L + RING_OFF, g, S, E);
    }
    SEAM(8);
    if (IN(9)) PH_REP(9) {
        if (rep_) xcd_barrier(bar);
        for (int p_ = vcu; p_ < BATCH * NHEAD * 8; p_ += G) { const int bh_ = p_ >> 3, sg_ = p_ & 7, b_ = bh_ / NHEAD, h_ = bh_ - b_ * NHEAD;
            const float slope2 = __builtin_amdgcn_exp2f(-8.0f * (float)(h_ + 1) / 12.0f) * LOG2E;
#pragma unroll 1
            for (int k_ = 0; k_ < 2; ++k_) { const int qb_ = k_ ? 15 - sg_ : sg_; const size_t qrow_ = (size_t)b_ * SEQ + (size_t)qb_ * 256, krow_ = (size_t)b_ * SEQ;
                attn_body::attn_unit<1, 8, 768, 768, 1024>((const attn_body::bf16*)(Q1 + qrow_ * TOKW + h_ * 64), (const attn_body::bf16*)(K1 + krow_ * TOKW + h_ * 64), (const attn_body::bf16*)(V1 + krow_ * TOKW + h_ * 64),
                    (attn_body::bf16*)(MIX + qrow_ * 1024 + h_ * 64), 4 * qb_ + 4, slope2, KMP + (size_t)bh_ * 1024, KMP + (size_t)(8 * 12 * 16 * 64) + (size_t)bh_ * 1024, qb_, (char*)lds + RING_OFF); } }
        MEMATTN_PHASE(vcu, G);
    }
    SEAM(9);
    if (IN(10)) PH_REP(10) {
        if (rep_) xcd_barrier(bar);
        pg8::Gemm g{MIX, WOUT1, TOK, 1024, 1024, 0}; pg8::StaticOrder S; S.init(TOK, 1024, G, bx);
        pg8::EpiRes E{out, out, XB, SSA};
        pg8::gemm_phase<pg8::EpiRes, pg8::StaticOrder, true, true>(L + RING_OFF, g, S, E);
    }
    SEAM(10);
    if (IN(11)) PH_REP(11) {
        if (rep_) xcd_barrier(bar);
        pg8::Gemm g{XB, WGU1, TOK, 2 * FFN, 1024, 0}; pg8::StaticOrder S; S.init(TOK, 2 * FFN, G, bx);
        pg8::EpiGU E{SSA, Hb, FFN};
        pg8::gemm_phase<pg8::EpiGU, pg8::StaticOrder, true, true>(L + RING_OFF, g, S, E);
    }
    SEAM(11);
    if (IN(12)) PH_REP(12) {
        if (rep_) xcd_barrier(bar);
        pg8::Gemm g{Hb, WDN1, TOK, 1024, FFN, 0}; pg8::StaticOrder S; S.init(TOK, 1024, G, bx);
        pg8::EpiRes E{out, out, XB, SSB};
        pg8::gemm_phase<pg8::EpiRes, pg8::StaticOrder, true, true>(L + RING_OFF, g, S, E);
    }
    SEAM(12);
    if (IN(13)) PH_REP(13) {
        if (rep_) xcd_barrier(bar);
        const float* gf = args.in[22];
        for (int m = gw; m < TOK; m += NGW) {
            const float rs = pg8::row_rstd(SSB, m);
            GAS f32x4* xr = (GAS f32x4*)(out + (size_t)m * DM) + lane; const GAS f32x4* gp = (const GAS f32x4*)gf + lane;
#pragma unroll
            for (int j = 0; j < 4; ++j) { const f32x4 v = xr[64 * j], gg = gp[64 * j]; xr[64 * j] = v * rs * gg; }
        }
    }
#undef IN
#undef SEAM
}

extern "C" void kernel_launch(void* const* d_in, const int* in_sizes, int n_in, void* d_out, int out_size, void* d_ws, size_t ws_size, hipStream_t stream) {
    static int grid = 0;
    if (grid == 0) {
        if (n_in != 23 || out_size != TOK * DM || ws_size < WS_END) { fprintf(stderr, "kernel_launch: unexpected shapes: n_in %d out %d ws %zu\n", n_in, out_size, ws_size); grid = -1; return; }
        int dev = 0, cus = 0, per_cu = 0;
        if (hipGetDevice(&dev) != hipSuccess || hipDeviceGetAttribute(&cus, hipDeviceAttributeMultiprocessorCount, dev) != hipSuccess) { grid = -1; return; }
        if (hipFuncSetAttribute((const void*)mega_fwd, hipFuncAttributeMaxDynamicSharedMemorySize, LDS_BYTES) != hipSuccess) { fprintf(stderr, "kernel_launch: hipFuncSetAttribute failed\n"); grid = -1; return; }
        if (hipOccupancyMaxActiveBlocksPerMultiprocessor(&per_cu, (const void*)mega_fwd, NWAVES * 64, LDS_BYTES) != hipSuccess || per_cu < 1)
            fprintf(stderr, "kernel_launch: occupancy query reports %d workgroups per CU\n", per_cu);
        (void)hipGetLastError();
        grid = cus;
    }
    if (grid < 0) return;
    if (hipMemsetAsync((char*)d_ws + WS_CTL, 0, CTL_ZERO_BYTES, stream) != hipSuccess) return;
    Args a{};
    for (int i = 0; i < 23; ++i) a.in[i] = (const float*)d_in[i];
    a.out = (float*)d_out; a.ws = (unsigned char*)d_ws;
#if MK_ONE_LAUNCH
    a.ph_lo = 0; a.ph_hi = N_PHASES;
    hipLaunchKernelGGL(mega_fwd, dim3(grid), dim3(NWAVES * 64), LDS_BYTES, stream, a);
#else
    for (int p = 0; p < N_PHASES; ++p) { a.ph_lo = p; a.ph_hi = p + 1; hipLaunchKernelGGL(mega_fwd, dim3(grid), dim3(NWAVES * 64), LDS_BYTES, stream, a); }
#endif
}
```

```cpp
#include <hip/hip_runtime.h>
#include <hip/hip_bf16.h>
#include <cstdio>
#include <cstdint>
#include <cmath>
namespace pg8 {
#define PG8_LAS __attribute__((address_space(3)))
typedef unsigned short bf16_t;
typedef short bf16x8 __attribute__((ext_vector_type(8)));
typedef float f32x4 __attribute__((ext_vector_type(4)));
typedef unsigned u32x4 __attribute__((ext_vector_type(4)));
constexpr int BM = 256, BK = 64, HALF = 128, HTB = HALF * BK * 2  , STAGE_BYTES = 8 * HTB, NXCD = 8, WGM = 8;

__host__ __device__ __forceinline__ int lds_byte(int r, int c) { const int st = (r >> 4) * 2 + (c >> 5), rr = r & 15, cc = c & 31, ob = rr * 64 + cc * 2; return st * 1024 + (ob ^ (((ob >> 9) & 1) << 5)); }
__host__ __device__ __forceinline__ void stage_rc(int b, int& R, int& C) { const int st = b / 1024, sb = b % 1024, swz = sb ^ (((sb >> 9) & 1) << 5); R = (st >> 1) * 16 + swz / 64; C = (st & 1) * 32 + (swz % 64) / 2; }
__host__ __device__ __forceinline__ int perm32(int rho) { const int n = rho >> 4, i = rho & 15; return 8 * (i >> 2) + 4 * n + (i & 3); }

struct Unit { int pm, pn; };
struct Gemm { const bf16_t* A; const bf16_t* Bt; int M, N, K, amode; };

struct StaticOrder {
    int nM, nN, nwg, G, c;
    __host__ __device__ void init(int M, int N, int G_, int c_) { nM = M / BM; nN = N / BM; nwg = nM * nN; G = G_; c = c_; }
    __host__ __device__ bool next(int i, Unit& u) const {
        const long L = (long)i * G + c; if (L >= nwg) return false;
        int wgid = (int)L; { const int q = nwg / NXCD, r = nwg % NXCD, xcd = wgid % NXCD, off = wgid / NXCD; wgid = (xcd < r ? xcd * (q + 1) : r * (q + 1) + (xcd - r) * q) + off; }
        const int nig = WGM * nN, gid = wgid / nig, fm = gid * WGM, gsz = (nM - fm) < WGM ? (nM - fm) : WGM;
        u.pm = fm + ((wgid % nig) % gsz); u.pn = (wgid % nig) / gsz; return true;
    }
    __device__ __forceinline__ void a_ready(const Unit&) const {}
    __device__ __forceinline__ void done(const Unit&) const {}
};

__device__ __forceinline__ unsigned cvt_pk_bf16(float lo, float hi) { unsigned r; asm volatile("v_cvt_pk_bf16_f32 %0, %1, %2" : "=v"(r) : "v"(lo), "v"(hi)); return r; }
typedef float f32x2 __attribute__((ext_vector_type(2)));
typedef unsigned u32x2 __attribute__((ext_vector_type(2)));
constexpr float RMS_EPS = 1e-6f;
__device__ __forceinline__ float row_rstd(const float* ssq, int row) {
    const f32x4* p = (const f32x4*)(ssq + (size_t)row * 16);
    const f32x4 a = p[0], b = p[1], c = p[2], d = p[3];
    const float s = (((a[0] + a[1]) + (a[2] + a[3])) + ((b[0] + b[1]) + (b[2] + b[3]))) + (((c[0] + c[1]) + (c[2] + c[3])) + ((d[0] + d[1]) + (d[2] + d[3])));
    return __builtin_amdgcn_rsqf(s * (1.0f / 1024.0f) + RMS_EPS);
}
__device__ __forceinline__ float bf2f(unsigned short h) { return __uint_as_float(((unsigned)h) << 16); }
__device__ __forceinline__ float bflo(unsigned w) { return __uint_as_float(w << 16); }
__device__ __forceinline__ float bfhi(unsigned w) { return __uint_as_float(w & 0xffff0000u); }

__device__ __forceinline__ f32x2 gelu_pk(f32x2 v) {
    const f32x2 av = __builtin_elementwise_abs(v), d = av * 0.2316418882f + 1.0f;
    f32x2 t; t.x = __builtin_amdgcn_rcpf(d.x); t.y = __builtin_amdgcn_rcpf(d.y);
    f32x2 q = t * 0.5307027145f + (-0.7265760135f); q = q * t + 0.7107068705f; q = q * t + (-0.142248368f); q = q * t + 0.127414796f; q = q * t;
    const f32x2 s = (v * v) * (-0.72134752044f);
    f32x2 e; e.x = __builtin_amdgcn_exp2f(s.x); e.y = __builtin_amdgcn_exp2f(s.y);
    const f32x2 m = v * (q * e), r = v - m;
    f32x2 o; o.x = v.x < 0.f ? m.x : r.x; o.y = v.y < 0.f ? m.y : r.y; return o;
}

__device__ __forceinline__ void row_rstd4x8(const float* ssq, int row0, int fq, float sc, float (&rs)[2][4]) {
    f32x4 a[2][4];
#pragma unroll
    for (int ai = 0; ai < 2; ++ai)
#pragma unroll
        for (int m = 0; m < 4; ++m) a[ai][m] = *(const __attribute__((address_space(1))) f32x4*)(ssq + (size_t)(row0 + ai * HALF + m * 16) * 16 + 4 * fq);
#pragma unroll
    for (int ai = 0; ai < 2; ++ai)
#pragma unroll
        for (int m = 0; m < 4; ++m) { float s = (a[ai][m][0] + a[ai][m][1]) + (a[ai][m][2] + a[ai][m][3]); s += __shfl_xor(s, 16); s += __shfl_xor(s, 32);
            rs[ai][m] = __builtin_amdgcn_rsqf(s * (1.0f / 1024.0f) + RMS_EPS) * sc; }
}
struct EpiProj {
    static constexpr bool PERM = true, AFTER_DRAIN = false;
    const float* ssq; bf16_t* base; size_t seg_stride; int tps, nseg, ldc; float scale0; bf16_t* qm; float scale_qm; int gm_rows;
    float* kmp; int kseg;
    __device__ __forceinline__ void operator()(const f32x4 (&acc)[2][2][4][2], const Unit& u, int wr, int wc, int fr, int fq) const {
        const int seg = u.pn / tps, within = u.pn - seg * tps;
        bf16_t* o; int ld, colt; float sc;
        if (seg < nseg) { o = base + (size_t)seg * seg_stride; ld = ldc; colt = within * BM; sc = (seg == 0) ? scale0 : 1.0f; }
        else { o = qm; ld = 256; colt = 0; sc = scale_qm; }
        const int row0 = u.pm * BM + wr * 64 + fr, col0 = colt + wc * 32 + 8 * fq;
        f32x4 cs[2][2] = {{{0.f, 0.f, 0.f, 0.f}, {0.f, 0.f, 0.f, 0.f}}, {{0.f, 0.f, 0.f, 0.f}, {0.f, 0.f, 0.f, 0.f}}};
        float rsv[2][4]; row_rstd4x8(ssq, row0, fq, sc, rsv);
#pragma unroll
        for (int ai = 0; ai < 2; ++ai)
#pragma unroll
            for (int m = 0; m < 4; ++m) { const int row = row0 + ai * HALF + m * 16; const float rs = rsv[ai][m]; bf16_t* rowp = o + (size_t)row * ld + col0;
                const bool gm = (gm_rows != 0) && (seg < nseg);
#pragma unroll
                for (int bj = 0; bj < 2; ++bj) { const f32x4 v0 = acc[ai][bj][m][0] * rs, v1 = acc[ai][bj][m][1] * rs;
                    u32x4 w; w.x = cvt_pk_bf16(v0[0], v0[1]); w.y = cvt_pk_bf16(v0[2], v0[3]); w.z = cvt_pk_bf16(v1[0], v1[1]); w.w = cvt_pk_bf16(v1[2], v1[3]);
                    const int cc = col0 + bj * HALF;
                    bf16_t* dst = gm ? (o + ((size_t)(cc >> 4) * gm_rows + row) * 16 + (cc & 15)) : (rowp + bj * HALF);
                    *(u32x4*)dst = w; cs[bj][0] += v0; cs[bj][1] += v1; } }
        if (seg == kseg) {
#pragma unroll
            for (int bj = 0; bj < 2; ++bj)
#pragma unroll
                for (int n = 0; n < 2; ++n)
#pragma unroll
                    for (int e = 0; e < 4; ++e) { float s = cs[bj][n][e]; s += __shfl_xor(s, 1); s += __shfl_xor(s, 2); s += __shfl_xor(s, 4); s += __shfl_xor(s, 8); cs[bj][n][e] = s; }
            if (fr == 0) { const int bb = u.pm >> 4, blk = u.pm & 15;
#pragma unroll
                for (int bj = 0; bj < 2; ++bj) { const int cc = col0 + bj * HALF, h = cc >> 6, d = cc & 63;
                    float* kd = kmp + (size_t)wr * (8 * 12 * 16 * 64) + ((size_t)((bb * 12 + h) * 16 + blk)) * 64 + d;
                    *(__attribute__((address_space(1))) f32x4*)kd = cs[bj][0]; *(__attribute__((address_space(1))) f32x4*)(kd + 4) = cs[bj][1]; } }
        }
    }
};
struct EpiGlu {
    static constexpr bool PERM = true, AFTER_DRAIN = false;
    const bf16_t* Y; int ldy; const float* bias; bf16_t* mix; int ldm; int ygm_rows;
    __device__ __forceinline__ void operator()(const f32x4 (&acc)[2][2][4][2], const Unit& u, int wr, int wc, int fr, int fq) const {
        const int row0 = u.pm * BM + wr * 64 + fr, col0 = u.pn * BM + wc * 32 + 8 * fq;
        f32x4 bv[2][2];
#pragma unroll
        for (int bj = 0; bj < 2; ++bj)
#pragma unroll
            for (int n = 0; n < 2; ++n) bv[bj][n] = *(const f32x4*)(bias + col0 + bj * HALF + 4 * n);
#pragma unroll
        for (int ai = 0; ai < 2; ++ai) {
            u32x4 yq[4][2];
#pragma unroll
            for (int m = 0; m < 4; ++m) { const int row = row0 + ai * HALF + m * 16;
#pragma unroll
                for (int bj = 0; bj < 2; ++bj) { const int cc = col0 + bj * HALF;
                    yq[m][bj] = ygm_rows ? *(const __attribute__((address_space(1))) u32x4*)(Y + ((size_t)(cc >> 4) * ygm_rows + row) * 16 + (cc & 15)) : *(const __attribute__((address_space(1))) u32x4*)(Y + (size_t)row * ldy + cc); } }
#pragma unroll
            for (int m = 0; m < 4; ++m) { const int row = row0 + ai * HALF + m * 16;
#pragma unroll
                for (int bj = 0; bj < 2; ++bj) { const u32x4 yw = yq[m][bj];
                    const f32x4 z0 = acc[ai][bj][m][0] + bv[bj][0], z1 = acc[ai][bj][m][1] + bv[bj][1];
                    float t[8]; const float yv[8] = {bflo(yw.x), bfhi(yw.x), bflo(yw.y), bfhi(yw.y), bflo(yw.z), bfhi(yw.z), bflo(yw.w), bfhi(yw.w)};
#pragma unroll
                    for (int e = 0; e < 4; ++e) { t[e] = yv[e] * __builtin_amdgcn_rcpf(1.0f + __builtin_amdgcn_exp2f(-1.4426950408889634f * z0[e])); t[4 + e] = yv[4 + e] * __builtin_amdgcn_rcpf(1.0f + __builtin_amdgcn_exp2f(-1.4426950408889634f * z1[e])); }
                    u32x4 w; w.x = cvt_pk_bf16(t[0], t[1]); w.y = cvt_pk_bf16(t[2], t[3]); w.z = cvt_pk_bf16(t[4], t[5]); w.w = cvt_pk_bf16(t[6], t[7]);
                    *(u32x4*)(mix + (size_t)row * ldm + col0 + bj * HALF) = w; } } }
    }
};
struct EpiRes {
    static constexpr bool PERM = false, AFTER_DRAIN = false;
    const float* base; float* out; bf16_t* xb; float* ssq_out;
    __device__ __forceinline__ void operator()(const f32x4 (&acc)[2][2][4][2], const Unit& u, int wr, int wc, int fr, int fq) const {
        const int row0 = u.pm * BM + wr * 64 + fr, col0 = u.pn * BM + wc * 32 + 4 * fq;
        typedef __attribute__((address_space(1))) const f32x4 gf4;
        f32x4 bn[2][2];
#pragma unroll
        for (int bj = 0; bj < 2; ++bj)
#pragma unroll
            for (int n = 0; n < 2; ++n) bn[bj][n] = *(gf4*)(base + (size_t)row0 * 1024 + col0 + bj * HALF + n * 16);
#pragma unroll
        for (int idx = 0; idx < 8; ++idx) { const int ai = idx >> 2, m = idx & 3; const int row = row0 + ai * HALF + m * 16; const size_t off = (size_t)row * 1024 + col0; float ss = 0.f;
            f32x4 bc[2][2];
#pragma unroll
            for (int bj = 0; bj < 2; ++bj)
#pragma unroll
                for (int n = 0; n < 2; ++n) bc[bj][n] = bn[bj][n];
            if (idx + 1 < 8) { const int row2 = row0 + ((idx + 1) >> 2) * HALF + ((idx + 1) & 3) * 16;
#pragma unroll
                for (int bj = 0; bj < 2; ++bj)
#pragma unroll
                    for (int n = 0; n < 2; ++n) bn[bj][n] = *(gf4*)(base + (size_t)row2 * 1024 + col0 + bj * HALF + n * 16); }
#pragma unroll
            for (int bj = 0; bj < 2; ++bj)
#pragma unroll
                for (int n = 0; n < 2; ++n) { const f32x4 o = bc[bj][n] + acc[ai][bj][m][n];
                    *(f32x4*)(out + off + bj * HALF + n * 16) = o; u32x2 w; w.x = cvt_pk_bf16(o[0], o[1]); w.y = cvt_pk_bf16(o[2], o[3]); *(u32x2*)(xb + off + bj * HALF + n * 16) = w;
                    ss += (o[0] * o[0] + o[1] * o[1]) + (o[2] * o[2] + o[3] * o[3]); }
            ss += __shfl_xor(ss, 16); ss += __shfl_xor(ss, 32);
            if (fq == 0) ssq_out[(size_t)row * 16 + u.pn * 4 + wc] = ss; }
    }
};
struct EpiGU {
    static constexpr bool PERM = true, AFTER_DRAIN = false;
    const float* ssq; bf16_t* H; int ldh;
    __device__ __forceinline__ void operator()(const f32x4 (&acc)[2][2][4][2], const Unit& u, int wr, int wc, int fr, int fq) const {
        const int row0 = u.pm * BM + wr * 64 + fr, col0 = u.pn * HALF + wc * 32 + 8 * fq;
        float rsv[2][4]; row_rstd4x8(ssq, row0, fq, 1.0f, rsv);
#pragma unroll
        for (int ai = 0; ai < 2; ++ai)
#pragma unroll
            for (int m = 0; m < 4; ++m) { const int row = row0 + ai * HALF + m * 16; const float rs = rsv[ai][m];
                float t[8];
#pragma unroll
                for (int n = 0; n < 2; ++n)
#pragma unroll
                    for (int e = 0; e < 4; ++e) { const float g = acc[ai][0][m][n][e] * rs, up = acc[ai][1][m][n][e] * rs;
                        t[4 * n + e] = g * __builtin_amdgcn_rcpf(1.0f + __builtin_amdgcn_exp2f(-1.4426950408889634f * g)) * up; }
                u32x4 w; w.x = cvt_pk_bf16(t[0], t[1]); w.y = cvt_pk_bf16(t[2], t[3]); w.z = cvt_pk_bf16(t[4], t[5]); w.w = cvt_pk_bf16(t[6], t[7]);
                *(u32x4*)(H + (size_t)row * ldh + col0) = w; }
    }
};

template <class Epi, class Sched, bool ALIGN_EPI = false, bool SP2 = false>
__device__ __forceinline__ void gemm_phase(PG8_LAS unsigned char* lds, const Gemm g, const Sched& S, const Epi& E) {
    const int tid = threadIdx.x, wid = __builtin_amdgcn_readfirstlane(tid >> 6), lane = tid & 63, wr = wid >> 2, wc = wid & 3, fr = lane & 15, fq = lane >> 4;
    const int K = g.K, nt = K / BK;
    unsigned voffA[2], voffB[2];
#pragma unroll
    for (int i = 0; i < 2; ++i) { int R, C; stage_rc(tid * 16 + i * 8192, R, C); const int Rb = Epi::PERM ? ((R & ~31) + perm32(R & 31)) : R;
        voffA[i] = g.amode ? (unsigned)((C >> 4) * g.M * 32 + R * 32 + (C & 15) * 2) : (unsigned)(R * K + C) * 2u; voffB[i] = (unsigned)(Rb * K + C) * 2u; }
    const size_t kstep = (size_t)(BK * 2);
    const size_t hstep = (size_t)HALF * K * 2;
    const size_t tstep = 2 * hstep;
    const size_t kstepA = g.amode ? (size_t)4 * g.M * 32 : kstep, hstepA = g.amode ? (size_t)HALF * 32 : hstep, tstepA = 2 * hstepA;
    const unsigned ldsw = (unsigned)wid * 1024u;
    const int aoff = lds_byte(wr * 64 + fr, fq * 8), boff = lds_byte(wc * 32 + fr, fq * 8);
#define PG8_SA(b, h) (((b) * 2 + (h)) * HTB)
#define PG8_SB(b, h) ((4 + (b) * 2 + (h)) * HTB)
#define PG8_STAGE(bufoff, gbase, voff) do { _Pragma("unroll") for (int _i = 0; _i < 2; ++_i) \
        __builtin_amdgcn_global_load_lds((const unsigned*)((const char*)(gbase) + (voff)[_i]), (PG8_LAS unsigned*)(lds + (bufoff) + ldsw + _i * 8192), 16, 0, 0); } while (0)
#define PG8_LDA(dst, b, h) do { _Pragma("unroll") for (int m = 0; m < 4; ++m) _Pragma("unroll") for (int k = 0; k < 2; ++k) dst[m][k] = *(const PG8_LAS bf16x8*)(lds + PG8_SA(b, h) + aoff + m * 2048 + k * 1024); } while (0)
#define PG8_LDB(dst, b, h) do { _Pragma("unroll") for (int n = 0; n < 2; ++n) _Pragma("unroll") for (int k = 0; k < 2; ++k) dst[n][k] = *(const PG8_LAS bf16x8*)(lds + PG8_SB(b, h) + boff + n * 2048 + k * 1024); } while (0)
#define PG8_MMA(ai, bj, At, Bt) do { __builtin_amdgcn_s_setprio(1); _Pragma("unroll") for (int m = 0; m < 4; ++m) _Pragma("unroll") for (int n = 0; n < 2; ++n) _Pragma("unroll") for (int k = 0; k < 2; ++k) \
        acc[ai][bj][m][n] = __builtin_amdgcn_mfma_f32_16x16x32_bf16(Bt[n][k], At[m][k], acc[ai][bj][m][n], 0, 0, 0); __builtin_amdgcn_s_setprio(0); } while (0)
#define PG8_WAIT_V(n) asm volatile("s_waitcnt vmcnt(" #n ")" ::: "memory")
#define PG8_WAIT_L(n) asm volatile("s_waitcnt lgkmcnt(" #n ")" ::: "memory")
#define PG8_BAR __builtin_amdgcn_s_barrier()
#define PG8_SCHED __builtin_amdgcn_sched_barrier(0)
    Unit cur, nxt; int ui = 0;
    if (!S.next(0, cur)) return;
    f32x4 acc[2][2][4][2];
#pragma unroll
    for (int a = 0; a < 2; ++a)
#pragma unroll
        for (int b = 0; b < 2; ++b)
#pragma unroll
            for (int m = 0; m < 4; ++m)
#pragma unroll
                for (int n = 0; n < 2; ++n) acc[a][b][m][n] = (f32x4){0.f, 0.f, 0.f, 0.f};
    bf16x8 At[4][2], B0[2][2], B1[2][2];
    const char* cA = (const char*)g.A + (size_t)cur.pm * tstepA; const char* cB = (const char*)g.Bt + (size_t)cur.pn * tstep;
    S.a_ready(cur);
    if constexpr (SP2) {
        PG8_STAGE(PG8_SB(0, 0), cB, voffB); PG8_STAGE(PG8_SB(0, 1), cB + hstep, voffB); PG8_STAGE(PG8_SA(0, 0), cA, voffA); PG8_STAGE(PG8_SA(0, 1), cA + hstepA, voffA);
        if (wr == 1) PG8_BAR;
        PG8_WAIT_V(2); PG8_BAR;
        PG8_STAGE(PG8_SB(1, 0), cB + kstep, voffB); PG8_STAGE(PG8_SA(1, 0), cA + kstepA, voffA); PG8_STAGE(PG8_SB(1, 1), cB + hstep + kstep, voffB);
        PG8_WAIT_V(6); PG8_BAR;
    } else {
        PG8_STAGE(PG8_SB(0, 0), cB, voffB); PG8_STAGE(PG8_SA(0, 0), cA, voffA); PG8_STAGE(PG8_SB(0, 1), cB + hstep, voffB); PG8_STAGE(PG8_SA(0, 1), cA + hstepA, voffA);
        if (wr == 1) PG8_BAR;
        PG8_WAIT_V(4); PG8_BAR;
        PG8_STAGE(PG8_SB(1, 0), cB + kstep, voffB); PG8_STAGE(PG8_SA(1, 0), cA + kstepA, voffA); PG8_STAGE(PG8_SB(1, 1), cB + hstep + kstep, voffB);
        PG8_WAIT_V(6); PG8_BAR;
    }
    for (;;) {
        const bool has_next = S.next(ui + 1, nxt);
        const char* nA = has_next ? (const char*)g.A + (size_t)nxt.pm * tstepA : cA; const char* nB = has_next ? (const char*)g.Bt + (size_t)nxt.pn * tstep : cB;
        for (int t = 0; t < nt; t += 2) {
            const bool last = (t == nt - 2);
            const char* a1 = cA + (size_t)(t + 1) * kstepA;
            const char* a2 = last ? nA : cA + (size_t)(t + 2) * kstepA; const char* b2 = last ? nB : cB + (size_t)(t + 2) * kstep;
            const char* a3 = a2 + kstepA; const char* b3 = b2 + kstep;
            if (last && has_next) S.a_ready(nxt);
            if constexpr (SP2) {
            PG8_LDB(B0, 0, 0); PG8_LDB(B1, 0, 1); PG8_SCHED; PG8_LDA(At, 0, 0); PG8_STAGE(PG8_SA(1, 1), a1 + hstepA, voffA);
            PG8_WAIT_V(8); PG8_WAIT_L(0); PG8_BAR; PG8_MMA(0, 0, At, B0); PG8_MMA(0, 1, At, B1); PG8_BAR; PG8_SCHED;
            PG8_LDA(At, 0, 1); PG8_STAGE(PG8_SB(0, 0), b2, voffB); PG8_STAGE(PG8_SB(0, 1), b2 + hstep, voffB); PG8_STAGE(PG8_SA(0, 0), a2, voffA);
            PG8_WAIT_V(8); PG8_WAIT_L(0); PG8_BAR; PG8_MMA(1, 0, At, B0); PG8_MMA(1, 1, At, B1); PG8_BAR; PG8_SCHED;
            PG8_LDB(B0, 1, 0); PG8_LDB(B1, 1, 1); PG8_SCHED; PG8_LDA(At, 1, 0); PG8_STAGE(PG8_SA(0, 1), a2 + hstepA, voffA);
            PG8_WAIT_V(8); PG8_WAIT_L(0); PG8_BAR; PG8_MMA(0, 0, At, B0); PG8_MMA(0, 1, At, B1); PG8_BAR; PG8_SCHED;
            PG8_LDA(At, 1, 1); PG8_STAGE(PG8_SB(1, 0), b3, voffB); PG8_STAGE(PG8_SB(1, 1), b3 + hstep, voffB); PG8_STAGE(PG8_SA(1, 0), a3, voffA);
            PG8_WAIT_V(8); PG8_WAIT_L(0); PG8_BAR; PG8_MMA(1, 0, At, B0); PG8_MMA(1, 1, At, B1); PG8_BAR; PG8_SCHED;
            } else {
            PG8_LDB(B0, 0, 0); PG8_SCHED; PG8_LDA(At, 0, 0); PG8_STAGE(PG8_SA(1, 1), a1 + hstepA, voffA);
            PG8_WAIT_L(8); PG8_BAR; PG8_WAIT_L(0); PG8_MMA(0, 0, At, B0); PG8_BAR; PG8_SCHED;
            PG8_LDB(B1, 0, 1); PG8_STAGE(PG8_SB(0, 0), b2, voffB);
            PG8_BAR; PG8_WAIT_L(0); PG8_MMA(0, 1, At, B1); PG8_BAR;
            PG8_LDA(At, 0, 1); PG8_STAGE(PG8_SA(0, 0), a2, voffA);
            PG8_BAR; PG8_WAIT_L(0); PG8_MMA(1, 0, At, B0); PG8_BAR; PG8_SCHED;
            PG8_STAGE(PG8_SB(0, 1), b2 + hstep, voffB);
            PG8_WAIT_V(6); PG8_BAR; PG8_MMA(1, 1, At, B1); PG8_BAR;
            PG8_LDB(B0, 1, 0); PG8_SCHED; PG8_LDA(At, 1, 0); PG8_STAGE(PG8_SA(0, 1), a2 + hstepA, voffA);
            PG8_WAIT_L(8); PG8_BAR; PG8_WAIT_L(0); PG8_MMA(0, 0, At, B0); PG8_BAR; PG8_SCHED;
            PG8_LDB(B1, 1, 1); PG8_STAGE(PG8_SB(1, 0), b3, voffB);
            PG8_BAR; PG8_WAIT_L(0); PG8_MMA(0, 1, At, B1); PG8_BAR;
            PG8_LDA(At, 1, 1); PG8_STAGE(PG8_SA(1, 0), a3, voffA);
            PG8_BAR; PG8_WAIT_L(0); PG8_MMA(1, 0, At, B0); PG8_BAR; PG8_SCHED;
            PG8_STAGE(PG8_SB(1, 1), b3 + hstep, voffB);
            PG8_WAIT_V(6); PG8_BAR; PG8_MMA(1, 1, At, B1); PG8_BAR;
            }
        }
        if constexpr (ALIGN_EPI) { if (wr == 0) PG8_BAR; }
        if constexpr (!Epi::AFTER_DRAIN) { E(acc, cur, wr, wc, fr, fq); S.done(cur); }
        if (!has_next) break;
#pragma unroll
        for (int a = 0; a < 2; ++a)
#pragma unroll
            for (int b = 0; b < 2; ++b)
#pragma unroll
                for (int m = 0; m < 4; ++m)
#pragma unroll
                    for (int n = 0; n < 2; ++n) acc[a][b][m][n] = (f32x4){0.f, 0.f, 0.f, 0.f};
        cur = nxt; cA = nA; cB = nB; ++ui;
        if constexpr (ALIGN_EPI) { if (wr == 1) PG8_BAR; }
    }
    PG8_WAIT_V(0);
    if constexpr (!ALIGN_EPI) { if (wr == 0) PG8_BAR; }
    PG8_BAR;
    if constexpr (Epi::AFTER_DRAIN) { E.fused(acc, cur, wr, wc, fr, fq, lds, wid, lane); S.done(cur); }
#undef PG8_SA
#undef PG8_SB
#undef PG8_STAGE
#undef PG8_LDA
#undef PG8_LDB
#undef PG8_MMA
#undef PG8_WAIT_V
#undef PG8_WAIT_L
#undef PG8_BAR
#undef PG8_SCHED
}
}
constexpr int NWAVES = 8;
constexpr int BATCH = 8, SEQ = 4096, DM = 1024, TOK = BATCH * SEQ;
constexpr int TOKW = 768, MEMW = 256, MEML = 256, NGRP = 48, NST = 64, GCH = 16, NHEAD = 12, MHEAD = 4, HD = 64, FFN = 2816, NBLK = 16, MBLK = 256;
constexpr float C2 = 0.125f * 1.4426950408889634f;
constexpr float LOG2E = 1.4426950408889634f;

constexpr size_t MiB = 1u << 20;
constexpr size_t WS_CTL = 0, CTL_ZERO_BYTES = 1 * MiB;
constexpr size_t WS_S5TAB = 9 * MiB, WS_S5E = 13 * MiB;
constexpr size_t WS_SS0 = 1 * MiB, WS_SSA = 3 * MiB, WS_SSB = 5 * MiB, WS_SSM = 7 * MiB, WS_KMEAN = 8 * MiB;
constexpr size_t WS_WIN0 = 16 * MiB, WS_WGLU = 18 * MiB, WS_WIN1 = 20 * MiB, WS_WOUT0 = 26 * MiB, WS_WOUT1 = 28 * MiB;
constexpr size_t WS_WGU0 = 30 * MiB, WS_WGU1 = 41 * MiB, WS_WDN0 = 52 * MiB, WS_WDN1 = 58 * MiB, WS_WMKV = 64 * MiB;
constexpr size_t WS_MEMB = 65 * MiB, WS_MEMK = 69 * MiB, WS_MEMV = 70 * MiB;
constexpr size_t WS_XB = 72 * MiB;
constexpr size_t WS_R = 136 * MiB;
constexpr size_t WS_U = WS_R, WS_Y = WS_R + 48 * MiB;
constexpr size_t WS_Q1 = WS_R, WS_K1 = WS_R + 48 * MiB, WS_V1 = WS_R + 96 * MiB;
constexpr size_t WS_QM = WS_R + 144 * MiB;
constexpr size_t WS_MIX = WS_R + 160 * MiB;
constexpr size_t WS_H = WS_R;
constexpr size_t WS_END = WS_R + 224 * MiB;
constexpr int CW_BAR = 4096;

constexpr int RING_OFF = 0, RING_BYTES = 147456;
constexpr int LDSCTL_OFF = RING_BYTES, MISC_OFF = LDSCTL_OFF + 320;
constexpr int LDS_BYTES = RING_BYTES + 1024;

#define GAS __attribute__((address_space(1)))
#define LAS __attribute__((address_space(3)))
typedef unsigned short bf16;
typedef unsigned v4u __attribute__((ext_vector_type(4)));
typedef unsigned v2u __attribute__((ext_vector_type(2)));
typedef float f32x4 __attribute__((ext_vector_type(4)));
typedef GAS unsigned gu32;
typedef float f32x2 __attribute__((ext_vector_type(2)));
#define RLX_AGENT __ATOMIC_RELAXED, __HIP_MEMORY_SCOPE_AGENT
#define LDS_WAIT() asm volatile("s_waitcnt lgkmcnt(0)" ::: "memory")
#define VM_WAIT() asm volatile("s_waitcnt vmcnt(0)" ::: "memory")
__device__ __forceinline__ unsigned f2bf(float f) { unsigned u = __builtin_bit_cast(unsigned, f); return (u + 0x7fffu + ((u >> 16) & 1u)) >> 16; }
__device__ __forceinline__ unsigned pk2(float lo, float hi) { return f2bf(lo) | (f2bf(hi) << 16); }
__device__ __forceinline__ float bf2f(unsigned short h) { return __uint_as_float(((unsigned)h) << 16); }
__device__ __forceinline__ float bflo(unsigned w) { return __uint_as_float(w << 16); }
__device__ __forceinline__ float bfhi(unsigned w) { return __uint_as_float(w & 0xffff0000u); }

#define XB_TMO      128
#define XB_XCNT(j)  (256  + 64 * (j))
#define XB_XSUB(j)  (1280 + 64 * (j))
#define XB_XGEN(j)  (2304 + 64 * (j))
#define XB_TOP      3328
#define XB_TOPGEN   3392
#define XCD_BAR_WORDS 3456
#define XB_SPIN_CAP (1u << 18)

__device__ __forceinline__ unsigned xb_ld(unsigned* p)              { return __hip_atomic_load(p, __ATOMIC_RELAXED, __HIP_MEMORY_SCOPE_AGENT); }
__device__ __forceinline__ unsigned xb_add(unsigned* p, unsigned v) { return __hip_atomic_fetch_add(p, v, __ATOMIC_RELAXED, __HIP_MEMORY_SCOPE_AGENT); }
__device__ __forceinline__ unsigned xb_xcc_id() { return (unsigned)__builtin_amdgcn_s_getreg((3 << 11) | 20) & 0xFu; }
#define XB_SPIN(cond, bar) do { unsigned _sp = 0; while (cond) { __builtin_amdgcn_s_sleep(1); \
    if ((++_sp & 255u) == 0u) { if (xb_ld(&(bar)[XB_TMO])) break; if (_sp > XB_SPIN_CAP) { atomicAdd(&(bar)[XB_TMO], 1u); break; } } } } while (0)

struct XcdBarrier {
    unsigned* bar; unsigned x;
    volatile LAS unsigned* st;
};

__device__ __forceinline__ XcdBarrier xcd_barrier_post(unsigned* bar, volatile LAS unsigned* st) {
    XcdBarrier b; b.bar = bar; b.x = xb_xcc_id(); b.st = st;
    if (threadIdx.x == 0) (void)xb_add(&bar[XB_XCNT(b.x)], 1u);
    return b;
}
__device__ __forceinline__ void xcd_barrier_complete(unsigned* bar, unsigned x, unsigned& nloc, unsigned& nx) {
    const unsigned G = gridDim.x * gridDim.y * gridDim.z;
    unsigned sum, cnt, mine, sp = 0u;
    for (;;) {
        sum = 0u; cnt = 0u; mine = 0u;
#pragma unroll
        for (unsigned j = 0; j < 16; ++j) { const unsigned c = xb_ld(&bar[XB_XCNT(j)]); sum += c; cnt += (c > 0u) ? 1u : 0u; mine = (j == x) ? c : mine; }
        if (sum == G) break;
        __builtin_amdgcn_s_sleep(1);
        if ((++sp & 255u) == 0u) { if (xb_ld(&bar[XB_TMO])) break; if (sp > XB_SPIN_CAP) { atomicAdd(&bar[XB_TMO], 1u); break; } }
    }
    nloc = mine > 0u ? mine : 1u; nx = cnt > 0u ? cnt : 1u;
}

__device__ __forceinline__ void xcd_barrier(const XcdBarrier& b) {
    asm volatile("s_waitcnt vmcnt(0)" ::: "memory");
    __syncthreads();
    if (threadIdx.x == 0) {
        unsigned* bar = b.bar;
        __builtin_amdgcn_s_waitcnt(0);
        unsigned nloc = b.st[0], nx = b.st[1];
        if (nloc == 0u) { xcd_barrier_complete(bar, b.x, nloc, nx); b.st[0] = nloc; b.st[1] = nx; }
        const unsigned old = xb_add(&bar[XB_XSUB(b.x)], 1u);
        const unsigned gen = old / nloc;
        if (old + 1u == (gen + 1u) * nloc) {
            __builtin_amdgcn_fence(__ATOMIC_RELEASE, "agent");
            asm volatile("s_waitcnt vmcnt(0)" ::: "memory");
            const unsigned og = xb_add(&bar[XB_TOP], 1u);
            const unsigned tg = og / nx;
            if (og + 1u == (tg + 1u) * nx) xb_add(&bar[XB_TOPGEN], 1u);
            else XB_SPIN(xb_ld(&bar[XB_TOPGEN]) == tg, bar);
            __builtin_amdgcn_fence(__ATOMIC_ACQUIRE, "agent");
            xb_add(&bar[XB_XGEN(b.x)], 1u);
            asm volatile("s_waitcnt vmcnt(0)" ::: "memory");
        } else {
            XB_SPIN(xb_ld(&bar[XB_XGEN(b.x)]) == gen, bar);
            __builtin_amdgcn_fence(__ATOMIC_ACQUIRE, "agent");
            asm volatile("s_waitcnt vmcnt(0)" ::: "memory");
        }
    }
    __syncthreads();
}
namespace attn_body {
using bf16=__hip_bfloat16;
using bf16x8=__attribute__((ext_vector_type(8)))short;
using s16x4=__attribute__((ext_vector_type(4)))short;
using f32x16=__attribute__((ext_vector_type(16)))float;
using u32x4=__attribute__((ext_vector_type(4)))unsigned;
constexpr int D=64;
constexpr int NW=8,QBLK=32,QB=QBLK*NW,KVBLK=64;
__device__ __forceinline__ int crow(int r,int hi){return (r&3)+8*(r>>2)+4*hi;}
#define SBAR() __builtin_amdgcn_sched_barrier(0)
__device__ __forceinline__ void cmask(f32x16&p0,f32x16&p1,int jb,int qrel,int hi){
  const float NEG=-INFINITY; int kb=64*jb+4*hi;
  #pragma unroll
  for(int r=0;r<16;++r){int kv=kb+(r&3)+8*(r>>2); if(kv>qrel)p0[r]=NEG; if(kv+32>qrel)p1[r]=NEG;}
}

constexpr int NSLOT=3, SLOTB=8192;
constexpr int LDS_K=0, LDS_V=NSLOT*SLOTB, LDS_WS=2*NSLOT*SLOTB, LDS_OST=LDS_WS+NW*64*4, LDS_BYTES=LDS_OST+NW*4096;
__device__ __forceinline__ void glds16(const void*gsrc,unsigned lds_dst){unsigned keep;
  asm volatile("s_mov_b32 %0, m0\n\ts_mov_b32 m0, %2\n\ts_nop 0\n\tglobal_load_lds_dwordx4 %1, off\n\ts_mov_b32 m0, %0":"=&s"(keep):"v"(gsrc),"s"(lds_dst):"memory");}
__device__ __forceinline__ float max3f(float a,float b,float c){float r;asm("v_max3_f32 %0, %1, %2, %3":"=v"(r):"v"(a),"v"(b),"v"(c));return r;}
__device__ __forceinline__ float max2f(float a,float b){float r;asm("v_max_f32_e32 %0, %1, %2":"=v"(r):"v"(a),"v"(b));return r;}
__device__ __forceinline__ float fadd_s(float a,float b){float r;asm("v_add_f32_e32 %0, %1, %2":"=v"(r):"v"(a),"v"(b));return r;}
__device__ __forceinline__ float fsub_s(float a,float b){float r;asm("v_sub_f32_e32 %0, %1, %2":"=v"(r):"v"(a),"v"(b));return r;}
typedef float f32x2_t __attribute__((ext_vector_type(2))); typedef float f32x4_t __attribute__((ext_vector_type(4))); typedef __bf16 bf16x2_t __attribute__((ext_vector_type(2)));
__device__ __forceinline__ unsigned cvtpk_s(float lo,float hi){f32x2_t v={lo,hi};bf16x2_t b=__builtin_convertvector(v,bf16x2_t);return __builtin_bit_cast(unsigned,b);}
#define WAIT_BAR(N) asm volatile("s_waitcnt vmcnt(" #N ") lgkmcnt(0)\n\ts_barrier":::"memory")

__device__ __forceinline__ void qkt(f32x16&p0,f32x16&p1,const char*Kslot,const bf16x8*qr,int r32,int hi){
  const char*kb=Kslot+hi*1024+r32*16;
  #pragma unroll
  for(int d0=0;d0<4;++d0){
    const bf16x8 b0=*reinterpret_cast<const bf16x8*>(kb+d0*2048);
    const bf16x8 b1=*reinterpret_cast<const bf16x8*>(kb+d0*2048+512);
    p0=__builtin_amdgcn_mfma_f32_32x32x16_bf16(b0,qr[d0],p0,0,0,0);p1=__builtin_amdgcn_mfma_f32_32x32x16_bf16(b1,qr[d0],p1,0,0,0);}
}
typedef __attribute__((address_space(3))) const char* lds_cptr;
typedef short v4i16_t __attribute__((ext_vector_type(4)));
__device__ __forceinline__ void kload8(bf16x8*kf,lds_cptr kp){
  kf[0]=*(const __attribute__((address_space(3))) bf16x8*)(kp);      kf[1]=*(const __attribute__((address_space(3))) bf16x8*)(kp+512);
  kf[2]=*(const __attribute__((address_space(3))) bf16x8*)(kp+2048); kf[3]=*(const __attribute__((address_space(3))) bf16x8*)(kp+2560);
  kf[4]=*(const __attribute__((address_space(3))) bf16x8*)(kp+4096); kf[5]=*(const __attribute__((address_space(3))) bf16x8*)(kp+4608);
  kf[6]=*(const __attribute__((address_space(3))) bf16x8*)(kp+6144); kf[7]=*(const __attribute__((address_space(3))) bf16x8*)(kp+6656);
}
__device__ __forceinline__ void kload2(bf16x8*kf,lds_cptr kp,int j){ kf[2*j]=*(const __attribute__((address_space(3))) bf16x8*)(kp+j*2048); kf[2*j+1]=*(const __attribute__((address_space(3))) bf16x8*)(kp+j*2048+512); }
__device__ __forceinline__ s16x4 vtr(lds_cptr p){ return __builtin_bit_cast(s16x4,__builtin_amdgcn_ds_read_tr16_b64_v4i16((__attribute__((address_space(3))) v4i16_t*)p)); }
__device__ __forceinline__ float rowmax(const f32x16&p0,const f32x16&p1){
  float a=max3f(p0[0],p0[1],p1[0]),b=max3f(p0[2],p0[3],p1[1]);a=max3f(a,p1[2],p1[3]);
  #pragma unroll
  for(int r=4;r<16;r+=4){a=max3f(a,p0[r],p0[r+1]);b=max3f(b,p0[r+2],p0[r+3]);a=max3f(a,p1[r],p1[r+1]);b=max3f(b,p1[r+2],p1[r+3]);}
  const float m=max2f(a,b);
  auto rr=__builtin_amdgcn_permlane32_swap(__float_as_uint(m),__float_as_uint(m),false,false);
  return max2f(__uint_as_float(rr[0]),__uint_as_float(rr[1]));
}
__device__ __forceinline__ void pv(f32x16*o,int vb,bf16x8 pa0,bf16x8 pa1,bf16x8 pa2,bf16x8 pa3){
  #pragma unroll
  for(int d0=0;d0<2;++d0){s16x4 lo[4],hi[4];
    #pragma unroll
    for(int ks=0;ks<4;++ks){
      asm volatile("ds_read_b64_tr_b16 %0,%1 offset:%c2":"=&v"(lo[ks]):"v"(vb),"i"(d0*4096+ks*1024):"memory");
      asm volatile("ds_read_b64_tr_b16 %0,%1 offset:%c2":"=&v"(hi[ks]):"v"(vb),"i"(d0*4096+ks*1024+512):"memory");}
    asm volatile("s_waitcnt lgkmcnt(0)":::"memory");SBAR();
    #define PK(k) (bf16x8){lo[k][0],lo[k][1],lo[k][2],lo[k][3],hi[k][0],hi[k][1],hi[k][2],hi[k][3]}
    o[d0]=__builtin_amdgcn_mfma_f32_32x32x16_bf16(pa0,PK(0),o[d0],0,0,0);
    o[d0]=__builtin_amdgcn_mfma_f32_32x32x16_bf16(pa1,PK(1),o[d0],0,0,0);
    o[d0]=__builtin_amdgcn_mfma_f32_32x32x16_bf16(pa2,PK(2),o[d0],0,0,0);
    o[d0]=__builtin_amdgcn_mfma_f32_32x32x16_bf16(pa3,PK(3),o[d0],0,0,0);
    #undef PK
  }
}

#ifndef ATTN_STORE16
#define ATTN_STORE16(p,v) (*(u32x4*)(p)=(v))
#endif
template<int MODE,int THRL,int QP,int KP,int OP> __device__ __forceinline__ void attn_unit(const bf16*Qw0,const bf16*__restrict__ Kh,const bf16*__restrict__ Vh,bf16*Ow0,const int NT,
                                                                                          const float slope2,const float*kms0,const float*kms1,const int qb,char*shm){
  int tid_=threadIdx.x; asm volatile("":"+v"(tid_));
  const int tid=tid_,lane=tid&63,r32=lane&31,hi=lane>>5; const int wid=__builtin_amdgcn_readfirstlane(tid>>6);
  const bf16*Qw=Qw0+(long)(wid*QBLK)*QP;
  const unsigned lds0=(unsigned)(uintptr_t)shm;
  float*wsf=(float*)(shm+LDS_WS)+wid*64;
  const bf16*ksrc=Kh+(long)lane*KP+wid*8;
  const bf16*vsrc=Vh+(long)(16*(wid&3)+(lane>>2))*KP+(wid>>2)*32+(lane&3)*8;
  const unsigned kdst=lds0+LDS_K+wid*1024, vdst=lds0+LDS_V+wid*1024;
  #define PT(t) ((MODE==0)?(NT-1-(t)):(((t)<NT-4)?(NT-5-(t)):(t)))
  #define DMA_K(t,slot) glds16(ksrc+(long)PT(t)*KVBLK*KP,(unsigned)__builtin_amdgcn_readfirstlane(kdst+(slot)))
  #define DMA_V(t,slot) glds16(vsrc+(long)PT(t)*KVBLK*KP,(unsigned)__builtin_amdgcn_readfirstlane(vdst+(slot)))
  const int vb0=(int)(lds0+LDS_V)+((lane>>4)&1)*32+(lane&3)*8+(4*hi+((lane&15)>>2))*64;
  const char*Kbase=shm+LDS_K; bf16x8 kf[8];
  const lds_cptr shm3=(lds_cptr)shm; const lds_cptr kp0=shm3+LDS_K+hi*1024+r32*16; const lds_cptr vp0=shm3+LDS_V+((lane>>4)&1)*32+(lane&3)*8+(4*hi+((lane&15)>>2))*64;
  DMA_K(0,0);DMA_V(0,0);DMA_K(1,SLOTB);
  bf16x8 qr[4];
  #pragma unroll
  for(int d0=0;d0<4;++d0)qr[d0]=*reinterpret_cast<const bf16x8*>(&Qw[(long)r32*QP+d0*16+hi*8]);
  unsigned selm=0xffffffffu;
  if constexpr(MODE==1){
    f32x16 G=f32x16{};
    #pragma unroll
    for(int d0=0;d0<4;++d0){
      bf16x8 ah=bf16x8{},al=bf16x8{};
      if(r32<16){ const float*p0_=kms0+r32*64+d0*16+hi*8,*p1_=kms1+r32*64+d0*16+hi*8;
        const f32x4_t s0=*reinterpret_cast<const f32x4_t*>(p0_)+*reinterpret_cast<const f32x4_t*>(p1_), s1=*reinterpret_cast<const f32x4_t*>(p0_+4)+*reinterpret_cast<const f32x4_t*>(p1_+4);
        const float km_[8]={s0[0],s0[1],s0[2],s0[3],s1[0],s1[1],s1[2],s1[3]};
        #pragma unroll
        for(int i_=0;i_<8;i_+=2){ const unsigned wh_=cvtpk_s(km_[i_],km_[i_+1]); const float r0_=km_[i_]-__uint_as_float(wh_<<16), r1_=km_[i_+1]-__uint_as_float(wh_&0xffff0000u); const unsigned wl_=cvtpk_s(r0_,r1_);
          ah[i_]=(short)(wh_&0xffffu); ah[i_+1]=(short)(wh_>>16); al[i_]=(short)(wl_&0xffffu); al[i_+1]=(short)(wl_>>16); } }
      G=__builtin_amdgcn_mfma_f32_32x32x16_bf16(ah,qr[d0],G,0,0,0); G=__builtin_amdgcn_mfma_f32_32x32x16_bf16(al,qr[d0],G,0,0,0);}
    float g[16];
    #pragma unroll
    for(int r=0;r<4;++r){ const float a=G[r],b=G[4+r]; const float oa=__shfl_xor(a,32),ob=__shfl_xor(b,32);
      g[r]=hi?oa:a; g[4+r]=hi?a:oa; g[8+r]=hi?ob:b; g[12+r]=hi?b:ob; }
    #pragma unroll
    for(int n=0;n<16;++n) if(n>=qb) g[n]=-1.0e30f;
    const int nsel=qb<3?qb:3; unsigned mask=0u;
    #pragma unroll
    for(int rr=0;rr<3;++rr){ float best=-3.0e38f; int bi=0;
      #pragma unroll
      for(int n=0;n<16;++n){ const bool c=!((mask>>n)&1u)&&g[n]>best; best=c?g[n]:best; bi=c?n:bi; }
      if(rr<nsel) mask|=1u<<bi; }
    selm=mask|(1u<<qb);
  }
  float mhat=0.f,l_reg=0.f;f32x16 o[2];o[0]=f32x16{};o[1]=f32x16{};
  const int qrel=wid*QBLK+r32;
  const float hb=(MODE==1)?slope2*(float)(4*hi):0.f, s32=(MODE==1)?32.f*slope2:0.f, s64=(MODE==1)?64.f*slope2:0.f;
  #define CBASE(b0_,b1_,t) float b0_=fsub_s(fadd_s(s64*(float)PT(t),hb),mhat); if(MODE==1){ if(!((selm>>(PT(t)>>2))&1u)) b0_=-3.0e38f; } const float b1_=b0_+s32
  #define CFILL(X,B,bb) do{ _Pragma("unroll") for(int i_=0;i_<4;++i_){ if(MODE==1) X[(B)+i_]=__builtin_fmaf(slope2,(float)((((B)+i_)&3)+8*(((B)+i_)>>2)),bb); else X[(B)+i_]=bb; } }while(0)
  #define CINIT(C0,C1,t) do{ CBASE(b0_,b1_,t); CFILL(C0,0,b0_);CFILL(C0,4,b0_);CFILL(C0,8,b0_);CFILL(C0,12,b0_);CFILL(C1,0,b1_);CFILL(C1,4,b1_);CFILL(C1,8,b1_);CFILL(C1,12,b1_); }while(0)
  #define CMASK(P0,P1,t) do{ if(MODE==1){ int jb_=(t)-(NT-4); if(jb_>=0)cmask(P0,P1,jb_,qrel,hi);} }while(0)
  bool resc=false;
  #define START(P0,P1) do{ const float rm=rowmax(P0,P1); resc=false; \
    { const float dl=__builtin_fmaxf(rm,-1000.f); mhat=fadd_s(mhat,dl); \
      _Pragma("unroll") for(int r=0;r<16;++r){P0[r]=fsub_s(P0[r],dl);P1[r]=fsub_s(P1[r],dl);} } \
    _Pragma("unroll") for(int r=0;r<16;++r)P0[r]=__builtin_amdgcn_exp2f(P0[r]); }while(0)
  #define RESC() do{ if(resc){ asm volatile("s_waitcnt lgkmcnt(0)":::"memory"); \
      _Pragma("unroll") for(int d_=0;d_<2;++d_) _Pragma("unroll") for(int r=0;r<16;++r)o[d_][r]*=wsf[crow(r,hi)]; } }while(0)
  f32x16 pA0,pA1,pB0,pB1;
  int sl_prev=0,sl_cur=0,sl_next=SLOTB;
  #define ROT() do{sl_prev=sl_cur;sl_cur=sl_next;sl_next=(sl_next==(NSLOT-1)*SLOTB)?0:sl_next+SLOTB;}while(0)
  DMA_K(2,2*SLOTB);
  WAIT_BAR(3);
  CINIT(pA0,pA1,0);
  qkt(pA0,pA1,Kbase,qr,r32,hi);asm volatile("s_nop 15\n\ts_nop 7":"+v"(pA0),"+v"(pA1));CMASK(pA0,pA1,0);
  START(pA0,pA1);
  _Pragma("unroll") for(int r=0;r<16;++r)pA1[r]=__builtin_amdgcn_exp2f(pA1[r]);
  WAIT_BAR(0);
  DMA_K(3,0);DMA_V(1,SLOTB);
  ROT();
  kload8(kf,kp0+sl_cur);
  WAIT_BAR(2);
  s16x4 vlo[8],vhi[8]; u32x4 pw0,pw1,pw2,pw3;
  #define PKW(P,B) cvtpk_s(P[B],P[B+1])
  #define PAF(k) __builtin_bit_cast(bf16x8,pw##k)
  #define VFR(i) (bf16x8){vlo[i][0],vlo[i][1],vlo[i][2],vlo[i][3],vhi[i][0],vhi[i][1],vhi[i][2],vhi[i][3]}
  #define PIN(x) asm volatile("":"+v"(x))
  #define MX3(a,b,c) __builtin_fmaxf(__builtin_fmaxf((a),(b)),(c))
  #define GAPA(MF,A0,A1,A2,A3,W0,W1,PW) do{ MF; sacc+=A0; sacc+=A1; sacc+=A2; sacc+=A3; PIN(sacc); W0; W1; PIN(PW); SBAR(); }while(0)
  #define EX(v) __builtin_amdgcn_exp2f(v)
  #define GAPB(MF,X,B,N,bb) do{ MF; X[B]=EX(X[B]); X[B+1]=EX(X[B+1]); X[B+2]=EX(X[B+2]); X[B+3]=EX(X[B+3]); PIN(X); CFILL(N,B,bb); PIN(N); SBAR(); }while(0)
  #define VRD(i) do{ vlo[i]=vtr(vp_+(((i)>>2)*4096+((i)&3)*1024)); vhi[i]=vtr(vp_+(((i)>>2)*4096+((i)&3)*1024+512)); }while(0)
  #define KRD(G,j) do{ if(G){ kload2(kf,kp0+sl_next,j); SBAR(); } }while(0)
  #define STEP(C0,C1,P0,P1,t,GK,GV,GL) do{ SBAR(); \
    const lds_cptr vp_=vp0+sl_prev; \
    VRD(0); SBAR(); float sacc=(P0[0]+P0[1]); \
    GAPA(C0=__builtin_amdgcn_mfma_f32_32x32x16_bf16(kf[0],qr[0],C0,0,0,0), P0[2],P0[3],P0[4],P0[5],     pw0[0]=PKW(P0,0), pw0[1]=PKW(P0,2), pw0); \
    VRD(4); SBAR(); GAPA(C1=__builtin_amdgcn_mfma_f32_32x32x16_bf16(kf[1],qr[0],C1,0,0,0), P0[6],P0[7],P0[8],P0[9],     pw0[2]=PKW(P0,4), pw0[3]=PKW(P0,6), pw0); \
    VRD(1); SBAR(); GAPA(C0=__builtin_amdgcn_mfma_f32_32x32x16_bf16(kf[2],qr[1],C0,0,0,0),   P0[10],P0[11],P0[12],P0[13], pw1[0]=PKW(P0,8), pw1[1]=PKW(P0,10), pw1); \
    VRD(5); SBAR(); GAPA(C1=__builtin_amdgcn_mfma_f32_32x32x16_bf16(kf[3],qr[1],C1,0,0,0),   P0[14],P0[15],P1[0],P1[1],   pw1[2]=PKW(P0,12),pw1[3]=PKW(P0,14), pw1); \
    VRD(2); SBAR(); GAPA(C0=__builtin_amdgcn_mfma_f32_32x32x16_bf16(kf[4],qr[2],C0,0,0,0),   P1[2],P1[3],P1[4],P1[5],     pw2[0]=PKW(P1,0), pw2[1]=PKW(P1,2), pw2); \
    VRD(6); SBAR(); GAPA(C1=__builtin_amdgcn_mfma_f32_32x32x16_bf16(kf[5],qr[2],C1,0,0,0),   P1[6],P1[7],P1[8],P1[9],     pw2[2]=PKW(P1,4), pw2[3]=PKW(P1,6), pw2); \
    VRD(3); SBAR(); GAPA(C0=__builtin_amdgcn_mfma_f32_32x32x16_bf16(kf[6],qr[3],C0,0,0,0),   P1[10],P1[11],P1[12],P1[13], pw3[0]=PKW(P1,8), pw3[1]=PKW(P1,10), pw3); \
    VRD(7); SBAR(); GAPA(C1=__builtin_amdgcn_mfma_f32_32x32x16_bf16(kf[7],qr[3],C1,0,0,0),   P1[14],P1[15],0.f,0.f,       pw3[2]=PKW(P1,12),pw3[3]=PKW(P1,14), pw3); \
    l_reg+=sacc; \
    if(GK){DMA_K((t)+3,sl_cur);} if(GV){DMA_V((t)+1,sl_next);} \
    CMASKX(C0,C1,t); \
    { float a=MX3(C0[0],C0[1],C1[0]),b=MX3(C0[2],C0[3],C1[1]); a=MX3(a,C1[2],C1[3]); \
      _Pragma("unroll") for(int r=4;r<16;r+=4){a=MX3(a,C0[r],C0[r+1]);b=MX3(b,C0[r+2],C0[r+3]);a=MX3(a,C1[r],C1[r+1]);b=MX3(b,C1[r+2],C1[r+3]);} \
      float rm=__builtin_fmaxf(a,b); { auto rr=__builtin_amdgcn_permlane32_swap(__float_as_uint(rm),__float_as_uint(rm),false,false); rm=__builtin_fmaxf(__uint_as_float(rr[0]),__uint_as_float(rr[1])); } \
      resc=false; \
      if(__builtin_expect(__any(rm>(float)THRL),0)){ const float dl=__builtin_fmaxf(rm,0.f); mhat+=dl; \
        _Pragma("unroll") for(int r=0;r<16;++r){C0[r]-=dl;C1[r]-=dl;} \
        const float f=__builtin_amdgcn_exp2f(-dl); l_reg*=f; if(hi==0)wsf[r32]=f; resc=true; } } \
    CBASE(n0_,n1_,(t)+1);                                   \
    SBAR(); \
    GAPB(o[0]=__builtin_amdgcn_mfma_f32_32x32x16_bf16(PAF(0),VFR(0),o[0],0,0,0), C0,0, P0,n0_); \
    GAPB(o[1]=__builtin_amdgcn_mfma_f32_32x32x16_bf16(PAF(0),VFR(4),o[1],0,0,0), C0,4, P0,n0_); \
    KRD(GL,0); GAPB(o[0]=__builtin_amdgcn_mfma_f32_32x32x16_bf16(PAF(1),VFR(1),o[0],0,0,0), C0,8, P0,n0_); \
    KRD(GL,1); GAPB(o[1]=__builtin_amdgcn_mfma_f32_32x32x16_bf16(PAF(1),VFR(5),o[1],0,0,0), C0,12, P0,n0_); \
    KRD(GL,2); GAPB(o[0]=__builtin_amdgcn_mfma_f32_32x32x16_bf16(PAF(2),VFR(2),o[0],0,0,0), C1,0, P1,n1_); \
    KRD(GL,3); GAPB(o[1]=__builtin_amdgcn_mfma_f32_32x32x16_bf16(PAF(2),VFR(6),o[1],0,0,0), C1,4, P1,n1_); \
    GAPB(o[0]=__builtin_amdgcn_mfma_f32_32x32x16_bf16(PAF(3),VFR(3),o[0],0,0,0), C1,8, P1,n1_); \
    GAPB(o[1]=__builtin_amdgcn_mfma_f32_32x32x16_bf16(PAF(3),VFR(7),o[1],0,0,0), C1,12, P1,n1_); \
    }while(0)
  int t=1;
  CINIT(pB0,pB1,1);
  #define ENDW(tt) do{ if((tt)+3<NT){WAIT_BAR(2);} else if((tt)+2<NT){WAIT_BAR(1);} else {WAIT_BAR(0);} }while(0)
  #define CMASKX(P0,P1,t) CMASK(P0,P1,t)
  for(;t+1<NT&&t<5;t+=2){
    STEP(pB0,pB1,pA0,pA1,t,(t+3<NT),(t+1<NT),(t+1<NT));       ENDW(t);   RESC(); ROT();
    STEP(pA0,pA1,pB0,pB1,t+1,(t+4<NT),(t+2<NT),(t+2<NT));     ENDW(t+1); RESC(); ROT();
  }
  #undef CMASKX
  #define CMASKX(P0,P1,t) do{}while(0)
  for(;t+5<NT;t+=2){
    STEP(pB0,pB1,pA0,pA1,t,true,true,true);     WAIT_BAR(2); RESC(); ROT();
    STEP(pA0,pA1,pB0,pB1,t+1,true,true,true);   WAIT_BAR(2); RESC(); ROT();
  }
  #undef CMASKX
  #define CMASKX(P0,P1,t) CMASK(P0,P1,t)
  for(;t+1<NT;t+=2){
    STEP(pB0,pB1,pA0,pA1,t,(t+3<NT),(t+1<NT),(t+1<NT));       ENDW(t);   RESC(); ROT();
    STEP(pA0,pA1,pB0,pB1,t+1,(t+4<NT),(t+2<NT),(t+2<NT));     ENDW(t+1); RESC(); ROT();
  }
  STEP(pB0,pB1,pA0,pA1,NT-1,false,false,false); RESC();
  { float sacc=pB0[0]+pB0[1]; _Pragma("unroll") for(int r=2;r<16;++r)sacc+=pB0[r]; _Pragma("unroll") for(int r=0;r<16;++r)sacc+=pB1[r]; l_reg+=sacc;
    pw0=(u32x4){PKW(pB0,0),PKW(pB0,2),PKW(pB0,4),PKW(pB0,6)};pw1=(u32x4){PKW(pB0,8),PKW(pB0,10),PKW(pB0,12),PKW(pB0,14)};pw2=(u32x4){PKW(pB1,0),PKW(pB1,2),PKW(pB1,4),PKW(pB1,6)};pw3=(u32x4){PKW(pB1,8),PKW(pB1,10),PKW(pB1,12),PKW(pB1,14)};
    SBAR(); pv(o,vb0+sl_cur,PAF(0),PAF(1),PAF(2),PAF(3)); }
  #undef PKW
  #undef PAF
  #undef VFR
  #undef PIN
  #undef MX3
  #undef GAPA
  #undef GAPB
  #undef EX
  #undef VRD
  #undef KRD
  #undef STEP
  #undef ENDW
  #undef CMASKX
  {auto rr=__builtin_amdgcn_permlane32_swap(__float_as_uint(l_reg),__float_as_uint(l_reg),false,false);l_reg=__uint_as_float(rr[0])+__uint_as_float(rr[1]);}
  if(hi==0)wsf[32+r32]=l_reg;asm volatile("s_waitcnt lgkmcnt(0)":::"memory");
  float rli[16];
  #pragma unroll
  for(int r=0;r<16;++r)rli[r]=__builtin_amdgcn_rcpf(wsf[32+crow(r,hi)]);
  bf16*Ow=Ow0+(long)(wid*QBLK)*OP;
  { bf16*stg=(bf16*)(shm+LDS_OST)+wid*2048;
    #pragma unroll
    for(int r=0;r<16;++r){const int orow=crow(r,hi);
      #pragma unroll
      for(int d0=0;d0<2;++d0)stg[orow*64+d0*32+r32]=__float2bfloat16(o[d0][r]*rli[r]);}
    asm volatile("s_waitcnt lgkmcnt(0)":::"memory");
    #pragma unroll
    for(int i=0;i<4;++i){const int row=i*8+(lane>>3),ch=lane&7; const u32x4 v=*(const u32x4*)(stg+row*64+ch*8); ATTN_STORE16(Ow+(long)row*OP+ch*8,v);} }
  asm volatile("s_waitcnt lgkmcnt(0)\n\ts_barrier":::"memory");
  #undef DMA_K
  #undef DMA_V
  #undef CMASK
  #undef CINIT
  #undef CBASE
  #undef CFILL
  #undef PT
  #undef START
  #undef RESC
  #undef ROT
}
constexpr int ATTN_LDS_BYTES=LDS_BYTES;
#undef SBAR
#undef WAIT_BAR
}
__device__ __forceinline__ float wave_sum(float v) {
#pragma unroll
    for (int o = 1; o < 64; o <<= 1) v += __shfl_xor(v, o);
    return v;
}
__device__ __forceinline__ float wave_max(float v) {
#pragma unroll
    for (int o = 1; o < 64; o <<= 1) v = fmaxf(v, __shfl_xor(v, o));
    return v;
}
__device__ __forceinline__ int opaque_zero() { int z; asm volatile("v_mov_b32 %0, 0" : "=v"(z)); return z; }

__device__ __forceinline__ void p0_transpose_item(const float* W, int K, int N, bf16* WT, int dest_row0, int k0, int n0, const float* gk, LAS float* scr, int lane) {
    float wv[32];
#pragma unroll
    for (int i = 0; i < 32; ++i) { const int kk = 2 * i + (lane >> 5); wv[i] = W[(size_t)(k0 + kk) * N + n0 + (lane & 31)]; }
    if (gk) {
#pragma unroll
        for (int i = 0; i < 32; ++i) wv[i] *= gk[k0 + 2 * i + (lane >> 5)]; }
#pragma unroll
    for (int i = 0; i < 32; ++i) { const int kk = 2 * i + (lane >> 5); scr[kk * 33 + (lane & 31)] = wv[i]; }
    LDS_WAIT(); asm volatile("" ::: "memory");
    const int c = lane & 7;
#pragma unroll
    for (int j = 0; j < 4; ++j) { const int n = (lane >> 3) + 8 * j; const LAS float* s = scr + (8 * c) * 33 + n;
        v4u o; o.x = pk2(s[0 * 33], s[1 * 33]); o.y = pk2(s[2 * 33], s[3 * 33]); o.z = pk2(s[4 * 33], s[5 * 33]); o.w = pk2(s[6 * 33], s[7 * 33]);
        *(GAS v4u*)(WT + (size_t)(dest_row0 + n) * K + k0 + 8 * c) = o; }
    LDS_WAIT(); asm volatile("" ::: "memory");
}
__device__ __forceinline__ void p0_matrix_item(const float* W, int K, int N, bf16* WT, const float* gk, int mode, int item, LAS float* scr, int lane) {
    const int nblk = N / 32, kb = item / nblk, nb = item - kb * nblk, k0 = 64 * kb, n0 = 32 * nb;
    const int dr = (mode == 0) ? n0 : (256 * (n0 >> 7) + (n0 & 127) + (mode == 2 ? 128 : 0));
    p0_transpose_item(W, K, N, WT, dr, k0, n0, gk, scr, lane);
}
template <int NR>
__device__ __forceinline__ void rows_to_bf16_ssq(const float* xrow, bf16* orow, float* ssq16, int lane) {
    f32x4 v[NR][4];
#pragma unroll
    for (int r = 0; r < NR; ++r) { const GAS f32x4* xr = (const GAS f32x4*)(xrow + (size_t)r * 1024) + lane;
#pragma unroll
        for (int j = 0; j < 4; ++j) v[r][j] = xr[64 * j]; }
#pragma unroll
    for (int r = 0; r < NR; ++r) { float s = 0.f;
#pragma unroll
        for (int j = 0; j < 4; ++j) s += (v[r][j].x * v[r][j].x + v[r][j].y * v[r][j].y) + (v[r][j].z * v[r][j].z + v[r][j].w * v[r][j].w);
        s = wave_sum(s);
        GAS unsigned long long* o8 = (GAS unsigned long long*)(orow + (size_t)r * 1024) + lane;
#pragma unroll
        for (int j = 0; j < 4; ++j) o8[64 * j] = (unsigned long long)pk2(v[r][j].x, v[r][j].y) | ((unsigned long long)pk2(v[r][j].z, v[r][j].w) << 32);
        if (lane < 16) ssq16[r * 16 + lane] = (lane == 0) ? s : 0.f; }
}

__device__ __forceinline__ void s5_naive_unit(int b, int g, const bf16* U, bf16* Y, const float* lam_re, const float* lam_im, const float* log_dt, const float* b_re, const float* b_im,
                                              const float* c_re, const float* c_im, const float* dvec, int lane) {
    const int p = lane;
    const float lr = lam_re[g * 64 + p], li = lam_im[g * 64 + p], dt = expf(log_dt[g]);
    const float mag = expf(lr * dt), ar = mag * cosf(li * dt), ai = mag * sinf(li * dt);
    const float den = lr * lr + li * li, nr = ar - 1.0f, fr = (nr * lr + ai * li) / den, fi = (ai * lr - nr * li) / den;
    float bbr[16], bbi[16], cr[16], ci[16];
#pragma unroll
    for (int c = 0; c < 16; ++c) { const float br = b_re[((size_t)g * 64 + p) * 16 + c], bi = b_im[((size_t)g * 64 + p) * 16 + c]; bbr[c] = fr * br - fi * bi; bbi[c] = fr * bi + fi * br;
        cr[c] = c_re[((size_t)g * 16 + c) * 64 + p]; ci[c] = c_im[((size_t)g * 16 + c) * 64 + p]; }
    const int ch = ((lane & 1) << 3) | ((lane & 2) << 1) | ((lane & 4) >> 1) | ((lane & 8) >> 3);
    const float dch = dvec[16 * g + ch];
    const int z0 = opaque_zero();
    constexpr int TP = 16;
    const bf16* up = U + ((size_t)g * TOK + (size_t)b * SEQ) * 16 + z0;
    bf16* yp = Y + ((size_t)g * TOK + (size_t)b * SEQ) * 16 + ch;
    float xr = 0.f, xi = 0.f;
#pragma unroll 2
    for (int s = 0; s < SEQ; ++s) {
        const v4u w0 = *(const GAS v4u*)(up + (size_t)s * TP), w1 = *(const GAS v4u*)(up + (size_t)s * TP + 8);
        const float uch = bf2f(up[(size_t)s * TP + ch]);
        const float uu[16] = {bflo(w0.x), bfhi(w0.x), bflo(w0.y), bfhi(w0.y), bflo(w0.z), bfhi(w0.z), bflo(w0.w), bfhi(w0.w), bflo(w1.x), bfhi(w1.x), bflo(w1.y), bfhi(w1.y), bflo(w1.z), bfhi(w1.z), bflo(w1.w), bfhi(w1.w)};
        float bur = 0.f, bui = 0.f;
#pragma unroll
        for (int c = 0; c < 16; ++c) { bur += bbr[c] * uu[c]; bui += bbi[c] * uu[c]; }
        const float nxr = ar * xr - ai * xi + bur, nxi = ar * xi + ai * xr + bui; xr = nxr; xi = nxi;
        float v[16];
#pragma unroll
        for (int c = 0; c < 16; ++c) v[c] = cr[c] * xr - ci[c] * xi;
        float w[8], x4[4], x2[2], z;
        { const bool bit = lane & 1;
#pragma unroll
          for (int j = 0; j < 8; ++j) { const float send = bit ? v[j] : v[j + 8], keep = bit ? v[j + 8] : v[j]; w[j] = keep + __shfl_xor(send, 1); } }
        { const bool bit = lane & 2;
#pragma unroll
          for (int j = 0; j < 4; ++j) { const float send = bit ? w[j] : w[j + 4], keep = bit ? w[j + 4] : w[j]; x4[j] = keep + __shfl_xor(send, 2); } }
        { const bool bit = lane & 4;
#pragma unroll
          for (int j = 0; j < 2; ++j) { const float send = bit ? x4[j] : x4[j + 2], keep = bit ? x4[j + 2] : x4[j]; x2[j] = keep + __shfl_xor(send, 4); } }
        { const bool bit = lane & 8; const float send = bit ? x2[0] : x2[1], keep = bit ? x2[1] : x2[0]; z = keep + __shfl_xor(send, 8); }
        z += __shfl_xor(z, 16); z += __shfl_xor(z, 32);
        const float yv = z + dch * uch;
        const float ge = 0.5f * yv * (1.0f + erff(yv * 0.70710678118654752f));
        if (lane < 16) yp[(size_t)s * TP] = (bf16)f2bf(ge);
    }
}

__device__ __forceinline__ void memattn_naive_unit(int tok, int h, const bf16* QM, const bf16* memk, const bf16* memv, bf16* mix, LAS float* ps, int lane) {
    const int b = tok >> 12; const int z0 = opaque_zero();
    const float qv = bf2f(QM[(size_t)tok * 256 + h * 64 + lane]);
    float q[64];
#pragma unroll
    for (int d = 0; d < 64; ++d) q[d] = __shfl(qv, d);
    float sc[4];
#pragma unroll
    for (int i = 0; i < 4; ++i) { const int j = lane + 64 * i; const GAS v4u* kr = (const GAS v4u*)(memk + ((size_t)(b * 256 + j)) * 256 + h * 64 + z0); float a = 0.f;
#pragma unroll
        for (int c = 0; c < 8; ++c) { const v4u w = kr[c]; a += q[8 * c] * bflo(w.x) + q[8 * c + 1] * bfhi(w.x) + q[8 * c + 2] * bflo(w.y) + q[8 * c + 3] * bfhi(w.y) + q[8 * c + 4] * bflo(w.z) + q[8 * c + 5] * bfhi(w.z) + q[8 * c + 6] * bflo(w.w) + q[8 * c + 7] * bfhi(w.w); }
        sc[i] = a; }
    const float m = wave_max(fmaxf(fmaxf(sc[0], sc[1]), fmaxf(sc[2], sc[3])));
    float l = 0.f;
#pragma unroll
    for (int i = 0; i < 4; ++i) { const float pe = __builtin_amdgcn_exp2f(sc[i] - m); l += pe; ps[lane + 64 * i] = pe; }
    l = wave_sum(l);
    LDS_WAIT(); asm volatile("" ::: "memory");
    float o = 0.f; const bf16* vp = memv + (size_t)(b * 256) * 256 + h * 64 + lane;
#pragma unroll 8
    for (int j = 0; j < 256; ++j) o += ps[j] * bf2f(vp[(size_t)j * 256]);
    mix[(size_t)tok * 1024 + 768 + h * 64 + lane] = (bf16)f2bf(o / l);
    LDS_WAIT(); asm volatile("" ::: "memory");
}

__device__ __forceinline__ float dot64_bf16(const float (&q)[64], const GAS v4u* kr) {
    float a = 0.f;
#pragma unroll
    for (int c = 0; c < 8; ++c) { const v4u w = kr[c]; a += q[8 * c] * bflo(w.x) + q[8 * c + 1] * bfhi(w.x) + q[8 * c + 2] * bflo(w.y) + q[8 * c + 3] * bfhi(w.y) + q[8 * c + 4] * bflo(w.z) + q[8 * c + 5] * bfhi(w.z) + q[8 * c + 6] * bflo(w.w) + q[8 * c + 7] * bfhi(w.w); }
    return a;
}
__device__ __forceinline__ void moba_naive_unit(int tok, int h, const bf16* Q1, const bf16* K1, const bf16* V1, const float* KMEAN, bf16* mix, LAS float* ps, int lane) {
    const int b = tok >> 12, s = tok & (SEQ - 1), qb = s >> 8; const int z0 = opaque_zero();
    const float qv = bf2f(Q1[(size_t)tok * TOKW + h * 64 + lane]);
    float q[64];
#pragma unroll
    for (int d = 0; d < 64; ++d) q[d] = __shfl(qv, d);
    float gate = -1e30f;
    { const int n = lane & 15; const GAS f32x4* km = (const GAS f32x4*)(KMEAN + ((size_t)((b * NHEAD + h) * NBLK + n)) * 64 + z0); float a = 0.f;
#pragma unroll
      for (int c = 0; c < 16; ++c) { const f32x4 w = km[c]; a += q[4 * c] * w.x + q[4 * c + 1] * w.y + q[4 * c + 2] * w.z + q[4 * c + 3] * w.w; }
      if (n < qb) gate = a; }
    float g[16];
#pragma unroll
    for (int n = 0; n < 16; ++n) g[n] = __shfl(gate, n);
    const int nsel = qb < 3 ? qb : 3;
    unsigned mask = 0u;
#pragma unroll
    for (int r = 0; r < 3; ++r) { float best = -3.0e38f; int bi = 0;
#pragma unroll
        for (int n = 0; n < 16; ++n) { const bool c = !((mask >> n) & 1u) && g[n] > best; best = c ? g[n] : best; bi = c ? n : bi; }
        if (r < nsel) mask |= 1u << bi; }
    int blk0 = 0, blk1 = 0, blk2 = 0, cnt = 0;
#pragma unroll
    for (int n = 0; n < 16; ++n) if ((mask >> n) & 1u) { if (cnt == 0) blk0 = n; else if (cnt == 1) blk1 = n; else blk2 = n; ++cnt; }
    const int nslots = nsel + 1;
    const float slope = __builtin_amdgcn_exp2f(-8.0f * (float)(h + 1) / 12.0f) * LOG2E;
    const bf16* kh = K1 + (size_t)b * SEQ * TOKW + h * 64 + z0;
    float mx = -3.0e38f;
#pragma unroll
    for (int sl = 0; sl < 4; ++sl) if (sl < nslots) {
        const int blk = (sl == nsel) ? qb : (sl == 0 ? blk0 : (sl == 1 ? blk1 : blk2));
#pragma unroll
        for (int i = 0; i < 4; ++i) { const int j = lane + 64 * i, pos = blk * 256 + j;
            float a = dot64_bf16(q, (const GAS v4u*)(kh + (size_t)pos * TOKW)) + slope * (float)(pos - s);
            if (pos > s) a = -3.0e38f;
            ps[sl * 256 + j] = a; mx = fmaxf(mx, a); } }
    mx = wave_max(mx);
    LDS_WAIT(); asm volatile("" ::: "memory");
    float l = 0.f;
#pragma unroll
    for (int sl = 0; sl < 4; ++sl) if (sl < nslots) {
#pragma unroll
        for (int i = 0; i < 4; ++i) { const int j = lane + 64 * i; const float a = ps[sl * 256 + j]; const float pe = (a < -1.0e37f) ? 0.f : __builtin_amdgcn_exp2f(a - mx); l += pe; ps[sl * 256 + j] = pe; } }
    l = wave_sum(l);
    LDS_WAIT(); asm volatile("" ::: "memory");
    float o = 0.f; const bf16* vh = V1 + (size_t)b * SEQ * TOKW + h * 64 + lane;
#pragma unroll
    for (int sl = 0; sl < 4; ++sl) if (sl < nslots) {
        const int blk = (sl == nsel) ? qb : (sl == 0 ? blk0 : (sl == 1 ? blk1 : blk2));
        const bf16* vp = vh + (size_t)(blk * 256) * TOKW;
#pragma unroll 8
        for (int j = 0; j < 256; ++j) o += ps[sl * 256 + j] * bf2f(vp[(size_t)j * TOKW]); }
    mix[(size_t)tok * 1024 + h * 64 + lane] = (bf16)f2bf(o / l);
    LDS_WAIT(); asm volatile("" ::: "memory");
}

constexpr int S5_PITCH = 272;
constexpr int S5_WST = 0, S5_WYC = 128 * S5_PITCH, S5_KT = 2 * 128 * S5_PITCH, S5_TAB_BYTES = S5_KT + 10 * 512;
constexpr int S5_XS = S5_TAB_BYTES, S5_XS_BYTES = 32 * S5_PITCH;
static_assert(S5_XS + NWAVES * S5_XS_BYTES <= RING_BYTES, "S5 LDS map");
typedef short s5_bf16x8 __attribute__((ext_vector_type(8)));
typedef float s5_f32x16 __attribute__((ext_vector_type(16)));

__device__ __forceinline__ void s5_apow(float lr, float li, float dt, int n, float& pr, float& pi) { const float m = expf(lr * dt * (float)n), th = li * dt * (float)n; pr = m * cosf(th); pi = m * sinf(th); }
__device__ __forceinline__ void s5_apow_fast(float lr, float li, float dt, int n, float& pr, float& pi) { const float m = __expf(lr * dt * (float)n), th = li * dt * (float)n; pr = m * __cosf(th); pi = m * __sinf(th); }
__device__ __forceinline__ void s5_zoh(float lr, float li, float dt, float& fr, float& fi) {
    float ar, ai; s5_apow(lr, li, dt, 1, ar, ai); const float den = lr * lr + li * li, nr = ar - 1.0f; fr = (nr * lr + ai * li) / den; fi = (ai * lr - nr * li) / den;
}
__device__ __forceinline__ void s5_tab_wst(int g, int jt, unsigned char* tab, const float* lam_re, const float* lam_im, const float* log_dt, const float* b_re, const float* b_im, int lane) {
    const int s = lane >> 3, cp = lane & 7; const float dt = expf(log_dt[g]);
    float zr, zi, mylr, myli;
    { const int p = (jt >> 1) * 32 + (lane & 31); mylr = lam_re[g * 64 + p]; myli = lam_im[g * 64 + p]; s5_zoh(mylr, myli, dt, zr, zi); }
#pragma unroll 4
    for (int r = 0; r < 32; ++r) { const int p = (jt >> 1) * 32 + r; const float lr = __shfl(mylr, r), li = __shfl(myli, r), fr = __shfl(zr, r), fi = __shfl(zi, r);
        float pr, pi; s5_apow_fast(lr, li, dt, 7 - s, pr, pi);
        float o[2];
#pragma unroll
        for (int e = 0; e < 2; ++e) { const int c = 2 * cp + e; const float br = b_re[((size_t)g * 64 + p) * 16 + c], bi = b_im[((size_t)g * 64 + p) * 16 + c];
            const float bbr = fr * br - fi * bi, bbi = fr * bi + fi * br; o[e] = (jt & 1) ? (pr * bbi + pi * bbr) : (pr * bbr - pi * bbi); }
        *(GAS unsigned*)(tab + S5_WST + (32 * jt + r) * S5_PITCH + (16 * s + 2 * cp) * 2) = pk2(o[0], o[1]); }
}
__device__ __forceinline__ void s5_tab_const(int g, float* ctab, const float* lam_re, const float* lam_im, const float* log_dt, int lane) {
    const float dt = expf(log_dt[g]); float xr, xi; s5_apow(lam_re[g * 64 + lane], lam_im[g * 64 + lane], dt, 1, xr, xi);
#pragma unroll
    for (int q = 0; q < 3; ++q) { const float nr = xr * xr - xi * xi, ni = 2.0f * xr * xi; xr = nr; xi = ni; }
    const float ar = xr, ai = xi;
#pragma unroll
    for (int q = 0; q < 5; ++q) { const float nr = xr * xr - xi * xi, ni = 2.0f * xr * xi; xr = nr; xi = ni; }
    *(GAS f32x4*)(ctab + ((size_t)g * 64 + lane) * 4) = (f32x4){ar, ai, xr, xi};
}
__device__ __forceinline__ void s5_tab_wyc(int g, int t, unsigned char* tab, const float* lam_re, const float* lam_im, const float* log_dt, const float* c_re, const float* c_im, int lane) {
    const int p = lane; const float dt = expf(log_dt[g]); float pr, pi; s5_apow_fast(lam_re[g * 64 + p], lam_im[g * 64 + p], dt, t + 1, pr, pi);
#pragma unroll
    for (int c = 0; c < 16; ++c) { const float cr = c_re[((size_t)g * 16 + c) * 64 + p], ci = c_im[((size_t)g * 16 + c) * 64 + p];
        *(GAS unsigned*)(tab + S5_WYC + (16 * t + c) * S5_PITCH + 4 * p) = pk2(cr * pr - ci * pi, -(cr * pi + ci * pr)); }
}
__device__ __forceinline__ void s5_tab_kt(int g, int d, unsigned char* tab, const float* lam_re, const float* lam_im, const float* log_dt, const float* b_re, const float* b_im, const float* c_re, const float* c_im,
                                          const float* dvec, int lane) {
    const float dt = expf(log_dt[g]); float mr, mi;
    { const float lr = lam_re[g * 64 + lane], li = lam_im[g * 64 + lane]; float pr, pi, fr, fi; s5_apow_fast(lr, li, dt, d, pr, pi); s5_zoh(lr, li, dt, fr, fi); mr = pr * fr - pi * fi; mi = pr * fi + pi * fr; }
    float acc[4] = {0.f, 0.f, 0.f, 0.f};
#pragma unroll 8
    for (int p = 0; p < 64; ++p) { const float pmr = __shfl(mr, p), pmi = __shfl(mi, p);
#pragma unroll
        for (int i = 0; i < 4; ++i) { const int e = lane + 64 * i, c = e >> 4, c2 = e & 15;
            const float br = b_re[((size_t)g * 64 + p) * 16 + c2], bi = b_im[((size_t)g * 64 + p) * 16 + c2], cr = c_re[((size_t)g * 16 + c) * 64 + p], ci = c_im[((size_t)g * 16 + c) * 64 + p];
            const float tr = pmr * br - pmi * bi, ti = pmr * bi + pmi * br; acc[i] += cr * tr - ci * ti; } }
#pragma unroll
    for (int i = 0; i < 4; ++i) { const int e = lane + 64 * i, c = e >> 4, c2 = e & 15; float v = acc[i]; if (d == 0 && c == c2) v += dvec[16 * g + c];
        *(GAS bf16*)(tab + S5_KT + (d + 1) * 512 + c * 32 + c2 * 2) = (bf16)f2bf(v);
        if (d == 0) *(GAS bf16*)(tab + S5_KT + c * 32 + c2 * 2) = (bf16)0; }
}

template <bool FINAL>
__device__ __forceinline__ void s5_unit(int g, int seg, const bf16* Ug, bf16* Yg, const unsigned char* tab, float* Ebuf, const float* ctab, LAS unsigned char* L) {
    int tid_ = threadIdx.x; asm volatile("" : "+v"(tid_));
    const int tid = tid_, lane = tid & 63, r32 = lane & 31, hi = lane >> 5, b = __builtin_amdgcn_readfirstlane(tid >> 6);
    { const int npc = (FINAL ? S5_TAB_BYTES : S5_WYC) / 1024; const unsigned l0 = (unsigned)(uintptr_t)(unsigned char*)L;
      for (int i = b; i < npc; i += NWAVES) attn_body::glds16(tab + (size_t)i * 1024 + lane * 16, (unsigned)__builtin_amdgcn_readfirstlane(l0 + i * 1024)); }
    const size_t tok0 = (size_t)g * TOK + (size_t)b * SEQ + (size_t)seg * 256;
    s5_bf16x8 A[8];
    { const bf16* up = Ug + (tok0 + 8 * r32) * 16 + 8 * hi;
#pragma unroll
      for (int s = 0; s < 8; ++s) A[s] = *(const GAS s5_bf16x8*)(up + s * 16); }
    float aLr[2], aLi[2], aSr[2], aSi[2];
#pragma unroll
    for (int k = 0; k < 2; ++k) { const f32x4 cv = *(const GAS f32x4*)(ctab + ((size_t)g * 64 + 32 * k + r32) * 4); aLr[k] = cv.x; aLi[k] = cv.y; aSr[k] = cv.z; aSi[k] = cv.w; }
    float cr[2] = {0.f, 0.f}, ci[2] = {0.f, 0.f};
    if (FINAL) {
        const float* eb = Ebuf + ((size_t)(b * NGRP + g) * 16) * 128;
        f32x2 ev[15][2];
#pragma unroll
        for (int j = 0; j < 15; ++j)
#pragma unroll
            for (int k = 0; k < 2; ++k) ev[j][k] = (j < seg) ? *(const GAS f32x2*)(eb + (size_t)j * 128 + 2 * (32 * k + r32)) : (f32x2){0.f, 0.f};
#pragma unroll
        for (int j = 0; j < 15; ++j) if (j < seg) {
#pragma unroll
            for (int k = 0; k < 2; ++k) { const float nr = aSr[k] * cr[k] - aSi[k] * ci[k] + ev[j][k].x, ni = aSr[k] * ci[k] + aSi[k] * cr[k] + ev[j][k].y; cr[k] = nr; ci[k] = ni; } }
    }
    asm volatile("s_waitcnt vmcnt(0)" ::: "memory");
    __syncthreads();
    s5_f32x16 S[4];
#pragma unroll
    for (int j = 0; j < 4; ++j) { S[j] = s5_f32x16{};
#pragma unroll
        for (int s = 0; s < 8; ++s) { const s5_bf16x8 bf = *(const LAS s5_bf16x8*)(L + S5_WST + (32 * j + r32) * S5_PITCH + (16 * s + 8 * hi) * 2);
            S[j] = __builtin_amdgcn_mfma_f32_32x32x16_bf16(A[s], bf, S[j], 0, 0, 0); } }
#pragma unroll
    for (int i = 0; i < 8; ++i) { const bool own = ((i & 1) == hi);
#pragma unroll
        for (int q = 0; q < 4; ++q) { const int reg = 4 * (i >> 1) + q;
#pragma unroll
            for (int k = 0; k < 2; ++k) { const float sr = S[2 * k][reg], si = S[2 * k + 1][reg];
                const float nr = aLr[k] * cr[k] - aLi[k] * ci[k] + sr, ni = aLr[k] * ci[k] + aLi[k] * cr[k] + si;
                S[2 * k][reg] = own ? cr[k] : sr; S[2 * k + 1][reg] = own ? ci[k] : si; cr[k] = own ? nr : cr[k]; ci[k] = own ? ni : ci[k]; } }
#pragma unroll
        for (int k = 0; k < 2; ++k) { const float orr = __shfl_xor(cr[k], 32), oi = __shfl_xor(ci[k], 32); cr[k] = own ? cr[k] : orr; ci[k] = own ? ci[k] : oi; } }
    if (!FINAL) {
        if (hi == 0) { float* eb = Ebuf + ((size_t)(b * NGRP + g) * 16 + seg) * 128;
#pragma unroll
            for (int k = 0; k < 2; ++k) *(GAS f32x2*)(eb + 2 * (32 * k + r32)) = (f32x2){cr[k], ci[k]}; }
    } else {
        LAS unsigned char* XS = L + S5_XS + b * S5_XS_BYTES;
#pragma unroll
        for (int reg = 0; reg < 16; ++reg) { const int chunk = (reg & 3) + 8 * (reg >> 2) + 4 * hi;
#pragma unroll
            for (int k = 0; k < 2; ++k) *(LAS unsigned*)(XS + chunk * S5_PITCH + 4 * (32 * k + r32)) = pg8::cvt_pk_bf16(S[2 * k][reg], S[2 * k + 1][reg]); }
        s5_bf16x8 Xf[8];
#pragma unroll
        for (int kk = 0; kk < 8; ++kk) Xf[kk] = *(const LAS s5_bf16x8*)(XS + r32 * S5_PITCH + (16 * kk + 8 * hi) * 2);
        s5_f32x16 Yc[4];
#pragma unroll
        for (int j = 0; j < 4; ++j) { Yc[j] = s5_f32x16{};
#pragma unroll
            for (int s = 0; s < 8; ++s) if (s <= 2 * j + 1) { const int d1 = 2 * j + (r32 >> 4) - s + 1;
                const s5_bf16x8 bf = *(const LAS s5_bf16x8*)(L + S5_KT + d1 * 512 + (r32 & 15) * 32 + 16 * hi);
                Yc[j] = __builtin_amdgcn_mfma_f32_32x32x16_bf16(A[s], bf, Yc[j], 0, 0, 0); }
#pragma unroll
            for (int kk = 0; kk < 8; ++kk) { const s5_bf16x8 bf = *(const LAS s5_bf16x8*)(L + S5_WYC + (32 * j + r32) * S5_PITCH + (16 * kk + 8 * hi) * 2);
                Yc[j] = __builtin_amdgcn_mfma_f32_32x32x16_bf16(Xf[kk], bf, Yc[j], 0, 0, 0); } }
        asm volatile("s_waitcnt lgkmcnt(0)" ::: "memory");
#pragma unroll
        for (int j = 0; j < 4; ++j)
#pragma unroll
            for (int reg = 0; reg < 16; reg += 2) { const pg8::f32x2 ge = pg8::gelu_pk((pg8::f32x2){Yc[j][reg], Yc[j][reg + 1]});
                const int chunk = (reg & 3) + 8 * (reg >> 2) + 4 * hi, tokl = 8 * chunk + 2 * j + (r32 >> 4), c = r32 & 15;
                const unsigned gw_ = pg8::cvt_pk_bf16(ge.x, ge.y); *(LAS bf16*)(XS + tokl * 32 + c * 2) = (bf16)(gw_ & 0xffffu); *(LAS bf16*)(XS + (tokl + 8) * 32 + c * 2) = (bf16)(gw_ >> 16); }
        asm volatile("s_waitcnt lgkmcnt(0)" ::: "memory");
        bf16* yo = Yg + tok0 * 16;
#pragma unroll
        for (int i = 0; i < 8; ++i) { const int pc = lane + 64 * i; const v4u w = *(const LAS v4u*)(XS + 16 * pc); *(GAS v4u*)(yo + 8 * pc) = w; }
    }
    __syncthreads();
}

#ifndef MK_ONE_LAUNCH
#define MK_ONE_LAUNCH 1
#endif
constexpr int N_PHASES = 14;
struct Args { const float* in[23]; float* out; unsigned char* ws; int ph_lo, ph_hi; };

#ifndef PROBE_P0
#define PROBE_P0 0
#endif
#define P0_ITEM(it) do { \
            int r = it; \
            if (r < I_TKT) { s5_tab_kt(r >> 3, r & 7, S5TAB + (size_t)(r >> 3) * S5_TAB_BYTES, args.in[6], args.in[7], args.in[8], args.in[9], args.in[10], args.in[11], args.in[12], args.in[13], lane); break; } r -= I_TKT; \
            if (r < I_TST) { s5_tab_wst(r >> 2, r & 3, S5TAB + (size_t)(r >> 2) * S5_TAB_BYTES, args.in[6], args.in[7], args.in[8], args.in[9], args.in[10], lane); break; } r -= I_TST; \
            if (r < I_TYC) { s5_tab_wyc(r >> 3, r & 7, S5TAB + (size_t)(r >> 3) * S5_TAB_BYTES, args.in[6], args.in[7], args.in[8], args.in[11], args.in[12], lane); break; } r -= I_TYC; \
            if (r < I_TCO) { s5_tab_const(r, S5C, args.in[6], args.in[7], args.in[8], lane); break; } r -= I_TCO; \
            if (r < I_SQ) { p0_matrix_item(args.in[5], 1024, 1024, WIN0, mixg, 0, r, scr, lane); break; } r -= I_SQ; \
            if (r < I_GLU) { p0_matrix_item(args.in[14], 768, 768, WGLU, nullptr, 0, r, scr, lane); break; } r -= I_GLU; \
            if (r < I_IN1) { p0_matrix_item(args.in[16], 1024, 2560, WIN1, mixg + 1024, 0, r, scr, lane); break; } r -= I_IN1; \
            if (r < I_SQ) { p0_matrix_item(args.in[17], 1024, 1024, WOUT0, nullptr, 0, r, scr, lane); break; } r -= I_SQ; \
            if (r < I_SQ) { p0_matrix_item(args.in[17] + 1024 * 1024, 1024, 1024, WOUT1, nullptr, 0, r, scr, lane); break; } r -= I_SQ; \
            if (r < I_GU) { p0_matrix_item(args.in[19], 1024, FFN, WGU0, ffng, 1, r, scr, lane); break; } r -= I_GU; \
            if (r < I_GU) { p0_matrix_item(args.in[20], 1024, FFN, WGU0, ffng, 2, r, scr, lane); break; } r -= I_GU; \
            if (r < I_GU) { p0_matrix_item(args.in[19] + (size_t)1024 * FFN, 1024, FFN, WGU1, ffng + 1024, 1, r, scr, lane); break; } r -= I_GU; \
            if (r < I_GU) { p0_matrix_item(args.in[20] + (size_t)1024 * FFN, 1024, FFN, WGU1, ffng + 1024, 2, r, scr, lane); break; } r -= I_GU; \
            if (r < I_DN) { p0_matrix_item(args.in[21], FFN, 1024, WDN0, nullptr, 0, r, scr, lane); break; } r -= I_DN; \
            if (r < I_DN) { p0_matrix_item(args.in[21] + (size_t)FFN * 1024, FFN, 1024, WDN1, nullptr, 0, r, scr, lane); break; } r -= I_DN; \
            p0_matrix_item(args.in[3], 1024, 512, WMKV, args.in[2], 0, r, scr, lane); \
        } while (0)
__global__ void __launch_bounds__(NWAVES * 64, 2) mega_fwd(Args args) {
    extern __shared__ __attribute__((aligned(16))) unsigned char lds[];
    LAS unsigned char* L = (LAS unsigned char*)lds;
    volatile LAS unsigned* MISC = (volatile LAS unsigned*)(L + MISC_OFF);
    const int tid = threadIdx.x, lane = tid & 63, wave = __builtin_amdgcn_readfirstlane(tid >> 6);
    const int G = gridDim.x; const int bx = blockIdx.x;
    const int vcu = (G % 8 == 0) ? (bx % 8) * (G / 8) + bx / 8 : bx;
    const int gw = vcu * NWAVES + wave, NGW = G * NWAVES;
    unsigned char* ws = args.ws;
    gu32* ctl = (gu32*)(ws + WS_CTL);
    for (int u = tid; u < (LDS_BYTES - LDSCTL_OFF) / 4; u += NWAVES * 64) ((LAS unsigned*)(L + LDSCTL_OFF))[u] = 0u;
    __syncthreads();
    XcdBarrier bar; bar.bar = (unsigned*)(ctl + CW_BAR); bar.x = 0; bar.st = nullptr;
    if (MK_ONE_LAUNCH) bar = xcd_barrier_post((unsigned*)(ctl + CW_BAR), MISC + 8);
#define MEMATTN_PHASE(u0_, us_) do { for (int un = (u0_); un < BATCH * MHEAD * NBLK; un += (us_)) { const int b_ = un >> 6, h_ = (un >> 4) & 3, qb_ = un & 15; const size_t qrow_ = (size_t)b_ * SEQ + (size_t)qb_ * 256; \
        attn_body::attn_unit<0, 8, 256, 256, 1024>((const attn_body::bf16*)(QM + qrow_ * 256 + h_ * 64), (const attn_body::bf16*)(MEMK + (size_t)b_ * MEML * 256 + h_ * 64), (const attn_body::bf16*)(MEMV + (size_t)b_ * MEML * 256 + h_ * 64), \
            (attn_body::bf16*)(MIX + qrow_ * 1024 + 768 + h_ * 64), 4, 0.f, nullptr, nullptr, 0, (char*)lds + RING_OFF); } } while (0)
    const int lo = args.ph_lo, hi = args.ph_hi;
#ifndef PROBE_DUP
#define PROBE_DUP -1
#endif
#define IN(k) (lo <= (k) && (k) < hi)
#define PH_REP(k) for (int rep_ = 0; rep_ < ((PROBE_DUP == (k)) ? 2 : 1); ++rep_)
#define SEAM(k) do { if (IN(k) && IN((k) + 1)) xcd_barrier(bar); } while (0)

    const float* x = args.in[0]; const float* mem = args.in[1];
    float* out = args.out;
    float* SS0 = (float*)(ws + WS_SS0); float* SSA = (float*)(ws + WS_SSA); float* SSB = (float*)(ws + WS_SSB); float* SSM = (float*)(ws + WS_SSM);
    unsigned char* S5TAB = ws + WS_S5TAB; float* S5E = (float*)(ws + WS_S5E); float* S5C = (float*)(ws + WS_S5TAB + (size_t)NGRP * S5_TAB_BYTES);
    float* KMP = (float*)(ws + WS_KMEAN);
    bf16* WIN0 = (bf16*)(ws + WS_WIN0); bf16* WGLU = (bf16*)(ws + WS_WGLU); bf16* WIN1 = (bf16*)(ws + WS_WIN1);
    bf16* WOUT0 = (bf16*)(ws + WS_WOUT0); bf16* WOUT1 = (bf16*)(ws + WS_WOUT1);
    bf16* WGU0 = (bf16*)(ws + WS_WGU0); bf16* WGU1 = (bf16*)(ws + WS_WGU1); bf16* WDN0 = (bf16*)(ws + WS_WDN0); bf16* WDN1 = (bf16*)(ws + WS_WDN1); bf16* WMKV = (bf16*)(ws + WS_WMKV);
    bf16* MEMB = (bf16*)(ws + WS_MEMB); bf16* MEMK = (bf16*)(ws + WS_MEMK); bf16* MEMV = (bf16*)(ws + WS_MEMV);
    bf16* XB = (bf16*)(ws + WS_XB); bf16* Ub = (bf16*)(ws + WS_U); bf16* Yb = (bf16*)(ws + WS_Y);
    bf16* Q1 = (bf16*)(ws + WS_Q1); bf16* K1 = (bf16*)(ws + WS_K1); bf16* V1 = (bf16*)(ws + WS_V1);
    bf16* QM = (bf16*)(ws + WS_QM); bf16* MIX = (bf16*)(ws + WS_MIX); bf16* Hb = (bf16*)(ws + WS_H);

    if (IN(0)) PH_REP(0) {
        if (rep_) xcd_barrier(bar);
        LAS float* scr = (LAS float*)(L + RING_OFF + wave * 16384);
        constexpr int I_SQ = 16 * 32, I_GLU = 12 * 24, I_IN1 = 16 * 80, I_GU = 16 * 88, I_DN = 44 * 32, I_MKV = 16 * 16;
        constexpr int I_TKT = NGRP * 8, I_TST = NGRP * 4, I_TYC = NGRP * 8, I_TCO = NGRP;
        constexpr int NITEMS = I_TKT + I_TST + I_TYC + I_TCO + I_SQ + I_GLU + I_IN1 + 2 * I_SQ + 4 * I_GU + 2 * I_DN + I_MKV;
        const float* mixg = args.in[4]; const float* ffng = args.in[18];
        for (int it = gw; it < NITEMS; it += NGW) P0_ITEM(it);
        for (int m = 4 * gw; m < TOK; m += 4 * NGW) rows_to_bf16_ssq<4>(x + (size_t)m * DM, XB + (size_t)m * DM, SS0 + (size_t)m * 16, lane);
        for (int m = gw; m < BATCH * MEML; m += NGW) rows_to_bf16_ssq<1>(mem + (size_t)m * DM, MEMB + (size_t)m * DM, SSM + (size_t)m * 16, lane);
#if PROBE_P0 == 1
        for (int it = gw; it < I_TKT + I_TST + I_TYC + I_TCO; it += NGW) P0_ITEM(it);
#elif PROBE_P0 == 2
        for (int it = I_TKT + I_TST + I_TYC + I_TCO + gw; it < NITEMS; it += NGW) P0_ITEM(it);
#elif PROBE_P0 == 3
        for (int m = 4 * gw; m < TOK; m += 4 * NGW) rows_to_bf16_ssq<4>(x + (size_t)m * DM, XB + (size_t)m * DM, SS0 + (size_t)m * 16, lane);
        for (int m = gw; m < BATCH * MEML; m += NGW) rows_to_bf16_ssq<1>(mem + (size_t)m * DM, MEMB + (size_t)m * DM, SSM + (size_t)m * 16, lane);
#endif
    }
    SEAM(0);
    if (IN(1)) PH_REP(1) {
        if (rep_) xcd_barrier(bar);
        { pg8::Gemm g{XB, WIN0, TOK, 1024, 1024, 0}; pg8::StaticOrder S; S.init(TOK, 1024, G, bx);
          pg8::EpiProj E{SS0, Ub, 0, 3, 1, TOKW, 1.0f, QM, C2, TOK, nullptr, -1};
          pg8::gemm_phase<pg8::EpiProj, pg8::StaticOrder, true, true>(L + RING_OFF, g, S, E); }
    }
    SEAM(1);
    if (IN(2)) PH_REP(2) {
        if (rep_) xcd_barrier(bar);
        const int nS5 = (G == 256) ? 240 : G;
        if (bx < nS5) { for (int un = bx; un < NGRP * 16; un += nS5) s5_unit<false>(un >> 4, un & 15, Ub, Yb, S5TAB + (size_t)(un >> 4) * S5_TAB_BYTES, S5E, S5C, L + RING_OFF); }
        if (G != 256 || bx >= nS5) { pg8::Gemm g{MEMB, WMKV, BATCH * MEML, 512, 1024, 0}; pg8::StaticOrder S; S.init(BATCH * MEML, 512, (G == 256) ? 16 : G, (G == 256) ? bx - nS5 : bx);
          pg8::EpiProj E{SSM, MEMK, (size_t)(WS_MEMV - WS_MEMK) / 2, 1, 2, 256, 1.0f, nullptr, 1.0f, 0, nullptr, -1};
          pg8::gemm_phase<pg8::EpiProj, pg8::StaticOrder, true, true>(L + RING_OFF, g, S, E); }
    }
    SEAM(2);
    if (IN(3)) PH_REP(3) {
        if (rep_) xcd_barrier(bar);
        for (int un = vcu; un < NGRP * 16; un += G) s5_unit<true>(un >> 4, un & 15, Ub, Yb, S5TAB + (size_t)(un >> 4) * S5_TAB_BYTES, S5E, S5C, L + RING_OFF);
    }
    SEAM(3);
    if (IN(4)) PH_REP(4) {
        if (rep_) xcd_barrier(bar);
        pg8::Gemm g{Yb, WGLU, TOK, TOKW, TOKW, 1}; pg8::StaticOrder S; S.init(TOK, TOKW, G, bx);
        pg8::EpiGlu E{Yb, TOKW, args.in[15], MIX, 1024, TOK};
        pg8::gemm_phase<pg8::EpiGlu, pg8::StaticOrder, true, true>(L + RING_OFF, g, S, E);
        if (G == 256) { if (bx >= 128) MEMATTN_PHASE(bx - 128, 128); }
        else MEMATTN_PHASE(vcu, G);
    }
    SEAM(4);
    if (IN(5)) PH_REP(5) {
        if (rep_) xcd_barrier(bar);
        pg8::Gemm g{MIX, WOUT0, TOK, 1024, 1024, 0}; pg8::StaticOrder S; S.init(TOK, 1024, G, bx);
        pg8::EpiRes E{x, out, XB, SSA};
        pg8::gemm_phase<pg8::EpiRes, pg8::StaticOrder, true, true>(L + RING_OFF, g, S, E);
    }
    SEAM(5);
    if (IN(6)) PH_REP(6) {
        if (rep_) xcd_barrier(bar);
        pg8::Gemm g{XB, WGU0, TOK, 2 * FFN, 1024, 0}; pg8::StaticOrder S; S.init(TOK, 2 * FFN, G, bx);
        pg8::EpiGU E{SSA, Hb, FFN};
        pg8::gemm_phase<pg8::EpiGU, pg8::StaticOrder, true, true>(L + RING_OFF, g, S, E);
    }
    SEAM(6);
    if (IN(7)) PH_REP(7) {
        if (rep_) xcd_barrier(bar);
        pg8::Gemm g{Hb, WDN0, TOK, 1024, FFN, 0}; pg8::StaticOrder S; S.init(TOK, 1024, G, bx);
        pg8::EpiRes E{out, out, XB, SSB};
        pg8::gemm_phase<pg8::EpiRes, pg8::StaticOrder, true, true>(L + RING_OFF, g, S, E);
    }
    SEAM(7);
    if (IN(8)) PH_REP(8) {
        if (rep_) xcd_barrier(bar);
        pg8::Gemm g{XB, WIN1, TOK, 2560, 1024, 0}; pg8::StaticOrder S; S.init(TOK, 2560, G, bx);
        pg8::EpiProj E{SSB, Q1, (size_t)(WS_K1 - WS_Q1) / 2, 3, 3, TOKW, C2, QM, C2, 0, KMP, 1};
        pg8::gemm_phase<pg8::EpiProj, pg8::StaticOrder, true, true>(L + RING_OFF, g, S, E);
    }
    SEAM(8);
    if (IN(9)) PH_REP(9) {
        if (rep_) xcd_barrier(bar);
        for (int p_ = vcu; p_ < BATCH * NHEAD * 8; p_ += G) { const int bh_ = p_ >> 3, sg_ = p_ & 7, b_ = bh_ / NHEAD, h_ = bh_ - b_ * NHEAD;
            const float slope2 = __builtin_amdgcn_exp2f(-8.0f * (float)(h_ + 1) / 12.0f) * LOG2E;
#pragma unroll 1
            for (int k_ = 0; k_ < 2; ++k_) { const int qb_ = k_ ? 15 - sg_ : sg_; const size_t qrow_ = (size_t)b_ * SEQ + (size_t)qb_ * 256, krow_ = (size_t)b_ * SEQ;
                attn_body::attn_unit<1, 8, 768, 768, 1024>((const attn_body::bf16*)(Q1 + qrow_ * TOKW + h_ * 64), (const attn_body::bf16*)(K1 + krow_ * TOKW + h_ * 64), (const attn_body::bf16*)(V1 + krow_ * TOKW + h_ * 64),
                    (attn_body::bf16*)(MIX + qrow_ * 1024 + h_ * 64), 4 * qb_ + 4, slope2, KMP + (size_t)bh_ * 1024, KMP + (size_t)(8 * 12 * 16 * 64) + (size_t)bh_ * 1024, qb_, (char*)lds + RING_OFF); } }
        MEMATTN_PHASE(vcu, G);
    }
    SEAM(9);
    if (IN(10)) PH_REP(10) {
        if (rep_) xcd_barrier(bar);
        pg8::Gemm g{MIX, WOUT1, TOK, 1024, 1024, 0}; pg8::StaticOrder S; S.init(TOK, 1024, G, bx);
        pg8::EpiRes E{out, out, XB, SSA};
        pg8::gemm_phase<pg8::EpiRes, pg8::StaticOrder, true, true>(L + RING_OFF, g, S, E);
    }
    SEAM(10);
    if (IN(11)) PH_REP(11) {
        if (rep_) xcd_barrier(bar);
        pg8::Gemm g{XB, WGU1, TOK, 2 * FFN, 1024, 0}; pg8::StaticOrder S; S.init(TOK, 2 * FFN, G, bx);
        pg8::EpiGU E{SSA, Hb, FFN};
        pg8::gemm_phase<pg8::EpiGU, pg8::StaticOrder, true, true>(L + RING_OFF, g, S, E);
    }
    SEAM(11);
    if (IN(12)) PH_REP(12) {
        if (rep_) xcd_barrier(bar);
        pg8::Gemm g{Hb, WDN1, TOK, 1024, FFN, 0}; pg8::StaticOrder S; S.init(TOK, 1024, G, bx);
        pg8::EpiRes E{out, out, XB, SSB};
        pg8::gemm_phase<pg8::EpiRes, pg8::StaticOrder, true, true>(L + RING_OFF, g, S, E);
    }
    SEAM(12);
    if (IN(13)) PH_REP(13) {
        if (rep_) xcd_barrier(bar);
        const float* gf = args.in[22];
        for (int m = gw; m < TOK; m += NGW) {
            const float rs = pg8::row_rstd(SSB, m);
            GAS f32x4* xr = (GAS f32x4*)(out + (size_t)m * DM) + lane; const GAS f32x4* gp = (const GAS f32x4*)gf + lane;
#pragma unroll
            for (int j = 0; j < 4; ++j) { const f32x4 v = xr[64 * j], gg = gp[64 * j]; xr[64 * j] = v * rs * gg; }
        }
    }
#undef IN
#undef SEAM
}

extern "C" void kernel_launch(void* const* d_in, const int* in_sizes, int n_in, void* d_out, int out_size, void* d_ws, size_t ws_size, hipStream_t stream) {
    static int grid = 0;
    if (grid == 0) {
        if (n_in != 23 || out_size != TOK * DM || ws_size < WS_END) { fprintf(stderr, "kernel_launch: unexpected shapes: n_in %d out %d ws %zu\n", n_in, out_size, ws_size); grid = -1; return; }
        int dev = 0, cus = 0, per_cu = 0;
        if (hipGetDevice(&dev) != hipSuccess || hipDeviceGetAttribute(&cus, hipDeviceAttributeMultiprocessorCount, dev) != hipSuccess) { grid = -1; return; }
        if (hipFuncSetAttribute((const void*)mega_fwd, hipFuncAttributeMaxDynamicSharedMemorySize, LDS_BYTES) != hipSuccess) { fprintf(stderr, "kernel_launch: hipFuncSetAttribute failed\n"); grid = -1; return; }
        if (hipOccupancyMaxActiveBlocksPerMultiprocessor(&per_cu, (const void*)mega_fwd, NWAVES * 64, LDS_BYTES) != hipSuccess || per_cu < 1)
            fprintf(stderr, "kernel_launch: occupancy query reports %d workgroups per CU\n", per_cu);
        (void)hipGetLastError();
        grid = cus;
    }
    if (grid < 0) return;
    if (hipMemsetAsync((char*)d_ws + WS_CTL, 0, CTL_ZERO_BYTES, stream) != hipSuccess) return;
    Args a{};
    for (int i = 0; i < 23; ++i) a.in[i] = (const float*)d_in[i];
    a.out = (float*)d_out; a.ws = (unsigned char*)d_ws;
#if MK_ONE_LAUNCH
    a.ph_lo = 0; a.ph_hi = N_PHASES;
    hipLaunchKernelGGL(mega_fwd, dim3(grid), dim3(NWAVES * 64), LDS_BYTES, stream, a);
#else
    for (int p = 0; p < N_PHASES; ++p) { a.ph_lo = p; a.ph_hi = p + 1; hipLaunchKernelGGL(mega_fwd, dim3(grid), dim3(NWAVES * 64), LDS_BYTES, stream, a); }
#endif
}
```

```cpp
#include <hip/hip_runtime.h>
#include <hip/hip_bf16.h>
#include <cstdio>
#include <cstdint>
#include <cmath>
namespace pg8 {
#define PG8_LAS __attribute__((address_space(3)))
typedef unsigned short bf16_t;
typedef short bf16x8 __attribute__((ext_vector_type(8)));
typedef float f32x4 __attribute__((ext_vector_type(4)));
typedef unsigned u32x4 __attribute__((ext_vector_type(4)));
constexpr int BM = 256, BK = 64, HALF = 128, HTB = HALF * BK * 2  , STAGE_BYTES = 8 * HTB, NXCD = 8, WGM = 8;

__host__ __device__ __forceinline__ int lds_byte(int r, int c) { const int st = (r >> 4) * 2 + (c >> 5), rr = r & 15, cc = c & 31, ob = rr * 64 + cc * 2; return st * 1024 + (ob ^ (((ob >> 9) & 1) << 5)); }
__host__ __device__ __forceinline__ void stage_rc(int b, int& R, int& C) { const int st = b / 1024, sb = b % 1024, swz = sb ^ (((sb >> 9) & 1) << 5); R = (st >> 1) * 16 + swz / 64; C = (st & 1) * 32 + (swz % 64) / 2; }
__host__ __device__ __forceinline__ int perm32(int rho) { const int n = rho >> 4, i = rho & 15; return 8 * (i >> 2) + 4 * n + (i & 3); }

struct Unit { int pm, pn; };
struct Gemm { const bf16_t* A; const bf16_t* Bt; int M, N, K, amode; };

struct StaticOrder {
    int nM, nN, nwg, G, c;
    __host__ __device__ void init(int M, int N, int G_, int c_) { nM = M / BM; nN = N / BM; nwg = nM * nN; G = G_; c = c_; }
    __host__ __device__ bool next(int i, Unit& u) const {
        const long L = (long)i * G + c; if (L >= nwg) return false;
        int wgid = (int)L; { const int q = nwg / NXCD, r = nwg % NXCD, xcd = wgid % NXCD, off = wgid / NXCD; wgid = (xcd < r ? xcd * (q + 1) : r * (q + 1) + (xcd - r) * q) + off; }
        const int nig = WGM * nN, gid = wgid / nig, fm = gid * WGM, gsz = (nM - fm) < WGM ? (nM - fm) : WGM;
        u.pm = fm + ((wgid % nig) % gsz); u.pn = (wgid % nig) / gsz; return true;
    }
    __device__ __forceinline__ void a_ready(const Unit&) const {}
    __device__ __forceinline__ void done(const Unit&) const {}
};

__device__ __forceinline__ unsigned cvt_pk_bf16(float lo, float hi) { unsigned r; asm volatile("v_cvt_pk_bf16_f32 %0, %1, %2" : "=v"(r) : "v"(lo), "v"(hi)); return r; }
typedef float f32x2 __attribute__((ext_vector_type(2)));
typedef unsigned u32x2 __attribute__((ext_vector_type(2)));
constexpr float RMS_EPS = 1e-6f;
__device__ __forceinline__ float row_rstd(const float* ssq, int row) {
    const f32x4* p = (const f32x4*)(ssq + (size_t)row * 16);
    const f32x4 a = p[0], b = p[1], c = p[2], d = p[3];
    const float s = (((a[0] + a[1]) + (a[2] + a[3])) + ((b[0] + b[1]) + (b[2] + b[3]))) + (((c[0] + c[1]) + (c[2] + c[3])) + ((d[0] + d[1]) + (d[2] + d[3])));
    return __builtin_amdgcn_rsqf(s * (1.0f / 1024.0f) + RMS_EPS);
}
__device__ __forceinline__ float bf2f(unsigned short h) { return __uint_as_float(((unsigned)h) << 16); }
__device__ __forceinline__ float bflo(unsigned w) { return __uint_as_float(w << 16); }
__device__ __forceinline__ float bfhi(unsigned w) { return __uint_as_float(w & 0xffff0000u); }

__device__ __forceinline__ f32x2 gelu_pk(f32x2 v) {
    const f32x2 av = __builtin_elementwise_abs(v), d = av * 0.2316418882f + 1.0f;
    f32x2 t; t.x = __builtin_amdgcn_rcpf(d.x); t.y = __builtin_amdgcn_rcpf(d.y);
    f32x2 q = t * 0.5307027145f + (-0.7265760135f); q = q * t + 0.7107068705f; q = q * t + (-0.142248368f); q = q * t + 0.127414796f; q = q * t;
    const f32x2 s = (v * v) * (-0.72134752044f);
    f32x2 e; e.x = __builtin_amdgcn_exp2f(s.x); e.y = __builtin_amdgcn_exp2f(s.y);
    const f32x2 m = v * (q * e), r = v - m;
    f32x2 o; o.x = v.x < 0.f ? m.x : r.x; o.y = v.y < 0.f ? m.y : r.y; return o;
}

__device__ __forceinline__ void row_rstd4x8(const float* ssq, int row0, int fq, float sc, float (&rs)[2][4]) {
    f32x4 a[2][4];
#pragma unroll
    for (int ai = 0; ai < 2; ++ai)
#pragma unroll
        for (int m = 0; m < 4; ++m) a[ai][m] = *(const __attribute__((address_space(1))) f32x4*)(ssq + (size_t)(row0 + ai * HALF + m * 16) * 16 + 4 * fq);
#pragma unroll
    for (int ai = 0; ai < 2; ++ai)
#pragma unroll
        for (int m = 0; m < 4; ++m) { float s = (a[ai][m][0] + a[ai][m][1]) + (a[ai][m][2] + a[ai][m][3]); s += __shfl_xor(s, 16); s += __shfl_xor(s, 32);
            rs[ai][m] = __builtin_amdgcn_rsqf(s * (1.0f / 1024.0f) + RMS_EPS) * sc; }
}
struct EpiProj {
    static constexpr bool PERM = true, AFTER_DRAIN = false;
    const float* ssq; bf16_t* base; size_t seg_stride; int tps, nseg, ldc; float scale0; bf16_t* qm; float scale_qm; int gm_rows;
    float* kmp; int kseg;
    __device__ __forceinline__ void operator()(const f32x4 (&acc)[2][2][4][2], const Unit& u, int wr, int wc, int fr, int fq) const {
        const int seg = u.pn / tps, within = u.pn - seg * tps;
        bf16_t* o; int ld, colt; float sc;
        if (seg < nseg) { o = base + (size_t)seg * seg_stride; ld = ldc; colt = within * BM; sc = (seg == 0) ? scale0 : 1.0f; }
        else { o = qm; ld = 256; colt = 0; sc = scale_qm; }
        const int row0 = u.pm * BM + wr * 64 + fr, col0 = colt + wc * 32 + 8 * fq;
        f32x4 cs[2][2] = {{{0.f, 0.f, 0.f, 0.f}, {0.f, 0.f, 0.f, 0.f}}, {{0.f, 0.f, 0.f, 0.f}, {0.f, 0.f, 0.f, 0.f}}};
        float rsv[2][4]; row_rstd4x8(ssq, row0, fq, sc, rsv);
#pragma unroll
        for (int ai = 0; ai < 2; ++ai)
#pragma unroll
            for (int m = 0; m < 4; ++m) { const int row = row0 + ai * HALF + m * 16; const float rs = rsv[ai][m]; bf16_t* rowp = o + (size_t)row * ld + col0;
                const bool gm = (gm_rows != 0) && (seg < nseg);
#pragma unroll
                for (int bj = 0; bj < 2; ++bj) { const f32x4 v0 = acc[ai][bj][m][0] * rs, v1 = acc[ai][bj][m][1] * rs;
                    u32x4 w; w.x = cvt_pk_bf16(v0[0], v0[1]); w.y = cvt_pk_bf16(v0[2], v0[3]); w.z = cvt_pk_bf16(v1[0], v1[1]); w.w = cvt_pk_bf16(v1[2], v1[3]);
                    const int cc = col0 + bj * HALF;
                    bf16_t* dst = gm ? (o + ((size_t)(cc >> 4) * gm_rows + row) * 16 + (cc & 15)) : (rowp + bj * HALF);
                    *(u32x4*)dst = w; cs[bj][0] += v0; cs[bj][1] += v1; } }
        if (seg == kseg) {
#pragma unroll
            for (int bj = 0; bj < 2; ++bj)
#pragma unroll
                for (int n = 0; n < 2; ++n)
#pragma unroll
                    for (int e = 0; e < 4; ++e) { float s = cs[bj][n][e]; s += __shfl_xor(s, 1); s += __shfl_xor(s, 2); s += __shfl_xor(s, 4); s += __shfl_xor(s, 8); cs[bj][n][e] = s; }
            if (fr == 0) { const int bb = u.pm >> 4, blk = u.pm & 15;
#pragma unroll
                for (int bj = 0; bj < 2; ++bj) { const int cc = col0 + bj * HALF, h = cc >> 6, d = cc & 63;
                    float* kd = kmp + (size_t)wr * (8 * 12 * 16 * 64) + ((size_t)((bb * 12 + h) * 16 + blk)) * 64 + d;
                    *(__attribute__((address_space(1))) f32x4*)kd = cs[bj][0]; *(__attribute__((address_space(1))) f32x4*)(kd + 4) = cs[bj][1]; } }
        }
    }
};
struct EpiGlu {
    static constexpr bool PERM = true, AFTER_DRAIN = false;
    const bf16_t* Y; int ldy; const float* bias; bf16_t* mix; int ldm; int ygm_rows;
    __device__ __forceinline__ void operator()(const f32x4 (&acc)[2][2][4][2], const Unit& u, int wr, int wc, int fr, int fq) const {
        const int row0 = u.pm * BM + wr * 64 + fr, col0 = u.pn * BM + wc * 32 + 8 * fq;
        f32x4 bv[2][2];
#pragma unroll
        for (int bj = 0; bj < 2; ++bj)
#pragma unroll
            for (int n = 0; n < 2; ++n) bv[bj][n] = *(const f32x4*)(bias + col0 + bj * HALF + 4 * n);
#pragma unroll
        for (int ai = 0; ai < 2; ++ai) {
            u32x4 yq[4][2];
#pragma unroll
            for (int m = 0; m < 4; ++m) { const int row = row0 + ai * HALF + m * 16;
#pragma unroll
                for (int bj = 0; bj < 2; ++bj) { const int cc = col0 + bj * HALF;
                    yq[m][bj] = ygm_rows ? *(const __attribute__((address_space(1))) u32x4*)(Y + ((size_t)(cc >> 4) * ygm_rows + row) * 16 + (cc & 15)) : *(const __attribute__((address_space(1))) u32x4*)(Y + (size_t)row * ldy + cc); } }
#pragma unroll
            for (int m = 0; m < 4; ++m) { const int row = row0 + ai * HALF + m * 16;
#pragma unroll
                for (int bj = 0; bj < 2; ++bj) { const u32x4 yw = yq[m][bj];
                    const f32x4 z0 = acc[ai][bj][m][0] + bv[bj][0], z1 = acc[ai][bj][m][1] + bv[bj][1];
                    float t[8]; const float yv[8] = {bflo(yw.x), bfhi(yw.x), bflo(yw.y), bfhi(yw.y), bflo(yw.z), bfhi(yw.z), bflo(yw.w), bfhi(yw.w)};
#pragma unroll
                    for (int e = 0; e < 4; ++e) { t[e] = yv[e] * __builtin_amdgcn_rcpf(1.0f + __builtin_amdgcn_exp2f(-1.4426950408889634f * z0[e])); t[4 + e] = yv[4 + e] * __builtin_amdgcn_rcpf(1.0f + __builtin_amdgcn_exp2f(-1.4426950408889634f * z1[e])); }
                    u32x4 w; w.x = cvt_pk_bf16(t[0], t[1]); w.y = cvt_pk_bf16(t[2], t[3]); w.z = cvt_pk_bf16(t[4], t[5]); w.w = cvt_pk_bf16(t[6], t[7]);
                    *(u32x4*)(mix + (size_t)row * ldm + col0 + bj * HALF) = w; } } }
    }
};
struct EpiRes {
    static constexpr bool PERM = true, AFTER_DRAIN = false;
    const float* basef; const bf16_t* baseb; bf16_t* xb; float* ssq_out;
    __device__ __forceinline__ void operator()(const f32x4 (&acc)[2][2][4][2], const Unit& u, int wr, int wc, int fr, int fq) const {
        const int row0 = u.pm * BM + wr * 64 + fr, col0 = u.pn * BM + wc * 32 + 8 * fq;
        typedef __attribute__((address_space(1))) const f32x4 gf4; typedef __attribute__((address_space(1))) const u32x4 gu4;
        if (basef) {
            f32x4 bn[2][2];
#pragma unroll
            for (int bj = 0; bj < 2; ++bj)
#pragma unroll
                for (int n = 0; n < 2; ++n) bn[bj][n] = *(gf4*)(basef + (size_t)row0 * 1024 + col0 + bj * HALF + n * 4);
#pragma unroll
            for (int idx = 0; idx < 8; ++idx) { const int ai = idx >> 2, m = idx & 3; const int row = row0 + ai * HALF + m * 16; const size_t off = (size_t)row * 1024 + col0; float ss = 0.f;
                f32x4 bc[2][2];
#pragma unroll
                for (int bj = 0; bj < 2; ++bj)
#pragma unroll
                    for (int n = 0; n < 2; ++n) bc[bj][n] = bn[bj][n];
                if (idx + 1 < 8) { const int row2 = row0 + ((idx + 1) >> 2) * HALF + ((idx + 1) & 3) * 16;
#pragma unroll
                    for (int bj = 0; bj < 2; ++bj)
#pragma unroll
                        for (int n = 0; n < 2; ++n) bn[bj][n] = *(gf4*)(basef + (size_t)row2 * 1024 + col0 + bj * HALF + n * 4); }
#pragma unroll
                for (int bj = 0; bj < 2; ++bj) { const f32x4 o0 = bc[bj][0] + acc[ai][bj][m][0], o1 = bc[bj][1] + acc[ai][bj][m][1];
                    u32x4 w; w.x = cvt_pk_bf16(o0[0], o0[1]); w.y = cvt_pk_bf16(o0[2], o0[3]); w.z = cvt_pk_bf16(o1[0], o1[1]); w.w = cvt_pk_bf16(o1[2], o1[3]);
                    *(u32x4*)(xb + off + bj * HALF) = w;
                    ss += ((o0[0] * o0[0] + o0[1] * o0[1]) + (o0[2] * o0[2] + o0[3] * o0[3])) + ((o1[0] * o1[0] + o1[1] * o1[1]) + (o1[2] * o1[2] + o1[3] * o1[3])); }
                ss += __shfl_xor(ss, 16); ss += __shfl_xor(ss, 32);
                if (fq == 0) ssq_out[(size_t)row * 16 + u.pn * 4 + wc] = ss; }
        } else {
            u32x4 bq[2][4][2];
#pragma unroll
            for (int ai = 0; ai < 2; ++ai)
#pragma unroll
                for (int m = 0; m < 4; ++m)
#pragma unroll
                    for (int bj = 0; bj < 2; ++bj) bq[ai][m][bj] = *(gu4*)(baseb + (size_t)(row0 + ai * HALF + m * 16) * 1024 + col0 + bj * HALF);
#pragma unroll
            for (int ai = 0; ai < 2; ++ai)
#pragma unroll
                for (int m = 0; m < 4; ++m) { const int row = row0 + ai * HALF + m * 16; const size_t off = (size_t)row * 1024 + col0; float ss = 0.f;
#pragma unroll
                    for (int bj = 0; bj < 2; ++bj) { const u32x4 q = bq[ai][m][bj];
                        const f32x4 b0 = (f32x4){bflo(q.x), bfhi(q.x), bflo(q.y), bfhi(q.y)}, b1 = (f32x4){bflo(q.z), bfhi(q.z), bflo(q.w), bfhi(q.w)};
                        const f32x4 o0 = b0 + acc[ai][bj][m][0], o1 = b1 + acc[ai][bj][m][1];
                        u32x4 w; w.x = cvt_pk_bf16(o0[0], o0[1]); w.y = cvt_pk_bf16(o0[2], o0[3]); w.z = cvt_pk_bf16(o1[0], o1[1]); w.w = cvt_pk_bf16(o1[2], o1[3]);
                        *(u32x4*)(xb + off + bj * HALF) = w;
                        ss += ((o0[0] * o0[0] + o0[1] * o0[1]) + (o0[2] * o0[2] + o0[3] * o0[3])) + ((o1[0] * o1[0] + o1[1] * o1[1]) + (o1[2] * o1[2] + o1[3] * o1[3])); }
                    ss += __shfl_xor(ss, 16); ss += __shfl_xor(ss, 32);
                    if (fq == 0) ssq_out[(size_t)row * 16 + u.pn * 4 + wc] = ss; }
        }
    }
};
struct EpiGU {
    static constexpr bool PERM = true, AFTER_DRAIN = false;
    const float* ssq; bf16_t* H; int ldh;
    __device__ __forceinline__ void operator()(const f32x4 (&acc)[2][2][4][2], const Unit& u, int wr, int wc, int fr, int fq) const {
        const int row0 = u.pm * BM + wr * 64 + fr, col0 = u.pn * HALF + wc * 32 + 8 * fq;
        float rsv[2][4]; row_rstd4x8(ssq, row0, fq, 1.0f, rsv);
#pragma unroll
        for (int ai = 0; ai < 2; ++ai)
#pragma unroll
            for (int m = 0; m < 4; ++m) { const int row = row0 + ai * HALF + m * 16; const float rs = rsv[ai][m];
                float t[8];
#pragma unroll
                for (int n = 0; n < 2; ++n)
#pragma unroll
                    for (int e = 0; e < 4; ++e) { const float g = acc[ai][0][m][n][e] * rs, up = acc[ai][1][m][n][e] * rs;
                        t[4 * n + e] = g * __builtin_amdgcn_rcpf(1.0f + __builtin_amdgcn_exp2f(-1.4426950408889634f * g)) * up; }
                u32x4 w; w.x = cvt_pk_bf16(t[0], t[1]); w.y = cvt_pk_bf16(t[2], t[3]); w.z = cvt_pk_bf16(t[4], t[5]); w.w = cvt_pk_bf16(t[6], t[7]);
                *(u32x4*)(H + (size_t)row * ldh + col0) = w; }
    }
};

template <class Epi, class Sched, bool ALIGN_EPI = false, bool SP2 = false>
__device__ __forceinline__ void gemm_phase(PG8_LAS unsigned char* lds, const Gemm g, const Sched& S, const Epi& E) {
    const int tid = threadIdx.x, wid = __builtin_amdgcn_readfirstlane(tid >> 6), lane = tid & 63, wr = wid >> 2, wc = wid & 3, fr = lane & 15, fq = lane >> 4;
    const int K = g.K, nt = K / BK;
    unsigned voffA[2], voffB[2];
#pragma unroll
    for (int i = 0; i < 2; ++i) { int R, C; stage_rc(tid * 16 + i * 8192, R, C); const int Rb = Epi::PERM ? ((R & ~31) + perm32(R & 31)) : R;
        voffA[i] = g.amode ? (unsigned)((C >> 4) * g.M * 32 + R * 32 + (C & 15) * 2) : (unsigned)(R * K + C) * 2u; voffB[i] = (unsigned)(Rb * K + C) * 2u; }
    const size_t kstep = (size_t)(BK * 2);
    const size_t hstep = (size_t)HALF * K * 2;
    const size_t tstep = 2 * hstep;
    const size_t kstepA = g.amode ? (size_t)4 * g.M * 32 : kstep, hstepA = g.amode ? (size_t)HALF * 32 : hstep, tstepA = 2 * hstepA;
    const unsigned ldsw = (unsigned)wid * 1024u;
    const int aoff = lds_byte(wr * 64 + fr, fq * 8), boff = lds_byte(wc * 32 + fr, fq * 8);
#define PG8_SA(b, h) (((b) * 2 + (h)) * HTB)
#define PG8_SB(b, h) ((4 + (b) * 2 + (h)) * HTB)
#define PG8_STAGE(bufoff, gbase, voff) do { _Pragma("unroll") for (int _i = 0; _i < 2; ++_i) \
        __builtin_amdgcn_global_load_lds((const unsigned*)((const char*)(gbase) + (voff)[_i]), (PG8_LAS unsigned*)(lds + (bufoff) + ldsw + _i * 8192), 16, 0, 0); } while (0)
#define PG8_LDA(dst, b, h) do { _Pragma("unroll") for (int m = 0; m < 4; ++m) _Pragma("unroll") for (int k = 0; k < 2; ++k) dst[m][k] = *(const PG8_LAS bf16x8*)(lds + PG8_SA(b, h) + aoff + m * 2048 + k * 1024); } while (0)
#define PG8_LDB(dst, b, h) do { _Pragma("unroll") for (int n = 0; n < 2; ++n) _Pragma("unroll") for (int k = 0; k < 2; ++k) dst[n][k] = *(const PG8_LAS bf16x8*)(lds + PG8_SB(b, h) + boff + n * 2048 + k * 1024); } while (0)
#define PG8_MMA(ai, bj, At, Bt) do { __builtin_amdgcn_s_setprio(1); _Pragma("unroll") for (int m = 0; m < 4; ++m) _Pragma("unroll") for (int n = 0; n < 2; ++n) _Pragma("unroll") for (int k = 0; k < 2; ++k) \
        acc[ai][bj][m][n] = __builtin_amdgcn_mfma_f32_16x16x32_bf16(Bt[n][k], At[m][k], acc[ai][bj][m][n], 0, 0, 0); __builtin_amdgcn_s_setprio(0); } while (0)
#define PG8_WAIT_V(n) asm volatile("s_waitcnt vmcnt(" #n ")" ::: "memory")
#define PG8_WAIT_L(n) asm volatile("s_waitcnt lgkmcnt(" #n ")" ::: "memory")
#define PG8_BAR __builtin_amdgcn_s_barrier()
#define PG8_SCHED __builtin_amdgcn_sched_barrier(0)
    Unit cur, nxt; int ui = 0;
    if (!S.next(0, cur)) return;
    f32x4 acc[2][2][4][2];
#pragma unroll
    for (int a = 0; a < 2; ++a)
#pragma unroll
        for (int b = 0; b < 2; ++b)
#pragma unroll
            for (int m = 0; m < 4; ++m)
#pragma unroll
                for (int n = 0; n < 2; ++n) acc[a][b][m][n] = (f32x4){0.f, 0.f, 0.f, 0.f};
    bf16x8 At[4][2], B0[2][2], B1[2][2];
    const char* cA = (const char*)g.A + (size_t)cur.pm * tstepA; const char* cB = (const char*)g.Bt + (size_t)cur.pn * tstep;
    S.a_ready(cur);
    if constexpr (SP2) {
        PG8_STAGE(PG8_SB(0, 0), cB, voffB); PG8_STAGE(PG8_SB(0, 1), cB + hstep, voffB); PG8_STAGE(PG8_SA(0, 0), cA, voffA); PG8_STAGE(PG8_SA(0, 1), cA + hstepA, voffA);
        if (wr == 1) PG8_BAR;
        PG8_WAIT_V(2); PG8_BAR;
        PG8_STAGE(PG8_SB(1, 0), cB + kstep, voffB); PG8_STAGE(PG8_SA(1, 0), cA + kstepA, voffA); PG8_STAGE(PG8_SB(1, 1), cB + hstep + kstep, voffB);
        PG8_WAIT_V(6); PG8_BAR;
    } else {
        PG8_STAGE(PG8_SB(0, 0), cB, voffB); PG8_STAGE(PG8_SA(0, 0), cA, voffA); PG8_STAGE(PG8_SB(0, 1), cB + hstep, voffB); PG8_STAGE(PG8_SA(0, 1), cA + hstepA, voffA);
        if (wr == 1) PG8_BAR;
        PG8_WAIT_V(4); PG8_BAR;
        PG8_STAGE(PG8_SB(1, 0), cB + kstep, voffB); PG8_STAGE(PG8_SA(1, 0), cA + kstepA, voffA); PG8_STAGE(PG8_SB(1, 1), cB + hstep + kstep, voffB);
        PG8_WAIT_V(6); PG8_BAR;
    }
    for (;;) {
        const bool has_next = S.next(ui + 1, nxt);
        const char* nA = has_next ? (const char*)g.A + (size_t)nxt.pm * tstepA : cA; const char* nB = has_next ? (const char*)g.Bt + (size_t)nxt.pn * tstep : cB;
        for (int t = 0; t < nt; t += 2) {
            const bool last = (t == nt - 2);
            const char* a1 = cA + (size_t)(t + 1) * kstepA;
            const char* a2 = last ? nA : cA + (size_t)(t + 2) * kstepA; const char* b2 = last ? nB : cB + (size_t)(t + 2) * kstep;
            const char* a3 = a2 + kstepA; const char* b3 = b2 + kstep;
            if (last && has_next) S.a_ready(nxt);
            if constexpr (SP2) {
            PG8_LDB(B0, 0, 0); PG8_LDB(B1, 0, 1); PG8_SCHED; PG8_LDA(At, 0, 0); PG8_STAGE(PG8_SA(1, 1), a1 + hstepA, voffA);
            PG8_WAIT_V(8); PG8_WAIT_L(0); PG8_BAR; PG8_MMA(0, 0, At, B0); PG8_MMA(0, 1, At, B1); PG8_BAR; PG8_SCHED;
            PG8_LDA(At, 0, 1); PG8_STAGE(PG8_SB(0, 0), b2, voffB); PG8_STAGE(PG8_SB(0, 1), b2 + hstep, voffB); PG8_STAGE(PG8_SA(0, 0), a2, voffA);
            PG8_WAIT_V(8); PG8_WAIT_L(0); PG8_BAR; PG8_MMA(1, 0, At, B0); PG8_MMA(1, 1, At, B1); PG8_BAR; PG8_SCHED;
            PG8_LDB(B0, 1, 0); PG8_LDB(B1, 1, 1); PG8_SCHED; PG8_LDA(At, 1, 0); PG8_STAGE(PG8_SA(0, 1), a2 + hstepA, voffA);
            PG8_WAIT_V(8); PG8_WAIT_L(0); PG8_BAR; PG8_MMA(0, 0, At, B0); PG8_MMA(0, 1, At, B1); PG8_BAR; PG8_SCHED;
            PG8_LDA(At, 1, 1); PG8_STAGE(PG8_SB(1, 0), b3, voffB); PG8_STAGE(PG8_SB(1, 1), b3 + hstep, voffB); PG8_STAGE(PG8_SA(1, 0), a3, voffA);
            PG8_WAIT_V(8); PG8_WAIT_L(0); PG8_BAR; PG8_MMA(1, 0, At, B0); PG8_MMA(1, 1, At, B1); PG8_BAR; PG8_SCHED;
            } else {
            PG8_LDB(B0, 0, 0); PG8_SCHED; PG8_LDA(At, 0, 0); PG8_STAGE(PG8_SA(1, 1), a1 + hstepA, voffA);
            PG8_WAIT_L(8); PG8_BAR; PG8_WAIT_L(0); PG8_MMA(0, 0, At, B0); PG8_BAR; PG8_SCHED;
            PG8_LDB(B1, 0, 1); PG8_STAGE(PG8_SB(0, 0), b2, voffB);
            PG8_BAR; PG8_WAIT_L(0); PG8_MMA(0, 1, At, B1); PG8_BAR;
            PG8_LDA(At, 0, 1); PG8_STAGE(PG8_SA(0, 0), a2, voffA);
            PG8_BAR; PG8_WAIT_L(0); PG8_MMA(1, 0, At, B0); PG8_BAR; PG8_SCHED;
            PG8_STAGE(PG8_SB(0, 1), b2 + hstep, voffB);
            PG8_WAIT_V(6); PG8_BAR; PG8_MMA(1, 1, At, B1); PG8_BAR;
            PG8_LDB(B0, 1, 0); PG8_SCHED; PG8_LDA(At, 1, 0); PG8_STAGE(PG8_SA(0, 1), a2 + hstepA, voffA);
            PG8_WAIT_L(8); PG8_BAR; PG8_WAIT_L(0); PG8_MMA(0, 0, At, B0); PG8_BAR; PG8_SCHED;
            PG8_LDB(B1, 1, 1); PG8_STAGE(PG8_SB(1, 0), b3, voffB);
            PG8_BAR; PG8_WAIT_L(0); PG8_MMA(0, 1, At, B1); PG8_BAR;
            PG8_LDA(At, 1, 1); PG8_STAGE(PG8_SA(1, 0), a3, voffA);
            PG8_BAR; PG8_WAIT_L(0); PG8_MMA(1, 0, At, B0); PG8_BAR; PG8_SCHED;
            PG8_STAGE(PG8_SB(1, 1), b3 + hstep, voffB);
            PG8_WAIT_V(6); PG8_BAR; PG8_MMA(1, 1, At, B1); PG8_BAR;
            }
        }
        if constexpr (ALIGN_EPI) { if (wr == 0) PG8_BAR; }
        if constexpr (!Epi::AFTER_DRAIN) { E(acc, cur, wr, wc, fr, fq); S.done(cur); }
        if (!has_next) break;
#pragma unroll
        for (int a = 0; a < 2; ++a)
#pragma unroll
            for (int b = 0; b < 2; ++b)
#pragma unroll
                for (int m = 0; m < 4; ++m)
#pragma unroll
                    for (int n = 0; n < 2; ++n) acc[a][b][m][n] = (f32x4){0.f, 0.f, 0.f, 0.f};
        cur = nxt; cA = nA; cB = nB; ++ui;
        if constexpr (ALIGN_EPI) { if (wr == 1) PG8_BAR; }
    }
    PG8_WAIT_V(0);
    if constexpr (!ALIGN_EPI) { if (wr == 0) PG8_BAR; }
    PG8_BAR;
    if constexpr (Epi::AFTER_DRAIN) { E.fused(acc, cur, wr, wc, fr, fq, lds, wid, lane); S.done(cur); }
#undef PG8_SA
#undef PG8_SB
#undef PG8_STAGE
#undef PG8_LDA
#undef PG8_LDB
#undef PG8_MMA
#undef PG8_WAIT_V
#undef PG8_WAIT_L
#undef PG8_BAR
#undef PG8_SCHED
}
}
constexpr int NWAVES = 8;
constexpr int BATCH = 8, SEQ = 4096, DM = 1024, TOK = BATCH * SEQ;
constexpr int TOKW = 768, MEMW = 256, MEML = 256, NGRP = 48, NST = 64, GCH = 16, NHEAD = 12, MHEAD = 4, HD = 64, FFN = 2816, NBLK = 16, MBLK = 256;
constexpr float C2 = 0.125f * 1.4426950408889634f;
constexpr float LOG2E = 1.4426950408889634f;

constexpr size_t MiB = 1u << 20;
constexpr size_t WS_CTL = 0, CTL_ZERO_BYTES = 1 * MiB;
constexpr size_t WS_S5TAB = 9 * MiB, WS_S5E = 13 * MiB;
constexpr size_t WS_SS0 = 1 * MiB, WS_SSA = 3 * MiB, WS_SSB = 5 * MiB, WS_SSM = 7 * MiB, WS_KMEAN = 8 * MiB;
constexpr size_t WS_WIN0 = 16 * MiB, WS_WGLU = 18 * MiB, WS_WIN1 = 20 * MiB, WS_WOUT0 = 26 * MiB, WS_WOUT1 = 28 * MiB;
constexpr size_t WS_WGU0 = 30 * MiB, WS_WGU1 = 41 * MiB, WS_WDN0 = 52 * MiB, WS_WDN1 = 58 * MiB, WS_WMKV = 64 * MiB;
constexpr size_t WS_MEMB = 65 * MiB, WS_MEMK = 69 * MiB, WS_MEMV = 70 * MiB;
constexpr size_t WS_XB = 72 * MiB;
constexpr size_t WS_R = 136 * MiB;
constexpr size_t WS_U = WS_R, WS_Y = WS_R + 48 * MiB;
constexpr size_t WS_Q1 = WS_R, WS_K1 = WS_R + 48 * MiB, WS_V1 = WS_R + 96 * MiB;
constexpr size_t WS_QM = WS_R + 144 * MiB;
constexpr size_t WS_MIX = WS_R + 160 * MiB;
constexpr size_t WS_H = WS_R;
constexpr size_t WS_END = WS_R + 224 * MiB;
constexpr int CW_BAR = 4096;

constexpr int RING_OFF = 0, RING_BYTES = 147456;
constexpr int LDSCTL_OFF = RING_BYTES, MISC_OFF = LDSCTL_OFF + 320;
constexpr int LDS_BYTES = RING_BYTES + 1024;

#define GAS __attribute__((address_space(1)))
#define LAS __attribute__((address_space(3)))
typedef unsigned short bf16;
typedef unsigned v4u __attribute__((ext_vector_type(4)));
typedef unsigned v2u __attribute__((ext_vector_type(2)));
typedef float f32x4 __attribute__((ext_vector_type(4)));
typedef GAS unsigned gu32;
typedef float f32x2 __attribute__((ext_vector_type(2)));
#define RLX_AGENT __ATOMIC_RELAXED, __HIP_MEMORY_SCOPE_AGENT
#define LDS_WAIT() asm volatile("s_waitcnt lgkmcnt(0)" ::: "memory")
#define VM_WAIT() asm volatile("s_waitcnt vmcnt(0)" ::: "memory")
__device__ __forceinline__ unsigned f2bf(float f) { unsigned u = __builtin_bit_cast(unsigned, f); return (u + 0x7fffu + ((u >> 16) & 1u)) >> 16; }
__device__ __forceinline__ unsigned pk2(float lo, float hi) { return f2bf(lo) | (f2bf(hi) << 16); }
__device__ __forceinline__ float bf2f(unsigned short h) { return __uint_as_float(((unsigned)h) << 16); }
__device__ __forceinline__ float bflo(unsigned w) { return __uint_as_float(w << 16); }
__device__ __forceinline__ float bfhi(unsigned w) { return __uint_as_float(w & 0xffff0000u); }

#define XB_TMO      128
#define XB_XCNT(j)  (256  + 64 * (j))
#define XB_XSUB(j)  (1280 + 64 * (j))
#define XB_XGEN(j)  (2304 + 64 * (j))
#define XB_TOP      3328
#define XB_TOPGEN   3392
#define XCD_BAR_WORDS 3456
#define XB_SPIN_CAP (1u << 18)

__device__ __forceinline__ unsigned xb_ld(unsigned* p)              { return __hip_atomic_load(p, __ATOMIC_RELAXED, __HIP_MEMORY_SCOPE_AGENT); }
__device__ __forceinline__ unsigned xb_add(unsigned* p, unsigned v) { return __hip_atomic_fetch_add(p, v, __ATOMIC_RELAXED, __HIP_MEMORY_SCOPE_AGENT); }
__device__ __forceinline__ unsigned xb_xcc_id() { return (unsigned)__builtin_amdgcn_s_getreg((3 << 11) | 20) & 0xFu; }
#define XB_SPIN(cond, bar) do { unsigned _sp = 0; while (cond) { __builtin_amdgcn_s_sleep(1); \
    if ((++_sp & 255u) == 0u) { if (xb_ld(&(bar)[XB_TMO])) break; if (_sp > XB_SPIN_CAP) { atomicAdd(&(bar)[XB_TMO], 1u); break; } } } } while (0)

struct XcdBarrier {
    unsigned* bar; unsigned x;
    volatile LAS unsigned* st;
};

__device__ __forceinline__ XcdBarrier xcd_barrier_post(unsigned* bar, volatile LAS unsigned* st) {
    XcdBarrier b; b.bar = bar; b.x = xb_xcc_id(); b.st = st;
    if (threadIdx.x == 0) (void)xb_add(&bar[XB_XCNT(b.x)], 1u);
    return b;
}
__device__ __forceinline__ void xcd_barrier_complete(unsigned* bar, unsigned x, unsigned& nloc, unsigned& nx) {
    const unsigned G = gridDim.x * gridDim.y * gridDim.z;
    unsigned sum, cnt, mine, sp = 0u;
    for (;;) {
        sum = 0u; cnt = 0u; mine = 0u;
#pragma unroll
        for (unsigned j = 0; j < 16; ++j) { const unsigned c = xb_ld(&bar[XB_XCNT(j)]); sum += c; cnt += (c > 0u) ? 1u : 0u; mine = (j == x) ? c : mine; }
        if (sum == G) break;
        __builtin_amdgcn_s_sleep(1);
        if ((++sp & 255u) == 0u) { if (xb_ld(&bar[XB_TMO])) break; if (sp > XB_SPIN_CAP) { atomicAdd(&bar[XB_TMO], 1u); break; } }
    }
    nloc = mine > 0u ? mine : 1u; nx = cnt > 0u ? cnt : 1u;
}

__device__ __forceinline__ void xcd_barrier(const XcdBarrier& b) {
    asm volatile("s_waitcnt vmcnt(0)" ::: "memory");
    __syncthreads();
    if (threadIdx.x == 0) {
        unsigned* bar = b.bar;
        __builtin_amdgcn_s_waitcnt(0);
        unsigned nloc = b.st[0], nx = b.st[1];
        if (nloc == 0u) { xcd_barrier_complete(bar, b.x, nloc, nx); b.st[0] = nloc; b.st[1] = nx; }
        const unsigned old = xb_add(&bar[XB_XSUB(b.x)], 1u);
        const unsigned gen = old / nloc;
        if (old + 1u == (gen + 1u) * nloc) {
            __builtin_amdgcn_fence(__ATOMIC_RELEASE, "agent");
            asm volatile("s_waitcnt vmcnt(0)" ::: "memory");
            const unsigned og = xb_add(&bar[XB_TOP], 1u);
            const unsigned tg = og / nx;
            if (og + 1u == (tg + 1u) * nx) xb_add(&bar[XB_TOPGEN], 1u);
            else XB_SPIN(xb_ld(&bar[XB_TOPGEN]) == tg, bar);
            __builtin_amdgcn_fence(__ATOMIC_ACQUIRE, "agent");
            xb_add(&bar[XB_XGEN(b.x)], 1u);
            asm volatile("s_waitcnt vmcnt(0)" ::: "memory");
        } else {
            XB_SPIN(xb_ld(&bar[XB_XGEN(b.x)]) == gen, bar);
            __builtin_amdgcn_fence(__ATOMIC_ACQUIRE, "agent");
            asm volatile("s_waitcnt vmcnt(0)" ::: "memory");
        }
    }
    __syncthreads();
}
namespace attn_body {
using bf16=__hip_bfloat16;
using bf16x8=__attribute__((ext_vector_type(8)))short;
using s16x4=__attribute__((ext_vector_type(4)))short;
using f32x16=__attribute__((ext_vector_type(16)))float;
using u32x4=__attribute__((ext_vector_type(4)))unsigned;
constexpr int D=64;
constexpr int NW=8,QBLK=32,QB=QBLK*NW,KVBLK=64;
__device__ __forceinline__ int crow(int r,int hi){return (r&3)+8*(r>>2)+4*hi;}
#define SBAR() __builtin_amdgcn_sched_barrier(0)
__device__ __forceinline__ void cmask(f32x16&p0,f32x16&p1,int jb,int qrel,int hi){
  const float NEG=-INFINITY; int kb=64*jb+4*hi;
  #pragma unroll
  for(int r=0;r<16;++r){int kv=kb+(r&3)+8*(r>>2); if(kv>qrel)p0[r]=NEG; if(kv+32>qrel)p1[r]=NEG;}
}

constexpr int NSLOT=3, SLOTB=8192;
constexpr int LDS_K=0, LDS_V=NSLOT*SLOTB, LDS_WS=2*NSLOT*SLOTB, LDS_OST=LDS_WS+NW*64*4, LDS_BYTES=LDS_OST+NW*4096;
__device__ __forceinline__ void glds16(const void*gsrc,unsigned lds_dst){unsigned keep;
  asm volatile("s_mov_b32 %0, m0\n\ts_mov_b32 m0, %2\n\ts_nop 0\n\tglobal_load_lds_dwordx4 %1, off\n\ts_mov_b32 m0, %0":"=&s"(keep):"v"(gsrc),"s"(lds_dst):"memory");}
__device__ __forceinline__ float max3f(float a,float b,float c){float r;asm("v_max3_f32 %0, %1, %2, %3":"=v"(r):"v"(a),"v"(b),"v"(c));return r;}
__device__ __forceinline__ float max2f(float a,float b){float r;asm("v_max_f32_e32 %0, %1, %2":"=v"(r):"v"(a),"v"(b));return r;}
__device__ __forceinline__ float fadd_s(float a,float b){float r;asm("v_add_f32_e32 %0, %1, %2":"=v"(r):"v"(a),"v"(b));return r;}
__device__ __forceinline__ float fsub_s(float a,float b){float r;asm("v_sub_f32_e32 %0, %1, %2":"=v"(r):"v"(a),"v"(b));return r;}
typedef float f32x2_t __attribute__((ext_vector_type(2))); typedef float f32x4_t __attribute__((ext_vector_type(4))); typedef __bf16 bf16x2_t __attribute__((ext_vector_type(2)));
__device__ __forceinline__ unsigned cvtpk_s(float lo,float hi){f32x2_t v={lo,hi};bf16x2_t b=__builtin_convertvector(v,bf16x2_t);return __builtin_bit_cast(unsigned,b);}
#define WAIT_BAR(N) asm volatile("s_waitcnt vmcnt(" #N ") lgkmcnt(0)\n\ts_barrier":::"memory")

__device__ __forceinline__ void qkt(f32x16&p0,f32x16&p1,const char*Kslot,const bf16x8*qr,int r32,int hi){
  const char*kb=Kslot+hi*1024+r32*16;
  #pragma unroll
  for(int d0=0;d0<4;++d0){
    const bf16x8 b0=*reinterpret_cast<const bf16x8*>(kb+d0*2048);
    const bf16x8 b1=*reinterpret_cast<const bf16x8*>(kb+d0*2048+512);
    p0=__builtin_amdgcn_mfma_f32_32x32x16_bf16(b0,qr[d0],p0,0,0,0);p1=__builtin_amdgcn_mfma_f32_32x32x16_bf16(b1,qr[d0],p1,0,0,0);}
}
typedef __attribute__((address_space(3))) const char* lds_cptr;
typedef short v4i16_t __attribute__((ext_vector_type(4)));
__device__ __forceinline__ void kload8(bf16x8*kf,lds_cptr kp){
  kf[0]=*(const __attribute__((address_space(3))) bf16x8*)(kp);      kf[1]=*(const __attribute__((address_space(3))) bf16x8*)(kp+512);
  kf[2]=*(const __attribute__((address_space(3))) bf16x8*)(kp+2048); kf[3]=*(const __attribute__((address_space(3))) bf16x8*)(kp+2560);
  kf[4]=*(const __attribute__((address_space(3))) bf16x8*)(kp+4096); kf[5]=*(const __attribute__((address_space(3))) bf16x8*)(kp+4608);
  kf[6]=*(const __attribute__((address_space(3))) bf16x8*)(kp+6144); kf[7]=*(const __attribute__((address_space(3))) bf16x8*)(kp+6656);
}
__device__ __forceinline__ void kload2(bf16x8*kf,lds_cptr kp,int j){ kf[2*j]=*(const __attribute__((address_space(3))) bf16x8*)(kp+j*2048); kf[2*j+1]=*(const __attribute__((address_space(3))) bf16x8*)(kp+j*2048+512); }
__device__ __forceinline__ s16x4 vtr(lds_cptr p){ return __builtin_bit_cast(s16x4,__builtin_amdgcn_ds_read_tr16_b64_v4i16((__attribute__((address_space(3))) v4i16_t*)p)); }
__device__ __forceinline__ float rowmax(const f32x16&p0,const f32x16&p1){
  float a=max3f(p0[0],p0[1],p1[0]),b=max3f(p0[2],p0[3],p1[1]);a=max3f(a,p1[2],p1[3]);
  #pragma unroll
  for(int r=4;r<16;r+=4){a=max3f(a,p0[r],p0[r+1]);b=max3f(b,p0[r+2],p0[r+3]);a=max3f(a,p1[r],p1[r+1]);b=max3f(b,p1[r+2],p1[r+3]);}
  const float m=max2f(a,b);
  auto rr=__builtin_amdgcn_permlane32_swap(__float_as_uint(m),__float_as_uint(m),false,false);
  return max2f(__uint_as_float(rr[0]),__uint_as_float(rr[1]));
}
__device__ __forceinline__ void pv(f32x16*o,int vb,bf16x8 pa0,bf16x8 pa1,bf16x8 pa2,bf16x8 pa3){
  #pragma unroll
  for(int d0=0;d0<2;++d0){s16x4 lo[4],hi[4];
    #pragma unroll
    for(int ks=0;ks<4;++ks){
      asm volatile("ds_read_b64_tr_b16 %0,%1 offset:%c2":"=&v"(lo[ks]):"v"(vb),"i"(d0*4096+ks*1024):"memory");
      asm volatile("ds_read_b64_tr_b16 %0,%1 offset:%c2":"=&v"(hi[ks]):"v"(vb),"i"(d0*4096+ks*1024+512):"memory");}
    asm volatile("s_waitcnt lgkmcnt(0)":::"memory");SBAR();
    #define PK(k) (bf16x8){lo[k][0],lo[k][1],lo[k][2],lo[k][3],hi[k][0],hi[k][1],hi[k][2],hi[k][3]}
    o[d0]=__builtin_amdgcn_mfma_f32_32x32x16_bf16(pa0,PK(0),o[d0],0,0,0);
    o[d0]=__builtin_amdgcn_mfma_f32_32x32x16_bf16(pa1,PK(1),o[d0],0,0,0);
    o[d0]=__builtin_amdgcn_mfma_f32_32x32x16_bf16(pa2,PK(2),o[d0],0,0,0);
    o[d0]=__builtin_amdgcn_mfma_f32_32x32x16_bf16(pa3,PK(3),o[d0],0,0,0);
    #undef PK
  }
}

#ifndef ATTN_STORE16
#define ATTN_STORE16(p,v) (*(u32x4*)(p)=(v))
#endif
template<int MODE,int THRL,int QP,int KP,int OP> __device__ __forceinline__ void attn_unit(const bf16*Qw0,const bf16*__restrict__ Kh,const bf16*__restrict__ Vh,bf16*Ow0,const int NT,
                                                                                          const float slope2,const float*kms0,const float*kms1,const int qb,char*shm){
  int tid_=threadIdx.x; asm volatile("":"+v"(tid_));
  const int tid=tid_,lane=tid&63,r32=lane&31,hi=lane>>5; const int wid=__builtin_amdgcn_readfirstlane(tid>>6);
  const bf16*Qw=Qw0+(long)(wid*QBLK)*QP;
  const unsigned lds0=(unsigned)(uintptr_t)shm;
  float*wsf=(float*)(shm+LDS_WS)+wid*64;
  const bf16*ksrc=Kh+(long)lane*KP+wid*8;
  const bf16*vsrc=Vh+(long)(16*(wid&3)+(lane>>2))*KP+(wid>>2)*32+(lane&3)*8;
  const unsigned kdst=lds0+LDS_K+wid*1024, vdst=lds0+LDS_V+wid*1024;
  #define PT(t) ((MODE==0)?(NT-1-(t)):(((t)<NT-4)?(NT-5-(t)):(t)))
  #define DMA_K(t,slot) glds16(ksrc+(long)PT(t)*KVBLK*KP,(unsigned)__builtin_amdgcn_readfirstlane(kdst+(slot)))
  #define DMA_V(t,slot) glds16(vsrc+(long)PT(t)*KVBLK*KP,(unsigned)__builtin_amdgcn_readfirstlane(vdst+(slot)))
  const int vb0=(int)(lds0+LDS_V)+((lane>>4)&1)*32+(lane&3)*8+(4*hi+((lane&15)>>2))*64;
  const char*Kbase=shm+LDS_K; bf16x8 kf[8];
  const lds_cptr shm3=(lds_cptr)shm; const lds_cptr kp0=shm3+LDS_K+hi*1024+r32*16; const lds_cptr vp0=shm3+LDS_V+((lane>>4)&1)*32+(lane&3)*8+(4*hi+((lane&15)>>2))*64;
  DMA_K(0,0);DMA_V(0,0);DMA_K(1,SLOTB);
  bf16x8 qr[4];
  #pragma unroll
  for(int d0=0;d0<4;++d0)qr[d0]=*reinterpret_cast<const bf16x8*>(&Qw[(long)r32*QP+d0*16+hi*8]);
  unsigned selm=0xffffffffu;
  if constexpr(MODE==1){
    f32x16 G=f32x16{};
    #pragma unroll
    for(int d0=0;d0<4;++d0){
      bf16x8 ah=bf16x8{},al=bf16x8{};
      if(r32<16){ const float*p0_=kms0+r32*64+d0*16+hi*8,*p1_=kms1+r32*64+d0*16+hi*8;
        const f32x4_t s0=*reinterpret_cast<const f32x4_t*>(p0_)+*reinterpret_cast<const f32x4_t*>(p1_), s1=*reinterpret_cast<const f32x4_t*>(p0_+4)+*reinterpret_cast<const f32x4_t*>(p1_+4);
        const float km_[8]={s0[0],s0[1],s0[2],s0[3],s1[0],s1[1],s1[2],s1[3]};
        #pragma unroll
        for(int i_=0;i_<8;i_+=2){ const unsigned wh_=cvtpk_s(km_[i_],km_[i_+1]); const float r0_=km_[i_]-__uint_as_float(wh_<<16), r1_=km_[i_+1]-__uint_as_float(wh_&0xffff0000u); const unsigned wl_=cvtpk_s(r0_,r1_);
          ah[i_]=(short)(wh_&0xffffu); ah[i_+1]=(short)(wh_>>16); al[i_]=(short)(wl_&0xffffu); al[i_+1]=(short)(wl_>>16); } }
      G=__builtin_amdgcn_mfma_f32_32x32x16_bf16(ah,qr[d0],G,0,0,0); G=__builtin_amdgcn_mfma_f32_32x32x16_bf16(al,qr[d0],G,0,0,0);}
    float g[16];
    #pragma unroll
    for(int r=0;r<4;++r){ const float a=G[r],b=G[4+r]; const float oa=__shfl_xor(a,32),ob=__shfl_xor(b,32);
      g[r]=hi?oa:a; g[4+r]=hi?a:oa; g[8+r]=hi?ob:b; g[12+r]=hi?b:ob; }
    #pragma unroll
    for(int n=0;n<16;++n) if(n>=qb) g[n]=-1.0e30f;
    const int nsel=qb<3?qb:3; unsigned mask=0u;
    #pragma unroll
    for(int rr=0;rr<3;++rr){ float best=-3.0e38f; int bi=0;
      #pragma unroll
      for(int n=0;n<16;++n){ const bool c=!((mask>>n)&1u)&&g[n]>best; best=c?g[n]:best; bi=c?n:bi; }
      if(rr<nsel) mask|=1u<<bi; }
    selm=mask|(1u<<qb);
  }
  float mhat=0.f,l_reg=0.f;f32x16 o[2];o[0]=f32x16{};o[1]=f32x16{};
  const int qrel=wid*QBLK+r32;
  const float hb=(MODE==1)?slope2*(float)(4*hi):0.f, s32=(MODE==1)?32.f*slope2:0.f, s64=(MODE==1)?64.f*slope2:0.f;
  #define CBASE(b0_,b1_,t) float b0_=fsub_s(fadd_s(s64*(float)PT(t),hb),mhat); if(MODE==1){ if(!((selm>>(PT(t)>>2))&1u)) b0_=-3.0e38f; } const float b1_=b0_+s32
  #define CFILL(X,B,bb) do{ _Pragma("unroll") for(int i_=0;i_<4;++i_){ if(MODE==1) X[(B)+i_]=__builtin_fmaf(slope2,(float)((((B)+i_)&3)+8*(((B)+i_)>>2)),bb); else X[(B)+i_]=bb; } }while(0)
  #define CINIT(C0,C1,t) do{ CBASE(b0_,b1_,t); CFILL(C0,0,b0_);CFILL(C0,4,b0_);CFILL(C0,8,b0_);CFILL(C0,12,b0_);CFILL(C1,0,b1_);CFILL(C1,4,b1_);CFILL(C1,8,b1_);CFILL(C1,12,b1_); }while(0)
  #define CMASK(P0,P1,t) do{ if(MODE==1){ int jb_=(t)-(NT-4); if(jb_>=0)cmask(P0,P1,jb_,qrel,hi);} }while(0)
  bool resc=false;
  #define START(P0,P1) do{ const float rm=rowmax(P0,P1); resc=false; \
    { const float dl=__builtin_fmaxf(rm,-1000.f); mhat=fadd_s(mhat,dl); \
      _Pragma("unroll") for(int r=0;r<16;++r){P0[r]=fsub_s(P0[r],dl);P1[r]=fsub_s(P1[r],dl);} } \
    _Pragma("unroll") for(int r=0;r<16;++r)P0[r]=__builtin_amdgcn_exp2f(P0[r]); }while(0)
  #define RESC() do{ if(resc){ asm volatile("s_waitcnt lgkmcnt(0)":::"memory"); \
      _Pragma("unroll") for(int d_=0;d_<2;++d_) _Pragma("unroll") for(int r=0;r<16;++r)o[d_][r]*=wsf[crow(r,hi)]; } }while(0)
  f32x16 pA0,pA1,pB0,pB1;
  int sl_prev=0,sl_cur=0,sl_next=SLOTB;
  #define ROT() do{sl_prev=sl_cur;sl_cur=sl_next;sl_next=(sl_next==(NSLOT-1)*SLOTB)?0:sl_next+SLOTB;}while(0)
  DMA_K(2,2*SLOTB);
  WAIT_BAR(3);
  CINIT(pA0,pA1,0);
  qkt(pA0,pA1,Kbase,qr,r32,hi);asm volatile("s_nop 15\n\ts_nop 7":"+v"(pA0),"+v"(pA1));CMASK(pA0,pA1,0);
  START(pA0,pA1);
  _Pragma("unroll") for(int r=0;r<16;++r)pA1[r]=__builtin_amdgcn_exp2f(pA1[r]);
  WAIT_BAR(0);
  DMA_K(3,0);DMA_V(1,SLOTB);
  ROT();
  kload8(kf,kp0+sl_cur);
  WAIT_BAR(2);
  s16x4 vlo[8],vhi[8]; u32x4 pw0,pw1,pw2,pw3;
  #define PKW(P,B) cvtpk_s(P[B],P[B+1])
  #define PAF(k) __builtin_bit_cast(bf16x8,pw##k)
  #define VFR(i) (bf16x8){vlo[i][0],vlo[i][1],vlo[i][2],vlo[i][3],vhi[i][0],vhi[i][1],vhi[i][2],vhi[i][3]}
  #define PIN(x) asm volatile("":"+v"(x))
  #define MX3(a,b,c) __builtin_fmaxf(__builtin_fmaxf((a),(b)),(c))
  #define GAPA(MF,A0,A1,A2,A3,W0,W1,PW) do{ MF; sacc+=A0; sacc+=A1; sacc+=A2; sacc+=A3; PIN(sacc); W0; W1; PIN(PW); SBAR(); }while(0)
  #define EX(v) __builtin_amdgcn_exp2f(v)
  #define GAPB(MF,X,B,N,bb) do{ MF; X[B]=EX(X[B]); X[B+1]=EX(X[B+1]); X[B+2]=EX(X[B+2]); X[B+3]=EX(X[B+3]); PIN(X); CFILL(N,B,bb); PIN(N); SBAR(); }while(0)
  #define VRD(i) do{ vlo[i]=vtr(vp_+(((i)>>2)*4096+((i)&3)*1024)); vhi[i]=vtr(vp_+(((i)>>2)*4096+((i)&3)*1024+512)); }while(0)
  #define KRD(G,j) do{ if(G){ kload2(kf,kp0+sl_next,j); SBAR(); } }while(0)
  #define STEP(C0,C1,P0,P1,t,GK,GV,GL) do{ SBAR(); \
    const lds_cptr vp_=vp0+sl_prev; \
    VRD(0); SBAR(); float sacc=(P0[0]+P0[1]); \
    GAPA(C0=__builtin_amdgcn_mfma_f32_32x32x16_bf16(kf[0],qr[0],C0,0,0,0), P0[2],P0[3],P0[4],P0[5],     pw0[0]=PKW(P0,0), pw0[1]=PKW(P0,2), pw0); \
    VRD(4); SBAR(); GAPA(C1=__builtin_amdgcn_mfma_f32_32x32x16_bf16(kf[1],qr[0],C1,0,0,0), P0[6],P0[7],P0[8],P0[9],     pw0[2]=PKW(P0,4), pw0[3]=PKW(P0,6), pw0); \
    VRD(1); SBAR(); GAPA(C0=__builtin_amdgcn_mfma_f32_32x32x16_bf16(kf[2],qr[1],C0,0,0,0),   P0[10],P0[11],P0[12],P0[13], pw1[0]=PKW(P0,8), pw1[1]=PKW(P0,10), pw1); \
    VRD(5); SBAR(); GAPA(C1=__builtin_amdgcn_mfma_f32_32x32x16_bf16(kf[3],qr[1],C1,0,0,0),   P0[14],P0[15],P1[0],P1[1],   pw1[2]=PKW(P0,12),pw1[3]=PKW(P0,14), pw1); \
    VRD(2); SBAR(); GAPA(C0=__builtin_amdgcn_mfma_f32_32x32x16_bf16(kf[4],qr[2],C0,0,0,0),   P1[2],P1[3],P1[4],P1[5],     pw2[0]=PKW(P1,0), pw2[1]=PKW(P1,2), pw2); \
    VRD(6); SBAR(); GAPA(C1=__builtin_amdgcn_mfma_f32_32x32x16_bf16(kf[5],qr[2],C1,0,0,0),   P1[6],P1[7],P1[8],P1[9],     pw2[2]=PKW(P1,4), pw2[3]=PKW(P1,6), pw2); \
    VRD(3); SBAR(); GAPA(C0=__builtin_amdgcn_mfma_f32_32x32x16_bf16(kf[6],qr[3],C0,0,0,0),   P1[10],P1[11],P1[12],P1[13], pw3[0]=PKW(P1,8), pw3[1]=PKW(P1,10), pw3); \
    VRD(7); SBAR(); GAPA(C1=__builtin_amdgcn_mfma_f32_32x32x16_bf16(kf[7],qr[3],C1,0,0,0),   P1[14],P1[15],0.f,0.f,       pw3[2]=PKW(P1,12),pw3[3]=PKW(P1,14), pw3); \
    l_reg+=sacc; \
    if(GK){DMA_K((t)+3,sl_cur);} if(GV){DMA_V((t)+1,sl_next);} \
    CMASKX(C0,C1,t); \
    { float a=MX3(C0[0],C0[1],C1[0]),b=MX3(C0[2],C0[3],C1[1]); a=MX3(a,C1[2],C1[3]); \
      _Pragma("unroll") for(int r=4;r<16;r+=4){a=MX3(a,C0[r],C0[r+1]);b=MX3(b,C0[r+2],C0[r+3]);a=MX3(a,C1[r],C1[r+1]);b=MX3(b,C1[r+2],C1[r+3]);} \
      float rm=__builtin_fmaxf(a,b); { auto rr=__builtin_amdgcn_permlane32_swap(__float_as_uint(rm),__float_as_uint(rm),false,false); rm=__builtin_fmaxf(__uint_as_float(rr[0]),__uint_as_float(rr[1])); } \
      resc=false; \
      if(__builtin_expect(__any(rm>(float)THRL),0)){ const float dl=__builtin_fmaxf(rm,0.f); mhat+=dl; \
        _Pragma("unroll") for(int r=0;r<16;++r){C0[r]-=dl;C1[r]-=dl;} \
        const float f=__builtin_amdgcn_exp2f(-dl); l_reg*=f; if(hi==0)wsf[r32]=f; resc=true; } } \
    CBASE(n0_,n1_,(t)+1);                                   \
    SBAR(); \
    GAPB(o[0]=__builtin_amdgcn_mfma_f32_32x32x16_bf16(PAF(0),VFR(0),o[0],0,0,0), C0,0, P0,n0_); \
    GAPB(o[1]=__builtin_amdgcn_mfma_f32_32x32x16_bf16(PAF(0),VFR(4),o[1],0,0,0), C0,4, P0,n0_); \
    KRD(GL,0); GAPB(o[0]=__builtin_amdgcn_mfma_f32_32x32x16_bf16(PAF(1),VFR(1),o[0],0,0,0), C0,8, P0,n0_); \
    KRD(GL,1); GAPB(o[1]=__builtin_amdgcn_mfma_f32_32x32x16_bf16(PAF(1),VFR(5),o[1],0,0,0), C0,12, P0,n0_); \
    KRD(GL,2); GAPB(o[0]=__builtin_amdgcn_mfma_f32_32x32x16_bf16(PAF(2),VFR(2),o[0],0,0,0), C1,0, P1,n1_); \
    KRD(GL,3); GAPB(o[1]=__builtin_amdgcn_mfma_f32_32x32x16_bf16(PAF(2),VFR(6),o[1],0,0,0), C1,4, P1,n1_); \
    GAPB(o[0]=__builtin_amdgcn_mfma_f32_32x32x16_bf16(PAF(3),VFR(3),o[0],0,0,0), C1,8, P1,n1_); \
    GAPB(o[1]=__builtin_amdgcn_mfma_f32_32x32x16_bf16(PAF(3),VFR(7),o[1],0,0,0), C1,12, P1,n1_); \
    }while(0)
  int t=1;
  CINIT(pB0,pB1,1);
  #define ENDW(tt) do{ if((tt)+3<NT){WAIT_BAR(2);} else if((tt)+2<NT){WAIT_BAR(1);} else {WAIT_BAR(0);} }while(0)
  #define CMASKX(P0,P1,t) CMASK(P0,P1,t)
  for(;t+1<NT&&t<5;t+=2){
    STEP(pB0,pB1,pA0,pA1,t,(t+3<NT),(t+1<NT),(t+1<NT));       ENDW(t);   RESC(); ROT();
    STEP(pA0,pA1,pB0,pB1,t+1,(t+4<NT),(t+2<NT),(t+2<NT));     ENDW(t+1); RESC(); ROT();
  }
  #undef CMASKX
  #define CMASKX(P0,P1,t) do{}while(0)
  for(;t+5<NT;t+=2){
    STEP(pB0,pB1,pA0,pA1,t,true,true,true);     WAIT_BAR(2); RESC(); ROT();
    STEP(pA0,pA1,pB0,pB1,t+1,true,true,true);   WAIT_BAR(2); RESC(); ROT();
  }
  #undef CMASKX
  #define CMASKX(P0,P1,t) CMASK(P0,P1,t)
  for(;t+1<NT;t+=2){
    STEP(pB0,pB1,pA0,pA1,t,(t+3<NT),(t+1<NT),(t+1<NT));       ENDW(t);   RESC(); ROT();
    STEP(pA0,pA1,pB0,pB1,t+1,(t+4<NT),(t+2<NT),(t+2<NT));     ENDW(t+1); RESC(); ROT();
  }
  STEP(pB0,pB1,pA0,pA1,NT-1,false,false,false); RESC();
  { float sacc=pB0[0]+pB0[1]; _Pragma("unroll") for(int r=2;r<16;++r)sacc+=pB0[r]; _Pragma("unroll") for(int r=0;r<16;++r)sacc+=pB1[r]; l_reg+=sacc;
    pw0=(u32x4){PKW(pB0,0),PKW(pB0,2),PKW(pB0,4),PKW(pB0,6)};pw1=(u32x4){PKW(pB0,8),PKW(pB0,10),PKW(pB0,12),PKW(pB0,14)};pw2=(u32x4){PKW(pB1,0),PKW(pB1,2),PKW(pB1,4),PKW(pB1,6)};pw3=(u32x4){PKW(pB1,8),PKW(pB1,10),PKW(pB1,12),PKW(pB1,14)};
    SBAR(); pv(o,vb0+sl_cur,PAF(0),PAF(1),PAF(2),PAF(3)); }
  #undef PKW
  #undef PAF
  #undef VFR
  #undef PIN
  #undef MX3
  #undef GAPA
  #undef GAPB
  #undef EX
  #undef VRD
  #undef KRD
  #undef STEP
  #undef ENDW
  #undef CMASKX
  {auto rr=__builtin_amdgcn_permlane32_swap(__float_as_uint(l_reg),__float_as_uint(l_reg),false,false);l_reg=__uint_as_float(rr[0])+__uint_as_float(rr[1]);}
  if(hi==0)wsf[32+r32]=l_reg;asm volatile("s_waitcnt lgkmcnt(0)":::"memory");
  float rli[16];
  #pragma unroll
  for(int r=0;r<16;++r)rli[r]=__builtin_amdgcn_rcpf(wsf[32+crow(r,hi)]);
  bf16*Ow=Ow0+(long)(wid*QBLK)*OP;
  { bf16*stg=(bf16*)(shm+LDS_OST)+wid*2048;
    #pragma unroll
    for(int r=0;r<16;++r){const int orow=crow(r,hi);
      #pragma unroll
      for(int d0=0;d0<2;++d0)stg[orow*64+d0*32+r32]=__float2bfloat16(o[d0][r]*rli[r]);}
    asm volatile("s_waitcnt lgkmcnt(0)":::"memory");
    #pragma unroll
    for(int i=0;i<4;++i){const int row=i*8+(lane>>3),ch=lane&7; const u32x4 v=*(const u32x4*)(stg+row*64+ch*8); ATTN_STORE16(Ow+(long)row*OP+ch*8,v);} }
  asm volatile("s_waitcnt lgkmcnt(0)\n\ts_barrier":::"memory");
  #undef DMA_K
  #undef DMA_V
  #undef CMASK
  #undef CINIT
  #undef CBASE
  #undef CFILL
  #undef PT
  #undef START
  #undef RESC
  #undef ROT
}
constexpr int ATTN_LDS_BYTES=LDS_BYTES;
#undef SBAR
#undef WAIT_BAR
}
__device__ __forceinline__ float wave_sum(float v) {
#pragma unroll
    for (int o = 1; o < 64; o <<= 1) v += __shfl_xor(v, o);
    return v;
}
__device__ __forceinline__ float wave_max(float v) {
#pragma unroll
    for (int o = 1; o < 64; o <<= 1) v = fmaxf(v, __shfl_xor(v, o));
    return v;
}
__device__ __forceinline__ int opaque_zero() { int z; asm volatile("v_mov_b32 %0, 0" : "=v"(z)); return z; }

__device__ __forceinline__ void p0_transpose_item(const float* W, int K, int N, bf16* WT, int dest_row0, int k0, int n0, const float* gk, LAS float* scr, int lane) {
    float wv[32];
#pragma unroll
    for (int i = 0; i < 32; ++i) { const int kk = 2 * i + (lane >> 5); wv[i] = W[(size_t)(k0 + kk) * N + n0 + (lane & 31)]; }
    if (gk) {
#pragma unroll
        for (int i = 0; i < 32; ++i) wv[i] *= gk[k0 + 2 * i + (lane >> 5)]; }
#pragma unroll
    for (int i = 0; i < 32; ++i) { const int kk = 2 * i + (lane >> 5); scr[kk * 33 + (lane & 31)] = wv[i]; }
    LDS_WAIT(); asm volatile("" ::: "memory");
    const int c = lane & 7;
#pragma unroll
    for (int j = 0; j < 4; ++j) { const int n = (lane >> 3) + 8 * j; const LAS float* s = scr + (8 * c) * 33 + n;
        v4u o; o.x = pk2(s[0 * 33], s[1 * 33]); o.y = pk2(s[2 * 33], s[3 * 33]); o.z = pk2(s[4 * 33], s[5 * 33]); o.w = pk2(s[6 * 33], s[7 * 33]);
        *(GAS v4u*)(WT + (size_t)(dest_row0 + n) * K + k0 + 8 * c) = o; }
    LDS_WAIT(); asm volatile("" ::: "memory");
}
__device__ __forceinline__ void p0_matrix_item(const float* W, int K, int N, bf16* WT, const float* gk, int mode, int item, LAS float* scr, int lane) {
    const int nblk = N / 32, kb = item / nblk, nb = item - kb * nblk, k0 = 64 * kb, n0 = 32 * nb;
    const int dr = (mode == 0) ? n0 : (256 * (n0 >> 7) + (n0 & 127) + (mode == 2 ? 128 : 0));
    p0_transpose_item(W, K, N, WT, dr, k0, n0, gk, scr, lane);
}
template <int NR>
__device__ __forceinline__ void rows_to_bf16_ssq(const float* xrow, bf16* orow, float* ssq16, int lane) {
    f32x4 v[NR][4];
#pragma unroll
    for (int r = 0; r < NR; ++r) { const GAS f32x4* xr = (const GAS f32x4*)(xrow + (size_t)r * 1024) + lane;
#pragma unroll
        for (int j = 0; j < 4; ++j) v[r][j] = xr[64 * j]; }
#pragma unroll
    for (int r = 0; r < NR; ++r) { float s = 0.f;
#pragma unroll
        for (int j = 0; j < 4; ++j) s += (v[r][j].x * v[r][j].x + v[r][j].y * v[r][j].y) + (v[r][j].z * v[r][j].z + v[r][j].w * v[r][j].w);
        s = wave_sum(s);
        GAS unsigned long long* o8 = (GAS unsigned long long*)(orow + (size_t)r * 1024) + lane;
#pragma unroll
        for (int j = 0; j < 4; ++j) o8[64 * j] = (unsigned long long)pk2(v[r][j].x, v[r][j].y) | ((unsigned long long)pk2(v[r][j].z, v[r][j].w) << 32);
        if (lane < 16) ssq16[r * 16 + lane] = (lane == 0) ? s : 0.f; }
}

__device__ __forceinline__ void s5_naive_unit(int b, int g, const bf16* U, bf16* Y, const float* lam_re, const float* lam_im, const float* log_dt, const float* b_re, const float* b_im,
                                              const float* c_re, const float* c_im, const float* dvec, int lane) {
    const int p = lane;
    const float lr = lam_re[g * 64 + p], li = lam_im[g * 64 + p], dt = expf(log_dt[g]);
    const float mag = expf(lr * dt), ar = mag * cosf(li * dt), ai = mag * sinf(li * dt);
    const float den = lr * lr + li * li, nr = ar - 1.0f, fr = (nr * lr + ai * li) / den, fi = (ai * lr - nr * li) / den;
    float bbr[16], bbi[16], cr[16], ci[16];
#pragma unroll
    for (int c = 0; c < 16; ++c) { const float br = b_re[((size_t)g * 64 + p) * 16 + c], bi = b_im[((size_t)g * 64 + p) * 16 + c]; bbr[c] = fr * br - fi * bi; bbi[c] = fr * bi + fi * br;
        cr[c] = c_re[((size_t)g * 16 + c) * 64 + p]; ci[c] = c_im[((size_t)g * 16 + c) * 64 + p]; }
    const int ch = ((lane & 1) << 3) | ((lane & 2) << 1) | ((lane & 4) >> 1) | ((lane & 8) >> 3);
    const float dch = dvec[16 * g + ch];
    const int z0 = opaque_zero();
    constexpr int TP = 16;
    const bf16* up = U + ((size_t)g * TOK + (size_t)b * SEQ) * 16 + z0;
    bf16* yp = Y + ((size_t)g * TOK + (size_t)b * SEQ) * 16 + ch;
    float xr = 0.f, xi = 0.f;
#pragma unroll 2
    for (int s = 0; s < SEQ; ++s) {
        const v4u w0 = *(const GAS v4u*)(up + (size_t)s * TP), w1 = *(const GAS v4u*)(up + (size_t)s * TP + 8);
        const float uch = bf2f(up[(size_t)s * TP + ch]);
        const float uu[16] = {bflo(w0.x), bfhi(w0.x), bflo(w0.y), bfhi(w0.y), bflo(w0.z), bfhi(w0.z), bflo(w0.w), bfhi(w0.w), bflo(w1.x), bfhi(w1.x), bflo(w1.y), bfhi(w1.y), bflo(w1.z), bfhi(w1.z), bflo(w1.w), bfhi(w1.w)};
        float bur = 0.f, bui = 0.f;
#pragma unroll
        for (int c = 0; c < 16; ++c) { bur += bbr[c] * uu[c]; bui += bbi[c] * uu[c]; }
        const float nxr = ar * xr - ai * xi + bur, nxi = ar * xi + ai * xr + bui; xr = nxr; xi = nxi;
        float v[16];
#pragma unroll
        for (int c = 0; c < 16; ++c) v[c] = cr[c] * xr - ci[c] * xi;
        float w[8], x4[4], x2[2], z;
        { const bool bit = lane & 1;
#pragma unroll
          for (int j = 0; j < 8; ++j) { const float send = bit ? v[j] : v[j + 8], keep = bit ? v[j + 8] : v[j]; w[j] = keep + __shfl_xor(send, 1); } }
        { const bool bit = lane & 2;
#pragma unroll
          for (int j = 0; j < 4; ++j) { const float send = bit ? w[j] : w[j + 4], keep = bit ? w[j + 4] : w[j]; x4[j] = keep + __shfl_xor(send, 2); } }
        { const bool bit = lane & 4;
#pragma unroll
          for (int j = 0; j < 2; ++j) { const float send = bit ? x4[j] : x4[j + 2], keep = bit ? x4[j + 2] : x4[j]; x2[j] = keep + __shfl_xor(send, 4); } }
        { const bool bit = lane & 8; const float send = bit ? x2[0] : x2[1], keep = bit ? x2[1] : x2[0]; z = keep + __shfl_xor(send, 8); }
        z += __shfl_xor(z, 16); z += __shfl_xor(z, 32);
        const float yv = z + dch * uch;
        const float ge = 0.5f * yv * (1.0f + erff(yv * 0.70710678118654752f));
        if (lane < 16) yp[(size_t)s * TP] = (bf16)f2bf(ge);
    }
}

__device__ __forceinline__ void memattn_naive_unit(int tok, int h, const bf16* QM, const bf16* memk, const bf16* memv, bf16* mix, LAS float* ps, int lane) {
    const int b = tok >> 12; const int z0 = opaque_zero();
    const float qv = bf2f(QM[(size_t)tok * 256 + h * 64 + lane]);
    float q[64];
#pragma unroll
    for (int d = 0; d < 64; ++d) q[d] = __shfl(qv, d);
    float sc[4];
#pragma unroll
    for (int i = 0; i < 4; ++i) { const int j = lane + 64 * i; const GAS v4u* kr = (const GAS v4u*)(memk + ((size_t)(b * 256 + j)) * 256 + h * 64 + z0); float a = 0.f;
#pragma unroll
        for (int c = 0; c < 8; ++c) { const v4u w = kr[c]; a += q[8 * c] * bflo(w.x) + q[8 * c + 1] * bfhi(w.x) + q[8 * c + 2] * bflo(w.y) + q[8 * c + 3] * bfhi(w.y) + q[8 * c + 4] * bflo(w.z) + q[8 * c + 5] * bfhi(w.z) + q[8 * c + 6] * bflo(w.w) + q[8 * c + 7] * bfhi(w.w); }
        sc[i] = a; }
    const float m = wave_max(fmaxf(fmaxf(sc[0], sc[1]), fmaxf(sc[2], sc[3])));
    float l = 0.f;
#pragma unroll
    for (int i = 0; i < 4; ++i) { const float pe = __builtin_amdgcn_exp2f(sc[i] - m); l += pe; ps[lane + 64 * i] = pe; }
    l = wave_sum(l);
    LDS_WAIT(); asm volatile("" ::: "memory");
    float o = 0.f; const bf16* vp = memv + (size_t)(b * 256) * 256 + h * 64 + lane;
#pragma unroll 8
    for (int j = 0; j < 256; ++j) o += ps[j] * bf2f(vp[(size_t)j * 256]);
    mix[(size_t)tok * 1024 + 768 + h * 64 + lane] = (bf16)f2bf(o / l);
    LDS_WAIT(); asm volatile("" ::: "memory");
}

__device__ __forceinline__ float dot64_bf16(const float (&q)[64], const GAS v4u* kr) {
    float a = 0.f;
#pragma unroll
    for (int c = 0; c < 8; ++c) { const v4u w = kr[c]; a += q[8 * c] * bflo(w.x) + q[8 * c + 1] * bfhi(w.x) + q[8 * c + 2] * bflo(w.y) + q[8 * c + 3] * bfhi(w.y) + q[8 * c + 4] * bflo(w.z) + q[8 * c + 5] * bfhi(w.z) + q[8 * c + 6] * bflo(w.w) + q[8 * c + 7] * bfhi(w.w); }
    return a;
}
__device__ __forceinline__ void moba_naive_unit(int tok, int h, const bf16* Q1, const bf16* K1, const bf16* V1, const float* KMEAN, bf16* mix, LAS float* ps, int lane) {
    const int b = tok >> 12, s = tok & (SEQ - 1), qb = s >> 8; const int z0 = opaque_zero();
    const float qv = bf2f(Q1[(size_t)tok * TOKW + h * 64 + lane]);
    float q[64];
#pragma unroll
    for (int d = 0; d < 64; ++d) q[d] = __shfl(qv, d);
    float gate = -1e30f;
    { const int n = lane & 15; const GAS f32x4* km = (const GAS f32x4*)(KMEAN + ((size_t)((b * NHEAD + h) * NBLK + n)) * 64 + z0); float a = 0.f;
#pragma unroll
      for (int c = 0; c < 16; ++c) { const f32x4 w = km[c]; a += q[4 * c] * w.x + q[4 * c + 1] * w.y + q[4 * c + 2] * w.z + q[4 * c + 3] * w.w; }
      if (n < qb) gate = a; }
    float g[16];
#pragma unroll
    for (int n = 0; n < 16; ++n) g[n] = __shfl(gate, n);
    const int nsel = qb < 3 ? qb : 3;
    unsigned mask = 0u;
#pragma unroll
    for (int r = 0; r < 3; ++r) { float best = -3.0e38f; int bi = 0;
#pragma unroll
        for (int n = 0; n < 16; ++n) { const bool c = !((mask >> n) & 1u) && g[n] > best; best = c ? g[n] : best; bi = c ? n : bi; }
        if (r < nsel) mask |= 1u << bi; }
    int blk0 = 0, blk1 = 0, blk2 = 0, cnt = 0;
#pragma unroll
    for (int n = 0; n < 16; ++n) if ((mask >> n) & 1u) { if (cnt == 0) blk0 = n; else if (cnt == 1) blk1 = n; else blk2 = n; ++cnt; }
    const int nslots = nsel + 1;
    const float slope = __builtin_amdgcn_exp2f(-8.0f * (float)(h + 1) / 12.0f) * LOG2E;
    const bf16* kh = K1 + (size_t)b * SEQ * TOKW + h * 64 + z0;
    float mx = -3.0e38f;
#pragma unroll
    for (int sl = 0; sl < 4; ++sl) if (sl < nslots) {
        const int blk = (sl == nsel) ? qb : (sl == 0 ? blk0 : (sl == 1 ? blk1 : blk2));
#pragma unroll
        for (int i = 0; i < 4; ++i) { const int j = lane + 64 * i, pos = blk * 256 + j;
            float a = dot64_bf16(q, (const GAS v4u*)(kh + (size_t)pos * TOKW)) + slope * (float)(pos - s);
            if (pos > s) a = -3.0e38f;
            ps[sl * 256 + j] = a; mx = fmaxf(mx, a); } }
    mx = wave_max(mx);
    LDS_WAIT(); asm volatile("" ::: "memory");
    float l = 0.f;
#pragma unroll
    for (int sl = 0; sl < 4; ++sl) if (sl < nslots) {
#pragma unroll
        for (int i = 0; i < 4; ++i) { const int j = lane + 64 * i; const float a = ps[sl * 256 + j]; const float pe = (a < -1.0e37f) ? 0.f : __builtin_amdgcn_exp2f(a - mx); l += pe; ps[sl * 256 + j] = pe; } }
    l = wave_sum(l);
    LDS_WAIT(); asm volatile("" ::: "memory");
    float o = 0.f; const bf16* vh = V1 + (size_t)b * SEQ * TOKW + h * 64 + lane;
#pragma unroll
    for (int sl = 0; sl < 4; ++sl) if (sl < nslots) {
        const int blk = (sl == nsel) ? qb : (sl == 0 ? blk0 : (sl == 1 ? blk1 : blk2));
        const bf16* vp = vh + (size_t)(blk * 256) * TOKW;
#pragma unroll 8
        for (int j = 0; j < 256; ++j) o += ps[sl * 256 + j] * bf2f(vp[(size_t)j * TOKW]); }
    mix[(size_t)tok * 1024 + h * 64 + lane] = (bf16)f2bf(o / l);
    LDS_WAIT(); asm volatile("" ::: "memory");
}

constexpr int S5_PITCH = 272;
constexpr int S5_WST = 0, S5_WYC = 128 * S5_PITCH, S5_KT = 2 * 128 * S5_PITCH, S5_TAB_BYTES = S5_KT + 10 * 512;
constexpr int S5_XS = S5_TAB_BYTES, S5_XS_BYTES = 32 * S5_PITCH;
static_assert(S5_XS + NWAVES * S5_XS_BYTES <= RING_BYTES, "S5 LDS map");
typedef short s5_bf16x8 __attribute__((ext_vector_type(8)));
typedef float s5_f32x16 __attribute__((ext_vector_type(16)));

__device__ __forceinline__ void s5_apow(float lr, float li, float dt, int n, float& pr, float& pi) { const float m = expf(lr * dt * (float)n), th = li * dt * (float)n; pr = m * cosf(th); pi = m * sinf(th); }
__device__ __forceinline__ void s5_apow_fast(float lr, float li, float dt, int n, float& pr, float& pi) { const float m = __expf(lr * dt * (float)n), th = li * dt * (float)n; pr = m * __cosf(th); pi = m * __sinf(th); }
__device__ __forceinline__ void s5_zoh(float lr, float li, float dt, float& fr, float& fi) {
    float ar, ai; s5_apow(lr, li, dt, 1, ar, ai); const float den = lr * lr + li * li, nr = ar - 1.0f; fr = (nr * lr + ai * li) / den; fi = (ai * lr - nr * li) / den;
}
__device__ __forceinline__ void s5_tab_wst(int g, int jt, unsigned char* tab, const float* lam_re, const float* lam_im, const float* log_dt, const float* b_re, const float* b_im, int lane) {
    const int s = lane >> 3, cp = lane & 7; const float dt = expf(log_dt[g]);
    float zr, zi, mylr, myli;
    { const int p = (jt >> 1) * 32 + (lane & 31); mylr = lam_re[g * 64 + p]; myli = lam_im[g * 64 + p]; s5_zoh(mylr, myli, dt, zr, zi); }
#pragma unroll 4
    for (int r = 0; r < 32; ++r) { const int p = (jt >> 1) * 32 + r; const float lr = __shfl(mylr, r), li = __shfl(myli, r), fr = __shfl(zr, r), fi = __shfl(zi, r);
        float pr, pi; s5_apow_fast(lr, li, dt, 7 - s, pr, pi);
        float o[2];
#pragma unroll
        for (int e = 0; e < 2; ++e) { const int c = 2 * cp + e; const float br = b_re[((size_t)g * 64 + p) * 16 + c], bi = b_im[((size_t)g * 64 + p) * 16 + c];
            const float bbr = fr * br - fi * bi, bbi = fr * bi + fi * br; o[e] = (jt & 1) ? (pr * bbi + pi * bbr) : (pr * bbr - pi * bbi); }
        *(GAS unsigned*)(tab + S5_WST + (32 * jt + r) * S5_PITCH + (16 * s + 2 * cp) * 2) = pk2(o[0], o[1]); }
}
__device__ __forceinline__ void s5_tab_const(int g, float* ctab, const float* lam_re, const float* lam_im, const float* log_dt, int lane) {
    const float dt = expf(log_dt[g]); float xr, xi; s5_apow(lam_re[g * 64 + lane], lam_im[g * 64 + lane], dt, 1, xr, xi);
#pragma unroll
    for (int q = 0; q < 3; ++q) { const float nr = xr * xr - xi * xi, ni = 2.0f * xr * xi; xr = nr; xi = ni; }
    const float ar = xr, ai = xi;
#pragma unroll
    for (int q = 0; q < 5; ++q) { const float nr = xr * xr - xi * xi, ni = 2.0f * xr * xi; xr = nr; xi = ni; }
    *(GAS f32x4*)(ctab + ((size_t)g * 64 + lane) * 4) = (f32x4){ar, ai, xr, xi};
}
__device__ __forceinline__ void s5_tab_wyc(int g, int t, unsigned char* tab, const float* lam_re, const float* lam_im, const float* log_dt, const float* c_re, const float* c_im, int lane) {
    const int p = lane; const float dt = expf(log_dt[g]); float pr, pi; s5_apow_fast(lam_re[g * 64 + p], lam_im[g * 64 + p], dt, t + 1, pr, pi);
#pragma unroll
    for (int c = 0; c < 16; ++c) { const float cr = c_re[((size_t)g * 16 + c) * 64 + p], ci = c_im[((size_t)g * 16 + c) * 64 + p];
        *(GAS unsigned*)(tab + S5_WYC + (16 * t + c) * S5_PITCH + 4 * p) = pk2(cr * pr - ci * pi, -(cr * pi + ci * pr)); }
}
__device__ __forceinline__ void s5_tab_kt(int g, int d, unsigned char* tab, const float* lam_re, const float* lam_im, const float* log_dt, const float* b_re, const float* b_im, const float* c_re, const float* c_im,
                                          const float* dvec, int lane) {
    const float dt = expf(log_dt[g]); float mr, mi;
    { const float lr = lam_re[g * 64 + lane], li = lam_im[g * 64 + lane]; float pr, pi, fr, fi; s5_apow_fast(lr, li, dt, d, pr, pi); s5_zoh(lr, li, dt, fr, fi); mr = pr * fr - pi * fi; mi = pr * fi + pi * fr; }
    float acc[4] = {0.f, 0.f, 0.f, 0.f};
#pragma unroll 8
    for (int p = 0; p < 64; ++p) { const float pmr = __shfl(mr, p), pmi = __shfl(mi, p);
#pragma unroll
        for (int i = 0; i < 4; ++i) { const int e = lane + 64 * i, c = e >> 4, c2 = e & 15;
            const float br = b_re[((size_t)g * 64 + p) * 16 + c2], bi = b_im[((size_t)g * 64 + p) * 16 + c2], cr = c_re[((size_t)g * 16 + c) * 64 + p], ci = c_im[((size_t)g * 16 + c) * 64 + p];
            const float tr = pmr * br - pmi * bi, ti = pmr * bi + pmi * br; acc[i] += cr * tr - ci * ti; } }
#pragma unroll
    for (int i = 0; i < 4; ++i) { const int e = lane + 64 * i, c = e >> 4, c2 = e & 15; float v = acc[i]; if (d == 0 && c == c2) v += dvec[16 * g + c];
        *(GAS bf16*)(tab + S5_KT + (d + 1) * 512 + c * 32 + c2 * 2) = (bf16)f2bf(v);
        if (d == 0) *(GAS bf16*)(tab + S5_KT + c * 32 + c2 * 2) = (bf16)0; }
}

template <bool FINAL>
__device__ __forceinline__ void s5_unit(int g, int seg, const bf16* Ug, bf16* Yg, const unsigned char* tab, float* Ebuf, const float* ctab, LAS unsigned char* L) {
    int tid_ = threadIdx.x; asm volatile("" : "+v"(tid_));
    const int tid = tid_, lane = tid & 63, r32 = lane & 31, hi = lane >> 5, b = __builtin_amdgcn_readfirstlane(tid >> 6);
    { const int npc = (FINAL ? S5_TAB_BYTES : S5_WYC) / 1024; const unsigned l0 = (unsigned)(uintptr_t)(unsigned char*)L;
      for (int i = b; i < npc; i += NWAVES) attn_body::glds16(tab + (size_t)i * 1024 + lane * 16, (unsigned)__builtin_amdgcn_readfirstlane(l0 + i * 1024)); }
    const size_t tok0 = (size_t)g * TOK + (size_t)b * SEQ + (size_t)seg * 256;
    s5_bf16x8 A[8];
    { const bf16* up = Ug + (tok0 + 8 * r32) * 16 + 8 * hi;
#pragma unroll
      for (int s = 0; s < 8; ++s) A[s] = *(const GAS s5_bf16x8*)(up + s * 16); }
    float aLr[2], aLi[2], aSr[2], aSi[2];
#pragma unroll
    for (int k = 0; k < 2; ++k) { const f32x4 cv = *(const GAS f32x4*)(ctab + ((size_t)g * 64 + 32 * k + r32) * 4); aLr[k] = cv.x; aLi[k] = cv.y; aSr[k] = cv.z; aSi[k] = cv.w; }
    float cr[2] = {0.f, 0.f}, ci[2] = {0.f, 0.f};
    if (FINAL) {
        const float* eb = Ebuf + ((size_t)(b * NGRP + g) * 16) * 128;
        f32x2 ev[15][2];
#pragma unroll
        for (int j = 0; j < 15; ++j)
#pragma unroll
            for (int k = 0; k < 2; ++k) ev[j][k] = (j < seg) ? *(const GAS f32x2*)(eb + (size_t)j * 128 + 2 * (32 * k + r32)) : (f32x2){0.f, 0.f};
#pragma unroll
        for (int j = 0; j < 15; ++j) if (j < seg) {
#pragma unroll
            for (int k = 0; k < 2; ++k) { const float nr = aSr[k] * cr[k] - aSi[k] * ci[k] + ev[j][k].x, ni = aSr[k] * ci[k] + aSi[k] * cr[k] + ev[j][k].y; cr[k] = nr; ci[k] = ni; } }
    }
    asm volatile("s_waitcnt vmcnt(0)" ::: "memory");
    __syncthreads();
    s5_f32x16 S[4];
#pragma unroll
    for (int j = 0; j < 4; ++j) { S[j] = s5_f32x16{};
#pragma unroll
        for (int s = 0; s < 8; ++s) { const s5_bf16x8 bf = *(const LAS s5_bf16x8*)(L + S5_WST + (32 * j + r32) * S5_PITCH + (16 * s + 8 * hi) * 2);
            S[j] = __builtin_amdgcn_mfma_f32_32x32x16_bf16(A[s], bf, S[j], 0, 0, 0); } }
#pragma unroll
    for (int i = 0; i < 8; ++i) { const bool own = ((i & 1) == hi);
#pragma unroll
        for (int q = 0; q < 4; ++q) { const int reg = 4 * (i >> 1) + q;
#pragma unroll
            for (int k = 0; k < 2; ++k) { const float sr = S[2 * k][reg], si = S[2 * k + 1][reg];
                const float nr = aLr[k] * cr[k] - aLi[k] * ci[k] + sr, ni = aLr[k] * ci[k] + aLi[k] * cr[k] + si;
                S[2 * k][reg] = own ? cr[k] : sr; S[2 * k + 1][reg] = own ? ci[k] : si; cr[k] = own ? nr : cr[k]; ci[k] = own ? ni : ci[k]; } }
#pragma unroll
        for (int k = 0; k < 2; ++k) { const float orr = __shfl_xor(cr[k], 32), oi = __shfl_xor(ci[k], 32); cr[k] = own ? cr[k] : orr; ci[k] = own ? ci[k] : oi; } }
    if (!FINAL) {
        if (hi == 0) { float* eb = Ebuf + ((size_t)(b * NGRP + g) * 16 + seg) * 128;
#pragma unroll
            for (int k = 0; k < 2; ++k) *(GAS f32x2*)(eb + 2 * (32 * k + r32)) = (f32x2){cr[k], ci[k]}; }
    } else {
        LAS unsigned char* XS = L + S5_XS + b * S5_XS_BYTES;
#pragma unroll
        for (int reg = 0; reg < 16; ++reg) { const int chunk = (reg & 3) + 8 * (reg >> 2) + 4 * hi;
#pragma unroll
            for (int k = 0; k < 2; ++k) *(LAS unsigned*)(XS + chunk * S5_PITCH + 4 * (32 * k + r32)) = pg8::cvt_pk_bf16(S[2 * k][reg], S[2 * k + 1][reg]); }
        s5_bf16x8 Xf[8];
#pragma unroll
        for (int kk = 0; kk < 8; ++kk) Xf[kk] = *(const LAS s5_bf16x8*)(XS + r32 * S5_PITCH + (16 * kk + 8 * hi) * 2);
        s5_f32x16 Yc[4];
#pragma unroll
        for (int j = 0; j < 4; ++j) { Yc[j] = s5_f32x16{};
#pragma unroll
            for (int s = 0; s < 8; ++s) if (s <= 2 * j + 1) { const int d1 = 2 * j + (r32 >> 4) - s + 1;
                const s5_bf16x8 bf = *(const LAS s5_bf16x8*)(L + S5_KT + d1 * 512 + (r32 & 15) * 32 + 16 * hi);
                Yc[j] = __builtin_amdgcn_mfma_f32_32x32x16_bf16(A[s], bf, Yc[j], 0, 0, 0); }
#pragma unroll
            for (int kk = 0; kk < 8; ++kk) { const s5_bf16x8 bf = *(const LAS s5_bf16x8*)(L + S5_WYC + (32 * j + r32) * S5_PITCH + (16 * kk + 8 * hi) * 2);
                Yc[j] = __builtin_amdgcn_mfma_f32_32x32x16_bf16(Xf[kk], bf, Yc[j], 0, 0, 0); } }
        asm volatile("s_waitcnt lgkmcnt(0)" ::: "memory");
#pragma unroll
        for (int j = 0; j < 4; ++j)
#pragma unroll
            for (int reg = 0; reg < 16; reg += 2) { const pg8::f32x2 ge = pg8::gelu_pk((pg8::f32x2){Yc[j][reg], Yc[j][reg + 1]});
                const int chunk = (reg & 3) + 8 * (reg >> 2) + 4 * hi, tokl = 8 * chunk + 2 * j + (r32 >> 4), c = r32 & 15;
                const unsigned gw_ = pg8::cvt_pk_bf16(ge.x, ge.y); *(LAS bf16*)(XS + tokl * 32 + c * 2) = (bf16)(gw_ & 0xffffu); *(LAS bf16*)(XS + (tokl + 8) * 32 + c * 2) = (bf16)(gw_ >> 16); }
        asm volatile("s_waitcnt lgkmcnt(0)" ::: "memory");
        bf16* yo = Yg + tok0 * 16;
#pragma unroll
        for (int i = 0; i < 8; ++i) { const int pc = lane + 64 * i; const v4u w = *(const LAS v4u*)(XS + 16 * pc); *(GAS v4u*)(yo + 8 * pc) = w; }
    }
    __syncthreads();
}

#ifndef MK_ONE_LAUNCH
#define MK_ONE_LAUNCH 1
#endif
constexpr int N_PHASES = 14;
struct Args { const float* in[23]; float* out; unsigned char* ws; int ph_lo, ph_hi; };

#ifndef PROBE_P0
#define PROBE_P0 0
#endif
#define P0_ITEM(it) do { \
            int r = it; \
            if (r < I_TKT) { s5_tab_kt(r >> 3, r & 7, S5TAB + (size_t)(r >> 3) * S5_TAB_BYTES, args.in[6], args.in[7], args.in[8], args.in[9], args.in[10], args.in[11], args.in[12], args.in[13], lane); break; } r -= I_TKT; \
            if (r < I_TST) { s5_tab_wst(r >> 2, r & 3, S5TAB + (size_t)(r >> 2) * S5_TAB_BYTES, args.in[6], args.in[7], args.in[8], args.in[9], args.in[10], lane); break; } r -= I_TST; \
            if (r < I_TYC) { s5_tab_wyc(r >> 3, r & 7, S5TAB + (size_t)(r >> 3) * S5_TAB_BYTES, args.in[6], args.in[7], args.in[8], args.in[11], args.in[12], lane); break; } r -= I_TYC; \
            if (r < I_TCO) { s5_tab_const(r, S5C, args.in[6], args.in[7], args.in[8], lane); break; } r -= I_TCO; \
            if (r < I_SQ) { p0_matrix_item(args.in[5], 1024, 1024, WIN0, mixg, 0, r, scr, lane); break; } r -= I_SQ; \
            if (r < I_GLU) { p0_matrix_item(args.in[14], 768, 768, WGLU, nullptr, 0, r, scr, lane); break; } r -= I_GLU; \
            if (r < I_IN1) { p0_matrix_item(args.in[16], 1024, 2560, WIN1, mixg + 1024, 0, r, scr, lane); break; } r -= I_IN1; \
            if (r < I_SQ) { p0_matrix_item(args.in[17], 1024, 1024, WOUT0, nullptr, 0, r, scr, lane); break; } r -= I_SQ; \
            if (r < I_SQ) { p0_matrix_item(args.in[17] + 1024 * 1024, 1024, 1024, WOUT1, nullptr, 0, r, scr, lane); break; } r -= I_SQ; \
            if (r < I_GU) { p0_matrix_item(args.in[19], 1024, FFN, WGU0, ffng, 1, r, scr, lane); break; } r -= I_GU; \
            if (r < I_GU) { p0_matrix_item(args.in[20], 1024, FFN, WGU0, ffng, 2, r, scr, lane); break; } r -= I_GU; \
            if (r < I_GU) { p0_matrix_item(args.in[19] + (size_t)1024 * FFN, 1024, FFN, WGU1, ffng + 1024, 1, r, scr, lane); break; } r -= I_GU; \
            if (r < I_GU) { p0_matrix_item(args.in[20] + (size_t)1024 * FFN, 1024, FFN, WGU1, ffng + 1024, 2, r, scr, lane); break; } r -= I_GU; \
            if (r < I_DN) { p0_matrix_item(args.in[21], FFN, 1024, WDN0, nullptr, 0, r, scr, lane); break; } r -= I_DN; \
            if (r < I_DN) { p0_matrix_item(args.in[21] + (size_t)FFN * 1024, FFN, 1024, WDN1, nullptr, 0, r, scr, lane); break; } r -= I_DN; \
            p0_matrix_item(args.in[3], 1024, 512, WMKV, args.in[2], 0, r, scr, lane); \
        } while (0)
__global__ void __launch_bounds__(NWAVES * 64, 2) mega_fwd(Args args) {
    extern __shared__ __attribute__((aligned(16))) unsigned char lds[];
    LAS unsigned char* L = (LAS unsigned char*)lds;
    volatile LAS unsigned* MISC = (volatile LAS unsigned*)(L + MISC_OFF);
    const int tid = threadIdx.x, lane = tid & 63, wave = __builtin_amdgcn_readfirstlane(tid >> 6);
    const int G = gridDim.x; const int bx = blockIdx.x;
    const int vcu = (G % 8 == 0) ? (bx % 8) * (G / 8) + bx / 8 : bx;
    const int gw = vcu * NWAVES + wave, NGW = G * NWAVES;
    unsigned char* ws = args.ws;
    gu32* ctl = (gu32*)(ws + WS_CTL);
    for (int u = tid; u < (LDS_BYTES - LDSCTL_OFF) / 4; u += NWAVES * 64) ((LAS unsigned*)(L + LDSCTL_OFF))[u] = 0u;
    __syncthreads();
    XcdBarrier bar; bar.bar = (unsigned*)(ctl + CW_BAR); bar.x = 0; bar.st = nullptr;
    if (MK_ONE_LAUNCH) bar = xcd_barrier_post((unsigned*)(ctl + CW_BAR), MISC + 8);
#define MEMATTN_PHASE(u0_, us_) do { for (int un = (u0_); un < BATCH * MHEAD * NBLK; un += (us_)) { const int b_ = un >> 6, h_ = (un >> 4) & 3, qb_ = un & 15; const size_t qrow_ = (size_t)b_ * SEQ + (size_t)qb_ * 256; \
        attn_body::attn_unit<0, 8, 256, 256, 1024>((const attn_body::bf16*)(QM + qrow_ * 256 + h_ * 64), (const attn_body::bf16*)(MEMK + (size_t)b_ * MEML * 256 + h_ * 64), (const attn_body::bf16*)(MEMV + (size_t)b_ * MEML * 256 + h_ * 64), \
            (attn_body::bf16*)(MIX + qrow_ * 1024 + 768 + h_ * 64), 4, 0.f, nullptr, nullptr, 0, (char*)lds + RING_OFF); } } while (0)
    const int lo = args.ph_lo, hi = args.ph_hi;
#ifndef PROBE_DUP
#define PROBE_DUP -1
#endif
#define IN(k) (lo <= (k) && (k) < hi)
#define PH_REP(k) for (int rep_ = 0; rep_ < ((PROBE_DUP == (k)) ? 2 : 1); ++rep_)
#define SEAM(k) do { if (IN(k) && IN((k) + 1)) xcd_barrier(bar); } while (0)

    const float* x = args.in[0]; const float* mem = args.in[1];
    float* out = args.out;
    float* SS0 = (float*)(ws + WS_SS0); float* SSA = (float*)(ws + WS_SSA); float* SSB = (float*)(ws + WS_SSB); float* SSM = (float*)(ws + WS_SSM);
    unsigned char* S5TAB = ws + WS_S5TAB; float* S5E = (float*)(ws + WS_S5E); float* S5C = (float*)(ws + WS_S5TAB + (size_t)NGRP * S5_TAB_BYTES);
    float* KMP = (float*)(ws + WS_KMEAN);
    bf16* WIN0 = (bf16*)(ws + WS_WIN0); bf16* WGLU = (bf16*)(ws + WS_WGLU); bf16* WIN1 = (bf16*)(ws + WS_WIN1);
    bf16* WOUT0 = (bf16*)(ws + WS_WOUT0); bf16* WOUT1 = (bf16*)(ws + WS_WOUT1);
    bf16* WGU0 = (bf16*)(ws + WS_WGU0); bf16* WGU1 = (bf16*)(ws + WS_WGU1); bf16* WDN0 = (bf16*)(ws + WS_WDN0); bf16* WDN1 = (bf16*)(ws + WS_WDN1); bf16* WMKV = (bf16*)(ws + WS_WMKV);
    bf16* MEMB = (bf16*)(ws + WS_MEMB); bf16* MEMK = (bf16*)(ws + WS_MEMK); bf16* MEMV = (bf16*)(ws + WS_MEMV);
    bf16* XB = (bf16*)(ws + WS_XB); bf16* Ub = (bf16*)(ws + WS_U); bf16* Yb = (bf16*)(ws + WS_Y);
    bf16* Q1 = (bf16*)(ws + WS_Q1); bf16* K1 = (bf16*)(ws + WS_K1); bf16* V1 = (bf16*)(ws + WS_V1);
    bf16* QM = (bf16*)(ws + WS_QM); bf16* MIX = (bf16*)(ws + WS_MIX); bf16* Hb = (bf16*)(ws + WS_H);

    if (IN(0)) PH_REP(0) {
        if (rep_) xcd_barrier(bar);
        LAS float* scr = (LAS float*)(L + RING_OFF + wave * 16384);
        constexpr int I_SQ = 16 * 32, I_GLU = 12 * 24, I_IN1 = 16 * 80, I_GU = 16 * 88, I_DN = 44 * 32, I_MKV = 16 * 16;
        constexpr int I_TKT = NGRP * 8, I_TST = NGRP * 4, I_TYC = NGRP * 8, I_TCO = NGRP;
        constexpr int NITEMS = I_TKT + I_TST + I_TYC + I_TCO + I_SQ + I_GLU + I_IN1 + 2 * I_SQ + 4 * I_GU + 2 * I_DN + I_MKV;
        const float* mixg = args.in[4]; const float* ffng = args.in[18];
        for (int it = gw; it < NITEMS; it += NGW) P0_ITEM(it);
        for (int m = 4 * gw; m < TOK; m += 4 * NGW) rows_to_bf16_ssq<4>(x + (size_t)m * DM, XB + (size_t)m * DM, SS0 + (size_t)m * 16, lane);
        for (int m = gw; m < BATCH * MEML; m += NGW) rows_to_bf16_ssq<1>(mem + (size_t)m * DM, MEMB + (size_t)m * DM, SSM + (size_t)m * 16, lane);
#if PROBE_P0 == 1
        for (int it = gw; it < I_TKT + I_TST + I_TYC + I_TCO; it += NGW) P0_ITEM(it);
#elif PROBE_P0 == 2
        for (int it = I_TKT + I_TST + I_TYC + I_TCO + gw; it < NITEMS; it += NGW) P0_ITEM(it);
#elif PROBE_P0 == 3
        for (int m = 4 * gw; m < TOK; m += 4 * NGW) rows_to_bf16_ssq<4>(x + (size_t)m * DM, XB + (size_t)m * DM, SS0 + (size_t)m * 16, lane);
        for (int m = gw; m < BATCH * MEML; m += NGW) rows_to_bf16_ssq<1>(mem + (size_t)m * DM, MEMB + (size_t)m * DM, SSM + (size_t)m * 16, lane);
#endif
    }
    SEAM(0);
    if (IN(1)) PH_REP(1) {
        if (rep_) xcd_barrier(bar);
        { pg8::Gemm g{XB, WIN0, TOK, 1024, 1024, 0}; pg8::StaticOrder S; S.init(TOK, 1024, G, bx);
          pg8::EpiProj E{SS0, Ub, 0, 3, 1, TOKW, 1.0f, QM, C2, TOK, nullptr, -1};
          pg8::gemm_phase<pg8::EpiProj, pg8::StaticOrder, true, true>(L + RING_OFF, g, S, E); }
    }
    SEAM(1);
    if (IN(2)) PH_REP(2) {
        if (rep_) xcd_barrier(bar);
        const int nS5 = (G == 256) ? 240 : G;
        if (bx < nS5) { for (int un = bx; un < NGRP * 16; un += nS5) s5_unit<false>(un >> 4, un & 15, Ub, Yb, S5TAB + (size_t)(un >> 4) * S5_TAB_BYTES, S5E, S5C, L + RING_OFF); }
        if (G != 256 || bx >= nS5) { pg8::Gemm g{MEMB, WMKV, BATCH * MEML, 512, 1024, 0}; pg8::StaticOrder S; S.init(BATCH * MEML, 512, (G == 256) ? 16 : G, (G == 256) ? bx - nS5 : bx);
          pg8::EpiProj E{SSM, MEMK, (size_t)(WS_MEMV - WS_MEMK) / 2, 1, 2, 256, 1.0f, nullptr, 1.0f, 0, nullptr, -1};
          pg8::gemm_phase<pg8::EpiProj, pg8::StaticOrder, true, true>(L + RING_OFF, g, S, E); }
    }
    SEAM(2);
    if (IN(3)) PH_REP(3) {
        if (rep_) xcd_barrier(bar);
        for (int un = vcu; un < NGRP * 16; un += G) s5_unit<true>(un >> 4, un & 15, Ub, Yb, S5TAB + (size_t)(un >> 4) * S5_TAB_BYTES, S5E, S5C, L + RING_OFF);
    }
    SEAM(3);
    if (IN(4)) PH_REP(4) {
        if (rep_) xcd_barrier(bar);
        pg8::Gemm g{Yb, WGLU, TOK, TOKW, TOKW, 1}; pg8::StaticOrder S; S.init(TOK, TOKW, G, bx);
        pg8::EpiGlu E{Yb, TOKW, args.in[15], MIX, 1024, TOK};
        pg8::gemm_phase<pg8::EpiGlu, pg8::StaticOrder, true, true>(L + RING_OFF, g, S, E);
        if (G == 256) { if (bx >= 128) MEMATTN_PHASE(bx - 128, 128); }
        else MEMATTN_PHASE(vcu, G);
    }
    SEAM(4);
    if (IN(5)) PH_REP(5) {
        if (rep_) xcd_barrier(bar);
        pg8::Gemm g{MIX, WOUT0, TOK, 1024, 1024, 0}; pg8::StaticOrder S; S.init(TOK, 1024, G, bx);
        pg8::EpiRes E{x, nullptr, XB, SSA};
        pg8::gemm_phase<pg8::EpiRes, pg8::StaticOrder, true, true>(L + RING_OFF, g, S, E);
    }
    SEAM(5);
    if (IN(6)) PH_REP(6) {
        if (rep_) xcd_barrier(bar);
        pg8::Gemm g{XB, WGU0, TOK, 2 * FFN, 1024, 0}; pg8::StaticOrder S; S.init(TOK, 2 * FFN, G, bx);
        pg8::EpiGU E{SSA, Hb, FFN};
        pg8::gemm_phase<pg8::EpiGU, pg8::StaticOrder, true, true>(L + RING_OFF, g, S, E);
    }
    SEAM(6);
    if (IN(7)) PH_REP(7) {
        if (rep_) xcd_barrier(bar);
        pg8::Gemm g{Hb, WDN0, TOK, 1024, FFN, 0}; pg8::StaticOrder S; S.init(TOK, 1024, G, bx);
        pg8::EpiRes E{nullptr, XB, XB, SSB};
        pg8::gemm_phase<pg8::EpiRes, pg8::StaticOrder, true, true>(L + RING_OFF, g, S, E);
    }
    SEAM(7);
    if (IN(8)) PH_REP(8) {
        if (rep_) xcd_barrier(bar);
        pg8::Gemm g{XB, WIN1, TOK, 2560, 1024, 0}; pg8::StaticOrder S; S.init(TOK, 2560, G, bx);
        pg8::EpiProj E{SSB, Q1, (size_t)(WS_K1 - WS_Q1) / 2, 3, 3, TOKW, C2, QM, C2, 0, KMP, 1};
        pg8::gemm_phase<pg8::EpiProj, pg8::StaticOrder, true, true>(L + RING_OFF, g, S, E);
    }
    SEAM(8);
    if (IN(9)) PH_REP(9) {
        if (rep_) xcd_barrier(bar);
        for (int p_ = vcu; p_ < BATCH * NHEAD * 8; p_ += G) { const int bh_ = p_ >> 3, sg_ = p_ & 7, b_ = bh_ / NHEAD, h_ = bh_ - b_ * NHEAD;
            const float slope2 = __builtin_amdgcn_exp2f(-8.0f * (float)(h_ + 1) / 12.0f) * LOG2E;
#pragma unroll 1
            for (int k_ = 0; k_ < 2; ++k_) { const int qb_ = k_ ? 15 - sg_ : sg_; const size_t qrow_ = (size_t)b_ * SEQ + (size_t)qb_ * 256, krow_ = (size_t)b_ * SEQ;
                attn_body::attn_unit<1, 8, 768, 768, 1024>((const attn_body::bf16*)(Q1 + qrow_ * TOKW + h_ * 64), (const attn_body::bf16*)(K1 + krow_ * TOKW + h_ * 64), (const attn_body::bf16*)(V1 + krow_ * TOKW + h_ * 64),
                    (attn_body::bf16*)(MIX + qrow_ * 1024 + h_ * 64), 4 * qb_ + 4, slope2, KMP + (size_t)bh_ * 1024, KMP + (size_t)(8 * 12 * 16 * 64) + (size_t)bh_ * 1024, qb_, (char*)lds + RING_OFF); } }
        MEMATTN_PHASE(vcu, G);
    }
    SEAM(9);
    if (IN(10)) PH_REP(10) {
        if (rep_) xcd_barrier(bar);
        pg8::Gemm g{MIX, WOUT1, TOK, 1024, 1024, 0}; pg8::StaticOrder S; S.init(TOK, 1024, G, bx);
        pg8::EpiRes E{nullptr, XB, XB, SSA};
        pg8::gemm_phase<pg8::EpiRes, pg8::StaticOrder, true, true>(L + RING_OFF, g, S, E);
    }
    SEAM(10);
    if (IN(11)) PH_REP(11) {
        if (rep_) xcd_barrier(bar);
        pg8::Gemm g{XB, WGU1, TOK, 2 * FFN, 1024, 0}; pg8::StaticOrder S; S.init(TOK, 2 * FFN, G, bx);
        pg8::EpiGU E{SSA, Hb, FFN};
        pg8::gemm_phase<pg8::EpiGU, pg8::StaticOrder, true, true>(L + RING_OFF, g, S, E);
    }
    SEAM(11);
    if (IN(12)) PH_REP(12) {
        if (rep_) xcd_barrier(bar);
        pg8::Gemm g{Hb, WDN1, TOK, 1024, FFN, 0}; pg8::StaticOrder S; S.init(TOK, 1024, G, bx);
        pg8::EpiRes E{nullptr, XB, XB, SSB};
        pg8::gemm_phase<pg8::EpiRes, pg8::StaticOrder, true, true>(L + RING_OFF, g, S, E);
    }
    SEAM(12);
    if (IN(13)) PH_REP(13) {
        if (rep_) xcd_barrier(bar);
        const float* gf = args.in[22];
        for (int m = gw; m < TOK; m += NGW) {
            const float rs = pg8::row_rstd(SSB, m);
            const GAS v4u* xr = (const GAS v4u*)(XB + (size_t)m * DM) + 2 * lane; GAS f32x4* orow = (GAS f32x4*)(out + (size_t)m * DM) + 4 * lane; const GAS f32x4* gp = (const GAS f32x4*)gf + 4 * lane;
            const v4u q0 = xr[0], q1 = xr[1];
            const f32x4 g0 = gp[0], g1 = gp[1], g2 = gp[2], g3 = gp[3];
            orow[0] = (f32x4){bflo(q0.x), bfhi(q0.x), bflo(q0.y), bfhi(q0.y)} * rs * g0; orow[1] = (f32x4){bflo(q0.z), bfhi(q0.z), bflo(q0.w), bfhi(q0.w)} * rs * g1;
            orow[2] = (f32x4){bflo(q1.x), bfhi(q1.x), bflo(q1.y), bfhi(q1.y)} * rs * g2; orow[3] = (f32x4){bflo(q1.z), bfhi(q1.z), bflo(q1.w), bfhi(q1.w)} * rs * g3;
        }
    }
#undef IN
#undef SEAM
}

extern "C" void kernel_launch(void* const* d_in, const int* in_sizes, int n_in, void* d_out, int out_size, void* d_ws, size_t ws_size, hipStream_t stream) {
    static int grid = 0;
    if (grid == 0) {
        if (n_in != 23 || out_size != TOK * DM || ws_size < WS_END) { fprintf(stderr, "kernel_launch: unexpected shapes: n_in %d out %d ws %zu\n", n_in, out_size, ws_size); grid = -1; return; }
        int dev = 0, cus = 0, per_cu = 0;
        if (hipGetDevice(&dev) != hipSuccess || hipDeviceGetAttribute(&cus, hipDeviceAttributeMultiprocessorCount, dev) != hipSuccess) { grid = -1; return; }
        if (hipFuncSetAttribute((const void*)mega_fwd, hipFuncAttributeMaxDynamicSharedMemorySize, LDS_BYTES) != hipSuccess) { fprintf(stderr, "kernel_launch: hipFuncSetAttribute failed\n"); grid = -1; return; }
        if (hipOccupancyMaxActiveBlocksPerMultiprocessor(&per_cu, (const void*)mega_fwd, NWAVES * 64, LDS_BYTES) != hipSuccess || per_cu < 1)
            fprintf(stderr, "kernel_launch: occupancy query reports %d workgroups per CU\n", per_cu);
        (void)hipGetLastError();
        grid = cus;
    }
    if (grid < 0) return;
    if (hipMemsetAsync((char*)d_ws + WS_CTL, 0, CTL_ZERO_BYTES, stream) != hipSuccess) return;
    Args a{};
    for (int i = 0; i < 23; ++i) a.in[i] = (const float*)d_in[i];
    a.out = (float*)d_out; a.ws = (unsigned char*)d_ws;
#if MK_ONE_LAUNCH
    a.ph_lo = 0; a.ph_hi = N_PHASES;
    hipLaunchKernelGGL(mega_fwd, dim3(grid), dim3(NWAVES * 64), LDS_BYTES, stream, a);
#else
    for (int p = 0; p < N_PHASES; ++p) { a.ph_lo = p; a.ph_hi = p + 1; hipLaunchKernelGGL(mega_fwd, dim3(grid), dim3(NWAVES * 64), LDS_BYTES, stream, a); }
#endif
}
```

```cpp
#include <hip/hip_runtime.h>
#include <hip/hip_bf16.h>
#include <cstdio>
#include <cstdint>
#include <cmath>
namespace pg8 {
#define PG8_LAS __attribute__((address_space(3)))
typedef unsigned short bf16_t;
typedef short bf16x8 __attribute__((ext_vector_type(8)));
typedef float f32x4 __attribute__((ext_vector_type(4)));
typedef unsigned u32x4 __attribute__((ext_vector_type(4)));
constexpr int BM = 256, BK = 64, HALF = 128, HTB = HALF * BK * 2  , STAGE_BYTES = 8 * HTB, NXCD = 8, WGM = 8;

__host__ __device__ __forceinline__ int lds_byte(int r, int c) { const int st = (r >> 4) * 2 + (c >> 5), rr = r & 15, cc = c & 31, ob = rr * 64 + cc * 2; return st * 1024 + (ob ^ (((ob >> 9) & 1) << 5)); }
__host__ __device__ __forceinline__ void stage_rc(int b, int& R, int& C) { const int st = b / 1024, sb = b % 1024, swz = sb ^ (((sb >> 9) & 1) << 5); R = (st >> 1) * 16 + swz / 64; C = (st & 1) * 32 + (swz % 64) / 2; }
__host__ __device__ __forceinline__ int perm32(int rho) { const int n = rho >> 4, i = rho & 15; return 8 * (i >> 2) + 4 * n + (i & 3); }

struct Unit { int pm, pn; };
struct Gemm { const bf16_t* A; const bf16_t* Bt; int M, N, K, amode; };

struct StaticOrder {
    int nM, nN, nwg, G, c;
    __host__ __device__ void init(int M, int N, int G_, int c_) { nM = M / BM; nN = N / BM; nwg = nM * nN; G = G_; c = c_; }
    __host__ __device__ bool next(int i, Unit& u) const {
        const long L = (long)i * G + c; if (L >= nwg) return false;
        int wgid = (int)L; { const int q = nwg / NXCD, r = nwg % NXCD, xcd = wgid % NXCD, off = wgid / NXCD; wgid = (xcd < r ? xcd * (q + 1) : r * (q + 1) + (xcd - r) * q) + off; }
        const int nig = WGM * nN, gid = wgid / nig, fm = gid * WGM, gsz = (nM - fm) < WGM ? (nM - fm) : WGM;
        u.pm = fm + ((wgid % nig) % gsz); u.pn = (wgid % nig) / gsz; return true;
    }
    __device__ __forceinline__ void a_ready(const Unit&) const {}
    __device__ __forceinline__ void done(const Unit&) const {}
};

__device__ __forceinline__ unsigned cvt_pk_bf16(float lo, float hi) { unsigned r; asm volatile("v_cvt_pk_bf16_f32 %0, %1, %2" : "=v"(r) : "v"(lo), "v"(hi)); return r; }
typedef float f32x2 __attribute__((ext_vector_type(2)));
typedef unsigned u32x2 __attribute__((ext_vector_type(2)));
constexpr float RMS_EPS = 1e-6f;
__device__ __forceinline__ float row_rstd(const float* ssq, int row) {
    const f32x4* p = (const f32x4*)(ssq + (size_t)row * 16);
    const f32x4 a = p[0], b = p[1], c = p[2], d = p[3];
    const float s = (((a[0] + a[1]) + (a[2] + a[3])) + ((b[0] + b[1]) + (b[2] + b[3]))) + (((c[0] + c[1]) + (c[2] + c[3])) + ((d[0] + d[1]) + (d[2] + d[3])));
    return __builtin_amdgcn_rsqf(s * (1.0f / 1024.0f) + RMS_EPS);
}
__device__ __forceinline__ float bf2f(unsigned short h) { return __uint_as_float(((unsigned)h) << 16); }
__device__ __forceinline__ float bflo(unsigned w) { return __uint_as_float(w << 16); }
__device__ __forceinline__ float bfhi(unsigned w) { return __uint_as_float(w & 0xffff0000u); }

__device__ __forceinline__ f32x2 gelu_pk(f32x2 v) {
    const f32x2 av = __builtin_elementwise_abs(v), d = av * 0.2316418882f + 1.0f;
    f32x2 t; t.x = __builtin_amdgcn_rcpf(d.x); t.y = __builtin_amdgcn_rcpf(d.y);
    f32x2 q = t * 0.5307027145f + (-0.7265760135f); q = q * t + 0.7107068705f; q = q * t + (-0.142248368f); q = q * t + 0.127414796f; q = q * t;
    const f32x2 s = (v * v) * (-0.72134752044f);
    f32x2 e; e.x = __builtin_amdgcn_exp2f(s.x); e.y = __builtin_amdgcn_exp2f(s.y);
    const f32x2 m = v * (q * e), r = v - m;
    f32x2 o; o.x = v.x < 0.f ? m.x : r.x; o.y = v.y < 0.f ? m.y : r.y; return o;
}

__device__ __forceinline__ void row_rstd4x8(const float* ssq, int row0, int fq, float sc, float (&rs)[2][4]) {
    f32x4 a[2][4];
#pragma unroll
    for (int ai = 0; ai < 2; ++ai)
#pragma unroll
        for (int m = 0; m < 4; ++m) a[ai][m] = *(const __attribute__((address_space(1))) f32x4*)(ssq + (size_t)(row0 + ai * HALF + m * 16) * 16 + 4 * fq);
#pragma unroll
    for (int ai = 0; ai < 2; ++ai)
#pragma unroll
        for (int m = 0; m < 4; ++m) { float s = (a[ai][m][0] + a[ai][m][1]) + (a[ai][m][2] + a[ai][m][3]); s += __shfl_xor(s, 16); s += __shfl_xor(s, 32);
            rs[ai][m] = __builtin_amdgcn_rsqf(s * (1.0f / 1024.0f) + RMS_EPS) * sc; }
}
struct EpiProj {
    static constexpr bool PERM = true, AFTER_DRAIN = false;
    const float* ssq; bf16_t* base; size_t seg_stride; int tps, nseg, ldc; float scale0; bf16_t* qm; float scale_qm; int gm_rows;
    float* kmp; int kseg;
    __device__ __forceinline__ void operator()(const f32x4 (&acc)[2][2][4][2], const Unit& u, int wr, int wc, int fr, int fq) const {
        const int seg = u.pn / tps, within = u.pn - seg * tps;
        bf16_t* o; int ld, colt; float sc;
        if (seg < nseg) { o = base + (size_t)seg * seg_stride; ld = ldc; colt = within * BM; sc = (seg == 0) ? scale0 : 1.0f; }
        else { o = qm; ld = 256; colt = 0; sc = scale_qm; }
        const int row0 = u.pm * BM + wr * 64 + fr, col0 = colt + wc * 32 + 8 * fq;
        f32x4 cs[2][2] = {{{0.f, 0.f, 0.f, 0.f}, {0.f, 0.f, 0.f, 0.f}}, {{0.f, 0.f, 0.f, 0.f}, {0.f, 0.f, 0.f, 0.f}}};
        float rsv[2][4]; row_rstd4x8(ssq, row0, fq, sc, rsv);
#pragma unroll
        for (int ai = 0; ai < 2; ++ai)
#pragma unroll
            for (int m = 0; m < 4; ++m) { const int row = row0 + ai * HALF + m * 16; const float rs = rsv[ai][m]; bf16_t* rowp = o + (size_t)row * ld + col0;
                const bool gm = (gm_rows != 0) && (seg < nseg);
#pragma unroll
                for (int bj = 0; bj < 2; ++bj) { const f32x4 v0 = acc[ai][bj][m][0] * rs, v1 = acc[ai][bj][m][1] * rs;
                    u32x4 w; w.x = cvt_pk_bf16(v0[0], v0[1]); w.y = cvt_pk_bf16(v0[2], v0[3]); w.z = cvt_pk_bf16(v1[0], v1[1]); w.w = cvt_pk_bf16(v1[2], v1[3]);
                    const int cc = col0 + bj * HALF;
                    bf16_t* dst = gm ? (o + ((size_t)(cc >> 4) * gm_rows + row) * 16 + (cc & 15)) : (rowp + bj * HALF);
                    *(u32x4*)dst = w; cs[bj][0] += v0; cs[bj][1] += v1; } }
        if (seg == kseg) {
#pragma unroll
            for (int bj = 0; bj < 2; ++bj)
#pragma unroll
                for (int n = 0; n < 2; ++n)
#pragma unroll
                    for (int e = 0; e < 4; ++e) { float s = cs[bj][n][e]; s += __shfl_xor(s, 1); s += __shfl_xor(s, 2); s += __shfl_xor(s, 4); s += __shfl_xor(s, 8); cs[bj][n][e] = s; }
            if (fr == 0) { const int bb = u.pm >> 4, blk = u.pm & 15;
#pragma unroll
                for (int bj = 0; bj < 2; ++bj) { const int cc = col0 + bj * HALF, h = cc >> 6, d = cc & 63;
                    float* kd = kmp + (size_t)wr * (8 * 12 * 16 * 64) + ((size_t)((bb * 12 + h) * 16 + blk)) * 64 + d;
                    *(__attribute__((address_space(1))) f32x4*)kd = cs[bj][0]; *(__attribute__((address_space(1))) f32x4*)(kd + 4) = cs[bj][1]; } }
        }
    }
};
struct EpiGlu {
    static constexpr bool PERM = true, AFTER_DRAIN = false;
    const bf16_t* Y; int ldy; const float* bias; bf16_t* mix; int ldm; int ygm_rows;
    __device__ __forceinline__ void operator()(const f32x4 (&acc)[2][2][4][2], const Unit& u, int wr, int wc, int fr, int fq) const {
        const int row0 = u.pm * BM + wr * 64 + fr, col0 = u.pn * BM + wc * 32 + 8 * fq;
        f32x4 bv[2][2];
#pragma unroll
        for (int bj = 0; bj < 2; ++bj)
#pragma unroll
            for (int n = 0; n < 2; ++n) bv[bj][n] = *(const f32x4*)(bias + col0 + bj * HALF + 4 * n);
#pragma unroll
        for (int ai = 0; ai < 2; ++ai) {
            u32x4 yq[4][2];
#pragma unroll
            for (int m = 0; m < 4; ++m) { const int row = row0 + ai * HALF + m * 16;
#pragma unroll
                for (int bj = 0; bj < 2; ++bj) { const int cc = col0 + bj * HALF;
                    yq[m][bj] = ygm_rows ? *(const __attribute__((address_space(1))) u32x4*)(Y + ((size_t)(cc >> 4) * ygm_rows + row) * 16 + (cc & 15)) : *(const __attribute__((address_space(1))) u32x4*)(Y + (size_t)row * ldy + cc); } }
#pragma unroll
            for (int m = 0; m < 4; ++m) { const int row = row0 + ai * HALF + m * 16;
#pragma unroll
                for (int bj = 0; bj < 2; ++bj) { const u32x4 yw = yq[m][bj];
                    const f32x4 z0 = acc[ai][bj][m][0] + bv[bj][0], z1 = acc[ai][bj][m][1] + bv[bj][1];
                    float t[8]; const float yv[8] = {bflo(yw.x), bfhi(yw.x), bflo(yw.y), bfhi(yw.y), bflo(yw.z), bfhi(yw.z), bflo(yw.w), bfhi(yw.w)};
#pragma unroll
                    for (int e = 0; e < 4; ++e) { t[e] = yv[e] * __builtin_amdgcn_rcpf(1.0f + __builtin_amdgcn_exp2f(-1.4426950408889634f * z0[e])); t[4 + e] = yv[4 + e] * __builtin_amdgcn_rcpf(1.0f + __builtin_amdgcn_exp2f(-1.4426950408889634f * z1[e])); }
                    u32x4 w; w.x = cvt_pk_bf16(t[0], t[1]); w.y = cvt_pk_bf16(t[2], t[3]); w.z = cvt_pk_bf16(t[4], t[5]); w.w = cvt_pk_bf16(t[6], t[7]);
                    *(u32x4*)(mix + (size_t)row * ldm + col0 + bj * HALF) = w; } } }
    }
};
struct EpiRes {
    static constexpr bool PERM = true, AFTER_DRAIN = false;
    const float* basef; const bf16_t* baseb; bf16_t* xb; float* ssq_out;
    __device__ __forceinline__ void operator()(const f32x4 (&acc)[2][2][4][2], const Unit& u, int wr, int wc, int fr, int fq) const {
        const int row0 = u.pm * BM + wr * 64 + fr, col0 = u.pn * BM + wc * 32 + 8 * fq;
        typedef __attribute__((address_space(1))) const f32x4 gf4; typedef __attribute__((address_space(1))) const u32x4 gu4;
        if (basef) {
            f32x4 bn[2][2];
#pragma unroll
            for (int bj = 0; bj < 2; ++bj)
#pragma unroll
                for (int n = 0; n < 2; ++n) bn[bj][n] = *(gf4*)(basef + (size_t)row0 * 1024 + col0 + bj * HALF + n * 4);
#pragma unroll
            for (int idx = 0; idx < 8; ++idx) { const int ai = idx >> 2, m = idx & 3; const int row = row0 + ai * HALF + m * 16; const size_t off = (size_t)row * 1024 + col0; float ss = 0.f;
                f32x4 bc[2][2];
#pragma unroll
                for (int bj = 0; bj < 2; ++bj)
#pragma unroll
                    for (int n = 0; n < 2; ++n) bc[bj][n] = bn[bj][n];
                if (idx + 1 < 8) { const int row2 = row0 + ((idx + 1) >> 2) * HALF + ((idx + 1) & 3) * 16;
#pragma unroll
                    for (int bj = 0; bj < 2; ++bj)
#pragma unroll
                        for (int n = 0; n < 2; ++n) bn[bj][n] = *(gf4*)(basef + (size_t)row2 * 1024 + col0 + bj * HALF + n * 4); }
#pragma unroll
                for (int bj = 0; bj < 2; ++bj) { const f32x4 o0 = bc[bj][0] + acc[ai][bj][m][0], o1 = bc[bj][1] + acc[ai][bj][m][1];
                    u32x4 w; w.x = cvt_pk_bf16(o0[0], o0[1]); w.y = cvt_pk_bf16(o0[2], o0[3]); w.z = cvt_pk_bf16(o1[0], o1[1]); w.w = cvt_pk_bf16(o1[2], o1[3]);
                    *(u32x4*)(xb + off + bj * HALF) = w;
                    ss += ((o0[0] * o0[0] + o0[1] * o0[1]) + (o0[2] * o0[2] + o0[3] * o0[3])) + ((o1[0] * o1[0] + o1[1] * o1[1]) + (o1[2] * o1[2] + o1[3] * o1[3])); }
                ss += __shfl_xor(ss, 16); ss += __shfl_xor(ss, 32);
                if (fq == 0) ssq_out[(size_t)row * 16 + u.pn * 4 + wc] = ss; }
        } else {
            u32x4 bq[2][4][2];
#pragma unroll
            for (int ai = 0; ai < 2; ++ai)
#pragma unroll
                for (int m = 0; m < 4; ++m)
#pragma unroll
                    for (int bj = 0; bj < 2; ++bj) bq[ai][m][bj] = *(gu4*)(baseb + (size_t)(row0 + ai * HALF + m * 16) * 1024 + col0 + bj * HALF);
#pragma unroll
            for (int ai = 0; ai < 2; ++ai)
#pragma unroll
                for (int m = 0; m < 4; ++m) { const int row = row0 + ai * HALF + m * 16; const size_t off = (size_t)row * 1024 + col0; float ss = 0.f;
#pragma unroll
                    for (int bj = 0; bj < 2; ++bj) { const u32x4 q = bq[ai][m][bj];
                        const f32x4 b0 = (f32x4){bflo(q.x), bfhi(q.x), bflo(q.y), bfhi(q.y)}, b1 = (f32x4){bflo(q.z), bfhi(q.z), bflo(q.w), bfhi(q.w)};
                        const f32x4 o0 = b0 + acc[ai][bj][m][0], o1 = b1 + acc[ai][bj][m][1];
                        u32x4 w; w.x = cvt_pk_bf16(o0[0], o0[1]); w.y = cvt_pk_bf16(o0[2], o0[3]); w.z = cvt_pk_bf16(o1[0], o1[1]); w.w = cvt_pk_bf16(o1[2], o1[3]);
                        *(u32x4*)(xb + off + bj * HALF) = w;
                        ss += ((o0[0] * o0[0] + o0[1] * o0[1]) + (o0[2] * o0[2] + o0[3] * o0[3])) + ((o1[0] * o1[0] + o1[1] * o1[1]) + (o1[2] * o1[2] + o1[3] * o1[3])); }
                    ss += __shfl_xor(ss, 16); ss += __shfl_xor(ss, 32);
                    if (fq == 0) ssq_out[(size_t)row * 16 + u.pn * 4 + wc] = ss; }
        }
    }
};
struct EpiGU {
    static constexpr bool PERM = true, AFTER_DRAIN = false;
    const float* ssq; bf16_t* H; int ldh;
    __device__ __forceinline__ void operator()(const f32x4 (&acc)[2][2][4][2], const Unit& u, int wr, int wc, int fr, int fq) const {
        const int row0 = u.pm * BM + wr * 64 + fr, col0 = u.pn * HALF + wc * 32 + 8 * fq;
        float rsv[2][4]; row_rstd4x8(ssq, row0, fq, 1.0f, rsv);
#pragma unroll
        for (int ai = 0; ai < 2; ++ai)
#pragma unroll
            for (int m = 0; m < 4; ++m) { const int row = row0 + ai * HALF + m * 16; const float rs = rsv[ai][m];
                float t[8];
#pragma unroll
                for (int n = 0; n < 2; ++n)
#pragma unroll
                    for (int e = 0; e < 4; ++e) { const float g = acc[ai][0][m][n][e] * rs, up = acc[ai][1][m][n][e] * rs;
                        t[4 * n + e] = g * __builtin_amdgcn_rcpf(1.0f + __builtin_amdgcn_exp2f(-1.4426950408889634f * g)) * up; }
                u32x4 w; w.x = cvt_pk_bf16(t[0], t[1]); w.y = cvt_pk_bf16(t[2], t[3]); w.z = cvt_pk_bf16(t[4], t[5]); w.w = cvt_pk_bf16(t[6], t[7]);
                *(u32x4*)(H + (size_t)row * ldh + col0) = w; }
    }
};

template <class Epi, class Sched, bool ALIGN_EPI = false, bool SP2 = false>
__device__ __forceinline__ void gemm_phase(PG8_LAS unsigned char* lds, const Gemm g, const Sched& S, const Epi& E) {
    const int tid = threadIdx.x, wid = __builtin_amdgcn_readfirstlane(tid >> 6), lane = tid & 63, wr = wid >> 2, wc = wid & 3, fr = lane & 15, fq = lane >> 4;
    const int K = g.K, nt = K / BK;
    unsigned voffA[2], voffB[2];
#pragma unroll
    for (int i = 0; i < 2; ++i) { int R, C; stage_rc(tid * 16 + i * 8192, R, C); const int Rb = Epi::PERM ? ((R & ~31) + perm32(R & 31)) : R;
        voffA[i] = g.amode ? (unsigned)((C >> 4) * g.M * 32 + R * 32 + (C & 15) * 2) : (unsigned)(R * K + C) * 2u; voffB[i] = (unsigned)(Rb * K + C) * 2u; }
    const size_t kstep = (size_t)(BK * 2);
    const size_t hstep = (size_t)HALF * K * 2;
    const size_t tstep = 2 * hstep;
    const size_t kstepA = g.amode ? (size_t)4 * g.M * 32 : kstep, hstepA = g.amode ? (size_t)HALF * 32 : hstep, tstepA = 2 * hstepA;
    const unsigned ldsw = (unsigned)wid * 1024u;
    const int aoff = lds_byte(wr * 64 + fr, fq * 8), boff = lds_byte(wc * 32 + fr, fq * 8);
#define PG8_SA(b, h) (((b) * 2 + (h)) * HTB)
#define PG8_SB(b, h) ((4 + (b) * 2 + (h)) * HTB)
#define PG8_STAGE(bufoff, gbase, voff) do { _Pragma("unroll") for (int _i = 0; _i < 2; ++_i) \
        __builtin_amdgcn_global_load_lds((const unsigned*)((const char*)(gbase) + (voff)[_i]), (PG8_LAS unsigned*)(lds + (bufoff) + ldsw + _i * 8192), 16, 0, 0); } while (0)
#define PG8_LDA(dst, b, h) do { _Pragma("unroll") for (int m = 0; m < 4; ++m) _Pragma("unroll") for (int k = 0; k < 2; ++k) dst[m][k] = *(const PG8_LAS bf16x8*)(lds + PG8_SA(b, h) + aoff + m * 2048 + k * 1024); } while (0)
#define PG8_LDB(dst, b, h) do { _Pragma("unroll") for (int n = 0; n < 2; ++n) _Pragma("unroll") for (int k = 0; k < 2; ++k) dst[n][k] = *(const PG8_LAS bf16x8*)(lds + PG8_SB(b, h) + boff + n * 2048 + k * 1024); } while (0)
#define PG8_MMA(ai, bj, At, Bt) do { __builtin_amdgcn_s_setprio(1); _Pragma("unroll") for (int m = 0; m < 4; ++m) _Pragma("unroll") for (int n = 0; n < 2; ++n) _Pragma("unroll") for (int k = 0; k < 2; ++k) \
        acc[ai][bj][m][n] = __builtin_amdgcn_mfma_f32_16x16x32_bf16(Bt[n][k], At[m][k], acc[ai][bj][m][n], 0, 0, 0); __builtin_amdgcn_s_setprio(0); } while (0)
#define PG8_WAIT_V(n) asm volatile("s_waitcnt vmcnt(" #n ")" ::: "memory")
#define PG8_WAIT_L(n) asm volatile("s_waitcnt lgkmcnt(" #n ")" ::: "memory")
#define PG8_BAR __builtin_amdgcn_s_barrier()
#define PG8_SCHED __builtin_amdgcn_sched_barrier(0)
    Unit cur, nxt; int ui = 0;
    if (!S.next(0, cur)) return;
    f32x4 acc[2][2][4][2];
#pragma unroll
    for (int a = 0; a < 2; ++a)
#pragma unroll
        for (int b = 0; b < 2; ++b)
#pragma unroll
            for (int m = 0; m < 4; ++m)
#pragma unroll
                for (int n = 0; n < 2; ++n) acc[a][b][m][n] = (f32x4){0.f, 0.f, 0.f, 0.f};
    bf16x8 At[4][2], B0[2][2], B1[2][2];
    const char* cA = (const char*)g.A + (size_t)cur.pm * tstepA; const char* cB = (const char*)g.Bt + (size_t)cur.pn * tstep;
    S.a_ready(cur);
    if constexpr (SP2) {
        PG8_STAGE(PG8_SB(0, 0), cB, voffB); PG8_STAGE(PG8_SB(0, 1), cB + hstep, voffB); PG8_STAGE(PG8_SA(0, 0), cA, voffA); PG8_STAGE(PG8_SA(0, 1), cA + hstepA, voffA);
        if (wr == 1) PG8_BAR;
        PG8_WAIT_V(2); PG8_BAR;
        PG8_STAGE(PG8_SB(1, 0), cB + kstep, voffB); PG8_STAGE(PG8_SA(1, 0), cA + kstepA, voffA); PG8_STAGE(PG8_SB(1, 1), cB + hstep + kstep, voffB);
        PG8_WAIT_V(6); PG8_BAR;
    } else {
        PG8_STAGE(PG8_SB(0, 0), cB, voffB); PG8_STAGE(PG8_SA(0, 0), cA, voffA); PG8_STAGE(PG8_SB(0, 1), cB + hstep, voffB); PG8_STAGE(PG8_SA(0, 1), cA + hstepA, voffA);
        if (wr == 1) PG8_BAR;
        PG8_WAIT_V(4); PG8_BAR;
        PG8_STAGE(PG8_SB(1, 0), cB + kstep, voffB); PG8_STAGE(PG8_SA(1, 0), cA + kstepA, voffA); PG8_STAGE(PG8_SB(1, 1), cB + hstep + kstep, voffB);
        PG8_WAIT_V(6); PG8_BAR;
    }
    for (;;) {
        const bool has_next = S.next(ui + 1, nxt);
        const char* nA = has_next ? (const char*)g.A + (size_t)nxt.pm * tstepA : cA; const char* nB = has_next ? (const char*)g.Bt + (size_t)nxt.pn * tstep : cB;
        for (int t = 0; t < nt; t += 2) {
            const bool last = (t == nt - 2);
            const char* a1 = cA + (size_t)(t + 1) * kstepA;
            const char* a2 = last ? nA : cA + (size_t)(t + 2) * kstepA; const char* b2 = last ? nB : cB + (size_t)(t + 2) * kstep;
            const char* a3 = a2 + kstepA; const char* b3 = b2 + kstep;
            if (last && has_next) S.a_ready(nxt);
            if constexpr (SP2) {
            PG8_LDB(B0, 0, 0); PG8_LDB(B1, 0, 1); PG8_SCHED; PG8_LDA(At, 0, 0); PG8_STAGE(PG8_SA(1, 1), a1 + hstepA, voffA);
            PG8_WAIT_V(8); PG8_WAIT_L(0); PG8_BAR; PG8_MMA(0, 0, At, B0); PG8_MMA(0, 1, At, B1); PG8_BAR; PG8_SCHED;
            PG8_LDA(At, 0, 1); PG8_STAGE(PG8_SB(0, 0), b2, voffB); PG8_STAGE(PG8_SB(0, 1), b2 + hstep, voffB); PG8_STAGE(PG8_SA(0, 0), a2, voffA);
            PG8_WAIT_V(8); PG8_WAIT_L(0); PG8_BAR; PG8_MMA(1, 0, At, B0); PG8_MMA(1, 1, At, B1); PG8_BAR; PG8_SCHED;
            PG8_LDB(B0, 1, 0); PG8_LDB(B1, 1, 1); PG8_SCHED; PG8_LDA(At, 1, 0); PG8_STAGE(PG8_SA(0, 1), a2 + hstepA, voffA);
            PG8_WAIT_V(8); PG8_WAIT_L(0); PG8_BAR; PG8_MMA(0, 0, At, B0); PG8_MMA(0, 1, At, B1); PG8_BAR; PG8_SCHED;
            PG8_LDA(At, 1, 1); PG8_STAGE(PG8_SB(1, 0), b3, voffB); PG8_STAGE(PG8_SB(1, 1), b3 + hstep, voffB); PG8_STAGE(PG8_SA(1, 0), a3, voffA);
            PG8_WAIT_V(8); PG8_WAIT_L(0); PG8_BAR; PG8_MMA(1, 0, At, B0); PG8_MMA(1, 1, At, B1); PG8_BAR; PG8_SCHED;
            } else {
            PG8_LDB(B0, 0, 0); PG8_SCHED; PG8_LDA(At, 0, 0); PG8_STAGE(PG8_SA(1, 1), a1 + hstepA, voffA);
            PG8_WAIT_L(8); PG8_BAR; PG8_WAIT_L(0); PG8_MMA(0, 0, At, B0); PG8_BAR; PG8_SCHED;
            PG8_LDB(B1, 0, 1); PG8_STAGE(PG8_SB(0, 0), b2, voffB);
            PG8_BAR; PG8_WAIT_L(0); PG8_MMA(0, 1, At, B1); PG8_BAR;
            PG8_LDA(At, 0, 1); PG8_STAGE(PG8_SA(0, 0), a2, voffA);
            PG8_BAR; PG8_WAIT_L(0); PG8_MMA(1, 0, At, B0); PG8_BAR; PG8_SCHED;
            PG8_STAGE(PG8_SB(0, 1), b2 + hstep, voffB);
            PG8_WAIT_V(6); PG8_BAR; PG8_MMA(1, 1, At, B1); PG8_BAR;
            PG8_LDB(B0, 1, 0); PG8_SCHED; PG8_LDA(At, 1, 0); PG8_STAGE(PG8_SA(0, 1), a2 + hstepA, voffA);
            PG8_WAIT_L(8); PG8_BAR; PG8_WAIT_L(0); PG8_MMA(0, 0, At, B0); PG8_BAR; PG8_SCHED;
            PG8_LDB(B1, 1, 1); PG8_STAGE(PG8_SB(1, 0), b3, voffB);
            PG8_BAR; PG8_WAIT_L(0); PG8_MMA(0, 1, At, B1); PG8_BAR;
            PG8_LDA(At, 1, 1); PG8_STAGE(PG8_SA(1, 0), a3, voffA);
            PG8_BAR; PG8_WAIT_L(0); PG8_MMA(1, 0, At, B0); PG8_BAR; PG8_SCHED;
            PG8_STAGE(PG8_SB(1, 1), b3 + hstep, voffB);
            PG8_WAIT_V(6); PG8_BAR; PG8_MMA(1, 1, At, B1); PG8_BAR;
            }
        }
        if constexpr (ALIGN_EPI) { if (wr == 0) PG8_BAR; }
        if constexpr (!Epi::AFTER_DRAIN) { E(acc, cur, wr, wc, fr, fq); S.done(cur); }
        if (!has_next) break;
#pragma unroll
        for (int a = 0; a < 2; ++a)
#pragma unroll
            for (int b = 0; b < 2; ++b)
#pragma unroll
                for (int m = 0; m < 4; ++m)
#pragma unroll
                    for (int n = 0; n < 2; ++n) acc[a][b][m][n] = (f32x4){0.f, 0.f, 0.f, 0.f};
        cur = nxt; cA = nA; cB = nB; ++ui;
        if constexpr (ALIGN_EPI) { if (wr == 1) PG8_BAR; }
    }
    PG8_WAIT_V(0);
    if constexpr (!ALIGN_EPI) { if (wr == 0) PG8_BAR; }
    PG8_BAR;
    if constexpr (Epi::AFTER_DRAIN) { E.fused(acc, cur, wr, wc, fr, fq, lds, wid, lane); S.done(cur); }
#undef PG8_SA
#undef PG8_SB
#undef PG8_STAGE
#undef PG8_LDA
#undef PG8_LDB
#undef PG8_MMA
#undef PG8_WAIT_V
#undef PG8_WAIT_L
#undef PG8_BAR
#undef PG8_SCHED
}
}
constexpr int NWAVES = 8;
constexpr int BATCH = 8, SEQ = 4096, DM = 1024, TOK = BATCH * SEQ;
constexpr int TOKW = 768, MEMW = 256, MEML = 256, NGRP = 48, NST = 64, GCH = 16, NHEAD = 12, MHEAD = 4, HD = 64, FFN = 2816, NBLK = 16, MBLK = 256;
constexpr float C2 = 0.125f * 1.4426950408889634f;
constexpr float LOG2E = 1.4426950408889634f;

constexpr size_t MiB = 1u << 20;
constexpr size_t WS_CTL = 0, CTL_ZERO_BYTES = 1 * MiB;
constexpr size_t WS_S5TAB = 9 * MiB, WS_S5E = 13 * MiB;
constexpr size_t WS_SS0 = 1 * MiB, WS_SSA = 3 * MiB, WS_SSB = 5 * MiB, WS_SSM = 7 * MiB, WS_KMEAN = 8 * MiB;
constexpr size_t WS_WIN0 = 16 * MiB, WS_WGLU = 18 * MiB, WS_WIN1 = 20 * MiB, WS_WOUT0 = 26 * MiB, WS_WOUT1 = 28 * MiB;
constexpr size_t WS_WGU0 = 30 * MiB, WS_WGU1 = 41 * MiB, WS_WDN0 = 52 * MiB, WS_WDN1 = 58 * MiB, WS_WMKV = 64 * MiB;
constexpr size_t WS_MEMB = 65 * MiB, WS_MEMK = 69 * MiB, WS_MEMV = 70 * MiB;
constexpr size_t WS_XB = 72 * MiB;
constexpr size_t WS_R = 136 * MiB;
constexpr size_t WS_U = WS_R, WS_Y = WS_R + 48 * MiB;
constexpr size_t WS_Q1 = WS_R, WS_K1 = WS_R + 48 * MiB, WS_V1 = WS_R + 96 * MiB;
constexpr size_t WS_QM = WS_R + 144 * MiB;
constexpr size_t WS_MIX = WS_R + 160 * MiB;
constexpr size_t WS_H = WS_R;
constexpr size_t WS_END = WS_R + 224 * MiB;
constexpr int CW_BAR = 4096;

constexpr int RING_OFF = 0, RING_BYTES = 147456;
constexpr int LDSCTL_OFF = RING_BYTES, MISC_OFF = LDSCTL_OFF + 320;
constexpr int LDS_BYTES = RING_BYTES + 1024;

#define GAS __attribute__((address_space(1)))
#define LAS __attribute__((address_space(3)))
typedef unsigned short bf16;
typedef unsigned v4u __attribute__((ext_vector_type(4)));
typedef unsigned v2u __attribute__((ext_vector_type(2)));
typedef float f32x4 __attribute__((ext_vector_type(4)));
typedef GAS unsigned gu32;
typedef float f32x2 __attribute__((ext_vector_type(2)));
#define RLX_AGENT __ATOMIC_RELAXED, __HIP_MEMORY_SCOPE_AGENT
#define LDS_WAIT() asm volatile("s_waitcnt lgkmcnt(0)" ::: "memory")
#define VM_WAIT() asm volatile("s_waitcnt vmcnt(0)" ::: "memory")
__device__ __forceinline__ unsigned f2bf(float f) { unsigned u = __builtin_bit_cast(unsigned, f); return (u + 0x7fffu + ((u >> 16) & 1u)) >> 16; }
__device__ __forceinline__ unsigned pk2(float lo, float hi) { return f2bf(lo) | (f2bf(hi) << 16); }
__device__ __forceinline__ float bf2f(unsigned short h) { return __uint_as_float(((unsigned)h) << 16); }
__device__ __forceinline__ float bflo(unsigned w) { return __uint_as_float(w << 16); }
__device__ __forceinline__ float bfhi(unsigned w) { return __uint_as_float(w & 0xffff0000u); }

#define XB_TMO      128
#define XB_XCNT(j)  (256  + 64 * (j))
#define XB_XSUB(j)  (1280 + 64 * (j))
#define XB_XGEN(j)  (2304 + 64 * (j))
#define XB_TOP      3328
#define XB_TOPGEN   3392
#define XCD_BAR_WORDS 3456
#define XB_SPIN_CAP (1u << 18)

__device__ __forceinline__ unsigned xb_ld(unsigned* p)              { return __hip_atomic_load(p, __ATOMIC_RELAXED, __HIP_MEMORY_SCOPE_AGENT); }
__device__ __forceinline__ unsigned xb_add(unsigned* p, unsigned v) { return __hip_atomic_fetch_add(p, v, __ATOMIC_RELAXED, __HIP_MEMORY_SCOPE_AGENT); }
__device__ __forceinline__ unsigned xb_xcc_id() { return (unsigned)__builtin_amdgcn_s_getreg((3 << 11) | 20) & 0xFu; }
#define XB_SPIN(cond, bar) do { unsigned _sp = 0; while (cond) { __builtin_amdgcn_s_sleep(1); \
    if ((++_sp & 255u) == 0u) { if (xb_ld(&(bar)[XB_TMO])) break; if (_sp > XB_SPIN_CAP) { atomicAdd(&(bar)[XB_TMO], 1u); break; } } } } while (0)

struct XcdBarrier {
    unsigned* bar; unsigned x;
    volatile LAS unsigned* st;
};

__device__ __forceinline__ XcdBarrier xcd_barrier_post(unsigned* bar, volatile LAS unsigned* st) {
    XcdBarrier b; b.bar = bar; b.x = xb_xcc_id(); b.st = st;
    if (threadIdx.x == 0) (void)xb_add(&bar[XB_XCNT(b.x)], 1u);
    return b;
}
__device__ __forceinline__ void xcd_barrier_complete(unsigned* bar, unsigned x, unsigned& nloc, unsigned& nx) {
    const unsigned G = gridDim.x * gridDim.y * gridDim.z;
    unsigned sum, cnt, mine, sp = 0u;
    for (;;) {
        sum = 0u; cnt = 0u; mine = 0u;
#pragma unroll
        for (unsigned j = 0; j < 16; ++j) { const unsigned c = xb_ld(&bar[XB_XCNT(j)]); sum += c; cnt += (c > 0u) ? 1u : 0u; mine = (j == x) ? c : mine; }
        if (sum == G) break;
        __builtin_amdgcn_s_sleep(1);
        if ((++sp & 255u) == 0u) { if (xb_ld(&bar[XB_TMO])) break; if (sp > XB_SPIN_CAP) { atomicAdd(&bar[XB_TMO], 1u); break; } }
    }
    nloc = mine > 0u ? mine : 1u; nx = cnt > 0u ? cnt : 1u;
}

__device__ __forceinline__ void xcd_barrier(const XcdBarrier& b) {
    asm volatile("s_waitcnt vmcnt(0)" ::: "memory");
    __syncthreads();
    if (threadIdx.x == 0) {
        unsigned* bar = b.bar;
        __builtin_amdgcn_s_waitcnt(0);
        unsigned nloc = b.st[0], nx = b.st[1];
        if (nloc == 0u) { xcd_barrier_complete(bar, b.x, nloc, nx); b.st[0] = nloc; b.st[1] = nx; }
        const unsigned old = xb_add(&bar[XB_XSUB(b.x)], 1u);
        const unsigned gen = old / nloc;
        if (old + 1u == (gen + 1u) * nloc) {
            __builtin_amdgcn_fence(__ATOMIC_RELEASE, "agent");
            asm volatile("s_waitcnt vmcnt(0)" ::: "memory");
            const unsigned og = xb_add(&bar[XB_TOP], 1u);
            const unsigned tg = og / nx;
            if (og + 1u == (tg + 1u) * nx) xb_add(&bar[XB_TOPGEN], 1u);
            else XB_SPIN(xb_ld(&bar[XB_TOPGEN]) == tg, bar);
            __builtin_amdgcn_fence(__ATOMIC_ACQUIRE, "agent");
            xb_add(&bar[XB_XGEN(b.x)], 1u);
            asm volatile("s_waitcnt vmcnt(0)" ::: "memory");
        } else {
            XB_SPIN(xb_ld(&bar[XB_XGEN(b.x)]) == gen, bar);
            __builtin_amdgcn_fence(__ATOMIC_ACQUIRE, "agent");
            asm volatile("s_waitcnt vmcnt(0)" ::: "memory");
        }
    }
    __syncthreads();
}
namespace attn_body {
using bf16=__hip_bfloat16;
using bf16x8=__attribute__((ext_vector_type(8)))short;
using s16x4=__attribute__((ext_vector_type(4)))short;
using f32x16=__attribute__((ext_vector_type(16)))float;
using u32x4=__attribute__((ext_vector_type(4)))unsigned;
constexpr int D=64;
constexpr int NW=8,QBLK=32,QB=QBLK*NW,KVBLK=64;
__device__ __forceinline__ int crow(int r,int hi){return (r&3)+8*(r>>2)+4*hi;}
#define SBAR() __builtin_amdgcn_sched_barrier(0)
__device__ __forceinline__ void cmask(f32x16&p0,f32x16&p1,int jb,int qrel,int hi){
  const float NEG=-INFINITY; int kb=64*jb+4*hi;
  #pragma unroll
  for(int r=0;r<16;++r){int kv=kb+(r&3)+8*(r>>2); if(kv>qrel)p0[r]=NEG; if(kv+32>qrel)p1[r]=NEG;}
}

constexpr int NSLOT=3, SLOTB=8192;
constexpr int LDS_K=0, LDS_V=NSLOT*SLOTB, LDS_WS=2*NSLOT*SLOTB, LDS_OST=LDS_WS+NW*64*4, LDS_BYTES=LDS_OST+NW*4096;
__device__ __forceinline__ void glds16(const void*gsrc,unsigned lds_dst){unsigned keep;
  asm volatile("s_mov_b32 %0, m0\n\ts_mov_b32 m0, %2\n\ts_nop 0\n\tglobal_load_lds_dwordx4 %1, off\n\ts_mov_b32 m0, %0":"=&s"(keep):"v"(gsrc),"s"(lds_dst):"memory");}
__device__ __forceinline__ float max3f(float a,float b,float c){float r;asm("v_max3_f32 %0, %1, %2, %3":"=v"(r):"v"(a),"v"(b),"v"(c));return r;}
__device__ __forceinline__ float max2f(float a,float b){float r;asm("v_max_f32_e32 %0, %1, %2":"=v"(r):"v"(a),"v"(b));return r;}
__device__ __forceinline__ float fadd_s(float a,float b){float r;asm("v_add_f32_e32 %0, %1, %2":"=v"(r):"v"(a),"v"(b));return r;}
__device__ __forceinline__ float fsub_s(float a,float b){float r;asm("v_sub_f32_e32 %0, %1, %2":"=v"(r):"v"(a),"v"(b));return r;}
typedef float f32x2_t __attribute__((ext_vector_type(2))); typedef float f32x4_t __attribute__((ext_vector_type(4))); typedef __bf16 bf16x2_t __attribute__((ext_vector_type(2)));
__device__ __forceinline__ unsigned cvtpk_s(float lo,float hi){f32x2_t v={lo,hi};bf16x2_t b=__builtin_convertvector(v,bf16x2_t);return __builtin_bit_cast(unsigned,b);}
#define WAIT_BAR(N) asm volatile("s_waitcnt vmcnt(" #N ") lgkmcnt(0)\n\ts_barrier":::"memory")

__device__ __forceinline__ void qkt(f32x16&p0,f32x16&p1,const char*Kslot,const bf16x8*qr,int r32,int hi){
  const char*kb=Kslot+hi*1024+r32*16;
  #pragma unroll
  for(int d0=0;d0<4;++d0){
    const bf16x8 b0=*reinterpret_cast<const bf16x8*>(kb+d0*2048);
    const bf16x8 b1=*reinterpret_cast<const bf16x8*>(kb+d0*2048+512);
    p0=__builtin_amdgcn_mfma_f32_32x32x16_bf16(b0,qr[d0],p0,0,0,0);p1=__builtin_amdgcn_mfma_f32_32x32x16_bf16(b1,qr[d0],p1,0,0,0);}
}
typedef __attribute__((address_space(3))) const char* lds_cptr;
typedef short v4i16_t __attribute__((ext_vector_type(4)));
__device__ __forceinline__ void kload8(bf16x8*kf,lds_cptr kp){
  kf[0]=*(const __attribute__((address_space(3))) bf16x8*)(kp);      kf[1]=*(const __attribute__((address_space(3))) bf16x8*)(kp+512);
  kf[2]=*(const __attribute__((address_space(3))) bf16x8*)(kp+2048); kf[3]=*(const __attribute__((address_space(3))) bf16x8*)(kp+2560);
  kf[4]=*(const __attribute__((address_space(3))) bf16x8*)(kp+4096); kf[5]=*(const __attribute__((address_space(3))) bf16x8*)(kp+4608);
  kf[6]=*(const __attribute__((address_space(3))) bf16x8*)(kp+6144); kf[7]=*(const __attribute__((address_space(3))) bf16x8*)(kp+6656);
}
__device__ __forceinline__ void kload2(bf16x8*kf,lds_cptr kp,int j){ kf[2*j]=*(const __attribute__((address_space(3))) bf16x8*)(kp+j*2048); kf[2*j+1]=*(const __attribute__((address_space(3))) bf16x8*)(kp+j*2048+512); }
__device__ __forceinline__ s16x4 vtr(lds_cptr p){ return __builtin_bit_cast(s16x4,__builtin_amdgcn_ds_read_tr16_b64_v4i16((__attribute__((address_space(3))) v4i16_t*)p)); }
__device__ __forceinline__ float rowmax(const f32x16&p0,const f32x16&p1){
  float a=max3f(p0[0],p0[1],p1[0]),b=max3f(p0[2],p0[3],p1[1]);a=max3f(a,p1[2],p1[3]);
  #pragma unroll
  for(int r=4;r<16;r+=4){a=max3f(a,p0[r],p0[r+1]);b=max3f(b,p0[r+2],p0[r+3]);a=max3f(a,p1[r],p1[r+1]);b=max3f(b,p1[r+2],p1[r+3]);}
  const float m=max2f(a,b);
  auto rr=__builtin_amdgcn_permlane32_swap(__float_as_uint(m),__float_as_uint(m),false,false);
  return max2f(__uint_as_float(rr[0]),__uint_as_float(rr[1]));
}
__device__ __forceinline__ void pv(f32x16*o,int vb,bf16x8 pa0,bf16x8 pa1,bf16x8 pa2,bf16x8 pa3){
  #pragma unroll
  for(int d0=0;d0<2;++d0){s16x4 lo[4],hi[4];
    #pragma unroll
    for(int ks=0;ks<4;++ks){
      asm volatile("ds_read_b64_tr_b16 %0,%1 offset:%c2":"=&v"(lo[ks]):"v"(vb),"i"(d0*4096+ks*1024):"memory");
      asm volatile("ds_read_b64_tr_b16 %0,%1 offset:%c2":"=&v"(hi[ks]):"v"(vb),"i"(d0*4096+ks*1024+512):"memory");}
    asm volatile("s_waitcnt lgkmcnt(0)":::"memory");SBAR();
    #define PK(k) (bf16x8){lo[k][0],lo[k][1],lo[k][2],lo[k][3],hi[k][0],hi[k][1],hi[k][2],hi[k][3]}
    o[d0]=__builtin_amdgcn_mfma_f32_32x32x16_bf16(pa0,PK(0),o[d0],0,0,0);
    o[d0]=__builtin_amdgcn_mfma_f32_32x32x16_bf16(pa1,PK(1),o[d0],0,0,0);
    o[d0]=__builtin_amdgcn_mfma_f32_32x32x16_bf16(pa2,PK(2),o[d0],0,0,0);
    o[d0]=__builtin_amdgcn_mfma_f32_32x32x16_bf16(pa3,PK(3),o[d0],0,0,0);
    #undef PK
  }
}

#ifndef ATTN_STORE16
#define ATTN_STORE16(p,v) (*(u32x4*)(p)=(v))
#endif
template<int MODE,int THRL,int QP,int KP,int OP> __device__ __forceinline__ void attn_unit(const bf16*Qw0,const bf16*__restrict__ Kh,const bf16*__restrict__ Vh,bf16*Ow0,const int NT,
                                                                                          const float slope2,const float*kms0,const float*kms1,const int qb,char*shm){
  int tid_=threadIdx.x; asm volatile("":"+v"(tid_));
  const int tid=tid_,lane=tid&63,r32=lane&31,hi=lane>>5; const int wid=__builtin_amdgcn_readfirstlane(tid>>6);
  const bf16*Qw=Qw0+(long)(wid*QBLK)*QP;
  const unsigned lds0=(unsigned)(uintptr_t)shm;
  float*wsf=(float*)(shm+LDS_WS)+wid*64;
  const bf16*ksrc=Kh+(long)lane*KP+wid*8;
  const bf16*vsrc=Vh+(long)(16*(wid&3)+(lane>>2))*KP+(wid>>2)*32+(lane&3)*8;
  const unsigned kdst=lds0+LDS_K+wid*1024, vdst=lds0+LDS_V+wid*1024;
  #define PT(t) ((MODE==0)?(NT-1-(t)):(((t)<NT-4)?(NT-5-(t)):(t)))
  #define DMA_K(t,slot) glds16(ksrc+(long)PT(t)*KVBLK*KP,(unsigned)__builtin_amdgcn_readfirstlane(kdst+(slot)))
  #define DMA_V(t,slot) glds16(vsrc+(long)PT(t)*KVBLK*KP,(unsigned)__builtin_amdgcn_readfirstlane(vdst+(slot)))
  const int vb0=(int)(lds0+LDS_V)+((lane>>4)&1)*32+(lane&3)*8+(4*hi+((lane&15)>>2))*64;
  const char*Kbase=shm+LDS_K; bf16x8 kf[8];
  const lds_cptr shm3=(lds_cptr)shm; const lds_cptr kp0=shm3+LDS_K+hi*1024+r32*16; const lds_cptr vp0=shm3+LDS_V+((lane>>4)&1)*32+(lane&3)*8+(4*hi+((lane&15)>>2))*64;
  DMA_K(0,0);DMA_V(0,0);DMA_K(1,SLOTB);
  bf16x8 qr[4];
  #pragma unroll
  for(int d0=0;d0<4;++d0)qr[d0]=*reinterpret_cast<const bf16x8*>(&Qw[(long)r32*QP+d0*16+hi*8]);
  unsigned selm=0xffffffffu;
  if constexpr(MODE==1){
    f32x16 G=f32x16{};
    #pragma unroll
    for(int d0=0;d0<4;++d0){
      bf16x8 ah=bf16x8{},al=bf16x8{};
      if(r32<16){ const float*p0_=kms0+r32*64+d0*16+hi*8,*p1_=kms1+r32*64+d0*16+hi*8;
        const f32x4_t s0=*reinterpret_cast<const f32x4_t*>(p0_)+*reinterpret_cast<const f32x4_t*>(p1_), s1=*reinterpret_cast<const f32x4_t*>(p0_+4)+*reinterpret_cast<const f32x4_t*>(p1_+4);
        const float km_[8]={s0[0],s0[1],s0[2],s0[3],s1[0],s1[1],s1[2],s1[3]};
        #pragma unroll
        for(int i_=0;i_<8;i_+=2){ const unsigned wh_=cvtpk_s(km_[i_],km_[i_+1]); const float r0_=km_[i_]-__uint_as_float(wh_<<16), r1_=km_[i_+1]-__uint_as_float(wh_&0xffff0000u); const unsigned wl_=cvtpk_s(r0_,r1_);
          ah[i_]=(short)(wh_&0xffffu); ah[i_+1]=(short)(wh_>>16); al[i_]=(short)(wl_&0xffffu); al[i_+1]=(short)(wl_>>16); } }
      G=__builtin_amdgcn_mfma_f32_32x32x16_bf16(ah,qr[d0],G,0,0,0); G=__builtin_amdgcn_mfma_f32_32x32x16_bf16(al,qr[d0],G,0,0,0);}
    float g[16];
    #pragma unroll
    for(int r=0;r<4;++r){ const float a=G[r],b=G[4+r]; const float oa=__shfl_xor(a,32),ob=__shfl_xor(b,32);
      g[r]=hi?oa:a; g[4+r]=hi?a:oa; g[8+r]=hi?ob:b; g[12+r]=hi?b:ob; }
    #pragma unroll
    for(int n=0;n<16;++n) if(n>=qb) g[n]=-1.0e30f;
    const int nsel=qb<3?qb:3; unsigned mask=0u;
    #pragma unroll
    for(int rr=0;rr<3;++rr){ float best=-3.0e38f; int bi=0;
      #pragma unroll
      for(int n=0;n<16;++n){ const bool c=!((mask>>n)&1u)&&g[n]>best; best=c?g[n]:best; bi=c?n:bi; }
      if(rr<nsel) mask|=1u<<bi; }
    selm=mask|(1u<<qb);
  }
  float mhat=0.f,l_reg=0.f;f32x16 o[2];o[0]=f32x16{};o[1]=f32x16{};
  const int qrel=wid*QBLK+r32;
  const float hb=(MODE==1)?slope2*(float)(4*hi):0.f, s32=(MODE==1)?32.f*slope2:0.f, s64=(MODE==1)?64.f*slope2:0.f;
  #define CBASE(b0_,b1_,t) float b0_=fsub_s(fadd_s(s64*(float)PT(t),hb),mhat); if(MODE==1){ if(!((selm>>(PT(t)>>2))&1u)) b0_=-3.0e38f; } const float b1_=b0_+s32
  #define CFILL(X,B,bb) do{ _Pragma("unroll") for(int i_=0;i_<4;++i_){ if(MODE==1) X[(B)+i_]=__builtin_fmaf(slope2,(float)((((B)+i_)&3)+8*(((B)+i_)>>2)),bb); else X[(B)+i_]=bb; } }while(0)
  #define CINIT(C0,C1,t) do{ CBASE(b0_,b1_,t); CFILL(C0,0,b0_);CFILL(C0,4,b0_);CFILL(C0,8,b0_);CFILL(C0,12,b0_);CFILL(C1,0,b1_);CFILL(C1,4,b1_);CFILL(C1,8,b1_);CFILL(C1,12,b1_); }while(0)
  #define CMASK(P0,P1,t) do{ if(MODE==1){ int jb_=(t)-(NT-4); if(jb_>=0)cmask(P0,P1,jb_,qrel,hi);} }while(0)
  bool resc=false;
  #define START(P0,P1) do{ const float rm=rowmax(P0,P1); resc=false; \
    { const float dl=__builtin_fmaxf(rm,-1000.f); mhat=fadd_s(mhat,dl); \
      _Pragma("unroll") for(int r=0;r<16;++r){P0[r]=fsub_s(P0[r],dl);P1[r]=fsub_s(P1[r],dl);} } \
    _Pragma("unroll") for(int r=0;r<16;++r)P0[r]=__builtin_amdgcn_exp2f(P0[r]); }while(0)
  #define RESC() do{ if(resc){ asm volatile("s_waitcnt lgkmcnt(0)":::"memory"); \
      _Pragma("unroll") for(int d_=0;d_<2;++d_) _Pragma("unroll") for(int r=0;r<16;++r)o[d_][r]*=wsf[crow(r,hi)]; } }while(0)
  f32x16 pA0,pA1,pB0,pB1;
  int sl_prev=0,sl_cur=0,sl_next=SLOTB;
  #define ROT() do{sl_prev=sl_cur;sl_cur=sl_next;sl_next=(sl_next==(NSLOT-1)*SLOTB)?0:sl_next+SLOTB;}while(0)
  DMA_K(2,2*SLOTB);
  WAIT_BAR(3);
  CINIT(pA0,pA1,0);
  qkt(pA0,pA1,Kbase,qr,r32,hi);asm volatile("s_nop 15\n\ts_nop 7":"+v"(pA0),"+v"(pA1));CMASK(pA0,pA1,0);
  START(pA0,pA1);
  _Pragma("unroll") for(int r=0;r<16;++r)pA1[r]=__builtin_amdgcn_exp2f(pA1[r]);
  WAIT_BAR(0);
  DMA_K(3,0);DMA_V(1,SLOTB);
  ROT();
  kload8(kf,kp0+sl_cur);
  WAIT_BAR(2);
  s16x4 vlo[8],vhi[8]; u32x4 pw0,pw1,pw2,pw3;
  #define PKW(P,B) cvtpk_s(P[B],P[B+1])
  #define PAF(k) __builtin_bit_cast(bf16x8,pw##k)
  #define VFR(i) (bf16x8){vlo[i][0],vlo[i][1],vlo[i][2],vlo[i][3],vhi[i][0],vhi[i][1],vhi[i][2],vhi[i][3]}
  #define PIN(x) asm volatile("":"+v"(x))
  #define MX3(a,b,c) __builtin_fmaxf(__builtin_fmaxf((a),(b)),(c))
  #define GAPA(MF,A0,A1,A2,A3,W0,W1,PW) do{ MF; sacc+=A0; sacc+=A1; sacc+=A2; sacc+=A3; PIN(sacc); W0; W1; PIN(PW); SBAR(); }while(0)
  #define EX(v) __builtin_amdgcn_exp2f(v)
  #define GAPB(MF,X,B,N,bb) do{ MF; X[B]=EX(X[B]); X[B+1]=EX(X[B+1]); X[B+2]=EX(X[B+2]); X[B+3]=EX(X[B+3]); PIN(X); CFILL(N,B,bb); PIN(N); SBAR(); }while(0)
  #define VRD(i) do{ vlo[i]=vtr(vp_+(((i)>>2)*4096+((i)&3)*1024)); vhi[i]=vtr(vp_+(((i)>>2)*4096+((i)&3)*1024+512)); }while(0)
  #define KRD(G,j) do{ if(G){ kload2(kf,kp0+sl_next,j); SBAR(); } }while(0)
  #define STEP(C0,C1,P0,P1,t,GK,GV,GL) do{ SBAR(); \
    const lds_cptr vp_=vp0+sl_prev; \
    VRD(0); SBAR(); float sacc=(P0[0]+P0[1]); \
    GAPA(C0=__builtin_amdgcn_mfma_f32_32x32x16_bf16(kf[0],qr[0],C0,0,0,0), P0[2],P0[3],P0[4],P0[5],     pw0[0]=PKW(P0,0), pw0[1]=PKW(P0,2), pw0); \
    VRD(4); SBAR(); GAPA(C1=__builtin_amdgcn_mfma_f32_32x32x16_bf16(kf[1],qr[0],C1,0,0,0), P0[6],P0[7],P0[8],P0[9],     pw0[2]=PKW(P0,4), pw0[3]=PKW(P0,6), pw0); \
    VRD(1); SBAR(); GAPA(C0=__builtin_amdgcn_mfma_f32_32x32x16_bf16(kf[2],qr[1],C0,0,0,0),   P0[10],P0[11],P0[12],P0[13], pw1[0]=PKW(P0,8), pw1[1]=PKW(P0,10), pw1); \
    VRD(5); SBAR(); GAPA(C1=__builtin_amdgcn_mfma_f32_32x32x16_bf16(kf[3],qr[1],C1,0,0,0),   P0[14],P0[15],P1[0],P1[1],   pw1[2]=PKW(P0,12),pw1[3]=PKW(P0,14), pw1); \
    VRD(2); SBAR(); GAPA(C0=__builtin_amdgcn_mfma_f32_32x32x16_bf16(kf[4],qr[2],C0,0,0,0),   P1[2],P1[3],P1[4],P1[5],     pw2[0]=PKW(P1,0), pw2[1]=PKW(P1,2), pw2); \
    VRD(6); SBAR(); GAPA(C1=__builtin_amdgcn_mfma_f32_32x32x16_bf16(kf[5],qr[2],C1,0,0,0),   P1[6],P1[7],P1[8],P1[9],     pw2[2]=PKW(P1,4), pw2[3]=PKW(P1,6), pw2); \
    VRD(3); SBAR(); GAPA(C0=__builtin_amdgcn_mfma_f32_32x32x16_bf16(kf[6],qr[3],C0,0,0,0),   P1[10],P1[11],P1[12],P1[13], pw3[0]=PKW(P1,8), pw3[1]=PKW(P1,10), pw3); \
    VRD(7); SBAR(); GAPA(C1=__builtin_amdgcn_mfma_f32_32x32x16_bf16(kf[7],qr[3],C1,0,0,0),   P1[14],P1[15],0.f,0.f,       pw3[2]=PKW(P1,12),pw3[3]=PKW(P1,14), pw3); \
    l_reg+=sacc; \
    if(GK){DMA_K((t)+3,sl_cur);} if(GV){DMA_V((t)+1,sl_next);} \
    CMASKX(C0,C1,t); \
    { float a=MX3(C0[0],C0[1],C1[0]),b=MX3(C0[2],C0[3],C1[1]); a=MX3(a,C1[2],C1[3]); \
      _Pragma("unroll") for(int r=4;r<16;r+=4){a=MX3(a,C0[r],C0[r+1]);b=MX3(b,C0[r+2],C0[r+3]);a=MX3(a,C1[r],C1[r+1]);b=MX3(b,C1[r+2],C1[r+3]);} \
      float rm=__builtin_fmaxf(a,b); { auto rr=__builtin_amdgcn_permlane32_swap(__float_as_uint(rm),__float_as_uint(rm),false,false); rm=__builtin_fmaxf(__uint_as_float(rr[0]),__uint_as_float(rr[1])); } \
      resc=false; \
      if(__builtin_expect(__any(rm>(float)THRL),0)){ const float dl=__builtin_fmaxf(rm,0.f); mhat+=dl; \
        _Pragma("unroll") for(int r=0;r<16;++r){C0[r]-=dl;C1[r]-=dl;} \
        const float f=__builtin_amdgcn_exp2f(-dl); l_reg*=f; if(hi==0)wsf[r32]=f; resc=true; } } \
    CBASE(n0_,n1_,(t)+1);                                   \
    SBAR(); \
    GAPB(o[0]=__builtin_amdgcn_mfma_f32_32x32x16_bf16(PAF(0),VFR(0),o[0],0,0,0), C0,0, P0,n0_); \
    GAPB(o[1]=__builtin_amdgcn_mfma_f32_32x32x16_bf16(PAF(0),VFR(4),o[1],0,0,0), C0,4, P0,n0_); \
    KRD(GL,0); GAPB(o[0]=__builtin_amdgcn_mfma_f32_32x32x16_bf16(PAF(1),VFR(1),o[0],0,0,0), C0,8, P0,n0_); \
    KRD(GL,1); GAPB(o[1]=__builtin_amdgcn_mfma_f32_32x32x16_bf16(PAF(1),VFR(5),o[1],0,0,0), C0,12, P0,n0_); \
    KRD(GL,2); GAPB(o[0]=__builtin_amdgcn_mfma_f32_32x32x16_bf16(PAF(2),VFR(2),o[0],0,0,0), C1,0, P1,n1_); \
    KRD(GL,3); GAPB(o[1]=__builtin_amdgcn_mfma_f32_32x32x16_bf16(PAF(2),VFR(6),o[1],0,0,0), C1,4, P1,n1_); \
    GAPB(o[0]=__builtin_amdgcn_mfma_f32_32x32x16_bf16(PAF(3),VFR(3),o[0],0,0,0), C1,8, P1,n1_); \
    GAPB(o[1]=__builtin_amdgcn_mfma_f32_32x32x16_bf16(PAF(3),VFR(7),o[1],0,0,0), C1,12, P1,n1_); \
    }while(0)
  int t=1;
  CINIT(pB0,pB1,1);
  #define ENDW(tt) do{ if((tt)+3<NT){WAIT_BAR(2);} else if((tt)+2<NT){WAIT_BAR(1);} else {WAIT_BAR(0);} }while(0)
  #define CMASKX(P0,P1,t) do{ asm volatile("; head step (masked)"); CMASK(P0,P1,t); }while(0)
  for(;t+1<NT&&t<5;t+=2){
    STEP(pB0,pB1,pA0,pA1,t,(t+3<NT),(t+1<NT),(t+1<NT));       ENDW(t);   RESC(); ROT();
    STEP(pA0,pA1,pB0,pB1,t+1,(t+4<NT),(t+2<NT),(t+2<NT));     ENDW(t+1); RESC(); ROT();
  }
  #undef CMASKX
  #define CMASKX(P0,P1,t) do{ asm volatile("; steady step (no mask)"); }while(0)
  for(;t+5<NT;t+=2){
    STEP(pB0,pB1,pA0,pA1,t,true,true,true);     WAIT_BAR(2); RESC(); ROT();
    STEP(pA0,pA1,pB0,pB1,t+1,true,true,true);   WAIT_BAR(2); RESC(); ROT();
  }
  #undef CMASKX
  #define CMASKX(P0,P1,t) do{ asm volatile("; tail step (masked)"); CMASK(P0,P1,t); }while(0)
  for(;t+1<NT;t+=2){
    STEP(pB0,pB1,pA0,pA1,t,(t+3<NT),(t+1<NT),(t+1<NT));       ENDW(t);   RESC(); ROT();
    STEP(pA0,pA1,pB0,pB1,t+1,(t+4<NT),(t+2<NT),(t+2<NT));     ENDW(t+1); RESC(); ROT();
  }
  STEP(pB0,pB1,pA0,pA1,NT-1,false,false,false); RESC();
  { float sacc=pB0[0]+pB0[1]; _Pragma("unroll") for(int r=2;r<16;++r)sacc+=pB0[r]; _Pragma("unroll") for(int r=0;r<16;++r)sacc+=pB1[r]; l_reg+=sacc;
    pw0=(u32x4){PKW(pB0,0),PKW(pB0,2),PKW(pB0,4),PKW(pB0,6)};pw1=(u32x4){PKW(pB0,8),PKW(pB0,10),PKW(pB0,12),PKW(pB0,14)};pw2=(u32x4){PKW(pB1,0),PKW(pB1,2),PKW(pB1,4),PKW(pB1,6)};pw3=(u32x4){PKW(pB1,8),PKW(pB1,10),PKW(pB1,12),PKW(pB1,14)};
    SBAR(); pv(o,vb0+sl_cur,PAF(0),PAF(1),PAF(2),PAF(3)); }
  #undef PKW
  #undef PAF
  #undef VFR
  #undef PIN
  #undef MX3
  #undef GAPA
  #undef GAPB
  #undef EX
  #undef VRD
  #undef KRD
  #undef STEP
  #undef ENDW
  #undef CMASKX
  {auto rr=__builtin_amdgcn_permlane32_swap(__float_as_uint(l_reg),__float_as_uint(l_reg),false,false);l_reg=__uint_as_float(rr[0])+__uint_as_float(rr[1]);}
  if(hi==0)wsf[32+r32]=l_reg;asm volatile("s_waitcnt lgkmcnt(0)":::"memory");
  float rli[16];
  #pragma unroll
  for(int r=0;r<16;++r)rli[r]=__builtin_amdgcn_rcpf(wsf[32+crow(r,hi)]);
  bf16*Ow=Ow0+(long)(wid*QBLK)*OP;
  { bf16*stg=(bf16*)(shm+LDS_OST)+wid*2048;
    #pragma unroll
    for(int r=0;r<16;++r){const int orow=crow(r,hi);
      #pragma unroll
      for(int d0=0;d0<2;++d0)stg[orow*64+d0*32+r32]=__float2bfloat16(o[d0][r]*rli[r]);}
    asm volatile("s_waitcnt lgkmcnt(0)":::"memory");
    #pragma unroll
    for(int i=0;i<4;++i){const int row=i*8+(lane>>3),ch=lane&7; const u32x4 v=*(const u32x4*)(stg+row*64+ch*8); ATTN_STORE16(Ow+(long)row*OP+ch*8,v);} }
  asm volatile("s_waitcnt lgkmcnt(0)\n\ts_barrier":::"memory");
  #undef DMA_K
  #undef DMA_V
  #undef CMASK
  #undef CINIT
  #undef CBASE
  #undef CFILL
  #undef PT
  #undef START
  #undef RESC
  #undef ROT
}
constexpr int ATTN_LDS_BYTES=LDS_BYTES;
#undef SBAR
#undef WAIT_BAR
}
__device__ __forceinline__ float wave_sum(float v) {
#pragma unroll
    for (int o = 1; o < 64; o <<= 1) v += __shfl_xor(v, o);
    return v;
}
__device__ __forceinline__ float wave_max(float v) {
#pragma unroll
    for (int o = 1; o < 64; o <<= 1) v = fmaxf(v, __shfl_xor(v, o));
    return v;
}
__device__ __forceinline__ int opaque_zero() { int z; asm volatile("v_mov_b32 %0, 0" : "=v"(z)); return z; }

__device__ __forceinline__ void p0_transpose_item(const float* W, int K, int N, bf16* WT, int dest_row0, int k0, int n0, const float* gk, LAS float* scr, int lane) {
    float wv[32];
#pragma unroll
    for (int i = 0; i < 32; ++i) { const int kk = 2 * i + (lane >> 5); wv[i] = W[(size_t)(k0 + kk) * N + n0 + (lane & 31)]; }
    if (gk) {
#pragma unroll
        for (int i = 0; i < 32; ++i) wv[i] *= gk[k0 + 2 * i + (lane >> 5)]; }
#pragma unroll
    for (int i = 0; i < 32; ++i) { const int kk = 2 * i + (lane >> 5); scr[kk * 33 + (lane & 31)] = wv[i]; }
    LDS_WAIT(); asm volatile("" ::: "memory");
    const int c = lane & 7;
#pragma unroll
    for (int j = 0; j < 4; ++j) { const int n = (lane >> 3) + 8 * j; const LAS float* s = scr + (8 * c) * 33 + n;
        v4u o; o.x = pk2(s[0 * 33], s[1 * 33]); o.y = pk2(s[2 * 33], s[3 * 33]); o.z = pk2(s[4 * 33], s[5 * 33]); o.w = pk2(s[6 * 33], s[7 * 33]);
        *(GAS v4u*)(WT + (size_t)(dest_row0 + n) * K + k0 + 8 * c) = o; }
    LDS_WAIT(); asm volatile("" ::: "memory");
}
__device__ __forceinline__ void p0_matrix_item(const float* W, int K, int N, bf16* WT, const float* gk, int mode, int item, LAS float* scr, int lane) {
    const int nblk = N / 32, kb = item / nblk, nb = item - kb * nblk, k0 = 64 * kb, n0 = 32 * nb;
    const int dr = (mode == 0) ? n0 : (256 * (n0 >> 7) + (n0 & 127) + (mode == 2 ? 128 : 0));
    p0_transpose_item(W, K, N, WT, dr, k0, n0, gk, scr, lane);
}
template <int NR>
__device__ __forceinline__ void rows_to_bf16_ssq(const float* xrow, bf16* orow, float* ssq16, int lane) {
    f32x4 v[NR][4];
#pragma unroll
    for (int r = 0; r < NR; ++r) { const GAS f32x4* xr = (const GAS f32x4*)(xrow + (size_t)r * 1024) + lane;
#pragma unroll
        for (int j = 0; j < 4; ++j) v[r][j] = xr[64 * j]; }
#pragma unroll
    for (int r = 0; r < NR; ++r) { float s = 0.f;
#pragma unroll
        for (int j = 0; j < 4; ++j) s += (v[r][j].x * v[r][j].x + v[r][j].y * v[r][j].y) + (v[r][j].z * v[r][j].z + v[r][j].w * v[r][j].w);
        s = wave_sum(s);
        GAS unsigned long long* o8 = (GAS unsigned long long*)(orow + (size_t)r * 1024) + lane;
#pragma unroll
        for (int j = 0; j < 4; ++j) o8[64 * j] = (unsigned long long)pk2(v[r][j].x, v[r][j].y) | ((unsigned long long)pk2(v[r][j].z, v[r][j].w) << 32);
        if (lane < 16) ssq16[r * 16 + lane] = (lane == 0) ? s : 0.f; }
}

__device__ __forceinline__ void s5_naive_unit(int b, int g, const bf16* U, bf16* Y, const float* lam_re, const float* lam_im, const float* log_dt, const float* b_re, const float* b_im,
                                              const float* c_re, const float* c_im, const float* dvec, int lane) {
    const int p = lane;
    const float lr = lam_re[g * 64 + p], li = lam_im[g * 64 + p], dt = expf(log_dt[g]);
    const float mag = expf(lr * dt), ar = mag * cosf(li * dt), ai = mag * sinf(li * dt);
    const float den = lr * lr + li * li, nr = ar - 1.0f, fr = (nr * lr + ai * li) / den, fi = (ai * lr - nr * li) / den;
    float bbr[16], bbi[16], cr[16], ci[16];
#pragma unroll
    for (int c = 0; c < 16; ++c) { const float br = b_re[((size_t)g * 64 + p) * 16 + c], bi = b_im[((size_t)g * 64 + p) * 16 + c]; bbr[c] = fr * br - fi * bi; bbi[c] = fr * bi + fi * br;
        cr[c] = c_re[((size_t)g * 16 + c) * 64 + p]; ci[c] = c_im[((size_t)g * 16 + c) * 64 + p]; }
    const int ch = ((lane & 1) << 3) | ((lane & 2) << 1) | ((lane & 4) >> 1) | ((lane & 8) >> 3);
    const float dch = dvec[16 * g + ch];
    const int z0 = opaque_zero();
    constexpr int TP = 16;
    const bf16* up = U + ((size_t)g * TOK + (size_t)b * SEQ) * 16 + z0;
    bf16* yp = Y + ((size_t)g * TOK + (size_t)b * SEQ) * 16 + ch;
    float xr = 0.f, xi = 0.f;
#pragma unroll 2
    for (int s = 0; s < SEQ; ++s) {
        const v4u w0 = *(const GAS v4u*)(up + (size_t)s * TP), w1 = *(const GAS v4u*)(up + (size_t)s * TP + 8);
        const float uch = bf2f(up[(size_t)s * TP + ch]);
        const float uu[16] = {bflo(w0.x), bfhi(w0.x), bflo(w0.y), bfhi(w0.y), bflo(w0.z), bfhi(w0.z), bflo(w0.w), bfhi(w0.w), bflo(w1.x), bfhi(w1.x), bflo(w1.y), bfhi(w1.y), bflo(w1.z), bfhi(w1.z), bflo(w1.w), bfhi(w1.w)};
        float bur = 0.f, bui = 0.f;
#pragma unroll
        for (int c = 0; c < 16; ++c) { bur += bbr[c] * uu[c]; bui += bbi[c] * uu[c]; }
        const float nxr = ar * xr - ai * xi + bur, nxi = ar * xi + ai * xr + bui; xr = nxr; xi = nxi;
        float v[16];
#pragma unroll
        for (int c = 0; c < 16; ++c) v[c] = cr[c] * xr - ci[c] * xi;
        float w[8], x4[4], x2[2], z;
        { const bool bit = lane & 1;
#pragma unroll
          for (int j = 0; j < 8; ++j) { const float send = bit ? v[j] : v[j + 8], keep = bit ? v[j + 8] : v[j]; w[j] = keep + __shfl_xor(send, 1); } }
        { const bool bit = lane & 2;
#pragma unroll
          for (int j = 0; j < 4; ++j) { const float send = bit ? w[j] : w[j + 4], keep = bit ? w[j + 4] : w[j]; x4[j] = keep + __shfl_xor(send, 2); } }
        { const bool bit = lane & 4;
#pragma unroll
          for (int j = 0; j < 2; ++j) { const float send = bit ? x4[j] : x4[j + 2], keep = bit ? x4[j + 2] : x4[j]; x2[j] = keep + __shfl_xor(send, 4); } }
        { const bool bit = lane & 8; const float send = bit ? x2[0] : x2[1], keep = bit ? x2[1] : x2[0]; z = keep + __shfl_xor(send, 8); }
        z += __shfl_xor(z, 16); z += __shfl_xor(z, 32);
        const float yv = z + dch * uch;
        const float ge = 0.5f * yv * (1.0f + erff(yv * 0.70710678118654752f));
        if (lane < 16) yp[(size_t)s * TP] = (bf16)f2bf(ge);
    }
}

__device__ __forceinline__ void memattn_naive_unit(int tok, int h, const bf16* QM, const bf16* memk, const bf16* memv, bf16* mix, LAS float* ps, int lane) {
    const int b = tok >> 12; const int z0 = opaque_zero();
    const float qv = bf2f(QM[(size_t)tok * 256 + h * 64 + lane]);
    float q[64];
#pragma unroll
    for (int d = 0; d < 64; ++d) q[d] = __shfl(qv, d);
    float sc[4];
#pragma unroll
    for (int i = 0; i < 4; ++i) { const int j = lane + 64 * i; const GAS v4u* kr = (const GAS v4u*)(memk + ((size_t)(b * 256 + j)) * 256 + h * 64 + z0); float a = 0.f;
#pragma unroll
        for (int c = 0; c < 8; ++c) { const v4u w = kr[c]; a += q[8 * c] * bflo(w.x) + q[8 * c + 1] * bfhi(w.x) + q[8 * c + 2] * bflo(w.y) + q[8 * c + 3] * bfhi(w.y) + q[8 * c + 4] * bflo(w.z) + q[8 * c + 5] * bfhi(w.z) + q[8 * c + 6] * bflo(w.w) + q[8 * c + 7] * bfhi(w.w); }
        sc[i] = a; }
    const float m = wave_max(fmaxf(fmaxf(sc[0], sc[1]), fmaxf(sc[2], sc[3])));
    float l = 0.f;
#pragma unroll
    for (int i = 0; i < 4; ++i) { const float pe = __builtin_amdgcn_exp2f(sc[i] - m); l += pe; ps[lane + 64 * i] = pe; }
    l = wave_sum(l);
    LDS_WAIT(); asm volatile("" ::: "memory");
    float o = 0.f; const bf16* vp = memv + (size_t)(b * 256) * 256 + h * 64 + lane;
#pragma unroll 8
    for (int j = 0; j < 256; ++j) o += ps[j] * bf2f(vp[(size_t)j * 256]);
    mix[(size_t)tok * 1024 + 768 + h * 64 + lane] = (bf16)f2bf(o / l);
    LDS_WAIT(); asm volatile("" ::: "memory");
}

__device__ __forceinline__ float dot64_bf16(const float (&q)[64], const GAS v4u* kr) {
    float a = 0.f;
#pragma unroll
    for (int c = 0; c < 8; ++c) { const v4u w = kr[c]; a += q[8 * c] * bflo(w.x) + q[8 * c + 1] * bfhi(w.x) + q[8 * c + 2] * bflo(w.y) + q[8 * c + 3] * bfhi(w.y) + q[8 * c + 4] * bflo(w.z) + q[8 * c + 5] * bfhi(w.z) + q[8 * c + 6] * bflo(w.w) + q[8 * c + 7] * bfhi(w.w); }
    return a;
}
__device__ __forceinline__ void moba_naive_unit(int tok, int h, const bf16* Q1, const bf16* K1, const bf16* V1, const float* KMEAN, bf16* mix, LAS float* ps, int lane) {
    const int b = tok >> 12, s = tok & (SEQ - 1), qb = s >> 8; const int z0 = opaque_zero();
    const float qv = bf2f(Q1[(size_t)tok * TOKW + h * 64 + lane]);
    float q[64];
#pragma unroll
    for (int d = 0; d < 64; ++d) q[d] = __shfl(qv, d);
    float gate = -1e30f;
    { const int n = lane & 15; const GAS f32x4* km = (const GAS f32x4*)(KMEAN + ((size_t)((b * NHEAD + h) * NBLK + n)) * 64 + z0); float a = 0.f;
#pragma unroll
      for (int c = 0; c < 16; ++c) { const f32x4 w = km[c]; a += q[4 * c] * w.x + q[4 * c + 1] * w.y + q[4 * c + 2] * w.z + q[4 * c + 3] * w.w; }
      if (n < qb) gate = a; }
    float g[16];
#pragma unroll
    for (int n = 0; n < 16; ++n) g[n] = __shfl(gate, n);
    const int nsel = qb < 3 ? qb : 3;
    unsigned mask = 0u;
#pragma unroll
    for (int r = 0; r < 3; ++r) { float best = -3.0e38f; int bi = 0;
#pragma unroll
        for (int n = 0; n < 16; ++n) { const bool c = !((mask >> n) & 1u) && g[n] > best; best = c ? g[n] : best; bi = c ? n : bi; }
        if (r < nsel) mask |= 1u << bi; }
    int blk0 = 0, blk1 = 0, blk2 = 0, cnt = 0;
#pragma unroll
    for (int n = 0; n < 16; ++n) if ((mask >> n) & 1u) { if (cnt == 0) blk0 = n; else if (cnt == 1) blk1 = n; else blk2 = n; ++cnt; }
    const int nslots = nsel + 1;
    const float slope = __builtin_amdgcn_exp2f(-8.0f * (float)(h + 1) / 12.0f) * LOG2E;
    const bf16* kh = K1 + (size_t)b * SEQ * TOKW + h * 64 + z0;
    float mx = -3.0e38f;
#pragma unroll
    for (int sl = 0; sl < 4; ++sl) if (sl < nslots) {
        const int blk = (sl == nsel) ? qb : (sl == 0 ? blk0 : (sl == 1 ? blk1 : blk2));
#pragma unroll
        for (int i = 0; i < 4; ++i) { const int j = lane + 64 * i, pos = blk * 256 + j;
            float a = dot64_bf16(q, (const GAS v4u*)(kh + (size_t)pos * TOKW)) + slope * (float)(pos - s);
            if (pos > s) a = -3.0e38f;
            ps[sl * 256 + j] = a; mx = fmaxf(mx, a); } }
    mx = wave_max(mx);
    LDS_WAIT(); asm volatile("" ::: "memory");
    float l = 0.f;
#pragma unroll
    for (int sl = 0; sl < 4; ++sl) if (sl < nslots) {
#pragma unroll
        for (int i = 0; i < 4; ++i) { const int j = lane + 64 * i; const float a = ps[sl * 256 + j]; const float pe = (a < -1.0e37f) ? 0.f : __builtin_amdgcn_exp2f(a - mx); l += pe; ps[sl * 256 + j] = pe; } }
    l = wave_sum(l);
    LDS_WAIT(); asm volatile("" ::: "memory");
    float o = 0.f; const bf16* vh = V1 + (size_t)b * SEQ * TOKW + h * 64 + lane;
#pragma unroll
    for (int sl = 0; sl < 4; ++sl) if (sl < nslots) {
        const int blk = (sl == nsel) ? qb : (sl == 0 ? blk0 : (sl == 1 ? blk1 : blk2));
        const bf16* vp = vh + (size_t)(blk * 256) * TOKW;
#pragma unroll 8
        for (int j = 0; j < 256; ++j) o += ps[sl * 256 + j] * bf2f(vp[(size_t)j * TOKW]); }
    mix[(size_t)tok * 1024 + h * 64 + lane] = (bf16)f2bf(o / l);
    LDS_WAIT(); asm volatile("" ::: "memory");
}

constexpr int S5_PITCH = 272;
constexpr int S5_WST = 0, S5_WYC = 128 * S5_PITCH, S5_KT = 2 * 128 * S5_PITCH, S5_TAB_BYTES = S5_KT + 10 * 512;
constexpr int S5_XS = S5_TAB_BYTES, S5_XS_BYTES = 32 * S5_PITCH;
static_assert(S5_XS + NWAVES * S5_XS_BYTES <= RING_BYTES, "S5 LDS map");
typedef short s5_bf16x8 __attribute__((ext_vector_type(8)));
typedef float s5_f32x16 __attribute__((ext_vector_type(16)));

__device__ __forceinline__ void s5_apow(float lr, float li, float dt, int n, float& pr, float& pi) { const float m = expf(lr * dt * (float)n), th = li * dt * (float)n; pr = m * cosf(th); pi = m * sinf(th); }
__device__ __forceinline__ void s5_apow_fast(float lr, float li, float dt, int n, float& pr, float& pi) { const float m = __expf(lr * dt * (float)n), th = li * dt * (float)n; pr = m * __cosf(th); pi = m * __sinf(th); }
__device__ __forceinline__ void s5_zoh(float lr, float li, float dt, float& fr, float& fi) {
    float ar, ai; s5_apow(lr, li, dt, 1, ar, ai); const float den = lr * lr + li * li, nr = ar - 1.0f; fr = (nr * lr + ai * li) / den; fi = (ai * lr - nr * li) / den;
}
__device__ __forceinline__ void s5_tab_wst(int g, int jt, unsigned char* tab, const float* lam_re, const float* lam_im, const float* log_dt, const float* b_re, const float* b_im, int lane) {
    const int s = lane >> 3, cp = lane & 7; const float dt = expf(log_dt[g]);
    float zr, zi, mylr, myli;
    { const int p = (jt >> 1) * 32 + (lane & 31); mylr = lam_re[g * 64 + p]; myli = lam_im[g * 64 + p]; s5_zoh(mylr, myli, dt, zr, zi); }
#pragma unroll 4
    for (int r = 0; r < 32; ++r) { const int p = (jt >> 1) * 32 + r; const float lr = __shfl(mylr, r), li = __shfl(myli, r), fr = __shfl(zr, r), fi = __shfl(zi, r);
        float pr, pi; s5_apow_fast(lr, li, dt, 7 - s, pr, pi);
        float o[2];
#pragma unroll
        for (int e = 0; e < 2; ++e) { const int c = 2 * cp + e; const float br = b_re[((size_t)g * 64 + p) * 16 + c], bi = b_im[((size_t)g * 64 + p) * 16 + c];
            const float bbr = fr * br - fi * bi, bbi = fr * bi + fi * br; o[e] = (jt & 1) ? (pr * bbi + pi * bbr) : (pr * bbr - pi * bbi); }
        *(GAS unsigned*)(tab + S5_WST + (32 * jt + r) * S5_PITCH + (16 * s + 2 * cp) * 2) = pk2(o[0], o[1]); }
}
__device__ __forceinline__ void s5_tab_const(int g, float* ctab, const float* lam_re, const float* lam_im, const float* log_dt, int lane) {
    const float dt = expf(log_dt[g]); float xr, xi; s5_apow(lam_re[g * 64 + lane], lam_im[g * 64 + lane], dt, 1, xr, xi);
#pragma unroll
    for (int q = 0; q < 3; ++q) { const float nr = xr * xr - xi * xi, ni = 2.0f * xr * xi; xr = nr; xi = ni; }
    const float ar = xr, ai = xi;
#pragma unroll
    for (int q = 0; q < 5; ++q) { const float nr = xr * xr - xi * xi, ni = 2.0f * xr * xi; xr = nr; xi = ni; }
    *(GAS f32x4*)(ctab + ((size_t)g * 64 + lane) * 4) = (f32x4){ar, ai, xr, xi};
}
__device__ __forceinline__ void s5_tab_wyc(int g, int t, unsigned char* tab, const float* lam_re, const float* lam_im, const float* log_dt, const float* c_re, const float* c_im, int lane) {
    const int p = lane; const float dt = expf(log_dt[g]); float pr, pi; s5_apow_fast(lam_re[g * 64 + p], lam_im[g * 64 + p], dt, t + 1, pr, pi);
#pragma unroll
    for (int c = 0; c < 16; ++c) { const float cr = c_re[((size_t)g * 16 + c) * 64 + p], ci = c_im[((size_t)g * 16 + c) * 64 + p];
        *(GAS unsigned*)(tab + S5_WYC + (16 * t + c) * S5_PITCH + 4 * p) = pk2(cr * pr - ci * pi, -(cr * pi + ci * pr)); }
}
__device__ __forceinline__ void s5_tab_kt(int g, int d, unsigned char* tab, const float* lam_re, const float* lam_im, const float* log_dt, const float* b_re, const float* b_im, const float* c_re, const float* c_im,
                                          const float* dvec, int lane) {
    const float dt = expf(log_dt[g]); float mr, mi;
    { const float lr = lam_re[g * 64 + lane], li = lam_im[g * 64 + lane]; float pr, pi, fr, fi; s5_apow_fast(lr, li, dt, d, pr, pi); s5_zoh(lr, li, dt, fr, fi); mr = pr * fr - pi * fi; mi = pr * fi + pi * fr; }
    float acc[4] = {0.f, 0.f, 0.f, 0.f};
#pragma unroll 8
    for (int p = 0; p < 64; ++p) { const float pmr = __shfl(mr, p), pmi = __shfl(mi, p);
#pragma unroll
        for (int i = 0; i < 4; ++i) { const int e = lane + 64 * i, c = e >> 4, c2 = e & 15;
            const float br = b_re[((size_t)g * 64 + p) * 16 + c2], bi = b_im[((size_t)g * 64 + p) * 16 + c2], cr = c_re[((size_t)g * 16 + c) * 64 + p], ci = c_im[((size_t)g * 16 + c) * 64 + p];
            const float tr = pmr * br - pmi * bi, ti = pmr * bi + pmi * br; acc[i] += cr * tr - ci * ti; } }
#pragma unroll
    for (int i = 0; i < 4; ++i) { const int e = lane + 64 * i, c = e >> 4, c2 = e & 15; float v = acc[i]; if (d == 0 && c == c2) v += dvec[16 * g + c];
        *(GAS bf16*)(tab + S5_KT + (d + 1) * 512 + c * 32 + c2 * 2) = (bf16)f2bf(v);
        if (d == 0) *(GAS bf16*)(tab + S5_KT + c * 32 + c2 * 2) = (bf16)0; }
}

template <bool FINAL>
__device__ __forceinline__ void s5_unit(int g, int seg, const bf16* Ug, bf16* Yg, const unsigned char* tab, float* Ebuf, const float* ctab, LAS unsigned char* L) {
    int tid_ = threadIdx.x; asm volatile("" : "+v"(tid_));
    const int tid = tid_, lane = tid & 63, r32 = lane & 31, hi = lane >> 5, b = __builtin_amdgcn_readfirstlane(tid >> 6);
    { const int npc = (FINAL ? S5_TAB_BYTES : S5_WYC) / 1024; const unsigned l0 = (unsigned)(uintptr_t)(unsigned char*)L;
      for (int i = b; i < npc; i += NWAVES) attn_body::glds16(tab + (size_t)i * 1024 + lane * 16, (unsigned)__builtin_amdgcn_readfirstlane(l0 + i * 1024)); }
    const size_t tok0 = (size_t)g * TOK + (size_t)b * SEQ + (size_t)seg * 256;
    s5_bf16x8 A[8];
    { const bf16* up = Ug + (tok0 + 8 * r32) * 16 + 8 * hi;
#pragma unroll
      for (int s = 0; s < 8; ++s) A[s] = *(const GAS s5_bf16x8*)(up + s * 16); }
    float aLr[2], aLi[2], aSr[2], aSi[2];
#pragma unroll
    for (int k = 0; k < 2; ++k) { const f32x4 cv = *(const GAS f32x4*)(ctab + ((size_t)g * 64 + 32 * k + r32) * 4); aLr[k] = cv.x; aLi[k] = cv.y; aSr[k] = cv.z; aSi[k] = cv.w; }
    float cr[2] = {0.f, 0.f}, ci[2] = {0.f, 0.f};
    if (FINAL) {
        const float* eb = Ebuf + ((size_t)(b * NGRP + g) * 16) * 128;
        f32x2 ev[15][2];
#pragma unroll
        for (int j = 0; j < 15; ++j)
#pragma unroll
            for (int k = 0; k < 2; ++k) ev[j][k] = (j < seg) ? *(const GAS f32x2*)(eb + (size_t)j * 128 + 2 * (32 * k + r32)) : (f32x2){0.f, 0.f};
#pragma unroll
        for (int j = 0; j < 15; ++j) if (j < seg) {
#pragma unroll
            for (int k = 0; k < 2; ++k) { const float nr = aSr[k] * cr[k] - aSi[k] * ci[k] + ev[j][k].x, ni = aSr[k] * ci[k] + aSi[k] * cr[k] + ev[j][k].y; cr[k] = nr; ci[k] = ni; } }
    }
    asm volatile("s_waitcnt vmcnt(0)" ::: "memory");
    __syncthreads();
    s5_f32x16 S[4];
#pragma unroll
    for (int j = 0; j < 4; ++j) { S[j] = s5_f32x16{};
#pragma unroll
        for (int s = 0; s < 8; ++s) { const s5_bf16x8 bf = *(const LAS s5_bf16x8*)(L + S5_WST + (32 * j + r32) * S5_PITCH + (16 * s + 8 * hi) * 2);
            S[j] = __builtin_amdgcn_mfma_f32_32x32x16_bf16(A[s], bf, S[j], 0, 0, 0); } }
#pragma unroll
    for (int i = 0; i < 8; ++i) { const bool own = ((i & 1) == hi);
#pragma unroll
        for (int q = 0; q < 4; ++q) { const int reg = 4 * (i >> 1) + q;
#pragma unroll
            for (int k = 0; k < 2; ++k) { const float sr = S[2 * k][reg], si = S[2 * k + 1][reg];
                const float nr = aLr[k] * cr[k] - aLi[k] * ci[k] + sr, ni = aLr[k] * ci[k] + aLi[k] * cr[k] + si;
                S[2 * k][reg] = own ? cr[k] : sr; S[2 * k + 1][reg] = own ? ci[k] : si; cr[k] = own ? nr : cr[k]; ci[k] = own ? ni : ci[k]; } }
#pragma unroll
        for (int k = 0; k < 2; ++k) { const float orr = __shfl_xor(cr[k], 32), oi = __shfl_xor(ci[k], 32); cr[k] = own ? cr[k] : orr; ci[k] = own ? ci[k] : oi; } }
    if (!FINAL) {
        if (hi == 0) { float* eb = Ebuf + ((size_t)(b * NGRP + g) * 16 + seg) * 128;
#pragma unroll
            for (int k = 0; k < 2; ++k) *(GAS f32x2*)(eb + 2 * (32 * k + r32)) = (f32x2){cr[k], ci[k]}; }
    } else {
        LAS unsigned char* XS = L + S5_XS + b * S5_XS_BYTES;
#pragma unroll
        for (int reg = 0; reg < 16; ++reg) { const int chunk = (reg & 3) + 8 * (reg >> 2) + 4 * hi;
#pragma unroll
            for (int k = 0; k < 2; ++k) *(LAS unsigned*)(XS + chunk * S5_PITCH + 4 * (32 * k + r32)) = pg8::cvt_pk_bf16(S[2 * k][reg], S[2 * k + 1][reg]); }
        s5_bf16x8 Xf[8];
#pragma unroll
        for (int kk = 0; kk < 8; ++kk) Xf[kk] = *(const LAS s5_bf16x8*)(XS + r32 * S5_PITCH + (16 * kk + 8 * hi) * 2);
        s5_f32x16 Yc[4];
#pragma unroll
        for (int j = 0; j < 4; ++j) { Yc[j] = s5_f32x16{};
#pragma unroll
            for (int s = 0; s < 8; ++s) if (s <= 2 * j + 1) { const int d1 = 2 * j + (r32 >> 4) - s + 1;
                const s5_bf16x8 bf = *(const LAS s5_bf16x8*)(L + S5_KT + d1 * 512 + (r32 & 15) * 32 + 16 * hi);
                Yc[j] = __builtin_amdgcn_mfma_f32_32x32x16_bf16(A[s], bf, Yc[j], 0, 0, 0); }
#pragma unroll
            for (int kk = 0; kk < 8; ++kk) { const s5_bf16x8 bf = *(const LAS s5_bf16x8*)(L + S5_WYC + (32 * j + r32) * S5_PITCH + (16 * kk + 8 * hi) * 2);
                Yc[j] = __builtin_amdgcn_mfma_f32_32x32x16_bf16(Xf[kk], bf, Yc[j], 0, 0, 0); } }
        asm volatile("s_waitcnt lgkmcnt(0)" ::: "memory");
#pragma unroll
        for (int j = 0; j < 4; ++j)
#pragma unroll
            for (int reg = 0; reg < 16; reg += 2) { const pg8::f32x2 ge = pg8::gelu_pk((pg8::f32x2){Yc[j][reg], Yc[j][reg + 1]});
                const int chunk = (reg & 3) + 8 * (reg >> 2) + 4 * hi, tokl = 8 * chunk + 2 * j + (r32 >> 4), c = r32 & 15;
                const unsigned gw_ = pg8::cvt_pk_bf16(ge.x, ge.y); *(LAS bf16*)(XS + tokl * 32 + c * 2) = (bf16)(gw_ & 0xffffu); *(LAS bf16*)(XS + (tokl + 8) * 32 + c * 2) = (bf16)(gw_ >> 16); }
        asm volatile("s_waitcnt lgkmcnt(0)" ::: "memory");
        bf16* yo = Yg + tok0 * 16;
#pragma unroll
        for (int i = 0; i < 8; ++i) { const int pc = lane + 64 * i; const v4u w = *(const LAS v4u*)(XS + 16 * pc); *(GAS v4u*)(yo + 8 * pc) = w; }
    }
    __syncthreads();
}

#ifndef MK_ONE_LAUNCH
#define MK_ONE_LAUNCH 1
#endif
constexpr int N_PHASES = 14;
struct Args { const float* in[23]; float* out; unsigned char* ws; int ph_lo, ph_hi; };

#ifndef PROBE_P0
#define PROBE_P0 0
#endif
#define P0_ITEM(it) do { \
            int r = it; \
            if (r < I_TKT) { s5_tab_kt(r >> 3, r & 7, S5TAB + (size_t)(r >> 3) * S5_TAB_BYTES, args.in[6], args.in[7], args.in[8], args.in[9], args.in[10], args.in[11], args.in[12], args.in[13], lane); break; } r -= I_TKT; \
            if (r < I_TST) { s5_tab_wst(r >> 2, r & 3, S5TAB + (size_t)(r >> 2) * S5_TAB_BYTES, args.in[6], args.in[7], args.in[8], args.in[9], args.in[10], lane); break; } r -= I_TST; \
            if (r < I_TYC) { s5_tab_wyc(r >> 3, r & 7, S5TAB + (size_t)(r >> 3) * S5_TAB_BYTES, args.in[6], args.in[7], args.in[8], args.in[11], args.in[12], lane); break; } r -= I_TYC; \
            if (r < I_TCO) { s5_tab_const(r, S5C, args.in[6], args.in[7], args.in[8], lane); break; } r -= I_TCO; \
            if (r < I_SQ) { p0_matrix_item(args.in[5], 1024, 1024, WIN0, mixg, 0, r, scr, lane); break; } r -= I_SQ; \
            if (r < I_GLU) { p0_matrix_item(args.in[14], 768, 768, WGLU, nullptr, 0, r, scr, lane); break; } r -= I_GLU; \
            if (r < I_IN1) { p0_matrix_item(args.in[16], 1024, 2560, WIN1, mixg + 1024, 0, r, scr, lane); break; } r -= I_IN1; \
            if (r < I_SQ) { p0_matrix_item(args.in[17], 1024, 1024, WOUT0, nullptr, 0, r, scr, lane); break; } r -= I_SQ; \
            if (r < I_SQ) { p0_matrix_item(args.in[17] + 1024 * 1024, 1024, 1024, WOUT1, nullptr, 0, r, scr, lane); break; } r -= I_SQ; \
            if (r < I_GU) { p0_matrix_item(args.in[19], 1024, FFN, WGU0, ffng, 1, r, scr, lane); break; } r -= I_GU; \
            if (r < I_GU) { p0_matrix_item(args.in[20], 1024, FFN, WGU0, ffng, 2, r, scr, lane); break; } r -= I_GU; \
            if (r < I_GU) { p0_matrix_item(args.in[19] + (size_t)1024 * FFN, 1024, FFN, WGU1, ffng + 1024, 1, r, scr, lane); break; } r -= I_GU; \
            if (r < I_GU) { p0_matrix_item(args.in[20] + (size_t)1024 * FFN, 1024, FFN, WGU1, ffng + 1024, 2, r, scr, lane); break; } r -= I_GU; \
            if (r < I_DN) { p0_matrix_item(args.in[21], FFN, 1024, WDN0, nullptr, 0, r, scr, lane); break; } r -= I_DN; \
            if (r < I_DN) { p0_matrix_item(args.in[21] + (size_t)FFN * 1024, FFN, 1024, WDN1, nullptr, 0, r, scr, lane); break; } r -= I_DN; \
            p0_matrix_item(args.in[3], 1024, 512, WMKV, args.in[2], 0, r, scr, lane); \
        } while (0)
__global__ void __launch_bounds__(NWAVES * 64, 2) mega_fwd(Args args) {
    extern __shared__ __attribute__((aligned(16))) unsigned char lds[];
    LAS unsigned char* L = (LAS unsigned char*)lds;
    volatile LAS unsigned* MISC = (volatile LAS unsigned*)(L + MISC_OFF);
    const int tid = threadIdx.x, lane = tid & 63, wave = __builtin_amdgcn_readfirstlane(tid >> 6);
    const int G = gridDim.x; const int bx = blockIdx.x;
    const int vcu = (G % 8 == 0) ? (bx % 8) * (G / 8) + bx / 8 : bx;
    const int gw = vcu * NWAVES + wave, NGW = G * NWAVES;
    unsigned char* ws = args.ws;
    gu32* ctl = (gu32*)(ws + WS_CTL);
    for (int u = tid; u < (LDS_BYTES - LDSCTL_OFF) / 4; u += NWAVES * 64) ((LAS unsigned*)(L + LDSCTL_OFF))[u] = 0u;
    __syncthreads();
    XcdBarrier bar; bar.bar = (unsigned*)(ctl + CW_BAR); bar.x = 0; bar.st = nullptr;
    if (MK_ONE_LAUNCH) bar = xcd_barrier_post((unsigned*)(ctl + CW_BAR), MISC + 8);
#define MEMATTN_PHASE(u0_, us_) do { for (int un = (u0_); un < BATCH * MHEAD * NBLK; un += (us_)) { const int b_ = un >> 6, h_ = (un >> 4) & 3, qb_ = un & 15; const size_t qrow_ = (size_t)b_ * SEQ + (size_t)qb_ * 256; \
        attn_body::attn_unit<0, 8, 256, 256, 1024>((const attn_body::bf16*)(QM + qrow_ * 256 + h_ * 64), (const attn_body::bf16*)(MEMK + (size_t)b_ * MEML * 256 + h_ * 64), (const attn_body::bf16*)(MEMV + (size_t)b_ * MEML * 256 + h_ * 64), \
            (attn_body::bf16*)(MIX + qrow_ * 1024 + 768 + h_ * 64), 4, 0.f, nullptr, nullptr, 0, (char*)lds + RING_OFF); } } while (0)
    const int lo = args.ph_lo, hi = args.ph_hi;
#ifndef PROBE_DUP
#define PROBE_DUP -1
#endif
#define IN(k) (lo <= (k) && (k) < hi)
#define PH_REP(k) for (int rep_ = 0; rep_ < ((PROBE_DUP == (k)) ? 2 : 1); ++rep_)
#define SEAM(k) do { if (IN(k) && IN((k) + 1)) xcd_barrier(bar); } while (0)

    const float* x = args.in[0]; const float* mem = args.in[1];
    float* out = args.out;
    float* SS0 = (float*)(ws + WS_SS0); float* SSA = (float*)(ws + WS_SSA); float* SSB = (float*)(ws + WS_SSB); float* SSM = (float*)(ws + WS_SSM);
    unsigned char* S5TAB = ws + WS_S5TAB; float* S5E = (float*)(ws + WS_S5E); float* S5C = (float*)(ws + WS_S5TAB + (size_t)NGRP * S5_TAB_BYTES);
    float* KMP = (float*)(ws + WS_KMEAN);
    bf16* WIN0 = (bf16*)(ws + WS_WIN0); bf16* WGLU = (bf16*)(ws + WS_WGLU); bf16* WIN1 = (bf16*)(ws + WS_WIN1);
    bf16* WOUT0 = (bf16*)(ws + WS_WOUT0); bf16* WOUT1 = (bf16*)(ws + WS_WOUT1);
    bf16* WGU0 = (bf16*)(ws + WS_WGU0); bf16* WGU1 = (bf16*)(ws + WS_WGU1); bf16* WDN0 = (bf16*)(ws + WS_WDN0); bf16* WDN1 = (bf16*)(ws + WS_WDN1); bf16* WMKV = (bf16*)(ws + WS_WMKV);
    bf16* MEMB = (bf16*)(ws + WS_MEMB); bf16* MEMK = (bf16*)(ws + WS_MEMK); bf16* MEMV = (bf16*)(ws + WS_MEMV);
    bf16* XB = (bf16*)(ws + WS_XB); bf16* Ub = (bf16*)(ws + WS_U); bf16* Yb = (bf16*)(ws + WS_Y);
    bf16* Q1 = (bf16*)(ws + WS_Q1); bf16* K1 = (bf16*)(ws + WS_K1); bf16* V1 = (bf16*)(ws + WS_V1);
    bf16* QM = (bf16*)(ws + WS_QM); bf16* MIX = (bf16*)(ws + WS_MIX); bf16* Hb = (bf16*)(ws + WS_H);

    if (IN(0)) PH_REP(0) {
        if (rep_) xcd_barrier(bar);
        LAS float* scr = (LAS float*)(L + RING_OFF + wave * 16384);
        constexpr int I_SQ = 16 * 32, I_GLU = 12 * 24, I_IN1 = 16 * 80, I_GU = 16 * 88, I_DN = 44 * 32, I_MKV = 16 * 16;
        constexpr int I_TKT = NGRP * 8, I_TST = NGRP * 4, I_TYC = NGRP * 8, I_TCO = NGRP;
        constexpr int NITEMS = I_TKT + I_TST + I_TYC + I_TCO + I_SQ + I_GLU + I_IN1 + 2 * I_SQ + 4 * I_GU + 2 * I_DN + I_MKV;
        const float* mixg = args.in[4]; const float* ffng = args.in[18];
        for (int it = gw; it < NITEMS; it += NGW) P0_ITEM(it);
        for (int m = 4 * gw; m < TOK; m += 4 * NGW) rows_to_bf16_ssq<4>(x + (size_t)m * DM, XB + (size_t)m * DM, SS0 + (size_t)m * 16, lane);
        for (int m = gw; m < BATCH * MEML; m += NGW) rows_to_bf16_ssq<1>(mem + (size_t)m * DM, MEMB + (size_t)m * DM, SSM + (size_t)m * 16, lane);
#if PROBE_P0 == 1
        for (int it = gw; it < I_TKT + I_TST + I_TYC + I_TCO; it += NGW) P0_ITEM(it);
#elif PROBE_P0 == 2
        for (int it = I_TKT + I_TST + I_TYC + I_TCO + gw; it < NITEMS; it += NGW) P0_ITEM(it);
#elif PROBE_P0 == 3
        for (int m = 4 * gw; m < TOK; m += 4 * NGW) rows_to_bf16_ssq<4>(x + (size_t)m * DM, XB + (size_t)m * DM, SS0 + (size_t)m * 16, lane);
        for (int m = gw; m < BATCH * MEML; m += NGW) rows_to_bf16_ssq<1>(mem + (size_t)m * DM, MEMB + (size_t)m * DM, SSM + (size_t)m * 16, lane);
#endif
    }
    SEAM(0);
    if (IN(1)) PH_REP(1) {
        if (rep_) xcd_barrier(bar);
        { pg8::Gemm g{XB, WIN0, TOK, 1024, 1024, 0}; pg8::StaticOrder S; S.init(TOK, 1024, G, bx);
          pg8::EpiProj E{SS0, Ub, 0, 3, 1, TOKW, 1.0f, QM, C2, TOK, nullptr, -1};
          pg8::gemm_phase<pg8::EpiProj, pg8::StaticOrder, true, true>(L + RING_OFF, g, S, E); }
    }
    SEAM(1);
    if (IN(2)) PH_REP(2) {
        if (rep_) xcd_barrier(bar);
        const int nS5 = (G == 256) ? 240 : G;
        if (bx < nS5) { for (int un = bx; un < NGRP * 16; un += nS5) s5_unit<false>(un >> 4, un & 15, Ub, Yb, S5TAB + (size_t)(un >> 4) * S5_TAB_BYTES, S5E, S5C, L + RING_OFF); }
        if (G != 256 || bx >= nS5) { pg8::Gemm g{MEMB, WMKV, BATCH * MEML, 512, 1024, 0}; pg8::StaticOrder S; S.init(BATCH * MEML, 512, (G == 256) ? 16 : G, (G == 256) ? bx - nS5 : bx);
          pg8::EpiProj E{SSM, MEMK, (size_t)(WS_MEMV - WS_MEMK) / 2, 1, 2, 256, 1.0f, nullptr, 1.0f, 0, nullptr, -1};
          pg8::gemm_phase<pg8::EpiProj, pg8::StaticOrder, true, true>(L + RING_OFF, g, S, E); }
    }
    SEAM(2);
    if (IN(3)) PH_REP(3) {
        if (rep_) xcd_barrier(bar);
        for (int un = vcu; un < NGRP * 16; un += G) s5_unit<true>(un >> 4, un & 15, Ub, Yb, S5TAB + (size_t)(un >> 4) * S5_TAB_BYTES, S5E, S5C, L + RING_OFF);
    }
    SEAM(3);
    if (IN(4)) PH_REP(4) {
        if (rep_) xcd_barrier(bar);
        pg8::Gemm g{Yb, WGLU, TOK, TOKW, TOKW, 1}; pg8::StaticOrder S; S.init(TOK, TOKW, G, bx);
        pg8::EpiGlu E{Yb, TOKW, args.in[15], MIX, 1024, TOK};
        pg8::gemm_phase<pg8::EpiGlu, pg8::StaticOrder, true, true>(L + RING_OFF, g, S, E);
        if (G == 256) { if (bx >= 128) MEMATTN_PHASE(bx - 128, 128); }
        else MEMATTN_PHASE(vcu, G);
    }
    SEAM(4);
    if (IN(5)) PH_REP(5) {
        if (rep_) xcd_barrier(bar);
        pg8::Gemm g{MIX, WOUT0, TOK, 1024, 1024, 0}; pg8::StaticOrder S; S.init(TOK, 1024, G, bx);
        pg8::EpiRes E{x, nullptr, XB, SSA};
        pg8::gemm_phase<pg8::EpiRes, pg8::StaticOrder, true, true>(L + RING_OFF, g, S, E);
    }
    SEAM(5);
    if (IN(6)) PH_REP(6) {
        if (rep_) xcd_barrier(bar);
        pg8::Gemm g{XB, WGU0, TOK, 2 * FFN, 1024, 0}; pg8::StaticOrder S; S.init(TOK, 2 * FFN, G, bx);
        pg8::EpiGU E{SSA, Hb, FFN};
        pg8::gemm_phase<pg8::EpiGU, pg8::StaticOrder, true, true>(L + RING_OFF, g, S, E);
    }
    SEAM(6);
    if (IN(7)) PH_REP(7) {
        if (rep_) xcd_barrier(bar);
        pg8::Gemm g{Hb, WDN0, TOK, 1024, FFN, 0}; pg8::StaticOrder S; S.init(TOK, 1024, G, bx);
        pg8::EpiRes E{nullptr, XB, XB, SSB};
        pg8::gemm_phase<pg8::EpiRes, pg8::StaticOrder, true, true>(L + RING_OFF, g, S, E);
    }
    SEAM(7);
    if (IN(8)) PH_REP(8) {
        if (rep_) xcd_barrier(bar);
        pg8::Gemm g{XB, WIN1, TOK, 2560, 1024, 0}; pg8::StaticOrder S; S.init(TOK, 2560, G, bx);
        pg8::EpiProj E{SSB, Q1, (size_t)(WS_K1 - WS_Q1) / 2, 3, 3, TOKW, C2, QM, C2, 0, KMP, 1};
        pg8::gemm_phase<pg8::EpiProj, pg8::StaticOrder, true, true>(L + RING_OFF, g, S, E);
    }
    SEAM(8);
    if (IN(9)) PH_REP(9) {
        if (rep_) xcd_barrier(bar);
        for (int p_ = vcu; p_ < BATCH * NHEAD * 8; p_ += G) { const int bh_ = p_ >> 3, sg_ = p_ & 7, b_ = bh_ / NHEAD, h_ = bh_ - b_ * NHEAD;
            const float slope2 = __builtin_amdgcn_exp2f(-8.0f * (float)(h_ + 1) / 12.0f) * LOG2E;
#pragma unroll 1
            for (int k_ = 0; k_ < 2; ++k_) { const int qb_ = k_ ? 15 - sg_ : sg_; const size_t qrow_ = (size_t)b_ * SEQ + (size_t)qb_ * 256, krow_ = (size_t)b_ * SEQ;
                attn_body::attn_unit<1, 8, 768, 768, 1024>((const attn_body::bf16*)(Q1 + qrow_ * TOKW + h_ * 64), (const attn_body::bf16*)(K1 + krow_ * TOKW + h_ * 64), (const attn_body::bf16*)(V1 + krow_ * TOKW + h_ * 64),
                    (attn_body::bf16*)(MIX + qrow_ * 1024 + h_ * 64), 4 * qb_ + 4, slope2, KMP + (size_t)bh_ * 1024, KMP + (size_t)(8 * 12 * 16 * 64) + (size_t)bh_ * 1024, qb_, (char*)lds + RING_OFF); } }
        MEMATTN_PHASE(vcu, G);
    }
    SEAM(9);
    if (IN(10)) PH_REP(10) {
        if (rep_) xcd_barrier(bar);
        pg8::Gemm g{MIX, WOUT1, TOK, 1024, 1024, 0}; pg8::StaticOrder S; S.init(TOK, 1024, G, bx);
        pg8::EpiRes E{nullptr, XB, XB, SSA};
        pg8::gemm_phase<pg8::EpiRes, pg8::StaticOrder, true, true>(L + RING_OFF, g, S, E);
    }
    SEAM(10);
    if (IN(11)) PH_REP(11) {
        if (rep_) xcd_barrier(bar);
        pg8::Gemm g{XB, WGU1, TOK, 2 * FFN, 1024, 0}; pg8::StaticOrder S; S.init(TOK, 2 * FFN, G, bx);
        pg8::EpiGU E{SSA, Hb, FFN};
        pg8::gemm_phase<pg8::EpiGU, pg8::StaticOrder, true, true>(L + RING_OFF, g, S, E);
    }
    SEAM(11);
    if (IN(12)) PH_REP(12) {
        if (rep_) xcd_barrier(bar);
        pg8::Gemm g{Hb, WDN1, TOK, 1024, FFN, 0}; pg8::StaticOrder S; S.init(TOK, 1024, G, bx);
        pg8::EpiRes E{nullptr, XB, XB, SSB};
        pg8::gemm_phase<pg8::EpiRes, pg8::StaticOrder, true, true>(L + RING_OFF, g, S, E);
    }
    SEAM(12);
    if (IN(13)) PH_REP(13) {
        if (rep_) xcd_barrier(bar);
        const float* gf = args.in[22];
        const GAS f32x4* gp = (const GAS f32x4*)gf + 4 * lane; const f32x4 g0 = gp[0], g1 = gp[1], g2 = gp[2], g3 = gp[3];
        for (int m0 = 4 * gw; m0 < TOK; m0 += 4 * NGW) {
            v4u q[4][2]; f32x4 sq[4];
#pragma unroll
            for (int r = 0; r < 4; ++r) { const GAS v4u* xr = (const GAS v4u*)(XB + (size_t)(m0 + r) * DM) + 2 * lane; q[r][0] = xr[0]; q[r][1] = xr[1];
                sq[r] = *(const GAS f32x4*)(SSB + (size_t)(m0 + r) * 16 + 4 * (lane & 3)); }
#pragma unroll
            for (int r = 0; r < 4; ++r) { float s = (sq[r].x + sq[r].y) + (sq[r].z + sq[r].w); s += __shfl_xor(s, 1); s += __shfl_xor(s, 2);
                const float rs = __builtin_amdgcn_rsqf(s * (1.0f / 1024.0f) + 1e-6f);
                GAS f32x4* orow = (GAS f32x4*)(out + (size_t)(m0 + r) * DM) + 4 * lane; const v4u q0 = q[r][0], q1 = q[r][1];
                orow[0] = (f32x4){bflo(q0.x), bfhi(q0.x), bflo(q0.y), bfhi(q0.y)} * rs * g0; orow[1] = (f32x4){bflo(q0.z), bfhi(q0.z), bflo(q0.w), bfhi(q0.w)} * rs * g1;
                orow[2] = (f32x4){bflo(q1.x), bfhi(q1.x), bflo(q1.y), bfhi(q1.y)} * rs * g2; orow[3] = (f32x4){bflo(q1.z), bfhi(q1.z), bflo(q1.w), bfhi(q1.w)} * rs * g3; }
        }
    }
#undef IN
#undef SEAM
}

extern "C" void kernel_launch(void* const* d_in, const int* in_sizes, int n_in, void* d_out, int out_size, void* d_ws, size_t ws_size, hipStream_t stream) {
    static int grid = 0;
    if (grid == 0) {
        if (n_in != 23 || out_size != TOK * DM || ws_size < WS_END) { fprintf(stderr, "kernel_launch: unexpected shapes: n_in %d out %d ws %zu\n", n_in, out_size, ws_size); grid = -1; return; }
        int dev = 0, cus = 0, per_cu = 0;
        if (hipGetDevice(&dev) != hipSuccess || hipDeviceGetAttribute(&cus, hipDeviceAttributeMultiprocessorCount, dev) != hipSuccess) { grid = -1; return; }
        if (hipFuncSetAttribute((const void*)mega_fwd, hipFuncAttributeMaxDynamicSharedMemorySize, LDS_BYTES) != hipSuccess) { fprintf(stderr, "kernel_launch: hipFuncSetAttribute failed\n"); grid = -1; return; }
        if (hipOccupancyMaxActiveBlocksPerMultiprocessor(&per_cu, (const void*)mega_fwd, NWAVES * 64, LDS_BYTES) != hipSuccess || per_cu < 1)
            fprintf(stderr, "kernel_launch: occupancy query reports %d workgroups per CU\n", per_cu);
        (void)hipGetLastError();
        grid = cus;
    }
    if (grid < 0) return;
    if (hipMemsetAsync((char*)d_ws + WS_CTL, 0, CTL_ZERO_BYTES, stream) != hipSuccess) return;
    Args a{};
    for (int i = 0; i < 23; ++i) a.in[i] = (const float*)d_in[i];
    a.out = (float*)d_out; a.ws = (unsigned char*)d_ws;
#if MK_ONE_LAUNCH
    a.ph_lo = 0; a.ph_hi = N_PHASES;
    hipLaunchKernelGGL(mega_fwd, dim3(grid), dim3(NWAVES * 64), LDS_BYTES, stream, a);
#else
    for (int p = 0; p < N_PHASES; ++p) { a.ph_lo = p; a.ph_hi = p + 1; hipLaunchKernelGGL(mega_fwd, dim3(grid), dim3(NWAVES * 64), LDS_BYTES, stream, a); }
#endif
}
```

```cpp
#include <hip/hip_runtime.h>
#include <hip/hip_bf16.h>
#include <cstdio>
#include <cstdint>
#include <cmath>
namespace pg8 {
#define PG8_LAS __attribute__((address_space(3)))
typedef unsigned short bf16_t;
typedef short bf16x8 __attribute__((ext_vector_type(8)));
typedef float f32x4 __attribute__((ext_vector_type(4)));
typedef unsigned u32x4 __attribute__((ext_vector_type(4)));
constexpr int BM = 256, BK = 64, HALF = 128, HTB = HALF * BK * 2  , STAGE_BYTES = 8 * HTB, NXCD = 8, WGM = 8;

__host__ __device__ __forceinline__ int lds_byte(int r, int c) { const int st = (r >> 4) * 2 + (c >> 5), rr = r & 15, cc = c & 31, ob = rr * 64 + cc * 2; return st * 1024 + (ob ^ (((ob >> 9) & 1) << 5)); }
__host__ __device__ __forceinline__ void stage_rc(int b, int& R, int& C) { const int st = b / 1024, sb = b % 1024, swz = sb ^ (((sb >> 9) & 1) << 5); R = (st >> 1) * 16 + swz / 64; C = (st & 1) * 32 + (swz % 64) / 2; }
__host__ __device__ __forceinline__ int perm32(int rho) { const int n = rho >> 4, i = rho & 15; return 8 * (i >> 2) + 4 * n + (i & 3); }

struct Unit { int pm, pn; };
struct Gemm { const bf16_t* A; const bf16_t* Bt; int M, N, K, amode; };

struct StaticOrder {
    int nM, nN, nwg, G, c;
    __host__ __device__ void init(int M, int N, int G_, int c_) { nM = M / BM; nN = N / BM; nwg = nM * nN; G = G_; c = c_; }
    __host__ __device__ bool next(int i, Unit& u) const {
        const long L = (long)i * G + c; if (L >= nwg) return false;
        int wgid = (int)L; { const int q = nwg / NXCD, r = nwg % NXCD, xcd = wgid % NXCD, off = wgid / NXCD; wgid = (xcd < r ? xcd * (q + 1) : r * (q + 1) + (xcd - r) * q) + off; }
        const int nig = WGM * nN, gid = wgid / nig, fm = gid * WGM, gsz = (nM - fm) < WGM ? (nM - fm) : WGM;
        u.pm = fm + ((wgid % nig) % gsz); u.pn = (wgid % nig) / gsz; return true;
    }
    __device__ __forceinline__ void a_ready(const Unit&) const {}
    __device__ __forceinline__ void done(const Unit&) const {}
};

__device__ __forceinline__ unsigned cvt_pk_bf16(float lo, float hi) { unsigned r; asm volatile("v_cvt_pk_bf16_f32 %0, %1, %2" : "=v"(r) : "v"(lo), "v"(hi)); return r; }
typedef float f32x2 __attribute__((ext_vector_type(2)));
typedef unsigned u32x2 __attribute__((ext_vector_type(2)));
constexpr float RMS_EPS = 1e-6f;
__device__ __forceinline__ float row_rstd(const float* ssq, int row) {
    const f32x4* p = (const f32x4*)(ssq + (size_t)row * 16);
    const f32x4 a = p[0], b = p[1], c = p[2], d = p[3];
    const float s = (((a[0] + a[1]) + (a[2] + a[3])) + ((b[0] + b[1]) + (b[2] + b[3]))) + (((c[0] + c[1]) + (c[2] + c[3])) + ((d[0] + d[1]) + (d[2] + d[3])));
    return __builtin_amdgcn_rsqf(s * (1.0f / 1024.0f) + RMS_EPS);
}
__device__ __forceinline__ float bf2f(unsigned short h) { return __uint_as_float(((unsigned)h) << 16); }
__device__ __forceinline__ float bflo(unsigned w) { return __uint_as_float(w << 16); }
__device__ __forceinline__ float bfhi(unsigned w) { return __uint_as_float(w & 0xffff0000u); }

__device__ __forceinline__ f32x2 gelu_pk(f32x2 v) {
    const f32x2 av = __builtin_elementwise_abs(v), d = av * 0.2316418882f + 1.0f;
    f32x2 t; t.x = __builtin_amdgcn_rcpf(d.x); t.y = __builtin_amdgcn_rcpf(d.y);
    f32x2 q = t * 0.5307027145f + (-0.7265760135f); q = q * t + 0.7107068705f; q = q * t + (-0.142248368f); q = q * t + 0.127414796f; q = q * t;
    const f32x2 s = (v * v) * (-0.72134752044f);
    f32x2 e; e.x = __builtin_amdgcn_exp2f(s.x); e.y = __builtin_amdgcn_exp2f(s.y);
    const f32x2 m = v * (q * e), r = v - m;
    f32x2 o; o.x = v.x < 0.f ? m.x : r.x; o.y = v.y < 0.f ? m.y : r.y; return o;
}

__device__ __forceinline__ void row_rstd4x8(const float* ssq, int row0, int fq, float sc, float (&rs)[2][4]) {
    f32x4 a[2][4];
#pragma unroll
    for (int ai = 0; ai < 2; ++ai)
#pragma unroll
        for (int m = 0; m < 4; ++m) a[ai][m] = *(const __attribute__((address_space(1))) f32x4*)(ssq + (size_t)(row0 + ai * HALF + m * 16) * 16 + 4 * fq);
#pragma unroll
    for (int ai = 0; ai < 2; ++ai)
#pragma unroll
        for (int m = 0; m < 4; ++m) { float s = (a[ai][m][0] + a[ai][m][1]) + (a[ai][m][2] + a[ai][m][3]); s += __shfl_xor(s, 16); s += __shfl_xor(s, 32);
            rs[ai][m] = __builtin_amdgcn_rsqf(s * (1.0f / 1024.0f) + RMS_EPS) * sc; }
}
struct EpiProj {
    static constexpr bool PERM = true, AFTER_DRAIN = false;
    const float* ssq; bf16_t* base; size_t seg_stride; int tps, nseg, ldc; float scale0; bf16_t* qm; float scale_qm; int gm_rows;
    float* kmp; int kseg;
    __device__ __forceinline__ void operator()(const f32x4 (&acc)[2][2][4][2], const Unit& u, int wr, int wc, int fr, int fq) const {
        const int seg = u.pn / tps, within = u.pn - seg * tps;
        bf16_t* o; int ld, colt; float sc;
        if (seg < nseg) { o = base + (size_t)seg * seg_stride; ld = ldc; colt = within * BM; sc = (seg == 0) ? scale0 : 1.0f; }
        else { o = qm; ld = 256; colt = 0; sc = scale_qm; }
        const int row0 = u.pm * BM + wr * 64 + fr, col0 = colt + wc * 32 + 8 * fq;
        f32x4 cs[2][2] = {{{0.f, 0.f, 0.f, 0.f}, {0.f, 0.f, 0.f, 0.f}}, {{0.f, 0.f, 0.f, 0.f}, {0.f, 0.f, 0.f, 0.f}}};
        float rsv[2][4]; row_rstd4x8(ssq, row0, fq, sc, rsv);
#pragma unroll
        for (int ai = 0; ai < 2; ++ai)
#pragma unroll
            for (int m = 0; m < 4; ++m) { const int row = row0 + ai * HALF + m * 16; const float rs = rsv[ai][m]; bf16_t* rowp = o + (size_t)row * ld + col0;
                const bool gm = (gm_rows != 0) && (seg < nseg);
#pragma unroll
                for (int bj = 0; bj < 2; ++bj) { const f32x4 v0 = acc[ai][bj][m][0] * rs, v1 = acc[ai][bj][m][1] * rs;
                    u32x4 w; w.x = cvt_pk_bf16(v0[0], v0[1]); w.y = cvt_pk_bf16(v0[2], v0[3]); w.z = cvt_pk_bf16(v1[0], v1[1]); w.w = cvt_pk_bf16(v1[2], v1[3]);
                    const int cc = col0 + bj * HALF;
                    bf16_t* dst = gm ? (o + ((size_t)(cc >> 4) * gm_rows + row) * 16 + (cc & 15)) : (rowp + bj * HALF);
                    *(u32x4*)dst = w; cs[bj][0] += v0; cs[bj][1] += v1; } }
        if (seg == kseg) {
#pragma unroll
            for (int bj = 0; bj < 2; ++bj)
#pragma unroll
                for (int n = 0; n < 2; ++n)
#pragma unroll
                    for (int e = 0; e < 4; ++e) { float s = cs[bj][n][e]; s += __shfl_xor(s, 1); s += __shfl_xor(s, 2); s += __shfl_xor(s, 4); s += __shfl_xor(s, 8); cs[bj][n][e] = s; }
            if (fr == 0) { const int bb = u.pm >> 4, blk = u.pm & 15;
#pragma unroll
                for (int bj = 0; bj < 2; ++bj) { const int cc = col0 + bj * HALF, h = cc >> 6, d = cc & 63;
                    float* kd = kmp + (size_t)wr * (8 * 12 * 16 * 64) + ((size_t)((bb * 12 + h) * 16 + blk)) * 64 + d;
                    *(__attribute__((address_space(1))) f32x4*)kd = cs[bj][0]; *(__attribute__((address_space(1))) f32x4*)(kd + 4) = cs[bj][1]; } }
        }
    }
};
struct EpiGlu {
    static constexpr bool PERM = true, AFTER_DRAIN = false;
    const bf16_t* Y; int ldy; const float* bias; bf16_t* mix; int ldm; int ygm_rows;
    __device__ __forceinline__ void operator()(const f32x4 (&acc)[2][2][4][2], const Unit& u, int wr, int wc, int fr, int fq) const {
        const int row0 = u.pm * BM + wr * 64 + fr, col0 = u.pn * BM + wc * 32 + 8 * fq;
        f32x4 bv[2][2];
#pragma unroll
        for (int bj = 0; bj < 2; ++bj)
#pragma unroll
            for (int n = 0; n < 2; ++n) bv[bj][n] = *(const f32x4*)(bias + col0 + bj * HALF + 4 * n);
#pragma unroll
        for (int ai = 0; ai < 2; ++ai) {
            u32x4 yq[4][2];
#pragma unroll
            for (int m = 0; m < 4; ++m) { const int row = row0 + ai * HALF + m * 16;
#pragma unroll
                for (int bj = 0; bj < 2; ++bj) { const int cc = col0 + bj * HALF;
                    yq[m][bj] = ygm_rows ? *(const __attribute__((address_space(1))) u32x4*)(Y + ((size_t)(cc >> 4) * ygm_rows + row) * 16 + (cc & 15)) : *(const __attribute__((address_space(1))) u32x4*)(Y + (size_t)row * ldy + cc); } }
#pragma unroll
            for (int m = 0; m < 4; ++m) { const int row = row0 + ai * HALF + m * 16;
#pragma unroll
                for (int bj = 0; bj < 2; ++bj) { const u32x4 yw = yq[m][bj];
                    const f32x4 z0 = acc[ai][bj][m][0] + bv[bj][0], z1 = acc[ai][bj][m][1] + bv[bj][1];
                    float t[8]; const float yv[8] = {bflo(yw.x), bfhi(yw.x), bflo(yw.y), bfhi(yw.y), bflo(yw.z), bfhi(yw.z), bflo(yw.w), bfhi(yw.w)};
#pragma unroll
                    for (int e = 0; e < 4; ++e) { t[e] = yv[e] * __builtin_amdgcn_rcpf(1.0f + __builtin_amdgcn_exp2f(-1.4426950408889634f * z0[e])); t[4 + e] = yv[4 + e] * __builtin_amdgcn_rcpf(1.0f + __builtin_amdgcn_exp2f(-1.4426950408889634f * z1[e])); }
                    u32x4 w; w.x = cvt_pk_bf16(t[0], t[1]); w.y = cvt_pk_bf16(t[2], t[3]); w.z = cvt_pk_bf16(t[4], t[5]); w.w = cvt_pk_bf16(t[6], t[7]);
                    *(u32x4*)(mix + (size_t)row * ldm + col0 + bj * HALF) = w; } } }
    }
};
struct EpiRes {
    static constexpr bool PERM = true, AFTER_DRAIN = false;
    const float* basef; const bf16_t* baseb; bf16_t* xb; float* ssq_out;
    __device__ __forceinline__ void operator()(const f32x4 (&acc)[2][2][4][2], const Unit& u, int wr, int wc, int fr, int fq) const {
        const int row0 = u.pm * BM + wr * 64 + fr, col0 = u.pn * BM + wc * 32 + 8 * fq;
        typedef __attribute__((address_space(1))) const f32x4 gf4; typedef __attribute__((address_space(1))) const u32x4 gu4;
        if (basef) {
            f32x4 bn[2][2];
#pragma unroll
            for (int bj = 0; bj < 2; ++bj)
#pragma unroll
                for (int n = 0; n < 2; ++n) bn[bj][n] = *(gf4*)(basef + (size_t)row0 * 1024 + col0 + bj * HALF + n * 4);
#pragma unroll
            for (int idx = 0; idx < 8; ++idx) { const int ai = idx >> 2, m = idx & 3; const int row = row0 + ai * HALF + m * 16; const size_t off = (size_t)row * 1024 + col0; float ss = 0.f;
                f32x4 bc[2][2];
#pragma unroll
                for (int bj = 0; bj < 2; ++bj)
#pragma unroll
                    for (int n = 0; n < 2; ++n) bc[bj][n] = bn[bj][n];
                if (idx + 1 < 8) { const int row2 = row0 + ((idx + 1) >> 2) * HALF + ((idx + 1) & 3) * 16;
#pragma unroll
                    for (int bj = 0; bj < 2; ++bj)
#pragma unroll
                        for (int n = 0; n < 2; ++n) bn[bj][n] = *(gf4*)(basef + (size_t)row2 * 1024 + col0 + bj * HALF + n * 4); }
#pragma unroll
                for (int bj = 0; bj < 2; ++bj) { const f32x4 o0 = bc[bj][0] + acc[ai][bj][m][0], o1 = bc[bj][1] + acc[ai][bj][m][1];
                    u32x4 w; w.x = cvt_pk_bf16(o0[0], o0[1]); w.y = cvt_pk_bf16(o0[2], o0[3]); w.z = cvt_pk_bf16(o1[0], o1[1]); w.w = cvt_pk_bf16(o1[2], o1[3]);
                    *(u32x4*)(xb + off + bj * HALF) = w;
                    ss += ((o0[0] * o0[0] + o0[1] * o0[1]) + (o0[2] * o0[2] + o0[3] * o0[3])) + ((o1[0] * o1[0] + o1[1] * o1[1]) + (o1[2] * o1[2] + o1[3] * o1[3])); }
                ss += __shfl_xor(ss, 16); ss += __shfl_xor(ss, 32);
                if (fq == 0) ssq_out[(size_t)row * 16 + u.pn * 4 + wc] = ss; }
        } else {
            u32x4 bq[2][4][2];
#pragma unroll
            for (int ai = 0; ai < 2; ++ai)
#pragma unroll
                for (int m = 0; m < 4; ++m)
#pragma unroll
                    for (int bj = 0; bj < 2; ++bj) bq[ai][m][bj] = *(gu4*)(baseb + (size_t)(row0 + ai * HALF + m * 16) * 1024 + col0 + bj * HALF);
#pragma unroll
            for (int ai = 0; ai < 2; ++ai)
#pragma unroll
                for (int m = 0; m < 4; ++m) { const int row = row0 + ai * HALF + m * 16; const size_t off = (size_t)row * 1024 + col0; float ss = 0.f;
#pragma unroll
                    for (int bj = 0; bj < 2; ++bj) { const u32x4 q = bq[ai][m][bj];
                        const f32x4 b0 = (f32x4){bflo(q.x), bfhi(q.x), bflo(q.y), bfhi(q.y)}, b1 = (f32x4){bflo(q.z), bfhi(q.z), bflo(q.w), bfhi(q.w)};
                        const f32x4 o0 = b0 + acc[ai][bj][m][0], o1 = b1 + acc[ai][bj][m][1];
                        u32x4 w; w.x = cvt_pk_bf16(o0[0], o0[1]); w.y = cvt_pk_bf16(o0[2], o0[3]); w.z = cvt_pk_bf16(o1[0], o1[1]); w.w = cvt_pk_bf16(o1[2], o1[3]);
                        *(u32x4*)(xb + off + bj * HALF) = w;
                        ss += ((o0[0] * o0[0] + o0[1] * o0[1]) + (o0[2] * o0[2] + o0[3] * o0[3])) + ((o1[0] * o1[0] + o1[1] * o1[1]) + (o1[2] * o1[2] + o1[3] * o1[3])); }
                    ss += __shfl_xor(ss, 16); ss += __shfl_xor(ss, 32);
                    if (fq == 0) ssq_out[(size_t)row * 16 + u.pn * 4 + wc] = ss; }
        }
    }
};
struct EpiGU {
    static constexpr bool PERM = true, AFTER_DRAIN = false;
    const float* ssq; bf16_t* H; int ldh;
    __device__ __forceinline__ void operator()(const f32x4 (&acc)[2][2][4][2], const Unit& u, int wr, int wc, int fr, int fq) const {
        const int row0 = u.pm * BM + wr * 64 + fr, col0 = u.pn * HALF + wc * 32 + 8 * fq;
        float rsv[2][4]; row_rstd4x8(ssq, row0, fq, 1.0f, rsv);
#pragma unroll
        for (int ai = 0; ai < 2; ++ai)
#pragma unroll
            for (int m = 0; m < 4; ++m) { const int row = row0 + ai * HALF + m * 16; const float rs = rsv[ai][m];
                f32x4 hv[2];
                const float rsn = rs * -1.4426950408889634f, rs2 = rs * rs;
#pragma unroll
                for (int n = 0; n < 2; ++n) { const f32x4 G = acc[ai][0][m][n], U = acc[ai][1][m][n]; const f32x4 a = G * rsn;
                    f32x4 d; d[0] = __builtin_amdgcn_exp2f(a[0]); d[1] = __builtin_amdgcn_exp2f(a[1]); d[2] = __builtin_amdgcn_exp2f(a[2]); d[3] = __builtin_amdgcn_exp2f(a[3]);
                    d = d + 1.0f;
                    f32x4 r; r[0] = __builtin_amdgcn_rcpf(d[0]); r[1] = __builtin_amdgcn_rcpf(d[1]); r[2] = __builtin_amdgcn_rcpf(d[2]); r[3] = __builtin_amdgcn_rcpf(d[3]);
                    hv[n] = ((G * U) * rs2) * r; }
                u32x4 w; w.x = cvt_pk_bf16(hv[0][0], hv[0][1]); w.y = cvt_pk_bf16(hv[0][2], hv[0][3]); w.z = cvt_pk_bf16(hv[1][0], hv[1][1]); w.w = cvt_pk_bf16(hv[1][2], hv[1][3]);
                *(u32x4*)(H + (size_t)row * ldh + col0) = w; }
    }
};

template <class Epi, class Sched, bool ALIGN_EPI = false, bool SP2 = false>
__device__ __forceinline__ void gemm_phase(PG8_LAS unsigned char* lds, const Gemm g, const Sched& S, const Epi& E) {
    const int tid = threadIdx.x, wid = __builtin_amdgcn_readfirstlane(tid >> 6), lane = tid & 63, wr = wid >> 2, wc = wid & 3, fr = lane & 15, fq = lane >> 4;
    const int K = g.K, nt = K / BK;
    unsigned voffA[2], voffB[2];
#pragma unroll
    for (int i = 0; i < 2; ++i) { int R, C; stage_rc(tid * 16 + i * 8192, R, C); const int Rb = Epi::PERM ? ((R & ~31) + perm32(R & 31)) : R;
        voffA[i] = g.amode ? (unsigned)((C >> 4) * g.M * 32 + R * 32 + (C & 15) * 2) : (unsigned)(R * K + C) * 2u; voffB[i] = (unsigned)(Rb * K + C) * 2u; }
    const size_t kstep = (size_t)(BK * 2);
    const size_t hstep = (size_t)HALF * K * 2;
    const size_t tstep = 2 * hstep;
    const size_t kstepA = g.amode ? (size_t)4 * g.M * 32 : kstep, hstepA = g.amode ? (size_t)HALF * 32 : hstep, tstepA = 2 * hstepA;
    const unsigned ldsw = (unsigned)wid * 1024u;
    const int aoff = lds_byte(wr * 64 + fr, fq * 8), boff = lds_byte(wc * 32 + fr, fq * 8);
#define PG8_SA(b, h) (((b) * 2 + (h)) * HTB)
#define PG8_SB(b, h) ((4 + (b) * 2 + (h)) * HTB)
#define PG8_STAGE(bufoff, gbase, voff) do { _Pragma("unroll") for (int _i = 0; _i < 2; ++_i) \
        __builtin_amdgcn_global_load_lds((const unsigned*)((const char*)(gbase) + (voff)[_i]), (PG8_LAS unsigned*)(lds + (bufoff) + ldsw + _i * 8192), 16, 0, 0); } while (0)
#define PG8_LDA(dst, b, h) do { _Pragma("unroll") for (int m = 0; m < 4; ++m) _Pragma("unroll") for (int k = 0; k < 2; ++k) dst[m][k] = *(const PG8_LAS bf16x8*)(lds + PG8_SA(b, h) + aoff + m * 2048 + k * 1024); } while (0)
#define PG8_LDB(dst, b, h) do { _Pragma("unroll") for (int n = 0; n < 2; ++n) _Pragma("unroll") for (int k = 0; k < 2; ++k) dst[n][k] = *(const PG8_LAS bf16x8*)(lds + PG8_SB(b, h) + boff + n * 2048 + k * 1024); } while (0)
#define PG8_MMA(ai, bj, At, Bt) do { __builtin_amdgcn_s_setprio(1); _Pragma("unroll") for (int m = 0; m < 4; ++m) _Pragma("unroll") for (int n = 0; n < 2; ++n) _Pragma("unroll") for (int k = 0; k < 2; ++k) \
        acc[ai][bj][m][n] = __builtin_amdgcn_mfma_f32_16x16x32_bf16(Bt[n][k], At[m][k], acc[ai][bj][m][n], 0, 0, 0); __builtin_amdgcn_s_setprio(0); } while (0)
#define PG8_WAIT_V(n) asm volatile("s_waitcnt vmcnt(" #n ")" ::: "memory")
#define PG8_WAIT_L(n) asm volatile("s_waitcnt lgkmcnt(" #n ")" ::: "memory")
#define PG8_BAR __builtin_amdgcn_s_barrier()
#define PG8_SCHED __builtin_amdgcn_sched_barrier(0)
    Unit cur, nxt; int ui = 0;
    if (!S.next(0, cur)) return;
    f32x4 acc[2][2][4][2];
#pragma unroll
    for (int a = 0; a < 2; ++a)
#pragma unroll
        for (int b = 0; b < 2; ++b)
#pragma unroll
            for (int m = 0; m < 4; ++m)
#pragma unroll
                for (int n = 0; n < 2; ++n) acc[a][b][m][n] = (f32x4){0.f, 0.f, 0.f, 0.f};
    bf16x8 At[4][2], B0[2][2], B1[2][2];
    const char* cA = (const char*)g.A + (size_t)cur.pm * tstepA; const char* cB = (const char*)g.Bt + (size_t)cur.pn * tstep;
    S.a_ready(cur);
    if constexpr (SP2) {
        PG8_STAGE(PG8_SB(0, 0), cB, voffB); PG8_STAGE(PG8_SB(0, 1), cB + hstep, voffB); PG8_STAGE(PG8_SA(0, 0), cA, voffA); PG8_STAGE(PG8_SA(0, 1), cA + hstepA, voffA);
        if (wr == 1) PG8_BAR;
        PG8_WAIT_V(2); PG8_BAR;
        PG8_STAGE(PG8_SB(1, 0), cB + kstep, voffB); PG8_STAGE(PG8_SA(1, 0), cA + kstepA, voffA); PG8_STAGE(PG8_SB(1, 1), cB + hstep + kstep, voffB);
        PG8_WAIT_V(6); PG8_BAR;
    } else {
        PG8_STAGE(PG8_SB(0, 0), cB, voffB); PG8_STAGE(PG8_SA(0, 0), cA, voffA); PG8_STAGE(PG8_SB(0, 1), cB + hstep, voffB); PG8_STAGE(PG8_SA(0, 1), cA + hstepA, voffA);
        if (wr == 1) PG8_BAR;
        PG8_WAIT_V(4); PG8_BAR;
        PG8_STAGE(PG8_SB(1, 0), cB + kstep, voffB); PG8_STAGE(PG8_SA(1, 0), cA + kstepA, voffA); PG8_STAGE(PG8_SB(1, 1), cB + hstep + kstep, voffB);
        PG8_WAIT_V(6); PG8_BAR;
    }
    for (;;) {
        const bool has_next = S.next(ui + 1, nxt);
        const char* nA = has_next ? (const char*)g.A + (size_t)nxt.pm * tstepA : cA; const char* nB = has_next ? (const char*)g.Bt + (size_t)nxt.pn * tstep : cB;
        for (int t = 0; t < nt; t += 2) {
            const bool last = (t == nt - 2);
            const char* a1 = cA + (size_t)(t + 1) * kstepA;
            const char* a2 = last ? nA : cA + (size_t)(t + 2) * kstepA; const char* b2 = last ? nB : cB + (size_t)(t + 2) * kstep;
            const char* a3 = a2 + kstepA; const char* b3 = b2 + kstep;
            if (last && has_next) S.a_ready(nxt);
            if constexpr (SP2) {
            PG8_LDB(B0, 0, 0); PG8_LDB(B1, 0, 1); PG8_SCHED; PG8_LDA(At, 0, 0); PG8_STAGE(PG8_SA(1, 1), a1 + hstepA, voffA);
            PG8_WAIT_V(8); PG8_WAIT_L(0); PG8_BAR; PG8_MMA(0, 0, At, B0); PG8_MMA(0, 1, At, B1); PG8_BAR; PG8_SCHED;
            PG8_LDA(At, 0, 1); PG8_STAGE(PG8_SB(0, 0), b2, voffB); PG8_STAGE(PG8_SB(0, 1), b2 + hstep, voffB); PG8_STAGE(PG8_SA(0, 0), a2, voffA);
            PG8_WAIT_V(8); PG8_WAIT_L(0); PG8_BAR; PG8_MMA(1, 0, At, B0); PG8_MMA(1, 1, At, B1); PG8_BAR; PG8_SCHED;
            PG8_LDB(B0, 1, 0); PG8_LDB(B1, 1, 1); PG8_SCHED; PG8_LDA(At, 1, 0); PG8_STAGE(PG8_SA(0, 1), a2 + hstepA, voffA);
            PG8_WAIT_V(8); PG8_WAIT_L(0); PG8_BAR; PG8_MMA(0, 0, At, B0); PG8_MMA(0, 1, At, B1); PG8_BAR; PG8_SCHED;
            PG8_LDA(At, 1, 1); PG8_STAGE(PG8_SB(1, 0), b3, voffB); PG8_STAGE(PG8_SB(1, 1), b3 + hstep, voffB); PG8_STAGE(PG8_SA(1, 0), a3, voffA);
            PG8_WAIT_V(8); PG8_WAIT_L(0); PG8_BAR; PG8_MMA(1, 0, At, B0); PG8_MMA(1, 1, At, B1); PG8_BAR; PG8_SCHED;
            } else {
            PG8_LDB(B0, 0, 0); PG8_SCHED; PG8_LDA(At, 0, 0); PG8_STAGE(PG8_SA(1, 1), a1 + hstepA, voffA);
            PG8_WAIT_L(8); PG8_BAR; PG8_WAIT_L(0); PG8_MMA(0, 0, At, B0); PG8_BAR; PG8_SCHED;
            PG8_LDB(B1, 0, 1); PG8_STAGE(PG8_SB(0, 0), b2, voffB);
            PG8_BAR; PG8_WAIT_L(0); PG8_MMA(0, 1, At, B1); PG8_BAR;
            PG8_LDA(At, 0, 1); PG8_STAGE(PG8_SA(0, 0), a2, voffA);
            PG8_BAR; PG8_WAIT_L(0); PG8_MMA(1, 0, At, B0); PG8_BAR; PG8_SCHED;
            PG8_STAGE(PG8_SB(0, 1), b2 + hstep, voffB);
            PG8_WAIT_V(6); PG8_BAR; PG8_MMA(1, 1, At, B1); PG8_BAR;
            PG8_LDB(B0, 1, 0); PG8_SCHED; PG8_LDA(At, 1, 0); PG8_STAGE(PG8_SA(0, 1), a2 + hstepA, voffA);
            PG8_WAIT_L(8); PG8_BAR; PG8_WAIT_L(0); PG8_MMA(0, 0, At, B0); PG8_BAR; PG8_SCHED;
            PG8_LDB(B1, 1, 1); PG8_STAGE(PG8_SB(1, 0), b3, voffB);
            PG8_BAR; PG8_WAIT_L(0); PG8_MMA(0, 1, At, B1); PG8_BAR;
            PG8_LDA(At, 1, 1); PG8_STAGE(PG8_SA(1, 0), a3, voffA);
            PG8_BAR; PG8_WAIT_L(0); PG8_MMA(1, 0, At, B0); PG8_BAR; PG8_SCHED;
            PG8_STAGE(PG8_SB(1, 1), b3 + hstep, voffB);
            PG8_WAIT_V(6); PG8_BAR; PG8_MMA(1, 1, At, B1); PG8_BAR;
            }
        }
        if constexpr (ALIGN_EPI) { if (wr == 0) PG8_BAR; }
        if constexpr (!Epi::AFTER_DRAIN) { E(acc, cur, wr, wc, fr, fq); S.done(cur); }
        if (!has_next) break;
#pragma unroll
        for (int a = 0; a < 2; ++a)
#pragma unroll
            for (int b = 0; b < 2; ++b)
#pragma unroll
                for (int m = 0; m < 4; ++m)
#pragma unroll
                    for (int n = 0; n < 2; ++n) acc[a][b][m][n] = (f32x4){0.f, 0.f, 0.f, 0.f};
        cur = nxt; cA = nA; cB = nB; ++ui;
        if constexpr (ALIGN_EPI) { if (wr == 1) PG8_BAR; }
    }
    PG8_WAIT_V(0);
    if constexpr (!ALIGN_EPI) { if (wr == 0) PG8_BAR; }
    PG8_BAR;
    if constexpr (Epi::AFTER_DRAIN) { E.fused(acc, cur, wr, wc, fr, fq, lds, wid, lane); S.done(cur); }
#undef PG8_SA
#undef PG8_SB
#undef PG8_STAGE
#undef PG8_LDA
#undef PG8_LDB
#undef PG8_MMA
#undef PG8_WAIT_V
#undef PG8_WAIT_L
#undef PG8_BAR
#undef PG8_SCHED
}
}
constexpr int NWAVES = 8;
constexpr int BATCH = 8, SEQ = 4096, DM = 1024, TOK = BATCH * SEQ;
constexpr int TOKW = 768, MEMW = 256, MEML = 256, NGRP = 48, NST = 64, GCH = 16, NHEAD = 12, MHEAD = 4, HD = 64, FFN = 2816, NBLK = 16, MBLK = 256;
constexpr float C2 = 0.125f * 1.4426950408889634f;
constexpr float LOG2E = 1.4426950408889634f;

constexpr size_t MiB = 1u << 20;
constexpr size_t WS_CTL = 0, CTL_ZERO_BYTES = 1 * MiB;
constexpr size_t WS_S5TAB = 9 * MiB, WS_S5E = 13 * MiB;
constexpr size_t WS_SS0 = 1 * MiB, WS_SSA = 3 * MiB, WS_SSB = 5 * MiB, WS_SSM = 7 * MiB, WS_KMEAN = 8 * MiB;
constexpr size_t WS_WIN0 = 16 * MiB, WS_WGLU = 18 * MiB, WS_WIN1 = 20 * MiB, WS_WOUT0 = 26 * MiB, WS_WOUT1 = 28 * MiB;
constexpr size_t WS_WGU0 = 30 * MiB, WS_WGU1 = 41 * MiB, WS_WDN0 = 52 * MiB, WS_WDN1 = 58 * MiB, WS_WMKV = 64 * MiB;
constexpr size_t WS_MEMB = 65 * MiB, WS_MEMK = 69 * MiB, WS_MEMV = 70 * MiB;
constexpr size_t WS_XB = 72 * MiB;
constexpr size_t WS_R = 136 * MiB;
constexpr size_t WS_U = WS_R, WS_Y = WS_R + 48 * MiB;
constexpr size_t WS_Q1 = WS_R, WS_K1 = WS_R + 48 * MiB, WS_V1 = WS_R + 96 * MiB;
constexpr size_t WS_QM = WS_R + 144 * MiB;
constexpr size_t WS_MIX = WS_R + 160 * MiB;
constexpr size_t WS_H = WS_R;
constexpr size_t WS_END = WS_R + 224 * MiB;
constexpr int CW_BAR = 4096;

constexpr int RING_OFF = 0, RING_BYTES = 147456;
constexpr int LDSCTL_OFF = RING_BYTES, MISC_OFF = LDSCTL_OFF + 320;
constexpr int LDS_BYTES = RING_BYTES + 1024;

#define GAS __attribute__((address_space(1)))
#define LAS __attribute__((address_space(3)))
typedef unsigned short bf16;
typedef unsigned v4u __attribute__((ext_vector_type(4)));
typedef unsigned v2u __attribute__((ext_vector_type(2)));
typedef float f32x4 __attribute__((ext_vector_type(4)));
typedef GAS unsigned gu32;
typedef float f32x2 __attribute__((ext_vector_type(2)));
#define RLX_AGENT __ATOMIC_RELAXED, __HIP_MEMORY_SCOPE_AGENT
#define LDS_WAIT() asm volatile("s_waitcnt lgkmcnt(0)" ::: "memory")
#define VM_WAIT() asm volatile("s_waitcnt vmcnt(0)" ::: "memory")
__device__ __forceinline__ unsigned f2bf(float f) { unsigned u = __builtin_bit_cast(unsigned, f); return (u + 0x7fffu + ((u >> 16) & 1u)) >> 16; }
__device__ __forceinline__ unsigned pk2(float lo, float hi) { return f2bf(lo) | (f2bf(hi) << 16); }
__device__ __forceinline__ float bf2f(unsigned short h) { return __uint_as_float(((unsigned)h) << 16); }
__device__ __forceinline__ float bflo(unsigned w) { return __uint_as_float(w << 16); }
__device__ __forceinline__ float bfhi(unsigned w) { return __uint_as_float(w & 0xffff0000u); }

#define XB_TMO      128
#define XB_XCNT(j)  (256  + 64 * (j))
#define XB_XSUB(j)  (1280 + 64 * (j))
#define XB_XGEN(j)  (2304 + 64 * (j))
#define XB_TOP      3328
#define XB_TOPGEN   3392
#define XCD_BAR_WORDS 3456
#define XB_SPIN_CAP (1u << 18)

__device__ __forceinline__ unsigned xb_ld(unsigned* p)              { return __hip_atomic_load(p, __ATOMIC_RELAXED, __HIP_MEMORY_SCOPE_AGENT); }
__device__ __forceinline__ unsigned xb_add(unsigned* p, unsigned v) { return __hip_atomic_fetch_add(p, v, __ATOMIC_RELAXED, __HIP_MEMORY_SCOPE_AGENT); }
__device__ __forceinline__ unsigned xb_xcc_id() { return (unsigned)__builtin_amdgcn_s_getreg((3 << 11) | 20) & 0xFu; }
#define XB_SPIN(cond, bar) do { unsigned _sp = 0; while (cond) { __builtin_amdgcn_s_sleep(1); \
    if ((++_sp & 255u) == 0u) { if (xb_ld(&(bar)[XB_TMO])) break; if (_sp > XB_SPIN_CAP) { atomicAdd(&(bar)[XB_TMO], 1u); break; } } } } while (0)

struct XcdBarrier {
    unsigned* bar; unsigned x;
    volatile LAS unsigned* st;
};

__device__ __forceinline__ XcdBarrier xcd_barrier_post(unsigned* bar, volatile LAS unsigned* st) {
    XcdBarrier b; b.bar = bar; b.x = xb_xcc_id(); b.st = st;
    if (threadIdx.x == 0) (void)xb_add(&bar[XB_XCNT(b.x)], 1u);
    return b;
}
__device__ __forceinline__ void xcd_barrier_complete(unsigned* bar, unsigned x, unsigned& nloc, unsigned& nx) {
    const unsigned G = gridDim.x * gridDim.y * gridDim.z;
    unsigned sum, cnt, mine, sp = 0u;
    for (;;) {
        sum = 0u; cnt = 0u; mine = 0u;
#pragma unroll
        for (unsigned j = 0; j < 16; ++j) { const unsigned c = xb_ld(&bar[XB_XCNT(j)]); sum += c; cnt += (c > 0u) ? 1u : 0u; mine = (j == x) ? c : mine; }
        if (sum == G) break;
        __builtin_amdgcn_s_sleep(1);
        if ((++sp & 255u) == 0u) { if (xb_ld(&bar[XB_TMO])) break; if (sp > XB_SPIN_CAP) { atomicAdd(&bar[XB_TMO], 1u); break; } }
    }
    nloc = mine > 0u ? mine : 1u; nx = cnt > 0u ? cnt : 1u;
}

__device__ __forceinline__ void xcd_barrier(const XcdBarrier& b) {
    asm volatile("s_waitcnt vmcnt(0)" ::: "memory");
    __syncthreads();
    if (threadIdx.x == 0) {
        unsigned* bar = b.bar;
        __builtin_amdgcn_s_waitcnt(0);
        unsigned nloc = b.st[0], nx = b.st[1];
        if (nloc == 0u) { xcd_barrier_complete(bar, b.x, nloc, nx); b.st[0] = nloc; b.st[1] = nx; }
        const unsigned old = xb_add(&bar[XB_XSUB(b.x)], 1u);
        const unsigned gen = old / nloc;
        if (old + 1u == (gen + 1u) * nloc) {
            __builtin_amdgcn_fence(__ATOMIC_RELEASE, "agent");
            asm volatile("s_waitcnt vmcnt(0)" ::: "memory");
            const unsigned og = xb_add(&bar[XB_TOP], 1u);
            const unsigned tg = og / nx;
            if (og + 1u == (tg + 1u) * nx) xb_add(&bar[XB_TOPGEN], 1u);
            else XB_SPIN(xb_ld(&bar[XB_TOPGEN]) == tg, bar);
            __builtin_amdgcn_fence(__ATOMIC_ACQUIRE, "agent");
            xb_add(&bar[XB_XGEN(b.x)], 1u);
            asm volatile("s_waitcnt vmcnt(0)" ::: "memory");
        } else {
            XB_SPIN(xb_ld(&bar[XB_XGEN(b.x)]) == gen, bar);
            __builtin_amdgcn_fence(__ATOMIC_ACQUIRE, "agent");
            asm volatile("s_waitcnt vmcnt(0)" ::: "memory");
        }
    }
    __syncthreads();
}
namespace attn_body {
using bf16=__hip_bfloat16;
using bf16x8=__attribute__((ext_vector_type(8)))short;
using s16x4=__attribute__((ext_vector_type(4)))short;
using f32x16=__attribute__((ext_vector_type(16)))float;
using u32x4=__attribute__((ext_vector_type(4)))unsigned;
constexpr int D=64;
constexpr int NW=8,QBLK=32,QB=QBLK*NW,KVBLK=64;
__device__ __forceinline__ int crow(int r,int hi){return (r&3)+8*(r>>2)+4*hi;}
#define SBAR() __builtin_amdgcn_sched_barrier(0)
__device__ __forceinline__ void cmask(f32x16&p0,f32x16&p1,int jb,int qrel,int hi){
  const float NEG=-INFINITY; int kb=64*jb+4*hi;
  #pragma unroll
  for(int r=0;r<16;++r){int kv=kb+(r&3)+8*(r>>2); if(kv>qrel)p0[r]=NEG; if(kv+32>qrel)p1[r]=NEG;}
}

constexpr int NSLOT=3, SLOTB=8192;
constexpr int LDS_K=0, LDS_V=NSLOT*SLOTB, LDS_WS=2*NSLOT*SLOTB, LDS_OST=LDS_WS+NW*64*4, LDS_BYTES=LDS_OST+NW*4096;
__device__ __forceinline__ void glds16(const void*gsrc,unsigned lds_dst){unsigned keep;
  asm volatile("s_mov_b32 %0, m0\n\ts_mov_b32 m0, %2\n\ts_nop 0\n\tglobal_load_lds_dwordx4 %1, off\n\ts_mov_b32 m0, %0":"=&s"(keep):"v"(gsrc),"s"(lds_dst):"memory");}
__device__ __forceinline__ float max3f(float a,float b,float c){float r;asm("v_max3_f32 %0, %1, %2, %3":"=v"(r):"v"(a),"v"(b),"v"(c));return r;}
__device__ __forceinline__ float max2f(float a,float b){float r;asm("v_max_f32_e32 %0, %1, %2":"=v"(r):"v"(a),"v"(b));return r;}
__device__ __forceinline__ float fadd_s(float a,float b){float r;asm("v_add_f32_e32 %0, %1, %2":"=v"(r):"v"(a),"v"(b));return r;}
__device__ __forceinline__ float fsub_s(float a,float b){float r;asm("v_sub_f32_e32 %0, %1, %2":"=v"(r):"v"(a),"v"(b));return r;}
typedef float f32x2_t __attribute__((ext_vector_type(2))); typedef float f32x4_t __attribute__((ext_vector_type(4))); typedef __bf16 bf16x2_t __attribute__((ext_vector_type(2)));
__device__ __forceinline__ unsigned cvtpk_s(float lo,float hi){f32x2_t v={lo,hi};bf16x2_t b=__builtin_convertvector(v,bf16x2_t);return __builtin_bit_cast(unsigned,b);}
#define WAIT_BAR(N) asm volatile("s_waitcnt vmcnt(" #N ") lgkmcnt(0)\n\ts_barrier":::"memory")

__device__ __forceinline__ void qkt(f32x16&p0,f32x16&p1,const char*Kslot,const bf16x8*qr,int r32,int hi){
  const char*kb=Kslot+hi*1024+r32*16;
  #pragma unroll
  for(int d0=0;d0<4;++d0){
    const bf16x8 b0=*reinterpret_cast<const bf16x8*>(kb+d0*2048);
    const bf16x8 b1=*reinterpret_cast<const bf16x8*>(kb+d0*2048+512);
    p0=__builtin_amdgcn_mfma_f32_32x32x16_bf16(b0,qr[d0],p0,0,0,0);p1=__builtin_amdgcn_mfma_f32_32x32x16_bf16(b1,qr[d0],p1,0,0,0);}
}
typedef __attribute__((address_space(3))) const char* lds_cptr;
typedef short v4i16_t __attribute__((ext_vector_type(4)));
__device__ __forceinline__ void kload8(bf16x8*kf,lds_cptr kp){
  kf[0]=*(const __attribute__((address_space(3))) bf16x8*)(kp);      kf[1]=*(const __attribute__((address_space(3))) bf16x8*)(kp+512);
  kf[2]=*(const __attribute__((address_space(3))) bf16x8*)(kp+2048); kf[3]=*(const __attribute__((address_space(3))) bf16x8*)(kp+2560);
  kf[4]=*(const __attribute__((address_space(3))) bf16x8*)(kp+4096); kf[5]=*(const __attribute__((address_space(3))) bf16x8*)(kp+4608);
  kf[6]=*(const __attribute__((address_space(3))) bf16x8*)(kp+6144); kf[7]=*(const __attribute__((address_space(3))) bf16x8*)(kp+6656);
}
__device__ __forceinline__ void kload2(bf16x8*kf,lds_cptr kp,int j){ kf[2*j]=*(const __attribute__((address_space(3))) bf16x8*)(kp+j*2048); kf[2*j+1]=*(const __attribute__((address_space(3))) bf16x8*)(kp+j*2048+512); }
__device__ __forceinline__ s16x4 vtr(lds_cptr p){ return __builtin_bit_cast(s16x4,__builtin_amdgcn_ds_read_tr16_b64_v4i16((__attribute__((address_space(3))) v4i16_t*)p)); }
__device__ __forceinline__ float rowmax(const f32x16&p0,const f32x16&p1){
  float a=max3f(p0[0],p0[1],p1[0]),b=max3f(p0[2],p0[3],p1[1]);a=max3f(a,p1[2],p1[3]);
  #pragma unroll
  for(int r=4;r<16;r+=4){a=max3f(a,p0[r],p0[r+1]);b=max3f(b,p0[r+2],p0[r+3]);a=max3f(a,p1[r],p1[r+1]);b=max3f(b,p1[r+2],p1[r+3]);}
  const float m=max2f(a,b);
  auto rr=__builtin_amdgcn_permlane32_swap(__float_as_uint(m),__float_as_uint(m),false,false);
  return max2f(__uint_as_float(rr[0]),__uint_as_float(rr[1]));
}
__device__ __forceinline__ void pv(f32x16*o,int vb,bf16x8 pa0,bf16x8 pa1,bf16x8 pa2,bf16x8 pa3){
  #pragma unroll
  for(int d0=0;d0<2;++d0){s16x4 lo[4],hi[4];
    #pragma unroll
    for(int ks=0;ks<4;++ks){
      asm volatile("ds_read_b64_tr_b16 %0,%1 offset:%c2":"=&v"(lo[ks]):"v"(vb),"i"(d0*4096+ks*1024):"memory");
      asm volatile("ds_read_b64_tr_b16 %0,%1 offset:%c2":"=&v"(hi[ks]):"v"(vb),"i"(d0*4096+ks*1024+512):"memory");}
    asm volatile("s_waitcnt lgkmcnt(0)":::"memory");SBAR();
    #define PK(k) (bf16x8){lo[k][0],lo[k][1],lo[k][2],lo[k][3],hi[k][0],hi[k][1],hi[k][2],hi[k][3]}
    o[d0]=__builtin_amdgcn_mfma_f32_32x32x16_bf16(pa0,PK(0),o[d0],0,0,0);
    o[d0]=__builtin_amdgcn_mfma_f32_32x32x16_bf16(pa1,PK(1),o[d0],0,0,0);
    o[d0]=__builtin_amdgcn_mfma_f32_32x32x16_bf16(pa2,PK(2),o[d0],0,0,0);
    o[d0]=__builtin_amdgcn_mfma_f32_32x32x16_bf16(pa3,PK(3),o[d0],0,0,0);
    #undef PK
  }
}

#ifndef ATTN_STORE16
#define ATTN_STORE16(p,v) (*(u32x4*)(p)=(v))
#endif
template<int MODE,int THRL,int QP,int KP,int OP> __device__ __forceinline__ void attn_unit(const bf16*Qw0,const bf16*__restrict__ Kh,const bf16*__restrict__ Vh,bf16*Ow0,const int NT,
                                                                                          const float slope2,const float*kms0,const float*kms1,const int qb,char*shm){
  int tid_=threadIdx.x; asm volatile("":"+v"(tid_));
  const int tid=tid_,lane=tid&63,r32=lane&31,hi=lane>>5; const int wid=__builtin_amdgcn_readfirstlane(tid>>6);
  const bf16*Qw=Qw0+(long)(wid*QBLK)*QP;
  const unsigned lds0=(unsigned)(uintptr_t)shm;
  float*wsf=(float*)(shm+LDS_WS)+wid*64;
  const bf16*ksrc=Kh+(long)lane*KP+wid*8;
  const bf16*vsrc=Vh+(long)(16*(wid&3)+(lane>>2))*KP+(wid>>2)*32+(lane&3)*8;
  const unsigned kdst=lds0+LDS_K+wid*1024, vdst=lds0+LDS_V+wid*1024;
  #define PT(t) ((MODE==0)?(NT-1-(t)):(((t)<NT-4)?(NT-5-(t)):(t)))
  #define DMA_K(t,slot) glds16(ksrc+(long)PT(t)*KVBLK*KP,(unsigned)__builtin_amdgcn_readfirstlane(kdst+(slot)))
  #define DMA_V(t,slot) glds16(vsrc+(long)PT(t)*KVBLK*KP,(unsigned)__builtin_amdgcn_readfirstlane(vdst+(slot)))
  const int vb0=(int)(lds0+LDS_V)+((lane>>4)&1)*32+(lane&3)*8+(4*hi+((lane&15)>>2))*64;
  const char*Kbase=shm+LDS_K; bf16x8 kf[8];
  const lds_cptr shm3=(lds_cptr)shm; const lds_cptr kp0=shm3+LDS_K+hi*1024+r32*16; const lds_cptr vp0=shm3+LDS_V+((lane>>4)&1)*32+(lane&3)*8+(4*hi+((lane&15)>>2))*64;
  DMA_K(0,0);DMA_V(0,0);DMA_K(1,SLOTB);
  bf16x8 qr[4];
  #pragma unroll
  for(int d0=0;d0<4;++d0)qr[d0]=*reinterpret_cast<const bf16x8*>(&Qw[(long)r32*QP+d0*16+hi*8]);
  unsigned selm=0xffffffffu;
  if constexpr(MODE==1){
    f32x16 G=f32x16{};
    #pragma unroll
    for(int d0=0;d0<4;++d0){
      bf16x8 ah=bf16x8{},al=bf16x8{};
      if(r32<16){ const float*p0_=kms0+r32*64+d0*16+hi*8,*p1_=kms1+r32*64+d0*16+hi*8;
        const f32x4_t s0=*reinterpret_cast<const f32x4_t*>(p0_)+*reinterpret_cast<const f32x4_t*>(p1_), s1=*reinterpret_cast<const f32x4_t*>(p0_+4)+*reinterpret_cast<const f32x4_t*>(p1_+4);
        const float km_[8]={s0[0],s0[1],s0[2],s0[3],s1[0],s1[1],s1[2],s1[3]};
        #pragma unroll
        for(int i_=0;i_<8;i_+=2){ const unsigned wh_=cvtpk_s(km_[i_],km_[i_+1]); const float r0_=km_[i_]-__uint_as_float(wh_<<16), r1_=km_[i_+1]-__uint_as_float(wh_&0xffff0000u); const unsigned wl_=cvtpk_s(r0_,r1_);
          ah[i_]=(short)(wh_&0xffffu); ah[i_+1]=(short)(wh_>>16); al[i_]=(short)(wl_&0xffffu); al[i_+1]=(short)(wl_>>16); } }
      G=__builtin_amdgcn_mfma_f32_32x32x16_bf16(ah,qr[d0],G,0,0,0); G=__builtin_amdgcn_mfma_f32_32x32x16_bf16(al,qr[d0],G,0,0,0);}
    float g[16];
    #pragma unroll
    for(int r=0;r<4;++r){ const float a=G[r],b=G[4+r]; const float oa=__shfl_xor(a,32),ob=__shfl_xor(b,32);
      g[r]=hi?oa:a; g[4+r]=hi?a:oa; g[8+r]=hi?ob:b; g[12+r]=hi?b:ob; }
    #pragma unroll
    for(int n=0;n<16;++n) if(n>=qb) g[n]=-1.0e30f;
    const int nsel=qb<3?qb:3; unsigned mask=0u;
    #pragma unroll
    for(int rr=0;rr<3;++rr){ float best=-3.0e38f; int bi=0;
      #pragma unroll
      for(int n=0;n<16;++n){ const bool c=!((mask>>n)&1u)&&g[n]>best; best=c?g[n]:best; bi=c?n:bi; }
      if(rr<nsel) mask|=1u<<bi; }
    selm=mask|(1u<<qb);
  }
  float mhat=0.f,l_reg=0.f;f32x16 o[2];o[0]=f32x16{};o[1]=f32x16{};
  const int qrel=wid*QBLK+r32;
  const float hb=(MODE==1)?slope2*(float)(4*hi):0.f, s32=(MODE==1)?32.f*slope2:0.f, s64=(MODE==1)?64.f*slope2:0.f;
  #define CBASE(b0_,b1_,t) float b0_=fsub_s(fadd_s(s64*(float)PT(t),hb),mhat); if(MODE==1){ if(!((selm>>(PT(t)>>2))&1u)) b0_=-3.0e38f; } const float b1_=b0_+s32
  #define CFILL(X,B,bb) do{ _Pragma("unroll") for(int i_=0;i_<4;++i_){ if(MODE==1) X[(B)+i_]=__builtin_fmaf(slope2,(float)((((B)+i_)&3)+8*(((B)+i_)>>2)),bb); else X[(B)+i_]=bb; } }while(0)
  #define CINIT(C0,C1,t) do{ CBASE(b0_,b1_,t); CFILL(C0,0,b0_);CFILL(C0,4,b0_);CFILL(C0,8,b0_);CFILL(C0,12,b0_);CFILL(C1,0,b1_);CFILL(C1,4,b1_);CFILL(C1,8,b1_);CFILL(C1,12,b1_); }while(0)
  #define CMASK(P0,P1,t) do{ if(MODE==1){ int jb_=(t)-(NT-4); if(jb_>=0)cmask(P0,P1,jb_,qrel,hi);} }while(0)
  bool resc=false;
  #define START(P0,P1) do{ const float rm=rowmax(P0,P1); resc=false; \
    { const float dl=__builtin_fmaxf(rm,-1000.f); mhat=fadd_s(mhat,dl); \
      _Pragma("unroll") for(int r=0;r<16;++r){P0[r]=fsub_s(P0[r],dl);P1[r]=fsub_s(P1[r],dl);} } \
    _Pragma("unroll") for(int r=0;r<16;++r)P0[r]=__builtin_amdgcn_exp2f(P0[r]); }while(0)
  #define RESC() do{ if(resc){ asm volatile("s_waitcnt lgkmcnt(0)":::"memory"); \
      _Pragma("unroll") for(int d_=0;d_<2;++d_) _Pragma("unroll") for(int r=0;r<16;++r)o[d_][r]*=wsf[crow(r,hi)]; } }while(0)
  f32x16 pA0,pA1,pB0,pB1;
  int sl_prev=0,sl_cur=0,sl_next=SLOTB;
  #define ROT() do{sl_prev=sl_cur;sl_cur=sl_next;sl_next=(sl_next==(NSLOT-1)*SLOTB)?0:sl_next+SLOTB;}while(0)
  DMA_K(2,2*SLOTB);
  WAIT_BAR(3);
  CINIT(pA0,pA1,0);
  qkt(pA0,pA1,Kbase,qr,r32,hi);asm volatile("s_nop 15\n\ts_nop 7":"+v"(pA0),"+v"(pA1));CMASK(pA0,pA1,0);
  START(pA0,pA1);
  _Pragma("unroll") for(int r=0;r<16;++r)pA1[r]=__builtin_amdgcn_exp2f(pA1[r]);
  WAIT_BAR(0);
  DMA_K(3,0);DMA_V(1,SLOTB);
  ROT();
  kload8(kf,kp0+sl_cur);
  WAIT_BAR(2);
  s16x4 vlo[8],vhi[8]; u32x4 pw0,pw1,pw2,pw3;
  #define PKW(P,B) cvtpk_s(P[B],P[B+1])
  #define PAF(k) __builtin_bit_cast(bf16x8,pw##k)
  #define VFR(i) (bf16x8){vlo[i][0],vlo[i][1],vlo[i][2],vlo[i][3],vhi[i][0],vhi[i][1],vhi[i][2],vhi[i][3]}
  #define PIN(x) asm volatile("":"+v"(x))
  #define MX3(a,b,c) __builtin_fmaxf(__builtin_fmaxf((a),(b)),(c))
  #define GAPA(MF,A0,A1,A2,A3,W0,W1,PW) do{ MF; sacc+=A0; sacc+=A1; sacc+=A2; sacc+=A3; PIN(sacc); W0; W1; PIN(PW); SBAR(); }while(0)
  #define EX(v) __builtin_amdgcn_exp2f(v)
  #define GAPB(MF,X,B,N,bb) do{ MF; X[B]=EX(X[B]); X[B+1]=EX(X[B+1]); X[B+2]=EX(X[B+2]); X[B+3]=EX(X[B+3]); PIN(X); CFILL(N,B,bb); PIN(N); SBAR(); }while(0)
  #define VRD(i) do{ vlo[i]=vtr(vp_+(((i)>>2)*4096+((i)&3)*1024)); vhi[i]=vtr(vp_+(((i)>>2)*4096+((i)&3)*1024+512)); }while(0)
  #define KRD(G,j) do{ if(G){ kload2(kf,kp0+sl_next,j); SBAR(); } }while(0)
  #define STEP(C0,C1,P0,P1,t,GK,GV,GL) do{ SBAR(); \
    const lds_cptr vp_=vp0+sl_prev; \
    VRD(0); SBAR(); float sacc=(P0[0]+P0[1]); \
    GAPA(C0=__builtin_amdgcn_mfma_f32_32x32x16_bf16(kf[0],qr[0],C0,0,0,0), P0[2],P0[3],P0[4],P0[5],     pw0[0]=PKW(P0,0), pw0[1]=PKW(P0,2), pw0); \
    VRD(4); SBAR(); GAPA(C1=__builtin_amdgcn_mfma_f32_32x32x16_bf16(kf[1],qr[0],C1,0,0,0), P0[6],P0[7],P0[8],P0[9],     pw0[2]=PKW(P0,4), pw0[3]=PKW(P0,6), pw0); \
    VRD(1); SBAR(); GAPA(C0=__builtin_amdgcn_mfma_f32_32x32x16_bf16(kf[2],qr[1],C0,0,0,0),   P0[10],P0[11],P0[12],P0[13], pw1[0]=PKW(P0,8), pw1[1]=PKW(P0,10), pw1); \
    VRD(5); SBAR(); GAPA(C1=__builtin_amdgcn_mfma_f32_32x32x16_bf16(kf[3],qr[1],C1,0,0,0),   P0[14],P0[15],P1[0],P1[1],   pw1[2]=PKW(P0,12),pw1[3]=PKW(P0,14), pw1); \
    VRD(2); SBAR(); GAPA(C0=__builtin_amdgcn_mfma_f32_32x32x16_bf16(kf[4],qr[2],C0,0,0,0),   P1[2],P1[3],P1[4],P1[5],     pw2[0]=PKW(P1,0), pw2[1]=PKW(P1,2), pw2); \
    VRD(6); SBAR(); GAPA(C1=__builtin_amdgcn_mfma_f32_32x32x16_bf16(kf[5],qr[2],C1,0,0,0),   P1[6],P1[7],P1[8],P1[9],     pw2[2]=PKW(P1,4), pw2[3]=PKW(P1,6), pw2); \
    VRD(3); SBAR(); GAPA(C0=__builtin_amdgcn_mfma_f32_32x32x16_bf16(kf[6],qr[3],C0,0,0,0),   P1[10],P1[11],P1[12],P1[13], pw3[0]=PKW(P1,8), pw3[1]=PKW(P1,10), pw3); \
    VRD(7); SBAR(); GAPA(C1=__builtin_amdgcn_mfma_f32_32x32x16_bf16(kf[7],qr[3],C1,0,0,0),   P1[14],P1[15],0.f,0.f,       pw3[2]=PKW(P1,12),pw3[3]=PKW(P1,14), pw3); \
    l_reg+=sacc; \
    if(GK){DMA_K((t)+3,sl_cur);} if(GV){DMA_V((t)+1,sl_next);} \
    CMASKX(C0,C1,t); \
    { float a=MX3(C0[0],C0[1],C1[0]),b=MX3(C0[2],C0[3],C1[1]); a=MX3(a,C1[2],C1[3]); \
      _Pragma("unroll") for(int r=4;r<16;r+=4){a=MX3(a,C0[r],C0[r+1]);b=MX3(b,C0[r+2],C0[r+3]);a=MX3(a,C1[r],C1[r+1]);b=MX3(b,C1[r+2],C1[r+3]);} \
      float rm=__builtin_fmaxf(a,b); { auto rr=__builtin_amdgcn_permlane32_swap(__float_as_uint(rm),__float_as_uint(rm),false,false); rm=__builtin_fmaxf(__uint_as_float(rr[0]),__uint_as_float(rr[1])); } \
      resc=false; \
      if(__builtin_expect(__any(rm>(float)THRL),0)){ const float dl=__builtin_fmaxf(rm,0.f); mhat+=dl; \
        _Pragma("unroll") for(int r=0;r<16;++r){C0[r]-=dl;C1[r]-=dl;} \
        const float f=__builtin_amdgcn_exp2f(-dl); l_reg*=f; if(hi==0)wsf[r32]=f; resc=true; } } \
    CBASE(n0_,n1_,(t)+1);                                   \
    SBAR(); \
    GAPB(o[0]=__builtin_amdgcn_mfma_f32_32x32x16_bf16(PAF(0),VFR(0),o[0],0,0,0), C0,0, P0,n0_); \
    GAPB(o[1]=__builtin_amdgcn_mfma_f32_32x32x16_bf16(PAF(0),VFR(4),o[1],0,0,0), C0,4, P0,n0_); \
    KRD(GL,0); GAPB(o[0]=__builtin_amdgcn_mfma_f32_32x32x16_bf16(PAF(1),VFR(1),o[0],0,0,0), C0,8, P0,n0_); \
    KRD(GL,1); GAPB(o[1]=__builtin_amdgcn_mfma_f32_32x32x16_bf16(PAF(1),VFR(5),o[1],0,0,0), C0,12, P0,n0_); \
    KRD(GL,2); GAPB(o[0]=__builtin_amdgcn_mfma_f32_32x32x16_bf16(PAF(2),VFR(2),o[0],0,0,0), C1,0, P1,n1_); \
    KRD(GL,3); GAPB(o[1]=__builtin_amdgcn_mfma_f32_32x32x16_bf16(PAF(2),VFR(6),o[1],0,0,0), C1,4, P1,n1_); \
    GAPB(o[0]=__builtin_amdgcn_mfma_f32_32x32x16_bf16(PAF(3),VFR(3),o[0],0,0,0), C1,8, P1,n1_); \
    GAPB(o[1]=__builtin_amdgcn_mfma_f32_32x32x16_bf16(PAF(3),VFR(7),o[1],0,0,0), C1,12, P1,n1_); \
    }while(0)
  int t=1;
  CINIT(pB0,pB1,1);
  #define ENDW(tt) do{ if((tt)+3<NT){WAIT_BAR(2);} else if((tt)+2<NT){WAIT_BAR(1);} else {WAIT_BAR(0);} }while(0)
  #define CMASKX(P0,P1,t) do{ asm volatile("; head step (masked)"); CMASK(P0,P1,t); }while(0)
  for(;t+1<NT&&t<5;t+=2){
    STEP(pB0,pB1,pA0,pA1,t,(t+3<NT),(t+1<NT),(t+1<NT));       ENDW(t);   RESC(); ROT();
    STEP(pA0,pA1,pB0,pB1,t+1,(t+4<NT),(t+2<NT),(t+2<NT));     ENDW(t+1); RESC(); ROT();
  }
  #undef CMASKX
  #define CMASKX(P0,P1,t) do{ asm volatile("; steady step (no mask)"); }while(0)
  for(;t+5<NT;t+=2){
    STEP(pB0,pB1,pA0,pA1,t,true,true,true);     WAIT_BAR(2); RESC(); ROT();
    STEP(pA0,pA1,pB0,pB1,t+1,true,true,true);   WAIT_BAR(2); RESC(); ROT();
  }
  #undef CMASKX
  #define CMASKX(P0,P1,t) do{ asm volatile("; tail step (masked)"); CMASK(P0,P1,t); }while(0)
  for(;t+1<NT;t+=2){
    STEP(pB0,pB1,pA0,pA1,t,(t+3<NT),(t+1<NT),(t+1<NT));       ENDW(t);   RESC(); ROT();
    STEP(pA0,pA1,pB0,pB1,t+1,(t+4<NT),(t+2<NT),(t+2<NT));     ENDW(t+1); RESC(); ROT();
  }
  STEP(pB0,pB1,pA0,pA1,NT-1,false,false,false); RESC();
  { float sacc=pB0[0]+pB0[1]; _Pragma("unroll") for(int r=2;r<16;++r)sacc+=pB0[r]; _Pragma("unroll") for(int r=0;r<16;++r)sacc+=pB1[r]; l_reg+=sacc;
    pw0=(u32x4){PKW(pB0,0),PKW(pB0,2),PKW(pB0,4),PKW(pB0,6)};pw1=(u32x4){PKW(pB0,8),PKW(pB0,10),PKW(pB0,12),PKW(pB0,14)};pw2=(u32x4){PKW(pB1,0),PKW(pB1,2),PKW(pB1,4),PKW(pB1,6)};pw3=(u32x4){PKW(pB1,8),PKW(pB1,10),PKW(pB1,12),PKW(pB1,14)};
    SBAR(); pv(o,vb0+sl_cur,PAF(0),PAF(1),PAF(2),PAF(3)); }
  #undef PKW
  #undef PAF
  #undef VFR
  #undef PIN
  #undef MX3
  #undef GAPA
  #undef GAPB
  #undef EX
  #undef VRD
  #undef KRD
  #undef STEP
  #undef ENDW
  #undef CMASKX
  {auto rr=__builtin_amdgcn_permlane32_swap(__float_as_uint(l_reg),__float_as_uint(l_reg),false,false);l_reg=__uint_as_float(rr[0])+__uint_as_float(rr[1]);}
  if(hi==0)wsf[32+r32]=l_reg;asm volatile("s_waitcnt lgkmcnt(0)":::"memory");
  float rli[16];
  #pragma unroll
  for(int r=0;r<16;++r)rli[r]=__builtin_amdgcn_rcpf(wsf[32+crow(r,hi)]);
  bf16*Ow=Ow0+(long)(wid*QBLK)*OP;
  { bf16*stg=(bf16*)(shm+LDS_OST)+wid*2048;
    #pragma unroll
    for(int r=0;r<16;++r){const int orow=crow(r,hi);
      #pragma unroll
      for(int d0=0;d0<2;++d0)stg[orow*64+d0*32+r32]=__float2bfloat16(o[d0][r]*rli[r]);}
    asm volatile("s_waitcnt lgkmcnt(0)":::"memory");
    #pragma unroll
    for(int i=0;i<4;++i){const int row=i*8+(lane>>3),ch=lane&7; const u32x4 v=*(const u32x4*)(stg+row*64+ch*8); ATTN_STORE16(Ow+(long)row*OP+ch*8,v);} }
  asm volatile("s_waitcnt lgkmcnt(0)\n\ts_barrier":::"memory");
  #undef DMA_K
  #undef DMA_V
  #undef CMASK
  #undef CINIT
  #undef CBASE
  #undef CFILL
  #undef PT
  #undef START
  #undef RESC
  #undef ROT
}
constexpr int ATTN_LDS_BYTES=LDS_BYTES;
#undef SBAR
#undef WAIT_BAR
}
__device__ __forceinline__ float wave_sum(float v) {
#pragma unroll
    for (int o = 1; o < 64; o <<= 1) v += __shfl_xor(v, o);
    return v;
}
__device__ __forceinline__ float wave_max(float v) {
#pragma unroll
    for (int o = 1; o < 64; o <<= 1) v = fmaxf(v, __shfl_xor(v, o));
    return v;
}
__device__ __forceinline__ int opaque_zero() { int z; asm volatile("v_mov_b32 %0, 0" : "=v"(z)); return z; }

__device__ __forceinline__ void p0_transpose_item(const float* W, int K, int N, bf16* WT, int dest_row0, int k0, int n0, const float* gk, LAS float* scr, int lane) {
    float wv[32];
#pragma unroll
    for (int i = 0; i < 32; ++i) { const int kk = 2 * i + (lane >> 5); wv[i] = W[(size_t)(k0 + kk) * N + n0 + (lane & 31)]; }
    if (gk) {
#pragma unroll
        for (int i = 0; i < 32; ++i) wv[i] *= gk[k0 + 2 * i + (lane >> 5)]; }
#pragma unroll
    for (int i = 0; i < 32; ++i) { const int kk = 2 * i + (lane >> 5); scr[kk * 33 + (lane & 31)] = wv[i]; }
    LDS_WAIT(); asm volatile("" ::: "memory");
    const int c = lane & 7;
#pragma unroll
    for (int j = 0; j < 4; ++j) { const int n = (lane >> 3) + 8 * j; const LAS float* s = scr + (8 * c) * 33 + n;
        v4u o; o.x = pk2(s[0 * 33], s[1 * 33]); o.y = pk2(s[2 * 33], s[3 * 33]); o.z = pk2(s[4 * 33], s[5 * 33]); o.w = pk2(s[6 * 33], s[7 * 33]);
        *(GAS v4u*)(WT + (size_t)(dest_row0 + n) * K + k0 + 8 * c) = o; }
    LDS_WAIT(); asm volatile("" ::: "memory");
}
__device__ __forceinline__ void p0_matrix_item(const float* W, int K, int N, bf16* WT, const float* gk, int mode, int item, LAS float* scr, int lane) {
    const int nblk = N / 32, kb = item / nblk, nb = item - kb * nblk, k0 = 64 * kb, n0 = 32 * nb;
    const int dr = (mode == 0) ? n0 : (256 * (n0 >> 7) + (n0 & 127) + (mode == 2 ? 128 : 0));
    p0_transpose_item(W, K, N, WT, dr, k0, n0, gk, scr, lane);
}
template <int NR>
__device__ __forceinline__ void rows_to_bf16_ssq(const float* xrow, bf16* orow, float* ssq16, int lane) {
    f32x4 v[NR][4];
#pragma unroll
    for (int r = 0; r < NR; ++r) { const GAS f32x4* xr = (const GAS f32x4*)(xrow + (size_t)r * 1024) + lane;
#pragma unroll
        for (int j = 0; j < 4; ++j) v[r][j] = xr[64 * j]; }
#pragma unroll
    for (int r = 0; r < NR; ++r) { float s = 0.f;
#pragma unroll
        for (int j = 0; j < 4; ++j) s += (v[r][j].x * v[r][j].x + v[r][j].y * v[r][j].y) + (v[r][j].z * v[r][j].z + v[r][j].w * v[r][j].w);
        s = wave_sum(s);
        GAS unsigned long long* o8 = (GAS unsigned long long*)(orow + (size_t)r * 1024) + lane;
#pragma unroll
        for (int j = 0; j < 4; ++j) o8[64 * j] = (unsigned long long)pk2(v[r][j].x, v[r][j].y) | ((unsigned long long)pk2(v[r][j].z, v[r][j].w) << 32);
        if (lane < 16) ssq16[r * 16 + lane] = (lane == 0) ? s : 0.f; }
}

__device__ __forceinline__ void s5_naive_unit(int b, int g, const bf16* U, bf16* Y, const float* lam_re, const float* lam_im, const float* log_dt, const float* b_re, const float* b_im,
                                              const float* c_re, const float* c_im, const float* dvec, int lane) {
    const int p = lane;
    const float lr = lam_re[g * 64 + p], li = lam_im[g * 64 + p], dt = expf(log_dt[g]);
    const float mag = expf(lr * dt), ar = mag * cosf(li * dt), ai = mag * sinf(li * dt);
    const float den = lr * lr + li * li, nr = ar - 1.0f, fr = (nr * lr + ai * li) / den, fi = (ai * lr - nr * li) / den;
    float bbr[16], bbi[16], cr[16], ci[16];
#pragma unroll
    for (int c = 0; c < 16; ++c) { const float br = b_re[((size_t)g * 64 + p) * 16 + c], bi = b_im[((size_t)g * 64 + p) * 16 + c]; bbr[c] = fr * br - fi * bi; bbi[c] = fr * bi + fi * br;
        cr[c] = c_re[((size_t)g * 16 + c) * 64 + p]; ci[c] = c_im[((size_t)g * 16 + c) * 64 + p]; }
    const int ch = ((lane & 1) << 3) | ((lane & 2) << 1) | ((lane & 4) >> 1) | ((lane & 8) >> 3);
    const float dch = dvec[16 * g + ch];
    const int z0 = opaque_zero();
    constexpr int TP = 16;
    const bf16* up = U + ((size_t)g * TOK + (size_t)b * SEQ) * 16 + z0;
    bf16* yp = Y + ((size_t)g * TOK + (size_t)b * SEQ) * 16 + ch;
    float xr = 0.f, xi = 0.f;
#pragma unroll 2
    for (int s = 0; s < SEQ; ++s) {
        const v4u w0 = *(const GAS v4u*)(up + (size_t)s * TP), w1 = *(const GAS v4u*)(up + (size_t)s * TP + 8);
        const float uch = bf2f(up[(size_t)s * TP + ch]);
        const float uu[16] = {bflo(w0.x), bfhi(w0.x), bflo(w0.y), bfhi(w0.y), bflo(w0.z), bfhi(w0.z), bflo(w0.w), bfhi(w0.w), bflo(w1.x), bfhi(w1.x), bflo(w1.y), bfhi(w1.y), bflo(w1.z), bfhi(w1.z), bflo(w1.w), bfhi(w1.w)};
        float bur = 0.f, bui = 0.f;
#pragma unroll
        for (int c = 0; c < 16; ++c) { bur += bbr[c] * uu[c]; bui += bbi[c] * uu[c]; }
        const float nxr = ar * xr - ai * xi + bur, nxi = ar * xi + ai * xr + bui; xr = nxr; xi = nxi;
        float v[16];
#pragma unroll
        for (int c = 0; c < 16; ++c) v[c] = cr[c] * xr - ci[c] * xi;
        float w[8], x4[4], x2[2], z;
        { const bool bit = lane & 1;
#pragma unroll
          for (int j = 0; j < 8; ++j) { const float send = bit ? v[j] : v[j + 8], keep = bit ? v[j + 8] : v[j]; w[j] = keep + __shfl_xor(send, 1); } }
        { const bool bit = lane & 2;
#pragma unroll
          for (int j = 0; j < 4; ++j) { const float send = bit ? w[j] : w[j + 4], keep = bit ? w[j + 4] : w[j]; x4[j] = keep + __shfl_xor(send, 2); } }
        { const bool bit = lane & 4;
#pragma unroll
          for (int j = 0; j < 2; ++j) { const float send = bit ? x4[j] : x4[j + 2], keep = bit ? x4[j + 2] : x4[j]; x2[j] = keep + __shfl_xor(send, 4); } }
        { const bool bit = lane & 8; const float send = bit ? x2[0] : x2[1], keep = bit ? x2[1] : x2[0]; z = keep + __shfl_xor(send, 8); }
        z += __shfl_xor(z, 16); z += __shfl_xor(z, 32);
        const float yv = z + dch * uch;
        const float ge = 0.5f * yv * (1.0f + erff(yv * 0.70710678118654752f));
        if (lane < 16) yp[(size_t)s * TP] = (bf16)f2bf(ge);
    }
}

__device__ __forceinline__ void memattn_naive_unit(int tok, int h, const bf16* QM, const bf16* memk, const bf16* memv, bf16* mix, LAS float* ps, int lane) {
    const int b = tok >> 12; const int z0 = opaque_zero();
    const float qv = bf2f(QM[(size_t)tok * 256 + h * 64 + lane]);
    float q[64];
#pragma unroll
    for (int d = 0; d < 64; ++d) q[d] = __shfl(qv, d);
    float sc[4];
#pragma unroll
    for (int i = 0; i < 4; ++i) { const int j = lane + 64 * i; const GAS v4u* kr = (const GAS v4u*)(memk + ((size_t)(b * 256 + j)) * 256 + h * 64 + z0); float a = 0.f;
#pragma unroll
        for (int c = 0; c < 8; ++c) { const v4u w = kr[c]; a += q[8 * c] * bflo(w.x) + q[8 * c + 1] * bfhi(w.x) + q[8 * c + 2] * bflo(w.y) + q[8 * c + 3] * bfhi(w.y) + q[8 * c + 4] * bflo(w.z) + q[8 * c + 5] * bfhi(w.z) + q[8 * c + 6] * bflo(w.w) + q[8 * c + 7] * bfhi(w.w); }
        sc[i] = a; }
    const float m = wave_max(fmaxf(fmaxf(sc[0], sc[1]), fmaxf(sc[2], sc[3])));
    float l = 0.f;
#pragma unroll
    for (int i = 0; i < 4; ++i) { const float pe = __builtin_amdgcn_exp2f(sc[i] - m); l += pe; ps[lane + 64 * i] = pe; }
    l = wave_sum(l);
    LDS_WAIT(); asm volatile("" ::: "memory");
    float o = 0.f; const bf16* vp = memv + (size_t)(b * 256) * 256 + h * 64 + lane;
#pragma unroll 8
    for (int j = 0; j < 256; ++j) o += ps[j] * bf2f(vp[(size_t)j * 256]);
    mix[(size_t)tok * 1024 + 768 + h * 64 + lane] = (bf16)f2bf(o / l);
    LDS_WAIT(); asm volatile("" ::: "memory");
}

__device__ __forceinline__ float dot64_bf16(const float (&q)[64], const GAS v4u* kr) {
    float a = 0.f;
#pragma unroll
    for (int c = 0; c < 8; ++c) { const v4u w = kr[c]; a += q[8 * c] * bflo(w.x) + q[8 * c + 1] * bfhi(w.x) + q[8 * c + 2] * bflo(w.y) + q[8 * c + 3] * bfhi(w.y) + q[8 * c + 4] * bflo(w.z) + q[8 * c + 5] * bfhi(w.z) + q[8 * c + 6] * bflo(w.w) + q[8 * c + 7] * bfhi(w.w); }
    return a;
}
__device__ __forceinline__ void moba_naive_unit(int tok, int h, const bf16* Q1, const bf16* K1, const bf16* V1, const float* KMEAN, bf16* mix, LAS float* ps, int lane) {
    const int b = tok >> 12, s = tok & (SEQ - 1), qb = s >> 8; const int z0 = opaque_zero();
    const float qv = bf2f(Q1[(size_t)tok * TOKW + h * 64 + lane]);
    float q[64];
#pragma unroll
    for (int d = 0; d < 64; ++d) q[d] = __shfl(qv, d);
    float gate = -1e30f;
    { const int n = lane & 15; const GAS f32x4* km = (const GAS f32x4*)(KMEAN + ((size_t)((b * NHEAD + h) * NBLK + n)) * 64 + z0); float a = 0.f;
#pragma unroll
      for (int c = 0; c < 16; ++c) { const f32x4 w = km[c]; a += q[4 * c] * w.x + q[4 * c + 1] * w.y + q[4 * c + 2] * w.z + q[4 * c + 3] * w.w; }
      if (n < qb) gate = a; }
    float g[16];
#pragma unroll
    for (int n = 0; n < 16; ++n) g[n] = __shfl(gate, n);
    const int nsel = qb < 3 ? qb : 3;
    unsigned mask = 0u;
#pragma unroll
    for (int r = 0; r < 3; ++r) { float best = -3.0e38f; int bi = 0;
#pragma unroll
        for (int n = 0; n < 16; ++n) { const bool c = !((mask >> n) & 1u) && g[n] > best; best = c ? g[n] : best; bi = c ? n : bi; }
        if (r < nsel) mask |= 1u << bi; }
    int blk0 = 0, blk1 = 0, blk2 = 0, cnt = 0;
#pragma unroll
    for (int n = 0; n < 16; ++n) if ((mask >> n) & 1u) { if (cnt == 0) blk0 = n; else if (cnt == 1) blk1 = n; else blk2 = n; ++cnt; }
    const int nslots = nsel + 1;
    const float slope = __builtin_amdgcn_exp2f(-8.0f * (float)(h + 1) / 12.0f) * LOG2E;
    const bf16* kh = K1 + (size_t)b * SEQ * TOKW + h * 64 + z0;
    float mx = -3.0e38f;
#pragma unroll
    for (int sl = 0; sl < 4; ++sl) if (sl < nslots) {
        const int blk = (sl == nsel) ? qb : (sl == 0 ? blk0 : (sl == 1 ? blk1 : blk2));
#pragma unroll
        for (int i = 0; i < 4; ++i) { const int j = lane + 64 * i, pos = blk * 256 + j;
            float a = dot64_bf16(q, (const GAS v4u*)(kh + (size_t)pos * TOKW)) + slope * (float)(pos - s);
            if (pos > s) a = -3.0e38f;
            ps[sl * 256 + j] = a; mx = fmaxf(mx, a); } }
    mx = wave_max(mx);
    LDS_WAIT(); asm volatile("" ::: "memory");
    float l = 0.f;
#pragma unroll
    for (int sl = 0; sl < 4; ++sl) if (sl < nslots) {
#pragma unroll
        for (int i = 0; i < 4; ++i) { const int j = lane + 64 * i; const float a = ps[sl * 256 + j]; const float pe = (a < -1.0e37f) ? 0.f : __builtin_amdgcn_exp2f(a - mx); l += pe; ps[sl * 256 + j] = pe; } }
    l = wave_sum(l);
    LDS_WAIT(); asm volatile("" ::: "memory");
    float o = 0.f; const bf16* vh = V1 + (size_t)b * SEQ * TOKW + h * 64 + lane;
#pragma unroll
    for (int sl = 0; sl < 4; ++sl) if (sl < nslots) {
        const int blk = (sl == nsel) ? qb : (sl == 0 ? blk0 : (sl == 1 ? blk1 : blk2));
        const bf16* vp = vh + (size_t)(blk * 256) * TOKW;
#pragma unroll 8
        for (int j = 0; j < 256; ++j) o += ps[sl * 256 + j] * bf2f(vp[(size_t)j * TOKW]); }
    mix[(size_t)tok * 1024 + h * 64 + lane] = (bf16)f2bf(o / l);
    LDS_WAIT(); asm volatile("" ::: "memory");
}

constexpr int S5_PITCH = 272;
constexpr int S5_WST = 0, S5_WYC = 128 * S5_PITCH, S5_KT = 2 * 128 * S5_PITCH, S5_TAB_BYTES = S5_KT + 10 * 512;
constexpr int S5_XS = S5_TAB_BYTES, S5_XS_BYTES = 32 * S5_PITCH;
static_assert(S5_XS + NWAVES * S5_XS_BYTES <= RING_BYTES, "S5 LDS map");
typedef short s5_bf16x8 __attribute__((ext_vector_type(8)));
typedef float s5_f32x16 __attribute__((ext_vector_type(16)));

__device__ __forceinline__ void s5_apow(float lr, float li, float dt, int n, float& pr, float& pi) { const float m = expf(lr * dt * (float)n), th = li * dt * (float)n; pr = m * cosf(th); pi = m * sinf(th); }
__device__ __forceinline__ void s5_apow_fast(float lr, float li, float dt, int n, float& pr, float& pi) { const float m = __expf(lr * dt * (float)n), th = li * dt * (float)n; pr = m * __cosf(th); pi = m * __sinf(th); }
__device__ __forceinline__ void s5_zoh(float lr, float li, float dt, float& fr, float& fi) {
    float ar, ai; s5_apow(lr, li, dt, 1, ar, ai); const float den = lr * lr + li * li, nr = ar - 1.0f; fr = (nr * lr + ai * li) / den; fi = (ai * lr - nr * li) / den;
}
__device__ __forceinline__ void s5_tab_wst(int g, int jt, unsigned char* tab, const float* lam_re, const float* lam_im, const float* log_dt, const float* b_re, const float* b_im, int lane) {
    const int s = lane >> 3, cp = lane & 7; const float dt = expf(log_dt[g]);
    float zr, zi, mylr, myli;
    { const int p = (jt >> 1) * 32 + (lane & 31); mylr = lam_re[g * 64 + p]; myli = lam_im[g * 64 + p]; s5_zoh(mylr, myli, dt, zr, zi); }
#pragma unroll 4
    for (int r = 0; r < 32; ++r) { const int p = (jt >> 1) * 32 + r; const float lr = __shfl(mylr, r), li = __shfl(myli, r), fr = __shfl(zr, r), fi = __shfl(zi, r);
        float pr, pi; s5_apow_fast(lr, li, dt, 7 - s, pr, pi);
        float o[2];
#pragma unroll
        for (int e = 0; e < 2; ++e) { const int c = 2 * cp + e; const float br = b_re[((size_t)g * 64 + p) * 16 + c], bi = b_im[((size_t)g * 64 + p) * 16 + c];
            const float bbr = fr * br - fi * bi, bbi = fr * bi + fi * br; o[e] = (jt & 1) ? (pr * bbi + pi * bbr) : (pr * bbr - pi * bbi); }
        *(GAS unsigned*)(tab + S5_WST + (32 * jt + r) * S5_PITCH + (16 * s + 2 * cp) * 2) = pk2(o[0], o[1]); }
}
__device__ __forceinline__ void s5_tab_const(int g, float* ctab, const float* lam_re, const float* lam_im, const float* log_dt, int lane) {
    const float dt = expf(log_dt[g]); float xr, xi; s5_apow(lam_re[g * 64 + lane], lam_im[g * 64 + lane], dt, 1, xr, xi);
#pragma unroll
    for (int q = 0; q < 3; ++q) { const float nr = xr * xr - xi * xi, ni = 2.0f * xr * xi; xr = nr; xi = ni; }
    const float ar = xr, ai = xi;
#pragma unroll
    for (int q = 0; q < 5; ++q) { const float nr = xr * xr - xi * xi, ni = 2.0f * xr * xi; xr = nr; xi = ni; }
    *(GAS f32x4*)(ctab + ((size_t)g * 64 + lane) * 4) = (f32x4){ar, ai, xr, xi};
}
__device__ __forceinline__ void s5_tab_wyc(int g, int t, unsigned char* tab, const float* lam_re, const float* lam_im, const float* log_dt, const float* c_re, const float* c_im, int lane) {
    const int p = lane; const float dt = expf(log_dt[g]); float pr, pi; s5_apow_fast(lam_re[g * 64 + p], lam_im[g * 64 + p], dt, t + 1, pr, pi);
#pragma unroll
    for (int c = 0; c < 16; ++c) { const float cr = c_re[((size_t)g * 16 + c) * 64 + p], ci = c_im[((size_t)g * 16 + c) * 64 + p];
        *(GAS unsigned*)(tab + S5_WYC + (16 * t + c) * S5_PITCH + 4 * p) = pk2(cr * pr - ci * pi, -(cr * pi + ci * pr)); }
}
__device__ __forceinline__ void s5_tab_kt(int g, int d, unsigned char* tab, const float* lam_re, const float* lam_im, const float* log_dt, const float* b_re, const float* b_im, const float* c_re, const float* c_im,
                                          const float* dvec, int lane) {
    const float dt = expf(log_dt[g]); float mr, mi;
    { const float lr = lam_re[g * 64 + lane], li = lam_im[g * 64 + lane]; float pr, pi, fr, fi; s5_apow_fast(lr, li, dt, d, pr, pi); s5_zoh(lr, li, dt, fr, fi); mr = pr * fr - pi * fi; mi = pr * fi + pi * fr; }
    float acc[4] = {0.f, 0.f, 0.f, 0.f};
#pragma unroll 8
    for (int p = 0; p < 64; ++p) { const float pmr = __shfl(mr, p), pmi = __shfl(mi, p);
#pragma unroll
        for (int i = 0; i < 4; ++i) { const int e = lane + 64 * i, c = e >> 4, c2 = e & 15;
            const float br = b_re[((size_t)g * 64 + p) * 16 + c2], bi = b_im[((size_t)g * 64 + p) * 16 + c2], cr = c_re[((size_t)g * 16 + c) * 64 + p], ci = c_im[((size_t)g * 16 + c) * 64 + p];
            const float tr = pmr * br - pmi * bi, ti = pmr * bi + pmi * br; acc[i] += cr * tr - ci * ti; } }
#pragma unroll
    for (int i = 0; i < 4; ++i) { const int e = lane + 64 * i, c = e >> 4, c2 = e & 15; float v = acc[i]; if (d == 0 && c == c2) v += dvec[16 * g + c];
        *(GAS bf16*)(tab + S5_KT + (d + 1) * 512 + c * 32 + c2 * 2) = (bf16)f2bf(v);
        if (d == 0) *(GAS bf16*)(tab + S5_KT + c * 32 + c2 * 2) = (bf16)0; }
}

template <bool FINAL>
__device__ __forceinline__ void s5_unit(int g, int seg, const bf16* Ug, bf16* Yg, const unsigned char* tab, float* Ebuf, const float* ctab, LAS unsigned char* L) {
    int tid_ = threadIdx.x; asm volatile("" : "+v"(tid_));
    const int tid = tid_, lane = tid & 63, r32 = lane & 31, hi = lane >> 5, b = __builtin_amdgcn_readfirstlane(tid >> 6);
    { const int npc = (FINAL ? S5_TAB_BYTES : S5_WYC) / 1024; const unsigned l0 = (unsigned)(uintptr_t)(unsigned char*)L;
      for (int i = b; i < npc; i += NWAVES) attn_body::glds16(tab + (size_t)i * 1024 + lane * 16, (unsigned)__builtin_amdgcn_readfirstlane(l0 + i * 1024)); }
    const size_t tok0 = (size_t)g * TOK + (size_t)b * SEQ + (size_t)seg * 256;
    s5_bf16x8 A[8];
    { const bf16* up = Ug + (tok0 + 8 * r32) * 16 + 8 * hi;
#pragma unroll
      for (int s = 0; s < 8; ++s) A[s] = *(const GAS s5_bf16x8*)(up + s * 16); }
    float aLr[2], aLi[2], aSr[2], aSi[2];
#pragma unroll
    for (int k = 0; k < 2; ++k) { const f32x4 cv = *(const GAS f32x4*)(ctab + ((size_t)g * 64 + 32 * k + r32) * 4); aLr[k] = cv.x; aLi[k] = cv.y; aSr[k] = cv.z; aSi[k] = cv.w; }
    float cr[2] = {0.f, 0.f}, ci[2] = {0.f, 0.f};
    if (FINAL) {
        const float* eb = Ebuf + ((size_t)(b * NGRP + g) * 16) * 128;
        f32x2 ev[15][2];
#pragma unroll
        for (int j = 0; j < 15; ++j)
#pragma unroll
            for (int k = 0; k < 2; ++k) ev[j][k] = (j < seg) ? *(const GAS f32x2*)(eb + (size_t)j * 128 + 2 * (32 * k + r32)) : (f32x2){0.f, 0.f};
#pragma unroll
        for (int j = 0; j < 15; ++j) if (j < seg) {
#pragma unroll
            for (int k = 0; k < 2; ++k) { const float nr = aSr[k] * cr[k] - aSi[k] * ci[k] + ev[j][k].x, ni = aSr[k] * ci[k] + aSi[k] * cr[k] + ev[j][k].y; cr[k] = nr; ci[k] = ni; } }
    }
    asm volatile("s_waitcnt vmcnt(0)" ::: "memory");
    __syncthreads();
    s5_f32x16 S[4];
#pragma unroll
    for (int j = 0; j < 4; ++j) { S[j] = s5_f32x16{};
#pragma unroll
        for (int s = 0; s < 8; ++s) { const s5_bf16x8 bf = *(const LAS s5_bf16x8*)(L + S5_WST + (32 * j + r32) * S5_PITCH + (16 * s + 8 * hi) * 2);
            S[j] = __builtin_amdgcn_mfma_f32_32x32x16_bf16(A[s], bf, S[j], 0, 0, 0); } }
#pragma unroll
    for (int i = 0; i < 8; ++i) { const bool own = ((i & 1) == hi);
#pragma unroll
        for (int q = 0; q < 4; ++q) { const int reg = 4 * (i >> 1) + q;
#pragma unroll
            for (int k = 0; k < 2; ++k) { const float sr = S[2 * k][reg], si = S[2 * k + 1][reg];
                const float nr = aLr[k] * cr[k] - aLi[k] * ci[k] + sr, ni = aLr[k] * ci[k] + aLi[k] * cr[k] + si;
                S[2 * k][reg] = own ? cr[k] : sr; S[2 * k + 1][reg] = own ? ci[k] : si; cr[k] = own ? nr : cr[k]; ci[k] = own ? ni : ci[k]; } }
#pragma unroll
        for (int k = 0; k < 2; ++k) { const float orr = __shfl_xor(cr[k], 32), oi = __shfl_xor(ci[k], 32); cr[k] = own ? cr[k] : orr; ci[k] = own ? ci[k] : oi; } }
    if (!FINAL) {
        if (hi == 0) { float* eb = Ebuf + ((size_t)(b * NGRP + g) * 16 + seg) * 128;
#pragma unroll
            for (int k = 0; k < 2; ++k) *(GAS f32x2*)(eb + 2 * (32 * k + r32)) = (f32x2){cr[k], ci[k]}; }
    } else {
        LAS unsigned char* XS = L + S5_XS + b * S5_XS_BYTES;
#pragma unroll
        for (int reg = 0; reg < 16; ++reg) { const int chunk = (reg & 3) + 8 * (reg >> 2) + 4 * hi;
#pragma unroll
            for (int k = 0; k < 2; ++k) *(LAS unsigned*)(XS + chunk * S5_PITCH + 4 * (32 * k + r32)) = pg8::cvt_pk_bf16(S[2 * k][reg], S[2 * k + 1][reg]); }
        s5_bf16x8 Xf[8];
#pragma unroll
        for (int kk = 0; kk < 8; ++kk) Xf[kk] = *(const LAS s5_bf16x8*)(XS + r32 * S5_PITCH + (16 * kk + 8 * hi) * 2);
        s5_f32x16 Yc[4];
#pragma unroll
        for (int j = 0; j < 4; ++j) { Yc[j] = s5_f32x16{};
#pragma unroll
            for (int s = 0; s < 8; ++s) if (s <= 2 * j + 1) { const int d1 = 2 * j + (r32 >> 4) - s + 1;
                const s5_bf16x8 bf = *(const LAS s5_bf16x8*)(L + S5_KT + d1 * 512 + (r32 & 15) * 32 + 16 * hi);
                Yc[j] = __builtin_amdgcn_mfma_f32_32x32x16_bf16(A[s], bf, Yc[j], 0, 0, 0); }
#pragma unroll
            for (int kk = 0; kk < 8; ++kk) { const s5_bf16x8 bf = *(const LAS s5_bf16x8*)(L + S5_WYC + (32 * j + r32) * S5_PITCH + (16 * kk + 8 * hi) * 2);
                Yc[j] = __builtin_amdgcn_mfma_f32_32x32x16_bf16(Xf[kk], bf, Yc[j], 0, 0, 0); } }
        asm volatile("s_waitcnt lgkmcnt(0)" ::: "memory");
#pragma unroll
        for (int j = 0; j < 4; ++j)
#pragma unroll
            for (int reg = 0; reg < 16; reg += 2) { const pg8::f32x2 ge = pg8::gelu_pk((pg8::f32x2){Yc[j][reg], Yc[j][reg + 1]});
                const int chunk = (reg & 3) + 8 * (reg >> 2) + 4 * hi, tokl = 8 * chunk + 2 * j + (r32 >> 4), c = r32 & 15;
                const unsigned gw_ = pg8::cvt_pk_bf16(ge.x, ge.y); *(LAS bf16*)(XS + tokl * 32 + c * 2) = (bf16)(gw_ & 0xffffu); *(LAS bf16*)(XS + (tokl + 8) * 32 + c * 2) = (bf16)(gw_ >> 16); }
        asm volatile("s_waitcnt lgkmcnt(0)" ::: "memory");
        bf16* yo = Yg + tok0 * 16;
#pragma unroll
        for (int i = 0; i < 8; ++i) { const int pc = lane + 64 * i; const v4u w = *(const LAS v4u*)(XS + 16 * pc); *(GAS v4u*)(yo + 8 * pc) = w; }
    }
    __syncthreads();
}

#ifndef MK_ONE_LAUNCH
#define MK_ONE_LAUNCH 1
#endif
constexpr int N_PHASES = 14;
struct Args { const float* in[23]; float* out; unsigned char* ws; int ph_lo, ph_hi; };

#ifndef PROBE_P0
#define PROBE_P0 0
#endif
#define P0_ITEM(it) do { \
            int r = it; \
            if (r < I_TKT) { s5_tab_kt(r >> 3, r & 7, S5TAB + (size_t)(r >> 3) * S5_TAB_BYTES, args.in[6], args.in[7], args.in[8], args.in[9], args.in[10], args.in[11], args.in[12], args.in[13], lane); break; } r -= I_TKT; \
            if (r < I_TST) { s5_tab_wst(r >> 2, r & 3, S5TAB + (size_t)(r >> 2) * S5_TAB_BYTES, args.in[6], args.in[7], args.in[8], args.in[9], args.in[10], lane); break; } r -= I_TST; \
            if (r < I_TYC) { s5_tab_wyc(r >> 3, r & 7, S5TAB + (size_t)(r >> 3) * S5_TAB_BYTES, args.in[6], args.in[7], args.in[8], args.in[11], args.in[12], lane); break; } r -= I_TYC; \
            if (r < I_TCO) { s5_tab_const(r, S5C, args.in[6], args.in[7], args.in[8], lane); break; } r -= I_TCO; \
            if (r < I_SQ) { p0_matrix_item(args.in[5], 1024, 1024, WIN0, mixg, 0, r, scr, lane); break; } r -= I_SQ; \
            if (r < I_GLU) { p0_matrix_item(args.in[14], 768, 768, WGLU, nullptr, 0, r, scr, lane); break; } r -= I_GLU; \
            if (r < I_IN1) { p0_matrix_item(args.in[16], 1024, 2560, WIN1, mixg + 1024, 0, r, scr, lane); break; } r -= I_IN1; \
            if (r < I_SQ) { p0_matrix_item(args.in[17], 1024, 1024, WOUT0, nullptr, 0, r, scr, lane); break; } r -= I_SQ; \
            if (r < I_SQ) { p0_matrix_item(args.in[17] + 1024 * 1024, 1024, 1024, WOUT1, nullptr, 0, r, scr, lane); break; } r -= I_SQ; \
            if (r < I_GU) { p0_matrix_item(args.in[19], 1024, FFN, WGU0, ffng, 1, r, scr, lane); break; } r -= I_GU; \
            if (r < I_GU) { p0_matrix_item(args.in[20], 1024, FFN, WGU0, ffng, 2, r, scr, lane); break; } r -= I_GU; \
            if (r < I_GU) { p0_matrix_item(args.in[19] + (size_t)1024 * FFN, 1024, FFN, WGU1, ffng + 1024, 1, r, scr, lane); break; } r -= I_GU; \
            if (r < I_GU) { p0_matrix_item(args.in[20] + (size_t)1024 * FFN, 1024, FFN, WGU1, ffng + 1024, 2, r, scr, lane); break; } r -= I_GU; \
            if (r < I_DN) { p0_matrix_item(args.in[21], FFN, 1024, WDN0, nullptr, 0, r, scr, lane); break; } r -= I_DN; \
            if (r < I_DN) { p0_matrix_item(args.in[21] + (size_t)FFN * 1024, FFN, 1024, WDN1, nullptr, 0, r, scr, lane); break; } r -= I_DN; \
            p0_matrix_item(args.in[3], 1024, 512, WMKV, args.in[2], 0, r, scr, lane); \
        } while (0)
__global__ void __launch_bounds__(NWAVES * 64, 2) mega_fwd(Args args) {
    extern __shared__ __attribute__((aligned(16))) unsigned char lds[];
    LAS unsigned char* L = (LAS unsigned char*)lds;
    volatile LAS unsigned* MISC = (volatile LAS unsigned*)(L + MISC_OFF);
    const int tid = threadIdx.x, lane = tid & 63, wave = __builtin_amdgcn_readfirstlane(tid >> 6);
    const int G = gridDim.x; const int bx = blockIdx.x;
    const int vcu = (G % 8 == 0) ? (bx % 8) * (G / 8) + bx / 8 : bx;
    const int gw = vcu * NWAVES + wave, NGW = G * NWAVES;
    unsigned char* ws = args.ws;
    gu32* ctl = (gu32*)(ws + WS_CTL);
    for (int u = tid; u < (LDS_BYTES - LDSCTL_OFF) / 4; u += NWAVES * 64) ((LAS unsigned*)(L + LDSCTL_OFF))[u] = 0u;
    __syncthreads();
    XcdBarrier bar; bar.bar = (unsigned*)(ctl + CW_BAR); bar.x = 0; bar.st = nullptr;
    if (MK_ONE_LAUNCH) bar = xcd_barrier_post((unsigned*)(ctl + CW_BAR), MISC + 8);
#define MEMATTN_PHASE(u0_, us_) do { for (int un = (u0_); un < BATCH * MHEAD * NBLK; un += (us_)) { const int b_ = un >> 6, h_ = (un >> 4) & 3, qb_ = un & 15; const size_t qrow_ = (size_t)b_ * SEQ + (size_t)qb_ * 256; \
        attn_body::attn_unit<0, 8, 256, 256, 1024>((const attn_body::bf16*)(QM + qrow_ * 256 + h_ * 64), (const attn_body::bf16*)(MEMK + (size_t)b_ * MEML * 256 + h_ * 64), (const attn_body::bf16*)(MEMV + (size_t)b_ * MEML * 256 + h_ * 64), \
            (attn_body::bf16*)(MIX + qrow_ * 1024 + 768 + h_ * 64), 4, 0.f, nullptr, nullptr, 0, (char*)lds + RING_OFF); } } while (0)
    const int lo = args.ph_lo, hi = args.ph_hi;
#ifndef PROBE_DUP
#define PROBE_DUP -1
#endif
#define IN(k) (lo <= (k) && (k) < hi)
#define PH_REP(k) for (int rep_ = 0; rep_ < ((PROBE_DUP == (k)) ? 2 : 1); ++rep_)
#define SEAM(k) do { if (IN(k) && IN((k) + 1)) xcd_barrier(bar); } while (0)

    const float* x = args.in[0]; const float* mem = args.in[1];
    float* out = args.out;
    float* SS0 = (float*)(ws + WS_SS0); float* SSA = (float*)(ws + WS_SSA); float* SSB = (float*)(ws + WS_SSB); float* SSM = (float*)(ws + WS_SSM);
    unsigned char* S5TAB = ws + WS_S5TAB; float* S5E = (float*)(ws + WS_S5E); float* S5C = (float*)(ws + WS_S5TAB + (size_t)NGRP * S5_TAB_BYTES);
    float* KMP = (float*)(ws + WS_KMEAN);
    bf16* WIN0 = (bf16*)(ws + WS_WIN0); bf16* WGLU = (bf16*)(ws + WS_WGLU); bf16* WIN1 = (bf16*)(ws + WS_WIN1);
    bf16* WOUT0 = (bf16*)(ws + WS_WOUT0); bf16* WOUT1 = (bf16*)(ws + WS_WOUT1);
    bf16* WGU0 = (bf16*)(ws + WS_WGU0); bf16* WGU1 = (bf16*)(ws + WS_WGU1); bf16* WDN0 = (bf16*)(ws + WS_WDN0); bf16* WDN1 = (bf16*)(ws + WS_WDN1); bf16* WMKV = (bf16*)(ws + WS_WMKV);
    bf16* MEMB = (bf16*)(ws + WS_MEMB); bf16* MEMK = (bf16*)(ws + WS_MEMK); bf16* MEMV = (bf16*)(ws + WS_MEMV);
    bf16* XB = (bf16*)(ws + WS_XB); bf16* Ub = (bf16*)(ws + WS_U); bf16* Yb = (bf16*)(ws + WS_Y);
    bf16* Q1 = (bf16*)(ws + WS_Q1); bf16* K1 = (bf16*)(ws + WS_K1); bf16* V1 = (bf16*)(ws + WS_V1);
    bf16* QM = (bf16*)(ws + WS_QM); bf16* MIX = (bf16*)(ws + WS_MIX); bf16* Hb = (bf16*)(ws + WS_H);

    if (IN(0)) PH_REP(0) {
        if (rep_) xcd_barrier(bar);
        LAS float* scr = (LAS float*)(L + RING_OFF + wave * 16384);
        constexpr int I_SQ = 16 * 32, I_GLU = 12 * 24, I_IN1 = 16 * 80, I_GU = 16 * 88, I_DN = 44 * 32, I_MKV = 16 * 16;
        constexpr int I_TKT = NGRP * 8, I_TST = NGRP * 4, I_TYC = NGRP * 8, I_TCO = NGRP;
        constexpr int NITEMS = I_TKT + I_TST + I_TYC + I_TCO + I_SQ + I_GLU + I_IN1 + 2 * I_SQ + 4 * I_GU + 2 * I_DN + I_MKV;
        const float* mixg = args.in[4]; const float* ffng = args.in[18];
        for (int it = gw; it < NITEMS; it += NGW) P0_ITEM(it);
        for (int m = 4 * gw; m < TOK; m += 4 * NGW) rows_to_bf16_ssq<4>(x + (size_t)m * DM, XB + (size_t)m * DM, SS0 + (size_t)m * 16, lane);
        for (int m = gw; m < BATCH * MEML; m += NGW) rows_to_bf16_ssq<1>(mem + (size_t)m * DM, MEMB + (size_t)m * DM, SSM + (size_t)m * 16, lane);
#if PROBE_P0 == 1
        for (int it = gw; it < I_TKT + I_TST + I_TYC + I_TCO; it += NGW) P0_ITEM(it);
#elif PROBE_P0 == 2
        for (int it = I_TKT + I_TST + I_TYC + I_TCO + gw; it < NITEMS; it += NGW) P0_ITEM(it);
#elif PROBE_P0 == 3
        for (int m = 4 * gw; m < TOK; m += 4 * NGW) rows_to_bf16_ssq<4>(x + (size_t)m * DM, XB + (size_t)m * DM, SS0 + (size_t)m * 16, lane);
        for (int m = gw; m < BATCH * MEML; m += NGW) rows_to_bf16_ssq<1>(mem + (size_t)m * DM, MEMB + (size_t)m * DM, SSM + (size_t)m * 16, lane);
#endif
    }
    SEAM(0);
    if (IN(1)) PH_REP(1) {
        if (rep_) xcd_barrier(bar);
        { pg8::Gemm g{XB, WIN0, TOK, 1024, 1024, 0}; pg8::StaticOrder S; S.init(TOK, 1024, G, bx);
          pg8::EpiProj E{SS0, Ub, 0, 3, 1, TOKW, 1.0f, QM, C2, TOK, nullptr, -1};
          pg8::gemm_phase<pg8::EpiProj, pg8::StaticOrder, true, true>(L + RING_OFF, g, S, E); }
    }
    SEAM(1);
    if (IN(2)) PH_REP(2) {
        if (rep_) xcd_barrier(bar);
        const int nS5 = (G == 256) ? 240 : G;
        if (bx < nS5) { for (int un = bx; un < NGRP * 16; un += nS5) s5_unit<false>(un >> 4, un & 15, Ub, Yb, S5TAB + (size_t)(un >> 4) * S5_TAB_BYTES, S5E, S5C, L + RING_OFF); }
        if (G != 256 || bx >= nS5) { pg8::Gemm g{MEMB, WMKV, BATCH * MEML, 512, 1024, 0}; pg8::StaticOrder S; S.init(BATCH * MEML, 512, (G == 256) ? 16 : G, (G == 256) ? bx - nS5 : bx);
          pg8::EpiProj E{SSM, MEMK, (size_t)(WS_MEMV - WS_MEMK) / 2, 1, 2, 256, 1.0f, nullptr, 1.0f, 0, nullptr, -1};
          pg8::gemm_phase<pg8::EpiProj, pg8::StaticOrder, true, true>(L + RING_OFF, g, S, E); }
    }
    SEAM(2);
    if (IN(3)) PH_REP(3) {
        if (rep_) xcd_barrier(bar);
        for (int un = vcu; un < NGRP * 16; un += G) s5_unit<true>(un >> 4, un & 15, Ub, Yb, S5TAB + (size_t)(un >> 4) * S5_TAB_BYTES, S5E, S5C, L + RING_OFF);
    }
    SEAM(3);
    if (IN(4)) PH_REP(4) {
        if (rep_) xcd_barrier(bar);
        pg8::Gemm g{Yb, WGLU, TOK, TOKW, TOKW, 1}; pg8::StaticOrder S; S.init(TOK, TOKW, G, bx);
        pg8::EpiGlu E{Yb, TOKW, args.in[15], MIX, 1024, TOK};
        pg8::gemm_phase<pg8::EpiGlu, pg8::StaticOrder, true, true>(L + RING_OFF, g, S, E);
        if (G == 256) { if (bx >= 128) MEMATTN_PHASE(bx - 128, 128); }
        else MEMATTN_PHASE(vcu, G);
    }
    SEAM(4);
    if (IN(5)) PH_REP(5) {
        if (rep_) xcd_barrier(bar);
        pg8::Gemm g{MIX, WOUT0, TOK, 1024, 1024, 0}; pg8::StaticOrder S; S.init(TOK, 1024, G, bx);
        pg8::EpiRes E{x, nullptr, XB, SSA};
        pg8::gemm_phase<pg8::EpiRes, pg8::StaticOrder, true, true>(L + RING_OFF, g, S, E);
    }
    SEAM(5);
    if (IN(6)) PH_REP(6) {
        if (rep_) xcd_barrier(bar);
        pg8::Gemm g{XB, WGU0, TOK, 2 * FFN, 1024, 0}; pg8::StaticOrder S; S.init(TOK, 2 * FFN, G, bx);
        pg8::EpiGU E{SSA, Hb, FFN};
        pg8::gemm_phase<pg8::EpiGU, pg8::StaticOrder, true, true>(L + RING_OFF, g, S, E);
    }
    SEAM(6);
    if (IN(7)) PH_REP(7) {
        if (rep_) xcd_barrier(bar);
        pg8::Gemm g{Hb, WDN0, TOK, 1024, FFN, 0}; pg8::StaticOrder S; S.init(TOK, 1024, G, bx);
        pg8::EpiRes E{nullptr, XB, XB, SSB};
        pg8::gemm_phase<pg8::EpiRes, pg8::StaticOrder, true, true>(L + RING_OFF, g, S, E);
    }
    SEAM(7);
    if (IN(8)) PH_REP(8) {
        if (rep_) xcd_barrier(bar);
        pg8::Gemm g{XB, WIN1, TOK, 2560, 1024, 0}; pg8::StaticOrder S; S.init(TOK, 2560, G, bx);
        pg8::EpiProj E{SSB, Q1, (size_t)(WS_K1 - WS_Q1) / 2, 3, 3, TOKW, C2, QM, C2, 0, KMP, 1};
        pg8::gemm_phase<pg8::EpiProj, pg8::StaticOrder, true, true>(L + RING_OFF, g, S, E);
    }
    SEAM(8);
    if (IN(9)) PH_REP(9) {
        if (rep_) xcd_barrier(bar);
        for (int p_ = vcu; p_ < BATCH * NHEAD * 8; p_ += G) { const int bh_ = p_ >> 3, sg_ = p_ & 7, b_ = bh_ / NHEAD, h_ = bh_ - b_ * NHEAD;
            const float slope2 = __builtin_amdgcn_exp2f(-8.0f * (float)(h_ + 1) / 12.0f) * LOG2E;
#pragma unroll 1
            for (int k_ = 0; k_ < 2; ++k_) { const int qb_ = k_ ? 15 - sg_ : sg_; const size_t qrow_ = (size_t)b_ * SEQ + (size_t)qb_ * 256, krow_ = (size_t)b_ * SEQ;
                attn_body::attn_unit<1, 8, 768, 768, 1024>((const attn_body::bf16*)(Q1 + qrow_ * TOKW + h_ * 64), (const attn_body::bf16*)(K1 + krow_ * TOKW + h_ * 64), (const attn_body::bf16*)(V1 + krow_ * TOKW + h_ * 64),
                    (attn_body::bf16*)(MIX + qrow_ * 1024 + h_ * 64), 4 * qb_ + 4, slope2, KMP + (size_t)bh_ * 1024, KMP + (size_t)(8 * 12 * 16 * 64) + (size_t)bh_ * 1024, qb_, (char*)lds + RING_OFF); } }
        MEMATTN_PHASE(vcu, G);
    }
    SEAM(9);
    if (IN(10)) PH_REP(10) {
        if (rep_) xcd_barrier(bar);
        pg8::Gemm g{MIX, WOUT1, TOK, 1024, 1024, 0}; pg8::StaticOrder S; S.init(TOK, 1024, G, bx);
        pg8::EpiRes E{nullptr, XB, XB, SSA};
        pg8::gemm_phase<pg8::EpiRes, pg8::StaticOrder, true, true>(L + RING_OFF, g, S, E);
    }
    SEAM(10);
    if (IN(11)) PH_REP(11) {
        if (rep_) xcd_barrier(bar);
        pg8::Gemm g{XB, WGU1, TOK, 2 * FFN, 1024, 0}; pg8::StaticOrder S; S.init(TOK, 2 * FFN, G, bx);
        pg8::EpiGU E{SSA, Hb, FFN};
        pg8::gemm_phase<pg8::EpiGU, pg8::StaticOrder, true, true>(L + RING_OFF, g, S, E);
    }
    SEAM(11);
    if (IN(12)) PH_REP(12) {
        if (rep_) xcd_barrier(bar);
        pg8::Gemm g{Hb, WDN1, TOK, 1024, FFN, 0}; pg8::StaticOrder S; S.init(TOK, 1024, G, bx);
        pg8::EpiRes E{nullptr, XB, XB, SSB};
        pg8::gemm_phase<pg8::EpiRes, pg8::StaticOrder, true, true>(L + RING_OFF, g, S, E);
    }
    SEAM(12);
    if (IN(13)) PH_REP(13) {
        if (rep_) xcd_barrier(bar);
        const float* gf = args.in[22];
        const GAS f32x4* gp = (const GAS f32x4*)gf + 4 * lane; const f32x4 g0 = gp[0], g1 = gp[1], g2 = gp[2], g3 = gp[3];
        for (int m0 = 4 * gw; m0 < TOK; m0 += 4 * NGW) {
            v4u q[4][2]; f32x4 sq[4];
#pragma unroll
            for (int r = 0; r < 4; ++r) { const GAS v4u* xr = (const GAS v4u*)(XB + (size_t)(m0 + r) * DM) + 2 * lane; q[r][0] = xr[0]; q[r][1] = xr[1];
                sq[r] = *(const GAS f32x4*)(SSB + (size_t)(m0 + r) * 16 + 4 * (lane & 3)); }
#pragma unroll
            for (int r = 0; r < 4; ++r) { float s = (sq[r].x + sq[r].y) + (sq[r].z + sq[r].w); s += __shfl_xor(s, 1); s += __shfl_xor(s, 2);
                const float rs = __builtin_amdgcn_rsqf(s * (1.0f / 1024.0f) + 1e-6f);
                GAS f32x4* orow = (GAS f32x4*)(out + (size_t)(m0 + r) * DM) + 4 * lane; const v4u q0 = q[r][0], q1 = q[r][1];
                orow[0] = (f32x4){bflo(q0.x), bfhi(q0.x), bflo(q0.y), bfhi(q0.y)} * rs * g0; orow[1] = (f32x4){bflo(q0.z), bfhi(q0.z), bflo(q0.w), bfhi(q0.w)} * rs * g1;
                orow[2] = (f32x4){bflo(q1.x), bfhi(q1.x), bflo(q1.y), bfhi(q1.y)} * rs * g2; orow[3] = (f32x4){bflo(q1.z), bfhi(q1.z), bflo(q1.w), bfhi(q1.w)} * rs * g3; }
        }
    }
#undef IN
#undef SEAM
}

extern "C" void kernel_launch(void* const* d_in, const int* in_sizes, int n_in, void* d_out, int out_size, void* d_ws, size_t ws_size, hipStream_t stream) {
    static int grid = 0;
    if (grid == 0) {
        if (n_in != 23 || out_size != TOK * DM || ws_size < WS_END) { fprintf(stderr, "kernel_launch: unexpected shapes: n_in %d out %d ws %zu\n", n_in, out_size, ws_size); grid = -1; return; }
        int dev = 0, cus = 0, per_cu = 0;
        if (hipGetDevice(&dev) != hipSuccess || hipDeviceGetAttribute(&cus, hipDeviceAttributeMultiprocessorCount, dev) != hipSuccess) { grid = -1; return; }
        if (hipFuncSetAttribute((const void*)mega_fwd, hipFuncAttributeMaxDynamicSharedMemorySize, LDS_BYTES) != hipSuccess) { fprintf(stderr, "kernel_launch: hipFuncSetAttribute failed\n"); grid = -1; return; }
        if (hipOccupancyMaxActiveBlocksPerMultiprocessor(&per_cu, (const void*)mega_fwd, NWAVES * 64, LDS_BYTES) != hipSuccess || per_cu < 1)
            fprintf(stderr, "kernel_launch: occupancy query reports %d workgroups per CU\n", per_cu);
        (void)hipGetLastError();
        grid = cus;
    }
    if (grid < 0) return;
    if (hipMemsetAsync((char*)d_ws + WS_CTL, 0, CTL_ZERO_BYTES, stream) != hipSuccess) return;
    Args a{};
    for (int i = 0; i < 23; ++i) a.in[i] = (const float*)d_in[i];
    a.out = (float*)d_out; a.ws = (unsigned char*)d_ws;
#if MK_ONE_LAUNCH
    a.ph_lo = 0; a.ph_hi = N_PHASES;
    hipLaunchKernelGGL(mega_fwd, dim3(grid), dim3(NWAVES * 64), LDS_BYTES, stream, a);
#else
    for (int p = 0; p < N_PHASES; ++p) { a.ph_lo = p; a.ph_hi = p + 1; hipLaunchKernelGGL(mega_fwd, dim3(grid), dim3(NWAVES * 64), LDS_BYTES, stream, a); }
#endif
}
```

```cpp
#include <hip/hip_runtime.h>
#include <hip/hip_bf16.h>
#include <cstdio>
#include <cstdint>
#include <cmath>
namespace pg8 {
#define PG8_LAS __attribute__((address_space(3)))
typedef unsigned short bf16_t;
typedef short bf16x8 __attribute__((ext_vector_type(8)));
typedef float f32x4 __attribute__((ext_vector_type(4)));
typedef unsigned u32x4 __attribute__((ext_vector_type(4)));
constexpr int BM = 256, BK = 64, HALF = 128, HTB = HALF * BK * 2  , STAGE_BYTES = 8 * HTB, NXCD = 8, WGM = 8;

__host__ __device__ __forceinline__ int lds_byte(int r, int c) { const int st = (r >> 4) * 2 + (c >> 5), rr = r & 15, cc = c & 31, ob = rr * 64 + cc * 2; return st * 1024 + (ob ^ (((ob >> 9) & 1) << 5)); }
__host__ __device__ __forceinline__ void stage_rc(int b, int& R, int& C) { const int st = b / 1024, sb = b % 1024, swz = sb ^ (((sb >> 9) & 1) << 5); R = (st >> 1) * 16 + swz / 64; C = (st & 1) * 32 + (swz % 64) / 2; }
__host__ __device__ __forceinline__ int perm32(int rho) { const int n = rho >> 4, i = rho & 15; return 8 * (i >> 2) + 4 * n + (i & 3); }

struct Unit { int pm, pn; };
struct Gemm { const bf16_t* A; const bf16_t* Bt; int M, N, K, amode; };

struct StaticOrder {
    int nM, nN, nwg, G, c;
    __host__ __device__ void init(int M, int N, int G_, int c_) { nM = M / BM; nN = N / BM; nwg = nM * nN; G = G_; c = c_; }
    __host__ __device__ bool next(int i, Unit& u) const {
        const long L = (long)i * G + c; if (L >= nwg) return false;
        int wgid = (int)L; { const int q = nwg / NXCD, r = nwg % NXCD, xcd = wgid % NXCD, off = wgid / NXCD; wgid = (xcd < r ? xcd * (q + 1) : r * (q + 1) + (xcd - r) * q) + off; }
        const int nig = WGM * nN, gid = wgid / nig, fm = gid * WGM, gsz = (nM - fm) < WGM ? (nM - fm) : WGM;
        u.pm = fm + ((wgid % nig) % gsz); u.pn = (wgid % nig) / gsz; return true;
    }
    __device__ __forceinline__ void a_ready(const Unit&) const {}
    __device__ __forceinline__ void done(const Unit&) const {}
};

__device__ __forceinline__ unsigned cvt_pk_bf16(float lo, float hi) { unsigned r; asm volatile("v_cvt_pk_bf16_f32 %0, %1, %2" : "=v"(r) : "v"(lo), "v"(hi)); return r; }
typedef float f32x2 __attribute__((ext_vector_type(2)));
typedef unsigned u32x2 __attribute__((ext_vector_type(2)));
constexpr float RMS_EPS = 1e-6f;
__device__ __forceinline__ float row_rstd(const float* ssq, int row) {
    const f32x4* p = (const f32x4*)(ssq + (size_t)row * 16);
    const f32x4 a = p[0], b = p[1], c = p[2], d = p[3];
    const float s = (((a[0] + a[1]) + (a[2] + a[3])) + ((b[0] + b[1]) + (b[2] + b[3]))) + (((c[0] + c[1]) + (c[2] + c[3])) + ((d[0] + d[1]) + (d[2] + d[3])));
    return __builtin_amdgcn_rsqf(s * (1.0f / 1024.0f) + RMS_EPS);
}
__device__ __forceinline__ float bf2f(unsigned short h) { return __uint_as_float(((unsigned)h) << 16); }
__device__ __forceinline__ float bflo(unsigned w) { return __uint_as_float(w << 16); }
__device__ __forceinline__ float bfhi(unsigned w) { return __uint_as_float(w & 0xffff0000u); }

__device__ __forceinline__ f32x2 gelu_pk(f32x2 v) {
    const f32x2 av = __builtin_elementwise_abs(v), d = av * 0.2316418882f + 1.0f;
    f32x2 t; t.x = __builtin_amdgcn_rcpf(d.x); t.y = __builtin_amdgcn_rcpf(d.y);
    f32x2 q = t * 0.5307027145f + (-0.7265760135f); q = q * t + 0.7107068705f; q = q * t + (-0.142248368f); q = q * t + 0.127414796f; q = q * t;
    const f32x2 s = (v * v) * (-0.72134752044f);
    f32x2 e; e.x = __builtin_amdgcn_exp2f(s.x); e.y = __builtin_amdgcn_exp2f(s.y);
    const f32x2 m = v * (q * e), r = v - m;
    f32x2 o; o.x = v.x < 0.f ? m.x : r.x; o.y = v.y < 0.f ? m.y : r.y; return o;
}

__device__ __forceinline__ void row_rstd4x8(const float* ssq, int row0, int fq, float sc, float (&rs)[2][4]) {
    f32x4 a[2][4];
#pragma unroll
    for (int ai = 0; ai < 2; ++ai)
#pragma unroll
        for (int m = 0; m < 4; ++m) a[ai][m] = *(const __attribute__((address_space(1))) f32x4*)(ssq + (size_t)(row0 + ai * HALF + m * 16) * 16 + 4 * fq);
#pragma unroll
    for (int ai = 0; ai < 2; ++ai)
#pragma unroll
        for (int m = 0; m < 4; ++m) { float s = (a[ai][m][0] + a[ai][m][1]) + (a[ai][m][2] + a[ai][m][3]); s += __shfl_xor(s, 16); s += __shfl_xor(s, 32);
            rs[ai][m] = __builtin_amdgcn_rsqf(s * (1.0f / 1024.0f) + RMS_EPS) * sc; }
}
struct EpiProj {
    static constexpr bool PERM = true, AFTER_DRAIN = false;
    const float* ssq; bf16_t* base; size_t seg_stride; int tps, nseg, ldc; float scale0; bf16_t* qm; float scale_qm; int gm_rows;
    float* kmp; int kseg;
    __device__ __forceinline__ void operator()(const f32x4 (&acc)[2][2][4][2], const Unit& u, int wr, int wc, int fr, int fq) const {
        const int seg = u.pn / tps, within = u.pn - seg * tps;
        bf16_t* o; int ld, colt; float sc;
        if (seg < nseg) { o = base + (size_t)seg * seg_stride; ld = ldc; colt = within * BM; sc = (seg == 0) ? scale0 : 1.0f; }
        else { o = qm; ld = 256; colt = 0; sc = scale_qm; }
        const int row0 = u.pm * BM + wr * 64 + fr, col0 = colt + wc * 32 + 8 * fq;
        f32x4 cs[2][2] = {{{0.f, 0.f, 0.f, 0.f}, {0.f, 0.f, 0.f, 0.f}}, {{0.f, 0.f, 0.f, 0.f}, {0.f, 0.f, 0.f, 0.f}}};
        float rsv[2][4]; row_rstd4x8(ssq, row0, fq, sc, rsv);
#pragma unroll
        for (int ai = 0; ai < 2; ++ai)
#pragma unroll
            for (int m = 0; m < 4; ++m) { const int row = row0 + ai * HALF + m * 16; const float rs = rsv[ai][m]; bf16_t* rowp = o + (size_t)row * ld + col0;
                const bool gm = (gm_rows != 0) && (seg < nseg);
#pragma unroll
                for (int bj = 0; bj < 2; ++bj) { const f32x4 v0 = acc[ai][bj][m][0] * rs, v1 = acc[ai][bj][m][1] * rs;
                    u32x4 w; w.x = cvt_pk_bf16(v0[0], v0[1]); w.y = cvt_pk_bf16(v0[2], v0[3]); w.z = cvt_pk_bf16(v1[0], v1[1]); w.w = cvt_pk_bf16(v1[2], v1[3]);
                    const int cc = col0 + bj * HALF;
                    bf16_t* dst = gm ? (o + ((size_t)(cc >> 4) * gm_rows + row) * 16 + (cc & 15)) : (rowp + bj * HALF);
                    *(u32x4*)dst = w; cs[bj][0] += v0; cs[bj][1] += v1; } }
        if (seg == kseg) {
#pragma unroll
            for (int bj = 0; bj < 2; ++bj)
#pragma unroll
                for (int n = 0; n < 2; ++n)
#pragma unroll
                    for (int e = 0; e < 4; ++e) { float s = cs[bj][n][e]; s += __shfl_xor(s, 1); s += __shfl_xor(s, 2); s += __shfl_xor(s, 4); s += __shfl_xor(s, 8); cs[bj][n][e] = s; }
            if (fr == 0) { const int bb = u.pm >> 4, blk = u.pm & 15;
#pragma unroll
                for (int bj = 0; bj < 2; ++bj) { const int cc = col0 + bj * HALF, h = cc >> 6, d = cc & 63;
                    float* kd = kmp + (size_t)wr * (8 * 12 * 16 * 64) + ((size_t)((bb * 12 + h) * 16 + blk)) * 64 + d;
                    *(__attribute__((address_space(1))) f32x4*)kd = cs[bj][0]; *(__attribute__((address_space(1))) f32x4*)(kd + 4) = cs[bj][1]; } }
        }
    }
};
struct EpiGlu {
    static constexpr bool PERM = true, AFTER_DRAIN = false;
    const bf16_t* Y; int ldy; const float* bias; bf16_t* mix; int ldm; int ygm_rows;
    __device__ __forceinline__ void operator()(const f32x4 (&acc)[2][2][4][2], const Unit& u, int wr, int wc, int fr, int fq) const {
        const int row0 = u.pm * BM + wr * 64 + fr, col0 = u.pn * BM + wc * 32 + 8 * fq;
        f32x4 bv[2][2];
#pragma unroll
        for (int bj = 0; bj < 2; ++bj)
#pragma unroll
            for (int n = 0; n < 2; ++n) bv[bj][n] = *(const f32x4*)(bias + col0 + bj * HALF + 4 * n);
#pragma unroll
        for (int ai = 0; ai < 2; ++ai) {
            u32x4 yq[4][2];
#pragma unroll
            for (int m = 0; m < 4; ++m) { const int row = row0 + ai * HALF + m * 16;
#pragma unroll
                for (int bj = 0; bj < 2; ++bj) { const int cc = col0 + bj * HALF;
                    yq[m][bj] = ygm_rows ? *(const __attribute__((address_space(1))) u32x4*)(Y + ((size_t)(cc >> 4) * ygm_rows + row) * 16 + (cc & 15)) : *(const __attribute__((address_space(1))) u32x4*)(Y + (size_t)row * ldy + cc); } }
#pragma unroll
            for (int m = 0; m < 4; ++m) { const int row = row0 + ai * HALF + m * 16;
#pragma unroll
                for (int bj = 0; bj < 2; ++bj) { const u32x4 yw = yq[m][bj];
                    const f32x4 z0 = acc[ai][bj][m][0] + bv[bj][0], z1 = acc[ai][bj][m][1] + bv[bj][1];
                    float t[8]; const float yv[8] = {bflo(yw.x), bfhi(yw.x), bflo(yw.y), bfhi(yw.y), bflo(yw.z), bfhi(yw.z), bflo(yw.w), bfhi(yw.w)};
#pragma unroll
                    for (int e = 0; e < 4; ++e) { t[e] = yv[e] * __builtin_amdgcn_rcpf(1.0f + __builtin_amdgcn_exp2f(-1.4426950408889634f * z0[e])); t[4 + e] = yv[4 + e] * __builtin_amdgcn_rcpf(1.0f + __builtin_amdgcn_exp2f(-1.4426950408889634f * z1[e])); }
                    u32x4 w; w.x = cvt_pk_bf16(t[0], t[1]); w.y = cvt_pk_bf16(t[2], t[3]); w.z = cvt_pk_bf16(t[4], t[5]); w.w = cvt_pk_bf16(t[6], t[7]);
                    *(u32x4*)(mix + (size_t)row * ldm + col0 + bj * HALF) = w; } } }
    }
};
struct EpiRes {
    static constexpr bool PERM = true, AFTER_DRAIN = false;
    const float* basef; const bf16_t* baseb; bf16_t* xb; float* ssq_out;
    __device__ __forceinline__ void operator()(const f32x4 (&acc)[2][2][4][2], const Unit& u, int wr, int wc, int fr, int fq) const {
        const int row0 = u.pm * BM + wr * 64 + fr, col0 = u.pn * BM + wc * 32 + 8 * fq;
        typedef __attribute__((address_space(1))) const f32x4 gf4; typedef __attribute__((address_space(1))) const u32x4 gu4;
        if (basef) {
            f32x4 bn[2][2];
#pragma unroll
            for (int bj = 0; bj < 2; ++bj)
#pragma unroll
                for (int n = 0; n < 2; ++n) bn[bj][n] = *(gf4*)(basef + (size_t)row0 * 1024 + col0 + bj * HALF + n * 4);
#pragma unroll
            for (int idx = 0; idx < 8; ++idx) { const int ai = idx >> 2, m = idx & 3; const int row = row0 + ai * HALF + m * 16; const size_t off = (size_t)row * 1024 + col0; float ss = 0.f;
                f32x4 bc[2][2];
#pragma unroll
                for (int bj = 0; bj < 2; ++bj)
#pragma unroll
                    for (int n = 0; n < 2; ++n) bc[bj][n] = bn[bj][n];
                if (idx + 1 < 8) { const int row2 = row0 + ((idx + 1) >> 2) * HALF + ((idx + 1) & 3) * 16;
#pragma unroll
                    for (int bj = 0; bj < 2; ++bj)
#pragma unroll
                        for (int n = 0; n < 2; ++n) bn[bj][n] = *(gf4*)(basef + (size_t)row2 * 1024 + col0 + bj * HALF + n * 4); }
#pragma unroll
                for (int bj = 0; bj < 2; ++bj) { const f32x4 o0 = bc[bj][0] + acc[ai][bj][m][0], o1 = bc[bj][1] + acc[ai][bj][m][1];
                    u32x4 w; w.x = cvt_pk_bf16(o0[0], o0[1]); w.y = cvt_pk_bf16(o0[2], o0[3]); w.z = cvt_pk_bf16(o1[0], o1[1]); w.w = cvt_pk_bf16(o1[2], o1[3]);
                    *(u32x4*)(xb + off + bj * HALF) = w;
                    ss += ((o0[0] * o0[0] + o0[1] * o0[1]) + (o0[2] * o0[2] + o0[3] * o0[3])) + ((o1[0] * o1[0] + o1[1] * o1[1]) + (o1[2] * o1[2] + o1[3] * o1[3])); }
                ss += __shfl_xor(ss, 16); ss += __shfl_xor(ss, 32);
                if (fq == 0) ssq_out[(size_t)row * 16 + u.pn * 4 + wc] = ss; }
        } else {
            u32x4 bq[2][4][2];
#pragma unroll
            for (int ai = 0; ai < 2; ++ai)
#pragma unroll
                for (int m = 0; m < 4; ++m)
#pragma unroll
                    for (int bj = 0; bj < 2; ++bj) bq[ai][m][bj] = *(gu4*)(baseb + (size_t)(row0 + ai * HALF + m * 16) * 1024 + col0 + bj * HALF);
#pragma unroll
            for (int ai = 0; ai < 2; ++ai)
#pragma unroll
                for (int m = 0; m < 4; ++m) { const int row = row0 + ai * HALF + m * 16; const size_t off = (size_t)row * 1024 + col0; float ss = 0.f;
#pragma unroll
                    for (int bj = 0; bj < 2; ++bj) { const u32x4 q = bq[ai][m][bj];
                        const f32x4 b0 = (f32x4){bflo(q.x), bfhi(q.x), bflo(q.y), bfhi(q.y)}, b1 = (f32x4){bflo(q.z), bfhi(q.z), bflo(q.w), bfhi(q.w)};
                        const f32x4 o0 = b0 + acc[ai][bj][m][0], o1 = b1 + acc[ai][bj][m][1];
                        u32x4 w; w.x = cvt_pk_bf16(o0[0], o0[1]); w.y = cvt_pk_bf16(o0[2], o0[3]); w.z = cvt_pk_bf16(o1[0], o1[1]); w.w = cvt_pk_bf16(o1[2], o1[3]);
                        *(u32x4*)(xb + off + bj * HALF) = w;
                        ss += ((o0[0] * o0[0] + o0[1] * o0[1]) + (o0[2] * o0[2] + o0[3] * o0[3])) + ((o1[0] * o1[0] + o1[1] * o1[1]) + (o1[2] * o1[2] + o1[3] * o1[3])); }
                    ss += __shfl_xor(ss, 16); ss += __shfl_xor(ss, 32);
                    if (fq == 0) ssq_out[(size_t)row * 16 + u.pn * 4 + wc] = ss; }
        }
    }
};
struct EpiGU {
    static constexpr bool PERM = true, AFTER_DRAIN = false;
    const float* ssq; bf16_t* H; int ldh;
    __device__ __forceinline__ void operator()(const f32x4 (&acc)[2][2][4][2], const Unit& u, int wr, int wc, int fr, int fq) const {
        const int row0 = u.pm * BM + wr * 64 + fr, col0 = u.pn * HALF + wc * 32 + 8 * fq;
        float rsv[2][4]; row_rstd4x8(ssq, row0, fq, 1.0f, rsv);
#pragma unroll
        for (int ai = 0; ai < 2; ++ai)
#pragma unroll
            for (int m = 0; m < 4; ++m) { const int row = row0 + ai * HALF + m * 16; const float rs = rsv[ai][m];
                f32x4 hv[2];
                const float rsn = rs * -1.4426950408889634f, rs2 = rs * rs;
#pragma unroll
                for (int n = 0; n < 2; ++n) { const f32x4 G = acc[ai][0][m][n], U = acc[ai][1][m][n]; const f32x4 a = G * rsn;
                    f32x4 d; d[0] = __builtin_amdgcn_exp2f(a[0]); d[1] = __builtin_amdgcn_exp2f(a[1]); d[2] = __builtin_amdgcn_exp2f(a[2]); d[3] = __builtin_amdgcn_exp2f(a[3]);
                    d = d + 1.0f;
                    f32x4 r; r[0] = __builtin_amdgcn_rcpf(d[0]); r[1] = __builtin_amdgcn_rcpf(d[1]); r[2] = __builtin_amdgcn_rcpf(d[2]); r[3] = __builtin_amdgcn_rcpf(d[3]);
                    hv[n] = ((G * U) * rs2) * r; }
                u32x4 w; w.x = cvt_pk_bf16(hv[0][0], hv[0][1]); w.y = cvt_pk_bf16(hv[0][2], hv[0][3]); w.z = cvt_pk_bf16(hv[1][0], hv[1][1]); w.w = cvt_pk_bf16(hv[1][2], hv[1][3]);
                *(u32x4*)(H + (size_t)row * ldh + col0) = w; }
    }
};

template <class Epi, class Sched, bool ALIGN_EPI = false, bool SP2 = false>
__device__ __forceinline__ void gemm_phase(PG8_LAS unsigned char* lds, const Gemm g, const Sched& S, const Epi& E) {
    const int tid = threadIdx.x, wid = __builtin_amdgcn_readfirstlane(tid >> 6), lane = tid & 63, wr = wid >> 2, wc = wid & 3, fr = lane & 15, fq = lane >> 4;
    const int K = g.K, nt = K / BK;
    unsigned voffA[2], voffB[2];
#pragma unroll
    for (int i = 0; i < 2; ++i) { int R, C; stage_rc(tid * 16 + i * 8192, R, C); const int Rb = Epi::PERM ? ((R & ~31) + perm32(R & 31)) : R;
        voffA[i] = g.amode ? (unsigned)((C >> 4) * g.M * 32 + R * 32 + (C & 15) * 2) : (unsigned)(R * K + C) * 2u; voffB[i] = (unsigned)(Rb * K + C) * 2u; }
    const size_t kstep = (size_t)(BK * 2);
    const size_t hstep = (size_t)HALF * K * 2;
    const size_t tstep = 2 * hstep;
    const size_t kstepA = g.amode ? (size_t)4 * g.M * 32 : kstep, hstepA = g.amode ? (size_t)HALF * 32 : hstep, tstepA = 2 * hstepA;
    const unsigned ldsw = (unsigned)wid * 1024u;
    const int aoff = lds_byte(wr * 64 + fr, fq * 8), boff = lds_byte(wc * 32 + fr, fq * 8);
#define PG8_SA(b, h) (((b) * 2 + (h)) * HTB)
#define PG8_SB(b, h) ((4 + (b) * 2 + (h)) * HTB)
#define PG8_STAGE(bufoff, gbase, voff) do { _Pragma("unroll") for (int _i = 0; _i < 2; ++_i) \
        __builtin_amdgcn_global_load_lds((const unsigned*)((const char*)(gbase) + (voff)[_i]), (PG8_LAS unsigned*)(lds + (bufoff) + ldsw + _i * 8192), 16, 0, 0); } while (0)
#define PG8_LDA(dst, b, h) do { _Pragma("unroll") for (int m = 0; m < 4; ++m) _Pragma("unroll") for (int k = 0; k < 2; ++k) dst[m][k] = *(const PG8_LAS bf16x8*)(lds + PG8_SA(b, h) + aoff + m * 2048 + k * 1024); } while (0)
#define PG8_LDB(dst, b, h) do { _Pragma("unroll") for (int n = 0; n < 2; ++n) _Pragma("unroll") for (int k = 0; k < 2; ++k) dst[n][k] = *(const PG8_LAS bf16x8*)(lds + PG8_SB(b, h) + boff + n * 2048 + k * 1024); } while (0)
#define PG8_MMA(ai, bj, At, Bt) do { __builtin_amdgcn_s_setprio(1); _Pragma("unroll") for (int m = 0; m < 4; ++m) _Pragma("unroll") for (int n = 0; n < 2; ++n) _Pragma("unroll") for (int k = 0; k < 2; ++k) \
        acc[ai][bj][m][n] = __builtin_amdgcn_mfma_f32_16x16x32_bf16(Bt[n][k], At[m][k], acc[ai][bj][m][n], 0, 0, 0); __builtin_amdgcn_s_setprio(0); } while (0)
#define PG8_WAIT_V(n) asm volatile("s_waitcnt vmcnt(" #n ")" ::: "memory")
#define PG8_WAIT_L(n) asm volatile("s_waitcnt lgkmcnt(" #n ")" ::: "memory")
#define PG8_BAR __builtin_amdgcn_s_barrier()
#define PG8_SCHED __builtin_amdgcn_sched_barrier(0)
    Unit cur, nxt; int ui = 0;
    if (!S.next(0, cur)) return;
    f32x4 acc[2][2][4][2];
#pragma unroll
    for (int a = 0; a < 2; ++a)
#pragma unroll
        for (int b = 0; b < 2; ++b)
#pragma unroll
            for (int m = 0; m < 4; ++m)
#pragma unroll
                for (int n = 0; n < 2; ++n) acc[a][b][m][n] = (f32x4){0.f, 0.f, 0.f, 0.f};
    bf16x8 At[4][2], B0[2][2], B1[2][2];
    const char* cA = (const char*)g.A + (size_t)cur.pm * tstepA; const char* cB = (const char*)g.Bt + (size_t)cur.pn * tstep;
    S.a_ready(cur);
    if constexpr (SP2) {
        PG8_STAGE(PG8_SB(0, 0), cB, voffB); PG8_STAGE(PG8_SB(0, 1), cB + hstep, voffB); PG8_STAGE(PG8_SA(0, 0), cA, voffA); PG8_STAGE(PG8_SA(0, 1), cA + hstepA, voffA);
        if (wr == 1) PG8_BAR;
        PG8_WAIT_V(2); PG8_BAR;
        PG8_STAGE(PG8_SB(1, 0), cB + kstep, voffB); PG8_STAGE(PG8_SA(1, 0), cA + kstepA, voffA); PG8_STAGE(PG8_SB(1, 1), cB + hstep + kstep, voffB);
        PG8_WAIT_V(6); PG8_BAR;
    } else {
        PG8_STAGE(PG8_SB(0, 0), cB, voffB); PG8_STAGE(PG8_SA(0, 0), cA, voffA); PG8_STAGE(PG8_SB(0, 1), cB + hstep, voffB); PG8_STAGE(PG8_SA(0, 1), cA + hstepA, voffA);
        if (wr == 1) PG8_BAR;
        PG8_WAIT_V(4); PG8_BAR;
        PG8_STAGE(PG8_SB(1, 0), cB + kstep, voffB); PG8_STAGE(PG8_SA(1, 0), cA + kstepA, voffA); PG8_STAGE(PG8_SB(1, 1), cB + hstep + kstep, voffB);
        PG8_WAIT_V(6); PG8_BAR;
    }
    for (;;) {
        const bool has_next = S.next(ui + 1, nxt);
        const char* nA = has_next ? (const char*)g.A + (size_t)nxt.pm * tstepA : cA; const char* nB = has_next ? (const char*)g.Bt + (size_t)nxt.pn * tstep : cB;
        for (int t = 0; t < nt; t += 2) {
            const bool last = (t == nt - 2);
            const char* a1 = cA + (size_t)(t + 1) * kstepA;
            const char* a2 = last ? nA : cA + (size_t)(t + 2) * kstepA; const char* b2 = last ? nB : cB + (size_t)(t + 2) * kstep;
            const char* a3 = a2 + kstepA; const char* b3 = b2 + kstep;
            if (last && has_next) S.a_ready(nxt);
            if constexpr (SP2) {
            PG8_LDB(B0, 0, 0); PG8_LDB(B1, 0, 1); PG8_SCHED; PG8_LDA(At, 0, 0); PG8_STAGE(PG8_SA(1, 1), a1 + hstepA, voffA);
            PG8_WAIT_V(8); PG8_WAIT_L(0); PG8_BAR; PG8_MMA(0, 0, At, B0); PG8_MMA(0, 1, At, B1); PG8_BAR; PG8_SCHED;
            PG8_LDA(At, 0, 1); PG8_STAGE(PG8_SB(0, 0), b2, voffB); PG8_STAGE(PG8_SB(0, 1), b2 + hstep, voffB); PG8_STAGE(PG8_SA(0, 0), a2, voffA);
            PG8_WAIT_V(8); PG8_WAIT_L(0); PG8_BAR; PG8_MMA(1, 0, At, B0); PG8_MMA(1, 1, At, B1); PG8_BAR; PG8_SCHED;
            PG8_LDB(B0, 1, 0); PG8_LDB(B1, 1, 1); PG8_SCHED; PG8_LDA(At, 1, 0); PG8_STAGE(PG8_SA(0, 1), a2 + hstepA, voffA);
            PG8_WAIT_V(8); PG8_WAIT_L(0); PG8_BAR; PG8_MMA(0, 0, At, B0); PG8_MMA(0, 1, At, B1); PG8_BAR; PG8_SCHED;
            PG8_LDA(At, 1, 1); PG8_STAGE(PG8_SB(1, 0), b3, voffB); PG8_STAGE(PG8_SB(1, 1), b3 + hstep, voffB); PG8_STAGE(PG8_SA(1, 0), a3, voffA);
            PG8_WAIT_V(8); PG8_WAIT_L(0); PG8_BAR; PG8_MMA(1, 0, At, B0); PG8_MMA(1, 1, At, B1); PG8_BAR; PG8_SCHED;
            } else {
            PG8_LDB(B0, 0, 0); PG8_SCHED; PG8_LDA(At, 0, 0); PG8_STAGE(PG8_SA(1, 1), a1 + hstepA, voffA);
            PG8_WAIT_L(8); PG8_BAR; PG8_WAIT_L(0); PG8_MMA(0, 0, At, B0); PG8_BAR; PG8_SCHED;
            PG8_LDB(B1, 0, 1); PG8_STAGE(PG8_SB(0, 0), b2, voffB);
            PG8_BAR; PG8_WAIT_L(0); PG8_MMA(0, 1, At, B1); PG8_BAR;
            PG8_LDA(At, 0, 1); PG8_STAGE(PG8_SA(0, 0), a2, voffA);
            PG8_BAR; PG8_WAIT_L(0); PG8_MMA(1, 0, At, B0); PG8_BAR; PG8_SCHED;
            PG8_STAGE(PG8_SB(0, 1), b2 + hstep, voffB);
            PG8_WAIT_V(6); PG8_BAR; PG8_MMA(1, 1, At, B1); PG8_BAR;
            PG8_LDB(B0, 1, 0); PG8_SCHED; PG8_LDA(At, 1, 0); PG8_STAGE(PG8_SA(0, 1), a2 + hstepA, voffA);
            PG8_WAIT_L(8); PG8_BAR; PG8_WAIT_L(0); PG8_MMA(0, 0, At, B0); PG8_BAR; PG8_SCHED;
            PG8_LDB(B1, 1, 1); PG8_STAGE(PG8_SB(1, 0), b3, voffB);
            PG8_BAR; PG8_WAIT_L(0); PG8_MMA(0, 1, At, B1); PG8_BAR;
            PG8_LDA(At, 1, 1); PG8_STAGE(PG8_SA(1, 0), a3, voffA);
            PG8_BAR; PG8_WAIT_L(0); PG8_MMA(1, 0, At, B0); PG8_BAR; PG8_SCHED;
            PG8_STAGE(PG8_SB(1, 1), b3 + hstep, voffB);
            PG8_WAIT_V(6); PG8_BAR; PG8_MMA(1, 1, At, B1); PG8_BAR;
            }
        }
        if constexpr (ALIGN_EPI) { if (wr == 0) PG8_BAR; }
        if constexpr (!Epi::AFTER_DRAIN) { E(acc, cur, wr, wc, fr, fq); S.done(cur); }
        if (!has_next) break;
#pragma unroll
        for (int a = 0; a < 2; ++a)
#pragma unroll
            for (int b = 0; b < 2; ++b)
#pragma unroll
                for (int m = 0; m < 4; ++m)
#pragma unroll
                    for (int n = 0; n < 2; ++n) acc[a][b][m][n] = (f32x4){0.f, 0.f, 0.f, 0.f};
        cur = nxt; cA = nA; cB = nB; ++ui;
        if constexpr (ALIGN_EPI) { if (wr == 1) PG8_BAR; }
    }
    PG8_WAIT_V(0);
    if constexpr (!ALIGN_EPI) { if (wr == 0) PG8_BAR; }
    PG8_BAR;
    if constexpr (Epi::AFTER_DRAIN) { E.fused(acc, cur, wr, wc, fr, fq, lds, wid, lane); S.done(cur); }
#undef PG8_SA
#undef PG8_SB
#undef PG8_STAGE
#undef PG8_LDA
#undef PG8_LDB
#undef PG8_MMA
#undef PG8_WAIT_V
#undef PG8_WAIT_L
#undef PG8_BAR
#undef PG8_SCHED
}
}
constexpr int NWAVES = 8;
constexpr int BATCH = 8, SEQ = 4096, DM = 1024, TOK = BATCH * SEQ;
constexpr int TOKW = 768, MEMW = 256, MEML = 256, NGRP = 48, NST = 64, GCH = 16, NHEAD = 12, MHEAD = 4, HD = 64, FFN = 2816, NBLK = 16, MBLK = 256;
constexpr float C2 = 0.125f * 1.4426950408889634f;
constexpr float LOG2E = 1.4426950408889634f;

constexpr size_t MiB = 1u << 20;
constexpr size_t WS_CTL = 0, CTL_ZERO_BYTES = 1 * MiB;
constexpr size_t WS_S5TAB = 9 * MiB, WS_S5E = 13 * MiB;
constexpr size_t WS_SS0 = 1 * MiB, WS_SSA = 3 * MiB, WS_SSB = 5 * MiB, WS_SSM = 7 * MiB, WS_KMEAN = 8 * MiB;
constexpr size_t WS_WIN0 = 16 * MiB, WS_WGLU = 18 * MiB, WS_WIN1 = 20 * MiB, WS_WOUT0 = 26 * MiB, WS_WOUT1 = 28 * MiB;
constexpr size_t WS_WGU0 = 30 * MiB, WS_WGU1 = 41 * MiB, WS_WDN0 = 52 * MiB, WS_WDN1 = 58 * MiB, WS_WMKV = 64 * MiB;
constexpr size_t WS_MEMB = 65 * MiB, WS_MEMK = 69 * MiB, WS_MEMV = 70 * MiB;
constexpr size_t WS_XB = 72 * MiB;
constexpr size_t WS_R = 136 * MiB;
constexpr size_t WS_U = WS_R, WS_Y = WS_R + 48 * MiB;
constexpr size_t WS_Q1 = WS_R, WS_K1 = WS_R + 48 * MiB, WS_V1 = WS_R + 96 * MiB;
constexpr size_t WS_QM = WS_R + 144 * MiB;
constexpr size_t WS_MIX = WS_R + 160 * MiB;
constexpr size_t WS_H = WS_R;
constexpr size_t WS_END = WS_R + 224 * MiB;
constexpr int CW_BAR = 4096;

constexpr int RING_OFF = 0, RING_BYTES = 147456;
constexpr int LDSCTL_OFF = RING_BYTES, MISC_OFF = LDSCTL_OFF + 320;
constexpr int LDS_BYTES = RING_BYTES + 1024;

#define GAS __attribute__((address_space(1)))
#define LAS __attribute__((address_space(3)))
typedef unsigned short bf16;
typedef unsigned v4u __attribute__((ext_vector_type(4)));
typedef unsigned v2u __attribute__((ext_vector_type(2)));
typedef float f32x4 __attribute__((ext_vector_type(4)));
typedef GAS unsigned gu32;
typedef float f32x2 __attribute__((ext_vector_type(2)));
#define RLX_AGENT __ATOMIC_RELAXED, __HIP_MEMORY_SCOPE_AGENT
#define LDS_WAIT() asm volatile("s_waitcnt lgkmcnt(0)" ::: "memory")
#define VM_WAIT() asm volatile("s_waitcnt vmcnt(0)" ::: "memory")
__device__ __forceinline__ unsigned f2bf(float f) { unsigned u = __builtin_bit_cast(unsigned, f); return (u + 0x7fffu + ((u >> 16) & 1u)) >> 16; }
__device__ __forceinline__ unsigned pk2(float lo, float hi) { return f2bf(lo) | (f2bf(hi) << 16); }
__device__ __forceinline__ float bf2f(unsigned short h) { return __uint_as_float(((unsigned)h) << 16); }
__device__ __forceinline__ float bflo(unsigned w) { return __uint_as_float(w << 16); }
__device__ __forceinline__ float bfhi(unsigned w) { return __uint_as_float(w & 0xffff0000u); }

#define XB_TMO      128
#define XB_XCNT(j)  (256  + 64 * (j))
#define XB_XSUB(j)  (1280 + 64 * (j))
#define XB_XGEN(j)  (2304 + 64 * (j))
#define XB_TOP      3328
#define XB_TOPGEN   3392
#define XCD_BAR_WORDS 3456
#define XB_SPIN_CAP (1u << 18)

__device__ __forceinline__ unsigned xb_ld(unsigned* p)              { return __hip_atomic_load(p, __ATOMIC_RELAXED, __HIP_MEMORY_SCOPE_AGENT); }
__device__ __forceinline__ unsigned xb_add(unsigned* p, unsigned v) { return __hip_atomic_fetch_add(p, v, __ATOMIC_RELAXED, __HIP_MEMORY_SCOPE_AGENT); }
__device__ __forceinline__ unsigned xb_xcc_id() { return (unsigned)__builtin_amdgcn_s_getreg((3 << 11) | 20) & 0xFu; }
#define XB_SPIN(cond, bar) do { unsigned _sp = 0; while (cond) { __builtin_amdgcn_s_sleep(1); \
    if ((++_sp & 255u) == 0u) { if (xb_ld(&(bar)[XB_TMO])) break; if (_sp > XB_SPIN_CAP) { atomicAdd(&(bar)[XB_TMO], 1u); break; } } } } while (0)

struct XcdBarrier {
    unsigned* bar; unsigned x;
    volatile LAS unsigned* st;
};

__device__ __forceinline__ XcdBarrier xcd_barrier_post(unsigned* bar, volatile LAS unsigned* st) {
    XcdBarrier b; b.bar = bar; b.x = xb_xcc_id(); b.st = st;
    if (threadIdx.x == 0) (void)xb_add(&bar[XB_XCNT(b.x)], 1u);
    return b;
}
__device__ __forceinline__ void xcd_barrier_complete(unsigned* bar, unsigned x, unsigned& nloc, unsigned& nx) {
    const unsigned G = gridDim.x * gridDim.y * gridDim.z;
    unsigned sum, cnt, mine, sp = 0u;
    for (;;) {
        sum = 0u; cnt = 0u; mine = 0u;
#pragma unroll
        for (unsigned j = 0; j < 16; ++j) { const unsigned c = xb_ld(&bar[XB_XCNT(j)]); sum += c; cnt += (c > 0u) ? 1u : 0u; mine = (j == x) ? c : mine; }
        if (sum == G) break;
        __builtin_amdgcn_s_sleep(1);
        if ((++sp & 255u) == 0u) { if (xb_ld(&bar[XB_TMO])) break; if (sp > XB_SPIN_CAP) { atomicAdd(&bar[XB_TMO], 1u); break; } }
    }
    nloc = mine > 0u ? mine : 1u; nx = cnt > 0u ? cnt : 1u;
}

__device__ __forceinline__ void xcd_barrier(const XcdBarrier& b) {
    asm volatile("s_waitcnt vmcnt(0)" ::: "memory");
    __syncthreads();
    if (threadIdx.x == 0) {
        unsigned* bar = b.bar;
        __builtin_amdgcn_s_waitcnt(0);
        unsigned nloc = b.st[0], nx = b.st[1];
        if (nloc == 0u) { xcd_barrier_complete(bar, b.x, nloc, nx); b.st[0] = nloc; b.st[1] = nx; }
        const unsigned old = xb_add(&bar[XB_XSUB(b.x)], 1u);
        const unsigned gen = old / nloc;
        if (old + 1u == (gen + 1u) * nloc) {
            __builtin_amdgcn_fence(__ATOMIC_RELEASE, "agent");
            asm volatile("s_waitcnt vmcnt(0)" ::: "memory");
            const unsigned og = xb_add(&bar[XB_TOP], 1u);
            const unsigned tg = og / nx;
            if (og + 1u == (tg + 1u) * nx) xb_add(&bar[XB_TOPGEN], 1u);
            else XB_SPIN(xb_ld(&bar[XB_TOPGEN]) == tg, bar);
            __builtin_amdgcn_fence(__ATOMIC_ACQUIRE, "agent");
            xb_add(&bar[XB_XGEN(b.x)], 1u);
            asm volatile("s_waitcnt vmcnt(0)" ::: "memory");
        } else {
            XB_SPIN(xb_ld(&bar[XB_XGEN(b.x)]) == gen, bar);
            __builtin_amdgcn_fence(__ATOMIC_ACQUIRE, "agent");
            asm volatile("s_waitcnt vmcnt(0)" ::: "memory");
        }
    }
    __syncthreads();
}
namespace attn_body {
using bf16=__hip_bfloat16;
using bf16x8=__attribute__((ext_vector_type(8)))short;
using s16x4=__attribute__((ext_vector_type(4)))short;
using f32x16=__attribute__((ext_vector_type(16)))float;
using u32x4=__attribute__((ext_vector_type(4)))unsigned;
constexpr int D=64;
constexpr int NW=8,QBLK=32,QB=QBLK*NW,KVBLK=64;
__device__ __forceinline__ int crow(int r,int hi){return (r&3)+8*(r>>2)+4*hi;}
#define SBAR() __builtin_amdgcn_sched_barrier(0)
__device__ __forceinline__ void cmask(f32x16&p0,f32x16&p1,int jb,int qrel,int hi){
  const float NEG=-INFINITY; int kb=64*jb+4*hi;
  #pragma unroll
  for(int r=0;r<16;++r){int kv=kb+(r&3)+8*(r>>2); if(kv>qrel)p0[r]=NEG; if(kv+32>qrel)p1[r]=NEG;}
}

constexpr int NSLOT=3, SLOTB=8192;
constexpr int LDS_K=0, LDS_V=NSLOT*SLOTB, LDS_WS=2*NSLOT*SLOTB, LDS_OST=LDS_WS+NW*64*4, LDS_BYTES=LDS_OST+NW*4096;
__device__ __forceinline__ void glds16(const void*gsrc,unsigned lds_dst){unsigned keep;
  asm volatile("s_mov_b32 %0, m0\n\ts_mov_b32 m0, %2\n\ts_nop 0\n\tglobal_load_lds_dwordx4 %1, off\n\ts_mov_b32 m0, %0":"=&s"(keep):"v"(gsrc),"s"(lds_dst):"memory");}
__device__ __forceinline__ float max3f(float a,float b,float c){float r;asm("v_max3_f32 %0, %1, %2, %3":"=v"(r):"v"(a),"v"(b),"v"(c));return r;}
__device__ __forceinline__ float max2f(float a,float b){float r;asm("v_max_f32_e32 %0, %1, %2":"=v"(r):"v"(a),"v"(b));return r;}
__device__ __forceinline__ float fadd_s(float a,float b){float r;asm("v_add_f32_e32 %0, %1, %2":"=v"(r):"v"(a),"v"(b));return r;}
__device__ __forceinline__ float fsub_s(float a,float b){float r;asm("v_sub_f32_e32 %0, %1, %2":"=v"(r):"v"(a),"v"(b));return r;}
typedef float f32x2_t __attribute__((ext_vector_type(2))); typedef float f32x4_t __attribute__((ext_vector_type(4))); typedef __bf16 bf16x2_t __attribute__((ext_vector_type(2)));
__device__ __forceinline__ unsigned cvtpk_s(float lo,float hi){f32x2_t v={lo,hi};bf16x2_t b=__builtin_convertvector(v,bf16x2_t);return __builtin_bit_cast(unsigned,b);}
#define WAIT_BAR(N) asm volatile("s_waitcnt vmcnt(" #N ") lgkmcnt(0)\n\ts_barrier":::"memory")

__device__ __forceinline__ void qkt(f32x16&p0,f32x16&p1,const char*Kslot,const bf16x8*qr,int r32,int hi){
  const char*kb=Kslot+hi*1024+r32*16;
  #pragma unroll
  for(int d0=0;d0<4;++d0){
    const bf16x8 b0=*reinterpret_cast<const bf16x8*>(kb+d0*2048);
    const bf16x8 b1=*reinterpret_cast<const bf16x8*>(kb+d0*2048+512);
    p0=__builtin_amdgcn_mfma_f32_32x32x16_bf16(b0,qr[d0],p0,0,0,0);p1=__builtin_amdgcn_mfma_f32_32x32x16_bf16(b1,qr[d0],p1,0,0,0);}
}
typedef __attribute__((address_space(3))) const char* lds_cptr;
typedef short v4i16_t __attribute__((ext_vector_type(4)));
__device__ __forceinline__ void kload8(bf16x8*kf,lds_cptr kp){
  kf[0]=*(const __attribute__((address_space(3))) bf16x8*)(kp);      kf[1]=*(const __attribute__((address_space(3))) bf16x8*)(kp+512);
  kf[2]=*(const __attribute__((address_space(3))) bf16x8*)(kp+2048); kf[3]=*(const __attribute__((address_space(3))) bf16x8*)(kp+2560);
  kf[4]=*(const __attribute__((address_space(3))) bf16x8*)(kp+4096); kf[5]=*(const __attribute__((address_space(3))) bf16x8*)(kp+4608);
  kf[6]=*(const __attribute__((address_space(3))) bf16x8*)(kp+6144); kf[7]=*(const __attribute__((address_space(3))) bf16x8*)(kp+6656);
}
__device__ __forceinline__ void kload2(bf16x8*kf,lds_cptr kp,int j){ kf[2*j]=*(const __attribute__((address_space(3))) bf16x8*)(kp+j*2048); kf[2*j+1]=*(const __attribute__((address_space(3))) bf16x8*)(kp+j*2048+512); }
__device__ __forceinline__ s16x4 vtr(lds_cptr p){ return __builtin_bit_cast(s16x4,__builtin_amdgcn_ds_read_tr16_b64_v4i16((__attribute__((address_space(3))) v4i16_t*)p)); }
__device__ __forceinline__ float rowmax(const f32x16&p0,const f32x16&p1){
  float a=max3f(p0[0],p0[1],p1[0]),b=max3f(p0[2],p0[3],p1[1]);a=max3f(a,p1[2],p1[3]);
  #pragma unroll
  for(int r=4;r<16;r+=4){a=max3f(a,p0[r],p0[r+1]);b=max3f(b,p0[r+2],p0[r+3]);a=max3f(a,p1[r],p1[r+1]);b=max3f(b,p1[r+2],p1[r+3]);}
  const float m=max2f(a,b);
  auto rr=__builtin_amdgcn_permlane32_swap(__float_as_uint(m),__float_as_uint(m),false,false);
  return max2f(__uint_as_float(rr[0]),__uint_as_float(rr[1]));
}
__device__ __forceinline__ void pv(f32x16*o,int vb,bf16x8 pa0,bf16x8 pa1,bf16x8 pa2,bf16x8 pa3){
  #pragma unroll
  for(int d0=0;d0<2;++d0){s16x4 lo[4],hi[4];
    #pragma unroll
    for(int ks=0;ks<4;++ks){
      asm volatile("ds_read_b64_tr_b16 %0,%1 offset:%c2":"=&v"(lo[ks]):"v"(vb),"i"(d0*4096+ks*1024):"memory");
      asm volatile("ds_read_b64_tr_b16 %0,%1 offset:%c2":"=&v"(hi[ks]):"v"(vb),"i"(d0*4096+ks*1024+512):"memory");}
    asm volatile("s_waitcnt lgkmcnt(0)":::"memory");SBAR();
    #define PK(k) (bf16x8){lo[k][0],lo[k][1],lo[k][2],lo[k][3],hi[k][0],hi[k][1],hi[k][2],hi[k][3]}
    o[d0]=__builtin_amdgcn_mfma_f32_32x32x16_bf16(pa0,PK(0),o[d0],0,0,0);
    o[d0]=__builtin_amdgcn_mfma_f32_32x32x16_bf16(pa1,PK(1),o[d0],0,0,0);
    o[d0]=__builtin_amdgcn_mfma_f32_32x32x16_bf16(pa2,PK(2),o[d0],0,0,0);
    o[d0]=__builtin_amdgcn_mfma_f32_32x32x16_bf16(pa3,PK(3),o[d0],0,0,0);
    #undef PK
  }
}

#ifndef ATTN_STORE16
#define ATTN_STORE16(p,v) (*(u32x4*)(p)=(v))
#endif
template<int MODE,int THRL,int QP,int KP,int OP> __device__ __forceinline__ void attn_unit(const bf16*Qw0,const bf16*__restrict__ Kh,const bf16*__restrict__ Vh,bf16*Ow0,const int NT,
                                                                                          const float slope2,const float*kms0,const float*kms1,const int qb,char*shm){
  int tid_=threadIdx.x; asm volatile("":"+v"(tid_));
  const int tid=tid_,lane=tid&63,r32=lane&31,hi=lane>>5; const int wid=__builtin_amdgcn_readfirstlane(tid>>6);
  const bf16*Qw=Qw0+(long)(wid*QBLK)*QP;
  const unsigned lds0=(unsigned)(uintptr_t)shm;
  float*wsf=(float*)(shm+LDS_WS)+wid*64;
  const bf16*ksrc=Kh+(long)lane*KP+wid*8;
  const bf16*vsrc=Vh+(long)(16*(wid&3)+(lane>>2))*KP+(wid>>2)*32+(lane&3)*8;
  const unsigned kdst=lds0+LDS_K+wid*1024, vdst=lds0+LDS_V+wid*1024;
  #define PT(t) ((MODE==0)?(NT-1-(t)):(((t)<NT-4)?(NT-5-(t)):(t)))
  #define DMA_K(t,slot) glds16(ksrc+(long)PT(t)*KVBLK*KP,(unsigned)__builtin_amdgcn_readfirstlane(kdst+(slot)))
  #define DMA_V(t,slot) glds16(vsrc+(long)PT(t)*KVBLK*KP,(unsigned)__builtin_amdgcn_readfirstlane(vdst+(slot)))
  const int vb0=(int)(lds0+LDS_V)+((lane>>4)&1)*32+(lane&3)*8+(4*hi+((lane&15)>>2))*64;
  const char*Kbase=shm+LDS_K; bf16x8 kf[8];
  const lds_cptr shm3=(lds_cptr)shm; const lds_cptr kp0=shm3+LDS_K+hi*1024+r32*16; const lds_cptr vp0=shm3+LDS_V+((lane>>4)&1)*32+(lane&3)*8+(4*hi+((lane&15)>>2))*64;
  DMA_K(0,0);DMA_V(0,0);DMA_K(1,SLOTB);
  bf16x8 qr[4];
  #pragma unroll
  for(int d0=0;d0<4;++d0)qr[d0]=*reinterpret_cast<const bf16x8*>(&Qw[(long)r32*QP+d0*16+hi*8]);
  unsigned selm=0xffffffffu;
  if constexpr(MODE==1){
    f32x16 G=f32x16{};
    #pragma unroll
    for(int d0=0;d0<4;++d0){
      bf16x8 ah=bf16x8{},al=bf16x8{};
      if(r32<16){ const float*p0_=kms0+r32*64+d0*16+hi*8,*p1_=kms1+r32*64+d0*16+hi*8;
        const f32x4_t s0=*reinterpret_cast<const f32x4_t*>(p0_)+*reinterpret_cast<const f32x4_t*>(p1_), s1=*reinterpret_cast<const f32x4_t*>(p0_+4)+*reinterpret_cast<const f32x4_t*>(p1_+4);
        const float km_[8]={s0[0],s0[1],s0[2],s0[3],s1[0],s1[1],s1[2],s1[3]};
        #pragma unroll
        for(int i_=0;i_<8;i_+=2){ const unsigned wh_=cvtpk_s(km_[i_],km_[i_+1]); const float r0_=km_[i_]-__uint_as_float(wh_<<16), r1_=km_[i_+1]-__uint_as_float(wh_&0xffff0000u); const unsigned wl_=cvtpk_s(r0_,r1_);
          ah[i_]=(short)(wh_&0xffffu); ah[i_+1]=(short)(wh_>>16); al[i_]=(short)(wl_&0xffffu); al[i_+1]=(short)(wl_>>16); } }
      G=__builtin_amdgcn_mfma_f32_32x32x16_bf16(ah,qr[d0],G,0,0,0); G=__builtin_amdgcn_mfma_f32_32x32x16_bf16(al,qr[d0],G,0,0,0);}
    float g[16];
    #pragma unroll
    for(int r=0;r<4;++r){ const float a=G[r],b=G[4+r]; const float oa=__shfl_xor(a,32),ob=__shfl_xor(b,32);
      g[r]=hi?oa:a; g[4+r]=hi?a:oa; g[8+r]=hi?ob:b; g[12+r]=hi?b:ob; }
    #pragma unroll
    for(int n=0;n<16;++n) if(n>=qb) g[n]=-1.0e30f;
    const int nsel=qb<3?qb:3; unsigned mask=0u;
    #pragma unroll
    for(int rr=0;rr<3;++rr){ float best=-3.0e38f; int bi=0;
      #pragma unroll
      for(int n=0;n<16;++n){ const bool c=!((mask>>n)&1u)&&g[n]>best; best=c?g[n]:best; bi=c?n:bi; }
      if(rr<nsel) mask|=1u<<bi; }
    selm=mask|(1u<<qb);
  }
  float mhat=0.f,l_reg=0.f;f32x16 o[2];o[0]=f32x16{};o[1]=f32x16{};
  const int qrel=wid*QBLK+r32;
  const float hb=(MODE==1)?slope2*(float)(4*hi):0.f, s32=(MODE==1)?32.f*slope2:0.f, s64=(MODE==1)?64.f*slope2:0.f;
  #define CBASE(b0_,b1_,t) float b0_=fsub_s(fadd_s(s64*(float)PT(t),hb),mhat); if(MODE==1){ if(!((selm>>(PT(t)>>2))&1u)) b0_=-3.0e38f; } const float b1_=b0_+s32
  #define CFILL(X,B,bb) do{ _Pragma("unroll") for(int i_=0;i_<4;++i_){ if(MODE==1) X[(B)+i_]=__builtin_fmaf(slope2,(float)((((B)+i_)&3)+8*(((B)+i_)>>2)),bb); else X[(B)+i_]=bb; } }while(0)
  #define CINIT(C0,C1,t) do{ CBASE(b0_,b1_,t); CFILL(C0,0,b0_);CFILL(C0,4,b0_);CFILL(C0,8,b0_);CFILL(C0,12,b0_);CFILL(C1,0,b1_);CFILL(C1,4,b1_);CFILL(C1,8,b1_);CFILL(C1,12,b1_); }while(0)
  #define CMASK(P0,P1,t) do{ if(MODE==1){ int jb_=(t)-(NT-4); if(jb_>=0)cmask(P0,P1,jb_,qrel,hi);} }while(0)
  bool resc=false;
  #define START(P0,P1) do{ const float rm=rowmax(P0,P1); resc=false; \
    { const float dl=__builtin_fmaxf(rm,-1000.f); mhat=fadd_s(mhat,dl); \
      _Pragma("unroll") for(int r=0;r<16;++r){P0[r]=fsub_s(P0[r],dl);P1[r]=fsub_s(P1[r],dl);} } \
    _Pragma("unroll") for(int r=0;r<16;++r)P0[r]=__builtin_amdgcn_exp2f(P0[r]); }while(0)
  #define RESC() do{ if(resc){ asm volatile("s_waitcnt lgkmcnt(0)":::"memory"); \
      _Pragma("unroll") for(int d_=0;d_<2;++d_) _Pragma("unroll") for(int r=0;r<16;++r)o[d_][r]*=wsf[crow(r,hi)]; } }while(0)
  f32x16 pA0,pA1,pB0,pB1;
  int sl_prev=0,sl_cur=0,sl_next=SLOTB;
  #define ROT() do{sl_prev=sl_cur;sl_cur=sl_next;sl_next=(sl_next==(NSLOT-1)*SLOTB)?0:sl_next+SLOTB;}while(0)
  DMA_K(2,2*SLOTB);
  WAIT_BAR(3);
  CINIT(pA0,pA1,0);
  qkt(pA0,pA1,Kbase,qr,r32,hi);asm volatile("s_nop 15\n\ts_nop 7":"+v"(pA0),"+v"(pA1));CMASK(pA0,pA1,0);
  START(pA0,pA1);
  _Pragma("unroll") for(int r=0;r<16;++r)pA1[r]=__builtin_amdgcn_exp2f(pA1[r]);
  WAIT_BAR(0);
  DMA_K(3,0);DMA_V(1,SLOTB);
  ROT();
  kload8(kf,kp0+sl_cur);
  WAIT_BAR(2);
  s16x4 vlo[8],vhi[8]; u32x4 pw0,pw1,pw2,pw3;
  #define PKW(P,B) cvtpk_s(P[B],P[B+1])
  #define PAF(k) __builtin_bit_cast(bf16x8,pw##k)
  #define VFR(i) (bf16x8){vlo[i][0],vlo[i][1],vlo[i][2],vlo[i][3],vhi[i][0],vhi[i][1],vhi[i][2],vhi[i][3]}
  #define PIN(x) asm volatile("":"+v"(x))
  #define MX3(a,b,c) __builtin_fmaxf(__builtin_fmaxf((a),(b)),(c))
  #define GAPA(MF,A0,A1,A2,A3,W0,W1,PW) do{ MF; sacc+=A0; sacc+=A1; sacc+=A2; sacc+=A3; PIN(sacc); W0; W1; PIN(PW); SBAR(); }while(0)
  #define EX(v) __builtin_amdgcn_exp2f(v)
  #define GAPB(MF,X,B,N,bb) do{ MF; X[B]=EX(X[B]); X[B+1]=EX(X[B+1]); X[B+2]=EX(X[B+2]); X[B+3]=EX(X[B+3]); PIN(X); CFILL(N,B,bb); PIN(N); SBAR(); }while(0)
  #define VRD(i) do{ vlo[i]=vtr(vp_+(((i)>>2)*4096+((i)&3)*1024)); vhi[i]=vtr(vp_+(((i)>>2)*4096+((i)&3)*1024+512)); }while(0)
  #define KRD(G,j) do{ if(G){ kload2(kf,kp0+sl_next,j); SBAR(); } }while(0)
  #define STEP(C0,C1,P0,P1,t,GK,GV,GL) do{ SBAR(); \
    const lds_cptr vp_=vp0+sl_prev; \
    VRD(0); SBAR(); float sacc=(P0[0]+P0[1]); \
    GAPA(C0=__builtin_amdgcn_mfma_f32_32x32x16_bf16(kf[0],qr[0],C0,0,0,0), P0[2],P0[3],P0[4],P0[5],     pw0[0]=PKW(P0,0), pw0[1]=PKW(P0,2), pw0); \
    VRD(4); SBAR(); GAPA(C1=__builtin_amdgcn_mfma_f32_32x32x16_bf16(kf[1],qr[0],C1,0,0,0), P0[6],P0[7],P0[8],P0[9],     pw0[2]=PKW(P0,4), pw0[3]=PKW(P0,6), pw0); \
    VRD(1); SBAR(); GAPA(C0=__builtin_amdgcn_mfma_f32_32x32x16_bf16(kf[2],qr[1],C0,0,0,0),   P0[10],P0[11],P0[12],P0[13], pw1[0]=PKW(P0,8), pw1[1]=PKW(P0,10), pw1); \
    VRD(5); SBAR(); GAPA(C1=__builtin_amdgcn_mfma_f32_32x32x16_bf16(kf[3],qr[1],C1,0,0,0),   P0[14],P0[15],P1[0],P1[1],   pw1[2]=PKW(P0,12),pw1[3]=PKW(P0,14), pw1); \
    VRD(2); SBAR(); GAPA(C0=__builtin_amdgcn_mfma_f32_32x32x16_bf16(kf[4],qr[2],C0,0,0,0),   P1[2],P1[3],P1[4],P1[5],     pw2[0]=PKW(P1,0), pw2[1]=PKW(P1,2), pw2); \
    VRD(6); SBAR(); GAPA(C1=__builtin_amdgcn_mfma_f32_32x32x16_bf16(kf[5],qr[2],C1,0,0,0),   P1[6],P1[7],P1[8],P1[9],     pw2[2]=PKW(P1,4), pw2[3]=PKW(P1,6), pw2); \
    VRD(3); SBAR(); GAPA(C0=__builtin_amdgcn_mfma_f32_32x32x16_bf16(kf[6],qr[3],C0,0,0,0),   P1[10],P1[11],P1[12],P1[13], pw3[0]=PKW(P1,8), pw3[1]=PKW(P1,10), pw3); \
    VRD(7); SBAR(); GAPA(C1=__builtin_amdgcn_mfma_f32_32x32x16_bf16(kf[7],qr[3],C1,0,0,0),   P1[14],P1[15],0.f,0.f,       pw3[2]=PKW(P1,12),pw3[3]=PKW(P1,14), pw3); \
    l_reg+=sacc; \
    if(GK){DMA_K((t)+3,sl_cur);} if(GV){DMA_V((t)+1,sl_next);} \
    CMASKX(C0,C1,t); \
    { float a=MX3(C0[0],C0[1],C1[0]),b=MX3(C0[2],C0[3],C1[1]); a=MX3(a,C1[2],C1[3]); \
      _Pragma("unroll") for(int r=4;r<16;r+=4){a=MX3(a,C0[r],C0[r+1]);b=MX3(b,C0[r+2],C0[r+3]);a=MX3(a,C1[r],C1[r+1]);b=MX3(b,C1[r+2],C1[r+3]);} \
      float rm=__builtin_fmaxf(a,b); { auto rr=__builtin_amdgcn_permlane32_swap(__float_as_uint(rm),__float_as_uint(rm),false,false); rm=__builtin_fmaxf(__uint_as_float(rr[0]),__uint_as_float(rr[1])); } \
      resc=false; \
      if(__builtin_expect(__any(rm>(float)THRL),0)){ const float dl=__builtin_fmaxf(rm,0.f); mhat+=dl; \
        _Pragma("unroll") for(int r=0;r<16;++r){C0[r]-=dl;C1[r]-=dl;} \
        const float f=__builtin_amdgcn_exp2f(-dl); l_reg*=f; if(hi==0)wsf[r32]=f; resc=true; } } \
    CBASE(n0_,n1_,(t)+1);                                   \
    SBAR(); \
    GAPB(o[0]=__builtin_amdgcn_mfma_f32_32x32x16_bf16(PAF(0),VFR(0),o[0],0,0,0), C0,0, P0,n0_); \
    GAPB(o[1]=__builtin_amdgcn_mfma_f32_32x32x16_bf16(PAF(0),VFR(4),o[1],0,0,0), C0,4, P0,n0_); \
    KRD(GL,0); GAPB(o[0]=__builtin_amdgcn_mfma_f32_32x32x16_bf16(PAF(1),VFR(1),o[0],0,0,0), C0,8, P0,n0_); \
    KRD(GL,1); GAPB(o[1]=__builtin_amdgcn_mfma_f32_32x32x16_bf16(PAF(1),VFR(5),o[1],0,0,0), C0,12, P0,n0_); \
    KRD(GL,2); GAPB(o[0]=__builtin_amdgcn_mfma_f32_32x32x16_bf16(PAF(2),VFR(2),o[0],0,0,0), C1,0, P1,n1_); \
    KRD(GL,3); GAPB(o[1]=__builtin_amdgcn_mfma_f32_32x32x16_bf16(PAF(2),VFR(6),o[1],0,0,0), C1,4, P1,n1_); \
    GAPB(o[0]=__builtin_amdgcn_mfma_f32_32x32x16_bf16(PAF(3),VFR(3),o[0],0,0,0), C1,8, P1,n1_); \
    GAPB(o[1]=__builtin_amdgcn_mfma_f32_32x32x16_bf16(PAF(3),VFR(7),o[1],0,0,0), C1,12, P1,n1_); \
    }while(0)
  int t=1;
  CINIT(pB0,pB1,1);
  #define ENDW(tt) do{ if((tt)+3<NT){WAIT_BAR(2);} else if((tt)+2<NT){WAIT_BAR(1);} else {WAIT_BAR(0);} }while(0)
  #define CMASKX(P0,P1,t) do{ asm volatile("; head step (masked)"); CMASK(P0,P1,t); }while(0)
  for(;t+1<NT&&t<5;t+=2){
    STEP(pB0,pB1,pA0,pA1,t,(t+3<NT),(t+1<NT),(t+1<NT));       ENDW(t);   RESC(); ROT();
    STEP(pA0,pA1,pB0,pB1,t+1,(t+4<NT),(t+2<NT),(t+2<NT));     ENDW(t+1); RESC(); ROT();
  }
  #undef CMASKX
  #define CMASKX(P0,P1,t) do{ asm volatile("; steady step (no mask)"); }while(0)
  for(;t+5<NT;t+=2){
    STEP(pB0,pB1,pA0,pA1,t,true,true,true);     WAIT_BAR(2); RESC(); ROT();
    STEP(pA0,pA1,pB0,pB1,t+1,true,true,true);   WAIT_BAR(2); RESC(); ROT();
  }
  #undef CMASKX
  #define CMASKX(P0,P1,t) do{ asm volatile("; tail step (masked)"); CMASK(P0,P1,t); }while(0)
  for(;t+1<NT;t+=2){
    STEP(pB0,pB1,pA0,pA1,t,(t+3<NT),(t+1<NT),(t+1<NT));       ENDW(t);   RESC(); ROT();
    STEP(pA0,pA1,pB0,pB1,t+1,(t+4<NT),(t+2<NT),(t+2<NT));     ENDW(t+1); RESC(); ROT();
  }
  STEP(pB0,pB1,pA0,pA1,NT-1,false,false,false); RESC();
  { float sacc=pB0[0]+pB0[1]; _Pragma("unroll") for(int r=2;r<16;++r)sacc+=pB0[r]; _Pragma("unroll") for(int r=0;r<16;++r)sacc+=pB1[r]; l_reg+=sacc;
    pw0=(u32x4){PKW(pB0,0),PKW(pB0,2),PKW(pB0,4),PKW(pB0,6)};pw1=(u32x4){PKW(pB0,8),PKW(pB0,10),PKW(pB0,12),PKW(pB0,14)};pw2=(u32x4){PKW(pB1,0),PKW(pB1,2),PKW(pB1,4),PKW(pB1,6)};pw3=(u32x4){PKW(pB1,8),PKW(pB1,10),PKW(pB1,12),PKW(pB1,14)};
    SBAR(); pv(o,vb0+sl_cur,PAF(0),PAF(1),PAF(2),PAF(3)); }
  #undef PKW
  #undef PAF
  #undef VFR
  #undef PIN
  #undef MX3
  #undef GAPA
  #undef GAPB
  #undef EX
  #undef VRD
  #undef KRD
  #undef STEP
  #undef ENDW
  #undef CMASKX
  {auto rr=__builtin_amdgcn_permlane32_swap(__float_as_uint(l_reg),__float_as_uint(l_reg),false,false);l_reg=__uint_as_float(rr[0])+__uint_as_float(rr[1]);}
  if(hi==0)wsf[32+r32]=l_reg;asm volatile("s_waitcnt lgkmcnt(0)":::"memory");
  float rli[16];
  #pragma unroll
  for(int r=0;r<16;++r)rli[r]=__builtin_amdgcn_rcpf(wsf[32+crow(r,hi)]);
  bf16*Ow=Ow0+(long)(wid*QBLK)*OP;
  { bf16*stg=(bf16*)(shm+LDS_OST)+wid*2048;
    #pragma unroll
    for(int r=0;r<16;++r){const int orow=crow(r,hi);
      #pragma unroll
      for(int d0=0;d0<2;++d0)stg[orow*64+d0*32+r32]=__float2bfloat16(o[d0][r]*rli[r]);}
    asm volatile("s_waitcnt lgkmcnt(0)":::"memory");
    #pragma unroll
    for(int i=0;i<4;++i){const int row=i*8+(lane>>3),ch=lane&7; const u32x4 v=*(const u32x4*)(stg+row*64+ch*8); ATTN_STORE16(Ow+(long)row*OP+ch*8,v);} }
  asm volatile("s_waitcnt lgkmcnt(0)\n\ts_barrier":::"memory");
  #undef DMA_K
  #undef DMA_V
  #undef CMASK
  #undef CINIT
  #undef CBASE
  #undef CFILL
  #undef PT
  #undef START
  #undef RESC
  #undef ROT
}
constexpr int ATTN_LDS_BYTES=LDS_BYTES;
#undef SBAR
#undef WAIT_BAR
}
__device__ __forceinline__ float wave_sum(float v) {
#pragma unroll
    for (int o = 1; o < 64; o <<= 1) v += __shfl_xor(v, o);
    return v;
}
__device__ __forceinline__ float wave_max(float v) {
#pragma unroll
    for (int o = 1; o < 64; o <<= 1) v = fmaxf(v, __shfl_xor(v, o));
    return v;
}
__device__ __forceinline__ int opaque_zero() { int z; asm volatile("v_mov_b32 %0, 0" : "=v"(z)); return z; }

__device__ __forceinline__ void p0_transpose_item(const float* W, int K, int N, bf16* WT, int dest_row0, int k0, int n0, const float* gk, LAS float* scr, int lane) {
    float wv[32];
#pragma unroll
    for (int i = 0; i < 32; ++i) { const int kk = 2 * i + (lane >> 5); wv[i] = W[(size_t)(k0 + kk) * N + n0 + (lane & 31)]; }
    if (gk) {
#pragma unroll
        for (int i = 0; i < 32; ++i) wv[i] *= gk[k0 + 2 * i + (lane >> 5)]; }
#pragma unroll
    for (int i = 0; i < 32; ++i) { const int kk = 2 * i + (lane >> 5); scr[kk * 33 + (lane & 31)] = wv[i]; }
    LDS_WAIT(); asm volatile("" ::: "memory");
    const int c = lane & 7;
#pragma unroll
    for (int j = 0; j < 4; ++j) { const int n = (lane >> 3) + 8 * j; const LAS float* s = scr + (8 * c) * 33 + n;
        v4u o; o.x = pk2(s[0 * 33], s[1 * 33]); o.y = pk2(s[2 * 33], s[3 * 33]); o.z = pk2(s[4 * 33], s[5 * 33]); o.w = pk2(s[6 * 33], s[7 * 33]);
        *(GAS v4u*)(WT + (size_t)(dest_row0 + n) * K + k0 + 8 * c) = o; }
    LDS_WAIT(); asm volatile("" ::: "memory");
}
__device__ __forceinline__ void p0_matrix_item(const float* W, int K, int N, bf16* WT, const float* gk, int mode, int item, LAS float* scr, int lane) {
    const int nblk = N / 32, kb = item / nblk, nb = item - kb * nblk, k0 = 64 * kb, n0 = 32 * nb;
    const int dr = (mode == 0) ? n0 : (256 * (n0 >> 7) + (n0 & 127) + (mode == 2 ? 128 : 0));
    p0_transpose_item(W, K, N, WT, dr, k0, n0, gk, scr, lane);
}
template <int NR>
__device__ __forceinline__ void rows_to_bf16_ssq(const float* xrow, bf16* orow, float* ssq16, int lane) {
    f32x4 v[NR][4];
#pragma unroll
    for (int r = 0; r < NR; ++r) { const GAS f32x4* xr = (const GAS f32x4*)(xrow + (size_t)r * 1024) + lane;
#pragma unroll
        for (int j = 0; j < 4; ++j) v[r][j] = xr[64 * j]; }
#pragma unroll
    for (int r = 0; r < NR; ++r) { float s = 0.f;
#pragma unroll
        for (int j = 0; j < 4; ++j) s += (v[r][j].x * v[r][j].x + v[r][j].y * v[r][j].y) + (v[r][j].z * v[r][j].z + v[r][j].w * v[r][j].w);
        s = wave_sum(s);
        GAS unsigned long long* o8 = (GAS unsigned long long*)(orow + (size_t)r * 1024) + lane;
#pragma unroll
        for (int j = 0; j < 4; ++j) o8[64 * j] = (unsigned long long)pk2(v[r][j].x, v[r][j].y) | ((unsigned long long)pk2(v[r][j].z, v[r][j].w) << 32);
        if (lane < 16) ssq16[r * 16 + lane] = (lane == 0) ? s : 0.f; }
}

__device__ __forceinline__ void s5_naive_unit(int b, int g, const bf16* U, bf16* Y, const float* lam_re, const float* lam_im, const float* log_dt, const float* b_re, const float* b_im,
                                              const float* c_re, const float* c_im, const float* dvec, int lane) {
    const int p = lane;
    const float lr = lam_re[g * 64 + p], li = lam_im[g * 64 + p], dt = expf(log_dt[g]);
    const float mag = expf(lr * dt), ar = mag * cosf(li * dt), ai = mag * sinf(li * dt);
    const float den = lr * lr + li * li, nr = ar - 1.0f, fr = (nr * lr + ai * li) / den, fi = (ai * lr - nr * li) / den;
    float bbr[16], bbi[16], cr[16], ci[16];
#pragma unroll
    for (int c = 0; c < 16; ++c) { const float br = b_re[((size_t)g * 64 + p) * 16 + c], bi = b_im[((size_t)g * 64 + p) * 16 + c]; bbr[c] = fr * br - fi * bi; bbi[c] = fr * bi + fi * br;
        cr[c] = c_re[((size_t)g * 16 + c) * 64 + p]; ci[c] = c_im[((size_t)g * 16 + c) * 64 + p]; }
    const int ch = ((lane & 1) << 3) | ((lane & 2) << 1) | ((lane & 4) >> 1) | ((lane & 8) >> 3);
    const float dch = dvec[16 * g + ch];
    const int z0 = opaque_zero();
    constexpr int TP = 16;
    const bf16* up = U + ((size_t)g * TOK + (size_t)b * SEQ) * 16 + z0;
    bf16* yp = Y + ((size_t)g * TOK + (size_t)b * SEQ) * 16 + ch;
    float xr = 0.f, xi = 0.f;
#pragma unroll 2
    for (int s = 0; s < SEQ; ++s) {
        const v4u w0 = *(const GAS v4u*)(up + (size_t)s * TP), w1 = *(const GAS v4u*)(up + (size_t)s * TP + 8);
        const float uch = bf2f(up[(size_t)s * TP + ch]);
        const float uu[16] = {bflo(w0.x), bfhi(w0.x), bflo(w0.y), bfhi(w0.y), bflo(w0.z), bfhi(w0.z), bflo(w0.w), bfhi(w0.w), bflo(w1.x), bfhi(w1.x), bflo(w1.y), bfhi(w1.y), bflo(w1.z), bfhi(w1.z), bflo(w1.w), bfhi(w1.w)};
        float bur = 0.f, bui = 0.f;
#pragma unroll
        for (int c = 0; c < 16; ++c) { bur += bbr[c] * uu[c]; bui += bbi[c] * uu[c]; }
        const float nxr = ar * xr - ai * xi + bur, nxi = ar * xi + ai * xr + bui; xr = nxr; xi = nxi;
        float v[16];
#pragma unroll
        for (int c = 0; c < 16; ++c) v[c] = cr[c] * xr - ci[c] * xi;
        float w[8], x4[4], x2[2], z;
        { const bool bit = lane & 1;
#pragma unroll
          for (int j = 0; j < 8; ++j) { const float send = bit ? v[j] : v[j + 8], keep = bit ? v[j + 8] : v[j]; w[j] = keep + __shfl_xor(send, 1); } }
        { const bool bit = lane & 2;
#pragma unroll
          for (int j = 0; j < 4; ++j) { const float send = bit ? w[j] : w[j + 4], keep = bit ? w[j + 4] : w[j]; x4[j] = keep + __shfl_xor(send, 2); } }
        { const bool bit = lane & 4;
#pragma unroll
          for (int j = 0; j < 2; ++j) { const float send = bit ? x4[j] : x4[j + 2], keep = bit ? x4[j + 2] : x4[j]; x2[j] = keep + __shfl_xor(send, 4); } }
        { const bool bit = lane & 8; const float send = bit ? x2[0] : x2[1], keep = bit ? x2[1] : x2[0]; z = keep + __shfl_xor(send, 8); }
        z += __shfl_xor(z, 16); z += __shfl_xor(z, 32);
        const float yv = z + dch * uch;
        const float ge = 0.5f * yv * (1.0f + erff(yv * 0.70710678118654752f));
        if (lane < 16) yp[(size_t)s * TP] = (bf16)f2bf(ge);
    }
}

__device__ __forceinline__ void memattn_naive_unit(int tok, int h, const bf16* QM, const bf16* memk, const bf16* memv, bf16* mix, LAS float* ps, int lane) {
    const int b = tok >> 12; const int z0 = opaque_zero();
    const float qv = bf2f(QM[(size_t)tok * 256 + h * 64 + lane]);
    float q[64];
#pragma unroll
    for (int d = 0; d < 64; ++d) q[d] = __shfl(qv, d);
    float sc[4];
#pragma unroll
    for (int i = 0; i < 4; ++i) { const int j = lane + 64 * i; const GAS v4u* kr = (const GAS v4u*)(memk + ((size_t)(b * 256 + j)) * 256 + h * 64 + z0); float a = 0.f;
#pragma unroll
        for (int c = 0; c < 8; ++c) { const v4u w = kr[c]; a += q[8 * c] * bflo(w.x) + q[8 * c + 1] * bfhi(w.x) + q[8 * c + 2] * bflo(w.y) + q[8 * c + 3] * bfhi(w.y) + q[8 * c + 4] * bflo(w.z) + q[8 * c + 5] * bfhi(w.z) + q[8 * c + 6] * bflo(w.w) + q[8 * c + 7] * bfhi(w.w); }
        sc[i] = a; }
    const float m = wave_max(fmaxf(fmaxf(sc[0], sc[1]), fmaxf(sc[2], sc[3])));
    float l = 0.f;
#pragma unroll
    for (int i = 0; i < 4; ++i) { const float pe = __builtin_amdgcn_exp2f(sc[i] - m); l += pe; ps[lane + 64 * i] = pe; }
    l = wave_sum(l);
    LDS_WAIT(); asm volatile("" ::: "memory");
    float o = 0.f; const bf16* vp = memv + (size_t)(b * 256) * 256 + h * 64 + lane;
#pragma unroll 8
    for (int j = 0; j < 256; ++j) o += ps[j] * bf2f(vp[(size_t)j * 256]);
    mix[(size_t)tok * 1024 + 768 + h * 64 + lane] = (bf16)f2bf(o / l);
    LDS_WAIT(); asm volatile("" ::: "memory");
}

__device__ __forceinline__ float dot64_bf16(const float (&q)[64], const GAS v4u* kr) {
    float a = 0.f;
#pragma unroll
    for (int c = 0; c < 8; ++c) { const v4u w = kr[c]; a += q[8 * c] * bflo(w.x) + q[8 * c + 1] * bfhi(w.x) + q[8 * c + 2] * bflo(w.y) + q[8 * c + 3] * bfhi(w.y) + q[8 * c + 4] * bflo(w.z) + q[8 * c + 5] * bfhi(w.z) + q[8 * c + 6] * bflo(w.w) + q[8 * c + 7] * bfhi(w.w); }
    return a;
}
__device__ __forceinline__ void moba_naive_unit(int tok, int h, const bf16* Q1, const bf16* K1, const bf16* V1, const float* KMEAN, bf16* mix, LAS float* ps, int lane) {
    const int b = tok >> 12, s = tok & (SEQ - 1), qb = s >> 8; const int z0 = opaque_zero();
    const float qv = bf2f(Q1[(size_t)tok * TOKW + h * 64 + lane]);
    float q[64];
#pragma unroll
    for (int d = 0; d < 64; ++d) q[d] = __shfl(qv, d);
    float gate = -1e30f;
    { const int n = lane & 15; const GAS f32x4* km = (const GAS f32x4*)(KMEAN + ((size_t)((b * NHEAD + h) * NBLK + n)) * 64 + z0); float a = 0.f;
#pragma unroll
      for (int c = 0; c < 16; ++c) { const f32x4 w = km[c]; a += q[4 * c] * w.x + q[4 * c + 1] * w.y + q[4 * c + 2] * w.z + q[4 * c + 3] * w.w; }
      if (n < qb) gate = a; }
    float g[16];
#pragma unroll
    for (int n = 0; n < 16; ++n) g[n] = __shfl(gate, n);
    const int nsel = qb < 3 ? qb : 3;
    unsigned mask = 0u;
#pragma unroll
    for (int r = 0; r < 3; ++r) { float best = -3.0e38f; int bi = 0;
#pragma unroll
        for (int n = 0; n < 16; ++n) { const bool c = !((mask >> n) & 1u) && g[n] > best; best = c ? g[n] : best; bi = c ? n : bi; }
        if (r < nsel) mask |= 1u << bi; }
    int blk0 = 0, blk1 = 0, blk2 = 0, cnt = 0;
#pragma unroll
    for (int n = 0; n < 16; ++n) if ((mask >> n) & 1u) { if (cnt == 0) blk0 = n; else if (cnt == 1) blk1 = n; else blk2 = n; ++cnt; }
    const int nslots = nsel + 1;
    const float slope = __builtin_amdgcn_exp2f(-8.0f * (float)(h + 1) / 12.0f) * LOG2E;
    const bf16* kh = K1 + (size_t)b * SEQ * TOKW + h * 64 + z0;
    float mx = -3.0e38f;
#pragma unroll
    for (int sl = 0; sl < 4; ++sl) if (sl < nslots) {
        const int blk = (sl == nsel) ? qb : (sl == 0 ? blk0 : (sl == 1 ? blk1 : blk2));
#pragma unroll
        for (int i = 0; i < 4; ++i) { const int j = lane + 64 * i, pos = blk * 256 + j;
            float a = dot64_bf16(q, (const GAS v4u*)(kh + (size_t)pos * TOKW)) + slope * (float)(pos - s);
            if (pos > s) a = -3.0e38f;
            ps[sl * 256 + j] = a; mx = fmaxf(mx, a); } }
    mx = wave_max(mx);
    LDS_WAIT(); asm volatile("" ::: "memory");
    float l = 0.f;
#pragma unroll
    for (int sl = 0; sl < 4; ++sl) if (sl < nslots) {
#pragma unroll
        for (int i = 0; i < 4; ++i) { const int j = lane + 64 * i; const float a = ps[sl * 256 + j]; const float pe = (a < -1.0e37f) ? 0.f : __builtin_amdgcn_exp2f(a - mx); l += pe; ps[sl * 256 + j] = pe; } }
    l = wave_sum(l);
    LDS_WAIT(); asm volatile("" ::: "memory");
    float o = 0.f; const bf16* vh = V1 + (size_t)b * SEQ * TOKW + h * 64 + lane;
#pragma unroll
    for (int sl = 0; sl < 4; ++sl) if (sl < nslots) {
        const int blk = (sl == nsel) ? qb : (sl == 0 ? blk0 : (sl == 1 ? blk1 : blk2));
        const bf16* vp = vh + (size_t)(blk * 256) * TOKW;
#pragma unroll 8
        for (int j = 0; j < 256; ++j) o += ps[sl * 256 + j] * bf2f(vp[(size_t)j * TOKW]); }
    mix[(size_t)tok * 1024 + h * 64 + lane] = (bf16)f2bf(o / l);
    LDS_WAIT(); asm volatile("" ::: "memory");
}

constexpr int S5_PITCH = 272;
constexpr int S5_WST = 0, S5_WYC = 128 * S5_PITCH, S5_KT = 2 * 128 * S5_PITCH, S5_TAB_BYTES = S5_KT + 10 * 512;
constexpr int S5_XS = S5_TAB_BYTES, S5_XS_BYTES = 32 * S5_PITCH;
static_assert(S5_XS + NWAVES * S5_XS_BYTES <= RING_BYTES, "S5 LDS map");
typedef short s5_bf16x8 __attribute__((ext_vector_type(8)));
typedef float s5_f32x16 __attribute__((ext_vector_type(16)));

__device__ __forceinline__ void s5_apow(float lr, float li, float dt, int n, float& pr, float& pi) { const float m = expf(lr * dt * (float)n), th = li * dt * (float)n; pr = m * cosf(th); pi = m * sinf(th); }
__device__ __forceinline__ void s5_apow_fast(float lr, float li, float dt, int n, float& pr, float& pi) { const float m = __expf(lr * dt * (float)n), th = li * dt * (float)n; pr = m * __cosf(th); pi = m * __sinf(th); }
__device__ __forceinline__ void s5_zoh(float lr, float li, float dt, float& fr, float& fi) {
    float ar, ai; s5_apow(lr, li, dt, 1, ar, ai); const float den = lr * lr + li * li, nr = ar - 1.0f; fr = (nr * lr + ai * li) / den; fi = (ai * lr - nr * li) / den;
}
__device__ __forceinline__ void s5_tab_wst(int g, int jt, unsigned char* tab, const float* lam_re, const float* lam_im, const float* log_dt, const float* b_re, const float* b_im, int lane) {
    const int s = lane >> 3, cp = lane & 7; const float dt = expf(log_dt[g]);
    float zr, zi, mylr, myli;
    { const int p = (jt >> 1) * 32 + (lane & 31); mylr = lam_re[g * 64 + p]; myli = lam_im[g * 64 + p]; s5_zoh(mylr, myli, dt, zr, zi); }
#pragma unroll 4
    for (int r = 0; r < 32; ++r) { const int p = (jt >> 1) * 32 + r; const float lr = __shfl(mylr, r), li = __shfl(myli, r), fr = __shfl(zr, r), fi = __shfl(zi, r);
        float pr, pi; s5_apow_fast(lr, li, dt, 7 - s, pr, pi);
        float o[2];
#pragma unroll
        for (int e = 0; e < 2; ++e) { const int c = 2 * cp + e; const float br = b_re[((size_t)g * 64 + p) * 16 + c], bi = b_im[((size_t)g * 64 + p) * 16 + c];
            const float bbr = fr * br - fi * bi, bbi = fr * bi + fi * br; o[e] = (jt & 1) ? (pr * bbi + pi * bbr) : (pr * bbr - pi * bbi); }
        *(GAS unsigned*)(tab + S5_WST + (32 * jt + r) * S5_PITCH + (16 * s + 2 * cp) * 2) = pk2(o[0], o[1]); }
}
__device__ __forceinline__ void s5_tab_const(int g, float* ctab, const float* lam_re, const float* lam_im, const float* log_dt, int lane) {
    const float dt = expf(log_dt[g]); float xr, xi; s5_apow(lam_re[g * 64 + lane], lam_im[g * 64 + lane], dt, 1, xr, xi);
#pragma unroll
    for (int q = 0; q < 3; ++q) { const float nr = xr * xr - xi * xi, ni = 2.0f * xr * xi; xr = nr; xi = ni; }
    const float ar = xr, ai = xi;
#pragma unroll
    for (int q = 0; q < 5; ++q) { const float nr = xr * xr - xi * xi, ni = 2.0f * xr * xi; xr = nr; xi = ni; }
    *(GAS f32x4*)(ctab + ((size_t)g * 64 + lane) * 4) = (f32x4){ar, ai, xr, xi};
}
__device__ __forceinline__ void s5_tab_wyc(int g, int t, unsigned char* tab, const float* lam_re, const float* lam_im, const float* log_dt, const float* c_re, const float* c_im, int lane) {
    const int p = lane; const float dt = expf(log_dt[g]); float pr, pi; s5_apow_fast(lam_re[g * 64 + p], lam_im[g * 64 + p], dt, t + 1, pr, pi);
#pragma unroll
    for (int c = 0; c < 16; ++c) { const float cr = c_re[((size_t)g * 16 + c) * 64 + p], ci = c_im[((size_t)g * 16 + c) * 64 + p];
        *(GAS unsigned*)(tab + S5_WYC + (16 * t + c) * S5_PITCH + 4 * p) = pk2(cr * pr - ci * pi, -(cr * pi + ci * pr)); }
}
__device__ __forceinline__ void s5_tab_kt(int g, int d, unsigned char* tab, const float* lam_re, const float* lam_im, const float* log_dt, const float* b_re, const float* b_im, const float* c_re, const float* c_im,
                                          const float* dvec, int lane) {
    const float dt = expf(log_dt[g]); float mr, mi;
    { const float lr = lam_re[g * 64 + lane], li = lam_im[g * 64 + lane]; float pr, pi, fr, fi; s5_apow_fast(lr, li, dt, d, pr, pi); s5_zoh(lr, li, dt, fr, fi); mr = pr * fr - pi * fi; mi = pr * fi + pi * fr; }
    float acc[4] = {0.f, 0.f, 0.f, 0.f};
#pragma unroll 8
    for (int p = 0; p < 64; ++p) { const float pmr = __shfl(mr, p), pmi = __shfl(mi, p);
#pragma unroll
        for (int i = 0; i < 4; ++i) { const int e = lane + 64 * i, c = e >> 4, c2 = e & 15;
            const float br = b_re[((size_t)g * 64 + p) * 16 + c2], bi = b_im[((size_t)g * 64 + p) * 16 + c2], cr = c_re[((size_t)g * 16 + c) * 64 + p], ci = c_im[((size_t)g * 16 + c) * 64 + p];
            const float tr = pmr * br - pmi * bi, ti = pmr * bi + pmi * br; acc[i] += cr * tr - ci * ti; } }
#pragma unroll
    for (int i = 0; i < 4; ++i) { const int e = lane + 64 * i, c = e >> 4, c2 = e & 15; float v = acc[i]; if (d == 0 && c == c2) v += dvec[16 * g + c];
        *(GAS bf16*)(tab + S5_KT + (d + 1) * 512 + c * 32 + c2 * 2) = (bf16)f2bf(v);
        if (d == 0) *(GAS bf16*)(tab + S5_KT + c * 32 + c2 * 2) = (bf16)0; }
}

template <bool FINAL>
__device__ __forceinline__ void s5_unit(int g, int seg, const bf16* Ug, bf16* Yg, const unsigned char* tab, float* Ebuf, const float* ctab, LAS unsigned char* L) {
    int tid_ = threadIdx.x; asm volatile("" : "+v"(tid_));
    const int tid = tid_, lane = tid & 63, r32 = lane & 31, hi = lane >> 5, b = __builtin_amdgcn_readfirstlane(tid >> 6);
    { const int npc = (FINAL ? S5_TAB_BYTES : S5_WYC) / 1024; const unsigned l0 = (unsigned)(uintptr_t)(unsigned char*)L;
      for (int i = b; i < npc; i += NWAVES) attn_body::glds16(tab + (size_t)i * 1024 + lane * 16, (unsigned)__builtin_amdgcn_readfirstlane(l0 + i * 1024)); }
    const size_t tok0 = (size_t)g * TOK + (size_t)b * SEQ + (size_t)seg * 256;
    s5_bf16x8 A[8];
    { const bf16* up = Ug + (tok0 + 8 * r32) * 16 + 8 * hi;
#pragma unroll
      for (int s = 0; s < 8; ++s) A[s] = *(const GAS s5_bf16x8*)(up + s * 16); }
    float aLr[2], aLi[2], aSr[2], aSi[2];
#pragma unroll
    for (int k = 0; k < 2; ++k) { const f32x4 cv = *(const GAS f32x4*)(ctab + ((size_t)g * 64 + 32 * k + r32) * 4); aLr[k] = cv.x; aLi[k] = cv.y; aSr[k] = cv.z; aSi[k] = cv.w; }
    float cr[2] = {0.f, 0.f}, ci[2] = {0.f, 0.f};
    if (FINAL) {
        const float* eb = Ebuf + ((size_t)(b * NGRP + g) * 16) * 128;
        f32x2 ev[15][2];
#pragma unroll
        for (int j = 0; j < 15; ++j)
#pragma unroll
            for (int k = 0; k < 2; ++k) ev[j][k] = (j < seg) ? *(const GAS f32x2*)(eb + (size_t)j * 128 + 2 * (32 * k + r32)) : (f32x2){0.f, 0.f};
#pragma unroll
        for (int j = 0; j < 15; ++j) if (j < seg) {
#pragma unroll
            for (int k = 0; k < 2; ++k) { const float nr = aSr[k] * cr[k] - aSi[k] * ci[k] + ev[j][k].x, ni = aSr[k] * ci[k] + aSi[k] * cr[k] + ev[j][k].y; cr[k] = nr; ci[k] = ni; } }
    }
    asm volatile("s_waitcnt vmcnt(0)" ::: "memory");
    __syncthreads();
    s5_f32x16 S[4];
#pragma unroll
    for (int j = 0; j < 4; ++j) { S[j] = s5_f32x16{};
#pragma unroll
        for (int s = 0; s < 8; ++s) { const s5_bf16x8 bf = *(const LAS s5_bf16x8*)(L + S5_WST + (32 * j + r32) * S5_PITCH + (16 * s + 8 * hi) * 2);
            S[j] = __builtin_amdgcn_mfma_f32_32x32x16_bf16(A[s], bf, S[j], 0, 0, 0); } }
    if (!FINAL) {
        float e_r[2], e_i[2];
#pragma unroll
        for (int k = 0; k < 2; ++k) { const float a2r = aLr[k] * aLr[k] - aLi[k] * aLi[k], a2i = 2.0f * aLr[k] * aLi[k], a4r = a2r * a2r - a2i * a2i, a4i = 2.0f * a2r * a2i;
            const float a5r = a4r * aLr[k] - a4i * aLi[k], a5i = a4r * aLi[k] + a4i * aLr[k];
            float xr = S[2 * k][0], xi = S[2 * k + 1][0];
#pragma unroll
            for (int reg = 1; reg < 16; ++reg) { const float mr = ((reg & 3) == 0) ? a5r : aLr[k], mi = ((reg & 3) == 0) ? a5i : aLi[k];
                const float nr = mr * xr - mi * xi + S[2 * k][reg], ni = mr * xi + mi * xr + S[2 * k + 1][reg]; xr = nr; xi = ni; }
            const float fr_ = hi ? xr : (a4r * xr - a4i * xi), fi_ = hi ? xi : (a4r * xi + a4i * xr);
            e_r[k] = fr_ + __shfl_xor(fr_, 32); e_i[k] = fi_ + __shfl_xor(fi_, 32); }
        if (hi == 0) { float* eb = Ebuf + ((size_t)(b * NGRP + g) * 16 + seg) * 128;
#pragma unroll
            for (int k = 0; k < 2; ++k) *(GAS f32x2*)(eb + 2 * (32 * k + r32)) = (f32x2){e_r[k], e_i[k]}; }
    } else {
        LAS unsigned char* XS = L + S5_XS + b * S5_XS_BYTES;
#pragma unroll
        for (int i = 0; i < 8; ++i) { const bool own = ((i & 1) == hi);
            if (own) {
#pragma unroll
                for (int q = 0; q < 4; ++q) { const int reg = 4 * (i >> 1) + q, chunk = 4 * i + q;
#pragma unroll
                    for (int k = 0; k < 2; ++k) { *(LAS unsigned*)(XS + chunk * S5_PITCH + 4 * (32 * k + r32)) = pg8::cvt_pk_bf16(cr[k], ci[k]);
                        const float nr = aLr[k] * cr[k] - aLi[k] * ci[k] + S[2 * k][reg], ni = aLr[k] * ci[k] + aLi[k] * cr[k] + S[2 * k + 1][reg]; cr[k] = nr; ci[k] = ni; } } }
#pragma unroll
            for (int k = 0; k < 2; ++k) { const float orr = __shfl_xor(cr[k], 32), oi = __shfl_xor(ci[k], 32); cr[k] = own ? cr[k] : orr; ci[k] = own ? ci[k] : oi; } }
        s5_bf16x8 Xf[8];
#pragma unroll
        for (int kk = 0; kk < 8; ++kk) Xf[kk] = *(const LAS s5_bf16x8*)(XS + r32 * S5_PITCH + (16 * kk + 8 * hi) * 2);
        s5_f32x16 Yc[4];
#pragma unroll
        for (int j = 0; j < 4; ++j) { Yc[j] = s5_f32x16{};
#pragma unroll
            for (int s = 0; s < 8; ++s) if (s <= 2 * j + 1) { const int d1 = 2 * j + (r32 >> 4) - s + 1;
                const s5_bf16x8 bf = *(const LAS s5_bf16x8*)(L + S5_KT + d1 * 512 + (r32 & 15) * 32 + 16 * hi);
                Yc[j] = __builtin_amdgcn_mfma_f32_32x32x16_bf16(A[s], bf, Yc[j], 0, 0, 0); }
#pragma unroll
            for (int kk = 0; kk < 8; ++kk) { const s5_bf16x8 bf = *(const LAS s5_bf16x8*)(L + S5_WYC + (32 * j + r32) * S5_PITCH + (16 * kk + 8 * hi) * 2);
                Yc[j] = __builtin_amdgcn_mfma_f32_32x32x16_bf16(Xf[kk], bf, Yc[j], 0, 0, 0); } }
        asm volatile("s_waitcnt lgkmcnt(0)" ::: "memory");
#pragma unroll
        for (int j = 0; j < 4; ++j)
#pragma unroll
            for (int reg = 0; reg < 16; reg += 2) { const pg8::f32x2 ge = pg8::gelu_pk((pg8::f32x2){Yc[j][reg], Yc[j][reg + 1]});
                const int chunk = (reg & 3) + 8 * (reg >> 2) + 4 * hi, tokl = 8 * chunk + 2 * j + (r32 >> 4), c = r32 & 15;
                const unsigned gw_ = pg8::cvt_pk_bf16(ge.x, ge.y); *(LAS bf16*)(XS + tokl * 32 + c * 2) = (bf16)(gw_ & 0xffffu); *(LAS bf16*)(XS + (tokl + 8) * 32 + c * 2) = (bf16)(gw_ >> 16); }
        asm volatile("s_waitcnt lgkmcnt(0)" ::: "memory");
        bf16* yo = Yg + tok0 * 16;
#pragma unroll
        for (int i = 0; i < 8; ++i) { const int pc = lane + 64 * i; const v4u w = *(const LAS v4u*)(XS + 16 * pc); *(GAS v4u*)(yo + 8 * pc) = w; }
    }
    __syncthreads();
}

#ifndef MK_ONE_LAUNCH
#define MK_ONE_LAUNCH 1
#endif
constexpr int N_PHASES = 14;
struct Args { const float* in[23]; float* out; unsigned char* ws; int ph_lo, ph_hi; };

#ifndef PROBE_P0
#define PROBE_P0 0
#endif
#define P0_ITEM(it) do { \
            int r = it; \
            if (r < I_TKT) { s5_tab_kt(r >> 3, r & 7, S5TAB + (size_t)(r >> 3) * S5_TAB_BYTES, args.in[6], args.in[7], args.in[8], args.in[9], args.in[10], args.in[11], args.in[12], args.in[13], lane); break; } r -= I_TKT; \
            if (r < I_TST) { s5_tab_wst(r >> 2, r & 3, S5TAB + (size_t)(r >> 2) * S5_TAB_BYTES, args.in[6], args.in[7], args.in[8], args.in[9], args.in[10], lane); break; } r -= I_TST; \
            if (r < I_TYC) { s5_tab_wyc(r >> 3, r & 7, S5TAB + (size_t)(r >> 3) * S5_TAB_BYTES, args.in[6], args.in[7], args.in[8], args.in[11], args.in[12], lane); break; } r -= I_TYC; \
            if (r < I_TCO) { s5_tab_const(r, S5C, args.in[6], args.in[7], args.in[8], lane); break; } r -= I_TCO; \
            if (r < I_SQ) { p0_matrix_item(args.in[5], 1024, 1024, WIN0, mixg, 0, r, scr, lane); break; } r -= I_SQ; \
            if (r < I_GLU) { p0_matrix_item(args.in[14], 768, 768, WGLU, nullptr, 0, r, scr, lane); break; } r -= I_GLU; \
            if (r < I_IN1) { p0_matrix_item(args.in[16], 1024, 2560, WIN1, mixg + 1024, 0, r, scr, lane); break; } r -= I_IN1; \
            if (r < I_SQ) { p0_matrix_item(args.in[17], 1024, 1024, WOUT0, nullptr, 0, r, scr, lane); break; } r -= I_SQ; \
            if (r < I_SQ) { p0_matrix_item(args.in[17] + 1024 * 1024, 1024, 1024, WOUT1, nullptr, 0, r, scr, lane); break; } r -= I_SQ; \
            if (r < I_GU) { p0_matrix_item(args.in[19], 1024, FFN, WGU0, ffng, 1, r, scr, lane); break; } r -= I_GU; \
            if (r < I_GU) { p0_matrix_item(args.in[20], 1024, FFN, WGU0, ffng, 2, r, scr, lane); break; } r -= I_GU; \
            if (r < I_GU) { p0_matrix_item(args.in[19] + (size_t)1024 * FFN, 1024, FFN, WGU1, ffng + 1024, 1, r, scr, lane); break; } r -= I_GU; \
            if (r < I_GU) { p0_matrix_item(args.in[20] + (size_t)1024 * FFN, 1024, FFN, WGU1, ffng + 1024, 2, r, scr, lane); break; } r -= I_GU; \
            if (r < I_DN) { p0_matrix_item(args.in[21], FFN, 1024, WDN0, nullptr, 0, r, scr, lane); break; } r -= I_DN; \
            if (r < I_DN) { p0_matrix_item(args.in[21] + (size_t)FFN * 1024, FFN, 1024, WDN1, nullptr, 0, r, scr, lane); break; } r -= I_DN; \
            p0_matrix_item(args.in[3], 1024, 512, WMKV, args.in[2], 0, r, scr, lane); \
        } while (0)
__global__ void __launch_bounds__(NWAVES * 64, 2) mega_fwd(Args args) {
    extern __shared__ __attribute__((aligned(16))) unsigned char lds[];
    LAS unsigned char* L = (LAS unsigned char*)lds;
    volatile LAS unsigned* MISC = (volatile LAS unsigned*)(L + MISC_OFF);
    const int tid = threadIdx.x, lane = tid & 63, wave = __builtin_amdgcn_readfirstlane(tid >> 6);
    const int G = gridDim.x; const int bx = blockIdx.x;
    const int vcu = (G % 8 == 0) ? (bx % 8) * (G / 8) + bx / 8 : bx;
    const int gw = vcu * NWAVES + wave, NGW = G * NWAVES;
    unsigned char* ws = args.ws;
    gu32* ctl = (gu32*)(ws + WS_CTL);
    for (int u = tid; u < (LDS_BYTES - LDSCTL_OFF) / 4; u += NWAVES * 64) ((LAS unsigned*)(L + LDSCTL_OFF))[u] = 0u;
    __syncthreads();
    XcdBarrier bar; bar.bar = (unsigned*)(ctl + CW_BAR); bar.x = 0; bar.st = nullptr;
    if (MK_ONE_LAUNCH) bar = xcd_barrier_post((unsigned*)(ctl + CW_BAR), MISC + 8);
#define MEMATTN_PHASE(u0_, us_) do { for (int un = (u0_); un < BATCH * MHEAD * NBLK; un += (us_)) { const int b_ = un >> 6, h_ = (un >> 4) & 3, qb_ = un & 15; const size_t qrow_ = (size_t)b_ * SEQ + (size_t)qb_ * 256; \
        attn_body::attn_unit<0, 8, 256, 256, 1024>((const attn_body::bf16*)(QM + qrow_ * 256 + h_ * 64), (const attn_body::bf16*)(MEMK + (size_t)b_ * MEML * 256 + h_ * 64), (const attn_body::bf16*)(MEMV + (size_t)b_ * MEML * 256 + h_ * 64), \
            (attn_body::bf16*)(MIX + qrow_ * 1024 + 768 + h_ * 64), 4, 0.f, nullptr, nullptr, 0, (char*)lds + RING_OFF); } } while (0)
    const int lo = args.ph_lo, hi = args.ph_hi;
#ifndef PROBE_DUP
#define PROBE_DUP -1
#endif
#define IN(k) (lo <= (k) && (k) < hi)
#define PH_REP(k) for (int rep_ = 0; rep_ < ((PROBE_DUP == (k)) ? 2 : 1); ++rep_)
#define SEAM(k) do { if (IN(k) && IN((k) + 1)) xcd_barrier(bar); } while (0)

    const float* x = args.in[0]; const float* mem = args.in[1];
    float* out = args.out;
    float* SS0 = (float*)(ws + WS_SS0); float* SSA = (float*)(ws + WS_SSA); float* SSB = (float*)(ws + WS_SSB); float* SSM = (float*)(ws + WS_SSM);
    unsigned char* S5TAB = ws + WS_S5TAB; float* S5E = (float*)(ws + WS_S5E); float* S5C = (float*)(ws + WS_S5TAB + (size_t)NGRP * S5_TAB_BYTES);
    float* KMP = (float*)(ws + WS_KMEAN);
    bf16* WIN0 = (bf16*)(ws + WS_WIN0); bf16* WGLU = (bf16*)(ws + WS_WGLU); bf16* WIN1 = (bf16*)(ws + WS_WIN1);
    bf16* WOUT0 = (bf16*)(ws + WS_WOUT0); bf16* WOUT1 = (bf16*)(ws + WS_WOUT1);
    bf16* WGU0 = (bf16*)(ws + WS_WGU0); bf16* WGU1 = (bf16*)(ws + WS_WGU1); bf16* WDN0 = (bf16*)(ws + WS_WDN0); bf16* WDN1 = (bf16*)(ws + WS_WDN1); bf16* WMKV = (bf16*)(ws + WS_WMKV);
    bf16* MEMB = (bf16*)(ws + WS_MEMB); bf16* MEMK = (bf16*)(ws + WS_MEMK); bf16* MEMV = (bf16*)(ws + WS_MEMV);
    bf16* XB = (bf16*)(ws + WS_XB); bf16* Ub = (bf16*)(ws + WS_U); bf16* Yb = (bf16*)(ws + WS_Y);
    bf16* Q1 = (bf16*)(ws + WS_Q1); bf16* K1 = (bf16*)(ws + WS_K1); bf16* V1 = (bf16*)(ws + WS_V1);
    bf16* QM = (bf16*)(ws + WS_QM); bf16* MIX = (bf16*)(ws + WS_MIX); bf16* Hb = (bf16*)(ws + WS_H);

    if (IN(0)) PH_REP(0) {
        if (rep_) xcd_barrier(bar);
        LAS float* scr = (LAS float*)(L + RING_OFF + wave * 16384);
        constexpr int I_SQ = 16 * 32, I_GLU = 12 * 24, I_IN1 = 16 * 80, I_GU = 16 * 88, I_DN = 44 * 32, I_MKV = 16 * 16;
        constexpr int I_TKT = NGRP * 8, I_TST = NGRP * 4, I_TYC = NGRP * 8, I_TCO = NGRP;
        constexpr int NITEMS = I_TKT + I_TST + I_TYC + I_TCO + I_SQ + I_GLU + I_IN1 + 2 * I_SQ + 4 * I_GU + 2 * I_DN + I_MKV;
        const float* mixg = args.in[4]; const float* ffng = args.in[18];
        for (int it = gw; it < NITEMS; it += NGW) P0_ITEM(it);
        for (int m = 4 * gw; m < TOK; m += 4 * NGW) rows_to_bf16_ssq<4>(x + (size_t)m * DM, XB + (size_t)m * DM, SS0 + (size_t)m * 16, lane);
        for (int m = gw; m < BATCH * MEML; m += NGW) rows_to_bf16_ssq<1>(mem + (size_t)m * DM, MEMB + (size_t)m * DM, SSM + (size_t)m * 16, lane);
#if PROBE_P0 == 1
        for (int it = gw; it < I_TKT + I_TST + I_TYC + I_TCO; it += NGW) P0_ITEM(it);
#elif PROBE_P0 == 2
        for (int it = I_TKT + I_TST + I_TYC + I_TCO + gw; it < NITEMS; it += NGW) P0_ITEM(it);
#elif PROBE_P0 == 3
        for (int m = 4 * gw; m < TOK; m += 4 * NGW) rows_to_bf16_ssq<4>(x + (size_t)m * DM, XB + (size_t)m * DM, SS0 + (size_t)m * 16, lane);
        for (int m = gw; m < BATCH * MEML; m += NGW) rows_to_bf16_ssq<1>(mem + (size_t)m * DM, MEMB + (size_t)m * DM, SSM + (size_t)m * 16, lane);
#endif
    }
    SEAM(0);
    if (IN(1)) PH_REP(1) {
        if (rep_) xcd_barrier(bar);
        { pg8::Gemm g{XB, WIN0, TOK, 1024, 1024, 0}; pg8::StaticOrder S; S.init(TOK, 1024, G, bx);
          pg8::EpiProj E{SS0, Ub, 0, 3, 1, TOKW, 1.0f, QM, C2, TOK, nullptr, -1};
          pg8::gemm_phase<pg8::EpiProj, pg8::StaticOrder, true, true>(L + RING_OFF, g, S, E); }
    }
    SEAM(1);
    if (IN(2)) PH_REP(2) {
        if (rep_) xcd_barrier(bar);
        const int nS5 = (G == 256) ? 240 : G;
        if (bx < nS5) { for (int un = bx; un < NGRP * 16; un += nS5) s5_unit<false>(un >> 4, un & 15, Ub, Yb, S5TAB + (size_t)(un >> 4) * S5_TAB_BYTES, S5E, S5C, L + RING_OFF); }
        if (G != 256 || bx >= nS5) { pg8::Gemm g{MEMB, WMKV, BATCH * MEML, 512, 1024, 0}; pg8::StaticOrder S; S.init(BATCH * MEML, 512, (G == 256) ? 16 : G, (G == 256) ? bx - nS5 : bx);
          pg8::EpiProj E{SSM, MEMK, (size_t)(WS_MEMV - WS_MEMK) / 2, 1, 2, 256, 1.0f, nullptr, 1.0f, 0, nullptr, -1};
          pg8::gemm_phase<pg8::EpiProj, pg8::StaticOrder, true, true>(L + RING_OFF, g, S, E); }
    }
    SEAM(2);
    if (IN(3)) PH_REP(3) {
        if (rep_) xcd_barrier(bar);
        for (int un = vcu; un < NGRP * 16; un += G) s5_unit<true>(un >> 4, un & 15, Ub, Yb, S5TAB + (size_t)(un >> 4) * S5_TAB_BYTES, S5E, S5C, L + RING_OFF);
    }
    SEAM(3);
    if (IN(4)) PH_REP(4) {
        if (rep_) xcd_barrier(bar);
        pg8::Gemm g{Yb, WGLU, TOK, TOKW, TOKW, 1}; pg8::StaticOrder S; S.init(TOK, TOKW, G, bx);
        pg8::EpiGlu E{Yb, TOKW, args.in[15], MIX, 1024, TOK};
        pg8::gemm_phase<pg8::EpiGlu, pg8::StaticOrder, true, true>(L + RING_OFF, g, S, E);
        if (G == 256) { if (bx >= 128) MEMATTN_PHASE(bx - 128, 128); }
        else MEMATTN_PHASE(vcu, G);
    }
    SEAM(4);
    if (IN(5)) PH_REP(5) {
        if (rep_) xcd_barrier(bar);
        pg8::Gemm g{MIX, WOUT0, TOK, 1024, 1024, 0}; pg8::StaticOrder S; S.init(TOK, 1024, G, bx);
        pg8::EpiRes E{x, nullptr, XB, SSA};
        pg8::gemm_phase<pg8::EpiRes, pg8::StaticOrder, true, true>(L + RING_OFF, g, S, E);
    }
    SEAM(5);
    if (IN(6)) PH_REP(6) {
        if (rep_) xcd_barrier(bar);
        pg8::Gemm g{XB, WGU0, TOK, 2 * FFN, 1024, 0}; pg8::StaticOrder S; S.init(TOK, 2 * FFN, G, bx);
        pg8::EpiGU E{SSA, Hb, FFN};
        pg8::gemm_phase<pg8::EpiGU, pg8::StaticOrder, true, true>(L + RING_OFF, g, S, E);
    }
    SEAM(6);
    if (IN(7)) PH_REP(7) {
        if (rep_) xcd_barrier(bar);
        pg8::Gemm g{Hb, WDN0, TOK, 1024, FFN, 0}; pg8::StaticOrder S; S.init(TOK, 1024, G, bx);
        pg8::EpiRes E{nullptr, XB, XB, SSB};
        pg8::gemm_phase<pg8::EpiRes, pg8::StaticOrder, true, true>(L + RING_OFF, g, S, E);
    }
    SEAM(7);
    if (IN(8)) PH_REP(8) {
        if (rep_) xcd_barrier(bar);
        pg8::Gemm g{XB, WIN1, TOK, 2560, 1024, 0}; pg8::StaticOrder S; S.init(TOK, 2560, G, bx);
        pg8::EpiProj E{SSB, Q1, (size_t)(WS_K1 - WS_Q1) / 2, 3, 3, TOKW, C2, QM, C2, 0, KMP, 1};
        pg8::gemm_phase<pg8::EpiProj, pg8::StaticOrder, true, true>(L + RING_OFF, g, S, E);
    }
    SEAM(8);
    if (IN(9)) PH_REP(9) {
        if (rep_) xcd_barrier(bar);
        for (int p_ = vcu; p_ < BATCH * NHEAD * 8; p_ += G) { const int bh_ = p_ >> 3, sg_ = p_ & 7, b_ = bh_ / NHEAD, h_ = bh_ - b_ * NHEAD;
            const float slope2 = __builtin_amdgcn_exp2f(-8.0f * (float)(h_ + 1) / 12.0f) * LOG2E;
#pragma unroll 1
            for (int k_ = 0; k_ < 2; ++k_) { const int qb_ = k_ ? 15 - sg_ : sg_; const size_t qrow_ = (size_t)b_ * SEQ + (size_t)qb_ * 256, krow_ = (size_t)b_ * SEQ;
                attn_body::attn_unit<1, 8, 768, 768, 1024>((const attn_body::bf16*)(Q1 + qrow_ * TOKW + h_ * 64), (const attn_body::bf16*)(K1 + krow_ * TOKW + h_ * 64), (const attn_body::bf16*)(V1 + krow_ * TOKW + h_ * 64),
                    (attn_body::bf16*)(MIX + qrow_ * 1024 + h_ * 64), 4 * qb_ + 4, slope2, KMP + (size_t)bh_ * 1024, KMP + (size_t)(8 * 12 * 16 * 64) + (size_t)bh_ * 1024, qb_, (char*)lds + RING_OFF); } }
        MEMATTN_PHASE(vcu, G);
    }
    SEAM(9);
    if (IN(10)) PH_REP(10) {
        if (rep_) xcd_barrier(bar);
        pg8::Gemm g{MIX, WOUT1, TOK, 1024, 1024, 0}; pg8::StaticOrder S; S.init(TOK, 1024, G, bx);
        pg8::EpiRes E{nullptr, XB, XB, SSA};
        pg8::gemm_phase<pg8::EpiRes, pg8::StaticOrder, true, true>(L + RING_OFF, g, S, E);
    }
    SEAM(10);
    if (IN(11)) PH_REP(11) {
        if (rep_) xcd_barrier(bar);
        pg8::Gemm g{XB, WGU1, TOK, 2 * FFN, 1024, 0}; pg8::StaticOrder S; S.init(TOK, 2 * FFN, G, bx);
        pg8::EpiGU E{SSA, Hb, FFN};
        pg8::gemm_phase<pg8::EpiGU, pg8::StaticOrder, true, true>(L + RING_OFF, g, S, E);
    }
    SEAM(11);
    if (IN(12)) PH_REP(12) {
        if (rep_) xcd_barrier(bar);
        pg8::Gemm g{Hb, WDN1, TOK, 1024, FFN, 0}; pg8::StaticOrder S; S.init(TOK, 1024, G, bx);
        pg8::EpiRes E{nullptr, XB, XB, SSB};
        pg8::gemm_phase<pg8::EpiRes, pg8::StaticOrder, true, true>(L + RING_OFF, g, S, E);
    }
    SEAM(12);
    if (IN(13)) PH_REP(13) {
        if (rep_) xcd_barrier(bar);
        const float* gf = args.in[22];
        const GAS f32x4* gp = (const GAS f32x4*)gf + 4 * lane; const f32x4 g0 = gp[0], g1 = gp[1], g2 = gp[2], g3 = gp[3];
        for (int m0 = 4 * gw; m0 < TOK; m0 += 4 * NGW) {
            v4u q[4][2]; f32x4 sq[4];
#pragma unroll
            for (int r = 0; r < 4; ++r) { const GAS v4u* xr = (const GAS v4u*)(XB + (size_t)(m0 + r) * DM) + 2 * lane; q[r][0] = xr[0]; q[r][1] = xr[1];
                sq[r] = *(const GAS f32x4*)(SSB + (size_t)(m0 + r) * 16 + 4 * (lane & 3)); }
#pragma unroll
            for (int r = 0; r < 4; ++r) { float s = (sq[r].x + sq[r].y) + (sq[r].z + sq[r].w); s += __shfl_xor(s, 1); s += __shfl_xor(s, 2);
                const float rs = __builtin_amdgcn_rsqf(s * (1.0f / 1024.0f) + 1e-6f);
                GAS f32x4* orow = (GAS f32x4*)(out + (size_t)(m0 + r) * DM) + 4 * lane; const v4u q0 = q[r][0], q1 = q[r][1];
                orow[0] = (f32x4){bflo(q0.x), bfhi(q0.x), bflo(q0.y), bfhi(q0.y)} * rs * g0; orow[1] = (f32x4){bflo(q0.z), bfhi(q0.z), bflo(q0.w), bfhi(q0.w)} * rs * g1;
                orow[2] = (f32x4){bflo(q1.x), bfhi(q1.x), bflo(q1.y), bfhi(q1.y)} * rs * g2; orow[3] = (f32x4){bflo(q1.z), bfhi(q1.z), bflo(q1.w), bfhi(q1.w)} * rs * g3; }
        }
    }
#undef IN
#undef SEAM
}

extern "C" void kernel_launch(void* const* d_in, const int* in_sizes, int n_in, void* d_out, int out_size, void* d_ws, size_t ws_size, hipStream_t stream) {
    static int grid = 0;
    if (grid == 0) {
        if (n_in != 23 || out_size != TOK * DM || ws_size < WS_END) { fprintf(stderr, "kernel_launch: unexpected shapes: n_in %d out %d ws %zu\n", n_in, out_size, ws_size); grid = -1; return; }
        int dev = 0, cus = 0, per_cu = 0;
        if (hipGetDevice(&dev) != hipSuccess || hipDeviceGetAttribute(&cus, hipDeviceAttributeMultiprocessorCount, dev) != hipSuccess) { grid = -1; return; }
        if (hipFuncSetAttribute((const void*)mega_fwd, hipFuncAttributeMaxDynamicSharedMemorySize, LDS_BYTES) != hipSuccess) { fprintf(stderr, "kernel_launch: hipFuncSetAttribute failed\n"); grid = -1; return; }
        if (hipOccupancyMaxActiveBlocksPerMultiprocessor(&per_cu, (const void*)mega_fwd, NWAVES * 64, LDS_BYTES) != hipSuccess || per_cu < 1)
            fprintf(stderr, "kernel_launch: occupancy query reports %d workgroups per CU\n", per_cu);
        (void)hipGetLastError();
        grid = cus;
    }
    if (grid < 0) return;
    if (hipMemsetAsync((char*)d_ws + WS_CTL, 0, CTL_ZERO_BYTES, stream) != hipSuccess) return;
    Args a{};
    for (int i = 0; i < 23; ++i) a.in[i] = (const float*)d_in[i];
    a.out = (float*)d_out; a.ws = (unsigned char*)d_ws;
#if MK_ONE_LAUNCH
    a.ph_lo = 0; a.ph_hi = N_PHASES;
    hipLaunchKernelGGL(mega_fwd, dim3(grid), dim3(NWAVES * 64), LDS_BYTES, stream, a);
#else
    for (int p = 0; p < N_PHASES; ++p) { a.ph_lo = p; a.ph_hi = p + 1; hipLaunchKernelGGL(mega_fwd, dim3(grid), dim3(NWAVES * 64), LDS_BYTES, stream, a); }
#endif
}
```

```cpp
#include <hip/hip_runtime.h>
#include <hip/hip_bf16.h>
#include <cstdio>
#include <cstdint>
#include <cmath>
namespace pg8 {
#define PG8_LAS __attribute__((address_space(3)))
typedef unsigned short bf16_t;
typedef short bf16x8 __attribute__((ext_vector_type(8)));
typedef float f32x4 __attribute__((ext_vector_type(4)));
typedef unsigned u32x4 __attribute__((ext_vector_type(4)));
constexpr int BM = 256, BK = 64, HALF = 128, HTB = HALF * BK * 2  , STAGE_BYTES = 8 * HTB, NXCD = 8, WGM = 8;

__host__ __device__ __forceinline__ int lds_byte(int r, int c) { const int st = (r >> 4) * 2 + (c >> 5), rr = r & 15, cc = c & 31, ob = rr * 64 + cc * 2; return st * 1024 + (ob ^ (((ob >> 9) & 1) << 5)); }
__host__ __device__ __forceinline__ void stage_rc(int b, int& R, int& C) { const int st = b / 1024, sb = b % 1024, swz = sb ^ (((sb >> 9) & 1) << 5); R = (st >> 1) * 16 + swz / 64; C = (st & 1) * 32 + (swz % 64) / 2; }
__host__ __device__ __forceinline__ int perm32(int rho) { const int n = rho >> 4, i = rho & 15; return 8 * (i >> 2) + 4 * n + (i & 3); }

struct Unit { int pm, pn; };
struct Gemm { const bf16_t* A; const bf16_t* Bt; int M, N, K, amode; };

struct StaticOrder {
    int nM, nN, nwg, G, c;
    __host__ __device__ void init(int M, int N, int G_, int c_) { nM = M / BM; nN = N / BM; nwg = nM * nN; G = G_; c = c_; }
    __host__ __device__ bool next(int i, Unit& u) const {
        const long L = (long)i * G + c; if (L >= nwg) return false;
        int wgid = (int)L; { const int q = nwg / NXCD, r = nwg % NXCD, xcd = wgid % NXCD, off = wgid / NXCD; wgid = (xcd < r ? xcd * (q + 1) : r * (q + 1) + (xcd - r) * q) + off; }
        const int nig = WGM * nN, gid = wgid / nig, fm = gid * WGM, gsz = (nM - fm) < WGM ? (nM - fm) : WGM;
        u.pm = fm + ((wgid % nig) % gsz); u.pn = (wgid % nig) / gsz; return true;
    }
    __device__ __forceinline__ void a_ready(const Unit&) const {}
    __device__ __forceinline__ void done(const Unit&) const {}
};

__device__ __forceinline__ unsigned cvt_pk_bf16(float lo, float hi) { unsigned r; asm volatile("v_cvt_pk_bf16_f32 %0, %1, %2" : "=v"(r) : "v"(lo), "v"(hi)); return r; }
typedef float f32x2 __attribute__((ext_vector_type(2)));
typedef unsigned u32x2 __attribute__((ext_vector_type(2)));
constexpr float RMS_EPS = 1e-6f;
__device__ __forceinline__ float row_rstd(const float* ssq, int row) {
    const f32x4* p = (const f32x4*)(ssq + (size_t)row * 16);
    const f32x4 a = p[0], b = p[1], c = p[2], d = p[3];
    const float s = (((a[0] + a[1]) + (a[2] + a[3])) + ((b[0] + b[1]) + (b[2] + b[3]))) + (((c[0] + c[1]) + (c[2] + c[3])) + ((d[0] + d[1]) + (d[2] + d[3])));
    return __builtin_amdgcn_rsqf(s * (1.0f / 1024.0f) + RMS_EPS);
}
__device__ __forceinline__ float bf2f(unsigned short h) { return __uint_as_float(((unsigned)h) << 16); }
__device__ __forceinline__ float bflo(unsigned w) { return __uint_as_float(w << 16); }
__device__ __forceinline__ float bfhi(unsigned w) { return __uint_as_float(w & 0xffff0000u); }

__device__ __forceinline__ f32x2 gelu_pk(f32x2 v) {
    const f32x2 av = __builtin_elementwise_abs(v), d = av * 0.2316418882f + 1.0f;
    f32x2 t; t.x = __builtin_amdgcn_rcpf(d.x); t.y = __builtin_amdgcn_rcpf(d.y);
    f32x2 q = t * 0.5307027145f + (-0.7265760135f); q = q * t + 0.7107068705f; q = q * t + (-0.142248368f); q = q * t + 0.127414796f; q = q * t;
    const f32x2 s = (v * v) * (-0.72134752044f);
    f32x2 e; e.x = __builtin_amdgcn_exp2f(s.x); e.y = __builtin_amdgcn_exp2f(s.y);
    const f32x2 m = v * (q * e), r = v - m;
    f32x2 o; o.x = v.x < 0.f ? m.x : r.x; o.y = v.y < 0.f ? m.y : r.y; return o;
}

__device__ __forceinline__ void row_rstd4x8(const float* ssq, int row0, int fq, float sc, float (&rs)[2][4]) {
    f32x4 a[2][4];
#pragma unroll
    for (int ai = 0; ai < 2; ++ai)
#pragma unroll
        for (int m = 0; m < 4; ++m) a[ai][m] = *(const __attribute__((address_space(1))) f32x4*)(ssq + (size_t)(row0 + ai * HALF + m * 16) * 16 + 4 * fq);
#pragma unroll
    for (int ai = 0; ai < 2; ++ai)
#pragma unroll
        for (int m = 0; m < 4; ++m) { float s = (a[ai][m][0] + a[ai][m][1]) + (a[ai][m][2] + a[ai][m][3]); s += __shfl_xor(s, 16); s += __shfl_xor(s, 32);
            rs[ai][m] = __builtin_amdgcn_rsqf(s * (1.0f / 1024.0f) + RMS_EPS) * sc; }
}
struct EpiProj {
    static constexpr bool PERM = true, AFTER_DRAIN = false;
    const float* ssq; bf16_t* base; size_t seg_stride; int tps, nseg, ldc; float scale0; bf16_t* qm; float scale_qm; int gm_rows;
    float* kmp; int kseg;
    __device__ __forceinline__ void operator()(const f32x4 (&acc)[2][2][4][2], const Unit& u, int wr, int wc, int fr, int fq) const {
        const int seg = u.pn / tps, within = u.pn - seg * tps;
        bf16_t* o; int ld, colt; float sc;
        if (seg < nseg) { o = base + (size_t)seg * seg_stride; ld = ldc; colt = within * BM; sc = (seg == 0) ? scale0 : 1.0f; }
        else { o = qm; ld = 256; colt = 0; sc = scale_qm; }
        const int row0 = u.pm * BM + wr * 64 + fr, col0 = colt + wc * 32 + 8 * fq;
        f32x4 cs[2][2] = {{{0.f, 0.f, 0.f, 0.f}, {0.f, 0.f, 0.f, 0.f}}, {{0.f, 0.f, 0.f, 0.f}, {0.f, 0.f, 0.f, 0.f}}};
        float rsv[2][4]; row_rstd4x8(ssq, row0, fq, sc, rsv);
#pragma unroll
        for (int ai = 0; ai < 2; ++ai)
#pragma unroll
            for (int m = 0; m < 4; ++m) { const int row = row0 + ai * HALF + m * 16; const float rs = rsv[ai][m]; bf16_t* rowp = o + (size_t)row * ld + col0;
                const bool gm = (gm_rows != 0) && (seg < nseg);
#pragma unroll
                for (int bj = 0; bj < 2; ++bj) { const f32x4 v0 = acc[ai][bj][m][0] * rs, v1 = acc[ai][bj][m][1] * rs;
                    u32x4 w; w.x = cvt_pk_bf16(v0[0], v0[1]); w.y = cvt_pk_bf16(v0[2], v0[3]); w.z = cvt_pk_bf16(v1[0], v1[1]); w.w = cvt_pk_bf16(v1[2], v1[3]);
                    const int cc = col0 + bj * HALF;
                    bf16_t* dst = gm ? (o + ((size_t)(cc >> 4) * gm_rows + row) * 16 + (cc & 15)) : (rowp + bj * HALF);
                    *(u32x4*)dst = w; cs[bj][0] += v0; cs[bj][1] += v1; } }
        if (seg == kseg) {
#pragma unroll
            for (int bj = 0; bj < 2; ++bj)
#pragma unroll
                for (int n = 0; n < 2; ++n)
#pragma unroll
                    for (int e = 0; e < 4; ++e) { float s = cs[bj][n][e]; s += __shfl_xor(s, 1); s += __shfl_xor(s, 2); s += __shfl_xor(s, 4); s += __shfl_xor(s, 8); cs[bj][n][e] = s; }
            if (fr == 0) { const int bb = u.pm >> 4, blk = u.pm & 15;
#pragma unroll
                for (int bj = 0; bj < 2; ++bj) { const int cc = col0 + bj * HALF, h = cc >> 6, d = cc & 63;
                    float* kd = kmp + (size_t)wr * (8 * 12 * 16 * 64) + ((size_t)((bb * 12 + h) * 16 + blk)) * 64 + d;
                    *(__attribute__((address_space(1))) f32x4*)kd = cs[bj][0]; *(__attribute__((address_space(1))) f32x4*)(kd + 4) = cs[bj][1]; } }
        }
    }
};
struct EpiGlu {
    static constexpr bool PERM = true, AFTER_DRAIN = false;
    const bf16_t* Y; int ldy; const float* bias; bf16_t* mix; int ldm; int ygm_rows;
    __device__ __forceinline__ void operator()(const f32x4 (&acc)[2][2][4][2], const Unit& u, int wr, int wc, int fr, int fq) const {
        const int row0 = u.pm * BM + wr * 64 + fr, col0 = u.pn * BM + wc * 32 + 8 * fq;
        f32x4 bv[2][2];
#pragma unroll
        for (int bj = 0; bj < 2; ++bj)
#pragma unroll
            for (int n = 0; n < 2; ++n) bv[bj][n] = *(const f32x4*)(bias + col0 + bj * HALF + 4 * n);
#pragma unroll
        for (int ai = 0; ai < 2; ++ai) {
            u32x4 yq[4][2];
#pragma unroll
            for (int m = 0; m < 4; ++m) { const int row = row0 + ai * HALF + m * 16;
#pragma unroll
                for (int bj = 0; bj < 2; ++bj) { const int cc = col0 + bj * HALF;
                    yq[m][bj] = ygm_rows ? *(const __attribute__((address_space(1))) u32x4*)(Y + ((size_t)(cc >> 4) * ygm_rows + row) * 16 + (cc & 15)) : *(const __attribute__((address_space(1))) u32x4*)(Y + (size_t)row * ldy + cc); } }
#pragma unroll
            for (int m = 0; m < 4; ++m) { const int row = row0 + ai * HALF + m * 16;
#pragma unroll
                for (int bj = 0; bj < 2; ++bj) { const u32x4 yw = yq[m][bj];
                    const f32x4 z0 = acc[ai][bj][m][0] + bv[bj][0], z1 = acc[ai][bj][m][1] + bv[bj][1];
                    float t[8]; const float yv[8] = {bflo(yw.x), bfhi(yw.x), bflo(yw.y), bfhi(yw.y), bflo(yw.z), bfhi(yw.z), bflo(yw.w), bfhi(yw.w)};
#pragma unroll
                    for (int e = 0; e < 4; ++e) { t[e] = yv[e] * __builtin_amdgcn_rcpf(1.0f + __builtin_amdgcn_exp2f(-1.4426950408889634f * z0[e])); t[4 + e] = yv[4 + e] * __builtin_amdgcn_rcpf(1.0f + __builtin_amdgcn_exp2f(-1.4426950408889634f * z1[e])); }
                    u32x4 w; w.x = cvt_pk_bf16(t[0], t[1]); w.y = cvt_pk_bf16(t[2], t[3]); w.z = cvt_pk_bf16(t[4], t[5]); w.w = cvt_pk_bf16(t[6], t[7]);
                    *(u32x4*)(mix + (size_t)row * ldm + col0 + bj * HALF) = w; } } }
    }
};
struct EpiRes {
    static constexpr bool PERM = true, AFTER_DRAIN = false;
    const float* basef; const bf16_t* baseb; bf16_t* xb; float* ssq_out;
    __device__ __forceinline__ void operator()(const f32x4 (&acc)[2][2][4][2], const Unit& u, int wr, int wc, int fr, int fq) const {
        const int row0 = u.pm * BM + wr * 64 + fr, col0 = u.pn * BM + wc * 32 + 8 * fq;
        typedef __attribute__((address_space(1))) const f32x4 gf4; typedef __attribute__((address_space(1))) const u32x4 gu4;
        if (basef) {
            f32x4 bn[2][2];
#pragma unroll
            for (int bj = 0; bj < 2; ++bj)
#pragma unroll
                for (int n = 0; n < 2; ++n) bn[bj][n] = *(gf4*)(basef + (size_t)row0 * 1024 + col0 + bj * HALF + n * 4);
#pragma unroll
            for (int idx = 0; idx < 8; ++idx) { const int ai = idx >> 2, m = idx & 3; const int row = row0 + ai * HALF + m * 16; const size_t off = (size_t)row * 1024 + col0; float ss = 0.f;
                f32x4 bc[2][2];
#pragma unroll
                for (int bj = 0; bj < 2; ++bj)
#pragma unroll
                    for (int n = 0; n < 2; ++n) bc[bj][n] = bn[bj][n];
                if (idx + 1 < 8) { const int row2 = row0 + ((idx + 1) >> 2) * HALF + ((idx + 1) & 3) * 16;
#pragma unroll
                    for (int bj = 0; bj < 2; ++bj)
#pragma unroll
                        for (int n = 0; n < 2; ++n) bn[bj][n] = *(gf4*)(basef + (size_t)row2 * 1024 + col0 + bj * HALF + n * 4); }
#pragma unroll
                for (int bj = 0; bj < 2; ++bj) { const f32x4 o0 = bc[bj][0] + acc[ai][bj][m][0], o1 = bc[bj][1] + acc[ai][bj][m][1];
                    u32x4 w; w.x = cvt_pk_bf16(o0[0], o0[1]); w.y = cvt_pk_bf16(o0[2], o0[3]); w.z = cvt_pk_bf16(o1[0], o1[1]); w.w = cvt_pk_bf16(o1[2], o1[3]);
                    *(u32x4*)(xb + off + bj * HALF) = w;
                    ss += ((o0[0] * o0[0] + o0[1] * o0[1]) + (o0[2] * o0[2] + o0[3] * o0[3])) + ((o1[0] * o1[0] + o1[1] * o1[1]) + (o1[2] * o1[2] + o1[3] * o1[3])); }
                ss += __shfl_xor(ss, 16); ss += __shfl_xor(ss, 32);
                if (fq == 0) ssq_out[(size_t)row * 16 + u.pn * 4 + wc] = ss; }
        } else {
            u32x4 bq[2][4][2];
#pragma unroll
            for (int ai = 0; ai < 2; ++ai)
#pragma unroll
                for (int m = 0; m < 4; ++m)
#pragma unroll
                    for (int bj = 0; bj < 2; ++bj) bq[ai][m][bj] = *(gu4*)(baseb + (size_t)(row0 + ai * HALF + m * 16) * 1024 + col0 + bj * HALF);
#pragma unroll
            for (int ai = 0; ai < 2; ++ai)
#pragma unroll
                for (int m = 0; m < 4; ++m) { const int row = row0 + ai * HALF + m * 16; const size_t off = (size_t)row * 1024 + col0; float ss = 0.f;
#pragma unroll
                    for (int bj = 0; bj < 2; ++bj) { const u32x4 q = bq[ai][m][bj];
                        const f32x4 b0 = (f32x4){bflo(q.x), bfhi(q.x), bflo(q.y), bfhi(q.y)}, b1 = (f32x4){bflo(q.z), bfhi(q.z), bflo(q.w), bfhi(q.w)};
                        const f32x4 o0 = b0 + acc[ai][bj][m][0], o1 = b1 + acc[ai][bj][m][1];
                        u32x4 w; w.x = cvt_pk_bf16(o0[0], o0[1]); w.y = cvt_pk_bf16(o0[2], o0[3]); w.z = cvt_pk_bf16(o1[0], o1[1]); w.w = cvt_pk_bf16(o1[2], o1[3]);
                        *(u32x4*)(xb + off + bj * HALF) = w;
                        ss += ((o0[0] * o0[0] + o0[1] * o0[1]) + (o0[2] * o0[2] + o0[3] * o0[3])) + ((o1[0] * o1[0] + o1[1] * o1[1]) + (o1[2] * o1[2] + o1[3] * o1[3])); }
                    ss += __shfl_xor(ss, 16); ss += __shfl_xor(ss, 32);
                    if (fq == 0) ssq_out[(size_t)row * 16 + u.pn * 4 + wc] = ss; }
        }
    }
};
struct EpiGU {
    static constexpr bool PERM = true, AFTER_DRAIN = false;
    const float* ssq; bf16_t* H; int ldh;
    __device__ __forceinline__ void operator()(const f32x4 (&acc)[2][2][4][2], const Unit& u, int wr, int wc, int fr, int fq) const {
        const int row0 = u.pm * BM + wr * 64 + fr, col0 = u.pn * HALF + wc * 32 + 8 * fq;
        float rsv[2][4]; row_rstd4x8(ssq, row0, fq, 1.0f, rsv);
#pragma unroll
        for (int ai = 0; ai < 2; ++ai)
#pragma unroll
            for (int m = 0; m < 4; ++m) { const int row = row0 + ai * HALF + m * 16; const float rs = rsv[ai][m];
                f32x4 hv[2];
                const float rsn = rs * -1.4426950408889634f, rs2 = rs * rs;
#pragma unroll
                for (int n = 0; n < 2; ++n) { const f32x4 G = acc[ai][0][m][n], U = acc[ai][1][m][n]; const f32x4 a = G * rsn;
                    f32x4 d; d[0] = __builtin_amdgcn_exp2f(a[0]); d[1] = __builtin_amdgcn_exp2f(a[1]); d[2] = __builtin_amdgcn_exp2f(a[2]); d[3] = __builtin_amdgcn_exp2f(a[3]);
                    d = d + 1.0f;
                    f32x4 r; r[0] = __builtin_amdgcn_rcpf(d[0]); r[1] = __builtin_amdgcn_rcpf(d[1]); r[2] = __builtin_amdgcn_rcpf(d[2]); r[3] = __builtin_amdgcn_rcpf(d[3]);
                    hv[n] = ((G * U) * rs2) * r; }
                u32x4 w; w.x = cvt_pk_bf16(hv[0][0], hv[0][1]); w.y = cvt_pk_bf16(hv[0][2], hv[0][3]); w.z = cvt_pk_bf16(hv[1][0], hv[1][1]); w.w = cvt_pk_bf16(hv[1][2], hv[1][3]);
                *(u32x4*)(H + (size_t)row * ldh + col0) = w; }
    }
};

template <class Epi, class Sched, bool ALIGN_EPI = false, bool SP2 = false>
__device__ __forceinline__ void gemm_phase(PG8_LAS unsigned char* lds, const Gemm g, const Sched& S, const Epi& E) {
    const int tid = threadIdx.x, wid = __builtin_amdgcn_readfirstlane(tid >> 6), lane = tid & 63, wr = wid >> 2, wc = wid & 3, fr = lane & 15, fq = lane >> 4;
    const int K = g.K, nt = K / BK;
    unsigned voffA[2], voffB[2];
#pragma unroll
    for (int i = 0; i < 2; ++i) { int R, C; stage_rc(tid * 16 + i * 8192, R, C); const int Rb = Epi::PERM ? ((R & ~31) + perm32(R & 31)) : R;
        voffA[i] = g.amode ? (unsigned)((C >> 4) * g.M * 32 + R * 32 + (C & 15) * 2) : (unsigned)(R * K + C) * 2u; voffB[i] = (unsigned)(Rb * K + C) * 2u; }
    const size_t kstep = (size_t)(BK * 2);
    const size_t hstep = (size_t)HALF * K * 2;
    const size_t tstep = 2 * hstep;
    const size_t kstepA = g.amode ? (size_t)4 * g.M * 32 : kstep, hstepA = g.amode ? (size_t)HALF * 32 : hstep, tstepA = 2 * hstepA;
    const unsigned ldsw = (unsigned)wid * 1024u;
    const int aoff = lds_byte(wr * 64 + fr, fq * 8), boff = lds_byte(wc * 32 + fr, fq * 8);
#define PG8_SA(b, h) (((b) * 2 + (h)) * HTB)
#define PG8_SB(b, h) ((4 + (b) * 2 + (h)) * HTB)
#define PG8_STAGE(bufoff, gbase, voff) do { _Pragma("unroll") for (int _i = 0; _i < 2; ++_i) \
        __builtin_amdgcn_global_load_lds((const unsigned*)((const char*)(gbase) + (voff)[_i]), (PG8_LAS unsigned*)(lds + (bufoff) + ldsw + _i * 8192), 16, 0, 0); } while (0)
#define PG8_LDA(dst, b, h) do { _Pragma("unroll") for (int m = 0; m < 4; ++m) _Pragma("unroll") for (int k = 0; k < 2; ++k) dst[m][k] = *(const PG8_LAS bf16x8*)(lds + PG8_SA(b, h) + aoff + m * 2048 + k * 1024); } while (0)
#define PG8_LDB(dst, b, h) do { _Pragma("unroll") for (int n = 0; n < 2; ++n) _Pragma("unroll") for (int k = 0; k < 2; ++k) dst[n][k] = *(const PG8_LAS bf16x8*)(lds + PG8_SB(b, h) + boff + n * 2048 + k * 1024); } while (0)
#define PG8_MMA(ai, bj, At, Bt) do { __builtin_amdgcn_s_setprio(1); _Pragma("unroll") for (int m = 0; m < 4; ++m) _Pragma("unroll") for (int n = 0; n < 2; ++n) _Pragma("unroll") for (int k = 0; k < 2; ++k) \
        acc[ai][bj][m][n] = __builtin_amdgcn_mfma_f32_16x16x32_bf16(Bt[n][k], At[m][k], acc[ai][bj][m][n], 0, 0, 0); __builtin_amdgcn_s_setprio(0); } while (0)
#define PG8_WAIT_V(n) asm volatile("s_waitcnt vmcnt(" #n ")" ::: "memory")
#define PG8_WAIT_L(n) asm volatile("s_waitcnt lgkmcnt(" #n ")" ::: "memory")
#define PG8_BAR __builtin_amdgcn_s_barrier()
#define PG8_SCHED __builtin_amdgcn_sched_barrier(0)
    Unit cur, nxt; int ui = 0;
    if (!S.next(0, cur)) return;
    f32x4 acc[2][2][4][2];
#pragma unroll
    for (int a = 0; a < 2; ++a)
#pragma unroll
        for (int b = 0; b < 2; ++b)
#pragma unroll
            for (int m = 0; m < 4; ++m)
#pragma unroll
                for (int n = 0; n < 2; ++n) acc[a][b][m][n] = (f32x4){0.f, 0.f, 0.f, 0.f};
    bf16x8 At[4][2], B0[2][2], B1[2][2];
    const char* cA = (const char*)g.A + (size_t)cur.pm * tstepA; const char* cB = (const char*)g.Bt + (size_t)cur.pn * tstep;
    S.a_ready(cur);
    if constexpr (SP2) {
        PG8_STAGE(PG8_SB(0, 0), cB, voffB); PG8_STAGE(PG8_SB(0, 1), cB + hstep, voffB); PG8_STAGE(PG8_SA(0, 0), cA, voffA); PG8_STAGE(PG8_SA(0, 1), cA + hstepA, voffA);
        if (wr == 1) PG8_BAR;
        PG8_WAIT_V(2); PG8_BAR;
        PG8_STAGE(PG8_SB(1, 0), cB + kstep, voffB); PG8_STAGE(PG8_SA(1, 0), cA + kstepA, voffA); PG8_STAGE(PG8_SB(1, 1), cB + hstep + kstep, voffB);
        PG8_WAIT_V(6); PG8_BAR;
    } else {
        PG8_STAGE(PG8_SB(0, 0), cB, voffB); PG8_STAGE(PG8_SA(0, 0), cA, voffA); PG8_STAGE(PG8_SB(0, 1), cB + hstep, voffB); PG8_STAGE(PG8_SA(0, 1), cA + hstepA, voffA);
        if (wr == 1) PG8_BAR;
        PG8_WAIT_V(4); PG8_BAR;
        PG8_STAGE(PG8_SB(1, 0), cB + kstep, voffB); PG8_STAGE(PG8_SA(1, 0), cA + kstepA, voffA); PG8_STAGE(PG8_SB(1, 1), cB + hstep + kstep, voffB);
        PG8_WAIT_V(6); PG8_BAR;
    }
    for (;;) {
        const bool has_next = S.next(ui + 1, nxt);
        const char* nA = has_next ? (const char*)g.A + (size_t)nxt.pm * tstepA : cA; const char* nB = has_next ? (const char*)g.Bt + (size_t)nxt.pn * tstep : cB;
        for (int t = 0; t < nt; t += 2) {
            const bool last = (t == nt - 2);
            const char* a1 = cA + (size_t)(t + 1) * kstepA;
            const char* a2 = last ? nA : cA + (size_t)(t + 2) * kstepA; const char* b2 = last ? nB : cB + (size_t)(t + 2) * kstep;
            const char* a3 = a2 + kstepA; const char* b3 = b2 + kstep;
            if (last && has_next) S.a_ready(nxt);
            if constexpr (SP2) {
            PG8_LDB(B0, 0, 0); PG8_LDB(B1, 0, 1); PG8_SCHED; PG8_LDA(At, 0, 0); PG8_STAGE(PG8_SA(1, 1), a1 + hstepA, voffA);
            PG8_WAIT_V(8); PG8_WAIT_L(0); PG8_BAR; PG8_MMA(0, 0, At, B0); PG8_MMA(0, 1, At, B1); PG8_BAR; PG8_SCHED;
            PG8_LDA(At, 0, 1); PG8_STAGE(PG8_SB(0, 0), b2, voffB); PG8_STAGE(PG8_SB(0, 1), b2 + hstep, voffB); PG8_STAGE(PG8_SA(0, 0), a2, voffA);
            PG8_WAIT_V(8); PG8_WAIT_L(0); PG8_BAR; PG8_MMA(1, 0, At, B0); PG8_MMA(1, 1, At, B1); PG8_BAR; PG8_SCHED;
            PG8_LDB(B0, 1, 0); PG8_LDB(B1, 1, 1); PG8_SCHED; PG8_LDA(At, 1, 0); PG8_STAGE(PG8_SA(0, 1), a2 + hstepA, voffA);
            PG8_WAIT_V(8); PG8_WAIT_L(0); PG8_BAR; PG8_MMA(0, 0, At, B0); PG8_MMA(0, 1, At, B1); PG8_BAR; PG8_SCHED;
            PG8_LDA(At, 1, 1); PG8_STAGE(PG8_SB(1, 0), b3, voffB); PG8_STAGE(PG8_SB(1, 1), b3 + hstep, voffB); PG8_STAGE(PG8_SA(1, 0), a3, voffA);
            PG8_WAIT_V(8); PG8_WAIT_L(0); PG8_BAR; PG8_MMA(1, 0, At, B0); PG8_MMA(1, 1, At, B1); PG8_BAR; PG8_SCHED;
            } else {
            PG8_LDB(B0, 0, 0); PG8_SCHED; PG8_LDA(At, 0, 0); PG8_STAGE(PG8_SA(1, 1), a1 + hstepA, voffA);
            PG8_WAIT_L(8); PG8_BAR; PG8_WAIT_L(0); PG8_MMA(0, 0, At, B0); PG8_BAR; PG8_SCHED;
            PG8_LDB(B1, 0, 1); PG8_STAGE(PG8_SB(0, 0), b2, voffB);
            PG8_BAR; PG8_WAIT_L(0); PG8_MMA(0, 1, At, B1); PG8_BAR;
            PG8_LDA(At, 0, 1); PG8_STAGE(PG8_SA(0, 0), a2, voffA);
            PG8_BAR; PG8_WAIT_L(0); PG8_MMA(1, 0, At, B0); PG8_BAR; PG8_SCHED;
            PG8_STAGE(PG8_SB(0, 1), b2 + hstep, voffB);
            PG8_WAIT_V(6); PG8_BAR; PG8_MMA(1, 1, At, B1); PG8_BAR;
            PG8_LDB(B0, 1, 0); PG8_SCHED; PG8_LDA(At, 1, 0); PG8_STAGE(PG8_SA(0, 1), a2 + hstepA, voffA);
            PG8_WAIT_L(8); PG8_BAR; PG8_WAIT_L(0); PG8_MMA(0, 0, At, B0); PG8_BAR; PG8_SCHED;
            PG8_LDB(B1, 1, 1); PG8_STAGE(PG8_SB(1, 0), b3, voffB);
            PG8_BAR; PG8_WAIT_L(0); PG8_MMA(0, 1, At, B1); PG8_BAR;
            PG8_LDA(At, 1, 1); PG8_STAGE(PG8_SA(1, 0), a3, voffA);
            PG8_BAR; PG8_WAIT_L(0); PG8_MMA(1, 0, At, B0); PG8_BAR; PG8_SCHED;
            PG8_STAGE(PG8_SB(1, 1), b3 + hstep, voffB);
            PG8_WAIT_V(6); PG8_BAR; PG8_MMA(1, 1, At, B1); PG8_BAR;
            }
        }
        if constexpr (ALIGN_EPI) { if (wr == 0) PG8_BAR; }
        if constexpr (!Epi::AFTER_DRAIN) { E(acc, cur, wr, wc, fr, fq); S.done(cur); }
        if (!has_next) break;
#pragma unroll
        for (int a = 0; a < 2; ++a)
#pragma unroll
            for (int b = 0; b < 2; ++b)
#pragma unroll
                for (int m = 0; m < 4; ++m)
#pragma unroll
                    for (int n = 0; n < 2; ++n) acc[a][b][m][n] = (f32x4){0.f, 0.f, 0.f, 0.f};
        cur = nxt; cA = nA; cB = nB; ++ui;
        if constexpr (ALIGN_EPI) { if (wr == 1) PG8_BAR; }
    }
    PG8_WAIT_V(0);
    if constexpr (!ALIGN_EPI) { if (wr == 0) PG8_BAR; }
    PG8_BAR;
    if constexpr (Epi::AFTER_DRAIN) { E.fused(acc, cur, wr, wc, fr, fq, lds, wid, lane); S.done(cur); }
#undef PG8_SA
#undef PG8_SB
#undef PG8_STAGE
#undef PG8_LDA
#undef PG8_LDB
#undef PG8_MMA
#undef PG8_WAIT_V
#undef PG8_WAIT_L
#undef PG8_BAR
#undef PG8_SCHED
}
}
constexpr int NWAVES = 8;
constexpr int BATCH = 8, SEQ = 4096, DM = 1024, TOK = BATCH * SEQ;
constexpr int TOKW = 768, MEMW = 256, MEML = 256, NGRP = 48, NST = 64, GCH = 16, NHEAD = 12, MHEAD = 4, HD = 64, FFN = 2816, NBLK = 16, MBLK = 256;
constexpr float C2 = 0.125f * 1.4426950408889634f;
constexpr float LOG2E = 1.4426950408889634f;

constexpr size_t MiB = 1u << 20;
constexpr size_t WS_CTL = 0, CTL_ZERO_BYTES = 1 * MiB;
constexpr size_t WS_S5TAB = 9 * MiB, WS_S5E = 13 * MiB;
constexpr size_t WS_SS0 = 1 * MiB, WS_SSA = 3 * MiB, WS_SSB = 5 * MiB, WS_SSM = 7 * MiB, WS_KMEAN = 8 * MiB;
constexpr size_t WS_WIN0 = 16 * MiB, WS_WGLU = 18 * MiB, WS_WIN1 = 20 * MiB, WS_WOUT0 = 26 * MiB, WS_WOUT1 = 28 * MiB;
constexpr size_t WS_WGU0 = 30 * MiB, WS_WGU1 = 41 * MiB, WS_WDN0 = 52 * MiB, WS_WDN1 = 58 * MiB, WS_WMKV = 64 * MiB;
constexpr size_t WS_MEMB = 65 * MiB, WS_MEMK = 69 * MiB, WS_MEMV = 70 * MiB;
constexpr size_t WS_XB = 72 * MiB;
constexpr size_t WS_R = 136 * MiB;
constexpr size_t WS_U = WS_R, WS_Y = WS_R + 48 * MiB;
constexpr size_t WS_Q1 = WS_R, WS_K1 = WS_R + 48 * MiB, WS_V1 = WS_R + 96 * MiB;
constexpr size_t WS_QM = WS_R + 144 * MiB;
constexpr size_t WS_MIX = WS_R + 160 * MiB;
constexpr size_t WS_H = WS_R;
constexpr size_t WS_END = WS_R + 224 * MiB;
constexpr int CW_BAR = 4096;

constexpr int RING_OFF = 0, RING_BYTES = 147456;
constexpr int LDSCTL_OFF = RING_BYTES, MISC_OFF = LDSCTL_OFF + 320;
constexpr int LDS_BYTES = RING_BYTES + 1024;

#define GAS __attribute__((address_space(1)))
#define LAS __attribute__((address_space(3)))
typedef unsigned short bf16;
typedef unsigned v4u __attribute__((ext_vector_type(4)));
typedef unsigned v2u __attribute__((ext_vector_type(2)));
typedef float f32x4 __attribute__((ext_vector_type(4)));
typedef GAS unsigned gu32;
typedef float f32x2 __attribute__((ext_vector_type(2)));
#define RLX_AGENT __ATOMIC_RELAXED, __HIP_MEMORY_SCOPE_AGENT
#define LDS_WAIT() asm volatile("s_waitcnt lgkmcnt(0)" ::: "memory")
#define VM_WAIT() asm volatile("s_waitcnt vmcnt(0)" ::: "memory")
__device__ __forceinline__ unsigned f2bf(float f) { unsigned u = __builtin_bit_cast(unsigned, f); return (u + 0x7fffu + ((u >> 16) & 1u)) >> 16; }
__device__ __forceinline__ unsigned pk2(float lo, float hi) { return f2bf(lo) | (f2bf(hi) << 16); }
__device__ __forceinline__ float bf2f(unsigned short h) { return __uint_as_float(((unsigned)h) << 16); }
__device__ __forceinline__ float bflo(unsigned w) { return __uint_as_float(w << 16); }
__device__ __forceinline__ float bfhi(unsigned w) { return __uint_as_float(w & 0xffff0000u); }

#define XB_TMO      128
#define XB_XCNT(j)  (256  + 64 * (j))
#define XB_XSUB(j)  (1280 + 64 * (j))
#define XB_XGEN(j)  (2304 + 64 * (j))
#define XB_TOP      3328
#define XB_TOPGEN   3392
#define XCD_BAR_WORDS 3456
#define XB_SPIN_CAP (1u << 18)

__device__ __forceinline__ unsigned xb_ld(unsigned* p)              { return __hip_atomic_load(p, __ATOMIC_RELAXED, __HIP_MEMORY_SCOPE_AGENT); }
__device__ __forceinline__ unsigned xb_add(unsigned* p, unsigned v) { return __hip_atomic_fetch_add(p, v, __ATOMIC_RELAXED, __HIP_MEMORY_SCOPE_AGENT); }
__device__ __forceinline__ unsigned xb_xcc_id() { return (unsigned)__builtin_amdgcn_s_getreg((3 << 11) | 20) & 0xFu; }
#define XB_SPIN(cond, bar) do { unsigned _sp = 0; while (cond) { __builtin_amdgcn_s_sleep(1); \
    if ((++_sp & 255u) == 0u) { if (xb_ld(&(bar)[XB_TMO])) break; if (_sp > XB_SPIN_CAP) { atomicAdd(&(bar)[XB_TMO], 1u); break; } } } } while (0)

struct XcdBarrier {
    unsigned* bar; unsigned x;
    volatile LAS unsigned* st;
};

__device__ __forceinline__ XcdBarrier xcd_barrier_post(unsigned* bar, volatile LAS unsigned* st) {
    XcdBarrier b; b.bar = bar; b.x = xb_xcc_id(); b.st = st;
    if (threadIdx.x == 0) (void)xb_add(&bar[XB_XCNT(b.x)], 1u);
    return b;
}
__device__ __forceinline__ void xcd_barrier_complete(unsigned* bar, unsigned x, unsigned& nloc, unsigned& nx) {
    const unsigned G = gridDim.x * gridDim.y * gridDim.z;
    unsigned sum, cnt, mine, sp = 0u;
    for (;;) {
        sum = 0u; cnt = 0u; mine = 0u;
#pragma unroll
        for (unsigned j = 0; j < 16; ++j) { const unsigned c = xb_ld(&bar[XB_XCNT(j)]); sum += c; cnt += (c > 0u) ? 1u : 0u; mine = (j == x) ? c : mine; }
        if (sum == G) break;
        __builtin_amdgcn_s_sleep(1);
        if ((++sp & 255u) == 0u) { if (xb_ld(&bar[XB_TMO])) break; if (sp > XB_SPIN_CAP) { atomicAdd(&bar[XB_TMO], 1u); break; } }
    }
    nloc = mine > 0u ? mine : 1u; nx = cnt > 0u ? cnt : 1u;
}

__device__ __forceinline__ void xcd_barrier(const XcdBarrier& b) {
    asm volatile("s_waitcnt vmcnt(0)" ::: "memory");
    __syncthreads();
    if (threadIdx.x == 0) {
        unsigned* bar = b.bar;
        __builtin_amdgcn_s_waitcnt(0);
        unsigned nloc = b.st[0], nx = b.st[1];
        if (nloc == 0u) { xcd_barrier_complete(bar, b.x, nloc, nx); b.st[0] = nloc; b.st[1] = nx; }
        const unsigned old = xb_add(&bar[XB_XSUB(b.x)], 1u);
        const unsigned gen = old / nloc;
        if (old + 1u == (gen + 1u) * nloc) {
            __builtin_amdgcn_fence(__ATOMIC_RELEASE, "agent");
            asm volatile("s_waitcnt vmcnt(0)" ::: "memory");
            const unsigned og = xb_add(&bar[XB_TOP], 1u);
            const unsigned tg = og / nx;
            if (og + 1u == (tg + 1u) * nx) xb_add(&bar[XB_TOPGEN], 1u);
            else XB_SPIN(xb_ld(&bar[XB_TOPGEN]) == tg, bar);
            __builtin_amdgcn_fence(__ATOMIC_ACQUIRE, "agent");
            xb_add(&bar[XB_XGEN(b.x)], 1u);
            asm volatile("s_waitcnt vmcnt(0)" ::: "memory");
        } else {
            XB_SPIN(xb_ld(&bar[XB_XGEN(b.x)]) == gen, bar);
            __builtin_amdgcn_fence(__ATOMIC_ACQUIRE, "agent");
            asm volatile("s_waitcnt vmcnt(0)" ::: "memory");
        }
    }
    __syncthreads();
}
namespace attn_body {
using bf16=__hip_bfloat16;
using bf16x8=__attribute__((ext_vector_type(8)))short;
using s16x4=__attribute__((ext_vector_type(4)))short;
using f32x16=__attribute__((ext_vector_type(16)))float;
using u32x4=__attribute__((ext_vector_type(4)))unsigned;
constexpr int D=64;
constexpr int NW=8,QBLK=32,QB=QBLK*NW,KVBLK=64;
__device__ __forceinline__ int crow(int r,int hi){return (r&3)+8*(r>>2)+4*hi;}
#define SBAR() __builtin_amdgcn_sched_barrier(0)
__device__ __forceinline__ void cmask(f32x16&p0,f32x16&p1,int jb,int qrel,int hi){
  const float NEG=-INFINITY; int kb=64*jb+4*hi;
  #pragma unroll
  for(int r=0;r<16;++r){int kv=kb+(r&3)+8*(r>>2); if(kv>qrel)p0[r]=NEG; if(kv+32>qrel)p1[r]=NEG;}
}

constexpr int NSLOT=3, SLOTB=8192;
constexpr int LDS_K=0, LDS_V=NSLOT*SLOTB, LDS_WS=2*NSLOT*SLOTB, LDS_OST=LDS_WS+NW*64*4, LDS_BYTES=LDS_OST+NW*4096;
__device__ __forceinline__ void glds16(const void*gsrc,unsigned lds_dst){unsigned keep;
  asm volatile("s_mov_b32 %0, m0\n\ts_mov_b32 m0, %2\n\ts_nop 0\n\tglobal_load_lds_dwordx4 %1, off\n\ts_mov_b32 m0, %0":"=&s"(keep):"v"(gsrc),"s"(lds_dst):"memory");}
__device__ __forceinline__ float max3f(float a,float b,float c){float r;asm("v_max3_f32 %0, %1, %2, %3":"=v"(r):"v"(a),"v"(b),"v"(c));return r;}
__device__ __forceinline__ float max2f(float a,float b){float r;asm("v_max_f32_e32 %0, %1, %2":"=v"(r):"v"(a),"v"(b));return r;}
__device__ __forceinline__ float fadd_s(float a,float b){float r;asm("v_add_f32_e32 %0, %1, %2":"=v"(r):"v"(a),"v"(b));return r;}
__device__ __forceinline__ float fsub_s(float a,float b){float r;asm("v_sub_f32_e32 %0, %1, %2":"=v"(r):"v"(a),"v"(b));return r;}
typedef float f32x2_t __attribute__((ext_vector_type(2))); typedef float f32x4_t __attribute__((ext_vector_type(4))); typedef __bf16 bf16x2_t __attribute__((ext_vector_type(2)));
__device__ __forceinline__ unsigned cvtpk_s(float lo,float hi){f32x2_t v={lo,hi};bf16x2_t b=__builtin_convertvector(v,bf16x2_t);return __builtin_bit_cast(unsigned,b);}
#define WAIT_BAR(N) asm volatile("s_waitcnt vmcnt(" #N ") lgkmcnt(0)\n\ts_barrier":::"memory")

__device__ __forceinline__ void qkt(f32x16&p0,f32x16&p1,const char*Kslot,const bf16x8*qr,int r32,int hi){
  const char*kb=Kslot+hi*1024+r32*16;
  #pragma unroll
  for(int d0=0;d0<4;++d0){
    const bf16x8 b0=*reinterpret_cast<const bf16x8*>(kb+d0*2048);
    const bf16x8 b1=*reinterpret_cast<const bf16x8*>(kb+d0*2048+512);
    p0=__builtin_amdgcn_mfma_f32_32x32x16_bf16(b0,qr[d0],p0,0,0,0);p1=__builtin_amdgcn_mfma_f32_32x32x16_bf16(b1,qr[d0],p1,0,0,0);}
}
typedef __attribute__((address_space(3))) const char* lds_cptr;
typedef short v4i16_t __attribute__((ext_vector_type(4)));
__device__ __forceinline__ void kload8(bf16x8*kf,lds_cptr kp){
  kf[0]=*(const __attribute__((address_space(3))) bf16x8*)(kp);      kf[1]=*(const __attribute__((address_space(3))) bf16x8*)(kp+512);
  kf[2]=*(const __attribute__((address_space(3))) bf16x8*)(kp+2048); kf[3]=*(const __attribute__((address_space(3))) bf16x8*)(kp+2560);
  kf[4]=*(const __attribute__((address_space(3))) bf16x8*)(kp+4096); kf[5]=*(const __attribute__((address_space(3))) bf16x8*)(kp+4608);
  kf[6]=*(const __attribute__((address_space(3))) bf16x8*)(kp+6144); kf[7]=*(const __attribute__((address_space(3))) bf16x8*)(kp+6656);
}
__device__ __forceinline__ void kload2(bf16x8*kf,lds_cptr kp,int j){ kf[2*j]=*(const __attribute__((address_space(3))) bf16x8*)(kp+j*2048); kf[2*j+1]=*(const __attribute__((address_space(3))) bf16x8*)(kp+j*2048+512); }
__device__ __forceinline__ s16x4 vtr(lds_cptr p){ return __builtin_bit_cast(s16x4,__builtin_amdgcn_ds_read_tr16_b64_v4i16((__attribute__((address_space(3))) v4i16_t*)p)); }
__device__ __forceinline__ float rowmax(const f32x16&p0,const f32x16&p1){
  float a=max3f(p0[0],p0[1],p1[0]),b=max3f(p0[2],p0[3],p1[1]);a=max3f(a,p1[2],p1[3]);
  #pragma unroll
  for(int r=4;r<16;r+=4){a=max3f(a,p0[r],p0[r+1]);b=max3f(b,p0[r+2],p0[r+3]);a=max3f(a,p1[r],p1[r+1]);b=max3f(b,p1[r+2],p1[r+3]);}
  const float m=max2f(a,b);
  auto rr=__builtin_amdgcn_permlane32_swap(__float_as_uint(m),__float_as_uint(m),false,false);
  return max2f(__uint_as_float(rr[0]),__uint_as_float(rr[1]));
}
__device__ __forceinline__ void pv(f32x16*o,int vb,bf16x8 pa0,bf16x8 pa1,bf16x8 pa2,bf16x8 pa3){
  #pragma unroll
  for(int d0=0;d0<2;++d0){s16x4 lo[4],hi[4];
    #pragma unroll
    for(int ks=0;ks<4;++ks){
      asm volatile("ds_read_b64_tr_b16 %0,%1 offset:%c2":"=&v"(lo[ks]):"v"(vb),"i"(d0*4096+ks*1024):"memory");
      asm volatile("ds_read_b64_tr_b16 %0,%1 offset:%c2":"=&v"(hi[ks]):"v"(vb),"i"(d0*4096+ks*1024+512):"memory");}
    asm volatile("s_waitcnt lgkmcnt(0)":::"memory");SBAR();
    #define PK(k) (bf16x8){lo[k][0],lo[k][1],lo[k][2],lo[k][3],hi[k][0],hi[k][1],hi[k][2],hi[k][3]}
    o[d0]=__builtin_amdgcn_mfma_f32_32x32x16_bf16(pa0,PK(0),o[d0],0,0,0);
    o[d0]=__builtin_amdgcn_mfma_f32_32x32x16_bf16(pa1,PK(1),o[d0],0,0,0);
    o[d0]=__builtin_amdgcn_mfma_f32_32x32x16_bf16(pa2,PK(2),o[d0],0,0,0);
    o[d0]=__builtin_amdgcn_mfma_f32_32x32x16_bf16(pa3,PK(3),o[d0],0,0,0);
    #undef PK
  }
}

#ifndef ATTN_STORE16
#define ATTN_STORE16(p,v) (*(u32x4*)(p)=(v))
#endif
template<int MODE,int THRL,int QP,int KP,int OP> __device__ __forceinline__ void attn_unit(const bf16*Qw0,const bf16*__restrict__ Kh,const bf16*__restrict__ Vh,bf16*Ow0,const int NT,
                                                                                          const float slope2,const float*kms0,const float*kms1,const int qb,char*shm){
  int tid_=threadIdx.x; asm volatile("":"+v"(tid_));
  const int tid=tid_,lane=tid&63,r32=lane&31,hi=lane>>5; const int wid=__builtin_amdgcn_readfirstlane(tid>>6);
  const bf16*Qw=Qw0+(long)(wid*QBLK)*QP;
  const unsigned lds0=(unsigned)(uintptr_t)shm;
  float*wsf=(float*)(shm+LDS_WS)+wid*64;
  const bf16*ksrc=Kh+(long)lane*KP+wid*8;
  const bf16*vsrc=Vh+(long)(16*(wid&3)+(lane>>2))*KP+(wid>>2)*32+(lane&3)*8;
  const unsigned kdst=lds0+LDS_K+wid*1024, vdst=lds0+LDS_V+wid*1024;
  #define PT(t) ((MODE==0)?(NT-1-(t)):(((t)<NT-4)?(NT-5-(t)):(t)))
  #define DMA_K(t,slot) glds16(ksrc+(long)PT(t)*KVBLK*KP,(unsigned)__builtin_amdgcn_readfirstlane(kdst+(slot)))
  #define DMA_V(t,slot) glds16(vsrc+(long)PT(t)*KVBLK*KP,(unsigned)__builtin_amdgcn_readfirstlane(vdst+(slot)))
  const int vb0=(int)(lds0+LDS_V)+((lane>>4)&1)*32+(lane&3)*8+(4*hi+((lane&15)>>2))*64;
  const char*Kbase=shm+LDS_K; bf16x8 kf[8];
  const lds_cptr shm3=(lds_cptr)shm; const lds_cptr kp0=shm3+LDS_K+hi*1024+r32*16; const lds_cptr vp0=shm3+LDS_V+((lane>>4)&1)*32+(lane&3)*8+(4*hi+((lane&15)>>2))*64;
  DMA_K(0,0);DMA_V(0,0);DMA_K(1,SLOTB);
  bf16x8 qr[4];
  #pragma unroll
  for(int d0=0;d0<4;++d0)qr[d0]=*reinterpret_cast<const bf16x8*>(&Qw[(long)r32*QP+d0*16+hi*8]);
  unsigned selm=0xffffffffu;
  if constexpr(MODE==1){
    f32x16 G=f32x16{};
    #pragma unroll
    for(int d0=0;d0<4;++d0){
      bf16x8 ah=bf16x8{},al=bf16x8{};
      if(r32<16){ const float*p0_=kms0+r32*64+d0*16+hi*8,*p1_=kms1+r32*64+d0*16+hi*8;
        const f32x4_t s0=*reinterpret_cast<const f32x4_t*>(p0_)+*reinterpret_cast<const f32x4_t*>(p1_), s1=*reinterpret_cast<const f32x4_t*>(p0_+4)+*reinterpret_cast<const f32x4_t*>(p1_+4);
        const float km_[8]={s0[0],s0[1],s0[2],s0[3],s1[0],s1[1],s1[2],s1[3]};
        #pragma unroll
        for(int i_=0;i_<8;i_+=2){ const unsigned wh_=cvtpk_s(km_[i_],km_[i_+1]); const float r0_=km_[i_]-__uint_as_float(wh_<<16), r1_=km_[i_+1]-__uint_as_float(wh_&0xffff0000u); const unsigned wl_=cvtpk_s(r0_,r1_);
          ah[i_]=(short)(wh_&0xffffu); ah[i_+1]=(short)(wh_>>16); al[i_]=(short)(wl_&0xffffu); al[i_+1]=(short)(wl_>>16); } }
      G=__builtin_amdgcn_mfma_f32_32x32x16_bf16(ah,qr[d0],G,0,0,0); G=__builtin_amdgcn_mfma_f32_32x32x16_bf16(al,qr[d0],G,0,0,0);}
    float g[16];
    #pragma unroll
    for(int r=0;r<4;++r){ const float a=G[r],b=G[4+r]; const float oa=__shfl_xor(a,32),ob=__shfl_xor(b,32);
      g[r]=hi?oa:a; g[4+r]=hi?a:oa; g[8+r]=hi?ob:b; g[12+r]=hi?b:ob; }
    #pragma unroll
    for(int n=0;n<16;++n) if(n>=qb) g[n]=-1.0e30f;
    const int nsel=qb<3?qb:3; unsigned mask=0u;
    #pragma unroll
    for(int rr=0;rr<3;++rr){ float best=-3.0e38f; int bi=0;
      #pragma unroll
      for(int n=0;n<16;++n){ const bool c=!((mask>>n)&1u)&&g[n]>best; best=c?g[n]:best; bi=c?n:bi; }
      if(rr<nsel) mask|=1u<<bi; }
    selm=mask|(1u<<qb);
  }
  float mhat=0.f,l_reg=0.f;f32x16 o[2];o[0]=f32x16{};o[1]=f32x16{};
  const int qrel=wid*QBLK+r32;
  const float hb=(MODE==1)?slope2*(float)(4*hi):0.f, s32=(MODE==1)?32.f*slope2:0.f, s64=(MODE==1)?64.f*slope2:0.f;
  #define CBASE(b0_,b1_,t) float b0_=fsub_s(fadd_s(s64*(float)PT(t),hb),mhat); if(MODE==1){ if(!((selm>>(PT(t)>>2))&1u)) b0_=-3.0e38f; } const float b1_=b0_+s32
  #define CFILL(X,B,bb) do{ _Pragma("unroll") for(int i_=0;i_<4;++i_){ if(MODE==1) X[(B)+i_]=__builtin_fmaf(slope2,(float)((((B)+i_)&3)+8*(((B)+i_)>>2)),bb); else X[(B)+i_]=bb; } }while(0)
  #define CINIT(C0,C1,t) do{ CBASE(b0_,b1_,t); CFILL(C0,0,b0_);CFILL(C0,4,b0_);CFILL(C0,8,b0_);CFILL(C0,12,b0_);CFILL(C1,0,b1_);CFILL(C1,4,b1_);CFILL(C1,8,b1_);CFILL(C1,12,b1_); }while(0)
  #define CMASK(P0,P1,t) do{ if(MODE==1){ int jb_=(t)-(NT-4); if(jb_>=0)cmask(P0,P1,jb_,qrel,hi);} }while(0)
  bool resc=false;
  #define START(P0,P1) do{ const float rm=rowmax(P0,P1); resc=false; \
    { const float dl=__builtin_fmaxf(rm,-1000.f); mhat=fadd_s(mhat,dl); \
      _Pragma("unroll") for(int r=0;r<16;++r){P0[r]=fsub_s(P0[r],dl);P1[r]=fsub_s(P1[r],dl);} } \
    _Pragma("unroll") for(int r=0;r<16;++r)P0[r]=__builtin_amdgcn_exp2f(P0[r]); }while(0)
  #define RESC() do{ if(resc){ asm volatile("s_waitcnt lgkmcnt(0)":::"memory"); \
      _Pragma("unroll") for(int d_=0;d_<2;++d_) _Pragma("unroll") for(int r=0;r<16;++r)o[d_][r]*=wsf[crow(r,hi)]; } }while(0)
  f32x16 pA0,pA1,pB0,pB1;
  int sl_prev=0,sl_cur=0,sl_next=SLOTB;
  #define ROT() do{sl_prev=sl_cur;sl_cur=sl_next;sl_next=(sl_next==(NSLOT-1)*SLOTB)?0:sl_next+SLOTB;}while(0)
  DMA_K(2,2*SLOTB);
  WAIT_BAR(3);
  CINIT(pA0,pA1,0);
  qkt(pA0,pA1,Kbase,qr,r32,hi);asm volatile("s_nop 15\n\ts_nop 7":"+v"(pA0),"+v"(pA1));CMASK(pA0,pA1,0);
  START(pA0,pA1);
  _Pragma("unroll") for(int r=0;r<16;++r)pA1[r]=__builtin_amdgcn_exp2f(pA1[r]);
  WAIT_BAR(0);
  DMA_K(3,0);DMA_V(1,SLOTB);
  ROT();
  kload8(kf,kp0+sl_cur);
  WAIT_BAR(2);
  s16x4 vlo[8],vhi[8]; u32x4 pw0,pw1,pw2,pw3;
  #define PKW(P,B) cvtpk_s(P[B],P[B+1])
  #define PAF(k) __builtin_bit_cast(bf16x8,pw##k)
  #define VFR(i) (bf16x8){vlo[i][0],vlo[i][1],vlo[i][2],vlo[i][3],vhi[i][0],vhi[i][1],vhi[i][2],vhi[i][3]}
  #define PIN(x) asm volatile("":"+v"(x))
  #define MX3(a,b,c) __builtin_fmaxf(__builtin_fmaxf((a),(b)),(c))
  #define GAPA(MF,A0,A1,A2,A3,W0,W1,PW) do{ MF; sacc+=A0; sacc+=A1; sacc+=A2; sacc+=A3; PIN(sacc); W0; W1; PIN(PW); SBAR(); }while(0)
  #define EX(v) __builtin_amdgcn_exp2f(v)
  #define GAPB(MF,X,B,N,bb) do{ MF; X[B]=EX(X[B]); X[B+1]=EX(X[B+1]); X[B+2]=EX(X[B+2]); X[B+3]=EX(X[B+3]); PIN(X); CFILL(N,B,bb); PIN(N); SBAR(); }while(0)
  #define VRD(i) do{ vlo[i]=vtr(vp_+(((i)>>2)*4096+((i)&3)*1024)); vhi[i]=vtr(vp_+(((i)>>2)*4096+((i)&3)*1024+512)); }while(0)
  #define KRD(G,j) do{ if(G){ kload2(kf,kp0+sl_next,j); SBAR(); } }while(0)
  #define STEP(C0,C1,P0,P1,t,GK,GV,GL) do{ SBAR(); \
    const lds_cptr vp_=vp0+sl_prev; \
    VRD(0); SBAR(); float sacc=(P0[0]+P0[1]); \
    GAPA(C0=__builtin_amdgcn_mfma_f32_32x32x16_bf16(kf[0],qr[0],C0,0,0,0), P0[2],P0[3],P0[4],P0[5],     pw0[0]=PKW(P0,0), pw0[1]=PKW(P0,2), pw0); \
    VRD(4); SBAR(); GAPA(C1=__builtin_amdgcn_mfma_f32_32x32x16_bf16(kf[1],qr[0],C1,0,0,0), P0[6],P0[7],P0[8],P0[9],     pw0[2]=PKW(P0,4), pw0[3]=PKW(P0,6), pw0); \
    VRD(1); SBAR(); GAPA(C0=__builtin_amdgcn_mfma_f32_32x32x16_bf16(kf[2],qr[1],C0,0,0,0),   P0[10],P0[11],P0[12],P0[13], pw1[0]=PKW(P0,8), pw1[1]=PKW(P0,10), pw1); \
    VRD(5); SBAR(); GAPA(C1=__builtin_amdgcn_mfma_f32_32x32x16_bf16(kf[3],qr[1],C1,0,0,0),   P0[14],P0[15],P1[0],P1[1],   pw1[2]=PKW(P0,12),pw1[3]=PKW(P0,14), pw1); \
    VRD(2); SBAR(); GAPA(C0=__builtin_amdgcn_mfma_f32_32x32x16_bf16(kf[4],qr[2],C0,0,0,0),   P1[2],P1[3],P1[4],P1[5],     pw2[0]=PKW(P1,0), pw2[1]=PKW(P1,2), pw2); \
    VRD(6); SBAR(); GAPA(C1=__builtin_amdgcn_mfma_f32_32x32x16_bf16(kf[5],qr[2],C1,0,0,0),   P1[6],P1[7],P1[8],P1[9],     pw2[2]=PKW(P1,4), pw2[3]=PKW(P1,6), pw2); \
    VRD(3); SBAR(); GAPA(C0=__builtin_amdgcn_mfma_f32_32x32x16_bf16(kf[6],qr[3],C0,0,0,0),   P1[10],P1[11],P1[12],P1[13], pw3[0]=PKW(P1,8), pw3[1]=PKW(P1,10), pw3); \
    VRD(7); SBAR(); GAPA(C1=__builtin_amdgcn_mfma_f32_32x32x16_bf16(kf[7],qr[3],C1,0,0,0),   P1[14],P1[15],0.f,0.f,       pw3[2]=PKW(P1,12),pw3[3]=PKW(P1,14), pw3); \
    l_reg+=sacc; \
    if(GK){DMA_K((t)+3,sl_cur);} if(GV){DMA_V((t)+1,sl_next);} \
    CMASKX(C0,C1,t); \
    { float a=MX3(C0[0],C0[1],C1[0]),b=MX3(C0[2],C0[3],C1[1]); a=MX3(a,C1[2],C1[3]); \
      _Pragma("unroll") for(int r=4;r<16;r+=4){a=MX3(a,C0[r],C0[r+1]);b=MX3(b,C0[r+2],C0[r+3]);a=MX3(a,C1[r],C1[r+1]);b=MX3(b,C1[r+2],C1[r+3]);} \
      float rm=__builtin_fmaxf(a,b); { auto rr=__builtin_amdgcn_permlane32_swap(__float_as_uint(rm),__float_as_uint(rm),false,false); rm=__builtin_fmaxf(__uint_as_float(rr[0]),__uint_as_float(rr[1])); } \
      resc=false; \
      if(__builtin_expect(__any(rm>(float)THRL),0)){ const float dl=__builtin_fmaxf(rm,0.f); mhat+=dl; \
        _Pragma("unroll") for(int r=0;r<16;++r){C0[r]-=dl;C1[r]-=dl;} \
        const float f=__builtin_amdgcn_exp2f(-dl); l_reg*=f; if(hi==0)wsf[r32]=f; resc=true; } } \
    CBASE(n0_,n1_,(t)+1);                                   \
    SBAR(); \
    GAPB(o[0]=__builtin_amdgcn_mfma_f32_32x32x16_bf16(PAF(0),VFR(0),o[0],0,0,0), C0,0, P0,n0_); \
    GAPB(o[1]=__builtin_amdgcn_mfma_f32_32x32x16_bf16(PAF(0),VFR(4),o[1],0,0,0), C0,4, P0,n0_); \
    KRD(GL,0); GAPB(o[0]=__builtin_amdgcn_mfma_f32_32x32x16_bf16(PAF(1),VFR(1),o[0],0,0,0), C0,8, P0,n0_); \
    KRD(GL,1); GAPB(o[1]=__builtin_amdgcn_mfma_f32_32x32x16_bf16(PAF(1),VFR(5),o[1],0,0,0), C0,12, P0,n0_); \
    KRD(GL,2); GAPB(o[0]=__builtin_amdgcn_mfma_f32_32x32x16_bf16(PAF(2),VFR(2),o[0],0,0,0), C1,0, P1,n1_); \
    KRD(GL,3); GAPB(o[1]=__builtin_amdgcn_mfma_f32_32x32x16_bf16(PAF(2),VFR(6),o[1],0,0,0), C1,4, P1,n1_); \
    GAPB(o[0]=__builtin_amdgcn_mfma_f32_32x32x16_bf16(PAF(3),VFR(3),o[0],0,0,0), C1,8, P1,n1_); \
    GAPB(o[1]=__builtin_amdgcn_mfma_f32_32x32x16_bf16(PAF(3),VFR(7),o[1],0,0,0), C1,12, P1,n1_); \
    }while(0)
  int t=1;
  CINIT(pB0,pB1,1);
  #define ENDW(tt) do{ if((tt)+3<NT){WAIT_BAR(2);} else if((tt)+2<NT){WAIT_BAR(1);} else {WAIT_BAR(0);} }while(0)
  #define CMASKX(P0,P1,t) do{ asm volatile("; head step (masked)"); CMASK(P0,P1,t); }while(0)
  for(;t+1<NT&&t<5;t+=2){
    STEP(pB0,pB1,pA0,pA1,t,(t+3<NT),(t+1<NT),(t+1<NT));       ENDW(t);   RESC(); ROT();
    STEP(pA0,pA1,pB0,pB1,t+1,(t+4<NT),(t+2<NT),(t+2<NT));     ENDW(t+1); RESC(); ROT();
  }
  #undef CMASKX
  #define CMASKX(P0,P1,t) do{ asm volatile("; steady step (no mask)"); }while(0)
  for(;t+5<NT;t+=2){
    STEP(pB0,pB1,pA0,pA1,t,true,true,true);     WAIT_BAR(2); RESC(); ROT();
    STEP(pA0,pA1,pB0,pB1,t+1,true,true,true);   WAIT_BAR(2); RESC(); ROT();
  }
  #undef CMASKX
  #define CMASKX(P0,P1,t) do{ asm volatile("; tail step (masked)"); CMASK(P0,P1,t); }while(0)
  for(;t+1<NT;t+=2){
    STEP(pB0,pB1,pA0,pA1,t,(t+3<NT),(t+1<NT),(t+1<NT));       ENDW(t);   RESC(); ROT();
    STEP(pA0,pA1,pB0,pB1,t+1,(t+4<NT),(t+2<NT),(t+2<NT));     ENDW(t+1); RESC(); ROT();
  }
  STEP(pB0,pB1,pA0,pA1,NT-1,false,false,false); RESC();
  { float sacc=pB0[0]+pB0[1]; _Pragma("unroll") for(int r=2;r<16;++r)sacc+=pB0[r]; _Pragma("unroll") for(int r=0;r<16;++r)sacc+=pB1[r]; l_reg+=sacc;
    pw0=(u32x4){PKW(pB0,0),PKW(pB0,2),PKW(pB0,4),PKW(pB0,6)};pw1=(u32x4){PKW(pB0,8),PKW(pB0,10),PKW(pB0,12),PKW(pB0,14)};pw2=(u32x4){PKW(pB1,0),PKW(pB1,2),PKW(pB1,4),PKW(pB1,6)};pw3=(u32x4){PKW(pB1,8),PKW(pB1,10),PKW(pB1,12),PKW(pB1,14)};
    SBAR(); pv(o,vb0+sl_cur,PAF(0),PAF(1),PAF(2),PAF(3)); }
  #undef PKW
  #undef PAF
  #undef VFR
  #undef PIN
  #undef MX3
  #undef GAPA
  #undef GAPB
  #undef EX
  #undef VRD
  #undef KRD
  #undef STEP
  #undef ENDW
  #undef CMASKX
  {auto rr=__builtin_amdgcn_permlane32_swap(__float_as_uint(l_reg),__float_as_uint(l_reg),false,false);l_reg=__uint_as_float(rr[0])+__uint_as_float(rr[1]);}
  if(hi==0)wsf[32+r32]=l_reg;asm volatile("s_waitcnt lgkmcnt(0)":::"memory");
  float rli[16];
  #pragma unroll
  for(int r=0;r<16;++r)rli[r]=__builtin_amdgcn_rcpf(wsf[32+crow(r,hi)]);
  bf16*Ow=Ow0+(long)(wid*QBLK)*OP;
  { bf16*stg=(bf16*)(shm+LDS_OST)+wid*2048;
    #pragma unroll
    for(int r=0;r<16;++r){const int orow=crow(r,hi);
      #pragma unroll
      for(int d0=0;d0<2;++d0)stg[orow*64+d0*32+r32]=__float2bfloat16(o[d0][r]*rli[r]);}
    asm volatile("s_waitcnt lgkmcnt(0)":::"memory");
    #pragma unroll
    for(int i=0;i<4;++i){const int row=i*8+(lane>>3),ch=lane&7; const u32x4 v=*(const u32x4*)(stg+row*64+ch*8); ATTN_STORE16(Ow+(long)row*OP+ch*8,v);} }
  asm volatile("s_waitcnt lgkmcnt(0)\n\ts_barrier":::"memory");
  #undef DMA_K
  #undef DMA_V
  #undef CMASK
  #undef CINIT
  #undef CBASE
  #undef CFILL
  #undef PT
  #undef START
  #undef RESC
  #undef ROT
}
constexpr int ATTN_LDS_BYTES=LDS_BYTES;
#undef SBAR
#undef WAIT_BAR
}
__device__ __forceinline__ float wave_sum(float v) {
#pragma unroll
    for (int o = 1; o < 64; o <<= 1) v += __shfl_xor(v, o);
    return v;
}
__device__ __forceinline__ float wave_max(float v) {
#pragma unroll
    for (int o = 1; o < 64; o <<= 1) v = fmaxf(v, __shfl_xor(v, o));
    return v;
}
__device__ __forceinline__ int opaque_zero() { int z; asm volatile("v_mov_b32 %0, 0" : "=v"(z)); return z; }

__device__ __forceinline__ void p0_transpose_item(const float* W, int K, int N, bf16* WT, int dest_row0, int k0, int n0, const float* gk, LAS float* scr, int lane) {
    float wv[32];
#pragma unroll
    for (int i = 0; i < 32; ++i) { const int kk = 2 * i + (lane >> 5); wv[i] = W[(size_t)(k0 + kk) * N + n0 + (lane & 31)]; }
    if (gk) {
#pragma unroll
        for (int i = 0; i < 32; ++i) wv[i] *= gk[k0 + 2 * i + (lane >> 5)]; }
#pragma unroll
    for (int i = 0; i < 32; ++i) { const int kk = 2 * i + (lane >> 5); scr[kk * 33 + (lane & 31)] = wv[i]; }
    LDS_WAIT(); asm volatile("" ::: "memory");
    const int c = lane & 7;
#pragma unroll
    for (int j = 0; j < 4; ++j) { const int n = (lane >> 3) + 8 * j; const LAS float* s = scr + (8 * c) * 33 + n;
        v4u o; o.x = pk2(s[0 * 33], s[1 * 33]); o.y = pk2(s[2 * 33], s[3 * 33]); o.z = pk2(s[4 * 33], s[5 * 33]); o.w = pk2(s[6 * 33], s[7 * 33]);
        *(GAS v4u*)(WT + (size_t)(dest_row0 + n) * K + k0 + 8 * c) = o; }
    LDS_WAIT(); asm volatile("" ::: "memory");
}
__device__ __forceinline__ void p0_matrix_item(const float* W, int K, int N, bf16* WT, const float* gk, int mode, int item, LAS float* scr, int lane) {
    const int nblk = N / 32, kb = item / nblk, nb = item - kb * nblk, k0 = 64 * kb, n0 = 32 * nb;
    const int dr = (mode == 0) ? n0 : (256 * (n0 >> 7) + (n0 & 127) + (mode == 2 ? 128 : 0));
    p0_transpose_item(W, K, N, WT, dr, k0, n0, gk, scr, lane);
}
template <int NR>
__device__ __forceinline__ void rows_to_bf16_ssq(const float* xrow, bf16* orow, float* ssq16, int lane) {
    f32x4 v[NR][4];
#pragma unroll
    for (int r = 0; r < NR; ++r) { const GAS f32x4* xr = (const GAS f32x4*)(xrow + (size_t)r * 1024) + lane;
#pragma unroll
        for (int j = 0; j < 4; ++j) v[r][j] = xr[64 * j]; }
#pragma unroll
    for (int r = 0; r < NR; ++r) { float s = 0.f;
#pragma unroll
        for (int j = 0; j < 4; ++j) s += (v[r][j].x * v[r][j].x + v[r][j].y * v[r][j].y) + (v[r][j].z * v[r][j].z + v[r][j].w * v[r][j].w);
        s = wave_sum(s);
        GAS unsigned long long* o8 = (GAS unsigned long long*)(orow + (size_t)r * 1024) + lane;
#pragma unroll
        for (int j = 0; j < 4; ++j) o8[64 * j] = (unsigned long long)pk2(v[r][j].x, v[r][j].y) | ((unsigned long long)pk2(v[r][j].z, v[r][j].w) << 32);
        if (lane < 16) ssq16[r * 16 + lane] = (lane == 0) ? s : 0.f; }
}

__device__ __forceinline__ void s5_naive_unit(int b, int g, const bf16* U, bf16* Y, const float* lam_re, const float* lam_im, const float* log_dt, const float* b_re, const float* b_im,
                                              const float* c_re, const float* c_im, const float* dvec, int lane) {
    const int p = lane;
    const float lr = lam_re[g * 64 + p], li = lam_im[g * 64 + p], dt = expf(log_dt[g]);
    const float mag = expf(lr * dt), ar = mag * cosf(li * dt), ai = mag * sinf(li * dt);
    const float den = lr * lr + li * li, nr = ar - 1.0f, fr = (nr * lr + ai * li) / den, fi = (ai * lr - nr * li) / den;
    float bbr[16], bbi[16], cr[16], ci[16];
#pragma unroll
    for (int c = 0; c < 16; ++c) { const float br = b_re[((size_t)g * 64 + p) * 16 + c], bi = b_im[((size_t)g * 64 + p) * 16 + c]; bbr[c] = fr * br - fi * bi; bbi[c] = fr * bi + fi * br;
        cr[c] = c_re[((size_t)g * 16 + c) * 64 + p]; ci[c] = c_im[((size_t)g * 16 + c) * 64 + p]; }
    const int ch = ((lane & 1) << 3) | ((lane & 2) << 1) | ((lane & 4) >> 1) | ((lane & 8) >> 3);
    const float dch = dvec[16 * g + ch];
    const int z0 = opaque_zero();
    constexpr int TP = 16;
    const bf16* up = U + ((size_t)g * TOK + (size_t)b * SEQ) * 16 + z0;
    bf16* yp = Y + ((size_t)g * TOK + (size_t)b * SEQ) * 16 + ch;
    float xr = 0.f, xi = 0.f;
#pragma unroll 2
    for (int s = 0; s < SEQ; ++s) {
        const v4u w0 = *(const GAS v4u*)(up + (size_t)s * TP), w1 = *(const GAS v4u*)(up + (size_t)s * TP + 8);
        const float uch = bf2f(up[(size_t)s * TP + ch]);
        const float uu[16] = {bflo(w0.x), bfhi(w0.x), bflo(w0.y), bfhi(w0.y), bflo(w0.z), bfhi(w0.z), bflo(w0.w), bfhi(w0.w), bflo(w1.x), bfhi(w1.x), bflo(w1.y), bfhi(w1.y), bflo(w1.z), bfhi(w1.z), bflo(w1.w), bfhi(w1.w)};
        float bur = 0.f, bui = 0.f;
#pragma unroll
        for (int c = 0; c < 16; ++c) { bur += bbr[c] * uu[c]; bui += bbi[c] * uu[c]; }
        const float nxr = ar * xr - ai * xi + bur, nxi = ar * xi + ai * xr + bui; xr = nxr; xi = nxi;
        float v[16];
#pragma unroll
        for (int c = 0; c < 16; ++c) v[c] = cr[c] * xr - ci[c] * xi;
        float w[8], x4[4], x2[2], z;
        { const bool bit = lane & 1;
#pragma unroll
          for (int j = 0; j < 8; ++j) { const float send = bit ? v[j] : v[j + 8], keep = bit ? v[j + 8] : v[j]; w[j] = keep + __shfl_xor(send, 1); } }
        { const bool bit = lane & 2;
#pragma unroll
          for (int j = 0; j < 4; ++j) { const float send = bit ? w[j] : w[j + 4], keep = bit ? w[j + 4] : w[j]; x4[j] = keep + __shfl_xor(send, 2); } }
        { const bool bit = lane & 4;
#pragma unroll
          for (int j = 0; j < 2; ++j) { const float send = bit ? x4[j] : x4[j + 2], keep = bit ? x4[j + 2] : x4[j]; x2[j] = keep + __shfl_xor(send, 4); } }
        { const bool bit = lane & 8; const float send = bit ? x2[0] : x2[1], keep = bit ? x2[1] : x2[0]; z = keep + __shfl_xor(send, 8); }
        z += __shfl_xor(z, 16); z += __shfl_xor(z, 32);
        const float yv = z + dch * uch;
        const float ge = 0.5f * yv * (1.0f + erff(yv * 0.70710678118654752f));
        if (lane < 16) yp[(size_t)s * TP] = (bf16)f2bf(ge);
    }
}

__device__ __forceinline__ void memattn_naive_unit(int tok, int h, const bf16* QM, const bf16* memk, const bf16* memv, bf16* mix, LAS float* ps, int lane) {
    const int b = tok >> 12; const int z0 = opaque_zero();
    const float qv = bf2f(QM[(size_t)tok * 256 + h * 64 + lane]);
    float q[64];
#pragma unroll
    for (int d = 0; d < 64; ++d) q[d] = __shfl(qv, d);
    float sc[4];
#pragma unroll
    for (int i = 0; i < 4; ++i) { const int j = lane + 64 * i; const GAS v4u* kr = (const GAS v4u*)(memk + ((size_t)(b * 256 + j)) * 256 + h * 64 + z0); float a = 0.f;
#pragma unroll
        for (int c = 0; c < 8; ++c) { const v4u w = kr[c]; a += q[8 * c] * bflo(w.x) + q[8 * c + 1] * bfhi(w.x) + q[8 * c + 2] * bflo(w.y) + q[8 * c + 3] * bfhi(w.y) + q[8 * c + 4] * bflo(w.z) + q[8 * c + 5] * bfhi(w.z) + q[8 * c + 6] * bflo(w.w) + q[8 * c + 7] * bfhi(w.w); }
        sc[i] = a; }
    const float m = wave_max(fmaxf(fmaxf(sc[0], sc[1]), fmaxf(sc[2], sc[3])));
    float l = 0.f;
#pragma unroll
    for (int i = 0; i < 4; ++i) { const float pe = __builtin_amdgcn_exp2f(sc[i] - m); l += pe; ps[lane + 64 * i] = pe; }
    l = wave_sum(l);
    LDS_WAIT(); asm volatile("" ::: "memory");
    float o = 0.f; const bf16* vp = memv + (size_t)(b * 256) * 256 + h * 64 + lane;
#pragma unroll 8
    for (int j = 0; j < 256; ++j) o += ps[j] * bf2f(vp[(size_t)j * 256]);
    mix[(size_t)tok * 1024 + 768 + h * 64 + lane] = (bf16)f2bf(o / l);
    LDS_WAIT(); asm volatile("" ::: "memory");
}

__device__ __forceinline__ float dot64_bf16(const float (&q)[64], const GAS v4u* kr) {
    float a = 0.f;
#pragma unroll
    for (int c = 0; c < 8; ++c) { const v4u w = kr[c]; a += q[8 * c] * bflo(w.x) + q[8 * c + 1] * bfhi(w.x) + q[8 * c + 2] * bflo(w.y) + q[8 * c + 3] * bfhi(w.y) + q[8 * c + 4] * bflo(w.z) + q[8 * c + 5] * bfhi(w.z) + q[8 * c + 6] * bflo(w.w) + q[8 * c + 7] * bfhi(w.w); }
    return a;
}
__device__ __forceinline__ void moba_naive_unit(int tok, int h, const bf16* Q1, const bf16* K1, const bf16* V1, const float* KMEAN, bf16* mix, LAS float* ps, int lane) {
    const int b = tok >> 12, s = tok & (SEQ - 1), qb = s >> 8; const int z0 = opaque_zero();
    const float qv = bf2f(Q1[(size_t)tok * TOKW + h * 64 + lane]);
    float q[64];
#pragma unroll
    for (int d = 0; d < 64; ++d) q[d] = __shfl(qv, d);
    float gate = -1e30f;
    { const int n = lane & 15; const GAS f32x4* km = (const GAS f32x4*)(KMEAN + ((size_t)((b * NHEAD + h) * NBLK + n)) * 64 + z0); float a = 0.f;
#pragma unroll
      for (int c = 0; c < 16; ++c) { const f32x4 w = km[c]; a += q[4 * c] * w.x + q[4 * c + 1] * w.y + q[4 * c + 2] * w.z + q[4 * c + 3] * w.w; }
      if (n < qb) gate = a; }
    float g[16];
#pragma unroll
    for (int n = 0; n < 16; ++n) g[n] = __shfl(gate, n);
    const int nsel = qb < 3 ? qb : 3;
    unsigned mask = 0u;
#pragma unroll
    for (int r = 0; r < 3; ++r) { float best = -3.0e38f; int bi = 0;
#pragma unroll
        for (int n = 0; n < 16; ++n) { const bool c = !((mask >> n) & 1u) && g[n] > best; best = c ? g[n] : best; bi = c ? n : bi; }
        if (r < nsel) mask |= 1u << bi; }
    int blk0 = 0, blk1 = 0, blk2 = 0, cnt = 0;
#pragma unroll
    for (int n = 0; n < 16; ++n) if ((mask >> n) & 1u) { if (cnt == 0) blk0 = n; else if (cnt == 1) blk1 = n; else blk2 = n; ++cnt; }
    const int nslots = nsel + 1;
    const float slope = __builtin_amdgcn_exp2f(-8.0f * (float)(h + 1) / 12.0f) * LOG2E;
    const bf16* kh = K1 + (size_t)b * SEQ * TOKW + h * 64 + z0;
    float mx = -3.0e38f;
#pragma unroll
    for (int sl = 0; sl < 4; ++sl) if (sl < nslots) {
        const int blk = (sl == nsel) ? qb : (sl == 0 ? blk0 : (sl == 1 ? blk1 : blk2));
#pragma unroll
        for (int i = 0; i < 4; ++i) { const int j = lane + 64 * i, pos = blk * 256 + j;
            float a = dot64_bf16(q, (const GAS v4u*)(kh + (size_t)pos * TOKW)) + slope * (float)(pos - s);
            if (pos > s) a = -3.0e38f;
            ps[sl * 256 + j] = a; mx = fmaxf(mx, a); } }
    mx = wave_max(mx);
    LDS_WAIT(); asm volatile("" ::: "memory");
    float l = 0.f;
#pragma unroll
    for (int sl = 0; sl < 4; ++sl) if (sl < nslots) {
#pragma unroll
        for (int i = 0; i < 4; ++i) { const int j = lane + 64 * i; const float a = ps[sl * 256 + j]; const float pe = (a < -1.0e37f) ? 0.f : __builtin_amdgcn_exp2f(a - mx); l += pe; ps[sl * 256 + j] = pe; } }
    l = wave_sum(l);
    LDS_WAIT(); asm volatile("" ::: "memory");
    float o = 0.f; const bf16* vh = V1 + (size_t)b * SEQ * TOKW + h * 64 + lane;
#pragma unroll
    for (int sl = 0; sl < 4; ++sl) if (sl < nslots) {
        const int blk = (sl == nsel) ? qb : (sl == 0 ? blk0 : (sl == 1 ? blk1 : blk2));
        const bf16* vp = vh + (size_t)(blk * 256) * TOKW;
#pragma unroll 8
        for (int j = 0; j < 256; ++j) o += ps[sl * 256 + j] * bf2f(vp[(size_t)j * TOKW]); }
    mix[(size_t)tok * 1024 + h * 64 + lane] = (bf16)f2bf(o / l);
    LDS_WAIT(); asm volatile("" ::: "memory");
}

constexpr int S5_PITCH = 272;
constexpr int S5_WST = 0, S5_WYC = 128 * S5_PITCH, S5_KT = 2 * 128 * S5_PITCH, S5_TAB_BYTES = S5_KT + 10 * 512;
constexpr int S5_XS = S5_TAB_BYTES, S5_XS_BYTES = 32 * S5_PITCH;
static_assert(S5_XS + NWAVES * S5_XS_BYTES <= RING_BYTES, "S5 LDS map");
typedef short s5_bf16x8 __attribute__((ext_vector_type(8)));
typedef float s5_f32x16 __attribute__((ext_vector_type(16)));

__device__ __forceinline__ void s5_apow(float lr, float li, float dt, int n, float& pr, float& pi) { const float m = expf(lr * dt * (float)n), th = li * dt * (float)n; pr = m * cosf(th); pi = m * sinf(th); }
__device__ __forceinline__ void s5_apow_fast(float lr, float li, float dt, int n, float& pr, float& pi) { const float m = __expf(lr * dt * (float)n), th = li * dt * (float)n; pr = m * __cosf(th); pi = m * __sinf(th); }
__device__ __forceinline__ void s5_zoh(float lr, float li, float dt, float& fr, float& fi) {
    float ar, ai; s5_apow(lr, li, dt, 1, ar, ai); const float den = lr * lr + li * li, nr = ar - 1.0f; fr = (nr * lr + ai * li) / den; fi = (ai * lr - nr * li) / den;
}
__device__ __forceinline__ void s5_tab_wst(int g, int jt, unsigned char* tab, const float* lam_re, const float* lam_im, const float* log_dt, const float* b_re, const float* b_im, int lane) {
    const int s = lane >> 3, cp = lane & 7; const float dt = expf(log_dt[g]);
    float zr, zi, mylr, myli;
    { const int p = (jt >> 1) * 32 + (lane & 31); mylr = lam_re[g * 64 + p]; myli = lam_im[g * 64 + p]; s5_zoh(mylr, myli, dt, zr, zi); }
#pragma unroll 4
    for (int r = 0; r < 32; ++r) { const int p = (jt >> 1) * 32 + r; const float lr = __shfl(mylr, r), li = __shfl(myli, r), fr = __shfl(zr, r), fi = __shfl(zi, r);
        float pr, pi; s5_apow_fast(lr, li, dt, 7 - s, pr, pi);
        float o[2];
#pragma unroll
        for (int e = 0; e < 2; ++e) { const int c = 2 * cp + e; const float br = b_re[((size_t)g * 64 + p) * 16 + c], bi = b_im[((size_t)g * 64 + p) * 16 + c];
            const float bbr = fr * br - fi * bi, bbi = fr * bi + fi * br; o[e] = (jt & 1) ? (pr * bbi + pi * bbr) : (pr * bbr - pi * bbi); }
        *(GAS unsigned*)(tab + S5_WST + (32 * jt + r) * S5_PITCH + (16 * s + 2 * cp) * 2) = pk2(o[0], o[1]); }
}
__device__ __forceinline__ void s5_tab_const(int g, float* ctab, const float* lam_re, const float* lam_im, const float* log_dt, int lane) {
    const float dt = expf(log_dt[g]); float xr, xi; s5_apow(lam_re[g * 64 + lane], lam_im[g * 64 + lane], dt, 1, xr, xi);
#pragma unroll
    for (int q = 0; q < 3; ++q) { const float nr = xr * xr - xi * xi, ni = 2.0f * xr * xi; xr = nr; xi = ni; }
    const float ar = xr, ai = xi;
#pragma unroll
    for (int q = 0; q < 5; ++q) { const float nr = xr * xr - xi * xi, ni = 2.0f * xr * xi; xr = nr; xi = ni; }
    *(GAS f32x4*)(ctab + ((size_t)g * 64 + lane) * 4) = (f32x4){ar, ai, xr, xi};
}
__device__ __forceinline__ void s5_tab_wyc(int g, int t, unsigned char* tab, const float* lam_re, const float* lam_im, const float* log_dt, const float* c_re, const float* c_im, int lane) {
    const int p = lane; const float dt = expf(log_dt[g]); float pr, pi; s5_apow_fast(lam_re[g * 64 + p], lam_im[g * 64 + p], dt, t + 1, pr, pi);
#pragma unroll
    for (int c = 0; c < 16; ++c) { const float cr = c_re[((size_t)g * 16 + c) * 64 + p], ci = c_im[((size_t)g * 16 + c) * 64 + p];
        *(GAS unsigned*)(tab + S5_WYC + (16 * t + c) * S5_PITCH + 4 * p) = pk2(cr * pr - ci * pi, -(cr * pi + ci * pr)); }
}
__device__ __forceinline__ void s5_tab_kt(int g, int d, unsigned char* tab, const float* lam_re, const float* lam_im, const float* log_dt, const float* b_re, const float* b_im, const float* c_re, const float* c_im,
                                          const float* dvec, int lane) {
    const float dt = expf(log_dt[g]); float mr, mi;
    { const float lr = lam_re[g * 64 + lane], li = lam_im[g * 64 + lane]; float pr, pi, fr, fi; s5_apow_fast(lr, li, dt, d, pr, pi); s5_zoh(lr, li, dt, fr, fi); mr = pr * fr - pi * fi; mi = pr * fi + pi * fr; }
    float acc[4] = {0.f, 0.f, 0.f, 0.f};
#pragma unroll 8
    for (int p = 0; p < 64; ++p) { const float pmr = __shfl(mr, p), pmi = __shfl(mi, p);
#pragma unroll
        for (int i = 0; i < 4; ++i) { const int e = lane + 64 * i, c = e >> 4, c2 = e & 15;
            const float br = b_re[((size_t)g * 64 + p) * 16 + c2], bi = b_im[((size_t)g * 64 + p) * 16 + c2], cr = c_re[((size_t)g * 16 + c) * 64 + p], ci = c_im[((size_t)g * 16 + c) * 64 + p];
            const float tr = pmr * br - pmi * bi, ti = pmr * bi + pmi * br; acc[i] += cr * tr - ci * ti; } }
#pragma unroll
    for (int i = 0; i < 4; ++i) { const int e = lane + 64 * i, c = e >> 4, c2 = e & 15; float v = acc[i]; if (d == 0 && c == c2) v += dvec[16 * g + c];
        *(GAS bf16*)(tab + S5_KT + (d + 1) * 512 + c * 32 + c2 * 2) = (bf16)f2bf(v);
        if (d == 0) *(GAS bf16*)(tab + S5_KT + c * 32 + c2 * 2) = (bf16)0; }
}

template <bool FINAL>
__device__ __forceinline__ void s5_unit(int g, int seg, const bf16* Ug, bf16* Yg, const unsigned char* tab, float* Ebuf, const float* ctab, LAS unsigned char* L) {
    int tid_ = threadIdx.x; asm volatile("" : "+v"(tid_));
    const int tid = tid_, lane = tid & 63, r32 = lane & 31, hi = lane >> 5, b = __builtin_amdgcn_readfirstlane(tid >> 6);
    { const int npc = (FINAL ? S5_TAB_BYTES : S5_WYC) / 1024; const unsigned l0 = (unsigned)(uintptr_t)(unsigned char*)L;
      for (int i = b; i < npc; i += NWAVES) attn_body::glds16(tab + (size_t)i * 1024 + lane * 16, (unsigned)__builtin_amdgcn_readfirstlane(l0 + i * 1024)); }
    const size_t tok0 = (size_t)g * TOK + (size_t)b * SEQ + (size_t)seg * 256;
    s5_bf16x8 A[8];
    { const bf16* up = Ug + (tok0 + 8 * r32) * 16 + 8 * hi;
#pragma unroll
      for (int s = 0; s < 8; ++s) A[s] = *(const GAS s5_bf16x8*)(up + s * 16); }
    float aLr[2], aLi[2], aSr[2], aSi[2];
#pragma unroll
    for (int k = 0; k < 2; ++k) { const f32x4 cv = *(const GAS f32x4*)(ctab + ((size_t)g * 64 + 32 * k + r32) * 4); aLr[k] = cv.x; aLi[k] = cv.y; aSr[k] = cv.z; aSi[k] = cv.w; }
    float cr[2] = {0.f, 0.f}, ci[2] = {0.f, 0.f};
    if (FINAL) {
        const float* eb = Ebuf + ((size_t)(b * NGRP + g) * 16) * 128;
        f32x2 ev[15][2];
#pragma unroll
        for (int j = 0; j < 15; ++j)
#pragma unroll
            for (int k = 0; k < 2; ++k) ev[j][k] = (j < seg) ? *(const GAS f32x2*)(eb + (size_t)j * 128 + 2 * (32 * k + r32)) : (f32x2){0.f, 0.f};
#pragma unroll
        for (int j = 0; j < 15; ++j) if (j < seg) {
#pragma unroll
            for (int k = 0; k < 2; ++k) { const float nr = aSr[k] * cr[k] - aSi[k] * ci[k] + ev[j][k].x, ni = aSr[k] * ci[k] + aSi[k] * cr[k] + ev[j][k].y; cr[k] = nr; ci[k] = ni; } }
    }
    asm volatile("s_waitcnt vmcnt(0)" ::: "memory");
    __syncthreads();
    s5_f32x16 S[4];
#pragma unroll
    for (int j = 0; j < 4; ++j) { S[j] = s5_f32x16{};
#pragma unroll
        for (int s = 0; s < 8; ++s) { const s5_bf16x8 bf = *(const LAS s5_bf16x8*)(L + S5_WST + (32 * j + r32) * S5_PITCH + (16 * s + 8 * hi) * 2);
            S[j] = __builtin_amdgcn_mfma_f32_32x32x16_bf16(A[s], bf, S[j], 0, 0, 0); } }
    if (!FINAL) {
        float e_r[2], e_i[2];
#pragma unroll
        for (int k = 0; k < 2; ++k) { const float a2r = aLr[k] * aLr[k] - aLi[k] * aLi[k], a2i = 2.0f * aLr[k] * aLi[k], a4r = a2r * a2r - a2i * a2i, a4i = 2.0f * a2r * a2i;
            const float a5r = a4r * aLr[k] - a4i * aLi[k], a5i = a4r * aLi[k] + a4i * aLr[k];
            float xr = S[2 * k][0], xi = S[2 * k + 1][0];
#pragma unroll
            for (int reg = 1; reg < 16; ++reg) { const float mr = ((reg & 3) == 0) ? a5r : aLr[k], mi = ((reg & 3) == 0) ? a5i : aLi[k];
                const float nr = mr * xr - mi * xi + S[2 * k][reg], ni = mr * xi + mi * xr + S[2 * k + 1][reg]; xr = nr; xi = ni; }
            const float fr_ = hi ? xr : (a4r * xr - a4i * xi), fi_ = hi ? xi : (a4r * xi + a4i * xr);
            e_r[k] = fr_ + __shfl_xor(fr_, 32); e_i[k] = fi_ + __shfl_xor(fi_, 32); }
        if (hi == 0) { float* eb = Ebuf + ((size_t)(b * NGRP + g) * 16 + seg) * 128;
#pragma unroll
            for (int k = 0; k < 2; ++k) *(GAS f32x2*)(eb + 2 * (32 * k + r32)) = (f32x2){e_r[k], e_i[k]}; }
    } else {
        LAS unsigned char* XS = L + S5_XS + b * S5_XS_BYTES;
#pragma unroll
        for (int i = 0; i < 8; ++i) { const bool own = ((i & 1) == hi);
            if (own) {
#pragma unroll
                for (int q = 0; q < 4; ++q) { const int reg = 4 * (i >> 1) + q, chunk = 4 * i + q;
#pragma unroll
                    for (int k = 0; k < 2; ++k) { *(LAS unsigned*)(XS + chunk * S5_PITCH + 4 * (32 * k + r32)) = pg8::cvt_pk_bf16(cr[k], ci[k]);
                        const float nr = aLr[k] * cr[k] - aLi[k] * ci[k] + S[2 * k][reg], ni = aLr[k] * ci[k] + aLi[k] * cr[k] + S[2 * k + 1][reg]; cr[k] = nr; ci[k] = ni; } } }
#pragma unroll
            for (int k = 0; k < 2; ++k) { const float orr = __shfl_xor(cr[k], 32), oi = __shfl_xor(ci[k], 32); cr[k] = own ? cr[k] : orr; ci[k] = own ? ci[k] : oi; } }
        s5_bf16x8 Xf[8];
#pragma unroll
        for (int kk = 0; kk < 8; ++kk) Xf[kk] = *(const LAS s5_bf16x8*)(XS + r32 * S5_PITCH + (16 * kk + 8 * hi) * 2);
        s5_f32x16 Yc[4];
#pragma unroll
        for (int j = 0; j < 4; ++j) { Yc[j] = s5_f32x16{};
#pragma unroll
            for (int s = 0; s < 8; ++s) if (s <= 2 * j + 1) { const int d1 = 2 * j + (r32 >> 4) - s + 1;
                const s5_bf16x8 bf = *(const LAS s5_bf16x8*)(L + S5_KT + d1 * 512 + (r32 & 15) * 32 + 16 * hi);
                Yc[j] = __builtin_amdgcn_mfma_f32_32x32x16_bf16(A[s], bf, Yc[j], 0, 0, 0); }
#pragma unroll
            for (int kk = 0; kk < 8; ++kk) { const s5_bf16x8 bf = *(const LAS s5_bf16x8*)(L + S5_WYC + (32 * j + r32) * S5_PITCH + (16 * kk + 8 * hi) * 2);
                Yc[j] = __builtin_amdgcn_mfma_f32_32x32x16_bf16(Xf[kk], bf, Yc[j], 0, 0, 0); } }
        asm volatile("s_waitcnt lgkmcnt(0)" ::: "memory");
#pragma unroll
        for (int j = 0; j < 4; ++j)
#pragma unroll
            for (int reg = 0; reg < 16; reg += 2) { const pg8::f32x2 ge = pg8::gelu_pk((pg8::f32x2){Yc[j][reg], Yc[j][reg + 1]});
                const int chunk = (reg & 3) + 8 * (reg >> 2) + 4 * hi, tokl = 8 * chunk + 2 * j + (r32 >> 4), c = r32 & 15;
                const unsigned gw_ = pg8::cvt_pk_bf16(ge.x, ge.y); *(LAS bf16*)(XS + tokl * 32 + c * 2) = (bf16)(gw_ & 0xffffu); *(LAS bf16*)(XS + (tokl + 8) * 32 + c * 2) = (bf16)(gw_ >> 16); }
        asm volatile("s_waitcnt lgkmcnt(0)" ::: "memory");
        bf16* yo = Yg + tok0 * 16;
#pragma unroll
        for (int i = 0; i < 8; ++i) { const int pc = lane + 64 * i; const v4u w = *(const LAS v4u*)(XS + 16 * pc); *(GAS v4u*)(yo + 8 * pc) = w; }
    }
    __syncthreads();
}

#ifndef MK_ONE_LAUNCH
#define MK_ONE_LAUNCH 1
#endif
constexpr int N_PHASES = 14;
struct Args { const float* in[23]; float* out; unsigned char* ws; int ph_lo, ph_hi; };

#ifndef PROBE_P0
#define PROBE_P0 0
#endif
#define P0_ITEM(it) do { \
            int r = it; \
            if (r < I_TKT) { s5_tab_kt(r >> 3, r & 7, S5TAB + (size_t)(r >> 3) * S5_TAB_BYTES, args.in[6], args.in[7], args.in[8], args.in[9], args.in[10], args.in[11], args.in[12], args.in[13], lane); break; } r -= I_TKT; \
            if (r < I_TST) { s5_tab_wst(r >> 2, r & 3, S5TAB + (size_t)(r >> 2) * S5_TAB_BYTES, args.in[6], args.in[7], args.in[8], args.in[9], args.in[10], lane); break; } r -= I_TST; \
            if (r < I_TYC) { s5_tab_wyc(r >> 3, r & 7, S5TAB + (size_t)(r >> 3) * S5_TAB_BYTES, args.in[6], args.in[7], args.in[8], args.in[11], args.in[12], lane); break; } r -= I_TYC; \
            if (r < I_TCO) { s5_tab_const(r, S5C, args.in[6], args.in[7], args.in[8], lane); break; } r -= I_TCO; \
            if (r < I_SQ) { p0_matrix_item(args.in[5], 1024, 1024, WIN0, mixg, 0, r, scr, lane); break; } r -= I_SQ; \
            if (r < I_MKV) { p0_matrix_item(args.in[3], 1024, 512, WMKV, args.in[2], 0, r, scr, lane); break; } r -= I_MKV; \
            if (r < I_GLU) { p0_matrix_item(args.in[14], 768, 768, WGLU, nullptr, 0, r, scr, lane); break; } r -= I_GLU; \
            if (r < I_IN1) { p0_matrix_item(args.in[16], 1024, 2560, WIN1, mixg + 1024, 0, r, scr, lane); break; } r -= I_IN1; \
            if (r < I_SQ) { p0_matrix_item(args.in[17], 1024, 1024, WOUT0, nullptr, 0, r, scr, lane); break; } r -= I_SQ; \
            if (r < I_SQ) { p0_matrix_item(args.in[17] + 1024 * 1024, 1024, 1024, WOUT1, nullptr, 0, r, scr, lane); break; } r -= I_SQ; \
            if (r < I_GU) { p0_matrix_item(args.in[19], 1024, FFN, WGU0, ffng, 1, r, scr, lane); break; } r -= I_GU; \
            if (r < I_GU) { p0_matrix_item(args.in[20], 1024, FFN, WGU0, ffng, 2, r, scr, lane); break; } r -= I_GU; \
            if (r < I_GU) { p0_matrix_item(args.in[19] + (size_t)1024 * FFN, 1024, FFN, WGU1, ffng + 1024, 1, r, scr, lane); break; } r -= I_GU; \
            if (r < I_GU) { p0_matrix_item(args.in[20] + (size_t)1024 * FFN, 1024, FFN, WGU1, ffng + 1024, 2, r, scr, lane); break; } r -= I_GU; \
            if (r < I_DN) { p0_matrix_item(args.in[21], FFN, 1024, WDN0, nullptr, 0, r, scr, lane); break; } r -= I_DN; \
            p0_matrix_item(args.in[21] + (size_t)FFN * 1024, FFN, 1024, WDN1, nullptr, 0, r, scr, lane); \
        } while (0)
__global__ void __launch_bounds__(NWAVES * 64, 2) mega_fwd(Args args) {
    extern __shared__ __attribute__((aligned(16))) unsigned char lds[];
    LAS unsigned char* L = (LAS unsigned char*)lds;
    volatile LAS unsigned* MISC = (volatile LAS unsigned*)(L + MISC_OFF);
    const int tid = threadIdx.x, lane = tid & 63, wave = __builtin_amdgcn_readfirstlane(tid >> 6);
    const int G = gridDim.x; const int bx = blockIdx.x;
    const int vcu = (G % 8 == 0) ? (bx % 8) * (G / 8) + bx / 8 : bx;
    const int gw = vcu * NWAVES + wave, NGW = G * NWAVES;
    unsigned char* ws = args.ws;
    gu32* ctl = (gu32*)(ws + WS_CTL);
    for (int u = tid; u < (LDS_BYTES - LDSCTL_OFF) / 4; u += NWAVES * 64) ((LAS unsigned*)(L + LDSCTL_OFF))[u] = 0u;
    __syncthreads();
    XcdBarrier bar; bar.bar = (unsigned*)(ctl + CW_BAR); bar.x = 0; bar.st = nullptr;
    if (MK_ONE_LAUNCH) bar = xcd_barrier_post((unsigned*)(ctl + CW_BAR), MISC + 8);
#define MEMATTN_PHASE(u0_, us_) do { for (int un = (u0_); un < BATCH * MHEAD * NBLK; un += (us_)) { const int b_ = un >> 6, h_ = (un >> 4) & 3, qb_ = un & 15; const size_t qrow_ = (size_t)b_ * SEQ + (size_t)qb_ * 256; \
        attn_body::attn_unit<0, 8, 256, 256, 1024>((const attn_body::bf16*)(QM + qrow_ * 256 + h_ * 64), (const attn_body::bf16*)(MEMK + (size_t)b_ * MEML * 256 + h_ * 64), (const attn_body::bf16*)(MEMV + (size_t)b_ * MEML * 256 + h_ * 64), \
            (attn_body::bf16*)(MIX + qrow_ * 1024 + 768 + h_ * 64), 4, 0.f, nullptr, nullptr, 0, (char*)lds + RING_OFF); } } while (0)
    const int lo = args.ph_lo, hi = args.ph_hi;
#ifndef PROBE_DUP
#define PROBE_DUP -1
#endif
#define IN(k) (lo <= (k) && (k) < hi)
#define PH_REP(k) for (int rep_ = 0; rep_ < ((PROBE_DUP == (k)) ? 2 : 1); ++rep_)
#define SEAM(k) do { if (IN(k) && IN((k) + 1)) xcd_barrier(bar); } while (0)

    const float* x = args.in[0]; const float* mem = args.in[1];
    float* out = args.out;
    float* SS0 = (float*)(ws + WS_SS0); float* SSA = (float*)(ws + WS_SSA); float* SSB = (float*)(ws + WS_SSB); float* SSM = (float*)(ws + WS_SSM);
    unsigned char* S5TAB = ws + WS_S5TAB; float* S5E = (float*)(ws + WS_S5E); float* S5C = (float*)(ws + WS_S5TAB + (size_t)NGRP * S5_TAB_BYTES);
    float* KMP = (float*)(ws + WS_KMEAN);
    bf16* WIN0 = (bf16*)(ws + WS_WIN0); bf16* WGLU = (bf16*)(ws + WS_WGLU); bf16* WIN1 = (bf16*)(ws + WS_WIN1);
    bf16* WOUT0 = (bf16*)(ws + WS_WOUT0); bf16* WOUT1 = (bf16*)(ws + WS_WOUT1);
    bf16* WGU0 = (bf16*)(ws + WS_WGU0); bf16* WGU1 = (bf16*)(ws + WS_WGU1); bf16* WDN0 = (bf16*)(ws + WS_WDN0); bf16* WDN1 = (bf16*)(ws + WS_WDN1); bf16* WMKV = (bf16*)(ws + WS_WMKV);
    bf16* MEMB = (bf16*)(ws + WS_MEMB); bf16* MEMK = (bf16*)(ws + WS_MEMK); bf16* MEMV = (bf16*)(ws + WS_MEMV);
    bf16* XB = (bf16*)(ws + WS_XB); bf16* Ub = (bf16*)(ws + WS_U); bf16* Yb = (bf16*)(ws + WS_Y);
    bf16* Q1 = (bf16*)(ws + WS_Q1); bf16* K1 = (bf16*)(ws + WS_K1); bf16* V1 = (bf16*)(ws + WS_V1);
    bf16* QM = (bf16*)(ws + WS_QM); bf16* MIX = (bf16*)(ws + WS_MIX); bf16* Hb = (bf16*)(ws + WS_H);

    LAS float* scr = (LAS float*)(L + RING_OFF + wave * 16384);
    constexpr int I_SQ = 16 * 32, I_GLU = 12 * 24, I_IN1 = 16 * 80, I_GU = 16 * 88, I_DN = 44 * 32, I_MKV = 16 * 16;
    constexpr int I_TKT = NGRP * 8, I_TST = NGRP * 4, I_TYC = NGRP * 8, I_TCO = NGRP;
    constexpr int N_EARLY = I_TKT + I_TST + I_TYC + I_TCO + I_SQ + I_MKV;
    constexpr int NITEMS = I_TKT + I_TST + I_TYC + I_TCO + I_SQ + I_GLU + I_IN1 + 2 * I_SQ + 4 * I_GU + 2 * I_DN + I_MKV;
    const float* mixg = args.in[4]; const float* ffng = args.in[18];
    if (IN(0)) PH_REP(0) {
        if (rep_) xcd_barrier(bar);
        for (int it = gw; it < N_EARLY; it += NGW) P0_ITEM(it);
        for (int m = 4 * gw; m < TOK; m += 4 * NGW) rows_to_bf16_ssq<4>(x + (size_t)m * DM, XB + (size_t)m * DM, SS0 + (size_t)m * 16, lane);
        for (int m = gw; m < BATCH * MEML; m += NGW) rows_to_bf16_ssq<1>(mem + (size_t)m * DM, MEMB + (size_t)m * DM, SSM + (size_t)m * 16, lane);
    }
    SEAM(0);
    if (IN(1)) PH_REP(1) {
        if (rep_) xcd_barrier(bar);
        { pg8::Gemm g{XB, WIN0, TOK, 1024, 1024, 0}; pg8::StaticOrder S; S.init(TOK, 1024, G, bx);
          pg8::EpiProj E{SS0, Ub, 0, 3, 1, TOKW, 1.0f, QM, C2, TOK, nullptr, -1};
          pg8::gemm_phase<pg8::EpiProj, pg8::StaticOrder, true, true>(L + RING_OFF, g, S, E); }
    }
    SEAM(1);
    if (IN(2)) PH_REP(2) {
        if (rep_) xcd_barrier(bar);
        const int nS5 = (G == 256) ? 240 : G;
        if (bx < nS5) { for (int un = bx; un < NGRP * 16; un += nS5) s5_unit<false>(un >> 4, un & 15, Ub, Yb, S5TAB + (size_t)(un >> 4) * S5_TAB_BYTES, S5E, S5C, L + RING_OFF);
            for (int it = N_EARLY + bx * NWAVES + wave; it < NITEMS; it += nS5 * NWAVES) P0_ITEM(it); }
        if (G != 256 || bx >= nS5) { pg8::Gemm g{MEMB, WMKV, BATCH * MEML, 512, 1024, 0}; pg8::StaticOrder S; S.init(BATCH * MEML, 512, (G == 256) ? 16 : G, (G == 256) ? bx - nS5 : bx);
          pg8::EpiProj E{SSM, MEMK, (size_t)(WS_MEMV - WS_MEMK) / 2, 1, 2, 256, 1.0f, nullptr, 1.0f, 0, nullptr, -1};
          pg8::gemm_phase<pg8::EpiProj, pg8::StaticOrder, true, true>(L + RING_OFF, g, S, E); }
    }
    SEAM(2);
    if (IN(3)) PH_REP(3) {
        if (rep_) xcd_barrier(bar);
        for (int un = vcu; un < NGRP * 16; un += G) s5_unit<true>(un >> 4, un & 15, Ub, Yb, S5TAB + (size_t)(un >> 4) * S5_TAB_BYTES, S5E, S5C, L + RING_OFF);
    }
    SEAM(3);
    if (IN(4)) PH_REP(4) {
        if (rep_) xcd_barrier(bar);
        pg8::Gemm g{Yb, WGLU, TOK, TOKW, TOKW, 1}; pg8::StaticOrder S; S.init(TOK, TOKW, G, bx);
        pg8::EpiGlu E{Yb, TOKW, args.in[15], MIX, 1024, TOK};
        pg8::gemm_phase<pg8::EpiGlu, pg8::StaticOrder, true, true>(L + RING_OFF, g, S, E);
        if (G == 256) { if (bx >= 128) MEMATTN_PHASE(bx - 128, 128); }
        else MEMATTN_PHASE(vcu, G);
    }
    SEAM(4);
    if (IN(5)) PH_REP(5) {
        if (rep_) xcd_barrier(bar);
        pg8::Gemm g{MIX, WOUT0, TOK, 1024, 1024, 0}; pg8::StaticOrder S; S.init(TOK, 1024, G, bx);
        pg8::EpiRes E{x, nullptr, XB, SSA};
        pg8::gemm_phase<pg8::EpiRes, pg8::StaticOrder, true, true>(L + RING_OFF, g, S, E);
    }
    SEAM(5);
    if (IN(6)) PH_REP(6) {
        if (rep_) xcd_barrier(bar);
        pg8::Gemm g{XB, WGU0, TOK, 2 * FFN, 1024, 0}; pg8::StaticOrder S; S.init(TOK, 2 * FFN, G, bx);
        pg8::EpiGU E{SSA, Hb, FFN};
        pg8::gemm_phase<pg8::EpiGU, pg8::StaticOrder, true, true>(L + RING_OFF, g, S, E);
    }
    SEAM(6);
    if (IN(7)) PH_REP(7) {
        if (rep_) xcd_barrier(bar);
        pg8::Gemm g{Hb, WDN0, TOK, 1024, FFN, 0}; pg8::StaticOrder S; S.init(TOK, 1024, G, bx);
        pg8::EpiRes E{nullptr, XB, XB, SSB};
        pg8::gemm_phase<pg8::EpiRes, pg8::StaticOrder, true, true>(L + RING_OFF, g, S, E);
    }
    SEAM(7);
    if (IN(8)) PH_REP(8) {
        if (rep_) xcd_barrier(bar);
        pg8::Gemm g{XB, WIN1, TOK, 2560, 1024, 0}; pg8::StaticOrder S; S.init(TOK, 2560, G, bx);
        pg8::EpiProj E{SSB, Q1, (size_t)(WS_K1 - WS_Q1) / 2, 3, 3, TOKW, C2, QM, C2, 0, KMP, 1};
        pg8::gemm_phase<pg8::EpiProj, pg8::StaticOrder, true, true>(L + RING_OFF, g, S, E);
    }
    SEAM(8);
    if (IN(9)) PH_REP(9) {
        if (rep_) xcd_barrier(bar);
        for (int p_ = vcu; p_ < BATCH * NHEAD * 8; p_ += G) { const int bh_ = p_ >> 3, sg_ = p_ & 7, b_ = bh_ / NHEAD, h_ = bh_ - b_ * NHEAD;
            const float slope2 = __builtin_amdgcn_exp2f(-8.0f * (float)(h_ + 1) / 12.0f) * LOG2E;
#pragma unroll 1
            for (int k_ = 0; k_ < 2; ++k_) { const int qb_ = k_ ? 15 - sg_ : sg_; const size_t qrow_ = (size_t)b_ * SEQ + (size_t)qb_ * 256, krow_ = (size_t)b_ * SEQ;
                attn_body::attn_unit<1, 8, 768, 768, 1024>((const attn_body::bf16*)(Q1 + qrow_ * TOKW + h_ * 64), (const attn_body::bf16*)(K1 + krow_ * TOKW + h_ * 64), (const attn_body::bf16*)(V1 + krow_ * TOKW + h_ * 64),
                    (attn_body::bf16*)(MIX + qrow_ * 1024 + h_ * 64), 4 * qb_ + 4, slope2, KMP + (size_t)bh_ * 1024, KMP + (size_t)(8 * 12 * 16 * 64) + (size_t)bh_ * 1024, qb_, (char*)lds + RING_OFF); } }
        MEMATTN_PHASE(vcu, G);
    }
    SEAM(9);
    if (IN(10)) PH_REP(10) {
        if (rep_) xcd_barrier(bar);
        pg8::Gemm g{MIX, WOUT1, TOK, 1024, 1024, 0}; pg8::StaticOrder S; S.init(TOK, 1024, G, bx);
        pg8::EpiRes E{nullptr, XB, XB, SSA};
        pg8::gemm_phase<pg8::EpiRes, pg8::StaticOrder, true, true>(L + RING_OFF, g, S, E);
    }
    SEAM(10);
    if (IN(11)) PH_REP(11) {
        if (rep_) xcd_barrier(bar);
        pg8::Gemm g{XB, WGU1, TOK, 2 * FFN, 1024, 0}; pg8::StaticOrder S; S.init(TOK, 2 * FFN, G, bx);
        pg8::EpiGU E{SSA, Hb, FFN};
        pg8::gemm_phase<pg8::EpiGU, pg8::StaticOrder, true, true>(L + RING_OFF, g, S, E);
    }
    SEAM(11);
    if (IN(12)) PH_REP(12) {
        if (rep_) xcd_barrier(bar);
        pg8::Gemm g{Hb, WDN1, TOK, 1024, FFN, 0}; pg8::StaticOrder S; S.init(TOK, 1024, G, bx);
        pg8::EpiRes E{nullptr, XB, XB, SSB};
        pg8::gemm_phase<pg8::EpiRes, pg8::StaticOrder, true, true>(L + RING_OFF, g, S, E);
    }
    SEAM(12);
    if (IN(13)) PH_REP(13) {
        if (rep_) xcd_barrier(bar);
        const float* gf = args.in[22];
        const GAS f32x4* gp = (const GAS f32x4*)gf + 4 * lane; const f32x4 g0 = gp[0], g1 = gp[1], g2 = gp[2], g3 = gp[3];
        for (int m0 = 4 * gw; m0 < TOK; m0 += 4 * NGW) {
            v4u q[4][2]; f32x4 sq[4];
#pragma unroll
            for (int r = 0; r < 4; ++r) { const GAS v4u* xr = (const GAS v4u*)(XB + (size_t)(m0 + r) * DM) + 2 * lane; q[r][0] = xr[0]; q[r][1] = xr[1];
                sq[r] = *(const GAS f32x4*)(SSB + (size_t)(m0 + r) * 16 + 4 * (lane & 3)); }
#pragma unroll
            for (int r = 0; r < 4; ++r) { float s = (sq[r].x + sq[r].y) + (sq[r].z + sq[r].w); s += __shfl_xor(s, 1); s += __shfl_xor(s, 2);
                const float rs = __builtin_amdgcn_rsqf(s * (1.0f / 1024.0f) + 1e-6f);
                GAS f32x4* orow = (GAS f32x4*)(out + (size_t)(m0 + r) * DM) + 4 * lane; const v4u q0 = q[r][0], q1 = q[r][1];
                orow[0] = (f32x4){bflo(q0.x), bfhi(q0.x), bflo(q0.y), bfhi(q0.y)} * rs * g0; orow[1] = (f32x4){bflo(q0.z), bfhi(q0.z), bflo(q0.w), bfhi(q0.w)} * rs * g1;
                orow[2] = (f32x4){bflo(q1.x), bfhi(q1.x), bflo(q1.y), bfhi(q1.y)} * rs * g2; orow[3] = (f32x4){bflo(q1.z), bfhi(q1.z), bflo(q1.w), bfhi(q1.w)} * rs * g3; }
        }
    }
#undef IN
#undef SEAM
}

extern "C" void kernel_launch(void* const* d_in, const int* in_sizes, int n_in, void* d_out, int out_size, void* d_ws, size_t ws_size, hipStream_t stream) {
    static int grid = 0;
    if (grid == 0) {
        if (n_in != 23 || out_size != TOK * DM || ws_size < WS_END) { fprintf(stderr, "kernel_launch: unexpected shapes: n_in %d out %d ws %zu\n", n_in, out_size, ws_size); grid = -1; return; }
        int dev = 0, cus = 0, per_cu = 0;
        if (hipGetDevice(&dev) != hipSuccess || hipDeviceGetAttribute(&cus, hipDeviceAttributeMultiprocessorCount, dev) != hipSuccess) { grid = -1; return; }
        if (hipFuncSetAttribute((const void*)mega_fwd, hipFuncAttributeMaxDynamicSharedMemorySize, LDS_BYTES) != hipSuccess) { fprintf(stderr, "kernel_launch: hipFuncSetAttribute failed\n"); grid = -1; return; }
        if (hipOccupancyMaxActiveBlocksPerMultiprocessor(&per_cu, (const void*)mega_fwd, NWAVES * 64, LDS_BYTES) != hipSuccess || per_cu < 1)
            fprintf(stderr, "kernel_launch: occupancy query reports %d workgroups per CU\n", per_cu);
        (void)hipGetLastError();
        grid = cus;
    }
    if (grid < 0) return;
    if (hipMemsetAsync((char*)d_ws + WS_CTL, 0, CTL_ZERO_BYTES, stream) != hipSuccess) return;
    Args a{};
    for (int i = 0; i < 23; ++i) a.in[i] = (const float*)d_in[i];
    a.out = (float*)d_out; a.ws = (unsigned char*)d_ws;
#if MK_ONE_LAUNCH
    a.ph_lo = 0; a.ph_hi = N_PHASES;
    hipLaunchKernelGGL(mega_fwd, dim3(grid), dim3(NWAVES * 64), LDS_BYTES, stream, a);
#else
    for (int p = 0; p < N_PHASES; ++p) { a.ph_lo = p; a.ph_hi = p + 1; hipLaunchKernelGGL(mega_fwd, dim3(grid), dim3(NWAVES * 64), LDS_BYTES, stream, a); }
#endif
}
```

```cpp
#include <hip/hip_runtime.h>
#include <hip/hip_bf16.h>
#include <cstdio>
#include <cstdint>
#include <cmath>
namespace pg8 {
#define PG8_LAS __attribute__((address_space(3)))
typedef unsigned short bf16_t;
typedef short bf16x8 __attribute__((ext_vector_type(8)));
typedef float f32x4 __attribute__((ext_vector_type(4)));
typedef unsigned u32x4 __attribute__((ext_vector_type(4)));
constexpr int BM = 256, BK = 64, HALF = 128, HTB = HALF * BK * 2  , STAGE_BYTES = 8 * HTB, NXCD = 8, WGM = 8;

__host__ __device__ __forceinline__ int lds_byte(int r, int c) { const int st = (r >> 4) * 2 + (c >> 5), rr = r & 15, cc = c & 31, ob = rr * 64 + cc * 2; return st * 1024 + (ob ^ (((ob >> 9) & 1) << 5)); }
__host__ __device__ __forceinline__ void stage_rc(int b, int& R, int& C) { const int st = b / 1024, sb = b % 1024, swz = sb ^ (((sb >> 9) & 1) << 5); R = (st >> 1) * 16 + swz / 64; C = (st & 1) * 32 + (swz % 64) / 2; }
__host__ __device__ __forceinline__ int perm32(int rho) { const int n = rho >> 4, i = rho & 15; return 8 * (i >> 2) + 4 * n + (i & 3); }

struct Unit { int pm, pn; };
struct Gemm { const bf16_t* A; const bf16_t* Bt; int M, N, K, amode; };

struct StaticOrder {
    int nM, nN, nwg, G, c;
    __host__ __device__ void init(int M, int N, int G_, int c_) { nM = M / BM; nN = N / BM; nwg = nM * nN; G = G_; c = c_; }
    __host__ __device__ bool next(int i, Unit& u) const {
        const long L = (long)i * G + c; if (L >= nwg) return false;
        int wgid = (int)L; { const int q = nwg / NXCD, r = nwg % NXCD, xcd = wgid % NXCD, off = wgid / NXCD; wgid = (xcd < r ? xcd * (q + 1) : r * (q + 1) + (xcd - r) * q) + off; }
        const int nig = WGM * nN, gid = wgid / nig, fm = gid * WGM, gsz = (nM - fm) < WGM ? (nM - fm) : WGM;
        u.pm = fm + ((wgid % nig) % gsz); u.pn = (wgid % nig) / gsz; return true;
    }
    __device__ __forceinline__ void a_ready(const Unit&) const {}
    __device__ __forceinline__ void done(const Unit&) const {}
};

__device__ __forceinline__ unsigned cvt_pk_bf16(float lo, float hi) { unsigned r; asm volatile("v_cvt_pk_bf16_f32 %0, %1, %2" : "=v"(r) : "v"(lo), "v"(hi)); return r; }
typedef float f32x2 __attribute__((ext_vector_type(2)));
typedef unsigned u32x2 __attribute__((ext_vector_type(2)));
constexpr float RMS_EPS = 1e-6f;
__device__ __forceinline__ float row_rstd(const float* ssq, int row) {
    const f32x4* p = (const f32x4*)(ssq + (size_t)row * 16);
    const f32x4 a = p[0], b = p[1], c = p[2], d = p[3];
    const float s = (((a[0] + a[1]) + (a[2] + a[3])) + ((b[0] + b[1]) + (b[2] + b[3]))) + (((c[0] + c[1]) + (c[2] + c[3])) + ((d[0] + d[1]) + (d[2] + d[3])));
    return __builtin_amdgcn_rsqf(s * (1.0f / 1024.0f) + RMS_EPS);
}
__device__ __forceinline__ float bf2f(unsigned short h) { return __uint_as_float(((unsigned)h) << 16); }
__device__ __forceinline__ float bflo(unsigned w) { return __uint_as_float(w << 16); }
__device__ __forceinline__ float bfhi(unsigned w) { return __uint_as_float(w & 0xffff0000u); }

__device__ __forceinline__ f32x2 gelu_pk(f32x2 v) {
    const f32x2 av = __builtin_elementwise_abs(v), d = av * 0.2316418882f + 1.0f;
    f32x2 t; t.x = __builtin_amdgcn_rcpf(d.x); t.y = __builtin_amdgcn_rcpf(d.y);
    f32x2 q = t * 0.5307027145f + (-0.7265760135f); q = q * t + 0.7107068705f; q = q * t + (-0.142248368f); q = q * t + 0.127414796f; q = q * t;
    const f32x2 s = (v * v) * (-0.72134752044f);
    f32x2 e; e.x = __builtin_amdgcn_exp2f(s.x); e.y = __builtin_amdgcn_exp2f(s.y);
    const f32x2 m = v * (q * e), r = v - m;
    f32x2 o; o.x = v.x < 0.f ? m.x : r.x; o.y = v.y < 0.f ? m.y : r.y; return o;
}

__device__ __forceinline__ void row_rstd4x8(const float* ssq, int row0, int fq, float sc, float (&rs)[2][4]) {
    f32x4 a[2][4];
#pragma unroll
    for (int ai = 0; ai < 2; ++ai)
#pragma unroll
        for (int m = 0; m < 4; ++m) a[ai][m] = *(const __attribute__((address_space(1))) f32x4*)(ssq + (size_t)(row0 + ai * HALF + m * 16) * 16 + 4 * fq);
#pragma unroll
    for (int ai = 0; ai < 2; ++ai)
#pragma unroll
        for (int m = 0; m < 4; ++m) { float s = (a[ai][m][0] + a[ai][m][1]) + (a[ai][m][2] + a[ai][m][3]); s += __shfl_xor(s, 16); s += __shfl_xor(s, 32);
            rs[ai][m] = __builtin_amdgcn_rsqf(s * (1.0f / 1024.0f) + RMS_EPS) * sc; }
}
struct EpiProj {
    static constexpr bool PERM = true, AFTER_DRAIN = false, RSTD = true;
    const float* ssq; bf16_t* base; size_t seg_stride; int tps, nseg, ldc; float scale0; bf16_t* qm; float scale_qm; int gm_rows;
    float* kmp; int kseg;
    __device__ __forceinline__ void operator()(const f32x4 (&acc)[2][2][4][2], const Unit& u, int wr, int wc, int fr, int fq, const PG8_LAS float* rsl) const {
        const int seg = u.pn / tps, within = u.pn - seg * tps;
        bf16_t* o; int ld, colt; float sc;
        if (seg < nseg) { o = base + (size_t)seg * seg_stride; ld = ldc; colt = within * BM; sc = (seg == 0) ? scale0 : 1.0f; }
        else { o = qm; ld = 256; colt = 0; sc = scale_qm; }
        const int row0 = u.pm * BM + wr * 64 + fr, col0 = colt + wc * 32 + 8 * fq;
        f32x4 cs[2][2] = {{{0.f, 0.f, 0.f, 0.f}, {0.f, 0.f, 0.f, 0.f}}, {{0.f, 0.f, 0.f, 0.f}, {0.f, 0.f, 0.f, 0.f}}};
        float rsv[2][4];
#pragma unroll
        for (int ai = 0; ai < 2; ++ai)
#pragma unroll
            for (int m = 0; m < 4; ++m) rsv[ai][m] = rsl[ai * 64 + 16 * m + fr] * sc;
#pragma unroll
        for (int ai = 0; ai < 2; ++ai)
#pragma unroll
            for (int m = 0; m < 4; ++m) { const int row = row0 + ai * HALF + m * 16; const float rs = rsv[ai][m]; bf16_t* rowp = o + (size_t)row * ld + col0;
                const bool gm = (gm_rows != 0) && (seg < nseg);
#pragma unroll
                for (int bj = 0; bj < 2; ++bj) { const f32x4 v0 = acc[ai][bj][m][0] * rs, v1 = acc[ai][bj][m][1] * rs;
                    u32x4 w; w.x = cvt_pk_bf16(v0[0], v0[1]); w.y = cvt_pk_bf16(v0[2], v0[3]); w.z = cvt_pk_bf16(v1[0], v1[1]); w.w = cvt_pk_bf16(v1[2], v1[3]);
                    const int cc = col0 + bj * HALF;
                    bf16_t* dst = gm ? (o + ((size_t)(cc >> 4) * gm_rows + row) * 16 + (cc & 15)) : (rowp + bj * HALF);
                    *(u32x4*)dst = w; cs[bj][0] += v0; cs[bj][1] += v1; } }
        if (seg == kseg) {
#pragma unroll
            for (int bj = 0; bj < 2; ++bj)
#pragma unroll
                for (int n = 0; n < 2; ++n)
#pragma unroll
                    for (int e = 0; e < 4; ++e) { float s = cs[bj][n][e]; s += __shfl_xor(s, 1); s += __shfl_xor(s, 2); s += __shfl_xor(s, 4); s += __shfl_xor(s, 8); cs[bj][n][e] = s; }
            if (fr == 0) { const int bb = u.pm >> 4, blk = u.pm & 15;
#pragma unroll
                for (int bj = 0; bj < 2; ++bj) { const int cc = col0 + bj * HALF, h = cc >> 6, d = cc & 63;
                    float* kd = kmp + (size_t)wr * (8 * 12 * 16 * 64) + ((size_t)((bb * 12 + h) * 16 + blk)) * 64 + d;
                    *(__attribute__((address_space(1))) f32x4*)kd = cs[bj][0]; *(__attribute__((address_space(1))) f32x4*)(kd + 4) = cs[bj][1]; } }
        }
    }
};
struct EpiGlu {
    static constexpr bool PERM = true, AFTER_DRAIN = false, RSTD = false;
    const bf16_t* Y; int ldy; const float* bias; bf16_t* mix; int ldm; int ygm_rows;
    __device__ __forceinline__ void operator()(const f32x4 (&acc)[2][2][4][2], const Unit& u, int wr, int wc, int fr, int fq, const PG8_LAS float* rsl) const {
        const int row0 = u.pm * BM + wr * 64 + fr, col0 = u.pn * BM + wc * 32 + 8 * fq;
        f32x4 bv[2][2];
#pragma unroll
        for (int bj = 0; bj < 2; ++bj)
#pragma unroll
            for (int n = 0; n < 2; ++n) bv[bj][n] = *(const f32x4*)(bias + col0 + bj * HALF + 4 * n);
#pragma unroll
        for (int ai = 0; ai < 2; ++ai) {
            u32x4 yq[4][2];
#pragma unroll
            for (int m = 0; m < 4; ++m) { const int row = row0 + ai * HALF + m * 16;
#pragma unroll
                for (int bj = 0; bj < 2; ++bj) { const int cc = col0 + bj * HALF;
                    yq[m][bj] = ygm_rows ? *(const __attribute__((address_space(1))) u32x4*)(Y + ((size_t)(cc >> 4) * ygm_rows + row) * 16 + (cc & 15)) : *(const __attribute__((address_space(1))) u32x4*)(Y + (size_t)row * ldy + cc); } }
#pragma unroll
            for (int m = 0; m < 4; ++m) { const int row = row0 + ai * HALF + m * 16;
#pragma unroll
                for (int bj = 0; bj < 2; ++bj) { const u32x4 yw = yq[m][bj];
                    const f32x4 z0 = acc[ai][bj][m][0] + bv[bj][0], z1 = acc[ai][bj][m][1] + bv[bj][1];
                    float t[8]; const float yv[8] = {bflo(yw.x), bfhi(yw.x), bflo(yw.y), bfhi(yw.y), bflo(yw.z), bfhi(yw.z), bflo(yw.w), bfhi(yw.w)};
#pragma unroll
                    for (int e = 0; e < 4; ++e) { t[e] = yv[e] * __builtin_amdgcn_rcpf(1.0f + __builtin_amdgcn_exp2f(-1.4426950408889634f * z0[e])); t[4 + e] = yv[4 + e] * __builtin_amdgcn_rcpf(1.0f + __builtin_amdgcn_exp2f(-1.4426950408889634f * z1[e])); }
                    u32x4 w; w.x = cvt_pk_bf16(t[0], t[1]); w.y = cvt_pk_bf16(t[2], t[3]); w.z = cvt_pk_bf16(t[4], t[5]); w.w = cvt_pk_bf16(t[6], t[7]);
                    *(u32x4*)(mix + (size_t)row * ldm + col0 + bj * HALF) = w; } } }
    }
};
struct EpiRes {
    static constexpr bool PERM = true, AFTER_DRAIN = false, RSTD = false;
    const float* basef; const bf16_t* baseb; bf16_t* xb; float* ssq_out;
    __device__ __forceinline__ void operator()(const f32x4 (&acc)[2][2][4][2], const Unit& u, int wr, int wc, int fr, int fq, const PG8_LAS float* rsl) const {
        const int row0 = u.pm * BM + wr * 64 + fr, col0 = u.pn * BM + wc * 32 + 8 * fq;
        typedef __attribute__((address_space(1))) const f32x4 gf4; typedef __attribute__((address_space(1))) const u32x4 gu4;
        if (basef) {
            f32x4 bn[2][2];
#pragma unroll
            for (int bj = 0; bj < 2; ++bj)
#pragma unroll
                for (int n = 0; n < 2; ++n) bn[bj][n] = *(gf4*)(basef + (size_t)row0 * 1024 + col0 + bj * HALF + n * 4);
#pragma unroll
            for (int idx = 0; idx < 8; ++idx) { const int ai = idx >> 2, m = idx & 3; const int row = row0 + ai * HALF + m * 16; const size_t off = (size_t)row * 1024 + col0; float ss = 0.f;
                f32x4 bc[2][2];
#pragma unroll
                for (int bj = 0; bj < 2; ++bj)
#pragma unroll
                    for (int n = 0; n < 2; ++n) bc[bj][n] = bn[bj][n];
                if (idx + 1 < 8) { const int row2 = row0 + ((idx + 1) >> 2) * HALF + ((idx + 1) & 3) * 16;
#pragma unroll
                    for (int bj = 0; bj < 2; ++bj)
#pragma unroll
                        for (int n = 0; n < 2; ++n) bn[bj][n] = *(gf4*)(basef + (size_t)row2 * 1024 + col0 + bj * HALF + n * 4); }
#pragma unroll
                for (int bj = 0; bj < 2; ++bj) { const f32x4 o0 = bc[bj][0] + acc[ai][bj][m][0], o1 = bc[bj][1] + acc[ai][bj][m][1];
                    u32x4 w; w.x = cvt_pk_bf16(o0[0], o0[1]); w.y = cvt_pk_bf16(o0[2], o0[3]); w.z = cvt_pk_bf16(o1[0], o1[1]); w.w = cvt_pk_bf16(o1[2], o1[3]);
                    *(u32x4*)(xb + off + bj * HALF) = w;
                    ss += ((o0[0] * o0[0] + o0[1] * o0[1]) + (o0[2] * o0[2] + o0[3] * o0[3])) + ((o1[0] * o1[0] + o1[1] * o1[1]) + (o1[2] * o1[2] + o1[3] * o1[3])); }
                ss += __shfl_xor(ss, 16); ss += __shfl_xor(ss, 32);
                if (fq == 0) ssq_out[(size_t)row * 16 + u.pn * 4 + wc] = ss; }
        } else {
            u32x4 bq[2][4][2];
#pragma unroll
            for (int ai = 0; ai < 2; ++ai)
#pragma unroll
                for (int m = 0; m < 4; ++m)
#pragma unroll
                    for (int bj = 0; bj < 2; ++bj) bq[ai][m][bj] = *(gu4*)(baseb + (size_t)(row0 + ai * HALF + m * 16) * 1024 + col0 + bj * HALF);
#pragma unroll
            for (int ai = 0; ai < 2; ++ai)
#pragma unroll
                for (int m = 0; m < 4; ++m) { const int row = row0 + ai * HALF + m * 16; const size_t off = (size_t)row * 1024 + col0; float ss = 0.f;
#pragma unroll
                    for (int bj = 0; bj < 2; ++bj) { const u32x4 q = bq[ai][m][bj];
                        const f32x4 b0 = (f32x4){bflo(q.x), bfhi(q.x), bflo(q.y), bfhi(q.y)}, b1 = (f32x4){bflo(q.z), bfhi(q.z), bflo(q.w), bfhi(q.w)};
                        const f32x4 o0 = b0 + acc[ai][bj][m][0], o1 = b1 + acc[ai][bj][m][1];
                        u32x4 w; w.x = cvt_pk_bf16(o0[0], o0[1]); w.y = cvt_pk_bf16(o0[2], o0[3]); w.z = cvt_pk_bf16(o1[0], o1[1]); w.w = cvt_pk_bf16(o1[2], o1[3]);
                        *(u32x4*)(xb + off + bj * HALF) = w;
                        ss += ((o0[0] * o0[0] + o0[1] * o0[1]) + (o0[2] * o0[2] + o0[3] * o0[3])) + ((o1[0] * o1[0] + o1[1] * o1[1]) + (o1[2] * o1[2] + o1[3] * o1[3])); }
                    ss += __shfl_xor(ss, 16); ss += __shfl_xor(ss, 32);
                    if (fq == 0) ssq_out[(size_t)row * 16 + u.pn * 4 + wc] = ss; }
        }
    }
};
struct EpiGU {
    static constexpr bool PERM = true, AFTER_DRAIN = false, RSTD = true;
    const float* ssq; bf16_t* H; int ldh;
    __device__ __forceinline__ void operator()(const f32x4 (&acc)[2][2][4][2], const Unit& u, int wr, int wc, int fr, int fq, const PG8_LAS float* rsl) const {
        const int row0 = u.pm * BM + wr * 64 + fr, col0 = u.pn * HALF + wc * 32 + 8 * fq;
        float rsv[2][4];
#pragma unroll
        for (int ai = 0; ai < 2; ++ai)
#pragma unroll
            for (int m = 0; m < 4; ++m) rsv[ai][m] = rsl[ai * 64 + 16 * m + fr];
#pragma unroll
        for (int ai = 0; ai < 2; ++ai)
#pragma unroll
            for (int m = 0; m < 4; ++m) { const int row = row0 + ai * HALF + m * 16; const float rs = rsv[ai][m];
                f32x4 hv[2];
                const float rsn = rs * -1.4426950408889634f, rs2 = rs * rs;
#pragma unroll
                for (int n = 0; n < 2; ++n) { const f32x4 G = acc[ai][0][m][n], U = acc[ai][1][m][n]; const f32x4 a = G * rsn;
                    f32x4 d; d[0] = __builtin_amdgcn_exp2f(a[0]); d[1] = __builtin_amdgcn_exp2f(a[1]); d[2] = __builtin_amdgcn_exp2f(a[2]); d[3] = __builtin_amdgcn_exp2f(a[3]);
                    d = d + 1.0f;
                    f32x4 r; r[0] = __builtin_amdgcn_rcpf(d[0]); r[1] = __builtin_amdgcn_rcpf(d[1]); r[2] = __builtin_amdgcn_rcpf(d[2]); r[3] = __builtin_amdgcn_rcpf(d[3]);
                    hv[n] = ((G * U) * rs2) * r; }
                u32x4 w; w.x = cvt_pk_bf16(hv[0][0], hv[0][1]); w.y = cvt_pk_bf16(hv[0][2], hv[0][3]); w.z = cvt_pk_bf16(hv[1][0], hv[1][1]); w.w = cvt_pk_bf16(hv[1][2], hv[1][3]);
                *(u32x4*)(H + (size_t)row * ldh + col0) = w; }
    }
};

template <class Epi, class Sched, bool ALIGN_EPI = false, bool SP2 = false>
__device__ __forceinline__ void gemm_phase(PG8_LAS unsigned char* lds, const Gemm g, const Sched& S, const Epi& E) {
    const int tid = threadIdx.x, wid = __builtin_amdgcn_readfirstlane(tid >> 6), lane = tid & 63, wr = wid >> 2, wc = wid & 3, fr = lane & 15, fq = lane >> 4;
    const int K = g.K, nt = K / BK;
    unsigned voffA[2], voffB[2];
#pragma unroll
    for (int i = 0; i < 2; ++i) { int R, C; stage_rc(tid * 16 + i * 8192, R, C); const int Rb = Epi::PERM ? ((R & ~31) + perm32(R & 31)) : R;
        voffA[i] = g.amode ? (unsigned)((C >> 4) * g.M * 32 + R * 32 + (C & 15) * 2) : (unsigned)(R * K + C) * 2u; voffB[i] = (unsigned)(Rb * K + C) * 2u; }
    const size_t kstep = (size_t)(BK * 2);
    const size_t hstep = (size_t)HALF * K * 2;
    const size_t tstep = 2 * hstep;
    const size_t kstepA = g.amode ? (size_t)4 * g.M * 32 : kstep, hstepA = g.amode ? (size_t)HALF * 32 : hstep, tstepA = 2 * hstepA;
    const unsigned ldsw = (unsigned)wid * 1024u;
    const int aoff = lds_byte(wr * 64 + fr, fq * 8), boff = lds_byte(wc * 32 + fr, fq * 8);
#define PG8_SA(b, h) (((b) * 2 + (h)) * HTB)
#define PG8_SB(b, h) ((4 + (b) * 2 + (h)) * HTB)
#define PG8_STAGE(bufoff, gbase, voff) do { _Pragma("unroll") for (int _i = 0; _i < 2; ++_i) \
        __builtin_amdgcn_global_load_lds((const unsigned*)((const char*)(gbase) + (voff)[_i]), (PG8_LAS unsigned*)(lds + (bufoff) + ldsw + _i * 8192), 16, 0, 0); } while (0)
#define PG8_LDA(dst, b, h) do { _Pragma("unroll") for (int m = 0; m < 4; ++m) _Pragma("unroll") for (int k = 0; k < 2; ++k) dst[m][k] = *(const PG8_LAS bf16x8*)(lds + PG8_SA(b, h) + aoff + m * 2048 + k * 1024); } while (0)
#define PG8_LDB(dst, b, h) do { _Pragma("unroll") for (int n = 0; n < 2; ++n) _Pragma("unroll") for (int k = 0; k < 2; ++k) dst[n][k] = *(const PG8_LAS bf16x8*)(lds + PG8_SB(b, h) + boff + n * 2048 + k * 1024); } while (0)
#define PG8_MMA(ai, bj, At, Bt) do { __builtin_amdgcn_s_setprio(1); _Pragma("unroll") for (int m = 0; m < 4; ++m) _Pragma("unroll") for (int n = 0; n < 2; ++n) _Pragma("unroll") for (int k = 0; k < 2; ++k) \
        acc[ai][bj][m][n] = __builtin_amdgcn_mfma_f32_16x16x32_bf16(Bt[n][k], At[m][k], acc[ai][bj][m][n], 0, 0, 0); __builtin_amdgcn_s_setprio(0); } while (0)
#define PG8_WAIT_V(n) asm volatile("s_waitcnt vmcnt(" #n ")" ::: "memory")
#define PG8_WAIT_L(n) asm volatile("s_waitcnt lgkmcnt(" #n ")" ::: "memory")
#define PG8_BAR __builtin_amdgcn_s_barrier()
#define PG8_SCHED __builtin_amdgcn_sched_barrier(0)
    Unit cur, nxt; int ui = 0;
    if (!S.next(0, cur)) return;
    f32x4 acc[2][2][4][2];
#pragma unroll
    for (int a = 0; a < 2; ++a)
#pragma unroll
        for (int b = 0; b < 2; ++b)
#pragma unroll
            for (int m = 0; m < 4; ++m)
#pragma unroll
                for (int n = 0; n < 2; ++n) acc[a][b][m][n] = (f32x4){0.f, 0.f, 0.f, 0.f};
    bf16x8 At[4][2], B0[2][2], B1[2][2];
    const char* cA = (const char*)g.A + (size_t)cur.pm * tstepA; const char* cB = (const char*)g.Bt + (size_t)cur.pn * tstep;
    S.a_ready(cur);
    if constexpr (SP2) {
        PG8_STAGE(PG8_SB(0, 0), cB, voffB); PG8_STAGE(PG8_SB(0, 1), cB + hstep, voffB); PG8_STAGE(PG8_SA(0, 0), cA, voffA); PG8_STAGE(PG8_SA(0, 1), cA + hstepA, voffA);
        if (wr == 1) PG8_BAR;
        PG8_WAIT_V(2); PG8_BAR;
        PG8_STAGE(PG8_SB(1, 0), cB + kstep, voffB); PG8_STAGE(PG8_SA(1, 0), cA + kstepA, voffA); PG8_STAGE(PG8_SB(1, 1), cB + hstep + kstep, voffB);
        PG8_WAIT_V(6); PG8_BAR;
    } else {
        PG8_STAGE(PG8_SB(0, 0), cB, voffB); PG8_STAGE(PG8_SA(0, 0), cA, voffA); PG8_STAGE(PG8_SB(0, 1), cB + hstep, voffB); PG8_STAGE(PG8_SA(0, 1), cA + hstepA, voffA);
        if (wr == 1) PG8_BAR;
        PG8_WAIT_V(4); PG8_BAR;
        PG8_STAGE(PG8_SB(1, 0), cB + kstep, voffB); PG8_STAGE(PG8_SA(1, 0), cA + kstepA, voffA); PG8_STAGE(PG8_SB(1, 1), cB + hstep + kstep, voffB);
        PG8_WAIT_V(6); PG8_BAR;
    }
    for (;;) {
        const bool has_next = S.next(ui + 1, nxt);
        const char* nA = has_next ? (const char*)g.A + (size_t)nxt.pm * tstepA : cA; const char* nB = has_next ? (const char*)g.Bt + (size_t)nxt.pn * tstep : cB;
        for (int t = 0; t < nt; t += 2) {
            const bool last = (t == nt - 2);
            const char* a1 = cA + (size_t)(t + 1) * kstepA;
            const char* a2 = last ? nA : cA + (size_t)(t + 2) * kstepA; const char* b2 = last ? nB : cB + (size_t)(t + 2) * kstep;
            const char* a3 = a2 + kstepA; const char* b3 = b2 + kstep;
            if (last && has_next) S.a_ready(nxt);
            f32x4 rq0, rq1;
            if constexpr (Epi::RSTD) { const int j = 32 * wc + (lane >> 1); const int row = cur.pm * BM + 128 * (j >> 6) + 64 * wr + (j & 63);
                const float* sp = E.ssq + (size_t)row * 16 + 8 * (lane & 1);
                asm volatile("global_load_dwordx4 %0, %2, off\n\tglobal_load_dwordx4 %1, %2, off offset:16" : "=&v"(rq0), "=&v"(rq1) : "v"(sp) : "memory"); }
            if constexpr (SP2) {
            PG8_LDB(B0, 0, 0); PG8_LDB(B1, 0, 1); PG8_SCHED; PG8_LDA(At, 0, 0); PG8_STAGE(PG8_SA(1, 1), a1 + hstepA, voffA);
            PG8_WAIT_V(8); PG8_WAIT_L(0); PG8_BAR; PG8_MMA(0, 0, At, B0); PG8_MMA(0, 1, At, B1); PG8_BAR; PG8_SCHED;
            PG8_LDA(At, 0, 1); PG8_STAGE(PG8_SB(0, 0), b2, voffB); PG8_STAGE(PG8_SB(0, 1), b2 + hstep, voffB); PG8_STAGE(PG8_SA(0, 0), a2, voffA);
            PG8_WAIT_V(8); PG8_WAIT_L(0); PG8_BAR; PG8_MMA(1, 0, At, B0); PG8_MMA(1, 1, At, B1); PG8_BAR; PG8_SCHED;
            if constexpr (Epi::RSTD) { if (last) { asm volatile("s_waitcnt vmcnt(8)" : "+v"(rq0), "+v"(rq1) :: "memory");
                float s_ = ((rq0[0] + rq0[1]) + (rq0[2] + rq0[3])) + ((rq1[0] + rq1[1]) + (rq1[2] + rq1[3])); s_ += __shfl_xor(s_, 1);
                if (!(lane & 1)) ((PG8_LAS float*)(lds + STAGE_BYTES))[wr * 128 + 32 * wc + (lane >> 1)] = __builtin_amdgcn_rsqf(s_ * (1.0f / 1024.0f) + RMS_EPS); } }
            PG8_LDB(B0, 1, 0); PG8_LDB(B1, 1, 1); PG8_SCHED; PG8_LDA(At, 1, 0); PG8_STAGE(PG8_SA(0, 1), a2 + hstepA, voffA);
            PG8_WAIT_V(8); PG8_WAIT_L(0); PG8_BAR; PG8_MMA(0, 0, At, B0); PG8_MMA(0, 1, At, B1); PG8_BAR; PG8_SCHED;
            PG8_LDA(At, 1, 1); PG8_STAGE(PG8_SB(1, 0), b3, voffB); PG8_STAGE(PG8_SB(1, 1), b3 + hstep, voffB); PG8_STAGE(PG8_SA(1, 0), a3, voffA);
            PG8_WAIT_V(8); PG8_WAIT_L(0); PG8_BAR; PG8_MMA(1, 0, At, B0); PG8_MMA(1, 1, At, B1); PG8_BAR; PG8_SCHED;
            } else {
            PG8_LDB(B0, 0, 0); PG8_SCHED; PG8_LDA(At, 0, 0); PG8_STAGE(PG8_SA(1, 1), a1 + hstepA, voffA);
            PG8_WAIT_L(8); PG8_BAR; PG8_WAIT_L(0); PG8_MMA(0, 0, At, B0); PG8_BAR; PG8_SCHED;
            PG8_LDB(B1, 0, 1); PG8_STAGE(PG8_SB(0, 0), b2, voffB);
            PG8_BAR; PG8_WAIT_L(0); PG8_MMA(0, 1, At, B1); PG8_BAR;
            PG8_LDA(At, 0, 1); PG8_STAGE(PG8_SA(0, 0), a2, voffA);
            PG8_BAR; PG8_WAIT_L(0); PG8_MMA(1, 0, At, B0); PG8_BAR; PG8_SCHED;
            PG8_STAGE(PG8_SB(0, 1), b2 + hstep, voffB);
            PG8_WAIT_V(6); PG8_BAR; PG8_MMA(1, 1, At, B1); PG8_BAR;
            PG8_LDB(B0, 1, 0); PG8_SCHED; PG8_LDA(At, 1, 0); PG8_STAGE(PG8_SA(0, 1), a2 + hstepA, voffA);
            PG8_WAIT_L(8); PG8_BAR; PG8_WAIT_L(0); PG8_MMA(0, 0, At, B0); PG8_BAR; PG8_SCHED;
            PG8_LDB(B1, 1, 1); PG8_STAGE(PG8_SB(1, 0), b3, voffB);
            PG8_BAR; PG8_WAIT_L(0); PG8_MMA(0, 1, At, B1); PG8_BAR;
            PG8_LDA(At, 1, 1); PG8_STAGE(PG8_SA(1, 0), a3, voffA);
            PG8_BAR; PG8_WAIT_L(0); PG8_MMA(1, 0, At, B0); PG8_BAR; PG8_SCHED;
            PG8_STAGE(PG8_SB(1, 1), b3 + hstep, voffB);
            PG8_WAIT_V(6); PG8_BAR; PG8_MMA(1, 1, At, B1); PG8_BAR;
            }
        }
        if constexpr (ALIGN_EPI) { if (wr == 0) PG8_BAR; }
        if constexpr (!Epi::AFTER_DRAIN) { E(acc, cur, wr, wc, fr, fq, (const PG8_LAS float*)(lds + STAGE_BYTES) + wr * 128); S.done(cur); }
        if (!has_next) break;
#pragma unroll
        for (int a = 0; a < 2; ++a)
#pragma unroll
            for (int b = 0; b < 2; ++b)
#pragma unroll
                for (int m = 0; m < 4; ++m)
#pragma unroll
                    for (int n = 0; n < 2; ++n) acc[a][b][m][n] = (f32x4){0.f, 0.f, 0.f, 0.f};
        cur = nxt; cA = nA; cB = nB; ++ui;
        if constexpr (ALIGN_EPI) { if (wr == 1) PG8_BAR; }
    }
    PG8_WAIT_V(0);
    if constexpr (!ALIGN_EPI) { if (wr == 0) PG8_BAR; }
    PG8_BAR;
    if constexpr (Epi::AFTER_DRAIN) { E.fused(acc, cur, wr, wc, fr, fq, lds, wid, lane); S.done(cur); }
#undef PG8_SA
#undef PG8_SB
#undef PG8_STAGE
#undef PG8_LDA
#undef PG8_LDB
#undef PG8_MMA
#undef PG8_WAIT_V
#undef PG8_WAIT_L
#undef PG8_BAR
#undef PG8_SCHED
}
}
constexpr int NWAVES = 8;
constexpr int BATCH = 8, SEQ = 4096, DM = 1024, TOK = BATCH * SEQ;
constexpr int TOKW = 768, MEMW = 256, MEML = 256, NGRP = 48, NST = 64, GCH = 16, NHEAD = 12, MHEAD = 4, HD = 64, FFN = 2816, NBLK = 16, MBLK = 256;
constexpr float C2 = 0.125f * 1.4426950408889634f;
constexpr float LOG2E = 1.4426950408889634f;

constexpr size_t MiB = 1u << 20;
constexpr size_t WS_CTL = 0, CTL_ZERO_BYTES = 1 * MiB;
constexpr size_t WS_S5TAB = 9 * MiB, WS_S5E = 13 * MiB;
constexpr size_t WS_SS0 = 1 * MiB, WS_SSA = 3 * MiB, WS_SSB = 5 * MiB, WS_SSM = 7 * MiB, WS_KMEAN = 8 * MiB;
constexpr size_t WS_WIN0 = 16 * MiB, WS_WGLU = 18 * MiB, WS_WIN1 = 20 * MiB, WS_WOUT0 = 26 * MiB, WS_WOUT1 = 28 * MiB;
constexpr size_t WS_WGU0 = 30 * MiB, WS_WGU1 = 41 * MiB, WS_WDN0 = 52 * MiB, WS_WDN1 = 58 * MiB, WS_WMKV = 64 * MiB;
constexpr size_t WS_MEMB = 65 * MiB, WS_MEMK = 69 * MiB, WS_MEMV = 70 * MiB;
constexpr size_t WS_XB = 72 * MiB;
constexpr size_t WS_R = 136 * MiB;
constexpr size_t WS_U = WS_R, WS_Y = WS_R + 48 * MiB;
constexpr size_t WS_Q1 = WS_R, WS_K1 = WS_R + 48 * MiB, WS_V1 = WS_R + 96 * MiB;
constexpr size_t WS_QM = WS_R + 144 * MiB;
constexpr size_t WS_MIX = WS_R + 160 * MiB;
constexpr size_t WS_H = WS_R;
constexpr size_t WS_END = WS_R + 224 * MiB;
constexpr int CW_BAR = 4096;

constexpr int RING_OFF = 0, RING_BYTES = 147456;
constexpr int LDSCTL_OFF = RING_BYTES, MISC_OFF = LDSCTL_OFF + 320;
constexpr int LDS_BYTES = RING_BYTES + 1024;

#define GAS __attribute__((address_space(1)))
#define LAS __attribute__((address_space(3)))
typedef unsigned short bf16;
typedef unsigned v4u __attribute__((ext_vector_type(4)));
typedef unsigned v2u __attribute__((ext_vector_type(2)));
typedef float f32x4 __attribute__((ext_vector_type(4)));
typedef GAS unsigned gu32;
typedef float f32x2 __attribute__((ext_vector_type(2)));
#define RLX_AGENT __ATOMIC_RELAXED, __HIP_MEMORY_SCOPE_AGENT
#define LDS_WAIT() asm volatile("s_waitcnt lgkmcnt(0)" ::: "memory")
#define VM_WAIT() asm volatile("s_waitcnt vmcnt(0)" ::: "memory")
__device__ __forceinline__ unsigned f2bf(float f) { unsigned u = __builtin_bit_cast(unsigned, f); return (u + 0x7fffu + ((u >> 16) & 1u)) >> 16; }
__device__ __forceinline__ unsigned pk2(float lo, float hi) { return f2bf(lo) | (f2bf(hi) << 16); }
__device__ __forceinline__ float bf2f(unsigned short h) { return __uint_as_float(((unsigned)h) << 16); }
__device__ __forceinline__ float bflo(unsigned w) { return __uint_as_float(w << 16); }
__device__ __forceinline__ float bfhi(unsigned w) { return __uint_as_float(w & 0xffff0000u); }

#define XB_TMO      128
#define XB_XCNT(j)  (256  + 64 * (j))
#define XB_XSUB(j)  (1280 + 64 * (j))
#define XB_XGEN(j)  (2304 + 64 * (j))
#define XB_TOP      3328
#define XB_TOPGEN   3392
#define XCD_BAR_WORDS 3456
#define XB_SPIN_CAP (1u << 18)

__device__ __forceinline__ unsigned xb_ld(unsigned* p)              { return __hip_atomic_load(p, __ATOMIC_RELAXED, __HIP_MEMORY_SCOPE_AGENT); }
__device__ __forceinline__ unsigned xb_add(unsigned* p, unsigned v) { return __hip_atomic_fetch_add(p, v, __ATOMIC_RELAXED, __HIP_MEMORY_SCOPE_AGENT); }
__device__ __forceinline__ unsigned xb_xcc_id() { return (unsigned)__builtin_amdgcn_s_getreg((3 << 11) | 20) & 0xFu; }
#define XB_SPIN(cond, bar) do { unsigned _sp = 0; while (cond) { __builtin_amdgcn_s_sleep(1); \
    if ((++_sp & 255u) == 0u) { if (xb_ld(&(bar)[XB_TMO])) break; if (_sp > XB_SPIN_CAP) { atomicAdd(&(bar)[XB_TMO], 1u); break; } } } } while (0)

struct XcdBarrier {
    unsigned* bar; unsigned x;
    volatile LAS unsigned* st;
};

__device__ __forceinline__ XcdBarrier xcd_barrier_post(unsigned* bar, volatile LAS unsigned* st) {
    XcdBarrier b; b.bar = bar; b.x = xb_xcc_id(); b.st = st;
    if (threadIdx.x == 0) (void)xb_add(&bar[XB_XCNT(b.x)], 1u);
    return b;
}
__device__ __forceinline__ void xcd_barrier_complete(unsigned* bar, unsigned x, unsigned& nloc, unsigned& nx) {
    const unsigned G = gridDim.x * gridDim.y * gridDim.z;
    unsigned sum, cnt, mine, sp = 0u;
    for (;;) {
        sum = 0u; cnt = 0u; mine = 0u;
#pragma unroll
        for (unsigned j = 0; j < 16; ++j) { const unsigned c = xb_ld(&bar[XB_XCNT(j)]); sum += c; cnt += (c > 0u) ? 1u : 0u; mine = (j == x) ? c : mine; }
        if (sum == G) break;
        __builtin_amdgcn_s_sleep(1);
        if ((++sp & 255u) == 0u) { if (xb_ld(&bar[XB_TMO])) break; if (sp > XB_SPIN_CAP) { atomicAdd(&bar[XB_TMO], 1u); break; } }
    }
    nloc = mine > 0u ? mine : 1u; nx = cnt > 0u ? cnt : 1u;
}

__device__ __forceinline__ void xcd_barrier(const XcdBarrier& b) {
    asm volatile("s_waitcnt vmcnt(0)" ::: "memory");
    __syncthreads();
    if (threadIdx.x == 0) {
        unsigned* bar = b.bar;
        __builtin_amdgcn_s_waitcnt(0);
        unsigned nloc = b.st[0], nx = b.st[1];
        if (nloc == 0u) { xcd_barrier_complete(bar, b.x, nloc, nx); b.st[0] = nloc; b.st[1] = nx; }
        const unsigned old = xb_add(&bar[XB_XSUB(b.x)], 1u);
        const unsigned gen = old / nloc;
        if (old + 1u == (gen + 1u) * nloc) {
            __builtin_amdgcn_fence(__ATOMIC_RELEASE, "agent");
            asm volatile("s_waitcnt vmcnt(0)" ::: "memory");
            const unsigned og = xb_add(&bar[XB_TOP], 1u);
            const unsigned tg = og / nx;
            if (og + 1u == (tg + 1u) * nx) xb_add(&bar[XB_TOPGEN], 1u);
            else XB_SPIN(xb_ld(&bar[XB_TOPGEN]) == tg, bar);
            __builtin_amdgcn_fence(__ATOMIC_ACQUIRE, "agent");
            xb_add(&bar[XB_XGEN(b.x)], 1u);
            asm volatile("s_waitcnt vmcnt(0)" ::: "memory");
        } else {
            XB_SPIN(xb_ld(&bar[XB_XGEN(b.x)]) == gen, bar);
            __builtin_amdgcn_fence(__ATOMIC_ACQUIRE, "agent");
            asm volatile("s_waitcnt vmcnt(0)" ::: "memory");
        }
    }
    __syncthreads();
}
namespace attn_body {
using bf16=__hip_bfloat16;
using bf16x8=__attribute__((ext_vector_type(8)))short;
using s16x4=__attribute__((ext_vector_type(4)))short;
using f32x16=__attribute__((ext_vector_type(16)))float;
using u32x4=__attribute__((ext_vector_type(4)))unsigned;
constexpr int D=64;
constexpr int NW=8,QBLK=32,QB=QBLK*NW,KVBLK=64;
__device__ __forceinline__ int crow(int r,int hi){return (r&3)+8*(r>>2)+4*hi;}
#define SBAR() __builtin_amdgcn_sched_barrier(0)
__device__ __forceinline__ void cmask(f32x16&p0,f32x16&p1,int jb,int qrel,int hi){
  const float NEG=-INFINITY; int kb=64*jb+4*hi;
  #pragma unroll
  for(int r=0;r<16;++r){int kv=kb+(r&3)+8*(r>>2); if(kv>qrel)p0[r]=NEG; if(kv+32>qrel)p1[r]=NEG;}
}

constexpr int NSLOT=3, SLOTB=8192;
constexpr int LDS_K=0, LDS_V=NSLOT*SLOTB, LDS_WS=2*NSLOT*SLOTB, LDS_OST=LDS_WS+NW*64*4, LDS_BYTES=LDS_OST+NW*4096;
__device__ __forceinline__ void glds16(const void*gsrc,unsigned lds_dst){unsigned keep;
  asm volatile("s_mov_b32 %0, m0\n\ts_mov_b32 m0, %2\n\ts_nop 0\n\tglobal_load_lds_dwordx4 %1, off\n\ts_mov_b32 m0, %0":"=&s"(keep):"v"(gsrc),"s"(lds_dst):"memory");}
__device__ __forceinline__ float max3f(float a,float b,float c){float r;asm("v_max3_f32 %0, %1, %2, %3":"=v"(r):"v"(a),"v"(b),"v"(c));return r;}
__device__ __forceinline__ float max2f(float a,float b){float r;asm("v_max_f32_e32 %0, %1, %2":"=v"(r):"v"(a),"v"(b));return r;}
__device__ __forceinline__ float fadd_s(float a,float b){float r;asm("v_add_f32_e32 %0, %1, %2":"=v"(r):"v"(a),"v"(b));return r;}
__device__ __forceinline__ float fsub_s(float a,float b){float r;asm("v_sub_f32_e32 %0, %1, %2":"=v"(r):"v"(a),"v"(b));return r;}
typedef float f32x2_t __attribute__((ext_vector_type(2))); typedef float f32x4_t __attribute__((ext_vector_type(4))); typedef __bf16 bf16x2_t __attribute__((ext_vector_type(2)));
__device__ __forceinline__ unsigned cvtpk_s(float lo,float hi){f32x2_t v={lo,hi};bf16x2_t b=__builtin_convertvector(v,bf16x2_t);return __builtin_bit_cast(unsigned,b);}
#define WAIT_BAR(N) asm volatile("s_waitcnt vmcnt(" #N ") lgkmcnt(0)\n\ts_barrier":::"memory")

__device__ __forceinline__ void qkt(f32x16&p0,f32x16&p1,const char*Kslot,const bf16x8*qr,int r32,int hi){
  const char*kb=Kslot+hi*1024+r32*16;
  #pragma unroll
  for(int d0=0;d0<4;++d0){
    const bf16x8 b0=*reinterpret_cast<const bf16x8*>(kb+d0*2048);
    const bf16x8 b1=*reinterpret_cast<const bf16x8*>(kb+d0*2048+512);
    p0=__builtin_amdgcn_mfma_f32_32x32x16_bf16(b0,qr[d0],p0,0,0,0);p1=__builtin_amdgcn_mfma_f32_32x32x16_bf16(b1,qr[d0],p1,0,0,0);}
}
typedef __attribute__((address_space(3))) const char* lds_cptr;
typedef short v4i16_t __attribute__((ext_vector_type(4)));
__device__ __forceinline__ void kload8(bf16x8*kf,lds_cptr kp){
  kf[0]=*(const __attribute__((address_space(3))) bf16x8*)(kp);      kf[1]=*(const __attribute__((address_space(3))) bf16x8*)(kp+512);
  kf[2]=*(const __attribute__((address_space(3))) bf16x8*)(kp+2048); kf[3]=*(const __attribute__((address_space(3))) bf16x8*)(kp+2560);
  kf[4]=*(const __attribute__((address_space(3))) bf16x8*)(kp+4096); kf[5]=*(const __attribute__((address_space(3))) bf16x8*)(kp+4608);
  kf[6]=*(const __attribute__((address_space(3))) bf16x8*)(kp+6144); kf[7]=*(const __attribute__((address_space(3))) bf16x8*)(kp+6656);
}
__device__ __forceinline__ void kload2(bf16x8*kf,lds_cptr kp,int j){ kf[2*j]=*(const __attribute__((address_space(3))) bf16x8*)(kp+j*2048); kf[2*j+1]=*(const __attribute__((address_space(3))) bf16x8*)(kp+j*2048+512); }
__device__ __forceinline__ s16x4 vtr(lds_cptr p){ return __builtin_bit_cast(s16x4,__builtin_amdgcn_ds_read_tr16_b64_v4i16((__attribute__((address_space(3))) v4i16_t*)p)); }
__device__ __forceinline__ float rowmax(const f32x16&p0,const f32x16&p1){
  float a=max3f(p0[0],p0[1],p1[0]),b=max3f(p0[2],p0[3],p1[1]);a=max3f(a,p1[2],p1[3]);
  #pragma unroll
  for(int r=4;r<16;r+=4){a=max3f(a,p0[r],p0[r+1]);b=max3f(b,p0[r+2],p0[r+3]);a=max3f(a,p1[r],p1[r+1]);b=max3f(b,p1[r+2],p1[r+3]);}
  const float m=max2f(a,b);
  auto rr=__builtin_amdgcn_permlane32_swap(__float_as_uint(m),__float_as_uint(m),false,false);
  return max2f(__uint_as_float(rr[0]),__uint_as_float(rr[1]));
}
__device__ __forceinline__ void pv(f32x16*o,int vb,bf16x8 pa0,bf16x8 pa1,bf16x8 pa2,bf16x8 pa3){
  #pragma unroll
  for(int d0=0;d0<2;++d0){s16x4 lo[4],hi[4];
    #pragma unroll
    for(int ks=0;ks<4;++ks){
      asm volatile("ds_read_b64_tr_b16 %0,%1 offset:%c2":"=&v"(lo[ks]):"v"(vb),"i"(d0*4096+ks*1024):"memory");
      asm volatile("ds_read_b64_tr_b16 %0,%1 offset:%c2":"=&v"(hi[ks]):"v"(vb),"i"(d0*4096+ks*1024+512):"memory");}
    asm volatile("s_waitcnt lgkmcnt(0)":::"memory");SBAR();
    #define PK(k) (bf16x8){lo[k][0],lo[k][1],lo[k][2],lo[k][3],hi[k][0],hi[k][1],hi[k][2],hi[k][3]}
    o[d0]=__builtin_amdgcn_mfma_f32_32x32x16_bf16(pa0,PK(0),o[d0],0,0,0);
    o[d0]=__builtin_amdgcn_mfma_f32_32x32x16_bf16(pa1,PK(1),o[d0],0,0,0);
    o[d0]=__builtin_amdgcn_mfma_f32_32x32x16_bf16(pa2,PK(2),o[d0],0,0,0);
    o[d0]=__builtin_amdgcn_mfma_f32_32x32x16_bf16(pa3,PK(3),o[d0],0,0,0);
    #undef PK
  }
}

#ifndef ATTN_STORE16
#define ATTN_STORE16(p,v) (*(u32x4*)(p)=(v))
#endif
template<int MODE,int THRL,int QP,int KP,int OP> __device__ __forceinline__ void attn_unit(const bf16*Qw0,const bf16*__restrict__ Kh,const bf16*__restrict__ Vh,bf16*Ow0,const int NT,
                                                                                          const float slope2,const float*kms0,const float*kms1,const int qb,char*shm){
  int tid_=threadIdx.x; asm volatile("":"+v"(tid_));
  const int tid=tid_,lane=tid&63,r32=lane&31,hi=lane>>5; const int wid=__builtin_amdgcn_readfirstlane(tid>>6);
  const bf16*Qw=Qw0+(long)(wid*QBLK)*QP;
  const unsigned lds0=(unsigned)(uintptr_t)shm;
  float*wsf=(float*)(shm+LDS_WS)+wid*64;
  const bf16*ksrc=Kh+(long)lane*KP+wid*8;
  const bf16*vsrc=Vh+(long)(16*(wid&3)+(lane>>2))*KP+(wid>>2)*32+(lane&3)*8;
  const unsigned kdst=lds0+LDS_K+wid*1024, vdst=lds0+LDS_V+wid*1024;
  #define PT(t) ((MODE==0)?(NT-1-(t)):(((t)<NT-4)?(NT-5-(t)):(t)))
  #define DMA_K(t,slot) glds16(ksrc+(long)PT(t)*KVBLK*KP,(unsigned)__builtin_amdgcn_readfirstlane(kdst+(slot)))
  #define DMA_V(t,slot) glds16(vsrc+(long)PT(t)*KVBLK*KP,(unsigned)__builtin_amdgcn_readfirstlane(vdst+(slot)))
  const int vb0=(int)(lds0+LDS_V)+((lane>>4)&1)*32+(lane&3)*8+(4*hi+((lane&15)>>2))*64;
  const char*Kbase=shm+LDS_K; bf16x8 kf[8];
  const lds_cptr shm3=(lds_cptr)shm; const lds_cptr kp0=shm3+LDS_K+hi*1024+r32*16; const lds_cptr vp0=shm3+LDS_V+((lane>>4)&1)*32+(lane&3)*8+(4*hi+((lane&15)>>2))*64;
  DMA_K(0,0);DMA_V(0,0);DMA_K(1,SLOTB);
  bf16x8 qr[4];
  #pragma unroll
  for(int d0=0;d0<4;++d0)qr[d0]=*reinterpret_cast<const bf16x8*>(&Qw[(long)r32*QP+d0*16+hi*8]);
  unsigned selm=0xffffffffu;
  if constexpr(MODE==1){
    f32x16 G=f32x16{};
    #pragma unroll
    for(int d0=0;d0<4;++d0){
      bf16x8 ah=bf16x8{},al=bf16x8{};
      if(r32<16){ const float*p0_=kms0+r32*64+d0*16+hi*8,*p1_=kms1+r32*64+d0*16+hi*8;
        const f32x4_t s0=*reinterpret_cast<const f32x4_t*>(p0_)+*reinterpret_cast<const f32x4_t*>(p1_), s1=*reinterpret_cast<const f32x4_t*>(p0_+4)+*reinterpret_cast<const f32x4_t*>(p1_+4);
        const float km_[8]={s0[0],s0[1],s0[2],s0[3],s1[0],s1[1],s1[2],s1[3]};
        #pragma unroll
        for(int i_=0;i_<8;i_+=2){ const unsigned wh_=cvtpk_s(km_[i_],km_[i_+1]); const float r0_=km_[i_]-__uint_as_float(wh_<<16), r1_=km_[i_+1]-__uint_as_float(wh_&0xffff0000u); const unsigned wl_=cvtpk_s(r0_,r1_);
          ah[i_]=(short)(wh_&0xffffu); ah[i_+1]=(short)(wh_>>16); al[i_]=(short)(wl_&0xffffu); al[i_+1]=(short)(wl_>>16); } }
      G=__builtin_amdgcn_mfma_f32_32x32x16_bf16(ah,qr[d0],G,0,0,0); G=__builtin_amdgcn_mfma_f32_32x32x16_bf16(al,qr[d0],G,0,0,0);}
    float g[16];
    #pragma unroll
    for(int r=0;r<4;++r){ const float a=G[r],b=G[4+r]; const float oa=__shfl_xor(a,32),ob=__shfl_xor(b,32);
      g[r]=hi?oa:a; g[4+r]=hi?a:oa; g[8+r]=hi?ob:b; g[12+r]=hi?b:ob; }
    #pragma unroll
    for(int n=0;n<16;++n) if(n>=qb) g[n]=-1.0e30f;
    const int nsel=qb<3?qb:3; unsigned mask=0u;
    #pragma unroll
    for(int rr=0;rr<3;++rr){ float best=-3.0e38f; int bi=0;
      #pragma unroll
      for(int n=0;n<16;++n){ const bool c=!((mask>>n)&1u)&&g[n]>best; best=c?g[n]:best; bi=c?n:bi; }
      if(rr<nsel) mask|=1u<<bi; }
    selm=mask|(1u<<qb);
  }
  float mhat=0.f,l_reg=0.f;f32x16 o[2];o[0]=f32x16{};o[1]=f32x16{};
  const int qrel=wid*QBLK+r32;
  const float hb=(MODE==1)?slope2*(float)(4*hi):0.f, s32=(MODE==1)?32.f*slope2:0.f, s64=(MODE==1)?64.f*slope2:0.f;
  #define CBASE(b0_,b1_,t) float b0_=fsub_s(fadd_s(s64*(float)PT(t),hb),mhat); if(MODE==1){ if(!((selm>>(PT(t)>>2))&1u)) b0_=-3.0e38f; } const float b1_=b0_+s32
  #define CFILL(X,B,bb) do{ _Pragma("unroll") for(int i_=0;i_<4;++i_){ if(MODE==1) X[(B)+i_]=__builtin_fmaf(slope2,(float)((((B)+i_)&3)+8*(((B)+i_)>>2)),bb); else X[(B)+i_]=bb; } }while(0)
  #define CINIT(C0,C1,t) do{ CBASE(b0_,b1_,t); CFILL(C0,0,b0_);CFILL(C0,4,b0_);CFILL(C0,8,b0_);CFILL(C0,12,b0_);CFILL(C1,0,b1_);CFILL(C1,4,b1_);CFILL(C1,8,b1_);CFILL(C1,12,b1_); }while(0)
  #define CMASK(P0,P1,t) do{ if(MODE==1){ int jb_=(t)-(NT-4); if(jb_>=0)cmask(P0,P1,jb_,qrel,hi);} }while(0)
  bool resc=false;
  #define START(P0,P1) do{ const float rm=rowmax(P0,P1); resc=false; \
    { const float dl=__builtin_fmaxf(rm,-1000.f); mhat=fadd_s(mhat,dl); \
      _Pragma("unroll") for(int r=0;r<16;++r){P0[r]=fsub_s(P0[r],dl);P1[r]=fsub_s(P1[r],dl);} } \
    _Pragma("unroll") for(int r=0;r<16;++r)P0[r]=__builtin_amdgcn_exp2f(P0[r]); }while(0)
  #define RESC() do{ if(resc){ asm volatile("s_waitcnt lgkmcnt(0)":::"memory"); \
      _Pragma("unroll") for(int d_=0;d_<2;++d_) _Pragma("unroll") for(int r=0;r<16;++r)o[d_][r]*=wsf[crow(r,hi)]; } }while(0)
  f32x16 pA0,pA1,pB0,pB1;
  int sl_prev=0,sl_cur=0,sl_next=SLOTB;
  #define ROT() do{sl_prev=sl_cur;sl_cur=sl_next;sl_next=(sl_next==(NSLOT-1)*SLOTB)?0:sl_next+SLOTB;}while(0)
  DMA_K(2,2*SLOTB);
  WAIT_BAR(3);
  CINIT(pA0,pA1,0);
  qkt(pA0,pA1,Kbase,qr,r32,hi);asm volatile("s_nop 15\n\ts_nop 7":"+v"(pA0),"+v"(pA1));CMASK(pA0,pA1,0);
  START(pA0,pA1);
  _Pragma("unroll") for(int r=0;r<16;++r)pA1[r]=__builtin_amdgcn_exp2f(pA1[r]);
  WAIT_BAR(0);
  DMA_K(3,0);DMA_V(1,SLOTB);
  ROT();
  kload8(kf,kp0+sl_cur);
  WAIT_BAR(2);
  s16x4 vlo[8],vhi[8]; u32x4 pw0,pw1,pw2,pw3;
  #define PKW(P,B) cvtpk_s(P[B],P[B+1])
  #define PAF(k) __builtin_bit_cast(bf16x8,pw##k)
  #define VFR(i) (bf16x8){vlo[i][0],vlo[i][1],vlo[i][2],vlo[i][3],vhi[i][0],vhi[i][1],vhi[i][2],vhi[i][3]}
  #define PIN(x) asm volatile("":"+v"(x))
  #define MX3(a,b,c) __builtin_fmaxf(__builtin_fmaxf((a),(b)),(c))
  #define GAPA(MF,A0,A1,A2,A3,W0,W1,PW) do{ MF; sacc+=A0; sacc+=A1; sacc+=A2; sacc+=A3; PIN(sacc); W0; W1; PIN(PW); SBAR(); }while(0)
  #define EX(v) __builtin_amdgcn_exp2f(v)
  #define GAPB(MF,X,B,N,bb) do{ MF; X[B]=EX(X[B]); X[B+1]=EX(X[B+1]); X[B+2]=EX(X[B+2]); X[B+3]=EX(X[B+3]); PIN(X); CFILL(N,B,bb); PIN(N); SBAR(); }while(0)
  #define VRD(i) do{ vlo[i]=vtr(vp_+(((i)>>2)*4096+((i)&3)*1024)); vhi[i]=vtr(vp_+(((i)>>2)*4096+((i)&3)*1024+512)); }while(0)
  #define KRD(G,j) do{ if(G){ kload2(kf,kp0+sl_next,j); SBAR(); } }while(0)
  #define STEP(C0,C1,P0,P1,t,GK,GV,GL) do{ SBAR(); \
    const lds_cptr vp_=vp0+sl_prev; \
    VRD(0); SBAR(); float sacc=(P0[0]+P0[1]); \
    GAPA(C0=__builtin_amdgcn_mfma_f32_32x32x16_bf16(kf[0],qr[0],C0,0,0,0), P0[2],P0[3],P0[4],P0[5],     pw0[0]=PKW(P0,0), pw0[1]=PKW(P0,2), pw0); \
    VRD(4); SBAR(); GAPA(C1=__builtin_amdgcn_mfma_f32_32x32x16_bf16(kf[1],qr[0],C1,0,0,0), P0[6],P0[7],P0[8],P0[9],     pw0[2]=PKW(P0,4), pw0[3]=PKW(P0,6), pw0); \
    VRD(1); SBAR(); GAPA(C0=__builtin_amdgcn_mfma_f32_32x32x16_bf16(kf[2],qr[1],C0,0,0,0),   P0[10],P0[11],P0[12],P0[13], pw1[0]=PKW(P0,8), pw1[1]=PKW(P0,10), pw1); \
    VRD(5); SBAR(); GAPA(C1=__builtin_amdgcn_mfma_f32_32x32x16_bf16(kf[3],qr[1],C1,0,0,0),   P0[14],P0[15],P1[0],P1[1],   pw1[2]=PKW(P0,12),pw1[3]=PKW(P0,14), pw1); \
    VRD(2); SBAR(); GAPA(C0=__builtin_amdgcn_mfma_f32_32x32x16_bf16(kf[4],qr[2],C0,0,0,0),   P1[2],P1[3],P1[4],P1[5],     pw2[0]=PKW(P1,0), pw2[1]=PKW(P1,2), pw2); \
    VRD(6); SBAR(); GAPA(C1=__builtin_amdgcn_mfma_f32_32x32x16_bf16(kf[5],qr[2],C1,0,0,0),   P1[6],P1[7],P1[8],P1[9],     pw2[2]=PKW(P1,4), pw2[3]=PKW(P1,6), pw2); \
    VRD(3); SBAR(); GAPA(C0=__builtin_amdgcn_mfma_f32_32x32x16_bf16(kf[6],qr[3],C0,0,0,0),   P1[10],P1[11],P1[12],P1[13], pw3[0]=PKW(P1,8), pw3[1]=PKW(P1,10), pw3); \
    VRD(7); SBAR(); GAPA(C1=__builtin_amdgcn_mfma_f32_32x32x16_bf16(kf[7],qr[3],C1,0,0,0),   P1[14],P1[15],0.f,0.f,       pw3[2]=PKW(P1,12),pw3[3]=PKW(P1,14), pw3); \
    l_reg+=sacc; \
    if(GK){DMA_K((t)+3,sl_cur);} if(GV){DMA_V((t)+1,sl_next);} \
    CMASKX(C0,C1,t); \
    { float a=MX3(C0[0],C0[1],C1[0]),b=MX3(C0[2],C0[3],C1[1]); a=MX3(a,C1[2],C1[3]); \
      _Pragma("unroll") for(int r=4;r<16;r+=4){a=MX3(a,C0[r],C0[r+1]);b=MX3(b,C0[r+2],C0[r+3]);a=MX3(a,C1[r],C1[r+1]);b=MX3(b,C1[r+2],C1[r+3]);} \
      float rm=__builtin_fmaxf(a,b); { auto rr=__builtin_amdgcn_permlane32_swap(__float_as_uint(rm),__float_as_uint(rm),false,false); rm=__builtin_fmaxf(__uint_as_float(rr[0]),__uint_as_float(rr[1])); } \
      resc=false; \
      if(__builtin_expect(__any(rm>(float)THRL),0)){ const float dl=__builtin_fmaxf(rm,0.f); mhat+=dl; \
        _Pragma("unroll") for(int r=0;r<16;++r){C0[r]-=dl;C1[r]-=dl;} \
        const float f=__builtin_amdgcn_exp2f(-dl); l_reg*=f; if(hi==0)wsf[r32]=f; resc=true; } } \
    CBASE(n0_,n1_,(t)+1);                                   \
    SBAR(); \
    GAPB(o[0]=__builtin_amdgcn_mfma_f32_32x32x16_bf16(PAF(0),VFR(0),o[0],0,0,0), C0,0, P0,n0_); \
    GAPB(o[1]=__builtin_amdgcn_mfma_f32_32x32x16_bf16(PAF(0),VFR(4),o[1],0,0,0), C0,4, P0,n0_); \
    KRD(GL,0); GAPB(o[0]=__builtin_amdgcn_mfma_f32_32x32x16_bf16(PAF(1),VFR(1),o[0],0,0,0), C0,8, P0,n0_); \
    KRD(GL,1); GAPB(o[1]=__builtin_amdgcn_mfma_f32_32x32x16_bf16(PAF(1),VFR(5),o[1],0,0,0), C0,12, P0,n0_); \
    KRD(GL,2); GAPB(o[0]=__builtin_amdgcn_mfma_f32_32x32x16_bf16(PAF(2),VFR(2),o[0],0,0,0), C1,0, P1,n1_); \
    KRD(GL,3); GAPB(o[1]=__builtin_amdgcn_mfma_f32_32x32x16_bf16(PAF(2),VFR(6),o[1],0,0,0), C1,4, P1,n1_); \
    GAPB(o[0]=__builtin_amdgcn_mfma_f32_32x32x16_bf16(PAF(3),VFR(3),o[0],0,0,0), C1,8, P1,n1_); \
    GAPB(o[1]=__builtin_amdgcn_mfma_f32_32x32x16_bf16(PAF(3),VFR(7),o[1],0,0,0), C1,12, P1,n1_); \
    }while(0)
  int t=1;
  CINIT(pB0,pB1,1);
  #define ENDW(tt) do{ if((tt)+3<NT){WAIT_BAR(2);} else if((tt)+2<NT){WAIT_BAR(1);} else {WAIT_BAR(0);} }while(0)
  #define CMASKX(P0,P1,t) do{ asm volatile("; head step (masked)"); CMASK(P0,P1,t); }while(0)
  for(;t+1<NT&&t<5;t+=2){
    STEP(pB0,pB1,pA0,pA1,t,(t+3<NT),(t+1<NT),(t+1<NT));       ENDW(t);   RESC(); ROT();
    STEP(pA0,pA1,pB0,pB1,t+1,(t+4<NT),(t+2<NT),(t+2<NT));     ENDW(t+1); RESC(); ROT();
  }
  #undef CMASKX
  #define CMASKX(P0,P1,t) do{ asm volatile("; steady step (no mask)"); }while(0)
  for(;t+5<NT;t+=2){
    STEP(pB0,pB1,pA0,pA1,t,true,true,true);     WAIT_BAR(2); RESC(); ROT();
    STEP(pA0,pA1,pB0,pB1,t+1,true,true,true);   WAIT_BAR(2); RESC(); ROT();
  }
  #undef CMASKX
  #define CMASKX(P0,P1,t) do{ asm volatile("; tail step (masked)"); CMASK(P0,P1,t); }while(0)
  for(;t+1<NT;t+=2){
    STEP(pB0,pB1,pA0,pA1,t,(t+3<NT),(t+1<NT),(t+1<NT));       ENDW(t);   RESC(); ROT();
    STEP(pA0,pA1,pB0,pB1,t+1,(t+4<NT),(t+2<NT),(t+2<NT));     ENDW(t+1); RESC(); ROT();
  }
  STEP(pB0,pB1,pA0,pA1,NT-1,false,false,false); RESC();
  { float sacc=pB0[0]+pB0[1]; _Pragma("unroll") for(int r=2;r<16;++r)sacc+=pB0[r]; _Pragma("unroll") for(int r=0;r<16;++r)sacc+=pB1[r]; l_reg+=sacc;
    pw0=(u32x4){PKW(pB0,0),PKW(pB0,2),PKW(pB0,4),PKW(pB0,6)};pw1=(u32x4){PKW(pB0,8),PKW(pB0,10),PKW(pB0,12),PKW(pB0,14)};pw2=(u32x4){PKW(pB1,0),PKW(pB1,2),PKW(pB1,4),PKW(pB1,6)};pw3=(u32x4){PKW(pB1,8),PKW(pB1,10),PKW(pB1,12),PKW(pB1,14)};
    SBAR(); pv(o,vb0+sl_cur,PAF(0),PAF(1),PAF(2),PAF(3)); }
  #undef PKW
  #undef PAF
  #undef VFR
  #undef PIN
  #undef MX3
  #undef GAPA
  #undef GAPB
  #undef EX
  #undef VRD
  #undef KRD
  #undef STEP
  #undef ENDW
  #undef CMASKX
  {auto rr=__builtin_amdgcn_permlane32_swap(__float_as_uint(l_reg),__float_as_uint(l_reg),false,false);l_reg=__uint_as_float(rr[0])+__uint_as_float(rr[1]);}
  if(hi==0)wsf[32+r32]=l_reg;asm volatile("s_waitcnt lgkmcnt(0)":::"memory");
  float rli[16];
  #pragma unroll
  for(int r=0;r<16;++r)rli[r]=__builtin_amdgcn_rcpf(wsf[32+crow(r,hi)]);
  bf16*Ow=Ow0+(long)(wid*QBLK)*OP;
  { bf16*stg=(bf16*)(shm+LDS_OST)+wid*2048;
    #pragma unroll
    for(int r=0;r<16;++r){const int orow=crow(r,hi);
      #pragma unroll
      for(int d0=0;d0<2;++d0)stg[orow*64+d0*32+r32]=__float2bfloat16(o[d0][r]*rli[r]);}
    asm volatile("s_waitcnt lgkmcnt(0)":::"memory");
    #pragma unroll
    for(int i=0;i<4;++i){const int row=i*8+(lane>>3),ch=lane&7; const u32x4 v=*(const u32x4*)(stg+row*64+ch*8); ATTN_STORE16(Ow+(long)row*OP+ch*8,v);} }
  asm volatile("s_waitcnt lgkmcnt(0)\n\ts_barrier":::"memory");
  #undef DMA_K
  #undef DMA_V
  #undef CMASK
  #undef CINIT
  #undef CBASE
  #undef CFILL
  #undef PT
  #undef START
  #undef RESC
  #undef ROT
}
constexpr int ATTN_LDS_BYTES=LDS_BYTES;
#undef SBAR
#undef WAIT_BAR
}
__device__ __forceinline__ float wave_sum(float v) {
#pragma unroll
    for (int o = 1; o < 64; o <<= 1) v += __shfl_xor(v, o);
    return v;
}
__device__ __forceinline__ float wave_max(float v) {
#pragma unroll
    for (int o = 1; o < 64; o <<= 1) v = fmaxf(v, __shfl_xor(v, o));
    return v;
}
__device__ __forceinline__ int opaque_zero() { int z; asm volatile("v_mov_b32 %0, 0" : "=v"(z)); return z; }

__device__ __forceinline__ void p0_transpose_item(const float* W, int K, int N, bf16* WT, int dest_row0, int k0, int n0, const float* gk, LAS float* scr, int lane) {
    float wv[32];
#pragma unroll
    for (int i = 0; i < 32; ++i) { const int kk = 2 * i + (lane >> 5); wv[i] = W[(size_t)(k0 + kk) * N + n0 + (lane & 31)]; }
    if (gk) {
#pragma unroll
        for (int i = 0; i < 32; ++i) wv[i] *= gk[k0 + 2 * i + (lane >> 5)]; }
#pragma unroll
    for (int i = 0; i < 32; ++i) { const int kk = 2 * i + (lane >> 5); scr[kk * 33 + (lane & 31)] = wv[i]; }
    LDS_WAIT(); asm volatile("" ::: "memory");
    const int c = lane & 7;
#pragma unroll
    for (int j = 0; j < 4; ++j) { const int n = (lane >> 3) + 8 * j; const LAS float* s = scr + (8 * c) * 33 + n;
        v4u o; o.x = pk2(s[0 * 33], s[1 * 33]); o.y = pk2(s[2 * 33], s[3 * 33]); o.z = pk2(s[4 * 33], s[5 * 33]); o.w = pk2(s[6 * 33], s[7 * 33]);
        *(GAS v4u*)(WT + (size_t)(dest_row0 + n) * K + k0 + 8 * c) = o; }
    LDS_WAIT(); asm volatile("" ::: "memory");
}
__device__ __forceinline__ void p0_matrix_item(const float* W, int K, int N, bf16* WT, const float* gk, int mode, int item, LAS float* scr, int lane) {
    const int nblk = N / 32, kb = item / nblk, nb = item - kb * nblk, k0 = 64 * kb, n0 = 32 * nb;
    const int dr = (mode == 0) ? n0 : (256 * (n0 >> 7) + (n0 & 127) + (mode == 2 ? 128 : 0));
    p0_transpose_item(W, K, N, WT, dr, k0, n0, gk, scr, lane);
}
template <int NR>
__device__ __forceinline__ void rows_to_bf16_ssq(const float* xrow, bf16* orow, float* ssq16, int lane) {
    f32x4 v[NR][4];
#pragma unroll
    for (int r = 0; r < NR; ++r) { const GAS f32x4* xr = (const GAS f32x4*)(xrow + (size_t)r * 1024) + lane;
#pragma unroll
        for (int j = 0; j < 4; ++j) v[r][j] = xr[64 * j]; }
#pragma unroll
    for (int r = 0; r < NR; ++r) { float s = 0.f;
#pragma unroll
        for (int j = 0; j < 4; ++j) s += (v[r][j].x * v[r][j].x + v[r][j].y * v[r][j].y) + (v[r][j].z * v[r][j].z + v[r][j].w * v[r][j].w);
        s = wave_sum(s);
        GAS unsigned long long* o8 = (GAS unsigned long long*)(orow + (size_t)r * 1024) + lane;
#pragma unroll
        for (int j = 0; j < 4; ++j) o8[64 * j] = (unsigned long long)pk2(v[r][j].x, v[r][j].y) | ((unsigned long long)pk2(v[r][j].z, v[r][j].w) << 32);
        if (lane < 16) ssq16[r * 16 + lane] = (lane == 0) ? s : 0.f; }
}

__device__ __forceinline__ void s5_naive_unit(int b, int g, const bf16* U, bf16* Y, const float* lam_re, const float* lam_im, const float* log_dt, const float* b_re, const float* b_im,
                                              const float* c_re, const float* c_im, const float* dvec, int lane) {
    const int p = lane;
    const float lr = lam_re[g * 64 + p], li = lam_im[g * 64 + p], dt = expf(log_dt[g]);
    const float mag = expf(lr * dt), ar = mag * cosf(li * dt), ai = mag * sinf(li * dt);
    const float den = lr * lr + li * li, nr = ar - 1.0f, fr = (nr * lr + ai * li) / den, fi = (ai * lr - nr * li) / den;
    float bbr[16], bbi[16], cr[16], ci[16];
#pragma unroll
    for (int c = 0; c < 16; ++c) { const float br = b_re[((size_t)g * 64 + p) * 16 + c], bi = b_im[((size_t)g * 64 + p) * 16 + c]; bbr[c] = fr * br - fi * bi; bbi[c] = fr * bi + fi * br;
        cr[c] = c_re[((size_t)g * 16 + c) * 64 + p]; ci[c] = c_im[((size_t)g * 16 + c) * 64 + p]; }
    const int ch = ((lane & 1) << 3) | ((lane & 2) << 1) | ((lane & 4) >> 1) | ((lane & 8) >> 3);
    const float dch = dvec[16 * g + ch];
    const int z0 = opaque_zero();
    constexpr int TP = 16;
    const bf16* up = U + ((size_t)g * TOK + (size_t)b * SEQ) * 16 + z0;
    bf16* yp = Y + ((size_t)g * TOK + (size_t)b * SEQ) * 16 + ch;
    float xr = 0.f, xi = 0.f;
#pragma unroll 2
    for (int s = 0; s < SEQ; ++s) {
        const v4u w0 = *(const GAS v4u*)(up + (size_t)s * TP), w1 = *(const GAS v4u*)(up + (size_t)s * TP + 8);
        const float uch = bf2f(up[(size_t)s * TP + ch]);
        const float uu[16] = {bflo(w0.x), bfhi(w0.x), bflo(w0.y), bfhi(w0.y), bflo(w0.z), bfhi(w0.z), bflo(w0.w), bfhi(w0.w), bflo(w1.x), bfhi(w1.x), bflo(w1.y), bfhi(w1.y), bflo(w1.z), bfhi(w1.z), bflo(w1.w), bfhi(w1.w)};
        float bur = 0.f, bui = 0.f;
#pragma unroll
        for (int c = 0; c < 16; ++c) { bur += bbr[c] * uu[c]; bui += bbi[c] * uu[c]; }
        const float nxr = ar * xr - ai * xi + bur, nxi = ar * xi + ai * xr + bui; xr = nxr; xi = nxi;
        float v[16];
#pragma unroll
        for (int c = 0; c < 16; ++c) v[c] = cr[c] * xr - ci[c] * xi;
        float w[8], x4[4], x2[2], z;
        { const bool bit = lane & 1;
#pragma unroll
          for (int j = 0; j < 8; ++j) { const float send = bit ? v[j] : v[j + 8], keep = bit ? v[j + 8] : v[j]; w[j] = keep + __shfl_xor(send, 1); } }
        { const bool bit = lane & 2;
#pragma unroll
          for (int j = 0; j < 4; ++j) { const float send = bit ? w[j] : w[j + 4], keep = bit ? w[j + 4] : w[j]; x4[j] = keep + __shfl_xor(send, 2); } }
        { const bool bit = lane & 4;
#pragma unroll
          for (int j = 0; j < 2; ++j) { const float send = bit ? x4[j] : x4[j + 2], keep = bit ? x4[j + 2] : x4[j]; x2[j] = keep + __shfl_xor(send, 4); } }
        { const bool bit = lane & 8; const float send = bit ? x2[0] : x2[1], keep = bit ? x2[1] : x2[0]; z = keep + __shfl_xor(send, 8); }
        z += __shfl_xor(z, 16); z += __shfl_xor(z, 32);
        const float yv = z + dch * uch;
        const float ge = 0.5f * yv * (1.0f + erff(yv * 0.70710678118654752f));
        if (lane < 16) yp[(size_t)s * TP] = (bf16)f2bf(ge);
    }
}

__device__ __forceinline__ void memattn_naive_unit(int tok, int h, const bf16* QM, const bf16* memk, const bf16* memv, bf16* mix, LAS float* ps, int lane) {
    const int b = tok >> 12; const int z0 = opaque_zero();
    const float qv = bf2f(QM[(size_t)tok * 256 + h * 64 + lane]);
    float q[64];
#pragma unroll
    for (int d = 0; d < 64; ++d) q[d] = __shfl(qv, d);
    float sc[4];
#pragma unroll
    for (int i = 0; i < 4; ++i) { const int j = lane + 64 * i; const GAS v4u* kr = (const GAS v4u*)(memk + ((size_t)(b * 256 + j)) * 256 + h * 64 + z0); float a = 0.f;
#pragma unroll
        for (int c = 0; c < 8; ++c) { const v4u w = kr[c]; a += q[8 * c] * bflo(w.x) + q[8 * c + 1] * bfhi(w.x) + q[8 * c + 2] * bflo(w.y) + q[8 * c + 3] * bfhi(w.y) + q[8 * c + 4] * bflo(w.z) + q[8 * c + 5] * bfhi(w.z) + q[8 * c + 6] * bflo(w.w) + q[8 * c + 7] * bfhi(w.w); }
        sc[i] = a; }
    const float m = wave_max(fmaxf(fmaxf(sc[0], sc[1]), fmaxf(sc[2], sc[3])));
    float l = 0.f;
#pragma unroll
    for (int i = 0; i < 4; ++i) { const float pe = __builtin_amdgcn_exp2f(sc[i] - m); l += pe; ps[lane + 64 * i] = pe; }
    l = wave_sum(l);
    LDS_WAIT(); asm volatile("" ::: "memory");
    float o = 0.f; const bf16* vp = memv + (size_t)(b * 256) * 256 + h * 64 + lane;
#pragma unroll 8
    for (int j = 0; j < 256; ++j) o += ps[j] * bf2f(vp[(size_t)j * 256]);
    mix[(size_t)tok * 1024 + 768 + h * 64 + lane] = (bf16)f2bf(o / l);
    LDS_WAIT(); asm volatile("" ::: "memory");
}

__device__ __forceinline__ float dot64_bf16(const float (&q)[64], const GAS v4u* kr) {
    float a = 0.f;
#pragma unroll
    for (int c = 0; c < 8; ++c) { const v4u w = kr[c]; a += q[8 * c] * bflo(w.x) + q[8 * c + 1] * bfhi(w.x) + q[8 * c + 2] * bflo(w.y) + q[8 * c + 3] * bfhi(w.y) + q[8 * c + 4] * bflo(w.z) + q[8 * c + 5] * bfhi(w.z) + q[8 * c + 6] * bflo(w.w) + q[8 * c + 7] * bfhi(w.w); }
    return a;
}
__device__ __forceinline__ void moba_naive_unit(int tok, int h, const bf16* Q1, const bf16* K1, const bf16* V1, const float* KMEAN, bf16* mix, LAS float* ps, int lane) {
    const int b = tok >> 12, s = tok & (SEQ - 1), qb = s >> 8; const int z0 = opaque_zero();
    const float qv = bf2f(Q1[(size_t)tok * TOKW + h * 64 + lane]);
    float q[64];
#pragma unroll
    for (int d = 0; d < 64; ++d) q[d] = __shfl(qv, d);
    float gate = -1e30f;
    { const int n = lane & 15; const GAS f32x4* km = (const GAS f32x4*)(KMEAN + ((size_t)((b * NHEAD + h) * NBLK + n)) * 64 + z0); float a = 0.f;
#pragma unroll
      for (int c = 0; c < 16; ++c) { const f32x4 w = km[c]; a += q[4 * c] * w.x + q[4 * c + 1] * w.y + q[4 * c + 2] * w.z + q[4 * c + 3] * w.w; }
      if (n < qb) gate = a; }
    float g[16];
#pragma unroll
    for (int n = 0; n < 16; ++n) g[n] = __shfl(gate, n);
    const int nsel = qb < 3 ? qb : 3;
    unsigned mask = 0u;
#pragma unroll
    for (int r = 0; r < 3; ++r) { float best = -3.0e38f; int bi = 0;
#pragma unroll
        for (int n = 0; n < 16; ++n) { const bool c = !((mask >> n) & 1u) && g[n] > best; best = c ? g[n] : best; bi = c ? n : bi; }
        if (r < nsel) mask |= 1u << bi; }
    int blk0 = 0, blk1 = 0, blk2 = 0, cnt = 0;
#pragma unroll
    for (int n = 0; n < 16; ++n) if ((mask >> n) & 1u) { if (cnt == 0) blk0 = n; else if (cnt == 1) blk1 = n; else blk2 = n; ++cnt; }
    const int nslots = nsel + 1;
    const float slope = __builtin_amdgcn_exp2f(-8.0f * (float)(h + 1) / 12.0f) * LOG2E;
    const bf16* kh = K1 + (size_t)b * SEQ * TOKW + h * 64 + z0;
    float mx = -3.0e38f;
#pragma unroll
    for (int sl = 0; sl < 4; ++sl) if (sl < nslots) {
        const int blk = (sl == nsel) ? qb : (sl == 0 ? blk0 : (sl == 1 ? blk1 : blk2));
#pragma unroll
        for (int i = 0; i < 4; ++i) { const int j = lane + 64 * i, pos = blk * 256 + j;
            float a = dot64_bf16(q, (const GAS v4u*)(kh + (size_t)pos * TOKW)) + slope * (float)(pos - s);
            if (pos > s) a = -3.0e38f;
            ps[sl * 256 + j] = a; mx = fmaxf(mx, a); } }
    mx = wave_max(mx);
    LDS_WAIT(); asm volatile("" ::: "memory");
    float l = 0.f;
#pragma unroll
    for (int sl = 0; sl < 4; ++sl) if (sl < nslots) {
#pragma unroll
        for (int i = 0; i < 4; ++i) { const int j = lane + 64 * i; const float a = ps[sl * 256 + j]; const float pe = (a < -1.0e37f) ? 0.f : __builtin_amdgcn_exp2f(a - mx); l += pe; ps[sl * 256 + j] = pe; } }
    l = wave_sum(l);
    LDS_WAIT(); asm volatile("" ::: "memory");
    float o = 0.f; const bf16* vh = V1 + (size_t)b * SEQ * TOKW + h * 64 + lane;
#pragma unroll
    for (int sl = 0; sl < 4; ++sl) if (sl < nslots) {
        const int blk = (sl == nsel) ? qb : (sl == 0 ? blk0 : (sl == 1 ? blk1 : blk2));
        const bf16* vp = vh + (size_t)(blk * 256) * TOKW;
#pragma unroll 8
        for (int j = 0; j < 256; ++j) o += ps[sl * 256 + j] * bf2f(vp[(size_t)j * TOKW]); }
    mix[(size_t)tok * 1024 + h * 64 + lane] = (bf16)f2bf(o / l);
    LDS_WAIT(); asm volatile("" ::: "memory");
}

constexpr int S5_PITCH = 272;
constexpr int S5_WST = 0, S5_WYC = 128 * S5_PITCH, S5_KT = 2 * 128 * S5_PITCH, S5_TAB_BYTES = S5_KT + 10 * 512;
constexpr int S5_XS = S5_TAB_BYTES, S5_XS_BYTES = 32 * S5_PITCH;
static_assert(S5_XS + NWAVES * S5_XS_BYTES <= RING_BYTES, "S5 LDS map");
typedef short s5_bf16x8 __attribute__((ext_vector_type(8)));
typedef float s5_f32x16 __attribute__((ext_vector_type(16)));

__device__ __forceinline__ void s5_apow(float lr, float li, float dt, int n, float& pr, float& pi) { const float m = expf(lr * dt * (float)n), th = li * dt * (float)n; pr = m * cosf(th); pi = m * sinf(th); }
__device__ __forceinline__ void s5_apow_fast(float lr, float li, float dt, int n, float& pr, float& pi) { const float m = __expf(lr * dt * (float)n), th = li * dt * (float)n; pr = m * __cosf(th); pi = m * __sinf(th); }
__device__ __forceinline__ void s5_zoh(float lr, float li, float dt, float& fr, float& fi) {
    float ar, ai; s5_apow(lr, li, dt, 1, ar, ai); const float den = lr * lr + li * li, nr = ar - 1.0f; fr = (nr * lr + ai * li) / den; fi = (ai * lr - nr * li) / den;
}
__device__ __forceinline__ void s5_tab_wst(int g, int jt, unsigned char* tab, const float* lam_re, const float* lam_im, const float* log_dt, const float* b_re, const float* b_im, int lane) {
    const int s = lane >> 3, cp = lane & 7; const float dt = expf(log_dt[g]);
    float zr, zi, mylr, myli;
    { const int p = (jt >> 1) * 32 + (lane & 31); mylr = lam_re[g * 64 + p]; myli = lam_im[g * 64 + p]; s5_zoh(mylr, myli, dt, zr, zi); }
#pragma unroll 4
    for (int r = 0; r < 32; ++r) { const int p = (jt >> 1) * 32 + r; const float lr = __shfl(mylr, r), li = __shfl(myli, r), fr = __shfl(zr, r), fi = __shfl(zi, r);
        float pr, pi; s5_apow_fast(lr, li, dt, 7 - s, pr, pi);
        float o[2];
#pragma unroll
        for (int e = 0; e < 2; ++e) { const int c = 2 * cp + e; const float br = b_re[((size_t)g * 64 + p) * 16 + c], bi = b_im[((size_t)g * 64 + p) * 16 + c];
            const float bbr = fr * br - fi * bi, bbi = fr * bi + fi * br; o[e] = (jt & 1) ? (pr * bbi + pi * bbr) : (pr * bbr - pi * bbi); }
        *(GAS unsigned*)(tab + S5_WST + (32 * jt + r) * S5_PITCH + (16 * s + 2 * cp) * 2) = pk2(o[0], o[1]); }
}
__device__ __forceinline__ void s5_tab_const(int g, float* ctab, const float* lam_re, const float* lam_im, const float* log_dt, int lane) {
    const float dt = expf(log_dt[g]); float xr, xi; s5_apow(lam_re[g * 64 + lane], lam_im[g * 64 + lane], dt, 1, xr, xi);
#pragma unroll
    for (int q = 0; q < 3; ++q) { const float nr = xr * xr - xi * xi, ni = 2.0f * xr * xi; xr = nr; xi = ni; }
    const float ar = xr, ai = xi;
#pragma unroll
    for (int q = 0; q < 5; ++q) { const float nr = xr * xr - xi * xi, ni = 2.0f * xr * xi; xr = nr; xi = ni; }
    *(GAS f32x4*)(ctab + ((size_t)g * 64 + lane) * 4) = (f32x4){ar, ai, xr, xi};
}
__device__ __forceinline__ void s5_tab_wyc(int g, int t, unsigned char* tab, const float* lam_re, const float* lam_im, const float* log_dt, const float* c_re, const float* c_im, int lane) {
    const int p = lane; const float dt = expf(log_dt[g]); float pr, pi; s5_apow_fast(lam_re[g * 64 + p], lam_im[g * 64 + p], dt, t + 1, pr, pi);
#pragma unroll
    for (int c = 0; c < 16; ++c) { const float cr = c_re[((size_t)g * 16 + c) * 64 + p], ci = c_im[((size_t)g * 16 + c) * 64 + p];
        *(GAS unsigned*)(tab + S5_WYC + (16 * t + c) * S5_PITCH + 4 * p) = pk2(cr * pr - ci * pi, -(cr * pi + ci * pr)); }
}
__device__ __forceinline__ void s5_tab_kt(int g, int d, unsigned char* tab, const float* lam_re, const float* lam_im, const float* log_dt, const float* b_re, const float* b_im, const float* c_re, const float* c_im,
                                          const float* dvec, int lane) {
    const float dt = expf(log_dt[g]); float mr, mi;
    { const float lr = lam_re[g * 64 + lane], li = lam_im[g * 64 + lane]; float pr, pi, fr, fi; s5_apow_fast(lr, li, dt, d, pr, pi); s5_zoh(lr, li, dt, fr, fi); mr = pr * fr - pi * fi; mi = pr * fi + pi * fr; }
    float acc[4] = {0.f, 0.f, 0.f, 0.f};
#pragma unroll 8
    for (int p = 0; p < 64; ++p) { const float pmr = __shfl(mr, p), pmi = __shfl(mi, p);
#pragma unroll
        for (int i = 0; i < 4; ++i) { const int e = lane + 64 * i, c = e >> 4, c2 = e & 15;
            const float br = b_re[((size_t)g * 64 + p) * 16 + c2], bi = b_im[((size_t)g * 64 + p) * 16 + c2], cr = c_re[((size_t)g * 16 + c) * 64 + p], ci = c_im[((size_t)g * 16 + c) * 64 + p];
            const float tr = pmr * br - pmi * bi, ti = pmr * bi + pmi * br; acc[i] += cr * tr - ci * ti; } }
#pragma unroll
    for (int i = 0; i < 4; ++i) { const int e = lane + 64 * i, c = e >> 4, c2 = e & 15; float v = acc[i]; if (d == 0 && c == c2) v += dvec[16 * g + c];
        *(GAS bf16*)(tab + S5_KT + (d + 1) * 512 + c * 32 + c2 * 2) = (bf16)f2bf(v);
        if (d == 0) *(GAS bf16*)(tab + S5_KT + c * 32 + c2 * 2) = (bf16)0; }
}

template <bool FINAL>
__device__ __forceinline__ void s5_unit(int g, int seg, const bf16* Ug, bf16* Yg, const unsigned char* tab, float* Ebuf, const float* ctab, LAS unsigned char* L) {
    int tid_ = threadIdx.x; asm volatile("" : "+v"(tid_));
    const int tid = tid_, lane = tid & 63, r32 = lane & 31, hi = lane >> 5, b = __builtin_amdgcn_readfirstlane(tid >> 6);
    { const int npc = (FINAL ? S5_TAB_BYTES : S5_WYC) / 1024; const unsigned l0 = (unsigned)(uintptr_t)(unsigned char*)L;
      for (int i = b; i < npc; i += NWAVES) attn_body::glds16(tab + (size_t)i * 1024 + lane * 16, (unsigned)__builtin_amdgcn_readfirstlane(l0 + i * 1024)); }
    const size_t tok0 = (size_t)g * TOK + (size_t)b * SEQ + (size_t)seg * 256;
    s5_bf16x8 A[8];
    { const bf16* up = Ug + (tok0 + 8 * r32) * 16 + 8 * hi;
#pragma unroll
      for (int s = 0; s < 8; ++s) A[s] = *(const GAS s5_bf16x8*)(up + s * 16); }
    float aLr[2], aLi[2], aSr[2], aSi[2];
#pragma unroll
    for (int k = 0; k < 2; ++k) { const f32x4 cv = *(const GAS f32x4*)(ctab + ((size_t)g * 64 + 32 * k + r32) * 4); aLr[k] = cv.x; aLi[k] = cv.y; aSr[k] = cv.z; aSi[k] = cv.w; }
    float cr[2] = {0.f, 0.f}, ci[2] = {0.f, 0.f};
    if (FINAL) {
        const float* eb = Ebuf + ((size_t)(b * NGRP + g) * 16) * 128;
        f32x2 ev[15][2];
#pragma unroll
        for (int j = 0; j < 15; ++j)
#pragma unroll
            for (int k = 0; k < 2; ++k) ev[j][k] = (j < seg) ? *(const GAS f32x2*)(eb + (size_t)j * 128 + 2 * (32 * k + r32)) : (f32x2){0.f, 0.f};
#pragma unroll
        for (int j = 0; j < 15; ++j) if (j < seg) {
#pragma unroll
            for (int k = 0; k < 2; ++k) { const float nr = aSr[k] * cr[k] - aSi[k] * ci[k] + ev[j][k].x, ni = aSr[k] * ci[k] + aSi[k] * cr[k] + ev[j][k].y; cr[k] = nr; ci[k] = ni; } }
    }
    asm volatile("s_waitcnt vmcnt(0)" ::: "memory");
    __syncthreads();
    s5_f32x16 S[4];
#pragma unroll
    for (int j = 0; j < 4; ++j) { S[j] = s5_f32x16{};
#pragma unroll
        for (int s = 0; s < 8; ++s) { const s5_bf16x8 bf = *(const LAS s5_bf16x8*)(L + S5_WST + (32 * j + r32) * S5_PITCH + (16 * s + 8 * hi) * 2);
            S[j] = __builtin_amdgcn_mfma_f32_32x32x16_bf16(A[s], bf, S[j], 0, 0, 0); } }
    if (!FINAL) {
        float e_r[2], e_i[2];
#pragma unroll
        for (int k = 0; k < 2; ++k) { const float a2r = aLr[k] * aLr[k] - aLi[k] * aLi[k], a2i = 2.0f * aLr[k] * aLi[k], a4r = a2r * a2r - a2i * a2i, a4i = 2.0f * a2r * a2i;
            const float a5r = a4r * aLr[k] - a4i * aLi[k], a5i = a4r * aLi[k] + a4i * aLr[k];
            float xr = S[2 * k][0], xi = S[2 * k + 1][0];
#pragma unroll
            for (int reg = 1; reg < 16; ++reg) { const float mr = ((reg & 3) == 0) ? a5r : aLr[k], mi = ((reg & 3) == 0) ? a5i : aLi[k];
                const float nr = mr * xr - mi * xi + S[2 * k][reg], ni = mr * xi + mi * xr + S[2 * k + 1][reg]; xr = nr; xi = ni; }
            const float fr_ = hi ? xr : (a4r * xr - a4i * xi), fi_ = hi ? xi : (a4r * xi + a4i * xr);
            e_r[k] = fr_ + __shfl_xor(fr_, 32); e_i[k] = fi_ + __shfl_xor(fi_, 32); }
        if (hi == 0) { float* eb = Ebuf + ((size_t)(b * NGRP + g) * 16 + seg) * 128;
#pragma unroll
            for (int k = 0; k < 2; ++k) *(GAS f32x2*)(eb + 2 * (32 * k + r32)) = (f32x2){e_r[k], e_i[k]}; }
    } else {
        LAS unsigned char* XS = L + S5_XS + b * S5_XS_BYTES;
#pragma unroll
        for (int i = 0; i < 8; ++i) { const bool own = ((i & 1) == hi);
            if (own) {
#pragma unroll
                for (int q = 0; q < 4; ++q) { const int reg = 4 * (i >> 1) + q, chunk = 4 * i + q;
#pragma unroll
                    for (int k = 0; k < 2; ++k) { *(LAS unsigned*)(XS + chunk * S5_PITCH + 4 * (32 * k + r32)) = pg8::cvt_pk_bf16(cr[k], ci[k]);
                        const float nr = aLr[k] * cr[k] - aLi[k] * ci[k] + S[2 * k][reg], ni = aLr[k] * ci[k] + aLi[k] * cr[k] + S[2 * k + 1][reg]; cr[k] = nr; ci[k] = ni; } } }
#pragma unroll
            for (int k = 0; k < 2; ++k) { const float orr = __shfl_xor(cr[k], 32), oi = __shfl_xor(ci[k], 32); cr[k] = own ? cr[k] : orr; ci[k] = own ? ci[k] : oi; } }
        s5_bf16x8 Xf[8];
#pragma unroll
        for (int kk = 0; kk < 8; ++kk) Xf[kk] = *(const LAS s5_bf16x8*)(XS + r32 * S5_PITCH + (16 * kk + 8 * hi) * 2);
        s5_f32x16 Yc[4];
#pragma unroll
        for (int j = 0; j < 4; ++j) { Yc[j] = s5_f32x16{};
#pragma unroll
            for (int s = 0; s < 8; ++s) if (s <= 2 * j + 1) { const int d1 = 2 * j + (r32 >> 4) - s + 1;
                const s5_bf16x8 bf = *(const LAS s5_bf16x8*)(L + S5_KT + d1 * 512 + (r32 & 15) * 32 + 16 * hi);
                Yc[j] = __builtin_amdgcn_mfma_f32_32x32x16_bf16(A[s], bf, Yc[j], 0, 0, 0); }
#pragma unroll
            for (int kk = 0; kk < 8; ++kk) { const s5_bf16x8 bf = *(const LAS s5_bf16x8*)(L + S5_WYC + (32 * j + r32) * S5_PITCH + (16 * kk + 8 * hi) * 2);
                Yc[j] = __builtin_amdgcn_mfma_f32_32x32x16_bf16(Xf[kk], bf, Yc[j], 0, 0, 0); } }
        asm volatile("s_waitcnt lgkmcnt(0)" ::: "memory");
#pragma unroll
        for (int j = 0; j < 4; ++j)
#pragma unroll
            for (int reg = 0; reg < 16; reg += 2) { const pg8::f32x2 ge = pg8::gelu_pk((pg8::f32x2){Yc[j][reg], Yc[j][reg + 1]});
                const int chunk = (reg & 3) + 8 * (reg >> 2) + 4 * hi, tokl = 8 * chunk + 2 * j + (r32 >> 4), c = r32 & 15;
                const unsigned gw_ = pg8::cvt_pk_bf16(ge.x, ge.y); *(LAS bf16*)(XS + tokl * 32 + c * 2) = (bf16)(gw_ & 0xffffu); *(LAS bf16*)(XS + (tokl + 8) * 32 + c * 2) = (bf16)(gw_ >> 16); }
        asm volatile("s_waitcnt lgkmcnt(0)" ::: "memory");
        bf16* yo = Yg + tok0 * 16;
#pragma unroll
        for (int i = 0; i < 8; ++i) { const int pc = lane + 64 * i; const v4u w = *(const LAS v4u*)(XS + 16 * pc); *(GAS v4u*)(yo + 8 * pc) = w; }
    }
    __syncthreads();
}

#ifndef MK_ONE_LAUNCH
#define MK_ONE_LAUNCH 1
#endif
constexpr int N_PHASES = 14;
struct Args { const float* in[23]; float* out; unsigned char* ws; int ph_lo, ph_hi; };

#ifndef PROBE_P0
#define PROBE_P0 0
#endif
#define P0_ITEM(it) do { \
            int r = it; \
            if (r < I_TKT) { s5_tab_kt(r >> 3, r & 7, S5TAB + (size_t)(r >> 3) * S5_TAB_BYTES, args.in[6], args.in[7], args.in[8], args.in[9], args.in[10], args.in[11], args.in[12], args.in[13], lane); break; } r -= I_TKT; \
            if (r < I_TST) { s5_tab_wst(r >> 2, r & 3, S5TAB + (size_t)(r >> 2) * S5_TAB_BYTES, args.in[6], args.in[7], args.in[8], args.in[9], args.in[10], lane); break; } r -= I_TST; \
            if (r < I_TYC) { s5_tab_wyc(r >> 3, r & 7, S5TAB + (size_t)(r >> 3) * S5_TAB_BYTES, args.in[6], args.in[7], args.in[8], args.in[11], args.in[12], lane); break; } r -= I_TYC; \
            if (r < I_TCO) { s5_tab_const(r, S5C, args.in[6], args.in[7], args.in[8], lane); break; } r -= I_TCO; \
            if (r < I_SQ) { p0_matrix_item(args.in[5], 1024, 1024, WIN0, mixg, 0, r, scr, lane); break; } r -= I_SQ; \
            if (r < I_MKV) { p0_matrix_item(args.in[3], 1024, 512, WMKV, args.in[2], 0, r, scr, lane); break; } r -= I_MKV; \
            if (r < I_GLU) { p0_matrix_item(args.in[14], 768, 768, WGLU, nullptr, 0, r, scr, lane); break; } r -= I_GLU; \
            if (r < I_IN1) { p0_matrix_item(args.in[16], 1024, 2560, WIN1, mixg + 1024, 0, r, scr, lane); break; } r -= I_IN1; \
            if (r < I_SQ) { p0_matrix_item(args.in[17], 1024, 1024, WOUT0, nullptr, 0, r, scr, lane); break; } r -= I_SQ; \
            if (r < I_SQ) { p0_matrix_item(args.in[17] + 1024 * 1024, 1024, 1024, WOUT1, nullptr, 0, r, scr, lane); break; } r -= I_SQ; \
            if (r < I_GU) { p0_matrix_item(args.in[19], 1024, FFN, WGU0, ffng, 1, r, scr, lane); break; } r -= I_GU; \
            if (r < I_GU) { p0_matrix_item(args.in[20], 1024, FFN, WGU0, ffng, 2, r, scr, lane); break; } r -= I_GU; \
            if (r < I_GU) { p0_matrix_item(args.in[19] + (size_t)1024 * FFN, 1024, FFN, WGU1, ffng + 1024, 1, r, scr, lane); break; } r -= I_GU; \
            if (r < I_GU) { p0_matrix_item(args.in[20] + (size_t)1024 * FFN, 1024, FFN, WGU1, ffng + 1024, 2, r, scr, lane); break; } r -= I_GU; \
            if (r < I_DN) { p0_matrix_item(args.in[21], FFN, 1024, WDN0, nullptr, 0, r, scr, lane); break; } r -= I_DN; \
            p0_matrix_item(args.in[21] + (size_t)FFN * 1024, FFN, 1024, WDN1, nullptr, 0, r, scr, lane); \
        } while (0)
__global__ void __launch_bounds__(NWAVES * 64, 2) mega_fwd(Args args) {
    extern __shared__ __attribute__((aligned(16))) unsigned char lds[];
    LAS unsigned char* L = (LAS unsigned char*)lds;
    volatile LAS unsigned* MISC = (volatile LAS unsigned*)(L + MISC_OFF);
    const int tid = threadIdx.x, lane = tid & 63, wave = __builtin_amdgcn_readfirstlane(tid >> 6);
    const int G = gridDim.x; const int bx = blockIdx.x;
    const int vcu = (G % 8 == 0) ? (bx % 8) * (G / 8) + bx / 8 : bx;
    const int gw = vcu * NWAVES + wave, NGW = G * NWAVES;
    unsigned char* ws = args.ws;
    gu32* ctl = (gu32*)(ws + WS_CTL);
    for (int u = tid; u < (LDS_BYTES - LDSCTL_OFF) / 4; u += NWAVES * 64) ((LAS unsigned*)(L + LDSCTL_OFF))[u] = 0u;
    __syncthreads();
    XcdBarrier bar; bar.bar = (unsigned*)(ctl + CW_BAR); bar.x = 0; bar.st = nullptr;
    if (MK_ONE_LAUNCH) bar = xcd_barrier_post((unsigned*)(ctl + CW_BAR), MISC + 8);
#define MEMATTN_PHASE(u0_, us_) do { for (int un = (u0_); un < BATCH * MHEAD * NBLK; un += (us_)) { const int b_ = un >> 6, h_ = (un >> 4) & 3, qb_ = un & 15; const size_t qrow_ = (size_t)b_ * SEQ + (size_t)qb_ * 256; \
        attn_body::attn_unit<0, 8, 256, 256, 1024>((const attn_body::bf16*)(QM + qrow_ * 256 + h_ * 64), (const attn_body::bf16*)(MEMK + (size_t)b_ * MEML * 256 + h_ * 64), (const attn_body::bf16*)(MEMV + (size_t)b_ * MEML * 256 + h_ * 64), \
            (attn_body::bf16*)(MIX + qrow_ * 1024 + 768 + h_ * 64), 4, 0.f, nullptr, nullptr, 0, (char*)lds + RING_OFF); } } while (0)
    const int lo = args.ph_lo, hi = args.ph_hi;
#ifndef PROBE_DUP
#define PROBE_DUP -1
#endif
#define IN(k) (lo <= (k) && (k) < hi)
#define PH_REP(k) for (int rep_ = 0; rep_ < ((PROBE_DUP == (k)) ? 2 : 1); ++rep_)
#define SEAM(k) do { if (IN(k) && IN((k) + 1)) xcd_barrier(bar); } while (0)

    const float* x = args.in[0]; const float* mem = args.in[1];
    float* out = args.out;
    float* SS0 = (float*)(ws + WS_SS0); float* SSA = (float*)(ws + WS_SSA); float* SSB = (float*)(ws + WS_SSB); float* SSM = (float*)(ws + WS_SSM);
    unsigned char* S5TAB = ws + WS_S5TAB; float* S5E = (float*)(ws + WS_S5E); float* S5C = (float*)(ws + WS_S5TAB + (size_t)NGRP * S5_TAB_BYTES);
    float* KMP = (float*)(ws + WS_KMEAN);
    bf16* WIN0 = (bf16*)(ws + WS_WIN0); bf16* WGLU = (bf16*)(ws + WS_WGLU); bf16* WIN1 = (bf16*)(ws + WS_WIN1);
    bf16* WOUT0 = (bf16*)(ws + WS_WOUT0); bf16* WOUT1 = (bf16*)(ws + WS_WOUT1);
    bf16* WGU0 = (bf16*)(ws + WS_WGU0); bf16* WGU1 = (bf16*)(ws + WS_WGU1); bf16* WDN0 = (bf16*)(ws + WS_WDN0); bf16* WDN1 = (bf16*)(ws + WS_WDN1); bf16* WMKV = (bf16*)(ws + WS_WMKV);
    bf16* MEMB = (bf16*)(ws + WS_MEMB); bf16* MEMK = (bf16*)(ws + WS_MEMK); bf16* MEMV = (bf16*)(ws + WS_MEMV);
    bf16* XB = (bf16*)(ws + WS_XB); bf16* Ub = (bf16*)(ws + WS_U); bf16* Yb = (bf16*)(ws + WS_Y);
    bf16* Q1 = (bf16*)(ws + WS_Q1); bf16* K1 = (bf16*)(ws + WS_K1); bf16* V1 = (bf16*)(ws + WS_V1);
    bf16* QM = (bf16*)(ws + WS_QM); bf16* MIX = (bf16*)(ws + WS_MIX); bf16* Hb = (bf16*)(ws + WS_H);

    LAS float* scr = (LAS float*)(L + RING_OFF + wave * 16384);
    constexpr int I_SQ = 16 * 32, I_GLU = 12 * 24, I_IN1 = 16 * 80, I_GU = 16 * 88, I_DN = 44 * 32, I_MKV = 16 * 16;
    constexpr int I_TKT = NGRP * 8, I_TST = NGRP * 4, I_TYC = NGRP * 8, I_TCO = NGRP;
    constexpr int N_EARLY = I_TKT + I_TST + I_TYC + I_TCO + I_SQ + I_MKV;
    constexpr int NITEMS = I_TKT + I_TST + I_TYC + I_TCO + I_SQ + I_GLU + I_IN1 + 2 * I_SQ + 4 * I_GU + 2 * I_DN + I_MKV;
    const float* mixg = args.in[4]; const float* ffng = args.in[18];
    if (IN(0)) PH_REP(0) {
        if (rep_) xcd_barrier(bar);
        for (int it = gw; it < N_EARLY; it += NGW) P0_ITEM(it);
        for (int m = 4 * gw; m < TOK; m += 4 * NGW) rows_to_bf16_ssq<4>(x + (size_t)m * DM, XB + (size_t)m * DM, SS0 + (size_t)m * 16, lane);
        for (int m = gw; m < BATCH * MEML; m += NGW) rows_to_bf16_ssq<1>(mem + (size_t)m * DM, MEMB + (size_t)m * DM, SSM + (size_t)m * 16, lane);
    }
    SEAM(0);
    if (IN(1)) PH_REP(1) {
        if (rep_) xcd_barrier(bar);
        { pg8::Gemm g{XB, WIN0, TOK, 1024, 1024, 0}; pg8::StaticOrder S; S.init(TOK, 1024, G, bx);
          pg8::EpiProj E{SS0, Ub, 0, 3, 1, TOKW, 1.0f, QM, C2, TOK, nullptr, -1};
          pg8::gemm_phase<pg8::EpiProj, pg8::StaticOrder, true, true>(L + RING_OFF, g, S, E); }
    }
    SEAM(1);
    if (IN(2)) PH_REP(2) {
        if (rep_) xcd_barrier(bar);
        const int nS5 = (G == 256) ? 240 : G;
        if (bx < nS5) { for (int un = bx; un < NGRP * 16; un += nS5) s5_unit<false>(un >> 4, un & 15, Ub, Yb, S5TAB + (size_t)(un >> 4) * S5_TAB_BYTES, S5E, S5C, L + RING_OFF);
            for (int it = N_EARLY + bx * NWAVES + wave; it < NITEMS; it += nS5 * NWAVES) P0_ITEM(it); }
        if (G != 256 || bx >= nS5) { pg8::Gemm g{MEMB, WMKV, BATCH * MEML, 512, 1024, 0}; pg8::StaticOrder S; S.init(BATCH * MEML, 512, (G == 256) ? 16 : G, (G == 256) ? bx - nS5 : bx);
          pg8::EpiProj E{SSM, MEMK, (size_t)(WS_MEMV - WS_MEMK) / 2, 1, 2, 256, 1.0f, nullptr, 1.0f, 0, nullptr, -1};
          pg8::gemm_phase<pg8::EpiProj, pg8::StaticOrder, true, true>(L + RING_OFF, g, S, E); }
    }
    SEAM(2);
    if (IN(3)) PH_REP(3) {
        if (rep_) xcd_barrier(bar);
        for (int un = vcu; un < NGRP * 16; un += G) s5_unit<true>(un >> 4, un & 15, Ub, Yb, S5TAB + (size_t)(un >> 4) * S5_TAB_BYTES, S5E, S5C, L + RING_OFF);
    }
    SEAM(3);
    if (IN(4)) PH_REP(4) {
        if (rep_) xcd_barrier(bar);
        pg8::Gemm g{Yb, WGLU, TOK, TOKW, TOKW, 1}; pg8::StaticOrder S; S.init(TOK, TOKW, G, bx);
        pg8::EpiGlu E{Yb, TOKW, args.in[15], MIX, 1024, TOK};
        pg8::gemm_phase<pg8::EpiGlu, pg8::StaticOrder, true, true>(L + RING_OFF, g, S, E);
        if (G == 256) { if (bx >= 128) MEMATTN_PHASE(bx - 128, 128); }
        else MEMATTN_PHASE(vcu, G);
    }
    SEAM(4);
    if (IN(5)) PH_REP(5) {
        if (rep_) xcd_barrier(bar);
        pg8::Gemm g{MIX, WOUT0, TOK, 1024, 1024, 0}; pg8::StaticOrder S; S.init(TOK, 1024, G, bx);
        pg8::EpiRes E{x, nullptr, XB, SSA};
        pg8::gemm_phase<pg8::EpiRes, pg8::StaticOrder, true, true>(L + RING_OFF, g, S, E);
    }
    SEAM(5);
    if (IN(6)) PH_REP(6) {
        if (rep_) xcd_barrier(bar);
        pg8::Gemm g{XB, WGU0, TOK, 2 * FFN, 1024, 0}; pg8::StaticOrder S; S.init(TOK, 2 * FFN, G, bx);
        pg8::EpiGU E{SSA, Hb, FFN};
        pg8::gemm_phase<pg8::EpiGU, pg8::StaticOrder, true, true>(L + RING_OFF, g, S, E);
    }
    SEAM(6);
    if (IN(7)) PH_REP(7) {
        if (rep_) xcd_barrier(bar);
        pg8::Gemm g{Hb, WDN0, TOK, 1024, FFN, 0}; pg8::StaticOrder S; S.init(TOK, 1024, G, bx);
        pg8::EpiRes E{nullptr, XB, XB, SSB};
        pg8::gemm_phase<pg8::EpiRes, pg8::StaticOrder, true, true>(L + RING_OFF, g, S, E);
    }
    SEAM(7);
    if (IN(8)) PH_REP(8) {
        if (rep_) xcd_barrier(bar);
        pg8::Gemm g{XB, WIN1, TOK, 2560, 1024, 0}; pg8::StaticOrder S; S.init(TOK, 2560, G, bx);
        pg8::EpiProj E{SSB, Q1, (size_t)(WS_K1 - WS_Q1) / 2, 3, 3, TOKW, C2, QM, C2, 0, KMP, 1};
        pg8::gemm_phase<pg8::EpiProj, pg8::StaticOrder, true, true>(L + RING_OFF, g, S, E);
    }
    SEAM(8);
    if (IN(9)) PH_REP(9) {
        if (rep_) xcd_barrier(bar);
        for (int p_ = vcu; p_ < BATCH * NHEAD * 8; p_ += G) { const int bh_ = p_ >> 3, sg_ = p_ & 7, b_ = bh_ / NHEAD, h_ = bh_ - b_ * NHEAD;
            const float slope2 = __builtin_amdgcn_exp2f(-8.0f * (float)(h_ + 1) / 12.0f) * LOG2E;
#pragma unroll 1
            for (int k_ = 0; k_ < 2; ++k_) { const int qb_ = k_ ? 15 - sg_ : sg_; const size_t qrow_ = (size_t)b_ * SEQ + (size_t)qb_ * 256, krow_ = (size_t)b_ * SEQ;
                attn_body::attn_unit<1, 8, 768, 768, 1024>((const attn_body::bf16*)(Q1 + qrow_ * TOKW + h_ * 64), (const attn_body::bf16*)(K1 + krow_ * TOKW + h_ * 64), (const attn_body::bf16*)(V1 + krow_ * TOKW + h_ * 64),
                    (attn_body::bf16*)(MIX + qrow_ * 1024 + h_ * 64), 4 * qb_ + 4, slope2, KMP + (size_t)bh_ * 1024, KMP + (size_t)(8 * 12 * 16 * 64) + (size_t)bh_ * 1024, qb_, (char*)lds + RING_OFF); } }
        MEMATTN_PHASE(vcu, G);
    }
    SEAM(9);
    if (IN(10)) PH_REP(10) {
        if (rep_) xcd_barrier(bar);
        pg8::Gemm g{MIX, WOUT1, TOK, 1024, 1024, 0}; pg8::StaticOrder S; S.init(TOK, 1024, G, bx);
        pg8::EpiRes E{nullptr, XB, XB, SSA};
        pg8::gemm_phase<pg8::EpiRes, pg8::StaticOrder, true, true>(L + RING_OFF, g, S, E);
    }
    SEAM(10);
    if (IN(11)) PH_REP(11) {
        if (rep_) xcd_barrier(bar);
        pg8::Gemm g{XB, WGU1, TOK, 2 * FFN, 1024, 0}; pg8::StaticOrder S; S.init(TOK, 2 * FFN, G, bx);
        pg8::EpiGU E{SSA, Hb, FFN};
        pg8::gemm_phase<pg8::EpiGU, pg8::StaticOrder, true, true>(L + RING_OFF, g, S, E);
    }
    SEAM(11);
    if (IN(12)) PH_REP(12) {
        if (rep_) xcd_barrier(bar);
        pg8::Gemm g{Hb, WDN1, TOK, 1024, FFN, 0}; pg8::StaticOrder S; S.init(TOK, 1024, G, bx);
        pg8::EpiRes E{nullptr, XB, XB, SSB};
        pg8::gemm_phase<pg8::EpiRes, pg8::StaticOrder, true, true>(L + RING_OFF, g, S, E);
    }
    SEAM(12);
    if (IN(13)) PH_REP(13) {
        if (rep_) xcd_barrier(bar);
        const float* gf = args.in[22];
        const GAS f32x4* gp = (const GAS f32x4*)gf + 4 * lane; const f32x4 g0 = gp[0], g1 = gp[1], g2 = gp[2], g3 = gp[3];
        for (int m0 = 4 * gw; m0 < TOK; m0 += 4 * NGW) {
            v4u q[4][2]; f32x4 sq[4];
#pragma unroll
            for (int r = 0; r < 4; ++r) { const GAS v4u* xr = (const GAS v4u*)(XB + (size_t)(m0 + r) * DM) + 2 * lane; q[r][0] = xr[0]; q[r][1] = xr[1];
                sq[r] = *(const GAS f32x4*)(SSB + (size_t)(m0 + r) * 16 + 4 * (lane & 3)); }
#pragma unroll
            for (int r = 0; r < 4; ++r) { float s = (sq[r].x + sq[r].y) + (sq[r].z + sq[r].w); s += __shfl_xor(s, 1); s += __shfl_xor(s, 2);
                const float rs = __builtin_amdgcn_rsqf(s * (1.0f / 1024.0f) + 1e-6f);
                GAS f32x4* orow = (GAS f32x4*)(out + (size_t)(m0 + r) * DM) + 4 * lane; const v4u q0 = q[r][0], q1 = q[r][1];
                orow[0] = (f32x4){bflo(q0.x), bfhi(q0.x), bflo(q0.y), bfhi(q0.y)} * rs * g0; orow[1] = (f32x4){bflo(q0.z), bfhi(q0.z), bflo(q0.w), bfhi(q0.w)} * rs * g1;
                orow[2] = (f32x4){bflo(q1.x), bfhi(q1.x), bflo(q1.y), bfhi(q1.y)} * rs * g2; orow[3] = (f32x4){bflo(q1.z), bfhi(q1.z), bflo(q1.w), bfhi(q1.w)} * rs * g3; }
        }
    }
#undef IN
#undef SEAM
}

extern "C" void kernel_launch(void* const* d_in, const int* in_sizes, int n_in, void* d_out, int out_size, void* d_ws, size_t ws_size, hipStream_t stream) {
    static int grid = 0;
    if (grid == 0) {
        if (n_in != 23 || out_size != TOK * DM || ws_size < WS_END) { fprintf(stderr, "kernel_launch: unexpected shapes: n_in %d out %d ws %zu\n", n_in, out_size, ws_size); grid = -1; return; }
        int dev = 0, cus = 0, per_cu = 0;
        if (hipGetDevice(&dev) != hipSuccess || hipDeviceGetAttribute(&cus, hipDeviceAttributeMultiprocessorCount, dev) != hipSuccess) { grid = -1; return; }
        if (hipFuncSetAttribute((const void*)mega_fwd, hipFuncAttributeMaxDynamicSharedMemorySize, LDS_BYTES) != hipSuccess) { fprintf(stderr, "kernel_launch: hipFuncSetAttribute failed\n"); grid = -1; return; }
        if (hipOccupancyMaxActiveBlocksPerMultiprocessor(&per_cu, (const void*)mega_fwd, NWAVES * 64, LDS_BYTES) != hipSuccess || per_cu < 1)
            fprintf(stderr, "kernel_launch: occupancy query reports %d workgroups per CU\n", per_cu);
        (void)hipGetLastError();
        grid = cus;
    }
    if (grid < 0) return;
    if (hipMemsetAsync((char*)d_ws + WS_CTL, 0, CTL_ZERO_BYTES, stream) != hipSuccess) return;
    Args a{};
    for (int i = 0; i < 23; ++i) a.in[i] = (const float*)d_in[i];
    a.out = (float*)d_out; a.ws = (unsigned char*)d_ws;
#if MK_ONE_LAUNCH
    a.ph_lo = 0; a.ph_hi = N_PHASES;
    hipLaunchKernelGGL(mega_fwd, dim3(grid), dim3(NWAVES * 64), LDS_BYTES, stream, a);
#else
    for (int p = 0; p < N_PHASES; ++p) { a.ph_lo = p; a.ph_hi = p + 1; hipLaunchKernelGGL(mega_fwd, dim3(grid), dim3(NWAVES * 64), LDS_BYTES, stream, a); }
#endif
}
```
